# Optimizing an MI355X kernel written in HIP

```python
import jax, jax.numpy as jnp
from jax import lax
import numpy as np


D_MODEL = 1024
BATCH = 2
SEQ = 16384
DEPTH = 2

GRID_W = 64
CTX_LEN = 256
MIX_WIDTH = D_MODEL
FOURIER_WIDTH = D_MODEL // 4
FOURIER_HEADS = 4
GLA_VALUE_WIDTH = D_MODEL // 2
GLA_HEADS = 4
GLA_KEY_WIDTH = GLA_VALUE_WIDTH // 2
GLA_DK = GLA_KEY_WIDTH // GLA_HEADS
GLA_DV = GLA_VALUE_WIDTH // GLA_HEADS
GLA_GATE_RANK = 16
GLA_GATE_NORMALIZER = 16.0
GLA_CHUNK = 64
CONV_WIDTH = MIX_WIDTH - FOURIER_WIDTH - GLA_VALUE_WIDTH
CONV_KERNEL = 31
N_EXPERTS = 32
TOP_K = 4
D_FF = D_MODEL
SWIGLU_LIMIT = 7.0
SWIGLU_ALPHA = 1.702
MOE_BLOCK = 256
NORM_EPS = 1e-6

PROJ_WIDTHS = (FOURIER_WIDTH, GLA_KEY_WIDTH, GLA_KEY_WIDTH, GLA_VALUE_WIDTH, GLA_VALUE_WIDTH,
               GLA_GATE_RANK, GLA_GATE_RANK, 2 * CONV_WIDTH)
PROJ_SPLITS = tuple(int(s) for s in np.cumsum(PROJ_WIDTHS)[:-1])
IN_WIDTH = int(sum(PROJ_WIDTHS))

kernel_name = 'hybrid_fourier_gla_conformer_moe_dit'


def rmsnorm(x, g):
    xf = x.astype(jnp.float32)
    y = xf * lax.rsqrt(jnp.mean(xf * xf, axis=-1, keepdims=True) + NORM_EPS)
    return (y * g.astype(jnp.float32)).astype(x.dtype)


def layernorm(x, g, b):
    xf = x.astype(jnp.float32)
    mu = jnp.mean(xf, axis=-1, keepdims=True)
    xc = xf - mu
    y = xc * lax.rsqrt(jnp.mean(xc * xc, axis=-1, keepdims=True) + NORM_EPS)
    return (y * g.astype(jnp.float32) + b.astype(jnp.float32)).astype(x.dtype)


def modulate(h, shift, scale):
    return h * (1.0 + scale) + shift


def fourier_mix(u):
    bsz, length, _ = u.shape
    uf = u.astype(jnp.float32).reshape(bsz, length, FOURIER_HEADS, FOURIER_WIDTH // FOURIER_HEADS)
    y = jnp.real(jnp.fft.fftn(uf, axes=(1, 3), norm='ortho'))
    return y.reshape(bsz, length, FOURIER_WIDTH).astype(u.dtype)


def split_heads(t, d):
    bsz, length, _ = t.shape
    return t.reshape(bsz, length, GLA_HEADS, d).transpose(0, 2, 1, 3)


def gla_chunked(q, k, v, g, s0):
    bsz, heads, length, _ = q.shape
    dv = v.shape[-1]
    n = length // GLA_CHUNK

    def blocks(t):
        return t.astype(jnp.float32).reshape(bsz, heads, n, GLA_CHUNK, t.shape[-1])

    q, k, v, g = blocks(q), blocks(k), blocks(v), blocks(g)
    b = jnp.cumsum(g, axis=3)
    b_last = b[:, :, :, -1:, :]
    qe = q * jnp.exp(b)
    ke = k * jnp.exp(-b)
    past_mask = jnp.tril(jnp.ones((GLA_CHUNK, GLA_CHUNK), dtype=bool))
    scores = jnp.where(past_mask, jnp.einsum('bhnid,bhnjd->bhnij', qe, ke), 0.0)
    o_intra = jnp.einsum('bhnij,bhnje->bhnie', scores, v)
    ds = jnp.einsum('bhnjd,bhnje->bhnde', k * jnp.exp(b_last - b), v)
    decay = jnp.exp(b_last[:, :, :, 0, :])

    def step(s, inp):
        d, dsn = inp
        return d[..., None] * s + dsn, s

    s_final, s_start = lax.scan(step, s0.astype(jnp.float32),
                                (jnp.moveaxis(decay, 2, 0), jnp.moveaxis(ds, 2, 0)))
    s_start = jnp.moveaxis(s_start, 0, 2)
    o = o_intra + jnp.einsum('bhnid,bhnde->bhnie', qe, s_start)
    return o.reshape(bsz, heads, length, dv), s_final


def gla_two_streams(ctx_in, lat_in):
    qc, kc, vc, gfc, gbc = ctx_in
    ql, kl, vl, gfl, gbl = lat_in
    bsz = qc.shape[0]
    zeros = jnp.zeros((bsz, GLA_HEADS, GLA_DK, GLA_DV), jnp.float32)

    def rev(t):
        return t[:, :, ::-1]

    ocf, scf = gla_chunked(qc, kc, vc, gfc, zeros)
    olf, _ = gla_chunked(ql, kl, vl, gfl, scf)
    ocb, scb = gla_chunked(rev(qc), rev(kc), rev(vc), rev(gbc), zeros)
    olb, _ = gla_chunked(rev(ql), rev(kl), rev(vl), rev(gbl), scb)
    return ocf + rev(ocb), olf + rev(olb)


def gla_prep(p, wg2_f, bg_f, wg2_b, bg_b):
    q = split_heads(p[1], GLA_DK) * (GLA_DK ** -0.5)
    k = split_heads(p[2], GLA_DK)
    v = split_heads(p[3], GLA_DV)
    gf = jax.nn.log_sigmoid((p[5] @ wg2_f + bg_f).astype(jnp.float32)) / GLA_GATE_NORMALIZER
    gb = jax.nn.log_sigmoid((p[6] @ wg2_b + bg_b).astype(jnp.float32)) / GLA_GATE_NORMALIZER
    return (q, k, v, split_heads(gf, GLA_DK), split_heads(gb, GLA_DK))


def gla_output(o, r, norm_g):
    bsz, heads, length, dv = o.shape
    o = o.transpose(0, 2, 1, 3)
    o = o * lax.rsqrt(jnp.mean(o * o, axis=-1, keepdims=True) + NORM_EPS) * norm_g.astype(jnp.float32)
    return (o.reshape(bsz, length, heads * dv) * jax.nn.silu(r.astype(jnp.float32))).astype(r.dtype)


def conformer_conv(u, n_seg, conv_w, conv_b, ln_g, ln_b):
    bsz, length, _ = u.shape
    a, gate = jnp.split(u, 2, axis=-1)
    y = (a * jax.nn.sigmoid(gate)).reshape(bsz * n_seg, length // n_seg, CONV_WIDTH)
    y = lax.conv_general_dilated(
        y, conv_w.reshape(CONV_KERNEL, 1, CONV_WIDTH).astype(y.dtype),
        window_strides=(1,), padding=[(CONV_KERNEL // 2, CONV_KERNEL // 2)],
        dimension_numbers=('NWC', 'WIO', 'NWC'), feature_group_count=CONV_WIDTH)
    y = y.reshape(bsz, length, CONV_WIDTH) + conv_b
    return jax.nn.silu(layernorm(y, ln_g, ln_b))


def moe_ffn(h, router_w, router_b, w_gu, b_gu, w_dn, b_dn):
    n_tok = h.shape[0]
    logits = (h @ router_w + router_b).astype(jnp.float32)
    top_logits, top_idx = lax.top_k(logits, TOP_K)
    probs = jax.nn.softmax(top_logits, axis=-1).astype(h.dtype)
    n_assign = n_tok * TOP_K
    flat_e = top_idx.reshape(-1).astype(jnp.int32)
    order = jnp.argsort(flat_e).astype(jnp.int32)
    sorted_e = flat_e[order]
    counts = jnp.bincount(flat_e, length=N_EXPERTS).astype(jnp.int32)
    padded = (counts + MOE_BLOCK - 1) // MOE_BLOCK * MOE_BLOCK
    pad_end = jnp.cumsum(padded)
    pad_start = pad_end - padded
    sort_start = jnp.cumsum(counts) - counts
    slot = jnp.arange(n_assign, dtype=jnp.int32) - sort_start[sorted_e] + pad_start[sorted_e]
    n_blocks = -(-n_assign // MOE_BLOCK) + N_EXPERTS
    slot_tok = jnp.zeros((n_blocks * MOE_BLOCK,), jnp.int32).at[slot].set(order // TOP_K)
    block_e = jnp.minimum(
        jnp.searchsorted(pad_end, jnp.arange(n_blocks, dtype=jnp.int32) * MOE_BLOCK, side='right'),
        N_EXPERTS - 1)
    xb = h[slot_tok].reshape(n_blocks, MOE_BLOCK, h.shape[-1])

    def expert_block(args):
        xblk, e = args
        gu = xblk @ w_gu[e] + b_gu[e]
        gate = jnp.minimum(gu[:, :D_FF], SWIGLU_LIMIT)
        up = jnp.clip(gu[:, D_FF:], -SWIGLU_LIMIT, SWIGLU_LIMIT)
        act = gate * jax.nn.sigmoid(SWIGLU_ALPHA * gate) * (up + 1.0)
        return act @ w_dn[e] + b_dn[e]

    yb = lax.map(expert_block, (xb, block_e)).reshape(n_blocks * MOE_BLOCK, h.shape[-1])
    assign_slot = jnp.zeros((n_assign,), jnp.int32).at[order].set(slot)
    y = yb[assign_slot].reshape(n_tok, TOP_K, h.shape[-1])
    return jnp.einsum('nkd,nk->nd', y, probs)


def setup_inputs(seed: int = 0) -> dict:
    key = jax.random.key(seed)
    ks = jax.random.split(key, 26)

    def nrm(k, shape, scale):
        return jax.random.normal(k, shape, jnp.float32) * scale

    L = DEPTH
    return {
        'x': nrm(ks[0], (BATCH, SEQ, D_MODEL), 1.0),
        'c': nrm(ks[1], (BATCH, D_MODEL), 1.0),
        'ctx': nrm(ks[2], (BATCH, CTX_LEN, D_MODEL), 1.0),
        'c_ctx': nrm(ks[3], (D_MODEL,), 1.0),
        'norm1_g': 1.0 + nrm(ks[4], (L, D_MODEL), 0.01),
        'norm2_g': 1.0 + nrm(ks[5], (L, D_MODEL), 0.01),
        'w_mod': nrm(ks[6], (L, D_MODEL, 6 * D_MODEL), 0.5 * D_MODEL ** -0.5),
        'b_mod': nrm(ks[7], (L, 6 * D_MODEL), 0.02),
        'w_in': nrm(ks[8], (L, D_MODEL, IN_WIDTH), D_MODEL ** -0.5),
        'gla_wg2_f': nrm(ks[9], (L, GLA_GATE_RANK, GLA_KEY_WIDTH), GLA_GATE_RANK ** -0.5),
        'gla_bg_f': nrm(ks[10], (L, GLA_KEY_WIDTH), 0.1),
        'gla_wg2_b': nrm(ks[11], (L, GLA_GATE_RANK, GLA_KEY_WIDTH), GLA_GATE_RANK ** -0.5),
        'gla_bg_b': nrm(ks[12], (L, GLA_KEY_WIDTH), 0.1),
        'gla_norm_g': 1.0 + nrm(ks[13], (L, GLA_DV), 0.01),
        'conv_w': nrm(ks[14], (L, CONV_KERNEL, CONV_WIDTH), CONV_KERNEL ** -0.5),
        'conv_b': nrm(ks[15], (L, CONV_WIDTH), 0.02),
        'conv_ln_g': 1.0 + nrm(ks[16], (L, CONV_WIDTH), 0.01),
        'conv_ln_b': nrm(ks[17], (L, CONV_WIDTH), 0.02),
        'w_out': nrm(ks[18], (L, MIX_WIDTH, D_MODEL), MIX_WIDTH ** -0.5),
        'router_w': nrm(ks[19], (L, D_MODEL, N_EXPERTS), D_MODEL ** -0.5),
        'router_b': nrm(ks[20], (L, N_EXPERTS), 0.01),
        'exp_w_gu': nrm(ks[21], (L, N_EXPERTS, D_MODEL, 2 * D_FF), D_MODEL ** -0.5),
        'exp_b_gu': nrm(ks[22], (L, N_EXPERTS, 2 * D_FF), 0.01),
        'exp_w_dn': nrm(ks[23], (L, N_EXPERTS, D_FF, D_MODEL), D_FF ** -0.5),
        'exp_b_dn': nrm(ks[24], (L, N_EXPERTS, D_MODEL), 0.01),
        'final_norm_g': 1.0 + nrm(ks[25], (D_MODEL,), 0.01),
    }


def reference(x, c, ctx, c_ctx, norm1_g, norm2_g, w_mod, b_mod, w_in, gla_wg2_f, gla_bg_f,
              gla_wg2_b, gla_bg_b, gla_norm_g, conv_w, conv_b, conv_ln_g, conv_ln_b, w_out,
              router_w, router_b, exp_w_gu, exp_b_gu, exp_w_dn, exp_b_dn, final_norm_g):
    bsz, seq_len, d = x.shape
    ctx_len = ctx.shape[1]
    rows = seq_len // GRID_W
    n_ctx_tok = bsz * ctx_len
    x_lat, x_ctx = x, ctx
    silu_c = jax.nn.silu(c)
    silu_cc = jax.nn.silu(c_ctx)

    for layer in range(DEPTH):
        last = layer == DEPTH - 1
        mod_lat = jnp.split((silu_c @ w_mod[layer] + b_mod[layer])[:, None, :], 6, axis=-1)
        mod_ctx = jnp.split(silu_cc @ w_mod[layer] + b_mod[layer], 6, axis=-1)

        h_lat = modulate(rmsnorm(x_lat, norm1_g[layer]), mod_lat[0], mod_lat[1])
        h_ctx = modulate(rmsnorm(x_ctx, norm1_g[layer]), mod_ctx[0], mod_ctx[1])
        p_lat = jnp.split(h_lat @ w_in[layer], PROJ_SPLITS, axis=-1)
        p_ctx = jnp.split(h_ctx @ w_in[layer], PROJ_SPLITS, axis=-1)

        o_ctx, o_lat = gla_two_streams(
            gla_prep(p_ctx, gla_wg2_f[layer], gla_bg_f[layer], gla_wg2_b[layer], gla_bg_b[layer]),
            gla_prep(p_lat, gla_wg2_f[layer], gla_bg_f[layer], gla_wg2_b[layer], gla_bg_b[layer]))

        y_lat = jnp.concatenate([
            fourier_mix(p_lat[0]),
            gla_output(o_lat, p_lat[4], gla_norm_g[layer]),
            conformer_conv(p_lat[7], rows, conv_w[layer], conv_b[layer], conv_ln_g[layer], conv_ln_b[layer]),
        ], axis=-1) @ w_out[layer]
        x_lat = x_lat + mod_lat[2] * y_lat
        if not last:
            y_ctx = jnp.concatenate([
                fourier_mix(p_ctx[0]),
                gla_output(o_ctx, p_ctx[4], gla_norm_g[layer]),
                conformer_conv(p_ctx[7], 1, conv_w[layer], conv_b[layer], conv_ln_g[layer], conv_ln_b[layer]),
            ], axis=-1) @ w_out[layer]
            x_ctx = x_ctx + mod_ctx[2] * y_ctx

        h2_lat = modulate(rmsnorm(x_lat, norm2_g[layer]), mod_lat[3], mod_lat[4]).reshape(-1, d)
        moe_args = (router_w[layer], router_b[layer], exp_w_gu[layer], exp_b_gu[layer],
                    exp_w_dn[layer], exp_b_dn[layer])
        if last:
            f_lat = moe_ffn(h2_lat, *moe_args)
        else:
            h2_ctx = modulate(rmsnorm(x_ctx, norm2_g[layer]), mod_ctx[3], mod_ctx[4]).reshape(-1, d)
            f_all = moe_ffn(jnp.concatenate([h2_ctx, h2_lat], axis=0), *moe_args)
            x_ctx = x_ctx + mod_ctx[5] * f_all[:n_ctx_tok].reshape(bsz, ctx_len, d)
            f_lat = f_all[n_ctx_tok:]
        x_lat = x_lat + mod_lat[5] * f_lat.reshape(bsz, seq_len, d)

    return rmsnorm(x_lat, final_norm_g)
```

```cpp
#include <hip/hip_runtime.h>
#include <cstdio>
#include <cstdint>

#define LAS __attribute__((address_space(3)))
#define GAS __attribute__((address_space(1)))
typedef unsigned short bf16_t;
typedef short bf16x8 __attribute__((ext_vector_type(8)));
typedef float f32x4 __attribute__((ext_vector_type(4)));
typedef float f32x2 __attribute__((ext_vector_type(2)));
typedef unsigned u32x4 __attribute__((ext_vector_type(4)));
typedef unsigned u32x2 __attribute__((ext_vector_type(2)));

constexpr int D = 1024, NBATCH = 2, SEQ = 16384, NLAT = NBATCH * SEQ, CTXL = 256, NCTX = NBATCH * CTXL, NTOK = NLAT + NCTX, DEPTH = 2;
constexpr int INW = 2336, INP = 2560;
constexpr int C_FOUR = 0, C_Q = 256, C_K = 512, C_V = 768, C_R = 1280, C_GF = 1792, C_GB = 1808, C_CA = 1824, C_CG = 2080;
constexpr int NE = 32, TOPK = 4, DFF = 1024;
constexpr int MAXROWS = NTOK * TOPK + NE * 256;
constexpr float NORM_EPS = 1e-6f;
constexpr int NTHREADS = 512, NWAVES = 8;

constexpr size_t MiB = 1u << 20;
constexpr size_t WS_CTL = 0, CTL_ZERO_BYTES = 1 * MiB;
constexpr size_t WS_MODP = 1 * MiB;
constexpr size_t WS_MODF = 3 * MiB;
constexpr size_t WS_CM3 = 4 * MiB;
constexpr size_t WS_TF2 = 4 * MiB + 65536;
constexpr size_t WS_TCTX = 4 * MiB + 262144;
constexpr size_t WS_TLAT = 5 * MiB;
constexpr size_t WS_WIN = 13 * MiB;
constexpr size_t WS_WOUT = 23 * MiB;
constexpr size_t WS_WGU = 27 * MiB;
constexpr size_t WS_WDN = 283 * MiB;
constexpr size_t WS_XRES = 411 * MiB;
constexpr size_t WS_HBUF = 541 * MiB;
constexpr size_t WS_PBUF = 606 * MiB;
constexpr size_t WS_CAT = 769 * MiB;
constexpr size_t WS_T2 = 834 * MiB;
constexpr size_t WS_STATE = 866 * MiB;
constexpr size_t WS_DECAY = 996 * MiB;
constexpr size_t WS_AEXP = 998 * MiB, WS_APOS = 999 * MiB, WS_APROB = 1000 * MiB, WS_ASLOT = 1001 * MiB;
constexpr size_t WS_XB = 1002 * MiB, WS_ACT = 1278 * MiB, WS_YB = 1554 * MiB, WS_END = 1830 * MiB;
constexpr int CW_BAR = 4096, CW_CNT = 16384;

constexpr int RING_BYTES = 131072;
constexpr int AUX_OFF = RING_BYTES;
constexpr int LCTL_OFF = RING_BYTES + 8192;
constexpr int LDS_BYTES = 147456;

__device__ __forceinline__ unsigned f2bf(float f) { unsigned u = __builtin_bit_cast(unsigned, f); return (u + 0x7fffu + ((u >> 16) & 1u)) >> 16; }
__device__ __forceinline__ unsigned pk2(float lo, float hi) { return f2bf(lo) | (f2bf(hi) << 16); }
__device__ __forceinline__ float bf2f(unsigned b) { return __builtin_bit_cast(float, b << 16); }
__device__ __forceinline__ float bflo(unsigned w) { return __builtin_bit_cast(float, w << 16); }
__device__ __forceinline__ float bfhi(unsigned w) { return __builtin_bit_cast(float, w & 0xffff0000u); }
__device__ __forceinline__ float wave_sum(float v) {
#pragma unroll
    for (int o = 1; o < 64; o <<= 1) v += __shfl_xor(v, o);
    return v;
}
__device__ __forceinline__ float sigmoidf_(float x) { return 1.0f / (1.0f + __expf(-x)); }

#define XB_TMO      128
#define XB_XCNT(j)  (256  + 64 * (j))
#define XB_XSUB(j)  (1280 + 64 * (j))
#define XB_XGEN(j)  (2304 + 64 * (j))
#define XB_TOP      3328
#define XB_TOPGEN   3392
#define XCD_BAR_WORDS 3456
#define XB_SPIN_CAP (1u << 22)

__device__ __forceinline__ unsigned xb_ld(unsigned* p)              { return __hip_atomic_load(p, __ATOMIC_RELAXED, __HIP_MEMORY_SCOPE_AGENT); }
__device__ __forceinline__ unsigned xb_add(unsigned* p, unsigned v) { return __hip_atomic_fetch_add(p, v, __ATOMIC_RELAXED, __HIP_MEMORY_SCOPE_AGENT); }
__device__ __forceinline__ unsigned xb_xcc_id() { return (unsigned)__builtin_amdgcn_s_getreg((3 << 11) | 20) & 0xFu; }
#define XB_SPIN(cond, bar) do { unsigned _sp = 0; while (cond) { __builtin_amdgcn_s_sleep(1); \
    if ((++_sp & 255u) == 0u) { if (xb_ld(&(bar)[XB_TMO])) break; if (_sp > XB_SPIN_CAP) { atomicAdd(&(bar)[XB_TMO], 1u); break; } } } } while (0)

struct XcdBarrier { unsigned* bar; unsigned x; volatile LAS unsigned* st; };

__device__ __forceinline__ XcdBarrier xcd_barrier_post(unsigned* bar, volatile LAS unsigned* st) {
    XcdBarrier b; b.bar = bar; b.x = xb_xcc_id(); b.st = st;
    if (threadIdx.x == 0) (void)xb_add(&bar[XB_XCNT(b.x)], 1u);
    return b;
}
__device__ __forceinline__ void xcd_barrier_complete(unsigned* bar, unsigned x, unsigned& nloc, unsigned& nx) {
    const unsigned G = gridDim.x * gridDim.y * gridDim.z;
    unsigned sum, cnt, mine, sp = 0u;
    for (;;) {
        sum = 0u; cnt = 0u; mine = 0u;
#pragma unroll
        for (unsigned j = 0; j < 16; ++j) { const unsigned c = xb_ld(&bar[XB_XCNT(j)]); sum += c; cnt += (c > 0u) ? 1u : 0u; mine = (j == x) ? c : mine; }
        if (sum == G) break;
        __builtin_amdgcn_s_sleep(1);
        if ((++sp & 255u) == 0u) { if (xb_ld(&bar[XB_TMO])) break; if (sp > XB_SPIN_CAP) { atomicAdd(&bar[XB_TMO], 1u); break; } }
    }
    nloc = mine > 0u ? mine : 1u; nx = cnt > 0u ? cnt : 1u;
}
__device__ __forceinline__ void xcd_barrier(const XcdBarrier& b) {
    asm volatile("s_waitcnt vmcnt(0)" ::: "memory");
    __syncthreads();
    if (threadIdx.x == 0) {
        unsigned* bar = b.bar;
        __builtin_amdgcn_s_waitcnt(0);
        unsigned nloc = b.st[0], nx = b.st[1];
        if (nloc == 0u) { xcd_barrier_complete(bar, b.x, nloc, nx); b.st[0] = nloc; b.st[1] = nx; }
        const unsigned old = xb_add(&bar[XB_XSUB(b.x)], 1u);
        const unsigned gen = old / nloc;
        if (old + 1u == (gen + 1u) * nloc) {
            __builtin_amdgcn_fence(__ATOMIC_RELEASE, "agent");
            asm volatile("s_waitcnt vmcnt(0)" ::: "memory");
            const unsigned og = xb_add(&bar[XB_TOP], 1u);
            const unsigned tg = og / nx;
            if (og + 1u == (tg + 1u) * nx) xb_add(&bar[XB_TOPGEN], 1u);
            else XB_SPIN(xb_ld(&bar[XB_TOPGEN]) == tg, bar);
            __builtin_amdgcn_fence(__ATOMIC_ACQUIRE, "agent");
            xb_add(&bar[XB_XGEN(b.x)], 1u);
            asm volatile("s_waitcnt vmcnt(0)" ::: "memory");
        } else {
            XB_SPIN(xb_ld(&bar[XB_XGEN(b.x)]) == gen, bar);
            __builtin_amdgcn_fence(__ATOMIC_ACQUIRE, "agent");
            asm volatile("s_waitcnt vmcnt(0)" ::: "memory");
        }
    }
    __syncthreads();
}

namespace pg8 {
constexpr int BM = 256, BK = 64, HALF = 128, HTB = HALF * BK * 2, STAGE_BYTES = 8 * HTB, NXCD = 8, WGM = 8;
__host__ __device__ __forceinline__ int lds_byte(int r, int c) { const int st = (r >> 4) * 2 + (c >> 5), rr = r & 15, cc = c & 31, ob = rr * 64 + cc * 2; return st * 1024 + (ob ^ (((ob >> 9) & 1) << 5)); }
__host__ __device__ __forceinline__ void stage_rc(int b, int& R, int& C) { const int st = b / 1024, sb = b % 1024, swz = sb ^ (((sb >> 9) & 1) << 5); R = (st >> 1) * 16 + swz / 64; C = (st & 1) * 32 + (swz % 64) / 2; }
__host__ __device__ __forceinline__ int perm32(int rho) { const int n = rho >> 4, i = rho & 15; return 8 * (i >> 2) + 4 * n + (i & 3); }

struct Unit { int pm, pn; };
struct Gemm { const bf16_t* A; const bf16_t* Bt; int M, N, K; };

struct StaticOrder {
    int nM, nN, nwg, G, c;
    __device__ void init(int M, int N, int G_, int c_) { nM = M / BM; nN = N / BM; nwg = nM * nN; G = G_; c = c_; }
    __device__ bool next(int i, Unit& u) const {
        const long L = (long)i * G + c; if (L >= nwg) return false;
        int wgid = (int)L; { const int q = nwg / NXCD, r = nwg % NXCD, xcd = wgid % NXCD, off = wgid / NXCD; wgid = (xcd < r ? xcd * (q + 1) : r * (q + 1) + (xcd - r) * q) + off; }
        const int nig = WGM * nN, gid = wgid / nig, fm = gid * WGM, gsz = (nM - fm) < WGM ? (nM - fm) : WGM;
        u.pm = fm + ((wgid % nig) % gsz); u.pn = (wgid % nig) / gsz; return true;
    }
};
struct MoeOrder {
    int nN, G, c, MT; const volatile LAS int* ts;
    __device__ bool next(int i, Unit& u) const {
        const long L = (long)i * G + c; if (L >= (long)MT * nN) return false;
        const int mt = (int)(L / nN), pl = (int)(L % nN);
        int e = 0;
#pragma unroll 1
        for (int j = 1; j < NE; ++j) e += (ts[j] <= mt) ? 1 : 0;
        u.pm = mt; u.pn = e * nN + pl; return true;
    }
};

__device__ __forceinline__ unsigned cvt_pk_bf16(float lo, float hi) { unsigned r; asm volatile("v_cvt_pk_bf16_f32 %0, %1, %2" : "=v"(r) : "v"(lo), "v"(hi)); return r; }

struct EpiStoreBf16 {
    static constexpr bool PERM = true;
    bf16_t* O; int ldc;
    __device__ __forceinline__ void operator()(const f32x4 (&acc)[2][2][4][2], const Unit& u, int wr, int wc, int fr, int fq) const {
        const int row0 = u.pm * BM + wr * 64 + fr; const int col0 = u.pn * BM + wc * 32 + 8 * fq;
#pragma unroll
        for (int ai = 0; ai < 2; ++ai)
#pragma unroll
            for (int m = 0; m < 4; ++m) { bf16_t* rowp = O + (size_t)(row0 + ai * HALF + m * 16) * ldc + col0;
#pragma unroll
                for (int bj = 0; bj < 2; ++bj) { const f32x4 v0 = acc[ai][bj][m][0], v1 = acc[ai][bj][m][1];
                    u32x4 w; w.x = cvt_pk_bf16(v0[0], v0[1]); w.y = cvt_pk_bf16(v0[2], v0[3]); w.z = cvt_pk_bf16(v1[0], v1[1]); w.w = cvt_pk_bf16(v1[2], v1[3]);
                    *(u32x4*)(rowp + bj * HALF) = w; } }
    }
};
struct EpiResid {
    static constexpr bool PERM = false;
    float* X; const float* modf;
    __device__ __forceinline__ void operator()(const f32x4 (&acc)[2][2][4][2], const Unit& u, int wr, int wc, int fr, int fq) const {
        const int row0 = u.pm * BM + wr * 64 + fr, col0 = u.pn * BM + wc * 32 + 4 * fq;
        const int v = (u.pm >= NLAT / BM) ? 2 : (u.pm >= SEQ / BM ? 1 : 0);
        const float* gv = modf + (size_t)v * 6144 + 2 * 1024;
        f32x4 bv[2][2];
#pragma unroll
        for (int bj = 0; bj < 2; ++bj)
#pragma unroll
            for (int n = 0; n < 2; ++n) bv[bj][n] = *(const f32x4*)(gv + col0 + bj * HALF + n * 16);
#pragma unroll
        for (int ai = 0; ai < 2; ++ai)
#pragma unroll
            for (int m = 0; m < 4; ++m) { float* rowp = X + (size_t)(row0 + ai * HALF + m * 16) * D + col0;
#pragma unroll
                for (int bj = 0; bj < 2; ++bj)
#pragma unroll
                    for (int n = 0; n < 2; ++n) { f32x4* p = (f32x4*)(rowp + bj * HALF + n * 16); const f32x4 x = *p; *p = x + bv[bj][n] * acc[ai][bj][m][n]; } }
    }
};
struct EpiGateUp {
    static constexpr bool PERM = true;
    bf16_t* O; const float* bgu;
    __device__ __forceinline__ void operator()(const f32x4 (&acc)[2][2][4][2], const Unit& u, int wr, int wc, int fr, int fq) const {
        const int e = u.pn >> 3, pl = u.pn & 7;
        const int row0 = u.pm * BM + wr * 64 + fr; const int cl = pl * 128 + wc * 32 + 8 * fq;
        const float* bg = bgu + (size_t)e * 2048 + cl; const float* bu = bg + 1024;
        f32x4 g0 = *(const f32x4*)bg, g1 = *(const f32x4*)(bg + 4), u0 = *(const f32x4*)bu, u1 = *(const f32x4*)(bu + 4);
#pragma unroll
        for (int ai = 0; ai < 2; ++ai)
#pragma unroll
            for (int m = 0; m < 4; ++m) { bf16_t* rowp = O + (size_t)(row0 + ai * HALF + m * 16) * DFF + cl;
                float r[8];
#pragma unroll
                for (int n = 0; n < 2; ++n) { const f32x4 gb = n ? g1 : g0, ub = n ? u1 : u0; const f32x4 ga = acc[ai][0][m][n] + gb, ua = acc[ai][1][m][n] + ub;
#pragma unroll
                    for (int j = 0; j < 4; ++j) { const float gate = fminf(ga[j], 7.0f), up = fminf(fmaxf(ua[j], -7.0f), 7.0f);
                        r[n * 4 + j] = gate * (1.0f / (1.0f + __expf(-1.702f * gate))) * (up + 1.0f); } }
                u32x4 w; w.x = cvt_pk_bf16(r[0], r[1]); w.y = cvt_pk_bf16(r[2], r[3]); w.z = cvt_pk_bf16(r[4], r[5]); w.w = cvt_pk_bf16(r[6], r[7]);
                *(u32x4*)rowp = w; }
    }
};
struct EpiDown {
    static constexpr bool PERM = true;
    bf16_t* O; const float* bdn;
    __device__ __forceinline__ void operator()(const f32x4 (&acc)[2][2][4][2], const Unit& u, int wr, int wc, int fr, int fq) const {
        const int e = u.pn >> 2, pl = u.pn & 3;
        const int row0 = u.pm * BM + wr * 64 + fr; const int col0 = pl * BM + wc * 32 + 8 * fq;
        f32x4 bv[2][2];
#pragma unroll
        for (int bj = 0; bj < 2; ++bj)
#pragma unroll
            for (int n = 0; n < 2; ++n) bv[bj][n] = *(const f32x4*)(bdn + (size_t)e * 1024 + col0 + bj * HALF + 4 * n);
#pragma unroll
        for (int ai = 0; ai < 2; ++ai)
#pragma unroll
            for (int m = 0; m < 4; ++m) { bf16_t* rowp = O + (size_t)(row0 + ai * HALF + m * 16) * D + col0;
#pragma unroll
                for (int bj = 0; bj < 2; ++bj) { const f32x4 v0 = acc[ai][bj][m][0] + bv[bj][0], v1 = acc[ai][bj][m][1] + bv[bj][1];
                    u32x4 w; w.x = cvt_pk_bf16(v0[0], v0[1]); w.y = cvt_pk_bf16(v0[2], v0[3]); w.z = cvt_pk_bf16(v1[0], v1[1]); w.w = cvt_pk_bf16(v1[2], v1[3]);
                    *(u32x4*)(rowp + bj * HALF) = w; } }
    }
};

template <class Epi, class Sched, bool ALIGN_EPI = true, bool SP2 = true>
__device__ __forceinline__ void gemm_phase(LAS unsigned char* lds, const Gemm g, const Sched& S, const Epi& E, const int tid) {
    const int wid = __builtin_amdgcn_readfirstlane(tid >> 6), lane = tid & 63, wr = wid >> 2, wc = wid & 3, fr = lane & 15, fq = lane >> 4;
    const int K = g.K, nt = K / BK;
    unsigned voffA[2], voffB[2];
#pragma unroll
    for (int i = 0; i < 2; ++i) { int R, C; stage_rc(tid * 16 + i * 8192, R, C); const int Rb = Epi::PERM ? ((R & ~31) + perm32(R & 31)) : R;
        voffA[i] = (unsigned)(R * K + C) * 2u; voffB[i] = (unsigned)(Rb * K + C) * 2u; }
    const size_t kstep = (size_t)(BK * 2);
    const size_t hstep = (size_t)HALF * K * 2;
    const size_t tstep = 2 * hstep;
    const unsigned ldsw = (unsigned)wid * 1024u;
    const int aoff = lds_byte(wr * 64 + fr, fq * 8), boff = lds_byte(wc * 32 + fr, fq * 8);
#define PG8_SA(b, h) (((b) * 2 + (h)) * HTB)
#define PG8_SB(b, h) ((4 + (b) * 2 + (h)) * HTB)
#define PG8_STAGE(bufoff, gbase, voff) do { _Pragma("unroll") for (int _i = 0; _i < 2; ++_i) \
        __builtin_amdgcn_global_load_lds((const unsigned*)((const char*)(gbase) + (voff)[_i]), (LAS unsigned*)(lds + (bufoff) + ldsw + _i * 8192), 16, 0, 0); } while (0)
#define PG8_LDA(dst, b, h) do { _Pragma("unroll") for (int m = 0; m < 4; ++m) _Pragma("unroll") for (int k = 0; k < 2; ++k) dst[m][k] = *(const LAS bf16x8*)(lds + PG8_SA(b, h) + aoff + m * 2048 + k * 1024); } while (0)
#define PG8_LDB(dst, b, h) do { _Pragma("unroll") for (int n = 0; n < 2; ++n) _Pragma("unroll") for (int k = 0; k < 2; ++k) dst[n][k] = *(const LAS bf16x8*)(lds + PG8_SB(b, h) + boff + n * 2048 + k * 1024); } while (0)
#define PG8_MMA(ai, bj, At, Bt) do { __builtin_amdgcn_s_setprio(1); _Pragma("unroll") for (int m = 0; m < 4; ++m) _Pragma("unroll") for (int n = 0; n < 2; ++n) _Pragma("unroll") for (int k = 0; k < 2; ++k) \
        acc[ai][bj][m][n] = __builtin_amdgcn_mfma_f32_16x16x32_bf16(Bt[n][k], At[m][k], acc[ai][bj][m][n], 0, 0, 0); __builtin_amdgcn_s_setprio(0); } while (0)
#define PG8_WAIT_V(n) asm volatile("s_waitcnt vmcnt(" #n ")" ::: "memory")
#define PG8_WAIT_L(n) asm volatile("s_waitcnt lgkmcnt(" #n ")" ::: "memory")
#define PG8_BAR __builtin_amdgcn_s_barrier()
#define PG8_SCHED __builtin_amdgcn_sched_barrier(0)
    Unit cur, nxt; int ui = 0;
    if (!S.next(0, cur)) return;
    f32x4 acc[2][2][4][2];
#pragma unroll
    for (int a = 0; a < 2; ++a)
#pragma unroll
        for (int b = 0; b < 2; ++b)
#pragma unroll
            for (int m = 0; m < 4; ++m)
#pragma unroll
                for (int n = 0; n < 2; ++n) acc[a][b][m][n] = (f32x4){0.f, 0.f, 0.f, 0.f};
    bf16x8 At[4][2], B0[2][2], B1[2][2];
    const char* cA = (const char*)g.A + (size_t)cur.pm * tstep; const char* cB = (const char*)g.Bt + (size_t)cur.pn * tstep;
    if constexpr (SP2) {
        PG8_STAGE(PG8_SB(0, 0), cB, voffB); PG8_STAGE(PG8_SB(0, 1), cB + hstep, voffB); PG8_STAGE(PG8_SA(0, 0), cA, voffA); PG8_STAGE(PG8_SA(0, 1), cA + hstep, voffA);
        if (wr == 1) PG8_BAR;
        PG8_WAIT_V(2); PG8_BAR;
        PG8_STAGE(PG8_SB(1, 0), cB + kstep, voffB); PG8_STAGE(PG8_SA(1, 0), cA + kstep, voffA); PG8_STAGE(PG8_SB(1, 1), cB + hstep + kstep, voffB);
        PG8_WAIT_V(6); PG8_BAR;
    } else {
        PG8_STAGE(PG8_SB(0, 0), cB, voffB); PG8_STAGE(PG8_SA(0, 0), cA, voffA); PG8_STAGE(PG8_SB(0, 1), cB + hstep, voffB); PG8_STAGE(PG8_SA(0, 1), cA + hstep, voffA);
        if (wr == 1) PG8_BAR;
        PG8_WAIT_V(4); PG8_BAR;
        PG8_STAGE(PG8_SB(1, 0), cB + kstep, voffB); PG8_STAGE(PG8_SA(1, 0), cA + kstep, voffA); PG8_STAGE(PG8_SB(1, 1), cB + hstep + kstep, voffB);
        PG8_WAIT_V(6); PG8_BAR;
    }
    for (;;) {
        const bool has_next = S.next(ui + 1, nxt);
        const char* nA = has_next ? (const char*)g.A + (size_t)nxt.pm * tstep : cA; const char* nB = has_next ? (const char*)g.Bt + (size_t)nxt.pn * tstep : cB;
        for (int t = 0; t < nt; t += 2) {
            const bool last = (t == nt - 2);
            const char* a1 = cA + (size_t)(t + 1) * kstep;
            const char* a2 = last ? nA : cA + (size_t)(t + 2) * kstep; const char* b2 = last ? nB : cB + (size_t)(t + 2) * kstep;
            const char* a3 = a2 + kstep; const char* b3 = b2 + kstep;
            if constexpr (SP2) {
            PG8_LDB(B0, 0, 0); PG8_LDB(B1, 0, 1); PG8_SCHED; PG8_LDA(At, 0, 0); PG8_STAGE(PG8_SA(1, 1), a1 + hstep, voffA);
            PG8_WAIT_V(8); PG8_WAIT_L(0); PG8_BAR; PG8_MMA(0, 0, At, B0); PG8_MMA(0, 1, At, B1); PG8_BAR; PG8_SCHED;
            PG8_LDA(At, 0, 1); PG8_STAGE(PG8_SB(0, 0), b2, voffB); PG8_STAGE(PG8_SB(0, 1), b2 + hstep, voffB); PG8_STAGE(PG8_SA(0, 0), a2, voffA);
            PG8_WAIT_V(8); PG8_WAIT_L(0); PG8_BAR; PG8_MMA(1, 0, At, B0); PG8_MMA(1, 1, At, B1); PG8_BAR; PG8_SCHED;
            PG8_LDB(B0, 1, 0); PG8_LDB(B1, 1, 1); PG8_SCHED; PG8_LDA(At, 1, 0); PG8_STAGE(PG8_SA(0, 1), a2 + hstep, voffA);
            PG8_WAIT_V(8); PG8_WAIT_L(0); PG8_BAR; PG8_MMA(0, 0, At, B0); PG8_MMA(0, 1, At, B1); PG8_BAR; PG8_SCHED;
            PG8_LDA(At, 1, 1); PG8_STAGE(PG8_SB(1, 0), b3, voffB); PG8_STAGE(PG8_SB(1, 1), b3 + hstep, voffB); PG8_STAGE(PG8_SA(1, 0), a3, voffA);
            PG8_WAIT_V(8); PG8_WAIT_L(0); PG8_BAR; PG8_MMA(1, 0, At, B0); PG8_MMA(1, 1, At, B1); PG8_BAR; PG8_SCHED;
            } else {
            PG8_LDB(B0, 0, 0); PG8_SCHED; PG8_LDA(At, 0, 0); PG8_STAGE(PG8_SA(1, 1), a1 + hstep, voffA);
            PG8_WAIT_L(8); PG8_BAR; PG8_WAIT_L(0); PG8_MMA(0, 0, At, B0); PG8_BAR; PG8_SCHED;
            PG8_LDB(B1, 0, 1); PG8_STAGE(PG8_SB(0, 0), b2, voffB);
            PG8_BAR; PG8_WAIT_L(0); PG8_MMA(0, 1, At, B1); PG8_BAR;
            PG8_LDA(At, 0, 1); PG8_STAGE(PG8_SA(0, 0), a2, voffA);
            PG8_BAR; PG8_WAIT_L(0); PG8_MMA(1, 0, At, B0); PG8_BAR; PG8_SCHED;
            PG8_STAGE(PG8_SB(0, 1), b2 + hstep, voffB);
            PG8_WAIT_V(6); PG8_BAR; PG8_MMA(1, 1, At, B1); PG8_BAR;
            PG8_LDB(B0, 1, 0); PG8_SCHED; PG8_LDA(At, 1, 0); PG8_STAGE(PG8_SA(0, 1), a2 + hstep, voffA);
            PG8_WAIT_L(8); PG8_BAR; PG8_WAIT_L(0); PG8_MMA(0, 0, At, B0); PG8_BAR; PG8_SCHED;
            PG8_LDB(B1, 1, 1); PG8_STAGE(PG8_SB(1, 0), b3, voffB);
            PG8_BAR; PG8_WAIT_L(0); PG8_MMA(0, 1, At, B1); PG8_BAR;
            PG8_LDA(At, 1, 1); PG8_STAGE(PG8_SA(1, 0), a3, voffA);
            PG8_BAR; PG8_WAIT_L(0); PG8_MMA(1, 0, At, B0); PG8_BAR; PG8_SCHED;
            PG8_STAGE(PG8_SB(1, 1), b3 + hstep, voffB);
            PG8_WAIT_V(6); PG8_BAR; PG8_MMA(1, 1, At, B1); PG8_BAR;
            }
        }
        if constexpr (ALIGN_EPI) { if (wr == 0) PG8_BAR; }
        E(acc, cur, wr, wc, fr, fq);
        if (!has_next) break;
#pragma unroll
        for (int a = 0; a < 2; ++a)
#pragma unroll
            for (int b = 0; b < 2; ++b)
#pragma unroll
                for (int m = 0; m < 4; ++m)
#pragma unroll
                    for (int n = 0; n < 2; ++n) acc[a][b][m][n] = (f32x4){0.f, 0.f, 0.f, 0.f};
        cur = nxt; cA = nA; cB = nB; ++ui;
        if constexpr (ALIGN_EPI) { if (wr == 1) PG8_BAR; }
    }
    PG8_WAIT_V(0);
    if constexpr (!ALIGN_EPI) { if (wr == 0) PG8_BAR; }
    PG8_BAR;
#undef PG8_SA
#undef PG8_SB
#undef PG8_STAGE
#undef PG8_LDA
#undef PG8_LDB
#undef PG8_MMA
#undef PG8_WAIT_V
#undef PG8_WAIT_L
#undef PG8_BAR
#undef PG8_SCHED
}
}

struct Params {
    const float* in[26];
    float* out;
    unsigned char* ws;
};
struct Frame {
    LAS unsigned char* lds;
    int tid, lane, wave, G, bid;
};

template <int MT, int NT>
__device__ __forceinline__ void mma_nt(f32x4 (&acc)[MT][NT], const LAS bf16_t* A, int lda, const LAS bf16_t* B, int ldb, int K, int fr, int fq) {
    for (int k0 = 0; k0 < K; k0 += 32) {
        bf16x8 a[MT], b[NT];
#pragma unroll
        for (int m = 0; m < MT; ++m) a[m] = *(const LAS bf16x8*)(A + (m * 16 + fr) * lda + k0 + fq * 8);
#pragma unroll
        for (int n = 0; n < NT; ++n) b[n] = *(const LAS bf16x8*)(B + (n * 16 + fr) * ldb + k0 + fq * 8);
#pragma unroll
        for (int m = 0; m < MT; ++m)
#pragma unroll
            for (int n = 0; n < NT; ++n) acc[m][n] = __builtin_amdgcn_mfma_f32_16x16x32_bf16(a[m], b[n], acc[m][n], 0, 0, 0);
    }
}
template <int MT, int NT> __device__ __forceinline__ void zero_acc(f32x4 (&acc)[MT][NT]) {
#pragma unroll
    for (int m = 0; m < MT; ++m)
#pragma unroll
        for (int n = 0; n < NT; ++n) acc[m][n] = (f32x4){0.f, 0.f, 0.f, 0.f};
}

__device__ __forceinline__ void p0_transpose_item(const float* W, int K, int N, bf16_t* WT, int k0, int n0, int orow0, LAS float* scr, int lane) {
#pragma unroll 8
    for (int i = 0; i < 32; ++i) { const int kk = 2 * i + (lane >> 5); scr[kk * 33 + (lane & 31)] = W[(size_t)(k0 + kk) * N + n0 + (lane & 31)]; }
    asm volatile("s_waitcnt lgkmcnt(0)" ::: "memory");
    const int c = lane & 7;
#pragma unroll
    for (int j = 0; j < 4; ++j) { const int n = (lane >> 3) + 8 * j; const LAS float* s = scr + (8 * c) * 33 + n;
        u32x4 o; o.x = pk2(s[0 * 33], s[1 * 33]); o.y = pk2(s[2 * 33], s[3 * 33]); o.z = pk2(s[4 * 33], s[5 * 33]); o.w = pk2(s[6 * 33], s[7 * 33]);
        *(u32x4*)(WT + (size_t)(orow0 + n) * K + k0 + 8 * c) = o; }
    asm volatile("s_waitcnt lgkmcnt(0)" ::: "memory");
}

__device__ __forceinline__ void phase_prologue(const Frame& F, const Params& P) {
    unsigned char* ws = P.ws;
    LAS float* scr = (LAS float*)(F.lds + F.wave * 16384);
    const int gw = F.bid * NWAVES + F.wave, NGW = F.G * NWAVES;
    constexpr int I_IN = 16 * 73, I_OUT = 16 * 32, I_GU = 16 * 64, I_DN = 16 * 32;
    constexpr int PER_LAYER = I_IN + I_OUT + NE * I_GU + NE * I_DN;
    for (int it = gw; it < DEPTH * PER_LAYER; it += NGW) {
        const int l = it / PER_LAYER; int r = it % PER_LAYER;
        if (r < I_IN) { const int kb = r / 73, nb = r % 73;
            p0_transpose_item(P.in[8] + (size_t)l * D * INW, D, INW, (bf16_t*)(ws + WS_WIN) + (size_t)l * INP * D, 64 * kb, 32 * nb, 32 * nb, scr, F.lane); continue; }
        r -= I_IN;
        if (r < I_OUT) { const int kb = r / 32, nb = r % 32;
            p0_transpose_item(P.in[18] + (size_t)l * D * D, D, D, (bf16_t*)(ws + WS_WOUT) + (size_t)l * D * D, 64 * kb, 32 * nb, 32 * nb, scr, F.lane); continue; }
        r -= I_OUT;
        if (r < NE * I_GU) { const int e = r / I_GU, q = r % I_GU, kb = q / 64, nb = q % 64; const int n0 = 32 * nb;
            const int j = n0 & 1023, orow = 256 * (j >> 7) + (n0 >= 1024 ? 128 : 0) + (j & 127);
            p0_transpose_item(P.in[21] + ((size_t)l * NE + e) * D * 2048, D, 2048, (bf16_t*)(ws + WS_WGU) + ((size_t)l * NE + e) * 2048 * D, 64 * kb, n0, orow, scr, F.lane); continue; }
        r -= NE * I_GU;
        { const int e = r / I_DN, q = r % I_DN, kb = q / 32, nb = q % 32;
            p0_transpose_item(P.in[23] + ((size_t)l * NE + e) * DFF * D, DFF, D, (bf16_t*)(ws + WS_WDN) + ((size_t)l * NE + e) * D * DFF, 64 * kb, 32 * nb, 32 * nb, scr, F.lane); }
    }
    {
        const int gt = F.bid * NTHREADS + F.tid, NGT = F.G * NTHREADS;
        constexpr int PADV = (INP - INW) * D / 8;
        for (int i = gt; i < DEPTH * PADV; i += NGT) { const int l = i / PADV, q = i % PADV;
            *((u32x4*)((bf16_t*)(ws + WS_WIN) + (size_t)l * INP * D + (size_t)INW * D) + q) = (u32x4){0u, 0u, 0u, 0u}; }
        bf16_t* cm3 = (bf16_t*)(ws + WS_CM3);
        for (int i = gt; i < 192 * 64; i += NGT) { const int m = i >> 6, n2 = i & 63, part = m >> 6, k2 = m & 63; const int ph = (k2 * n2) & 63;
            float s, c; sincospif((float)ph * (1.0f / 32.0f), &s, &c); const float v = part == 0 ? c : (part == 1 ? -s : -c); cm3[i] = (bf16_t)f2bf(v); }
        bf16_t* tf2 = (bf16_t*)(ws + WS_TF2);
        for (int i = gt; i < 128 * 128; i += NGT) { const int c_ = i >> 7, n = i & 127; const int ph = (c_ * n) & 127;
            float s, c; sincospif((float)ph * (1.0f / 64.0f), &s, &c); tf2[i] = (bf16_t)f2bf(c); tf2[128 * 128 + i] = (bf16_t)f2bf(s); }
        bf16_t* tctx = (bf16_t*)(ws + WS_TCTX);
        for (int i = gt; i < 256 * 256; i += NGT) { const int k1 = i >> 8, n = i & 255; const int ph = (k1 * n) & 255;
            float s, c; sincospif((float)ph * (1.0f / 128.0f), &s, &c); tctx[i] = (bf16_t)f2bf(c); tctx[256 * 256 + i] = (bf16_t)f2bf(s); }
        bf16_t* tlat = (bf16_t*)(ws + WS_TLAT);
        for (int i = gt; i < 128 * 128 * 128; i += NGT) { const int nlo = i >> 14, d = (i >> 7) & 127, a = i & 127; const int ph = (d * (nlo + 128 * a)) & 16383;
            float s, c; sincospif((float)ph * (1.0f / 8192.0f), &s, &c);
            tlat[(size_t)nlo * 32768 + d * 128 + a] = (bf16_t)f2bf(c); tlat[(size_t)nlo * 32768 + 16384 + d * 128 + a] = (bf16_t)f2bf(s); }
    }
    for (int it = gw; it < DEPTH * 24 * 8; it += NGW) {
        const int l = it / 192, q = it % 192, cb = q >> 3, ks = q & 7;
        const float* wm = P.in[6] + (size_t)l * D * 6144 + (size_t)(ks * 128) * 6144 + cb * 256 + 4 * F.lane;
        f32x4 a0 = {0.f, 0.f, 0.f, 0.f}, a1 = a0, a2 = a0;
#pragma unroll 4
        for (int k = 0; k < 128; ++k) { const int kk = ks * 128 + k;
            const float c0 = P.in[1][kk], c1 = P.in[1][D + kk], c2 = P.in[3][kk];
            const float s0 = c0 * sigmoidf_(c0), s1 = c1 * sigmoidf_(c1), s2 = c2 * sigmoidf_(c2);
            const f32x4 w = *(const f32x4*)(wm + (size_t)k * 6144);
            a0 += w * s0; a1 += w * s1; a2 += w * s2; }
        float* mp = (float*)(ws + WS_MODP) + ((size_t)(l * 8 + ks) * 3) * 6144 + cb * 256 + 4 * F.lane;
        *(f32x4*)(mp) = a0; *(f32x4*)(mp + 6144) = a1; *(f32x4*)(mp + 2 * 6144) = a2;
    }
}

__device__ __forceinline__ f32x4 mod_from_partials(const Params& P, int l, int v, int c4) {
    f32x4 s = *(const f32x4*)(P.in[7] + (size_t)l * 6144 + c4);
    const float* mp = (const float*)(P.ws + WS_MODP) + ((size_t)(l * 8) * 3 + v) * 6144 + c4;
#pragma unroll
    for (int ks = 0; ks < 8; ++ks) s += *(const f32x4*)(mp + (size_t)ks * 3 * 6144);
    return s;
}

__device__ __forceinline__ void norm_row_store(const f32x4 (&x)[4], const float* g, const float* shift, const float* scale, bf16_t* orow, int lane, bool from_partials, const Params& P, int l, int v) {
    float ss = 0.f;
#pragma unroll
    for (int j = 0; j < 4; ++j) ss += (x[j].x * x[j].x + x[j].y * x[j].y) + (x[j].z * x[j].z + x[j].w * x[j].w);
    const float rstd = 1.0f / sqrtf(wave_sum(ss) * (1.0f / D) + NORM_EPS);
#pragma unroll
    for (int j = 0; j < 4; ++j) { const int c = 4 * lane + 256 * j;
        const f32x4 gv = *(const f32x4*)(g + c);
        f32x4 sh, sc;
        if (from_partials) { sh = mod_from_partials(P, l, v, c); sc = mod_from_partials(P, l, v, 1024 + c); }
        else { sh = *(const f32x4*)(shift + c); sc = *(const f32x4*)(scale + c); }
        const f32x4 y = (x[j] * rstd) * gv * (sc + 1.0f) + sh;
        u32x2 o; o.x = pk2(y.x, y.y); o.y = pk2(y.z, y.w);
        *(u32x2*)(orow + c) = o; }
}

__device__ __forceinline__ void phase_p1(const Frame& F, const Params& P) {
    unsigned char* ws = P.ws;
    const int gt = F.bid * NTHREADS + F.tid, NGT = F.G * NTHREADS;
    float* modf = (float*)(ws + WS_MODF);
    for (int i = gt; i < DEPTH * 3 * 1536; i += NGT) { const int l = i / 4608, q = i % 4608, v = q / 1536, c4 = (q % 1536) * 4;
        *(f32x4*)(modf + ((size_t)l * 3 + v) * 6144 + c4) = mod_from_partials(P, l, v, c4); }
    const int gw = F.bid * NWAVES + F.wave, NGW = F.G * NWAVES;
    float* xres = (float*)(ws + WS_XRES); bf16_t* hb = (bf16_t*)(ws + WS_HBUF);
    for (int m = gw; m < NTOK; m += NGW) {
        const float* src = (m < NLAT) ? (P.in[0] + (size_t)m * D) : (P.in[2] + (size_t)(m - NLAT) * D);
        const int v = (m >= NLAT) ? 2 : (m >= SEQ ? 1 : 0);
        f32x4 x[4];
#pragma unroll
        for (int j = 0; j < 4; ++j) { x[j] = *(const f32x4*)(src + 4 * F.lane + 256 * j); *(f32x4*)(xres + (size_t)m * D + 4 * F.lane + 256 * j) = x[j]; }
        norm_row_store(x, P.in[4], nullptr, nullptr, hb + (size_t)m * D, F.lane, true, P, 0, v);
    }
}

constexpr int GL_GF = 0, GL_GB = 16384, GL_LR = 32768, GL_WG = 41472, GL_BG = 49664;
constexpr int GL_A1 = 53248, GL_KE = 78848, GL_RS = 97280;
constexpr int GL_KDT = 53248, GL_VT = 71680;

__device__ __forceinline__ float logsigmoidf_(float x) { return fminf(x, 0.f) - log1pf(__expf(-fabsf(x))); }

__device__ __forceinline__ void gla_gates(const Frame& F, const Params& P, int l, int row0, int h) {
    const bf16_t* pb = (const bf16_t*)(P.ws + WS_PBUF);
    LAS float* G = (LAS float*)(F.lds + GL_GF); LAS float* LR = (LAS float*)(F.lds + GL_LR); LAS float* WG = (LAS float*)(F.lds + GL_WG); LAS float* BG = (LAS float*)(F.lds + GL_BG);
    const int tid = F.tid;
    { const int row = tid >> 3, c4 = (tid & 7) * 4; const u32x2 w = *(const u32x2*)(pb + (size_t)(row0 + row) * INP + C_GF + c4);
      LR[row * 33 + c4 + 0] = bflo(w.x); LR[row * 33 + c4 + 1] = bfhi(w.x); LR[row * 33 + c4 + 2] = bflo(w.y); LR[row * 33 + c4 + 3] = bfhi(w.y); }
#pragma unroll
    for (int j = 0; j < 4; ++j) { const int idx = tid * 4 + j, dir = idx >> 10, r = (idx >> 6) & 15, d = idx & 63;
        WG[idx] = (dir ? P.in[11] : P.in[9])[(size_t)l * 16 * 256 + r * 256 + 64 * h + d]; }
    if (tid < 128) { const int dir = tid >> 6, d = tid & 63; BG[tid] = (dir ? P.in[12] : P.in[10])[(size_t)l * 256 + 64 * h + d]; }
    __syncthreads();
    { const int d = tid & 63, q = tid >> 6, dir = q & 1, tq = q >> 1;
      float wcol[16];
#pragma unroll
      for (int r = 0; r < 16; ++r) wcol[r] = WG[dir * 1024 + r * 64 + d];
      const float bg = BG[dir * 64 + d];
      for (int i = 0; i < 16; ++i) { const int t = tq * 16 + i; float pre = bg;
#pragma unroll
          for (int r = 0; r < 16; ++r) pre += LR[t * 33 + dir * 16 + r] * wcol[r];
          G[dir * 4096 + t * 64 + d] = logsigmoidf_(pre) * (1.0f / 16.0f); } }
    __syncthreads();
    if (tid < 128) { const int dir = tid >> 6, d = tid & 63; float s = 0.f;
        if (dir == 0) { for (int t = 0; t < 64; ++t) { s += G[t * 64 + d]; G[t * 64 + d] = s; } }
        else { for (int t = 63; t >= 0; --t) { s += G[4096 + t * 64 + d]; G[4096 + t * 64 + d] = s; } } }
    __syncthreads();
}

__device__ __forceinline__ void gla_g1_unit(const Frame& F, const Params& P, int l, int row0, int h, int unit) {
    gla_gates(F, P, l, row0, h);
    const bf16_t* pb = (const bf16_t*)(P.ws + WS_PBUF);
    LAS float* GFp = (LAS float*)(F.lds + GL_GF); LAS float* GBp = (LAS float*)(F.lds + GL_GB);
    LAS bf16_t* KDT = (LAS bf16_t*)(F.lds + GL_KDT); LAS bf16_t* VT = (LAS bf16_t*)(F.lds + GL_VT);
    const int tid = F.tid;
    { const int d = tid & 63, tg = tid >> 6; const float blf = GFp[63 * 64 + d], blb = GBp[d];
#pragma unroll
      for (int i = 0; i < 8; ++i) { const int t = tg * 8 + i; const float kv = bf2f(pb[(size_t)(row0 + t) * INP + C_K + 64 * h + d]);
          KDT[d * 72 + t] = (bf16_t)f2bf(kv * __expf(blf - GFp[t * 64 + d])); KDT[(64 + d) * 72 + t] = (bf16_t)f2bf(kv * __expf(blb - GBp[t * 64 + d])); } }
    { const int e = tid & 127, tg = tid >> 7;
#pragma unroll
      for (int i = 0; i < 16; ++i) { const int t = tg * 16 + i; VT[e * 72 + t] = pb[(size_t)(row0 + t) * INP + C_V + 128 * h + e]; } }
    if (tid < 128) ((float*)(P.ws + WS_DECAY))[(size_t)unit * 128 + tid] = __expf(tid < 64 ? GFp[63 * 64 + tid] : GBp[tid - 64]);
    __syncthreads();
    const int fr = F.lane & 15, fq = F.lane >> 4, w = F.wave;
    f32x4 acc[1][8]; zero_acc<1, 8>(acc);
    mma_nt<1, 8>(acc, VT + (16 * w) * 72, 72, KDT, 72, 64, fr, fq);
    float* st = (float*)(P.ws + WS_STATE) + (size_t)unit * 16384;
#pragma unroll
    for (int nt = 0; nt < 8; ++nt)
#pragma unroll
        for (int j = 0; j < 4; ++j) st[(16 * w + fq * 4 + j) * 128 + nt * 16 + fr] = acc[0][nt][j];
    __syncthreads();
}

__device__ __forceinline__ void gla_scan(const Frame& F, const Params& P) {
    float* stt = (float*)(P.ws + WS_STATE); const float* dec = (const float*)(P.ws + WS_DECAY);
    for (int gid = F.bid * NTHREADS + F.tid; gid < 8 * 128 * 128; gid += F.G * NTHREADS) {
        const int dd = gid & 127, e = (gid >> 7) & 127, bh = gid >> 14, dir = dd >> 6;
        const int latb = bh * 256, ctxb = 2048 + bh * 4;
        float s = 0.f;
        for (int p0 = 0; p0 < 260; p0 += 4) {
            float dsv[4], dcv[4]; size_t off[4];
#pragma unroll
            for (int i = 0; i < 4; ++i) { const int p = p0 + i; const int unit = dir == 0 ? (p < 4 ? ctxb + p : latb + (p - 4)) : (p < 4 ? ctxb + 3 - p : latb + 255 - (p - 4));
                off[i] = ((size_t)unit * 128 + e) * 128 + dd; dsv[i] = stt[off[i]]; dcv[i] = dec[(size_t)unit * 128 + dd]; }
#pragma unroll
            for (int i = 0; i < 4; ++i) { stt[off[i]] = s; s = dcv[i] * s + dsv[i]; }
        }
    }
}

__device__ __forceinline__ void gla_g3_unit(const Frame& F, const Params& P, int l, int row0, int h, int unit) {
    gla_gates(F, P, l, row0, h);
    const bf16_t* pb = (const bf16_t*)(P.ws + WS_PBUF);
    LAS float* GFp = (LAS float*)(F.lds + GL_GF); LAS float* GBp = (LAS float*)(F.lds + GL_GB);
    LAS bf16_t* A1 = (LAS bf16_t*)(F.lds + GL_A1); LAS bf16_t* KE = (LAS bf16_t*)(F.lds + GL_KE); LAS bf16_t* B1 = (LAS bf16_t*)(F.lds);
    LAS float* RS = (LAS float*)(F.lds + GL_RS);
    const int tid = F.tid, fr = F.lane & 15, fq = F.lane >> 4, w = F.wave;
    { const int d = tid & 63, tg = tid >> 6;
#pragma unroll
      for (int i = 0; i < 8; ++i) { const int t = tg * 8 + i; const size_t rb = (size_t)(row0 + t) * INP;
          const float qv = bf2f(pb[rb + C_Q + 64 * h + d]) * 0.125f, kv = bf2f(pb[rb + C_K + 64 * h + d]);
          const float bf_ = GFp[t * 64 + d], bb_ = GBp[t * 64 + d];
          A1[t * 200 + 64 + d] = (bf16_t)f2bf(qv * __expf(bf_)); A1[t * 200 + 128 + d] = (bf16_t)f2bf(qv * __expf(bb_));
          KE[t * 72 + d] = (bf16_t)f2bf(kv * __expf(-bf_)); KE[4608 + t * 72 + d] = (bf16_t)f2bf(kv * __expf(-bb_)); } }
    __syncthreads();
    {
        const int mt = w & 3, ntp = w >> 2;
        f32x4 af[1][2], ab[1][2]; zero_acc<1, 2>(af); zero_acc<1, 2>(ab);
        mma_nt<1, 2>(af, A1 + (16 * mt) * 200 + 64, 200, KE + (32 * ntp) * 72, 72, 64, fr, fq);
        mma_nt<1, 2>(ab, A1 + (16 * mt) * 200 + 128, 200, KE + 4608 + (32 * ntp) * 72, 72, 64, fr, fq);
        { const int e = tid & 127, tg = tid >> 7;
#pragma unroll
          for (int i = 0; i < 16; ++i) { const int t = tg * 16 + i; B1[e * 200 + t] = pb[(size_t)(row0 + t) * INP + C_V + 128 * h + e]; } }
        { const float* st = (const float*)(P.ws + WS_STATE) + (size_t)unit * 16384;
#pragma unroll
          for (int i = 0; i < 8; ++i) { const int idx = (i * 512 + tid) * 4, e = idx >> 7, dd = idx & 127; const f32x4 v = *(const f32x4*)(st + idx);
              u32x2 o; o.x = pk2(v.x, v.y); o.y = pk2(v.z, v.w); *(LAS u32x2*)(B1 + e * 200 + 64 + dd) = o; } }
#pragma unroll
        for (int nt = 0; nt < 2; ++nt)
#pragma unroll
            for (int j = 0; j < 4; ++j) { const int i = 16 * mt + fq * 4 + j, jj = (2 * ntp + nt) * 16 + fr;
                const float p = (jj <= i ? af[0][nt][j] : 0.f) + (jj >= i ? ab[0][nt][j] : 0.f); A1[i * 200 + jj] = (bf16_t)f2bf(p); }
    }
    __syncthreads();
    {
        const int mt = w & 3, nh = w >> 2;
        f32x4 acc[1][4]; zero_acc<1, 4>(acc);
        mma_nt<1, 4>(acc, A1 + (16 * mt) * 200, 200, B1 + (64 * nh) * 200, 200, 192, fr, fq);
        float ss[4];
#pragma unroll
        for (int j = 0; j < 4; ++j) { float s = 0.f;
#pragma unroll
            for (int nt = 0; nt < 4; ++nt) s += acc[0][nt][j] * acc[0][nt][j];
            s += __shfl_xor(s, 1); s += __shfl_xor(s, 2); s += __shfl_xor(s, 4); s += __shfl_xor(s, 8); ss[j] = s; }
        if (fr == 0) {
#pragma unroll
            for (int j = 0; j < 4; ++j) RS[nh * 64 + 16 * mt + fq * 4 + j] = ss[j]; }
        __syncthreads();
        const float* ng = P.in[13] + (size_t)l * 128;
        bf16_t* cat = (bf16_t*)(P.ws + WS_CAT);
#pragma unroll
        for (int j = 0; j < 4; ++j) { const int i = 16 * mt + fq * 4 + j; const float rinv = 1.0f / sqrtf((RS[i] + RS[64 + i]) * (1.0f / 128.0f) + NORM_EPS);
#pragma unroll
            for (int nt = 0; nt < 4; ++nt) { const int e = nh * 64 + nt * 16 + fr; const float rv = bf2f(pb[(size_t)(row0 + i) * INP + C_R + 128 * h + e]);
                const float o = acc[0][nt][j] * rinv * ng[e] * (rv * sigmoidf_(rv)); cat[(size_t)(row0 + i) * D + 256 + 128 * h + e] = (bf16_t)f2bf(o); } }
    }
    __syncthreads();
}

__device__ __forceinline__ void conv_unit(const Frame& F, const Params& P, int l, int rowbase, int Ls, int t0) {
    const bf16_t* pb = (const bf16_t*)(P.ws + WS_PBUF);
    LAS bf16_t* Y = (LAS bf16_t*)(F.lds);
    LAS float* Z = (LAS float*)(F.lds + 49152);
    const int tid = F.tid;
    for (int ch = tid; ch < 94 * 32; ch += NTHREADS) { const int r = ch >> 5, cc = (ch & 31) * 8; const int t = t0 - 15 + r;
        u32x4 o = (u32x4){0u, 0u, 0u, 0u};
        if (t >= 0 && t < Ls) { const size_t rb = (size_t)(rowbase + t) * INP; const u32x4 a = *(const u32x4*)(pb + rb + C_CA + cc), g = *(const u32x4*)(pb + rb + C_CG + cc);
            o.x = pk2(bflo(a.x) * sigmoidf_(bflo(g.x)), bfhi(a.x) * sigmoidf_(bfhi(g.x))); o.y = pk2(bflo(a.y) * sigmoidf_(bflo(g.y)), bfhi(a.y) * sigmoidf_(bfhi(g.y)));
            o.z = pk2(bflo(a.z) * sigmoidf_(bflo(g.z)), bfhi(a.z) * sigmoidf_(bfhi(g.z))); o.w = pk2(bflo(a.w) * sigmoidf_(bflo(g.w)), bfhi(a.w) * sigmoidf_(bfhi(g.w))); }
        *(LAS u32x4*)(Y + r * 256 + cc) = o; }
    __syncthreads();
    { const int c = tid & 255, half = tid >> 8; const float* cw = P.in[14] + (size_t)l * 31 * 256 + c; const float cb = P.in[15][(size_t)l * 256 + c];
      float wv[31], yv[62];
#pragma unroll
      for (int j = 0; j < 31; ++j) wv[j] = cw[j * 256];
#pragma unroll
      for (int r = 0; r < 62; ++r) yv[r] = bf2f(Y[(half * 32 + r) * 256 + c]);
#pragma unroll
      for (int tt = 0; tt < 32; ++tt) { float z = cb;
#pragma unroll
          for (int j = 0; j < 31; ++j) z += wv[j] * yv[tt + j];
          Z[(half * 32 + tt) * 256 + c] = z; } }
    __syncthreads();
    { const float* lg = P.in[16] + (size_t)l * 256 + 4 * F.lane; const float* lb = P.in[17] + (size_t)l * 256 + 4 * F.lane; const f32x4 g = *(const f32x4*)lg, bb = *(const f32x4*)lb;
      bf16_t* cat = (bf16_t*)(P.ws + WS_CAT);
      for (int i = 0; i < 8; ++i) { const int t = F.wave * 8 + i; const f32x4 z = *(const LAS f32x4*)(Z + t * 256 + 4 * F.lane);
          const float mean = wave_sum((z.x + z.y) + (z.z + z.w)) * (1.0f / 256.0f); const f32x4 zc = z - mean;
          const float var = wave_sum((zc.x * zc.x + zc.y * zc.y) + (zc.z * zc.z + zc.w * zc.w)) * (1.0f / 256.0f); const float rstd = 1.0f / sqrtf(var + NORM_EPS);
          const f32x4 y = zc * rstd * g + bb; u32x2 o; o.x = pk2(y.x * sigmoidf_(y.x), y.y * sigmoidf_(y.y)); o.y = pk2(y.z * sigmoidf_(y.z), y.w * sigmoidf_(y.w));
          *(u32x2*)(cat + (size_t)(rowbase + t0 + t) * D + 768 + 4 * F.lane) = o; } }
    __syncthreads();
}

template <int R, int NP>
__device__ __forceinline__ void fourier_f1_unit(const Frame& F, const Params& P, int rowbase, int rstride, int h, const bf16_t* tab, int orow0, float oscale) {
    const bf16_t* pb = (const bf16_t*)(P.ws + WS_PBUF); const bf16_t* cm3 = (const bf16_t*)(P.ws + WS_CM3);
    constexpr int LZ = R + 8, MT0 = 4 * NP, NTW = R / 128, MTW = R / 128;
    LAS bf16_t* U = (LAS bf16_t*)(F.lds); LAS bf16_t* CM = U + R * 72; LAS bf16_t* ZT = CM + 64 * NP * 72;
    const int tid = F.tid, fr = F.lane & 15, fq = F.lane >> 4, w = F.wave;
    for (int ch = tid; ch < R * 8; ch += NTHREADS) { const int a = ch >> 3, c8 = (ch & 7) * 8;
        *(LAS u32x4*)(U + a * 72 + c8) = *(const u32x4*)(pb + (size_t)(rowbase + a * rstride) * INP + C_FOUR + 64 * h + c8); }
    for (int ch = tid; ch < 64 * NP * 8; ch += NTHREADS) { const int m = ch >> 3, c8 = (ch & 7) * 8; *(LAS u32x4*)(CM + m * 72 + c8) = *(const u32x4*)(cm3 + m * 64 + c8); }
    __syncthreads();
    {
        f32x4 acc[MT0][NTW]; zero_acc<MT0, NTW>(acc);
        mma_nt<MT0, NTW>(acc, CM, 72, U + (w * NTW * 16) * 72, 72, 64, fr, fq);
#pragma unroll
        for (int mt = 0; mt < MT0; ++mt)
#pragma unroll
            for (int nt = 0; nt < NTW; ++nt)
#pragma unroll
                for (int j = 0; j < 4; ++j) ZT[(mt * 16 + fq * 4 + j) * LZ + (w * NTW + nt) * 16 + fr] = (bf16_t)f2bf(acc[mt][nt][j]);
    }
    __syncthreads();
    {
        f32x4 are[MTW][4], aim[MTW][4]; zero_acc<MTW, 4>(are); zero_acc<MTW, 4>(aim);
        const int m0 = w * MTW * 16;
        for (int k0 = 0; k0 < R; k0 += 32) {
            bf16x8 tc[MTW], ts[MTW];
#pragma unroll
            for (int mi = 0; mi < MTW; ++mi) { tc[mi] = *(const bf16x8*)(tab + (size_t)(m0 + mi * 16 + fr) * R + k0 + fq * 8); ts[mi] = *(const bf16x8*)(tab + (size_t)R * R + (size_t)(m0 + mi * 16 + fr) * R + k0 + fq * 8); }
#pragma unroll
            for (int nt = 0; nt < 4; ++nt) {
                const bf16x8 zr = *(const LAS bf16x8*)(ZT + (nt * 16 + fr) * LZ + k0 + fq * 8), zi = *(const LAS bf16x8*)(ZT + (64 + nt * 16 + fr) * LZ + k0 + fq * 8);
#pragma unroll
                for (int mi = 0; mi < MTW; ++mi) { are[mi][nt] = __builtin_amdgcn_mfma_f32_16x16x32_bf16(tc[mi], zr, are[mi][nt], 0, 0, 0); are[mi][nt] = __builtin_amdgcn_mfma_f32_16x16x32_bf16(ts[mi], zi, are[mi][nt], 0, 0, 0); }
                if constexpr (NP == 3) { const bf16x8 nzr = *(const LAS bf16x8*)(ZT + (128 + nt * 16 + fr) * LZ + k0 + fq * 8);
#pragma unroll
                    for (int mi = 0; mi < MTW; ++mi) { aim[mi][nt] = __builtin_amdgcn_mfma_f32_16x16x32_bf16(tc[mi], zi, aim[mi][nt], 0, 0, 0); aim[mi][nt] = __builtin_amdgcn_mfma_f32_16x16x32_bf16(ts[mi], nzr, aim[mi][nt], 0, 0, 0); } }
            }
        }
#pragma unroll
        for (int mi = 0; mi < MTW; ++mi)
#pragma unroll
            for (int nt = 0; nt < 4; ++nt)
#pragma unroll
                for (int j = 0; j < 4; ++j) { const int m = m0 + mi * 16 + fq * 4 + j, k2 = nt * 16 + fr;
                    if constexpr (NP == 3) { unsigned* t2 = (unsigned*)(P.ws + WS_T2); t2[(size_t)(orow0 + 128 * m) * 256 + h * 64 + k2] = pk2(are[mi][nt][j], aim[mi][nt][j]); }
                    else { bf16_t* cat = (bf16_t*)(P.ws + WS_CAT); cat[(size_t)(orow0 + m) * D + h * 64 + k2] = (bf16_t)f2bf(are[mi][nt][j] * oscale); } }
    }
    __syncthreads();
}

__device__ __forceinline__ void fourier_f2_unit(const Frame& F, const Params& P, int b, int d, int hp) {
    const bf16_t* t2 = (const bf16_t*)(P.ws + WS_T2); const bf16_t* tf2 = (const bf16_t*)(P.ws + WS_TF2);
    LAS bf16_t* X = (LAS bf16_t*)(F.lds);
    const int tid = F.tid, fr = F.lane & 15, fq = F.lane >> 4, w = F.wave;
    for (int ch = tid; ch < 128 * 32; ch += NTHREADS) { const int n = ch >> 5, c8 = (ch & 31) * 8;
        *(LAS u32x4*)(X + n * 264 + c8) = *(const u32x4*)(t2 + (size_t)(b * SEQ + 128 * d + n) * 512 + hp * 256 + c8); }
    __syncthreads();
    f32x4 acc[8];
#pragma unroll
    for (int mt = 0; mt < 8; ++mt) acc[mt] = (f32x4){0.f, 0.f, 0.f, 0.f};
    for (int k0 = 0; k0 < 128; k0 += 32) {
        bf16x8 xr, xi;
#pragma unroll
        for (int jj = 0; jj < 8; ++jj) { const unsigned wd = *(const LAS unsigned*)(X + (k0 + fq * 8 + jj) * 264 + 2 * (w * 16 + fr)); xr[jj] = (short)(wd & 0xffffu); xi[jj] = (short)(wd >> 16); }
#pragma unroll
        for (int mt = 0; mt < 8; ++mt) { const bf16x8 tc = *(const bf16x8*)(tf2 + (mt * 16 + fr) * 128 + k0 + fq * 8), ts = *(const bf16x8*)(tf2 + 16384 + (mt * 16 + fr) * 128 + k0 + fq * 8);
            acc[mt] = __builtin_amdgcn_mfma_f32_16x16x32_bf16(tc, xr, acc[mt], 0, 0, 0); acc[mt] = __builtin_amdgcn_mfma_f32_16x16x32_bf16(ts, xi, acc[mt], 0, 0, 0); }
    }
    bf16_t* cat = (bf16_t*)(P.ws + WS_CAT);
#pragma unroll
    for (int mt = 0; mt < 8; ++mt)
#pragma unroll
        for (int j = 0; j < 4; ++j) { const int c = mt * 16 + fq * 4 + j; cat[(size_t)(b * SEQ + 128 * c + d) * D + hp * 128 + w * 16 + fr] = (bf16_t)f2bf(acc[mt][j] * (1.0f / 1024.0f)); }
    __syncthreads();
}

constexpr int AX_LCNT = AUX_OFF, AX_GBASE = AUX_OFF + 128, AX_LE = AUX_OFF + 256, AX_LP = AUX_OFF + 256 + 2560;
constexpr int LC_BAR = LCTL_OFF, LC_TS = LCTL_OFF + 64;

__device__ __forceinline__ void phase_route(const Frame& F, const Params& P, int l, int ntok) {
    unsigned char* ws = P.ws;
    LAS float* RWT = (LAS float*)(F.lds);
    volatile LAS int* lcnt = (volatile LAS int*)(F.lds + AX_LCNT); volatile LAS int* gbase = (volatile LAS int*)(F.lds + AX_GBASE);
    volatile LAS int* LE = (volatile LAS int*)(F.lds + AX_LE); volatile LAS int* LP = (volatile LAS int*)(F.lds + AX_LP);
    const int tid = F.tid, lane = F.lane;
    const int tpb = (ntok + F.G - 1) / F.G, tb = F.bid * tpb, te = (tb + tpb < ntok) ? tb + tpb : ntok;
    { const float* rw = P.in[19] + (size_t)l * D * NE;
      for (int idx = tid; idx < D * NE; idx += NTHREADS) { const int k = idx >> 5, e = idx & 31; RWT[e * 1024 + k] = rw[idx]; } }
    if (tid < 32) lcnt[tid] = 0;
    __syncthreads();
    const float* xres = (const float*)(ws + WS_XRES); bf16_t* hb = (bf16_t*)(ws + WS_HBUF);
    const float* g2 = P.in[5] + (size_t)l * D; const float* rb = P.in[20] + (size_t)l * NE;
    float* aprob = (float*)(ws + WS_APROB);
    for (int tl = F.wave; tb + tl < te; tl += NWAVES) {
        const int m = tb + tl; const int v = (m >= NLAT) ? 2 : (m >= SEQ ? 1 : 0);
        const float* mf = (const float*)(ws + WS_MODF) + ((size_t)l * 3 + v) * 6144;
        f32x4 x[4]; float ss = 0.f;
#pragma unroll
        for (int j = 0; j < 4; ++j) { x[j] = *(const f32x4*)(xres + (size_t)m * D + 4 * lane + 256 * j); ss += (x[j].x * x[j].x + x[j].y * x[j].y) + (x[j].z * x[j].z + x[j].w * x[j].w); }
        const float rstd = 1.0f / sqrtf(wave_sum(ss) * (1.0f / D) + NORM_EPS);
#pragma unroll
        for (int j = 0; j < 4; ++j) { const int c = 4 * lane + 256 * j; const f32x4 gv = *(const f32x4*)(g2 + c), sh = *(const f32x4*)(mf + 3 * 1024 + c), sc = *(const f32x4*)(mf + 4 * 1024 + c);
            x[j] = (x[j] * rstd) * gv * (sc + 1.0f) + sh; u32x2 o; o.x = pk2(x[j].x, x[j].y); o.y = pk2(x[j].z, x[j].w); *(u32x2*)(hb + (size_t)m * D + c) = o; }
        float pv[32];
#pragma unroll
        for (int e = 0; e < 32; ++e) { float s = 0.f;
#pragma unroll
            for (int j = 0; j < 4; ++j) { const f32x4 wv = *(const LAS f32x4*)(RWT + e * 1024 + 4 * lane + 256 * j); s += (x[j].x * wv.x + x[j].y * wv.y) + (x[j].z * wv.z + x[j].w * wv.w); }
            pv[e] = s; }
        { const bool hi = (lane & 32) != 0;
#pragma unroll
          for (int i = 0; i < 16; ++i) { const float a = pv[i], b = pv[i + 16]; const float send = hi ? a : b, keep = hi ? b : a; pv[i] = keep + __shfl_xor(send, 32); } }
        { const bool hi = (lane & 16) != 0;
#pragma unroll
          for (int i = 0; i < 8; ++i) { const float a = pv[i], b = pv[i + 8]; const float send = hi ? a : b, keep = hi ? b : a; pv[i] = keep + __shfl_xor(send, 16); } }
        { const bool hi = (lane & 8) != 0;
#pragma unroll
          for (int i = 0; i < 4; ++i) { const float a = pv[i], b = pv[i + 4]; const float send = hi ? a : b, keep = hi ? b : a; pv[i] = keep + __shfl_xor(send, 8); } }
        { const bool hi = (lane & 4) != 0;
#pragma unroll
          for (int i = 0; i < 2; ++i) { const float a = pv[i], b = pv[i + 2]; const float send = hi ? a : b, keep = hi ? b : a; pv[i] = keep + __shfl_xor(send, 4); } }
        { const bool hi = (lane & 2) != 0; const float a = pv[0], b = pv[1]; const float send = hi ? a : b, keep = hi ? b : a; pv[0] = keep + __shfl_xor(send, 2); }
        const float mine = pv[0] + __shfl_xor(pv[0], 1);
        float lg[32];
#pragma unroll
        for (int e = 0; e < 32; ++e) lg[e] = __shfl(mine, 2 * e) + rb[e];
        unsigned taken = 0u; int bidx[4]; float bval[4];
#pragma unroll
        for (int k = 0; k < 4; ++k) { float best = -INFINITY; int bi = 0;
#pragma unroll
            for (int e = 0; e < 32; ++e) { const bool c = (((taken >> e) & 1u) == 0u) && (lg[e] > best); best = c ? lg[e] : best; bi = c ? e : bi; }
            taken |= 1u << bi; bidx[k] = bi; bval[k] = best; }
        float ex[4], sum = 0.f;
#pragma unroll
        for (int k = 0; k < 4; ++k) { ex[k] = __expf(bval[k] - bval[0]); sum += ex[k]; }
        if (lane == 0) {
#pragma unroll
            for (int k = 0; k < 4; ++k) { const int lp = __hip_atomic_fetch_add((LAS int*)(F.lds + AX_LCNT) + bidx[k], 1, __ATOMIC_RELAXED, __HIP_MEMORY_SCOPE_WORKGROUP);
                LE[tl * 4 + k] = bidx[k]; LP[tl * 4 + k] = lp; aprob[(size_t)m * 4 + k] = ex[k] / sum; } }
    }
    __syncthreads();
    if (tid < 32) gbase[tid] = (int)__hip_atomic_fetch_add((unsigned*)(ws + WS_CTL) + CW_CNT + l * 64 + tid, (unsigned)lcnt[tid], __ATOMIC_RELAXED, __HIP_MEMORY_SCOPE_AGENT);
    __syncthreads();
    int* aexp = (int*)(ws + WS_AEXP); int* apos = (int*)(ws + WS_APOS);
    for (int i = tid; i < (te - tb) * 4; i += NTHREADS) { const int e = LE[i]; aexp[(size_t)tb * 4 + i] = e; apos[(size_t)tb * 4 + i] = gbase[e] + LP[i]; }
    __syncthreads();
}

__device__ __forceinline__ void phase_gather(const Frame& F, const Params& P, int l, int ntok) {
    unsigned char* ws = P.ws;
    volatile LAS int* TS = (volatile LAS int*)(F.lds + LC_TS);
    if (F.tid == 0) { int s = 0; TS[0] = 0;
        for (int e = 0; e < NE; ++e) { const unsigned c = __hip_atomic_load((unsigned*)(ws + WS_CTL) + CW_CNT + l * 64 + e, __ATOMIC_RELAXED, __HIP_MEMORY_SCOPE_AGENT); s += (int)((c + 255u) >> 8); TS[e + 1] = s; } }
    __syncthreads();
    const int gw = F.bid * NWAVES + F.wave, NGW = F.G * NWAVES;
    const int* aexp = (const int*)(ws + WS_AEXP); const int* apos = (const int*)(ws + WS_APOS); int* aslot = (int*)(ws + WS_ASLOT);
    const bf16_t* hb = (const bf16_t*)(ws + WS_HBUF); bf16_t* xb = (bf16_t*)(ws + WS_XB);
    for (int a = gw; a < ntok * 4; a += NGW) { const int e = aexp[a]; const int row = TS[e] * 256 + apos[a];
        if (F.lane == 0) aslot[a] = row;
        const u32x4* src = (const u32x4*)(hb + (size_t)(a >> 2) * D); u32x4* dst = (u32x4*)(xb + (size_t)row * D);
        dst[F.lane] = src[F.lane]; dst[F.lane + 64] = src[F.lane + 64]; }
}

__device__ __forceinline__ void phase_combine(const Frame& F, const Params& P, int l, int ntok, bool last) {
    unsigned char* ws = P.ws;
    const int gw = F.bid * NWAVES + F.wave, NGW = F.G * NWAVES, lane = F.lane;
    float* xres = (float*)(ws + WS_XRES); const bf16_t* yb = (const bf16_t*)(ws + WS_YB);
    const int* aslot = (const int*)(ws + WS_ASLOT); const float* aprob = (const float*)(ws + WS_APROB);
    for (int m = gw; m < ntok; m += NGW) {
        const int v = (m >= NLAT) ? 2 : (m >= SEQ ? 1 : 0);
        const float* mf = (const float*)(ws + WS_MODF) + ((size_t)l * 3 + v) * 6144;
        f32x4 y[4];
#pragma unroll
        for (int j = 0; j < 4; ++j) y[j] = (f32x4){0.f, 0.f, 0.f, 0.f};
#pragma unroll
        for (int k = 0; k < 4; ++k) { const int slot = aslot[(size_t)m * 4 + k]; const float p = aprob[(size_t)m * 4 + k];
#pragma unroll
            for (int j = 0; j < 4; ++j) { const u32x2 wv = *(const u32x2*)(yb + (size_t)slot * D + 4 * lane + 256 * j); y[j] += (f32x4){bflo(wv.x), bfhi(wv.x), bflo(wv.y), bfhi(wv.y)} * p; } }
        f32x4 x[4];
#pragma unroll
        for (int j = 0; j < 4; ++j) { const int c = 4 * lane + 256 * j; x[j] = *(const f32x4*)(xres + (size_t)m * D + c) + *(const f32x4*)(mf + 5 * 1024 + c) * y[j]; }
        if (!last) {
#pragma unroll
            for (int j = 0; j < 4; ++j) *(f32x4*)(xres + (size_t)m * D + 4 * lane + 256 * j) = x[j];
            const float* mn = (const float*)(ws + WS_MODF) + ((size_t)(l + 1) * 3 + v) * 6144;
            norm_row_store(x, P.in[4] + (size_t)(l + 1) * D, mn, mn + 1024, (bf16_t*)(ws + WS_HBUF) + (size_t)m * D, lane, false, P, 0, 0);
        } else {
            float ss = 0.f;
#pragma unroll
            for (int j = 0; j < 4; ++j) ss += (x[j].x * x[j].x + x[j].y * x[j].y) + (x[j].z * x[j].z + x[j].w * x[j].w);
            const float rstd = 1.0f / sqrtf(wave_sum(ss) * (1.0f / D) + NORM_EPS);
#pragma unroll
            for (int j = 0; j < 4; ++j) { const int c = 4 * lane + 256 * j; *(f32x4*)(P.out + (size_t)m * D + c) = (x[j] * rstd) * *(const f32x4*)(P.in[25] + c); }
        }
    }
}

__global__ void __launch_bounds__(NTHREADS, 2) mega_fwd(Params P0) {
    extern __shared__ __attribute__((aligned(16))) unsigned char lds_raw[];
    Frame F0; F0.lds = (LAS unsigned char*)lds_raw; F0.tid = threadIdx.x; F0.lane = F0.tid & 63; F0.wave = __builtin_amdgcn_readfirstlane(F0.tid >> 6); F0.G = gridDim.x; F0.bid = blockIdx.x;
#define PHASE_ENV() Frame F = F0; asm volatile("" : "+v"(F.tid)); F.lane = F.tid & 63; F.wave = __builtin_amdgcn_readfirstlane(F.tid >> 6); asm volatile("" : "+s"(F.bid), "+s"(F.G)); \
    Params P = P0; asm volatile("" : "+s"(P.ws)); unsigned char* ws = P.ws; (void)ws;
    { PHASE_ENV();
    for (int u = F.tid; u < (LDS_BYTES - LCTL_OFF) / 4; u += NTHREADS) ((LAS unsigned*)(F.lds + LCTL_OFF))[u] = 0u;
    __syncthreads();
    }
    XcdBarrier bar = xcd_barrier_post((unsigned*)(P0.ws + WS_CTL) + CW_BAR, (volatile LAS unsigned*)(F0.lds + LC_BAR));
#define GRID_BAR() xcd_barrier(bar)

    { PHASE_ENV(); phase_prologue(F, P); }
    GRID_BAR();
    { PHASE_ENV(); phase_p1(F, P); }
    GRID_BAR();

    for (int l = 0; l < DEPTH; ++l) {
        const bool last = (l == DEPTH - 1);
        { PHASE_ENV(); pg8::Gemm g{(const bf16_t*)(ws + WS_HBUF), (const bf16_t*)(ws + WS_WIN) + (size_t)l * INP * D, NTOK, INP, D};
          pg8::StaticOrder S; S.init(NTOK, INP, F.G, F.bid);
          pg8::EpiStoreBf16 E{(bf16_t*)(ws + WS_PBUF), INP};
          pg8::gemm_phase<pg8::EpiStoreBf16, pg8::StaticOrder>(F.lds, g, S, E, F.tid); }
        GRID_BAR();
        { PHASE_ENV();
        for (int u = F.bid; u < 2080; u += F.G) { int row0, h;
            if (u < 2048) { const int bh = u >> 8, n = u & 255; h = bh & 3; row0 = (bh >> 2) * SEQ + 64 * n; }
            else { const int q = u - 2048, bh = q >> 2, n = q & 3; h = bh & 3; row0 = NLAT + (bh >> 2) * CTXL + 64 * n; }
            gla_g1_unit(F, P, l, row0, h, u); } }
        { PHASE_ENV();
        for (int u = F.bid; u < 1024; u += F.G) { const int b = u >> 9, nlo = (u >> 2) & 127, h = u & 3;
            fourier_f1_unit<128, 3>(F, P, b * SEQ + nlo, 128, h, (const bf16_t*)(ws + WS_TLAT) + (size_t)nlo * 32768, b * SEQ + nlo, 1.0f); }
        }
        { PHASE_ENV();
        if (!last) for (int u = F.bid; u < 8; u += F.G) { const int b = u >> 2, h = u & 3;
            fourier_f1_unit<256, 2>(F, P, NLAT + b * CTXL, 1, h, (const bf16_t*)(ws + WS_TCTX), NLAT + b * CTXL, 1.0f / 128.0f); }
        }
        { PHASE_ENV();
        for (int u = F.bid; u < (last ? 512 : 520); u += F.G) {
            if (u < 512) conv_unit(F, P, l, 64 * u, 64, 0);
            else { const int q = u - 512; conv_unit(F, P, l, NLAT + (q >> 2) * CTXL, CTXL, 64 * (q & 3)); } } }
        GRID_BAR();
        { PHASE_ENV(); gla_scan(F, P); }
        { PHASE_ENV();
        for (int u = F.bid; u < 512; u += F.G) fourier_f2_unit(F, P, u >> 8, (u >> 1) & 127, u & 1); }
        GRID_BAR();
        { PHASE_ENV();
        for (int u = F.bid; u < (last ? 2048 : 2080); u += F.G) { int row0, h;
            if (u < 2048) { const int bh = u >> 8, n = u & 255; h = bh & 3; row0 = (bh >> 2) * SEQ + 64 * n; }
            else { const int q = u - 2048, bh = q >> 2, n = q & 3; h = bh & 3; row0 = NLAT + (bh >> 2) * CTXL + 64 * n; }
            gla_g3_unit(F, P, l, row0, h, u); } }
        GRID_BAR();
        { PHASE_ENV(); const int M2 = last ? NLAT : NTOK;
          pg8::Gemm g{(const bf16_t*)(ws + WS_CAT), (const bf16_t*)(ws + WS_WOUT) + (size_t)l * D * D, M2, D, D};
          pg8::StaticOrder S; S.init(M2, D, F.G, F.bid);
          pg8::EpiResid E{(float*)(ws + WS_XRES), (const float*)(ws + WS_MODF) + (size_t)l * 3 * 6144};
          pg8::gemm_phase<pg8::EpiResid, pg8::StaticOrder>(F.lds, g, S, E, F.tid); }
        GRID_BAR();
        const int ntok = last ? NLAT : NTOK;
        { PHASE_ENV(); phase_route(F, P, l, ntok); }
        GRID_BAR();
        { PHASE_ENV(); phase_gather(F, P, l, ntok); }
        GRID_BAR();
        { PHASE_ENV(); const volatile LAS int* TS = (const volatile LAS int*)(F.lds + LC_TS);
          pg8::Gemm g{(const bf16_t*)(ws + WS_XB), (const bf16_t*)(ws + WS_WGU) + (size_t)l * NE * 2048 * D, 0, 2048, D};
          pg8::MoeOrder S{8, F.G, F.bid, TS[NE], TS};
          pg8::EpiGateUp E{(bf16_t*)(ws + WS_ACT), P.in[22] + (size_t)l * NE * 2048};
          pg8::gemm_phase<pg8::EpiGateUp, pg8::MoeOrder>(F.lds, g, S, E, F.tid); }
        GRID_BAR();
        { PHASE_ENV(); const volatile LAS int* TS = (const volatile LAS int*)(F.lds + LC_TS);
          pg8::Gemm g{(const bf16_t*)(ws + WS_ACT), (const bf16_t*)(ws + WS_WDN) + (size_t)l * NE * D * DFF, 0, D, DFF};
          pg8::MoeOrder S{4, F.G, F.bid, TS[NE], TS};
          pg8::EpiDown E{(bf16_t*)(ws + WS_YB), P.in[24] + (size_t)l * NE * D};
          pg8::gemm_phase<pg8::EpiDown, pg8::MoeOrder>(F.lds, g, S, E, F.tid); }
        GRID_BAR();
        { PHASE_ENV(); phase_combine(F, P, l, ntok, last); }
        if (!last) GRID_BAR();
    }
}

extern "C" void kernel_launch(void* const* d_in, const int* in_sizes, int n_in, void* d_out, int out_size, void* d_ws, size_t ws_size, hipStream_t stream) {
    static int grid = 0;
    if (grid == 0) {
        if (n_in != 26 || ws_size < WS_END) { fprintf(stderr, "kernel_launch: unexpected n_in %d or ws_size %zu (need %zu)\n", n_in, ws_size, (size_t)WS_END); grid = -1; return; }
        int dev = 0, cus = 0, per_cu = 0;
        if (hipGetDevice(&dev) != hipSuccess || hipDeviceGetAttribute(&cus, hipDeviceAttributeMultiprocessorCount, dev) != hipSuccess) { grid = -1; return; }
        if (hipFuncSetAttribute((const void*)mega_fwd, hipFuncAttributeMaxDynamicSharedMemorySize, LDS_BYTES) != hipSuccess) { fprintf(stderr, "kernel_launch: hipFuncSetAttribute failed\n"); grid = -1; return; }
        if (hipOccupancyMaxActiveBlocksPerMultiprocessor(&per_cu, (const void*)mega_fwd, NTHREADS, LDS_BYTES) != hipSuccess || per_cu < 1) { fprintf(stderr, "kernel_launch: occupancy query says %d\n", per_cu); }
        (void)hipGetLastError();
        grid = cus;
    }
    if (grid < 0) return;
    (void)hipMemsetAsync((char*)d_ws + WS_CTL, 0, CTL_ZERO_BYTES, stream);
    Params p{};
    for (int i = 0; i < 26; ++i) p.in[i] = (const float*)d_in[i];
    p.out = (float*)d_out; p.ws = (unsigned char*)d_ws;
    hipLaunchKernelGGL(mega_fwd, dim3(grid), dim3(NTHREADS), LDS_BYTES, stream, p);
}
```

```cpp
#include <hip/hip_runtime.h>
#include <cstdio>
#include <cstdint>

#define LAS __attribute__((address_space(3)))
#define GAS __attribute__((address_space(1)))
typedef unsigned short bf16_t;
typedef short bf16x8 __attribute__((ext_vector_type(8)));
typedef float f32x4 __attribute__((ext_vector_type(4)));
typedef float f32x2 __attribute__((ext_vector_type(2)));
typedef unsigned u32x4 __attribute__((ext_vector_type(4)));
typedef unsigned u32x2 __attribute__((ext_vector_type(2)));

constexpr int D = 1024, NBATCH = 2, SEQ = 16384, NLAT = NBATCH * SEQ, CTXL = 256, NCTX = NBATCH * CTXL, NTOK = NLAT + NCTX, DEPTH = 2;
constexpr int INW = 2336, INP = 2560;
constexpr int C_FOUR = 0, C_Q = 256, C_K = 512, C_V = 768, C_R = 1280, C_GF = 1792, C_GB = 1808, C_CA = 1824, C_CG = 2080;
constexpr int NE = 32, TOPK = 4, DFF = 1024;
constexpr int MAXROWS = NTOK * TOPK + NE * 256;
constexpr float NORM_EPS = 1e-6f;
constexpr int NTHREADS = 512, NWAVES = 8;

constexpr size_t MiB = 1u << 20;
constexpr size_t WS_CTL = 0, CTL_ZERO_BYTES = 1 * MiB;
constexpr size_t WS_MODP = 1 * MiB;
constexpr size_t WS_MODF = 3 * MiB;
constexpr size_t WS_CM3 = 4 * MiB;
constexpr size_t WS_TF2 = 4 * MiB + 65536;
constexpr size_t WS_TCTX = 4 * MiB + 262144;
constexpr size_t WS_TLAT = 5 * MiB;
constexpr size_t WS_WIN = 13 * MiB;
constexpr size_t WS_WOUT = 23 * MiB;
constexpr size_t WS_WGU = 27 * MiB;
constexpr size_t WS_WDN = 283 * MiB;
constexpr size_t WS_XRES = 411 * MiB;
constexpr size_t WS_HBUF = 541 * MiB;
constexpr size_t WS_PBUF = 606 * MiB;
constexpr size_t WS_CAT = 769 * MiB;
constexpr size_t WS_T2 = 834 * MiB;
constexpr size_t WS_STATE = 866 * MiB;
constexpr size_t WS_DECAY = 996 * MiB;
constexpr size_t WS_AEXP = 998 * MiB, WS_APOS = 999 * MiB, WS_APROB = 1000 * MiB, WS_ASLOT = 1001 * MiB;
constexpr size_t WS_XB = 1002 * MiB, WS_ACT = 1278 * MiB, WS_YB = 1554 * MiB, WS_END = 1830 * MiB;
constexpr int CW_BAR = 4096, CW_CNT = 16384;

constexpr int RING_BYTES = 131072;
constexpr int AUX_OFF = RING_BYTES;
constexpr int LCTL_OFF = RING_BYTES + 8192;
constexpr int LDS_BYTES = 147456;

__device__ __forceinline__ unsigned f2bf(float f) { unsigned u = __builtin_bit_cast(unsigned, f); return (u + 0x7fffu + ((u >> 16) & 1u)) >> 16; }
__device__ __forceinline__ unsigned pk2(float lo, float hi) { return f2bf(lo) | (f2bf(hi) << 16); }
__device__ __forceinline__ float bf2f(unsigned b) { return __builtin_bit_cast(float, b << 16); }
__device__ __forceinline__ float bflo(unsigned w) { return __builtin_bit_cast(float, w << 16); }
__device__ __forceinline__ float bfhi(unsigned w) { return __builtin_bit_cast(float, w & 0xffff0000u); }
__device__ __forceinline__ float wave_sum(float v) {
#pragma unroll
    for (int o = 1; o < 64; o <<= 1) v += __shfl_xor(v, o);
    return v;
}
__device__ __forceinline__ float sigmoidf_(float x) { return 1.0f / (1.0f + __expf(-x)); }

#define XB_TMO      128
#define XB_XCNT(j)  (256  + 64 * (j))
#define XB_XSUB(j)  (1280 + 64 * (j))
#define XB_XGEN(j)  (2304 + 64 * (j))
#define XB_TOP      3328
#define XB_TOPGEN   3392
#define XCD_BAR_WORDS 3456
#define XB_SPIN_CAP (1u << 22)

__device__ __forceinline__ unsigned xb_ld(unsigned* p)              { return __hip_atomic_load(p, __ATOMIC_RELAXED, __HIP_MEMORY_SCOPE_AGENT); }
__device__ __forceinline__ unsigned xb_add(unsigned* p, unsigned v) { return __hip_atomic_fetch_add(p, v, __ATOMIC_RELAXED, __HIP_MEMORY_SCOPE_AGENT); }
__device__ __forceinline__ unsigned xb_xcc_id() { return (unsigned)__builtin_amdgcn_s_getreg((3 << 11) | 20) & 0xFu; }
#define XB_SPIN(cond, bar) do { unsigned _sp = 0; while (cond) { __builtin_amdgcn_s_sleep(1); \
    if ((++_sp & 255u) == 0u) { if (xb_ld(&(bar)[XB_TMO])) break; if (_sp > XB_SPIN_CAP) { atomicAdd(&(bar)[XB_TMO], 1u); break; } } } } while (0)

struct XcdBarrier { unsigned* bar; unsigned x; volatile LAS unsigned* st; };

__device__ __forceinline__ XcdBarrier xcd_barrier_post(unsigned* bar, volatile LAS unsigned* st) {
    XcdBarrier b; b.bar = bar; b.x = xb_xcc_id(); b.st = st;
    if (threadIdx.x == 0) (void)xb_add(&bar[XB_XCNT(b.x)], 1u);
    return b;
}
__device__ __forceinline__ void xcd_barrier_complete(unsigned* bar, unsigned x, unsigned& nloc, unsigned& nx) {
    const unsigned G = gridDim.x * gridDim.y * gridDim.z;
    unsigned sum, cnt, mine, sp = 0u;
    for (;;) {
        sum = 0u; cnt = 0u; mine = 0u;
#pragma unroll
        for (unsigned j = 0; j < 16; ++j) { const unsigned c = xb_ld(&bar[XB_XCNT(j)]); sum += c; cnt += (c > 0u) ? 1u : 0u; mine = (j == x) ? c : mine; }
        if (sum == G) break;
        __builtin_amdgcn_s_sleep(1);
        if ((++sp & 255u) == 0u) { if (xb_ld(&bar[XB_TMO])) break; if (sp > XB_SPIN_CAP) { atomicAdd(&bar[XB_TMO], 1u); break; } }
    }
    nloc = mine > 0u ? mine : 1u; nx = cnt > 0u ? cnt : 1u;
}
__device__ __forceinline__ void xcd_barrier(const XcdBarrier& b) {
    asm volatile("s_waitcnt vmcnt(0)" ::: "memory");
    __syncthreads();
    if (threadIdx.x == 0) {
        unsigned* bar = b.bar;
        __builtin_amdgcn_s_waitcnt(0);
        unsigned nloc = b.st[0], nx = b.st[1];
        if (nloc == 0u) { xcd_barrier_complete(bar, b.x, nloc, nx); b.st[0] = nloc; b.st[1] = nx; }
        const unsigned old = xb_add(&bar[XB_XSUB(b.x)], 1u);
        const unsigned gen = old / nloc;
        if (old + 1u == (gen + 1u) * nloc) {
            __builtin_amdgcn_fence(__ATOMIC_RELEASE, "agent");
            asm volatile("s_waitcnt vmcnt(0)" ::: "memory");
            const unsigned og = xb_add(&bar[XB_TOP], 1u);
            const unsigned tg = og / nx;
            if (og + 1u == (tg + 1u) * nx) xb_add(&bar[XB_TOPGEN], 1u);
            else XB_SPIN(xb_ld(&bar[XB_TOPGEN]) == tg, bar);
            __builtin_amdgcn_fence(__ATOMIC_ACQUIRE, "agent");
            xb_add(&bar[XB_XGEN(b.x)], 1u);
            asm volatile("s_waitcnt vmcnt(0)" ::: "memory");
        } else {
            XB_SPIN(xb_ld(&bar[XB_XGEN(b.x)]) == gen, bar);
            __builtin_amdgcn_fence(__ATOMIC_ACQUIRE, "agent");
            asm volatile("s_waitcnt vmcnt(0)" ::: "memory");
        }
    }
    __syncthreads();
}

namespace pg8 {
constexpr int BM = 256, BK = 64, HALF = 128, HTB = HALF * BK * 2, STAGE_BYTES = 8 * HTB, NXCD = 8, WGM = 8;
__host__ __device__ __forceinline__ int lds_byte(int r, int c) { const int st = (r >> 4) * 2 + (c >> 5), rr = r & 15, cc = c & 31, ob = rr * 64 + cc * 2; return st * 1024 + (ob ^ (((ob >> 9) & 1) << 5)); }
__host__ __device__ __forceinline__ void stage_rc(int b, int& R, int& C) { const int st = b / 1024, sb = b % 1024, swz = sb ^ (((sb >> 9) & 1) << 5); R = (st >> 1) * 16 + swz / 64; C = (st & 1) * 32 + (swz % 64) / 2; }
__host__ __device__ __forceinline__ int perm32(int rho) { const int n = rho >> 4, i = rho & 15; return 8 * (i >> 2) + 4 * n + (i & 3); }

struct Unit { int pm, pn; };
struct Gemm { const bf16_t* A; const bf16_t* Bt; int M, N, K; };

struct StaticOrder {
    int nM, nN, nwg, G, c;
    __device__ void init(int M, int N, int G_, int c_) { nM = M / BM; nN = N / BM; nwg = nM * nN; G = G_; c = c_; }
    __device__ bool next(int i, Unit& u) const {
        const long L = (long)i * G + c; if (L >= nwg) return false;
        int wgid = (int)L; { const int q = nwg / NXCD, r = nwg % NXCD, xcd = wgid % NXCD, off = wgid / NXCD; wgid = (xcd < r ? xcd * (q + 1) : r * (q + 1) + (xcd - r) * q) + off; }
        const int nig = WGM * nN, gid = wgid / nig, fm = gid * WGM, gsz = (nM - fm) < WGM ? (nM - fm) : WGM;
        u.pm = fm + ((wgid % nig) % gsz); u.pn = (wgid % nig) / gsz; return true;
    }
};
struct MoeOrder {
    int nN, G, c, MT; const volatile LAS int* ts;
    __device__ bool next(int i, Unit& u) const {
        const long L = (long)i * G + c; if (L >= (long)MT * nN) return false;
        const int mt = (int)(L / nN), pl = (int)(L % nN);
        int e = 0;
#pragma unroll 1
        for (int j = 1; j < NE; ++j) e += (ts[j] <= mt) ? 1 : 0;
        u.pm = mt; u.pn = e * nN + pl; return true;
    }
};

__device__ __forceinline__ unsigned cvt_pk_bf16(float lo, float hi) { unsigned r; asm volatile("v_cvt_pk_bf16_f32 %0, %1, %2" : "=v"(r) : "v"(lo), "v"(hi)); return r; }

struct EpiStoreBf16 {
    static constexpr bool PERM = true;
    bf16_t* O; int ldc;
    __device__ __forceinline__ void operator()(const f32x4 (&acc)[2][2][4][2], const Unit& u, int wr, int wc, int fr, int fq) const {
        const int row0 = u.pm * BM + wr * 64 + fr; const int col0 = u.pn * BM + wc * 32 + 8 * fq;
#pragma unroll
        for (int ai = 0; ai < 2; ++ai)
#pragma unroll
            for (int m = 0; m < 4; ++m) { bf16_t* rowp = O + (size_t)(row0 + ai * HALF + m * 16) * ldc + col0;
#pragma unroll
                for (int bj = 0; bj < 2; ++bj) { const f32x4 v0 = acc[ai][bj][m][0], v1 = acc[ai][bj][m][1];
                    u32x4 w; w.x = cvt_pk_bf16(v0[0], v0[1]); w.y = cvt_pk_bf16(v0[2], v0[3]); w.z = cvt_pk_bf16(v1[0], v1[1]); w.w = cvt_pk_bf16(v1[2], v1[3]);
                    *(u32x4*)(rowp + bj * HALF) = w; } }
    }
};
struct EpiResid {
    static constexpr bool PERM = false;
    float* X; const float* modf;
    __device__ __forceinline__ void operator()(const f32x4 (&acc)[2][2][4][2], const Unit& u, int wr, int wc, int fr, int fq) const {
        const int row0 = u.pm * BM + wr * 64 + fr, col0 = u.pn * BM + wc * 32 + 4 * fq;
        const int v = (u.pm >= NLAT / BM) ? 2 : (u.pm >= SEQ / BM ? 1 : 0);
        const float* gv = modf + (size_t)v * 6144 + 2 * 1024;
        f32x4 bv[2][2];
#pragma unroll
        for (int bj = 0; bj < 2; ++bj)
#pragma unroll
            for (int n = 0; n < 2; ++n) bv[bj][n] = *(const f32x4*)(gv + col0 + bj * HALF + n * 16);
#pragma unroll
        for (int ai = 0; ai < 2; ++ai) {
            f32x4 xv[4][2][2];
#pragma unroll
            for (int m = 0; m < 4; ++m) { const float* rowp = X + (size_t)(row0 + ai * HALF + m * 16) * D + col0;
#pragma unroll
                for (int bj = 0; bj < 2; ++bj)
#pragma unroll
                    for (int n = 0; n < 2; ++n) xv[m][bj][n] = *(const f32x4*)(rowp + bj * HALF + n * 16); }
#pragma unroll
            for (int m = 0; m < 4; ++m) { float* rowp = X + (size_t)(row0 + ai * HALF + m * 16) * D + col0;
#pragma unroll
                for (int bj = 0; bj < 2; ++bj)
#pragma unroll
                    for (int n = 0; n < 2; ++n) *(f32x4*)(rowp + bj * HALF + n * 16) = xv[m][bj][n] + bv[bj][n] * acc[ai][bj][m][n]; }
        }
    }
};
struct EpiGateUp {
    static constexpr bool PERM = true;
    bf16_t* O; const float* bgu;
    __device__ __forceinline__ void operator()(const f32x4 (&acc)[2][2][4][2], const Unit& u, int wr, int wc, int fr, int fq) const {
        const int e = u.pn >> 3, pl = u.pn & 7;
        const int row0 = u.pm * BM + wr * 64 + fr; const int cl = pl * 128 + wc * 32 + 8 * fq;
        const float* bg = bgu + (size_t)e * 2048 + cl; const float* bu = bg + 1024;
        f32x4 g0 = *(const f32x4*)bg, g1 = *(const f32x4*)(bg + 4), u0 = *(const f32x4*)bu, u1 = *(const f32x4*)(bu + 4);
#pragma unroll
        for (int ai = 0; ai < 2; ++ai)
#pragma unroll
            for (int m = 0; m < 4; ++m) { bf16_t* rowp = O + (size_t)(row0 + ai * HALF + m * 16) * DFF + cl;
                float r[8];
#pragma unroll
                for (int n = 0; n < 2; ++n) { const f32x4 gb = n ? g1 : g0, ub = n ? u1 : u0; const f32x4 ga = acc[ai][0][m][n] + gb, ua = acc[ai][1][m][n] + ub;
#pragma unroll
                    for (int j = 0; j < 4; ++j) { const float gate = fminf(ga[j], 7.0f), up = fminf(fmaxf(ua[j], -7.0f), 7.0f);
                        r[n * 4 + j] = gate * (1.0f / (1.0f + __expf(-1.702f * gate))) * (up + 1.0f); } }
                u32x4 w; w.x = cvt_pk_bf16(r[0], r[1]); w.y = cvt_pk_bf16(r[2], r[3]); w.z = cvt_pk_bf16(r[4], r[5]); w.w = cvt_pk_bf16(r[6], r[7]);
                *(u32x4*)rowp = w; }
    }
};
struct EpiDown {
    static constexpr bool PERM = true;
    bf16_t* O; const float* bdn;
    __device__ __forceinline__ void operator()(const f32x4 (&acc)[2][2][4][2], const Unit& u, int wr, int wc, int fr, int fq) const {
        const int e = u.pn >> 2, pl = u.pn & 3;
        const int row0 = u.pm * BM + wr * 64 + fr; const int col0 = pl * BM + wc * 32 + 8 * fq;
        f32x4 bv[2][2];
#pragma unroll
        for (int bj = 0; bj < 2; ++bj)
#pragma unroll
            for (int n = 0; n < 2; ++n) bv[bj][n] = *(const f32x4*)(bdn + (size_t)e * 1024 + col0 + bj * HALF + 4 * n);
#pragma unroll
        for (int ai = 0; ai < 2; ++ai)
#pragma unroll
            for (int m = 0; m < 4; ++m) { bf16_t* rowp = O + (size_t)(row0 + ai * HALF + m * 16) * D + col0;
#pragma unroll
                for (int bj = 0; bj < 2; ++bj) { const f32x4 v0 = acc[ai][bj][m][0] + bv[bj][0], v1 = acc[ai][bj][m][1] + bv[bj][1];
                    u32x4 w; w.x = cvt_pk_bf16(v0[0], v0[1]); w.y = cvt_pk_bf16(v0[2], v0[3]); w.z = cvt_pk_bf16(v1[0], v1[1]); w.w = cvt_pk_bf16(v1[2], v1[3]);
                    *(u32x4*)(rowp + bj * HALF) = w; } }
    }
};

template <class Epi, class Sched, bool ALIGN_EPI = true, bool SP2 = true>
__device__ __forceinline__ void gemm_phase(LAS unsigned char* lds, const Gemm g, const Sched& S, const Epi& E, const int tid) {
    const int wid = __builtin_amdgcn_readfirstlane(tid >> 6), lane = tid & 63, wr = wid >> 2, wc = wid & 3, fr = lane & 15, fq = lane >> 4;
    const int K = g.K, nt = K / BK;
    unsigned voffA[2], voffB[2];
#pragma unroll
    for (int i = 0; i < 2; ++i) { int R, C; stage_rc(tid * 16 + i * 8192, R, C); const int Rb = Epi::PERM ? ((R & ~31) + perm32(R & 31)) : R;
        voffA[i] = (unsigned)(R * K + C) * 2u; voffB[i] = (unsigned)(Rb * K + C) * 2u; }
    const size_t kstep = (size_t)(BK * 2);
    const size_t hstep = (size_t)HALF * K * 2;
    const size_t tstep = 2 * hstep;
    const unsigned ldsw = (unsigned)wid * 1024u;
    const int aoff = lds_byte(wr * 64 + fr, fq * 8), boff = lds_byte(wc * 32 + fr, fq * 8);
#define PG8_SA(b, h) (((b) * 2 + (h)) * HTB)
#define PG8_SB(b, h) ((4 + (b) * 2 + (h)) * HTB)
#define PG8_STAGE(bufoff, gbase, voff) do { _Pragma("unroll") for (int _i = 0; _i < 2; ++_i) \
        __builtin_amdgcn_global_load_lds((const unsigned*)((const char*)(gbase) + (voff)[_i]), (LAS unsigned*)(lds + (bufoff) + ldsw + _i * 8192), 16, 0, 0); } while (0)
#define PG8_LDA(dst, b, h) do { _Pragma("unroll") for (int m = 0; m < 4; ++m) _Pragma("unroll") for (int k = 0; k < 2; ++k) dst[m][k] = *(const LAS bf16x8*)(lds + PG8_SA(b, h) + aoff + m * 2048 + k * 1024); } while (0)
#define PG8_LDB(dst, b, h) do { _Pragma("unroll") for (int n = 0; n < 2; ++n) _Pragma("unroll") for (int k = 0; k < 2; ++k) dst[n][k] = *(const LAS bf16x8*)(lds + PG8_SB(b, h) + boff + n * 2048 + k * 1024); } while (0)
#define PG8_MMA(ai, bj, At, Bt) do { __builtin_amdgcn_s_setprio(1); _Pragma("unroll") for (int m = 0; m < 4; ++m) _Pragma("unroll") for (int n = 0; n < 2; ++n) _Pragma("unroll") for (int k = 0; k < 2; ++k) \
        acc[ai][bj][m][n] = __builtin_amdgcn_mfma_f32_16x16x32_bf16(Bt[n][k], At[m][k], acc[ai][bj][m][n], 0, 0, 0); __builtin_amdgcn_s_setprio(0); } while (0)
#define PG8_WAIT_V(n) asm volatile("s_waitcnt vmcnt(" #n ")" ::: "memory")
#define PG8_WAIT_L(n) asm volatile("s_waitcnt lgkmcnt(" #n ")" ::: "memory")
#define PG8_BAR __builtin_amdgcn_s_barrier()
#define PG8_SCHED __builtin_amdgcn_sched_barrier(0)
    Unit cur, nxt; int ui = 0;
    if (!S.next(0, cur)) return;
    f32x4 acc[2][2][4][2];
#pragma unroll
    for (int a = 0; a < 2; ++a)
#pragma unroll
        for (int b = 0; b < 2; ++b)
#pragma unroll
            for (int m = 0; m < 4; ++m)
#pragma unroll
                for (int n = 0; n < 2; ++n) acc[a][b][m][n] = (f32x4){0.f, 0.f, 0.f, 0.f};
    bf16x8 At[4][2], B0[2][2], B1[2][2];
    const char* cA = (const char*)g.A + (size_t)cur.pm * tstep; const char* cB = (const char*)g.Bt + (size_t)cur.pn * tstep;
    if constexpr (SP2) {
        PG8_STAGE(PG8_SB(0, 0), cB, voffB); PG8_STAGE(PG8_SB(0, 1), cB + hstep, voffB); PG8_STAGE(PG8_SA(0, 0), cA, voffA); PG8_STAGE(PG8_SA(0, 1), cA + hstep, voffA);
        if (wr == 1) PG8_BAR;
        PG8_WAIT_V(2); PG8_BAR;
        PG8_STAGE(PG8_SB(1, 0), cB + kstep, voffB); PG8_STAGE(PG8_SA(1, 0), cA + kstep, voffA); PG8_STAGE(PG8_SB(1, 1), cB + hstep + kstep, voffB);
        PG8_WAIT_V(6); PG8_BAR;
    } else {
        PG8_STAGE(PG8_SB(0, 0), cB, voffB); PG8_STAGE(PG8_SA(0, 0), cA, voffA); PG8_STAGE(PG8_SB(0, 1), cB + hstep, voffB); PG8_STAGE(PG8_SA(0, 1), cA + hstep, voffA);
        if (wr == 1) PG8_BAR;
        PG8_WAIT_V(4); PG8_BAR;
        PG8_STAGE(PG8_SB(1, 0), cB + kstep, voffB); PG8_STAGE(PG8_SA(1, 0), cA + kstep, voffA); PG8_STAGE(PG8_SB(1, 1), cB + hstep + kstep, voffB);
        PG8_WAIT_V(6); PG8_BAR;
    }
    for (;;) {
        const bool has_next = S.next(ui + 1, nxt);
        const char* nA = has_next ? (const char*)g.A + (size_t)nxt.pm * tstep : cA; const char* nB = has_next ? (const char*)g.Bt + (size_t)nxt.pn * tstep : cB;
        for (int t = 0; t < nt; t += 2) {
            const bool last = (t == nt - 2);
            const char* a1 = cA + (size_t)(t + 1) * kstep;
            const char* a2 = last ? nA : cA + (size_t)(t + 2) * kstep; const char* b2 = last ? nB : cB + (size_t)(t + 2) * kstep;
            const char* a3 = a2 + kstep; const char* b3 = b2 + kstep;
            if constexpr (SP2) {
            PG8_LDB(B0, 0, 0); PG8_LDB(B1, 0, 1); PG8_SCHED; PG8_LDA(At, 0, 0); PG8_STAGE(PG8_SA(1, 1), a1 + hstep, voffA);
            PG8_WAIT_V(8); PG8_WAIT_L(0); PG8_BAR; PG8_MMA(0, 0, At, B0); PG8_MMA(0, 1, At, B1); PG8_BAR; PG8_SCHED;
            PG8_LDA(At, 0, 1); PG8_STAGE(PG8_SB(0, 0), b2, voffB); PG8_STAGE(PG8_SB(0, 1), b2 + hstep, voffB); PG8_STAGE(PG8_SA(0, 0), a2, voffA);
            PG8_WAIT_V(8); PG8_WAIT_L(0); PG8_BAR; PG8_MMA(1, 0, At, B0); PG8_MMA(1, 1, At, B1); PG8_BAR; PG8_SCHED;
            PG8_LDB(B0, 1, 0); PG8_LDB(B1, 1, 1); PG8_SCHED; PG8_LDA(At, 1, 0); PG8_STAGE(PG8_SA(0, 1), a2 + hstep, voffA);
            PG8_WAIT_V(8); PG8_WAIT_L(0); PG8_BAR; PG8_MMA(0, 0, At, B0); PG8_MMA(0, 1, At, B1); PG8_BAR; PG8_SCHED;
            PG8_LDA(At, 1, 1); PG8_STAGE(PG8_SB(1, 0), b3, voffB); PG8_STAGE(PG8_SB(1, 1), b3 + hstep, voffB); PG8_STAGE(PG8_SA(1, 0), a3, voffA);
            PG8_WAIT_V(8); PG8_WAIT_L(0); PG8_BAR; PG8_MMA(1, 0, At, B0); PG8_MMA(1, 1, At, B1); PG8_BAR; PG8_SCHED;
            } else {
            PG8_LDB(B0, 0, 0); PG8_SCHED; PG8_LDA(At, 0, 0); PG8_STAGE(PG8_SA(1, 1), a1 + hstep, voffA);
            PG8_WAIT_L(8); PG8_BAR; PG8_WAIT_L(0); PG8_MMA(0, 0, At, B0); PG8_BAR; PG8_SCHED;
            PG8_LDB(B1, 0, 1); PG8_STAGE(PG8_SB(0, 0), b2, voffB);
            PG8_BAR; PG8_WAIT_L(0); PG8_MMA(0, 1, At, B1); PG8_BAR;
            PG8_LDA(At, 0, 1); PG8_STAGE(PG8_SA(0, 0), a2, voffA);
            PG8_BAR; PG8_WAIT_L(0); PG8_MMA(1, 0, At, B0); PG8_BAR; PG8_SCHED;
            PG8_STAGE(PG8_SB(0, 1), b2 + hstep, voffB);
            PG8_WAIT_V(6); PG8_BAR; PG8_MMA(1, 1, At, B1); PG8_BAR;
            PG8_LDB(B0, 1, 0); PG8_SCHED; PG8_LDA(At, 1, 0); PG8_STAGE(PG8_SA(0, 1), a2 + hstep, voffA);
            PG8_WAIT_L(8); PG8_BAR; PG8_WAIT_L(0); PG8_MMA(0, 0, At, B0); PG8_BAR; PG8_SCHED;
            PG8_LDB(B1, 1, 1); PG8_STAGE(PG8_SB(1, 0), b3, voffB);
            PG8_BAR; PG8_WAIT_L(0); PG8_MMA(0, 1, At, B1); PG8_BAR;
            PG8_LDA(At, 1, 1); PG8_STAGE(PG8_SA(1, 0), a3, voffA);
            PG8_BAR; PG8_WAIT_L(0); PG8_MMA(1, 0, At, B0); PG8_BAR; PG8_SCHED;
            PG8_STAGE(PG8_SB(1, 1), b3 + hstep, voffB);
            PG8_WAIT_V(6); PG8_BAR; PG8_MMA(1, 1, At, B1); PG8_BAR;
            }
        }
        if constexpr (ALIGN_EPI) { if (wr == 0) PG8_BAR; }
        E(acc, cur, wr, wc, fr, fq);
        if (!has_next) break;
#pragma unroll
        for (int a = 0; a < 2; ++a)
#pragma unroll
            for (int b = 0; b < 2; ++b)
#pragma unroll
                for (int m = 0; m < 4; ++m)
#pragma unroll
                    for (int n = 0; n < 2; ++n) acc[a][b][m][n] = (f32x4){0.f, 0.f, 0.f, 0.f};
        cur = nxt; cA = nA; cB = nB; ++ui;
        if constexpr (ALIGN_EPI) { if (wr == 1) PG8_BAR; }
    }
    PG8_WAIT_V(0);
    if constexpr (!ALIGN_EPI) { if (wr == 0) PG8_BAR; }
    PG8_BAR;
#undef PG8_SA
#undef PG8_SB
#undef PG8_STAGE
#undef PG8_LDA
#undef PG8_LDB
#undef PG8_MMA
#undef PG8_WAIT_V
#undef PG8_WAIT_L
#undef PG8_BAR
#undef PG8_SCHED
}
}

struct Params {
    const float* in[26];
    float* out;
    unsigned char* ws;
};
struct Frame {
    LAS unsigned char* lds;
    int tid, lane, wave, G, bid;
};

template <int MT, int NT>
__device__ __forceinline__ void mma_nt(f32x4 (&acc)[MT][NT], const LAS bf16_t* A, int lda, const LAS bf16_t* B, int ldb, int K, int fr, int fq) {
    for (int k0 = 0; k0 < K; k0 += 32) {
        bf16x8 a[MT], b[NT];
#pragma unroll
        for (int m = 0; m < MT; ++m) a[m] = *(const LAS bf16x8*)(A + (m * 16 + fr) * lda + k0 + fq * 8);
#pragma unroll
        for (int n = 0; n < NT; ++n) b[n] = *(const LAS bf16x8*)(B + (n * 16 + fr) * ldb + k0 + fq * 8);
#pragma unroll
        for (int m = 0; m < MT; ++m)
#pragma unroll
            for (int n = 0; n < NT; ++n) acc[m][n] = __builtin_amdgcn_mfma_f32_16x16x32_bf16(a[m], b[n], acc[m][n], 0, 0, 0);
    }
}
template <int MT, int NT> __device__ __forceinline__ void zero_acc(f32x4 (&acc)[MT][NT]) {
#pragma unroll
    for (int m = 0; m < MT; ++m)
#pragma unroll
        for (int n = 0; n < NT; ++n) acc[m][n] = (f32x4){0.f, 0.f, 0.f, 0.f};
}

__device__ __forceinline__ void p0_transpose_item(const float* W, int K, int N, bf16_t* WT, int k0, int n0, int orow0, LAS float* scr, int lane) {
    float tv[32];
#pragma unroll
    for (int i = 0; i < 32; ++i) { const int kk = 2 * i + (lane >> 5); tv[i] = W[(size_t)(k0 + kk) * N + n0 + (lane & 31)]; }
#pragma unroll
    for (int i = 0; i < 32; ++i) { const int kk = 2 * i + (lane >> 5); scr[kk * 33 + (lane & 31)] = tv[i]; }
    asm volatile("s_waitcnt lgkmcnt(0)" ::: "memory");
    const int c = lane & 7;
#pragma unroll
    for (int j = 0; j < 4; ++j) { const int n = (lane >> 3) + 8 * j; const LAS float* s = scr + (8 * c) * 33 + n;
        u32x4 o; o.x = pk2(s[0 * 33], s[1 * 33]); o.y = pk2(s[2 * 33], s[3 * 33]); o.z = pk2(s[4 * 33], s[5 * 33]); o.w = pk2(s[6 * 33], s[7 * 33]);
        *(u32x4*)(WT + (size_t)(orow0 + n) * K + k0 + 8 * c) = o; }
    asm volatile("s_waitcnt lgkmcnt(0)" ::: "memory");
}

__device__ __forceinline__ void phase_prologue(const Frame& F, const Params& P) {
    unsigned char* ws = P.ws;
    LAS float* scr = (LAS float*)(F.lds + F.wave * 16384);
    const int gw = F.bid * NWAVES + F.wave, NGW = F.G * NWAVES;
    constexpr int I_IN = 16 * 73, I_OUT = 16 * 32, I_GU = 16 * 64, I_DN = 16 * 32;
    constexpr int PER_LAYER = I_IN + I_OUT + NE * I_GU + NE * I_DN;
    for (int it = gw; it < DEPTH * PER_LAYER; it += NGW) {
        const int l = it / PER_LAYER; int r = it % PER_LAYER;
        if (r < I_IN) { const int kb = r / 73, nb = r % 73;
            p0_transpose_item(P.in[8] + (size_t)l * D * INW, D, INW, (bf16_t*)(ws + WS_WIN) + (size_t)l * INP * D, 64 * kb, 32 * nb, 32 * nb, scr, F.lane); continue; }
        r -= I_IN;
        if (r < I_OUT) { const int kb = r / 32, nb = r % 32;
            p0_transpose_item(P.in[18] + (size_t)l * D * D, D, D, (bf16_t*)(ws + WS_WOUT) + (size_t)l * D * D, 64 * kb, 32 * nb, 32 * nb, scr, F.lane); continue; }
        r -= I_OUT;
        if (r < NE * I_GU) { const int e = r / I_GU, q = r % I_GU, kb = q / 64, nb = q % 64; const int n0 = 32 * nb;
            const int j = n0 & 1023, orow = 256 * (j >> 7) + (n0 >= 1024 ? 128 : 0) + (j & 127);
            p0_transpose_item(P.in[21] + ((size_t)l * NE + e) * D * 2048, D, 2048, (bf16_t*)(ws + WS_WGU) + ((size_t)l * NE + e) * 2048 * D, 64 * kb, n0, orow, scr, F.lane); continue; }
        r -= NE * I_GU;
        { const int e = r / I_DN, q = r % I_DN, kb = q / 32, nb = q % 32;
            p0_transpose_item(P.in[23] + ((size_t)l * NE + e) * DFF * D, DFF, D, (bf16_t*)(ws + WS_WDN) + ((size_t)l * NE + e) * D * DFF, 64 * kb, 32 * nb, 32 * nb, scr, F.lane); }
    }
    {
        const int gt = F.bid * NTHREADS + F.tid, NGT = F.G * NTHREADS;
        constexpr int PADV = (INP - INW) * D / 8;
        for (int i = gt; i < DEPTH * PADV; i += NGT) { const int l = i / PADV, q = i % PADV;
            *((u32x4*)((bf16_t*)(ws + WS_WIN) + (size_t)l * INP * D + (size_t)INW * D) + q) = (u32x4){0u, 0u, 0u, 0u}; }
        bf16_t* cm3 = (bf16_t*)(ws + WS_CM3);
        for (int i = gt; i < 192 * 64; i += NGT) { const int m = i >> 6, n2 = i & 63, part = m >> 6, k2 = m & 63; const int ph = (k2 * n2) & 63;
            float s, c; sincospif((float)ph * (1.0f / 32.0f), &s, &c); const float v = part == 0 ? c : (part == 1 ? -s : -c); cm3[i] = (bf16_t)f2bf(v); }
        bf16_t* tf2 = (bf16_t*)(ws + WS_TF2);
        for (int i = gt; i < 128 * 128; i += NGT) { const int c_ = i >> 7, n = i & 127; const int ph = (c_ * n) & 127;
            float s, c; sincospif((float)ph * (1.0f / 64.0f), &s, &c); tf2[i] = (bf16_t)f2bf(c); tf2[128 * 128 + i] = (bf16_t)f2bf(s); }
        bf16_t* tctx = (bf16_t*)(ws + WS_TCTX);
        for (int i = gt; i < 256 * 256; i += NGT) { const int k1 = i >> 8, n = i & 255; const int ph = (k1 * n) & 255;
            float s, c; sincospif((float)ph * (1.0f / 128.0f), &s, &c); tctx[i] = (bf16_t)f2bf(c); tctx[256 * 256 + i] = (bf16_t)f2bf(s); }
        bf16_t* tlat = (bf16_t*)(ws + WS_TLAT);
        for (int i = gt; i < 128 * 128 * 128; i += NGT) { const int nlo = i >> 14, d = (i >> 7) & 127, a = i & 127; const int ph = (d * (nlo + 128 * a)) & 16383;
            float s, c; sincospif((float)ph * (1.0f / 8192.0f), &s, &c);
            tlat[(size_t)nlo * 32768 + d * 128 + a] = (bf16_t)f2bf(c); tlat[(size_t)nlo * 32768 + 16384 + d * 128 + a] = (bf16_t)f2bf(s); }
    }
    for (int it = gw; it < DEPTH * 24 * 8; it += NGW) {
        const int l = it / 192, q = it % 192, cb = q >> 3, ks = q & 7;
        const float* wm = P.in[6] + (size_t)l * D * 6144 + (size_t)(ks * 128) * 6144 + cb * 256 + 4 * F.lane;
        f32x4 a0 = {0.f, 0.f, 0.f, 0.f}, a1 = a0, a2 = a0;
#pragma unroll 4
        for (int k = 0; k < 128; ++k) { const int kk = ks * 128 + k;
            const float c0 = P.in[1][kk], c1 = P.in[1][D + kk], c2 = P.in[3][kk];
            const float s0 = c0 * sigmoidf_(c0), s1 = c1 * sigmoidf_(c1), s2 = c2 * sigmoidf_(c2);
            const f32x4 w = *(const f32x4*)(wm + (size_t)k * 6144);
            a0 += w * s0; a1 += w * s1; a2 += w * s2; }
        float* mp = (float*)(ws + WS_MODP) + ((size_t)(l * 8 + ks) * 3) * 6144 + cb * 256 + 4 * F.lane;
        *(f32x4*)(mp) = a0; *(f32x4*)(mp + 6144) = a1; *(f32x4*)(mp + 2 * 6144) = a2;
    }
}

__device__ __forceinline__ f32x4 mod_from_partials(const Params& P, int l, int v, int c4) {
    f32x4 s = *(const f32x4*)(P.in[7] + (size_t)l * 6144 + c4);
    const float* mp = (const float*)(P.ws + WS_MODP) + ((size_t)(l * 8) * 3 + v) * 6144 + c4;
#pragma unroll
    for (int ks = 0; ks < 8; ++ks) s += *(const f32x4*)(mp + (size_t)ks * 3 * 6144);
    return s;
}

__device__ __forceinline__ void norm_row_store(const f32x4 (&x)[4], const float* g, const float* shift, const float* scale, bf16_t* orow, int lane, bool from_partials, const Params& P, int l, int v) {
    float ss = 0.f;
#pragma unroll
    for (int j = 0; j < 4; ++j) ss += (x[j].x * x[j].x + x[j].y * x[j].y) + (x[j].z * x[j].z + x[j].w * x[j].w);
    const float rstd = 1.0f / sqrtf(wave_sum(ss) * (1.0f / D) + NORM_EPS);
#pragma unroll
    for (int j = 0; j < 4; ++j) { const int c = 4 * lane + 256 * j;
        const f32x4 gv = *(const f32x4*)(g + c);
        f32x4 sh, sc;
        if (from_partials) { sh = mod_from_partials(P, l, v, c); sc = mod_from_partials(P, l, v, 1024 + c); }
        else { sh = *(const f32x4*)(shift + c); sc = *(const f32x4*)(scale + c); }
        const f32x4 y = (x[j] * rstd) * gv * (sc + 1.0f) + sh;
        u32x2 o; o.x = pk2(y.x, y.y); o.y = pk2(y.z, y.w);
        *(u32x2*)(orow + c) = o; }
}

__device__ __forceinline__ void phase_p1(const Frame& F, const Params& P) {
    unsigned char* ws = P.ws;
    const int gt = F.bid * NTHREADS + F.tid, NGT = F.G * NTHREADS;
    float* modf = (float*)(ws + WS_MODF);
    for (int i = gt; i < DEPTH * 3 * 1536; i += NGT) { const int l = i / 4608, q = i % 4608, v = q / 1536, c4 = (q % 1536) * 4;
        *(f32x4*)(modf + ((size_t)l * 3 + v) * 6144 + c4) = mod_from_partials(P, l, v, c4); }
    const int gw = F.bid * NWAVES + F.wave, NGW = F.G * NWAVES;
    float* xres = (float*)(ws + WS_XRES); bf16_t* hb = (bf16_t*)(ws + WS_HBUF);
    for (int m = gw; m < NTOK; m += NGW) {
        const float* src = (m < NLAT) ? (P.in[0] + (size_t)m * D) : (P.in[2] + (size_t)(m - NLAT) * D);
        const int v = (m >= NLAT) ? 2 : (m >= SEQ ? 1 : 0);
        f32x4 x[4];
#pragma unroll
        for (int j = 0; j < 4; ++j) { x[j] = *(const f32x4*)(src + 4 * F.lane + 256 * j); *(f32x4*)(xres + (size_t)m * D + 4 * F.lane + 256 * j) = x[j]; }
        norm_row_store(x, P.in[4], nullptr, nullptr, hb + (size_t)m * D, F.lane, true, P, 0, v);
    }
}

constexpr int GL_GF = 0, GL_GB = 16384, GL_LR = 32768, GL_WG = 41472, GL_BG = 49664;
constexpr int GL_A1 = 53248, GL_KE = 78848, GL_RS = 97280, GL_RT = 97792;
constexpr int GL_KDT = 53248, GL_VT = 71680;

__device__ __forceinline__ float logsigmoidf_(float x) { return fminf(x, 0.f) - log1pf(__expf(-fabsf(x))); }

struct GateRegs { u32x2 lr; float wg[4]; float bg; };
__device__ __forceinline__ GateRegs gla_load_gate_regs(const Frame& F, const Params& P, int l, int row0, int h) {
    const bf16_t* pb = (const bf16_t*)(P.ws + WS_PBUF); const int tid = F.tid; GateRegs g;
    { const int row = tid >> 3, c4 = (tid & 7) * 4; g.lr = *(const u32x2*)(pb + (size_t)(row0 + row) * INP + C_GF + c4); }
#pragma unroll
    for (int j = 0; j < 4; ++j) { const int idx = tid * 4 + j, dir = idx >> 10, r = (idx >> 6) & 15, d = idx & 63; g.wg[j] = (dir ? P.in[11] : P.in[9])[(size_t)l * 16 * 256 + r * 256 + 64 * h + d]; }
    { const int t2 = tid & 127, dir = t2 >> 6, d = t2 & 63; g.bg = (dir ? P.in[12] : P.in[10])[(size_t)l * 256 + 64 * h + d]; }
    return g;
}
__device__ __forceinline__ void gla_gates(const Frame& F, const GateRegs& gr) {
    LAS float* G = (LAS float*)(F.lds + GL_GF); LAS float* LR = (LAS float*)(F.lds + GL_LR); LAS float* WG = (LAS float*)(F.lds + GL_WG); LAS float* BG = (LAS float*)(F.lds + GL_BG);
    const int tid = F.tid;
    { const int row = tid >> 3, c4 = (tid & 7) * 4; LR[row * 33 + c4 + 0] = bflo(gr.lr.x); LR[row * 33 + c4 + 1] = bfhi(gr.lr.x); LR[row * 33 + c4 + 2] = bflo(gr.lr.y); LR[row * 33 + c4 + 3] = bfhi(gr.lr.y); }
#pragma unroll
    for (int j = 0; j < 4; ++j) WG[tid * 4 + j] = gr.wg[j];
    if (tid < 128) BG[tid] = gr.bg;
    __syncthreads();
    { const int d = tid & 63, q = tid >> 6, dir = q & 1, tq = q >> 1;
      float wcol[16];
#pragma unroll
      for (int r = 0; r < 16; ++r) wcol[r] = WG[dir * 1024 + r * 64 + d];
      const float bg = BG[dir * 64 + d];
#pragma unroll 4
      for (int i = 0; i < 16; ++i) { const int t = tq * 16 + i; float pre = bg;
#pragma unroll
          for (int r = 0; r < 16; ++r) pre += LR[t * 33 + dir * 16 + r] * wcol[r];
          G[dir * 4096 + t * 64 + d] = logsigmoidf_(pre) * (1.0f / 16.0f); } }
    __syncthreads();
    if (tid < 128) { const int dir = tid >> 6, d = tid & 63; float s = 0.f;
        if (dir == 0) {
#pragma unroll 8
            for (int t = 0; t < 64; ++t) { s += G[t * 64 + d]; G[t * 64 + d] = s; } }
        else {
#pragma unroll 8
            for (int t = 63; t >= 0; --t) { s += G[4096 + t * 64 + d]; G[4096 + t * 64 + d] = s; } } }
    __syncthreads();
}
__device__ __forceinline__ float bfel(const u32x4& v, int j) { const unsigned w = (j < 2) ? v.x : (j < 4 ? v.y : (j < 6 ? v.z : v.w)); return (j & 1) ? bfhi(w) : bflo(w); }
__device__ __forceinline__ unsigned short bfraw(const u32x4& v, int j) { const unsigned w = (j < 2) ? v.x : (j < 4 ? v.y : (j < 6 ? v.z : v.w)); return (unsigned short)((j & 1) ? (w >> 16) : (w & 0xffffu)); }

__device__ __forceinline__ void gla_g1_unit(const Frame& F, const Params& P, int l, int row0, int h, int unit) {
    const bf16_t* pb = (const bf16_t*)(P.ws + WS_PBUF);
    const int tid = F.tid, row = tid >> 3, c8 = (tid & 7) * 8;
    const GateRegs gr = gla_load_gate_regs(F, P, l, row0, h);
    const u32x4 kv = *(const u32x4*)(pb + (size_t)(row0 + row) * INP + C_K + 64 * h + c8);
    u32x4 vv[2];
#pragma unroll
    for (int i = 0; i < 2; ++i) { const int ch = tid + 512 * i, vr = ch >> 4, vc = (ch & 15) * 8; vv[i] = *(const u32x4*)(pb + (size_t)(row0 + vr) * INP + C_V + 128 * h + vc); }
    gla_gates(F, gr);
    LAS float* GFp = (LAS float*)(F.lds + GL_GF); LAS float* GBp = (LAS float*)(F.lds + GL_GB);
    LAS bf16_t* KDT = (LAS bf16_t*)(F.lds + GL_KDT); LAS bf16_t* VT = (LAS bf16_t*)(F.lds + GL_VT);
    {
#pragma unroll
      for (int j = 0; j < 8; ++j) { const int d = c8 + j; const float k_ = bfel(kv, j);
          KDT[d * 72 + row] = (bf16_t)f2bf(k_ * __expf(GFp[63 * 64 + d] - GFp[row * 64 + d])); KDT[(64 + d) * 72 + row] = (bf16_t)f2bf(k_ * __expf(GBp[d] - GBp[row * 64 + d])); } }
#pragma unroll
    for (int i = 0; i < 2; ++i) { const int ch = tid + 512 * i, vr = ch >> 4, vc = (ch & 15) * 8;
#pragma unroll
        for (int j = 0; j < 8; ++j) VT[(vc + j) * 72 + vr] = bfraw(vv[i], j); }
    if (tid < 128) ((float*)(P.ws + WS_DECAY))[(size_t)unit * 128 + tid] = __expf(tid < 64 ? GFp[63 * 64 + tid] : GBp[tid - 64]);
    __syncthreads();
    const int fr = F.lane & 15, fq = F.lane >> 4, w = F.wave;
    f32x4 acc[1][8]; zero_acc<1, 8>(acc);
    mma_nt<1, 8>(acc, VT + (16 * w) * 72, 72, KDT, 72, 64, fr, fq);
    float* st = (float*)(P.ws + WS_STATE) + (size_t)unit * 16384;
#pragma unroll
    for (int nt = 0; nt < 8; ++nt)
#pragma unroll
        for (int j = 0; j < 4; ++j) st[(16 * w + fq * 4 + j) * 128 + nt * 16 + fr] = acc[0][nt][j];
    __syncthreads();
}

__device__ __forceinline__ void gla_scan(const Frame& F, const Params& P) {
    float* stt = (float*)(P.ws + WS_STATE); const float* dec = (const float*)(P.ws + WS_DECAY);
    for (int gid = F.bid * NTHREADS + F.tid; gid < 8 * 128 * 128; gid += F.G * NTHREADS) {
        const int dd = gid & 127, e = (gid >> 7) & 127, bh = gid >> 14, dir = dd >> 6;
        const int latb = bh * 256, ctxb = 2048 + bh * 4;
        auto unit_of = [&](int p) { return dir == 0 ? (p < 4 ? ctxb + p : latb + (p - 4)) : (p < 4 ? ctxb + 3 - p : latb + 255 - (p - 4)); };
        float s = 0.f;
        float dA[10], cA[10], dB[10], cB[10];
#pragma unroll
        for (int i = 0; i < 10; ++i) { const int u = unit_of(i); dA[i] = stt[((size_t)u * 128 + e) * 128 + dd]; cA[i] = dec[(size_t)u * 128 + dd]; }
        for (int p0 = 0; p0 < 260; p0 += 20) {
#pragma unroll
            for (int i = 0; i < 10; ++i) { const int u = unit_of(p0 + 10 + i); dB[i] = stt[((size_t)u * 128 + e) * 128 + dd]; cB[i] = dec[(size_t)u * 128 + dd]; }
#pragma unroll
            for (int i = 0; i < 10; ++i) { const int u = unit_of(p0 + i); stt[((size_t)u * 128 + e) * 128 + dd] = s; s = cA[i] * s + dA[i]; }
            if (p0 + 20 < 260) {
#pragma unroll
                for (int i = 0; i < 10; ++i) { const int u = unit_of(p0 + 20 + i); dA[i] = stt[((size_t)u * 128 + e) * 128 + dd]; cA[i] = dec[(size_t)u * 128 + dd]; } }
#pragma unroll
            for (int i = 0; i < 10; ++i) { const int u = unit_of(p0 + 10 + i); stt[((size_t)u * 128 + e) * 128 + dd] = s; s = cB[i] * s + dB[i]; }
        }
    }
}

__device__ __forceinline__ void gla_g3_unit(const Frame& F, const Params& P, int l, int row0, int h, int unit) {
    const bf16_t* pb = (const bf16_t*)(P.ws + WS_PBUF);
    const int tid = F.tid, fr = F.lane & 15, fq = F.lane >> 4, w = F.wave, row = tid >> 3, c8 = (tid & 7) * 8;
    const GateRegs gr = gla_load_gate_regs(F, P, l, row0, h);
    const u32x4 qv = *(const u32x4*)(pb + (size_t)(row0 + row) * INP + C_Q + 64 * h + c8), kv = *(const u32x4*)(pb + (size_t)(row0 + row) * INP + C_K + 64 * h + c8);
    u32x4 vv[2], rv[2];
#pragma unroll
    for (int i = 0; i < 2; ++i) { const int ch = tid + 512 * i, vr = ch >> 4, vc = (ch & 15) * 8; const bf16_t* rp = pb + (size_t)(row0 + vr) * INP + 128 * h + vc; vv[i] = *(const u32x4*)(rp + C_V); rv[i] = *(const u32x4*)(rp + C_R); }
    f32x4 stv[8];
    { const float* st = (const float*)(P.ws + WS_STATE) + (size_t)unit * 16384;
#pragma unroll
      for (int i = 0; i < 8; ++i) stv[i] = *(const f32x4*)(st + (i * 512 + tid) * 4); }
    const float* ng = P.in[13] + (size_t)l * 128;
    float ngv[4];
#pragma unroll
    for (int nt = 0; nt < 4; ++nt) ngv[nt] = ng[(w >> 2) * 64 + nt * 16 + fr];
    gla_gates(F, gr);
    LAS float* GFp = (LAS float*)(F.lds + GL_GF); LAS float* GBp = (LAS float*)(F.lds + GL_GB);
    LAS bf16_t* A1 = (LAS bf16_t*)(F.lds + GL_A1); LAS bf16_t* KE = (LAS bf16_t*)(F.lds + GL_KE); LAS bf16_t* B1 = (LAS bf16_t*)(F.lds);
    LAS float* RS = (LAS float*)(F.lds + GL_RS); LAS bf16_t* RT = (LAS bf16_t*)(F.lds + GL_RT);
#pragma unroll
    for (int i = 0; i < 2; ++i) { const int ch = tid + 512 * i, vr = ch >> 4, vc = (ch & 15) * 8; *(LAS u32x4*)(RT + vr * 136 + vc) = rv[i]; }
    { const f32x4 f0 = *(const LAS f32x4*)(GFp + row * 64 + c8), f1 = *(const LAS f32x4*)(GFp + row * 64 + c8 + 4), b0 = *(const LAS f32x4*)(GBp + row * 64 + c8), b1 = *(const LAS f32x4*)(GBp + row * 64 + c8 + 4);
      float qf[8], qb[8], kf[8], kb[8];
#pragma unroll
      for (int j = 0; j < 8; ++j) { const float q_ = bfel(qv, j) * 0.125f, k_ = bfel(kv, j); const float bf_ = j < 4 ? f0[j & 3] : f1[j & 3], bb_ = j < 4 ? b0[j & 3] : b1[j & 3];
          qf[j] = q_ * __expf(bf_); qb[j] = q_ * __expf(bb_); kf[j] = k_ * __expf(-bf_); kb[j] = k_ * __expf(-bb_); }
      *(LAS u32x4*)(A1 + row * 200 + 64 + c8) = (u32x4){pk2(qf[0], qf[1]), pk2(qf[2], qf[3]), pk2(qf[4], qf[5]), pk2(qf[6], qf[7])};
      *(LAS u32x4*)(A1 + row * 200 + 128 + c8) = (u32x4){pk2(qb[0], qb[1]), pk2(qb[2], qb[3]), pk2(qb[4], qb[5]), pk2(qb[6], qb[7])};
      *(LAS u32x4*)(KE + row * 72 + c8) = (u32x4){pk2(kf[0], kf[1]), pk2(kf[2], kf[3]), pk2(kf[4], kf[5]), pk2(kf[6], kf[7])};
      *(LAS u32x4*)(KE + 4608 + row * 72 + c8) = (u32x4){pk2(kb[0], kb[1]), pk2(kb[2], kb[3]), pk2(kb[4], kb[5]), pk2(kb[6], kb[7])}; }
    __syncthreads();
    {
        const int mt = w & 3, ntp = w >> 2;
        f32x4 af[1][2], ab[1][2]; zero_acc<1, 2>(af); zero_acc<1, 2>(ab);
        mma_nt<1, 2>(af, A1 + (16 * mt) * 200 + 64, 200, KE + (32 * ntp) * 72, 72, 64, fr, fq);
        mma_nt<1, 2>(ab, A1 + (16 * mt) * 200 + 128, 200, KE + 4608 + (32 * ntp) * 72, 72, 64, fr, fq);
#pragma unroll
        for (int i = 0; i < 2; ++i) { const int ch = tid + 512 * i, vr = ch >> 4, vc = (ch & 15) * 8;
#pragma unroll
            for (int j = 0; j < 8; ++j) B1[(vc + j) * 200 + vr] = bfraw(vv[i], j); }
#pragma unroll
        for (int i = 0; i < 8; ++i) { const int idx = (i * 512 + tid) * 4, e = idx >> 7, dd = idx & 127; u32x2 o; o.x = pk2(stv[i].x, stv[i].y); o.y = pk2(stv[i].z, stv[i].w); *(LAS u32x2*)(B1 + e * 200 + 64 + dd) = o; }
#pragma unroll
        for (int nt = 0; nt < 2; ++nt)
#pragma unroll
            for (int j = 0; j < 4; ++j) { const int i = 16 * mt + fq * 4 + j, jj = (2 * ntp + nt) * 16 + fr;
                const float p = (jj <= i ? af[0][nt][j] : 0.f) + (jj >= i ? ab[0][nt][j] : 0.f); A1[i * 200 + jj] = (bf16_t)f2bf(p); }
    }
    __syncthreads();
    {
        const int mt = w & 3, nh = w >> 2;
        f32x4 acc[1][4]; zero_acc<1, 4>(acc);
        mma_nt<1, 4>(acc, A1 + (16 * mt) * 200, 200, B1 + (64 * nh) * 200, 200, 192, fr, fq);
        float ss[4];
#pragma unroll
        for (int j = 0; j < 4; ++j) { float s = 0.f;
#pragma unroll
            for (int nt = 0; nt < 4; ++nt) s += acc[0][nt][j] * acc[0][nt][j];
            s += __shfl_xor(s, 1); s += __shfl_xor(s, 2); s += __shfl_xor(s, 4); s += __shfl_xor(s, 8); ss[j] = s; }
        if (fr == 0) {
#pragma unroll
            for (int j = 0; j < 4; ++j) RS[nh * 64 + 16 * mt + fq * 4 + j] = ss[j]; }
        __syncthreads();
        bf16_t* cat = (bf16_t*)(P.ws + WS_CAT);
#pragma unroll
        for (int j = 0; j < 4; ++j) { const int i = 16 * mt + fq * 4 + j; const float rinv = 1.0f / sqrtf((RS[i] + RS[64 + i]) * (1.0f / 128.0f) + NORM_EPS);
#pragma unroll
            for (int nt = 0; nt < 4; ++nt) { const int e = nh * 64 + nt * 16 + fr; const float r_ = bf2f(RT[i * 136 + e]);
                const float o = acc[0][nt][j] * rinv * ngv[nt] * (r_ * sigmoidf_(r_)); cat[(size_t)(row0 + i) * D + 256 + 128 * h + e] = (bf16_t)f2bf(o); } }
    }
    __syncthreads();
}

__device__ __forceinline__ void conv_unit(const Frame& F, const Params& P, int l, int rowbase, int Ls, int t0) {
    const bf16_t* pb = (const bf16_t*)(P.ws + WS_PBUF);
    LAS bf16_t* Y = (LAS bf16_t*)(F.lds);
    LAS float* Z = (LAS float*)(F.lds + 49152);
    const int tid = F.tid;
    {
        u32x4 av[6], gv[6];
#pragma unroll
        for (int i = 0; i < 6; ++i) { const int ch = tid + 512 * i, r = ch >> 5, cc = (ch & 31) * 8, t = t0 - 15 + r;
            av[i] = (u32x4){0u, 0u, 0u, 0u}; gv[i] = av[i];
            if (ch < 94 * 32 && t >= 0 && t < Ls) { const size_t rb = (size_t)(rowbase + t) * INP; av[i] = *(const u32x4*)(pb + rb + C_CA + cc); gv[i] = *(const u32x4*)(pb + rb + C_CG + cc); } }
#pragma unroll
        for (int i = 0; i < 6; ++i) { const int ch = tid + 512 * i, r = ch >> 5, cc = (ch & 31) * 8; const u32x4 a = av[i], g = gv[i]; u32x4 o;
            o.x = pk2(bflo(a.x) * sigmoidf_(bflo(g.x)), bfhi(a.x) * sigmoidf_(bfhi(g.x))); o.y = pk2(bflo(a.y) * sigmoidf_(bflo(g.y)), bfhi(a.y) * sigmoidf_(bfhi(g.y)));
            o.z = pk2(bflo(a.z) * sigmoidf_(bflo(g.z)), bfhi(a.z) * sigmoidf_(bfhi(g.z))); o.w = pk2(bflo(a.w) * sigmoidf_(bflo(g.w)), bfhi(a.w) * sigmoidf_(bfhi(g.w)));
            if (ch < 94 * 32) *(LAS u32x4*)(Y + r * 256 + cc) = o; }
    }
    const int c = tid & 255, half = tid >> 8; const float* cw = P.in[14] + (size_t)l * 31 * 256 + c; const float cb = P.in[15][(size_t)l * 256 + c];
    float wv[31];
#pragma unroll
    for (int j = 0; j < 31; ++j) wv[j] = cw[j * 256];
    const f32x4 lng = *(const f32x4*)(P.in[16] + (size_t)l * 256 + 4 * F.lane), lnb = *(const f32x4*)(P.in[17] + (size_t)l * 256 + 4 * F.lane);
    __syncthreads();
    { float yv[62];
#pragma unroll
      for (int r = 0; r < 62; ++r) yv[r] = bf2f(Y[(half * 32 + r) * 256 + c]);
#pragma unroll
      for (int tt = 0; tt < 32; ++tt) { float z = cb;
#pragma unroll
          for (int j = 0; j < 31; ++j) z += wv[j] * yv[tt + j];
          Z[(half * 32 + tt) * 256 + c] = z; } }
    __syncthreads();
    { bf16_t* cat = (bf16_t*)(P.ws + WS_CAT);
#pragma unroll 2
      for (int i = 0; i < 8; ++i) { const int t = F.wave * 8 + i; const f32x4 z = *(const LAS f32x4*)(Z + t * 256 + 4 * F.lane);
          const float mean = wave_sum((z.x + z.y) + (z.z + z.w)) * (1.0f / 256.0f); const f32x4 zc = z - mean;
          const float var = wave_sum((zc.x * zc.x + zc.y * zc.y) + (zc.z * zc.z + zc.w * zc.w)) * (1.0f / 256.0f); const float rstd = 1.0f / sqrtf(var + NORM_EPS);
          const f32x4 y = zc * rstd * lng + lnb; u32x2 o; o.x = pk2(y.x * sigmoidf_(y.x), y.y * sigmoidf_(y.y)); o.y = pk2(y.z * sigmoidf_(y.z), y.w * sigmoidf_(y.w));
          *(u32x2*)(cat + (size_t)(rowbase + t0 + t) * D + 768 + 4 * F.lane) = o; } }
    __syncthreads();
}

template <int R, int NP>
__device__ __forceinline__ void fourier_f1_unit(const Frame& F, const Params& P, int rowbase, int rstride, int h, const bf16_t* tab, int orow0, float oscale) {
    const bf16_t* pb = (const bf16_t*)(P.ws + WS_PBUF); const bf16_t* cm3 = (const bf16_t*)(P.ws + WS_CM3);
    constexpr int LZ = R + 8, MT0 = 4 * NP, NTW = R / 128, MTW = R / 128;
    LAS bf16_t* U = (LAS bf16_t*)(F.lds); LAS bf16_t* CM = U + R * 72; LAS bf16_t* ZT = CM + 64 * NP * 72;
    const int tid = F.tid, fr = F.lane & 15, fq = F.lane >> 4, w = F.wave;
    bf16x8 tcp[4], tsp[4];
    if constexpr (R == 128) {
#pragma unroll
        for (int k = 0; k < 4; ++k) { tcp[k] = *(const bf16x8*)(tab + (size_t)(w * 16 + fr) * R + k * 32 + fq * 8); tsp[k] = *(const bf16x8*)(tab + (size_t)R * R + (size_t)(w * 16 + fr) * R + k * 32 + fq * 8); } }
    { constexpr int NU = R * 8 / NTHREADS, NC = (64 * NP * 8 + NTHREADS - 1) / NTHREADS; u32x4 uv[NU], cv[NC];
#pragma unroll
      for (int i = 0; i < NU; ++i) { const int ch = tid + NTHREADS * i, a = ch >> 3, c8 = (ch & 7) * 8; uv[i] = *(const u32x4*)(pb + (size_t)(rowbase + a * rstride) * INP + C_FOUR + 64 * h + c8); }
#pragma unroll
      for (int i = 0; i < NC; ++i) { const int ch = tid + NTHREADS * i, m = ch >> 3, c8 = (ch & 7) * 8; cv[i] = (ch < 64 * NP * 8) ? *(const u32x4*)(cm3 + m * 64 + c8) : (u32x4){0u, 0u, 0u, 0u}; }
#pragma unroll
      for (int i = 0; i < NU; ++i) { const int ch = tid + NTHREADS * i, a = ch >> 3, c8 = (ch & 7) * 8; *(LAS u32x4*)(U + a * 72 + c8) = uv[i]; }
#pragma unroll
      for (int i = 0; i < NC; ++i) { const int ch = tid + NTHREADS * i, m = ch >> 3, c8 = (ch & 7) * 8; if (ch < 64 * NP * 8) *(LAS u32x4*)(CM + m * 72 + c8) = cv[i]; } }
    __syncthreads();
    {
        f32x4 acc[MT0][NTW]; zero_acc<MT0, NTW>(acc);
        mma_nt<MT0, NTW>(acc, CM, 72, U + (w * NTW * 16) * 72, 72, 64, fr, fq);
#pragma unroll
        for (int mt = 0; mt < MT0; ++mt)
#pragma unroll
            for (int nt = 0; nt < NTW; ++nt)
#pragma unroll
                for (int j = 0; j < 4; ++j) ZT[(mt * 16 + fq * 4 + j) * LZ + (w * NTW + nt) * 16 + fr] = (bf16_t)f2bf(acc[mt][nt][j]);
    }
    __syncthreads();
    {
        f32x4 are[MTW][4], aim[MTW][4]; zero_acc<MTW, 4>(are); zero_acc<MTW, 4>(aim);
        const int m0 = w * MTW * 16;
#pragma unroll
        for (int k0 = 0; k0 < R; k0 += 32) {
            bf16x8 tc[MTW], ts[MTW];
#pragma unroll
            for (int mi = 0; mi < MTW; ++mi) { if constexpr (R == 128) { tc[mi] = tcp[k0 / 32]; ts[mi] = tsp[k0 / 32]; } else { tc[mi] = *(const bf16x8*)(tab + (size_t)(m0 + mi * 16 + fr) * R + k0 + fq * 8); ts[mi] = *(const bf16x8*)(tab + (size_t)R * R + (size_t)(m0 + mi * 16 + fr) * R + k0 + fq * 8); } }
#pragma unroll
            for (int nt = 0; nt < 4; ++nt) {
                const bf16x8 zr = *(const LAS bf16x8*)(ZT + (nt * 16 + fr) * LZ + k0 + fq * 8), zi = *(const LAS bf16x8*)(ZT + (64 + nt * 16 + fr) * LZ + k0 + fq * 8);
#pragma unroll
                for (int mi = 0; mi < MTW; ++mi) { are[mi][nt] = __builtin_amdgcn_mfma_f32_16x16x32_bf16(tc[mi], zr, are[mi][nt], 0, 0, 0); are[mi][nt] = __builtin_amdgcn_mfma_f32_16x16x32_bf16(ts[mi], zi, are[mi][nt], 0, 0, 0); }
                if constexpr (NP == 3) { const bf16x8 nzr = *(const LAS bf16x8*)(ZT + (128 + nt * 16 + fr) * LZ + k0 + fq * 8);
#pragma unroll
                    for (int mi = 0; mi < MTW; ++mi) { aim[mi][nt] = __builtin_amdgcn_mfma_f32_16x16x32_bf16(tc[mi], zi, aim[mi][nt], 0, 0, 0); aim[mi][nt] = __builtin_amdgcn_mfma_f32_16x16x32_bf16(ts[mi], nzr, aim[mi][nt], 0, 0, 0); } }
            }
        }
#pragma unroll
        for (int mi = 0; mi < MTW; ++mi)
#pragma unroll
            for (int nt = 0; nt < 4; ++nt)
#pragma unroll
                for (int j = 0; j < 4; ++j) { const int m = m0 + mi * 16 + fq * 4 + j, k2 = nt * 16 + fr;
                    if constexpr (NP == 3) { unsigned* t2 = (unsigned*)(P.ws + WS_T2); t2[(size_t)(orow0 + 128 * m) * 256 + h * 64 + k2] = pk2(are[mi][nt][j], aim[mi][nt][j]); }
                    else { bf16_t* cat = (bf16_t*)(P.ws + WS_CAT); cat[(size_t)(orow0 + m) * D + h * 64 + k2] = (bf16_t)f2bf(are[mi][nt][j] * oscale); } }
    }
    __syncthreads();
}

constexpr int F2_X = 0, F2_T = 67584;
__device__ __forceinline__ void fourier_f2_tables(const Frame& F, const Params& P) {
    const bf16_t* tf2 = (const bf16_t*)(P.ws + WS_TF2); LAS bf16_t* T = (LAS bf16_t*)(F.lds + F2_T);
#pragma unroll
    for (int i = 0; i < 8; ++i) { const int ch = F.tid + 512 * i, r = ch >> 4, c8 = (ch & 15) * 8; *(LAS u32x4*)(T + r * 136 + c8) = *(const u32x4*)(tf2 + r * 128 + c8); }
    __syncthreads();
}
__device__ __forceinline__ void fourier_f2_unit(const Frame& F, const Params& P, int b, int d, int hp) {
    const bf16_t* t2 = (const bf16_t*)(P.ws + WS_T2);
    LAS bf16_t* X = (LAS bf16_t*)(F.lds + F2_X); const LAS bf16_t* T = (const LAS bf16_t*)(F.lds + F2_T);
    const int tid = F.tid, fr = F.lane & 15, fq = F.lane >> 4, w = F.wave;
    { u32x4 xv[8];
#pragma unroll
      for (int i = 0; i < 8; ++i) { const int ch = tid + 512 * i, n = ch >> 5, c8 = (ch & 31) * 8; xv[i] = *(const u32x4*)(t2 + (size_t)(b * SEQ + 128 * d + n) * 512 + hp * 256 + c8); }
#pragma unroll
      for (int i = 0; i < 8; ++i) { const int ch = tid + 512 * i, n = ch >> 5, c8 = (ch & 31) * 8; *(LAS u32x4*)(X + n * 264 + c8) = xv[i]; } }
    __syncthreads();
    f32x4 acc[8];
#pragma unroll
    for (int mt = 0; mt < 8; ++mt) acc[mt] = (f32x4){0.f, 0.f, 0.f, 0.f};
#pragma unroll
    for (int k0 = 0; k0 < 128; k0 += 32) {
        bf16x8 xr, xi;
#pragma unroll
        for (int jj = 0; jj < 8; ++jj) { const unsigned wd = *(const LAS unsigned*)(X + (k0 + fq * 8 + jj) * 264 + 2 * (w * 16 + fr)); xr[jj] = (short)(wd & 0xffffu); xi[jj] = (short)(wd >> 16); }
#pragma unroll
        for (int mt = 0; mt < 8; ++mt) { const bf16x8 tc = *(const LAS bf16x8*)(T + (mt * 16 + fr) * 136 + k0 + fq * 8), ts = *(const LAS bf16x8*)(T + (128 + mt * 16 + fr) * 136 + k0 + fq * 8);
            acc[mt] = __builtin_amdgcn_mfma_f32_16x16x32_bf16(tc, xr, acc[mt], 0, 0, 0); acc[mt] = __builtin_amdgcn_mfma_f32_16x16x32_bf16(ts, xi, acc[mt], 0, 0, 0); }
    }
    bf16_t* cat = (bf16_t*)(P.ws + WS_CAT);
#pragma unroll
    for (int mt = 0; mt < 8; ++mt)
#pragma unroll
        for (int j = 0; j < 4; ++j) { const int c = mt * 16 + fq * 4 + j; cat[(size_t)(b * SEQ + 128 * c + d) * D + hp * 128 + w * 16 + fr] = (bf16_t)f2bf(acc[mt][j] * (1.0f / 1024.0f)); }
    __syncthreads();
}

constexpr int AX_LCNT = AUX_OFF, AX_GBASE = AUX_OFF + 128, AX_LE = AUX_OFF + 256, AX_LP = AUX_OFF + 256 + 2560;
constexpr int LC_BAR = LCTL_OFF, LC_TS = LCTL_OFF + 64;

__device__ __forceinline__ void phase_route(const Frame& F, const Params& P, int l, int ntok) {
    unsigned char* ws = P.ws;
    LAS float* RWT = (LAS float*)(F.lds);
    volatile LAS int* lcnt = (volatile LAS int*)(F.lds + AX_LCNT); volatile LAS int* gbase = (volatile LAS int*)(F.lds + AX_GBASE);
    volatile LAS int* LE = (volatile LAS int*)(F.lds + AX_LE); volatile LAS int* LP = (volatile LAS int*)(F.lds + AX_LP);
    const int tid = F.tid, lane = F.lane;
    const int tpb = (ntok + F.G - 1) / F.G, tb = F.bid * tpb, te = (tb + tpb < ntok) ? tb + tpb : ntok;
    { const float* rw = P.in[19] + (size_t)l * D * NE;
#pragma unroll 1
      for (int i0 = 0; i0 < 64; i0 += 16) { float tv[16];
#pragma unroll
          for (int i = 0; i < 16; ++i) tv[i] = rw[tid + NTHREADS * (i0 + i)];
#pragma unroll
          for (int i = 0; i < 16; ++i) { const int idx = tid + NTHREADS * (i0 + i), k = idx >> 5, e = idx & 31; RWT[e * 1024 + k] = tv[i]; } } }
    if (tid < 32) lcnt[tid] = 0;
    __syncthreads();
    const float* xres = (const float*)(ws + WS_XRES); bf16_t* hb = (bf16_t*)(ws + WS_HBUF);
    const float* g2 = P.in[5] + (size_t)l * D; const float* rb = P.in[20] + (size_t)l * NE;
    float* aprob = (float*)(ws + WS_APROB);
    f32x4 xn[4];
    if (tb + F.wave < te) {
#pragma unroll
        for (int j = 0; j < 4; ++j) xn[j] = *(const f32x4*)(xres + (size_t)(tb + F.wave) * D + 4 * lane + 256 * j); }
    for (int tl = F.wave; tb + tl < te; tl += NWAVES) {
        const int m = tb + tl; const int v = (m >= NLAT) ? 2 : (m >= SEQ ? 1 : 0);
        const float* mf = (const float*)(ws + WS_MODF) + ((size_t)l * 3 + v) * 6144;
        f32x4 x[4]; float ss = 0.f;
#pragma unroll
        for (int j = 0; j < 4; ++j) { x[j] = xn[j]; ss += (x[j].x * x[j].x + x[j].y * x[j].y) + (x[j].z * x[j].z + x[j].w * x[j].w); }
        if (m + NWAVES < te) {
#pragma unroll
            for (int j = 0; j < 4; ++j) xn[j] = *(const f32x4*)(xres + (size_t)(m + NWAVES) * D + 4 * lane + 256 * j); }
        const float rstd = 1.0f / sqrtf(wave_sum(ss) * (1.0f / D) + NORM_EPS);
#pragma unroll
        for (int j = 0; j < 4; ++j) { const int c = 4 * lane + 256 * j; const f32x4 gv = *(const f32x4*)(g2 + c), sh = *(const f32x4*)(mf + 3 * 1024 + c), sc = *(const f32x4*)(mf + 4 * 1024 + c);
            x[j] = (x[j] * rstd) * gv * (sc + 1.0f) + sh; u32x2 o; o.x = pk2(x[j].x, x[j].y); o.y = pk2(x[j].z, x[j].w); *(u32x2*)(hb + (size_t)m * D + c) = o; }
        float pv[32];
#pragma unroll
        for (int e = 0; e < 32; ++e) { float s = 0.f;
#pragma unroll
            for (int j = 0; j < 4; ++j) { const f32x4 wv = *(const LAS f32x4*)(RWT + e * 1024 + 4 * lane + 256 * j); s += (x[j].x * wv.x + x[j].y * wv.y) + (x[j].z * wv.z + x[j].w * wv.w); }
            pv[e] = s; }
        { const bool hi = (lane & 32) != 0;
#pragma unroll
          for (int i = 0; i < 16; ++i) { const float a = pv[i], b = pv[i + 16]; const float send = hi ? a : b, keep = hi ? b : a; pv[i] = keep + __shfl_xor(send, 32); } }
        { const bool hi = (lane & 16) != 0;
#pragma unroll
          for (int i = 0; i < 8; ++i) { const float a = pv[i], b = pv[i + 8]; const float send = hi ? a : b, keep = hi ? b : a; pv[i] = keep + __shfl_xor(send, 16); } }
        { const bool hi = (lane & 8) != 0;
#pragma unroll
          for (int i = 0; i < 4; ++i) { const float a = pv[i], b = pv[i + 4]; const float send = hi ? a : b, keep = hi ? b : a; pv[i] = keep + __shfl_xor(send, 8); } }
        { const bool hi = (lane & 4) != 0;
#pragma unroll
          for (int i = 0; i < 2; ++i) { const float a = pv[i], b = pv[i + 2]; const float send = hi ? a : b, keep = hi ? b : a; pv[i] = keep + __shfl_xor(send, 4); } }
        { const bool hi = (lane & 2) != 0; const float a = pv[0], b = pv[1]; const float send = hi ? a : b, keep = hi ? b : a; pv[0] = keep + __shfl_xor(send, 2); }
        const float mine = pv[0] + __shfl_xor(pv[0], 1);
        float lg[32];
#pragma unroll
        for (int e = 0; e < 32; ++e) lg[e] = __shfl(mine, 2 * e) + rb[e];
        unsigned taken = 0u; int bidx[4]; float bval[4];
#pragma unroll
        for (int k = 0; k < 4; ++k) { float best = -INFINITY; int bi = 0;
#pragma unroll
            for (int e = 0; e < 32; ++e) { const bool c = (((taken >> e) & 1u) == 0u) && (lg[e] > best); best = c ? lg[e] : best; bi = c ? e : bi; }
            taken |= 1u << bi; bidx[k] = bi; bval[k] = best; }
        float ex[4], sum = 0.f;
#pragma unroll
        for (int k = 0; k < 4; ++k) { ex[k] = __expf(bval[k] - bval[0]); sum += ex[k]; }
        if (lane == 0) {
#pragma unroll
            for (int k = 0; k < 4; ++k) { const int lp = __hip_atomic_fetch_add((LAS int*)(F.lds + AX_LCNT) + bidx[k], 1, __ATOMIC_RELAXED, __HIP_MEMORY_SCOPE_WORKGROUP);
                LE[tl * 4 + k] = bidx[k]; LP[tl * 4 + k] = lp; aprob[(size_t)m * 4 + k] = ex[k] / sum; } }
    }
    __syncthreads();
    if (tid < 32) gbase[tid] = (int)__hip_atomic_fetch_add((unsigned*)(ws + WS_CTL) + CW_CNT + l * 64 + tid, (unsigned)lcnt[tid], __ATOMIC_RELAXED, __HIP_MEMORY_SCOPE_AGENT);
    __syncthreads();
    int* aexp = (int*)(ws + WS_AEXP); int* apos = (int*)(ws + WS_APOS);
    for (int i = tid; i < (te - tb) * 4; i += NTHREADS) { const int e = LE[i]; aexp[(size_t)tb * 4 + i] = e; apos[(size_t)tb * 4 + i] = gbase[e] + LP[i]; }
    __syncthreads();
}

__device__ __forceinline__ void phase_gather(const Frame& F, const Params& P, int l, int ntok) {
    unsigned char* ws = P.ws;
    volatile LAS int* TS = (volatile LAS int*)(F.lds + LC_TS);
    if (F.tid < 64) { const int e = F.lane & 31;
        const unsigned c = __hip_atomic_load((unsigned*)(ws + WS_CTL) + CW_CNT + l * 64 + e, __ATOMIC_RELAXED, __HIP_MEMORY_SCOPE_AGENT);
        int incl = (int)((c + 255u) >> 8);
#pragma unroll
        for (int o = 1; o < 32; o <<= 1) { const int v = __shfl_up(incl, o); if (e >= o) incl += v; }
        if (F.lane < 32) TS[e + 1] = incl;
        if (F.lane == 0) TS[0] = 0; }
    __syncthreads();
    const int gw = F.bid * NWAVES + F.wave, NGW = F.G * NWAVES;
    const int* aexp = (const int*)(ws + WS_AEXP); const int* apos = (const int*)(ws + WS_APOS); int* aslot = (int*)(ws + WS_ASLOT);
    const bf16_t* hb = (const bf16_t*)(ws + WS_HBUF); bf16_t* xb = (bf16_t*)(ws + WS_XB);
    for (int cidx = gw; cidx < ntok / 16; cidx += NGW) {
        const int a0 = cidx * 64; const int e = aexp[a0 + F.lane]; const int rowl = TS[e] * 256 + apos[a0 + F.lane];
        aslot[a0 + F.lane] = rowl;
#pragma unroll 1
        for (int t4 = 0; t4 < 16; t4 += 4) {
            u32x4 v0[4], v1[4];
#pragma unroll
            for (int q = 0; q < 4; ++q) { const u32x4* src = (const u32x4*)(hb + (size_t)(a0 / 4 + t4 + q) * D); v0[q] = src[F.lane]; v1[q] = src[F.lane + 64]; }
#pragma unroll
            for (int q = 0; q < 4; ++q)
#pragma unroll
                for (int k = 0; k < 4; ++k) { const int row = __shfl(rowl, (t4 + q) * 4 + k); u32x4* dst = (u32x4*)(xb + (size_t)row * D); dst[F.lane] = v0[q]; dst[F.lane + 64] = v1[q]; }
        }
    }
}

__device__ __forceinline__ void phase_combine(const Frame& F, const Params& P, int l, int ntok, bool last) {
    unsigned char* ws = P.ws;
    const int gw = F.bid * NWAVES + F.wave, NGW = F.G * NWAVES, lane = F.lane;
    float* xres = (float*)(ws + WS_XRES); const bf16_t* yb = (const bf16_t*)(ws + WS_YB);
    const int* aslot = (const int*)(ws + WS_ASLOT); const float* aprob = (const float*)(ws + WS_APROB);
    int sl_n[4]; float pr_n[4];
    if (gw < ntok) {
#pragma unroll
        for (int k = 0; k < 4; ++k) { sl_n[k] = aslot[(size_t)gw * 4 + k]; pr_n[k] = aprob[(size_t)gw * 4 + k]; } }
    for (int m = gw; m < ntok; m += NGW) {
        const int v = (m >= NLAT) ? 2 : (m >= SEQ ? 1 : 0);
        const float* mf = (const float*)(ws + WS_MODF) + ((size_t)l * 3 + v) * 6144;
        int sl[4]; float pr[4];
#pragma unroll
        for (int k = 0; k < 4; ++k) { sl[k] = sl_n[k]; pr[k] = pr_n[k]; }
        u32x2 wv[4][4]; f32x4 xo[4], g5[4];
#pragma unroll
        for (int k = 0; k < 4; ++k)
#pragma unroll
            for (int j = 0; j < 4; ++j) wv[k][j] = *(const u32x2*)(yb + (size_t)sl[k] * D + 4 * lane + 256 * j);
#pragma unroll
        for (int j = 0; j < 4; ++j) { const int c = 4 * lane + 256 * j; xo[j] = *(const f32x4*)(xres + (size_t)m * D + c); g5[j] = *(const f32x4*)(mf + 5 * 1024 + c); }
        if (m + NGW < ntok) {
#pragma unroll
            for (int k = 0; k < 4; ++k) { sl_n[k] = aslot[(size_t)(m + NGW) * 4 + k]; pr_n[k] = aprob[(size_t)(m + NGW) * 4 + k]; } }
        f32x4 y[4];
#pragma unroll
        for (int j = 0; j < 4; ++j) y[j] = (f32x4){0.f, 0.f, 0.f, 0.f};
#pragma unroll
        for (int k = 0; k < 4; ++k)
#pragma unroll
            for (int j = 0; j < 4; ++j) y[j] += (f32x4){bflo(wv[k][j].x), bfhi(wv[k][j].x), bflo(wv[k][j].y), bfhi(wv[k][j].y)} * pr[k];
        f32x4 x[4];
#pragma unroll
        for (int j = 0; j < 4; ++j) x[j] = xo[j] + g5[j] * y[j];
        if (!last) {
#pragma unroll
            for (int j = 0; j < 4; ++j) *(f32x4*)(xres + (size_t)m * D + 4 * lane + 256 * j) = x[j];
            const float* mn = (const float*)(ws + WS_MODF) + ((size_t)(l + 1) * 3 + v) * 6144;
            norm_row_store(x, P.in[4] + (size_t)(l + 1) * D, mn, mn + 1024, (bf16_t*)(ws + WS_HBUF) + (size_t)m * D, lane, false, P, 0, 0);
        } else {
            float ss = 0.f;
#pragma unroll
            for (int j = 0; j < 4; ++j) ss += (x[j].x * x[j].x + x[j].y * x[j].y) + (x[j].z * x[j].z + x[j].w * x[j].w);
            const float rstd = 1.0f / sqrtf(wave_sum(ss) * (1.0f / D) + NORM_EPS);
#pragma unroll
            for (int j = 0; j < 4; ++j) { const int c = 4 * lane + 256 * j; *(f32x4*)(P.out + (size_t)m * D + c) = (x[j] * rstd) * *(const f32x4*)(P.in[25] + c); }
        }
    }
}

__global__ void __launch_bounds__(NTHREADS, 2) mega_fwd(Params P0) {
    extern __shared__ __attribute__((aligned(16))) unsigned char lds_raw[];
    Frame F0; F0.lds = (LAS unsigned char*)lds_raw; F0.tid = threadIdx.x; F0.lane = F0.tid & 63; F0.wave = __builtin_amdgcn_readfirstlane(F0.tid >> 6); F0.G = gridDim.x; F0.bid = blockIdx.x;
#define KAS __attribute__((address_space(4)))
    struct ParamsK { const GAS float* in[26]; GAS float* out; GAS unsigned char* ws; };
#define PHASE_ENV() Frame F = F0; asm volatile("" : "+v"(F.tid)); F.lane = F.tid & 63; F.wave = __builtin_amdgcn_readfirstlane(F.tid >> 6); asm volatile("" : "+s"(F.bid), "+s"(F.G)); \
    const KAS ParamsK* kp_ = (const KAS ParamsK*)__builtin_amdgcn_kernarg_segment_ptr(); asm volatile("" : "+s"(kp_)); Params P; \
    _Pragma("unroll") for (int i_ = 0; i_ < 26; ++i_) P.in[i_] = (const float*)kp_->in[i_]; \
    P.out = (float*)kp_->out; P.ws = (unsigned char*)kp_->ws; unsigned char* ws = P.ws; (void)ws;
    { PHASE_ENV();
    for (int u = F.tid; u < (LDS_BYTES - LCTL_OFF) / 4; u += NTHREADS) ((LAS unsigned*)(F.lds + LCTL_OFF))[u] = 0u;
    __syncthreads();
    }
    { PHASE_ENV(); (void)xcd_barrier_post((unsigned*)(ws + WS_CTL) + CW_BAR, (volatile LAS unsigned*)(F.lds + LC_BAR)); }
#define GRID_BAR() do { PHASE_ENV(); XcdBarrier b_; b_.bar = (unsigned*)(ws + WS_CTL) + CW_BAR; b_.x = xb_xcc_id(); b_.st = (volatile LAS unsigned*)(F.lds + LC_BAR); xcd_barrier(b_); } while (0)

    { PHASE_ENV(); phase_prologue(F, P); }
    GRID_BAR();
    { PHASE_ENV(); phase_p1(F, P); }
    GRID_BAR();

    for (int l = 0; l < DEPTH; ++l) {
        const bool last = (l == DEPTH - 1);
        { PHASE_ENV(); pg8::Gemm g{(const bf16_t*)(ws + WS_HBUF), (const bf16_t*)(ws + WS_WIN) + (size_t)l * INP * D, NTOK, INP, D};
          pg8::StaticOrder S; S.init(NTOK, INP, F.G, F.bid);
          pg8::EpiStoreBf16 E{(bf16_t*)(ws + WS_PBUF), INP};
          pg8::gemm_phase<pg8::EpiStoreBf16, pg8::StaticOrder>(F.lds, g, S, E, F.tid); }
        GRID_BAR();
        { PHASE_ENV();
        for (int u = F.bid; u < 2080; u += F.G) { int row0, h;
            if (u < 2048) { const int bh = u >> 8, n = u & 255; h = bh & 3; row0 = (bh >> 2) * SEQ + 64 * n; }
            else { const int q = u - 2048, bh = q >> 2, n = q & 3; h = bh & 3; row0 = NLAT + (bh >> 2) * CTXL + 64 * n; }
            gla_g1_unit(F, P, l, row0, h, u); } }
        { PHASE_ENV();
        for (int u = F.bid; u < 1024; u += F.G) { const int b = u >> 9, nlo = (u >> 2) & 127, h = u & 3;
            fourier_f1_unit<128, 3>(F, P, b * SEQ + nlo, 128, h, (const bf16_t*)(ws + WS_TLAT) + (size_t)nlo * 32768, b * SEQ + nlo, 1.0f); }
        }
        { PHASE_ENV();
        if (!last) for (int u = F.bid; u < 8; u += F.G) { const int b = u >> 2, h = u & 3;
            fourier_f1_unit<256, 2>(F, P, NLAT + b * CTXL, 1, h, (const bf16_t*)(ws + WS_TCTX), NLAT + b * CTXL, 1.0f / 128.0f); }
        }
        { PHASE_ENV();
        for (int u = F.bid; u < (last ? 512 : 520); u += F.G) {
            if (u < 512) conv_unit(F, P, l, 64 * u, 64, 0);
            else { const int q = u - 512; conv_unit(F, P, l, NLAT + (q >> 2) * CTXL, CTXL, 64 * (q & 3)); } } }
        GRID_BAR();
        { PHASE_ENV(); gla_scan(F, P); }
        { PHASE_ENV();
        fourier_f2_tables(F, P);
        for (int u = F.bid; u < 512; u += F.G) fourier_f2_unit(F, P, u >> 8, (u >> 1) & 127, u & 1); }
        GRID_BAR();
        { PHASE_ENV();
        for (int u = F.bid; u < (last ? 2048 : 2080); u += F.G) { int row0, h;
            if (u < 2048) { const int bh = u >> 8, n = u & 255; h = bh & 3; row0 = (bh >> 2) * SEQ + 64 * n; }
            else { const int q = u - 2048, bh = q >> 2, n = q & 3; h = bh & 3; row0 = NLAT + (bh >> 2) * CTXL + 64 * n; }
            gla_g3_unit(F, P, l, row0, h, u); } }
        GRID_BAR();
        { PHASE_ENV(); const int M2 = last ? NLAT : NTOK;
          pg8::Gemm g{(const bf16_t*)(ws + WS_CAT), (const bf16_t*)(ws + WS_WOUT) + (size_t)l * D * D, M2, D, D};
          pg8::StaticOrder S; S.init(M2, D, F.G, F.bid);
          pg8::EpiResid E{(float*)(ws + WS_XRES), (const float*)(ws + WS_MODF) + (size_t)l * 3 * 6144};
          pg8::gemm_phase<pg8::EpiResid, pg8::StaticOrder>(F.lds, g, S, E, F.tid); }
        GRID_BAR();
        const int ntok = last ? NLAT : NTOK;
        { PHASE_ENV(); phase_route(F, P, l, ntok); }
        GRID_BAR();
        { PHASE_ENV(); phase_gather(F, P, l, ntok); }
        GRID_BAR();
        { PHASE_ENV(); const volatile LAS int* TS = (const volatile LAS int*)(F.lds + LC_TS);
          pg8::Gemm g{(const bf16_t*)(ws + WS_XB), (const bf16_t*)(ws + WS_WGU) + (size_t)l * NE * 2048 * D, 0, 2048, D};
          pg8::MoeOrder S{8, F.G, F.bid, TS[NE], TS};
          pg8::EpiGateUp E{(bf16_t*)(ws + WS_ACT), P.in[22] + (size_t)l * NE * 2048};
          pg8::gemm_phase<pg8::EpiGateUp, pg8::MoeOrder>(F.lds, g, S, E, F.tid); }
        GRID_BAR();
        { PHASE_ENV(); const volatile LAS int* TS = (const volatile LAS int*)(F.lds + LC_TS);
          pg8::Gemm g{(const bf16_t*)(ws + WS_ACT), (const bf16_t*)(ws + WS_WDN) + (size_t)l * NE * D * DFF, 0, D, DFF};
          pg8::MoeOrder S{4, F.G, F.bid, TS[NE], TS};
          pg8::EpiDown E{(bf16_t*)(ws + WS_YB), P.in[24] + (size_t)l * NE * D};
          pg8::gemm_phase<pg8::EpiDown, pg8::MoeOrder>(F.lds, g, S, E, F.tid); }
        GRID_BAR();
        { PHASE_ENV(); phase_combine(F, P, l, ntok, last); }
        if (!last) GRID_BAR();
    }
}

extern "C" void kernel_launch(void* const* d_in, const int* in_sizes, int n_in, void* d_out, int out_size, void* d_ws, size_t ws_size, hipStream_t stream) {
    static int grid = 0;
    if (grid == 0) {
        if (n_in != 26 || ws_size < WS_END) { fprintf(stderr, "kernel_launch: unexpected n_in %d or ws_size %zu (need %zu)\n", n_in, ws_size, (size_t)WS_END); grid = -1; return; }
        int dev = 0, cus = 0, per_cu = 0;
        if (hipGetDevice(&dev) != hipSuccess || hipDeviceGetAttribute(&cus, hipDeviceAttributeMultiprocessorCount, dev) != hipSuccess) { grid = -1; return; }
        if (hipFuncSetAttribute((const void*)mega_fwd, hipFuncAttributeMaxDynamicSharedMemorySize, LDS_BYTES) != hipSuccess) { fprintf(stderr, "kernel_launch: hipFuncSetAttribute failed\n"); grid = -1; return; }
        if (hipOccupancyMaxActiveBlocksPerMultiprocessor(&per_cu, (const void*)mega_fwd, NTHREADS, LDS_BYTES) != hipSuccess || per_cu < 1) { fprintf(stderr, "kernel_launch: occupancy query says %d\n", per_cu); }
        (void)hipGetLastError();
        grid = cus;
    }
    if (grid < 0) return;
    (void)hipMemsetAsync((char*)d_ws + WS_CTL, 0, CTL_ZERO_BYTES, stream);
    Params p{};
    for (int i = 0; i < 26; ++i) p.in[i] = (const float*)d_in[i];
    p.out = (float*)d_out; p.ws = (unsigned char*)d_ws;
    hipLaunchKernelGGL(mega_fwd, dim3(grid), dim3(NTHREADS), LDS_BYTES, stream, p);
}
```

```cpp
#include <hip/hip_runtime.h>
#include <cstdio>
#include <cstdint>

#define LAS __attribute__((address_space(3)))
#define GAS __attribute__((address_space(1)))
typedef unsigned short bf16_t;
typedef short bf16x8 __attribute__((ext_vector_type(8)));
typedef float f32x4 __attribute__((ext_vector_type(4)));
typedef float f32x2 __attribute__((ext_vector_type(2)));
typedef unsigned u32x4 __attribute__((ext_vector_type(4)));
typedef unsigned u32x2 __attribute__((ext_vector_type(2)));

constexpr int D = 1024, NBATCH = 2, SEQ = 16384, NLAT = NBATCH * SEQ, CTXL = 256, NCTX = NBATCH * CTXL, NTOK = NLAT + NCTX, DEPTH = 2;
constexpr int INW = 2336, INP = 2560;
constexpr int C_FOUR = 0, C_Q = 256, C_K = 512, C_V = 768, C_R = 1280, C_GF = 1792, C_GB = 1808, C_CA = 1824, C_CG = 2080;
constexpr int NE = 32, TOPK = 4, DFF = 1024;
constexpr int MAXROWS = NTOK * TOPK + NE * 256;
constexpr float NORM_EPS = 1e-6f;
constexpr int NTHREADS = 512, NWAVES = 8;

constexpr size_t MiB = 1u << 20;
constexpr size_t WS_CTL = 0, CTL_ZERO_BYTES = 1 * MiB;
constexpr size_t WS_MODP = 1 * MiB;
constexpr size_t WS_MODF = 3 * MiB;
constexpr size_t WS_CM3 = 4 * MiB;
constexpr size_t WS_TF2 = 4 * MiB + 65536;
constexpr size_t WS_TCTX = 4 * MiB + 262144;
constexpr size_t WS_TLAT = 5 * MiB;
constexpr size_t WS_WIN = 13 * MiB;
constexpr size_t WS_WOUT = 23 * MiB;
constexpr size_t WS_WGU = 27 * MiB;
constexpr size_t WS_WDN = 283 * MiB;
constexpr size_t WS_XRES = 411 * MiB;
constexpr size_t WS_HBUF = 541 * MiB;
constexpr size_t WS_PBUF = 606 * MiB;
constexpr size_t WS_CAT = 769 * MiB;
constexpr size_t WS_T2 = 834 * MiB;
constexpr size_t WS_STATE = 866 * MiB;
constexpr size_t WS_DECAY = 996 * MiB;
constexpr size_t WS_AEXP = 998 * MiB, WS_APOS = 999 * MiB, WS_APROB = 1000 * MiB, WS_ASLOT = 1001 * MiB;
constexpr size_t WS_XB = 1002 * MiB, WS_ACT = 1278 * MiB, WS_YB = 1554 * MiB, WS_END = 1830 * MiB;
constexpr int CW_BAR = 4096, CW_CNT = 16384;

constexpr int RING_BYTES = 131072;
constexpr int AUX_OFF = RING_BYTES;
constexpr int LCTL_OFF = RING_BYTES + 8192;
constexpr int LDS_BYTES = 147456;

__device__ __forceinline__ unsigned f2bf(float f) { unsigned u = __builtin_bit_cast(unsigned, f); return (u + 0x7fffu + ((u >> 16) & 1u)) >> 16; }
__device__ __forceinline__ unsigned pk2(float lo, float hi) { return f2bf(lo) | (f2bf(hi) << 16); }
__device__ __forceinline__ float bf2f(unsigned b) { return __builtin_bit_cast(float, b << 16); }
__device__ __forceinline__ float bflo(unsigned w) { return __builtin_bit_cast(float, w << 16); }
__device__ __forceinline__ float bfhi(unsigned w) { return __builtin_bit_cast(float, w & 0xffff0000u); }
__device__ __forceinline__ float wave_sum(float v) {
#pragma unroll
    for (int o = 1; o < 64; o <<= 1) v += __shfl_xor(v, o);
    return v;
}
__device__ __forceinline__ float sigmoidf_(float x) { return __builtin_amdgcn_rcpf(1.0f + __expf(-x)); }

#define XB_TMO      128
#define XB_XCNT(j)  (256  + 64 * (j))
#define XB_XSUB(j)  (1280 + 64 * (j))
#define XB_XGEN(j)  (2304 + 64 * (j))
#define XB_TOP      3328
#define XB_TOPGEN   3392
#define XCD_BAR_WORDS 3456
#define XB_SPIN_CAP (1u << 22)

__device__ __forceinline__ unsigned xb_ld(unsigned* p)              { return __hip_atomic_load(p, __ATOMIC_RELAXED, __HIP_MEMORY_SCOPE_AGENT); }
__device__ __forceinline__ unsigned xb_add(unsigned* p, unsigned v) { return __hip_atomic_fetch_add(p, v, __ATOMIC_RELAXED, __HIP_MEMORY_SCOPE_AGENT); }
__device__ __forceinline__ unsigned xb_xcc_id() { return (unsigned)__builtin_amdgcn_s_getreg((3 << 11) | 20) & 0xFu; }
#define XB_SPIN(cond, bar) do { unsigned _sp = 0; while (cond) { __builtin_amdgcn_s_sleep(1); \
    if ((++_sp & 255u) == 0u) { if (xb_ld(&(bar)[XB_TMO])) break; if (_sp > XB_SPIN_CAP) { atomicAdd(&(bar)[XB_TMO], 1u); break; } } } } while (0)

struct XcdBarrier { unsigned* bar; unsigned x; volatile LAS unsigned* st; };

__device__ __forceinline__ XcdBarrier xcd_barrier_post(unsigned* bar, volatile LAS unsigned* st) {
    XcdBarrier b; b.bar = bar; b.x = xb_xcc_id(); b.st = st;
    if (threadIdx.x == 0) (void)xb_add(&bar[XB_XCNT(b.x)], 1u);
    return b;
}
__device__ __forceinline__ void xcd_barrier_complete(unsigned* bar, unsigned x, unsigned& nloc, unsigned& nx) {
    const unsigned G = gridDim.x * gridDim.y * gridDim.z;
    unsigned sum, cnt, mine, sp = 0u;
    for (;;) {
        sum = 0u; cnt = 0u; mine = 0u;
#pragma unroll
        for (unsigned j = 0; j < 16; ++j) { const unsigned c = xb_ld(&bar[XB_XCNT(j)]); sum += c; cnt += (c > 0u) ? 1u : 0u; mine = (j == x) ? c : mine; }
        if (sum == G) break;
        __builtin_amdgcn_s_sleep(1);
        if ((++sp & 255u) == 0u) { if (xb_ld(&bar[XB_TMO])) break; if (sp > XB_SPIN_CAP) { atomicAdd(&bar[XB_TMO], 1u); break; } }
    }
    nloc = mine > 0u ? mine : 1u; nx = cnt > 0u ? cnt : 1u;
}
__device__ __forceinline__ void xcd_barrier(const XcdBarrier& b) {
    asm volatile("s_waitcnt vmcnt(0)" ::: "memory");
    __syncthreads();
    if (threadIdx.x == 0) {
        unsigned* bar = b.bar;
        __builtin_amdgcn_s_waitcnt(0);
        unsigned nloc = b.st[0], nx = b.st[1];
        if (nloc == 0u) { xcd_barrier_complete(bar, b.x, nloc, nx); b.st[0] = nloc; b.st[1] = nx; }
        const unsigned old = xb_add(&bar[XB_XSUB(b.x)], 1u);
        const unsigned gen = old / nloc;
        if (old + 1u == (gen + 1u) * nloc) {
            __builtin_amdgcn_fence(__ATOMIC_RELEASE, "agent");
            asm volatile("s_waitcnt vmcnt(0)" ::: "memory");
            const unsigned og = xb_add(&bar[XB_TOP], 1u);
            const unsigned tg = og / nx;
            if (og + 1u == (tg + 1u) * nx) xb_add(&bar[XB_TOPGEN], 1u);
            else XB_SPIN(xb_ld(&bar[XB_TOPGEN]) == tg, bar);
            __builtin_amdgcn_fence(__ATOMIC_ACQUIRE, "agent");
            xb_add(&bar[XB_XGEN(b.x)], 1u);
            asm volatile("s_waitcnt vmcnt(0)" ::: "memory");
        } else {
            XB_SPIN(xb_ld(&bar[XB_XGEN(b.x)]) == gen, bar);
            __builtin_amdgcn_fence(__ATOMIC_ACQUIRE, "agent");
            asm volatile("s_waitcnt vmcnt(0)" ::: "memory");
        }
    }
    __syncthreads();
}

namespace pg8 {
constexpr int BM = 256, BK = 64, HALF = 128, HTB = HALF * BK * 2, STAGE_BYTES = 8 * HTB, NXCD = 8, WGM = 8;
__host__ __device__ __forceinline__ int lds_byte(int r, int c) { const int st = (r >> 4) * 2 + (c >> 5), rr = r & 15, cc = c & 31, ob = rr * 64 + cc * 2; return st * 1024 + (ob ^ (((ob >> 9) & 1) << 5)); }
__host__ __device__ __forceinline__ void stage_rc(int b, int& R, int& C) { const int st = b / 1024, sb = b % 1024, swz = sb ^ (((sb >> 9) & 1) << 5); R = (st >> 1) * 16 + swz / 64; C = (st & 1) * 32 + (swz % 64) / 2; }
__host__ __device__ __forceinline__ int perm32(int rho) { const int n = rho >> 4, i = rho & 15; return 8 * (i >> 2) + 4 * n + (i & 3); }

struct Unit { int pm, pn; };
struct Gemm { const bf16_t* A; const bf16_t* Bt; int M, N, K; };

struct StaticOrder {
    int nM, nN, nwg, G, c;
    __device__ void init(int M, int N, int G_, int c_) { nM = M / BM; nN = N / BM; nwg = nM * nN; G = G_; c = c_; }
    __device__ bool next(int i, Unit& u) const {
        const long L = (long)i * G + c; if (L >= nwg) return false;
        int wgid = (int)L; { const int q = nwg / NXCD, r = nwg % NXCD, xcd = wgid % NXCD, off = wgid / NXCD; wgid = (xcd < r ? xcd * (q + 1) : r * (q + 1) + (xcd - r) * q) + off; }
        const int nig = WGM * nN, gid = wgid / nig, fm = gid * WGM, gsz = (nM - fm) < WGM ? (nM - fm) : WGM;
        u.pm = fm + ((wgid % nig) % gsz); u.pn = (wgid % nig) / gsz; return true;
    }
};
struct MoeOrder {
    int nN, G, c, MT; const volatile LAS int* ts;
    __device__ bool next(int i, Unit& u) const {
        const long L = (G % 8 == 0) ? ((long)i * G + (long)(c & 7) * (G >> 3) + (c >> 3)) : ((long)i * G + c);
        if (L >= (long)MT * nN) return false;
        const int mt = (int)(L / nN), pl = (int)(L % nN);
        const int lane = threadIdx.x & 63;
        const unsigned long long bal = __ballot(lane >= 1 && lane < NE && ts[lane] <= mt);
        const int e = __popcll(bal);
        u.pm = mt; u.pn = e * nN + pl; return true;
    }
};

__device__ __forceinline__ unsigned cvt_pk_bf16(float lo, float hi) { unsigned r; asm volatile("v_cvt_pk_bf16_f32 %0, %1, %2" : "=v"(r) : "v"(lo), "v"(hi)); return r; }

struct EpiStoreBf16 {
    static constexpr bool PERM = true;
    bf16_t* O; int ldc;
    __device__ __forceinline__ void operator()(const f32x4 (&acc)[2][2][4][2], const Unit& u, int wr, int wc, int fr, int fq) const {
        const int row0 = u.pm * BM + wr * 64 + fr; const int col0 = u.pn * BM + wc * 32 + 8 * fq;
#pragma unroll
        for (int ai = 0; ai < 2; ++ai)
#pragma unroll
            for (int m = 0; m < 4; ++m) { bf16_t* rowp = O + (size_t)(row0 + ai * HALF + m * 16) * ldc + col0;
#pragma unroll
                for (int bj = 0; bj < 2; ++bj) { const f32x4 v0 = acc[ai][bj][m][0], v1 = acc[ai][bj][m][1];
                    u32x4 w; w.x = cvt_pk_bf16(v0[0], v0[1]); w.y = cvt_pk_bf16(v0[2], v0[3]); w.z = cvt_pk_bf16(v1[0], v1[1]); w.w = cvt_pk_bf16(v1[2], v1[3]);
                    *(u32x4*)(rowp + bj * HALF) = w; } }
    }
};
struct EpiResid {
    static constexpr bool PERM = false;
    float* X; const float* modf;
    __device__ __forceinline__ void operator()(const f32x4 (&acc)[2][2][4][2], const Unit& u, int wr, int wc, int fr, int fq) const {
        const int row0 = u.pm * BM + wr * 64 + fr, col0 = u.pn * BM + wc * 32 + 4 * fq;
        const int v = (u.pm >= NLAT / BM) ? 2 : (u.pm >= SEQ / BM ? 1 : 0);
        const float* gv = modf + (size_t)v * 6144 + 2 * 1024;
        f32x4 bv[2][2];
#pragma unroll
        for (int bj = 0; bj < 2; ++bj)
#pragma unroll
            for (int n = 0; n < 2; ++n) bv[bj][n] = *(const f32x4*)(gv + col0 + bj * HALF + n * 16);
#pragma unroll
        for (int ai = 0; ai < 2; ++ai) {
            f32x4 xv[4][2][2];
#pragma unroll
            for (int m = 0; m < 4; ++m) { const float* rowp = X + (size_t)(row0 + ai * HALF + m * 16) * D + col0;
#pragma unroll
                for (int bj = 0; bj < 2; ++bj)
#pragma unroll
                    for (int n = 0; n < 2; ++n) xv[m][bj][n] = *(const f32x4*)(rowp + bj * HALF + n * 16); }
#pragma unroll
            for (int m = 0; m < 4; ++m) { float* rowp = X + (size_t)(row0 + ai * HALF + m * 16) * D + col0;
#pragma unroll
                for (int bj = 0; bj < 2; ++bj)
#pragma unroll
                    for (int n = 0; n < 2; ++n) *(f32x4*)(rowp + bj * HALF + n * 16) = xv[m][bj][n] + bv[bj][n] * acc[ai][bj][m][n]; }
        }
    }
};
struct EpiGateUp {
    static constexpr bool PERM = true;
    bf16_t* O; const float* bgu;
    __device__ __forceinline__ void operator()(const f32x4 (&acc)[2][2][4][2], const Unit& u, int wr, int wc, int fr, int fq) const {
        const int e = u.pn >> 3, pl = u.pn & 7;
        const int row0 = u.pm * BM + wr * 64 + fr; const int cl = pl * 128 + wc * 32 + 8 * fq;
        const float* bg = bgu + (size_t)e * 2048 + cl; const float* bu = bg + 1024;
        f32x4 g0 = *(const f32x4*)bg, g1 = *(const f32x4*)(bg + 4), u0 = *(const f32x4*)bu, u1 = *(const f32x4*)(bu + 4);
#pragma unroll
        for (int ai = 0; ai < 2; ++ai)
#pragma unroll
            for (int m = 0; m < 4; ++m) { bf16_t* rowp = O + (size_t)(row0 + ai * HALF + m * 16) * DFF + cl;
                float r[8];
#pragma unroll
                for (int n = 0; n < 2; ++n) { const f32x4 gb = n ? g1 : g0, ub = n ? u1 : u0; const f32x4 ga = acc[ai][0][m][n] + gb, ua = acc[ai][1][m][n] + ub;
#pragma unroll
                    for (int j = 0; j < 4; ++j) { const float gate = fminf(ga[j], 7.0f), up = fminf(fmaxf(ua[j], -7.0f), 7.0f);
                        r[n * 4 + j] = gate * __builtin_amdgcn_rcpf(1.0f + __expf(-1.702f * gate)) * (up + 1.0f); } }
                u32x4 w; w.x = cvt_pk_bf16(r[0], r[1]); w.y = cvt_pk_bf16(r[2], r[3]); w.z = cvt_pk_bf16(r[4], r[5]); w.w = cvt_pk_bf16(r[6], r[7]);
                *(u32x4*)rowp = w; }
    }
};
struct EpiDown {
    static constexpr bool PERM = true;
    bf16_t* O; const float* bdn;
    __device__ __forceinline__ void operator()(const f32x4 (&acc)[2][2][4][2], const Unit& u, int wr, int wc, int fr, int fq) const {
        const int e = u.pn >> 2, pl = u.pn & 3;
        const int row0 = u.pm * BM + wr * 64 + fr; const int col0 = pl * BM + wc * 32 + 8 * fq;
        f32x4 bv[2][2];
#pragma unroll
        for (int bj = 0; bj < 2; ++bj)
#pragma unroll
            for (int n = 0; n < 2; ++n) bv[bj][n] = *(const f32x4*)(bdn + (size_t)e * 1024 + col0 + bj * HALF + 4 * n);
#pragma unroll
        for (int ai = 0; ai < 2; ++ai)
#pragma unroll
            for (int m = 0; m < 4; ++m) { bf16_t* rowp = O + (size_t)(row0 + ai * HALF + m * 16) * D + col0;
#pragma unroll
                for (int bj = 0; bj < 2; ++bj) { const f32x4 v0 = acc[ai][bj][m][0] + bv[bj][0], v1 = acc[ai][bj][m][1] + bv[bj][1];
                    u32x4 w; w.x = cvt_pk_bf16(v0[0], v0[1]); w.y = cvt_pk_bf16(v0[2], v0[3]); w.z = cvt_pk_bf16(v1[0], v1[1]); w.w = cvt_pk_bf16(v1[2], v1[3]);
                    *(u32x4*)(rowp + bj * HALF) = w; } }
    }
};

template <class Epi, class Sched, bool ALIGN_EPI = true, bool SP2 = true>
__device__ __forceinline__ void gemm_phase(LAS unsigned char* lds, const Gemm g, const Sched& S, const Epi& E, const int tid) {
    const int wid = __builtin_amdgcn_readfirstlane(tid >> 6), lane = tid & 63, wr = wid >> 2, wc = wid & 3, fr = lane & 15, fq = lane >> 4;
    const int K = g.K, nt = K / BK;
    unsigned voffA[2], voffB[2];
#pragma unroll
    for (int i = 0; i < 2; ++i) { int R, C; stage_rc(tid * 16 + i * 8192, R, C); const int Rb = Epi::PERM ? ((R & ~31) + perm32(R & 31)) : R;
        voffA[i] = (unsigned)(R * K + C) * 2u; voffB[i] = (unsigned)(Rb * K + C) * 2u; }
    const size_t kstep = (size_t)(BK * 2);
    const size_t hstep = (size_t)HALF * K * 2;
    const size_t tstep = 2 * hstep;
    const unsigned ldsw = (unsigned)wid * 1024u;
    const int aoff = lds_byte(wr * 64 + fr, fq * 8), boff = lds_byte(wc * 32 + fr, fq * 8);
#define PG8_SA(b, h) (((b) * 2 + (h)) * HTB)
#define PG8_SB(b, h) ((4 + (b) * 2 + (h)) * HTB)
#define PG8_STAGE(bufoff, gbase, voff) do { _Pragma("unroll") for (int _i = 0; _i < 2; ++_i) \
        __builtin_amdgcn_global_load_lds((const unsigned*)((const char*)(gbase) + (voff)[_i]), (LAS unsigned*)(lds + (bufoff) + ldsw + _i * 8192), 16, 0, 0); } while (0)
#define PG8_LDA(dst, b, h) do { _Pragma("unroll") for (int m = 0; m < 4; ++m) _Pragma("unroll") for (int k = 0; k < 2; ++k) dst[m][k] = *(const LAS bf16x8*)(lds + PG8_SA(b, h) + aoff + m * 2048 + k * 1024); } while (0)
#define PG8_LDB(dst, b, h) do { _Pragma("unroll") for (int n = 0; n < 2; ++n) _Pragma("unroll") for (int k = 0; k < 2; ++k) dst[n][k] = *(const LAS bf16x8*)(lds + PG8_SB(b, h) + boff + n * 2048 + k * 1024); } while (0)
#define PG8_MMA(ai, bj, At, Bt) do { __builtin_amdgcn_s_setprio(1); _Pragma("unroll") for (int m = 0; m < 4; ++m) _Pragma("unroll") for (int n = 0; n < 2; ++n) _Pragma("unroll") for (int k = 0; k < 2; ++k) \
        acc[ai][bj][m][n] = __builtin_amdgcn_mfma_f32_16x16x32_bf16(Bt[n][k], At[m][k], acc[ai][bj][m][n], 0, 0, 0); __builtin_amdgcn_s_setprio(0); } while (0)
#define PG8_WAIT_V(n) asm volatile("s_waitcnt vmcnt(" #n ")" ::: "memory")
#define PG8_WAIT_L(n) asm volatile("s_waitcnt lgkmcnt(" #n ")" ::: "memory")
#define PG8_BAR __builtin_amdgcn_s_barrier()
#define PG8_SCHED __builtin_amdgcn_sched_barrier(0)
    Unit cur, nxt; int ui = 0;
    if (!S.next(0, cur)) return;
    f32x4 acc[2][2][4][2];
#pragma unroll
    for (int a = 0; a < 2; ++a)
#pragma unroll
        for (int b = 0; b < 2; ++b)
#pragma unroll
            for (int m = 0; m < 4; ++m)
#pragma unroll
                for (int n = 0; n < 2; ++n) acc[a][b][m][n] = (f32x4){0.f, 0.f, 0.f, 0.f};
    bf16x8 At[4][2], B0[2][2], B1[2][2];
    const char* cA = (const char*)g.A + (size_t)cur.pm * tstep; const char* cB = (const char*)g.Bt + (size_t)cur.pn * tstep;
    if constexpr (SP2) {
        PG8_STAGE(PG8_SB(0, 0), cB, voffB); PG8_STAGE(PG8_SB(0, 1), cB + hstep, voffB); PG8_STAGE(PG8_SA(0, 0), cA, voffA); PG8_STAGE(PG8_SA(0, 1), cA + hstep, voffA);
        if (wr == 1) PG8_BAR;
        PG8_WAIT_V(2); PG8_BAR;
        PG8_STAGE(PG8_SB(1, 0), cB + kstep, voffB); PG8_STAGE(PG8_SA(1, 0), cA + kstep, voffA); PG8_STAGE(PG8_SB(1, 1), cB + hstep + kstep, voffB);
        PG8_WAIT_V(6); PG8_BAR;
    } else {
        PG8_STAGE(PG8_SB(0, 0), cB, voffB); PG8_STAGE(PG8_SA(0, 0), cA, voffA); PG8_STAGE(PG8_SB(0, 1), cB + hstep, voffB); PG8_STAGE(PG8_SA(0, 1), cA + hstep, voffA);
        if (wr == 1) PG8_BAR;
        PG8_WAIT_V(4); PG8_BAR;
        PG8_STAGE(PG8_SB(1, 0), cB + kstep, voffB); PG8_STAGE(PG8_SA(1, 0), cA + kstep, voffA); PG8_STAGE(PG8_SB(1, 1), cB + hstep + kstep, voffB);
        PG8_WAIT_V(6); PG8_BAR;
    }
    for (;;) {
        const bool has_next = S.next(ui + 1, nxt);
        const char* nA = has_next ? (const char*)g.A + (size_t)nxt.pm * tstep : cA; const char* nB = has_next ? (const char*)g.Bt + (size_t)nxt.pn * tstep : cB;
        for (int t = 0; t < nt; t += 2) {
            const bool last = (t == nt - 2);
            const char* a1 = cA + (size_t)(t + 1) * kstep;
            const char* a2 = last ? nA : cA + (size_t)(t + 2) * kstep; const char* b2 = last ? nB : cB + (size_t)(t + 2) * kstep;
            const char* a3 = a2 + kstep; const char* b3 = b2 + kstep;
            if constexpr (SP2) {
            PG8_LDB(B0, 0, 0); PG8_LDB(B1, 0, 1); PG8_SCHED; PG8_LDA(At, 0, 0); PG8_STAGE(PG8_SA(1, 1), a1 + hstep, voffA);
            PG8_WAIT_V(8); PG8_WAIT_L(0); PG8_BAR; PG8_MMA(0, 0, At, B0); PG8_MMA(0, 1, At, B1); PG8_BAR; PG8_SCHED;
            PG8_LDA(At, 0, 1); PG8_STAGE(PG8_SB(0, 0), b2, voffB); PG8_STAGE(PG8_SB(0, 1), b2 + hstep, voffB); PG8_STAGE(PG8_SA(0, 0), a2, voffA);
            PG8_WAIT_V(8); PG8_WAIT_L(0); PG8_BAR; PG8_MMA(1, 0, At, B0); PG8_MMA(1, 1, At, B1); PG8_BAR; PG8_SCHED;
            PG8_LDB(B0, 1, 0); PG8_LDB(B1, 1, 1); PG8_SCHED; PG8_LDA(At, 1, 0); PG8_STAGE(PG8_SA(0, 1), a2 + hstep, voffA);
            PG8_WAIT_V(8); PG8_WAIT_L(0); PG8_BAR; PG8_MMA(0, 0, At, B0); PG8_MMA(0, 1, At, B1); PG8_BAR; PG8_SCHED;
            PG8_LDA(At, 1, 1); PG8_STAGE(PG8_SB(1, 0), b3, voffB); PG8_STAGE(PG8_SB(1, 1), b3 + hstep, voffB); PG8_STAGE(PG8_SA(1, 0), a3, voffA);
            PG8_WAIT_V(8); PG8_WAIT_L(0); PG8_BAR; PG8_MMA(1, 0, At, B0); PG8_MMA(1, 1, At, B1); PG8_BAR; PG8_SCHED;
            } else {
            PG8_LDB(B0, 0, 0); PG8_SCHED; PG8_LDA(At, 0, 0); PG8_STAGE(PG8_SA(1, 1), a1 + hstep, voffA);
            PG8_WAIT_L(8); PG8_BAR; PG8_WAIT_L(0); PG8_MMA(0, 0, At, B0); PG8_BAR; PG8_SCHED;
            PG8_LDB(B1, 0, 1); PG8_STAGE(PG8_SB(0, 0), b2, voffB);
            PG8_BAR; PG8_WAIT_L(0); PG8_MMA(0, 1, At, B1); PG8_BAR;
            PG8_LDA(At, 0, 1); PG8_STAGE(PG8_SA(0, 0), a2, voffA);
            PG8_BAR; PG8_WAIT_L(0); PG8_MMA(1, 0, At, B0); PG8_BAR; PG8_SCHED;
            PG8_STAGE(PG8_SB(0, 1), b2 + hstep, voffB);
            PG8_WAIT_V(6); PG8_BAR; PG8_MMA(1, 1, At, B1); PG8_BAR;
            PG8_LDB(B0, 1, 0); PG8_SCHED; PG8_LDA(At, 1, 0); PG8_STAGE(PG8_SA(0, 1), a2 + hstep, voffA);
            PG8_WAIT_L(8); PG8_BAR; PG8_WAIT_L(0); PG8_MMA(0, 0, At, B0); PG8_BAR; PG8_SCHED;
            PG8_LDB(B1, 1, 1); PG8_STAGE(PG8_SB(1, 0), b3, voffB);
            PG8_BAR; PG8_WAIT_L(0); PG8_MMA(0, 1, At, B1); PG8_BAR;
            PG8_LDA(At, 1, 1); PG8_STAGE(PG8_SA(1, 0), a3, voffA);
            PG8_BAR; PG8_WAIT_L(0); PG8_MMA(1, 0, At, B0); PG8_BAR; PG8_SCHED;
            PG8_STAGE(PG8_SB(1, 1), b3 + hstep, voffB);
            PG8_WAIT_V(6); PG8_BAR; PG8_MMA(1, 1, At, B1); PG8_BAR;
            }
        }
        if constexpr (ALIGN_EPI) { if (wr == 0) PG8_BAR; }
        E(acc, cur, wr, wc, fr, fq);
        if (!has_next) break;
#pragma unroll
        for (int a = 0; a < 2; ++a)
#pragma unroll
            for (int b = 0; b < 2; ++b)
#pragma unroll
                for (int m = 0; m < 4; ++m)
#pragma unroll
                    for (int n = 0; n < 2; ++n) acc[a][b][m][n] = (f32x4){0.f, 0.f, 0.f, 0.f};
        cur = nxt; cA = nA; cB = nB; ++ui;
        if constexpr (ALIGN_EPI) { if (wr == 1) PG8_BAR; }
    }
    PG8_WAIT_V(0);
    if constexpr (!ALIGN_EPI) { if (wr == 0) PG8_BAR; }
    PG8_BAR;
#undef PG8_SA
#undef PG8_SB
#undef PG8_STAGE
#undef PG8_LDA
#undef PG8_LDB
#undef PG8_MMA
#undef PG8_WAIT_V
#undef PG8_WAIT_L
#undef PG8_BAR
#undef PG8_SCHED
}
}

struct Params {
    const float* in[26];
    float* out;
    unsigned char* ws;
};
struct Frame {
    LAS unsigned char* lds;
    int tid, lane, wave, G, bid;
};

template <int MT, int NT>
__device__ __forceinline__ void mma_nt(f32x4 (&acc)[MT][NT], const LAS bf16_t* A, int lda, const LAS bf16_t* B, int ldb, int K, int fr, int fq) {
    for (int k0 = 0; k0 < K; k0 += 32) {
        bf16x8 a[MT], b[NT];
#pragma unroll
        for (int m = 0; m < MT; ++m) a[m] = *(const LAS bf16x8*)(A + (m * 16 + fr) * lda + k0 + fq * 8);
#pragma unroll
        for (int n = 0; n < NT; ++n) b[n] = *(const LAS bf16x8*)(B + (n * 16 + fr) * ldb + k0 + fq * 8);
#pragma unroll
        for (int m = 0; m < MT; ++m)
#pragma unroll
            for (int n = 0; n < NT; ++n) acc[m][n] = __builtin_amdgcn_mfma_f32_16x16x32_bf16(a[m], b[n], acc[m][n], 0, 0, 0);
    }
}
template <int MT, int NT> __device__ __forceinline__ void zero_acc(f32x4 (&acc)[MT][NT]) {
#pragma unroll
    for (int m = 0; m < MT; ++m)
#pragma unroll
        for (int n = 0; n < NT; ++n) acc[m][n] = (f32x4){0.f, 0.f, 0.f, 0.f};
}

__device__ __forceinline__ void p0_transpose_item(const float* W, int K, int N, bf16_t* WT, int k0, int n0, int orow0, LAS float* scr, int lane) {
    float tv[32];
#pragma unroll
    for (int i = 0; i < 32; ++i) { const int kk = 2 * i + (lane >> 5); tv[i] = W[(size_t)(k0 + kk) * N + n0 + (lane & 31)]; }
#pragma unroll
    for (int i = 0; i < 32; ++i) { const int kk = 2 * i + (lane >> 5); scr[kk * 33 + (lane & 31)] = tv[i]; }
    asm volatile("s_waitcnt lgkmcnt(0)" ::: "memory");
    const int c = lane & 7;
#pragma unroll
    for (int j = 0; j < 4; ++j) { const int n = (lane >> 3) + 8 * j; const LAS float* s = scr + (8 * c) * 33 + n;
        u32x4 o; o.x = pk2(s[0 * 33], s[1 * 33]); o.y = pk2(s[2 * 33], s[3 * 33]); o.z = pk2(s[4 * 33], s[5 * 33]); o.w = pk2(s[6 * 33], s[7 * 33]);
        *(u32x4*)(WT + (size_t)(orow0 + n) * K + k0 + 8 * c) = o; }
    asm volatile("s_waitcnt lgkmcnt(0)" ::: "memory");
}

__device__ __forceinline__ void phase_prologue(const Frame& F, const Params& P) {
    unsigned char* ws = P.ws;
    LAS float* scr = (LAS float*)(F.lds + F.wave * 16384);
    const int gw = F.bid * NWAVES + F.wave, NGW = F.G * NWAVES;
    constexpr int I_IN = 16 * 73, I_OUT = 16 * 32, I_GU = 16 * 64, I_DN = 16 * 32;
    constexpr int PER_LAYER = I_IN + I_OUT + NE * I_GU + NE * I_DN;
    for (int it = gw; it < DEPTH * PER_LAYER; it += NGW) {
        const int l = it / PER_LAYER; int r = it % PER_LAYER;
        if (r < I_IN) { const int kb = r / 73, nb = r % 73;
            p0_transpose_item(P.in[8] + (size_t)l * D * INW, D, INW, (bf16_t*)(ws + WS_WIN) + (size_t)l * INP * D, 64 * kb, 32 * nb, 32 * nb, scr, F.lane); continue; }
        r -= I_IN;
        if (r < I_OUT) { const int kb = r / 32, nb = r % 32;
            p0_transpose_item(P.in[18] + (size_t)l * D * D, D, D, (bf16_t*)(ws + WS_WOUT) + (size_t)l * D * D, 64 * kb, 32 * nb, 32 * nb, scr, F.lane); continue; }
        r -= I_OUT;
        if (r < NE * I_GU) { const int e = r / I_GU, q = r % I_GU, kb = q / 64, nb = q % 64; const int n0 = 32 * nb;
            const int j = n0 & 1023, orow = 256 * (j >> 7) + (n0 >= 1024 ? 128 : 0) + (j & 127);
            p0_transpose_item(P.in[21] + ((size_t)l * NE + e) * D * 2048, D, 2048, (bf16_t*)(ws + WS_WGU) + ((size_t)l * NE + e) * 2048 * D, 64 * kb, n0, orow, scr, F.lane); continue; }
        r -= NE * I_GU;
        { const int e = r / I_DN, q = r % I_DN, kb = q / 32, nb = q % 32;
            p0_transpose_item(P.in[23] + ((size_t)l * NE + e) * DFF * D, DFF, D, (bf16_t*)(ws + WS_WDN) + ((size_t)l * NE + e) * D * DFF, 64 * kb, 32 * nb, 32 * nb, scr, F.lane); }
    }
    {
        const int gt = F.bid * NTHREADS + F.tid, NGT = F.G * NTHREADS;
        constexpr int PADV = (INP - INW) * D / 8;
        for (int i = gt; i < DEPTH * PADV; i += NGT) { const int l = i / PADV, q = i % PADV;
            *((u32x4*)((bf16_t*)(ws + WS_WIN) + (size_t)l * INP * D + (size_t)INW * D) + q) = (u32x4){0u, 0u, 0u, 0u}; }
        bf16_t* cm3 = (bf16_t*)(ws + WS_CM3);
        for (int i = gt; i < 192 * 64; i += NGT) { const int m = i >> 6, n2 = i & 63, part = m >> 6, k2 = m & 63; const int ph = (k2 * n2) & 63;
            float s, c; sincospif((float)ph * (1.0f / 32.0f), &s, &c); const float v = part == 0 ? c : (part == 1 ? -s : -c); cm3[i] = (bf16_t)f2bf(v); }
        bf16_t* tf2 = (bf16_t*)(ws + WS_TF2);
        for (int i = gt; i < 128 * 128; i += NGT) { const int c_ = i >> 7, n = i & 127; const int ph = (c_ * n) & 127;
            float s, c; sincospif((float)ph * (1.0f / 64.0f), &s, &c); tf2[i] = (bf16_t)f2bf(c); tf2[128 * 128 + i] = (bf16_t)f2bf(s); }
        bf16_t* tctx = (bf16_t*)(ws + WS_TCTX);
        for (int i = gt; i < 256 * 256; i += NGT) { const int k1 = i >> 8, n = i & 255; const int ph = (k1 * n) & 255;
            float s, c; sincospif((float)ph * (1.0f / 128.0f), &s, &c); tctx[i] = (bf16_t)f2bf(c); tctx[256 * 256 + i] = (bf16_t)f2bf(s); }
        bf16_t* tlat = (bf16_t*)(ws + WS_TLAT);
        for (int i = gt; i < 128 * 128 * 128; i += NGT) { const int nlo = i >> 14, d = (i >> 7) & 127, a = i & 127; const int ph = (d * (nlo + 128 * a)) & 16383;
            float s, c; sincospif((float)ph * (1.0f / 8192.0f), &s, &c);
            tlat[(size_t)nlo * 32768 + d * 128 + a] = (bf16_t)f2bf(c); tlat[(size_t)nlo * 32768 + 16384 + d * 128 + a] = (bf16_t)f2bf(s); }
    }
    for (int it = gw; it < DEPTH * 24 * 8; it += NGW) {
        const int l = it / 192, q = it % 192, cb = q >> 3, ks = q & 7;
        const float* wm = P.in[6] + (size_t)l * D * 6144 + (size_t)(ks * 128) * 6144 + cb * 256 + 4 * F.lane;
        f32x4 a0 = {0.f, 0.f, 0.f, 0.f}, a1 = a0, a2 = a0;
#pragma unroll 4
        for (int k = 0; k < 128; ++k) { const int kk = ks * 128 + k;
            const float c0 = P.in[1][kk], c1 = P.in[1][D + kk], c2 = P.in[3][kk];
            const float s0 = c0 * sigmoidf_(c0), s1 = c1 * sigmoidf_(c1), s2 = c2 * sigmoidf_(c2);
            const f32x4 w = *(const f32x4*)(wm + (size_t)k * 6144);
            a0 += w * s0; a1 += w * s1; a2 += w * s2; }
        float* mp = (float*)(ws + WS_MODP) + ((size_t)(l * 8 + ks) * 3) * 6144 + cb * 256 + 4 * F.lane;
        *(f32x4*)(mp) = a0; *(f32x4*)(mp + 6144) = a1; *(f32x4*)(mp + 2 * 6144) = a2;
    }
}

__device__ __forceinline__ f32x4 mod_from_partials(const Params& P, int l, int v, int c4) {
    f32x4 s = *(const f32x4*)(P.in[7] + (size_t)l * 6144 + c4);
    const float* mp = (const float*)(P.ws + WS_MODP) + ((size_t)(l * 8) * 3 + v) * 6144 + c4;
#pragma unroll
    for (int ks = 0; ks < 8; ++ks) s += *(const f32x4*)(mp + (size_t)ks * 3 * 6144);
    return s;
}

__device__ __forceinline__ void norm_row_store(const f32x4 (&x)[4], const float* g, const float* shift, const float* scale, bf16_t* orow, int lane, bool from_partials, const Params& P, int l, int v) {
    float ss = 0.f;
#pragma unroll
    for (int j = 0; j < 4; ++j) ss += (x[j].x * x[j].x + x[j].y * x[j].y) + (x[j].z * x[j].z + x[j].w * x[j].w);
    const float rstd = 1.0f / sqrtf(wave_sum(ss) * (1.0f / D) + NORM_EPS);
#pragma unroll
    for (int j = 0; j < 4; ++j) { const int c = 4 * lane + 256 * j;
        const f32x4 gv = *(const f32x4*)(g + c);
        f32x4 sh, sc;
        if (from_partials) { sh = mod_from_partials(P, l, v, c); sc = mod_from_partials(P, l, v, 1024 + c); }
        else { sh = *(const f32x4*)(shift + c); sc = *(const f32x4*)(scale + c); }
        const f32x4 y = (x[j] * rstd) * gv * (sc + 1.0f) + sh;
        u32x2 o; o.x = pk2(y.x, y.y); o.y = pk2(y.z, y.w);
        *(u32x2*)(orow + c) = o; }
}

__device__ __forceinline__ void phase_p1(const Frame& F, const Params& P) {
    unsigned char* ws = P.ws;
    const int gt = F.bid * NTHREADS + F.tid, NGT = F.G * NTHREADS;
    float* modf = (float*)(ws + WS_MODF);
    for (int i = gt; i < DEPTH * 3 * 1536; i += NGT) { const int l = i / 4608, q = i % 4608, v = q / 1536, c4 = (q % 1536) * 4;
        *(f32x4*)(modf + ((size_t)l * 3 + v) * 6144 + c4) = mod_from_partials(P, l, v, c4); }
    const int gw = F.bid * NWAVES + F.wave, NGW = F.G * NWAVES;
    float* xres = (float*)(ws + WS_XRES); bf16_t* hb = (bf16_t*)(ws + WS_HBUF);
    for (int m = gw; m < NTOK; m += NGW) {
        const float* src = (m < NLAT) ? (P.in[0] + (size_t)m * D) : (P.in[2] + (size_t)(m - NLAT) * D);
        const int v = (m >= NLAT) ? 2 : (m >= SEQ ? 1 : 0);
        f32x4 x[4];
#pragma unroll
        for (int j = 0; j < 4; ++j) { x[j] = *(const f32x4*)(src + 4 * F.lane + 256 * j); *(f32x4*)(xres + (size_t)m * D + 4 * F.lane + 256 * j) = x[j]; }
        norm_row_store(x, P.in[4], nullptr, nullptr, hb + (size_t)m * D, F.lane, true, P, 0, v);
    }
}

constexpr int GL_GT = 0;
constexpr int GL_A1 = 34816, GL_KE = 60416, GL_VTB = 78848, GL_RS = 97280, GL_RT = 97792;
constexpr int GL_KDT = 34816, GL_VT = 53248;

__device__ __forceinline__ float logsigmoidf_(float x) { return fminf(x, 0.f) - __logf(1.0f + __expf(-fabsf(x))); }
__device__ __forceinline__ float bfel(const u32x4& v, int j) { const unsigned w = (j < 2) ? v.x : (j < 4 ? v.y : (j < 6 ? v.z : v.w)); return (j & 1) ? bfhi(w) : bflo(w); }
__device__ __forceinline__ unsigned short bfraw(const u32x4& v, int j) { const unsigned w = (j < 2) ? v.x : (j < 4 ? v.y : (j < 6 ? v.z : v.w)); return (unsigned short)((j & 1) ? (w >> 16) : (w & 0xffffu)); }

struct GateRegs { u32x4 lr[2]; float wg[4]; float bg; };
__device__ __forceinline__ GateRegs gla_load_gate_regs(const Frame& F, const Params& P, int l, int row0, int h) {
    const bf16_t* pb = (const bf16_t*)(P.ws + WS_PBUF); GateRegs g;
    const int dir = F.wave >> 2, dbase = (F.wave & 3) * 16, lane = F.lane, t = dir ? 63 - lane : lane;
    const bf16_t* lrp = pb + (size_t)(row0 + t) * INP + C_GF + dir * 16;
    g.lr[0] = *(const u32x4*)lrp; g.lr[1] = *(const u32x4*)(lrp + 8);
    const float* wgp = (dir ? P.in[11] : P.in[9]) + (size_t)l * 16 * 256 + 64 * h + dbase;
#pragma unroll
    for (int q = 0; q < 4; ++q) { const int idx = lane * 4 + q, r = idx >> 4, i = idx & 15; g.wg[q] = wgp[r * 256 + i]; }
    g.bg = (dir ? P.in[12] : P.in[10])[(size_t)l * 256 + 64 * h + dbase + (lane & 15)];
    return g;
}
__device__ __forceinline__ float rdlane(float v, int srcLane) { return __builtin_bit_cast(float, __builtin_amdgcn_readlane(__builtin_bit_cast(int, v), srcLane)); }
#define DPP_ADD(v, ctrl, rmask) v += __builtin_bit_cast(float, __builtin_amdgcn_update_dpp(0, __builtin_bit_cast(int, v), ctrl, rmask, 0xf, false))
__device__ __forceinline__ float wave_scan_incl(float v) {
    DPP_ADD(v, 0x111, 0xf); DPP_ADD(v, 0x112, 0xf); DPP_ADD(v, 0x114, 0xf); DPP_ADD(v, 0x118, 0xf); DPP_ADD(v, 0x142, 0xa); DPP_ADD(v, 0x143, 0xc);
    return v;
}
__device__ __forceinline__ void gla_gates(const Frame& F, const GateRegs& gr) {
    LAS float* GT = (LAS float*)(F.lds + GL_GT);
    const int dir = F.wave >> 2, dbase = (F.wave & 3) * 16, lane = F.lane, t = dir ? 63 - lane : lane;
    float lr[16];
#pragma unroll
    for (int j = 0; j < 8; ++j) { lr[j] = bfel(gr.lr[0], j); lr[8 + j] = bfel(gr.lr[1], j); }
#pragma unroll
    for (int i = 0; i < 16; ++i) {
        float pre = rdlane(gr.bg, i);
#pragma unroll
        for (int r = 0; r < 16; ++r) { const int idx = r * 16 + i; pre += lr[r] * rdlane(gr.wg[idx & 3], idx >> 2); }
        const float g = wave_scan_incl(logsigmoidf_(pre) * (1.0f / 16.0f));
        GT[(dir * 64 + dbase + i) * 65 + t] = g;
    }
}

__device__ __forceinline__ void gla_g1_unit(const Frame& F, const Params& P, int l, int row0, int h, int unit) {
    const bf16_t* pb = (const bf16_t*)(P.ws + WS_PBUF);
    const int tid = F.tid, row = F.lane, c8 = F.wave * 8;
    const GateRegs gr = gla_load_gate_regs(F, P, l, row0, h);
    const u32x4 kv = *(const u32x4*)(pb + (size_t)(row0 + row) * INP + C_K + 64 * h + c8);
    u32x4 vv[2];
#pragma unroll
    for (int i = 0; i < 2; ++i) { const int vr = F.lane, vc = (F.wave + 8 * i) * 8; vv[i] = *(const u32x4*)(pb + (size_t)(row0 + vr) * INP + C_V + 128 * h + vc); }
    gla_gates(F, gr);
    __syncthreads();
    LAS float* GT = (LAS float*)(F.lds + GL_GT);
    LAS bf16_t* KDT = (LAS bf16_t*)(F.lds + GL_KDT); LAS bf16_t* VT = (LAS bf16_t*)(F.lds + GL_VT);
#pragma unroll
    for (int j = 0; j < 8; ++j) { const int d = c8 + j; const float k_ = bfel(kv, j);
        KDT[d * 72 + row] = (bf16_t)f2bf(k_ * __expf(GT[d * 65 + 63] - GT[d * 65 + row])); KDT[(64 + d) * 72 + row] = (bf16_t)f2bf(k_ * __expf(GT[(64 + d) * 65] - GT[(64 + d) * 65 + row])); }
#pragma unroll
    for (int i = 0; i < 2; ++i) { const int vr = F.lane, vc = (F.wave + 8 * i) * 8;
#pragma unroll
        for (int j = 0; j < 8; ++j) VT[(vc + j) * 72 + vr] = bfraw(vv[i], j); }
    if (tid < 128) ((float*)(P.ws + WS_DECAY))[(size_t)unit * 128 + tid] = __expf(tid < 64 ? GT[tid * 65 + 63] : GT[tid * 65]);
    __syncthreads();
    const int fr = F.lane & 15, fq = F.lane >> 4, w = F.wave;
    f32x4 acc[1][8]; zero_acc<1, 8>(acc);
    mma_nt<1, 8>(acc, KDT + (16 * w) * 72, 72, VT, 72, 64, fr, fq);
    bf16_t* st = (bf16_t*)(P.ws + WS_STATE) + (size_t)unit * 16384;
#pragma unroll
    for (int nt = 0; nt < 8; ++nt) { u32x2 o; o.x = pk2(acc[0][nt][0], acc[0][nt][1]); o.y = pk2(acc[0][nt][2], acc[0][nt][3]); *(u32x2*)(st + (nt * 16 + fr) * 128 + 16 * w + fq * 4) = o; }
}

__device__ __forceinline__ void gla_scan(const Frame& F, const Params& P) {
    unsigned* stt = (unsigned*)(P.ws + WS_STATE); const float* dec = (const float*)(P.ws + WS_DECAY);
    if (F.tid >= 256) return;
    for (int gid = F.bid * 256 + F.tid; gid < 8 * 128 * 64; gid += F.G * 256) {
        const int dp = gid & 63, e = (gid >> 6) & 127, bh = gid >> 13, dir = dp >> 5;
        const int latb = bh * 256, ctxb = 2048 + bh * 4;
        auto unit_of = [&](int p) { return dir == 0 ? (p < 4 ? ctxb + p : latb + (p - 4)) : (p < 4 ? ctxb + 3 - p : latb + 255 - (p - 4)); };
        float s0 = 0.f, s1 = 0.f;
        unsigned dA[10], dB[10]; f32x2 cA[10], cB[10];
#pragma unroll
        for (int i = 0; i < 10; ++i) { const int u = unit_of(i); dA[i] = stt[((size_t)u * 128 + e) * 64 + dp]; cA[i] = *(const f32x2*)(dec + (size_t)u * 128 + 2 * dp); }
        for (int p0 = 0; p0 < 260; p0 += 20) {
#pragma unroll
            for (int i = 0; i < 10; ++i) { const int u = unit_of(p0 + 10 + i); dB[i] = stt[((size_t)u * 128 + e) * 64 + dp]; cB[i] = *(const f32x2*)(dec + (size_t)u * 128 + 2 * dp); }
#pragma unroll
            for (int i = 0; i < 10; ++i) { const int u = unit_of(p0 + i); stt[((size_t)u * 128 + e) * 64 + dp] = pk2(s0, s1); s0 = cA[i].x * s0 + bflo(dA[i]); s1 = cA[i].y * s1 + bfhi(dA[i]); }
            if (p0 + 20 < 260) {
#pragma unroll
                for (int i = 0; i < 10; ++i) { const int u = unit_of(p0 + 20 + i); dA[i] = stt[((size_t)u * 128 + e) * 64 + dp]; cA[i] = *(const f32x2*)(dec + (size_t)u * 128 + 2 * dp); } }
#pragma unroll
            for (int i = 0; i < 10; ++i) { const int u = unit_of(p0 + 10 + i); stt[((size_t)u * 128 + e) * 64 + dp] = pk2(s0, s1); s0 = cB[i].x * s0 + bflo(dB[i]); s1 = cB[i].y * s1 + bfhi(dB[i]); }
        }
    }
}

__device__ __forceinline__ void gla_g3_unit(const Frame& F, const Params& P, int l, int row0, int h, int unit) {
    const bf16_t* pb = (const bf16_t*)(P.ws + WS_PBUF);
    const int tid = F.tid, fr = F.lane & 15, fq = F.lane >> 4, w = F.wave, row = F.lane, c8 = F.wave * 8;
    const GateRegs gr = gla_load_gate_regs(F, P, l, row0, h);
    const u32x4 qv = *(const u32x4*)(pb + (size_t)(row0 + row) * INP + C_Q + 64 * h + c8), kv = *(const u32x4*)(pb + (size_t)(row0 + row) * INP + C_K + 64 * h + c8);
    u32x4 vv[2], rv[2], stv[4];
#pragma unroll
    for (int i = 0; i < 2; ++i) { const int vr = F.lane, vc = (F.wave + 8 * i) * 8; const bf16_t* rp = pb + (size_t)(row0 + vr) * INP + 128 * h + vc; vv[i] = *(const u32x4*)(rp + C_V); rv[i] = *(const u32x4*)(rp + C_R); }
    { const bf16_t* st = (const bf16_t*)(P.ws + WS_STATE) + (size_t)unit * 16384;
#pragma unroll
      for (int i = 0; i < 4; ++i) stv[i] = *(const u32x4*)(st + (i * 512 + tid) * 8); }
    const float* ng = P.in[13] + (size_t)l * 128;
    float ngv[4];
#pragma unroll
    for (int nt = 0; nt < 4; ++nt) ngv[nt] = ng[(w >> 2) * 64 + nt * 16 + fr];
    gla_gates(F, gr);
    __syncthreads();
    LAS float* GT = (LAS float*)(F.lds + GL_GT);
    LAS bf16_t* A1 = (LAS bf16_t*)(F.lds + GL_A1); LAS bf16_t* KE = (LAS bf16_t*)(F.lds + GL_KE); LAS bf16_t* VTb = (LAS bf16_t*)(F.lds + GL_VTB); LAS bf16_t* STb = (LAS bf16_t*)(F.lds + GL_GT);
    LAS float* RS = (LAS float*)(F.lds + GL_RS); LAS bf16_t* RT = (LAS bf16_t*)(F.lds + GL_RT);
    { float qf[8], qb[8], kf[8], kb[8];
#pragma unroll
      for (int j = 0; j < 8; ++j) { const float q_ = bfel(qv, j) * 0.125f, k_ = bfel(kv, j); const float bf_ = GT[(c8 + j) * 65 + row], bb_ = GT[(64 + c8 + j) * 65 + row];
          qf[j] = q_ * __expf(bf_); qb[j] = q_ * __expf(bb_); kf[j] = k_ * __expf(-bf_); kb[j] = k_ * __expf(-bb_); }
      *(LAS u32x4*)(A1 + row * 200 + 64 + c8) = (u32x4){pk2(qf[0], qf[1]), pk2(qf[2], qf[3]), pk2(qf[4], qf[5]), pk2(qf[6], qf[7])};
      *(LAS u32x4*)(A1 + row * 200 + 128 + c8) = (u32x4){pk2(qb[0], qb[1]), pk2(qb[2], qb[3]), pk2(qb[4], qb[5]), pk2(qb[6], qb[7])};
      *(LAS u32x4*)(KE + row * 72 + c8) = (u32x4){pk2(kf[0], kf[1]), pk2(kf[2], kf[3]), pk2(kf[4], kf[5]), pk2(kf[6], kf[7])};
      *(LAS u32x4*)(KE + 4608 + row * 72 + c8) = (u32x4){pk2(kb[0], kb[1]), pk2(kb[2], kb[3]), pk2(kb[4], kb[5]), pk2(kb[6], kb[7])}; }
#pragma unroll
    for (int i = 0; i < 2; ++i) { const int vr = F.lane, vc = (F.wave + 8 * i) * 8; *(LAS u32x4*)(RT + vr * 136 + vc) = rv[i];
#pragma unroll
        for (int j = 0; j < 8; ++j) VTb[(vc + j) * 72 + vr] = bfraw(vv[i], j); }
    __syncthreads();
    {
        const int mt = w & 3, ntp = w >> 2;
        f32x4 af[1][2], ab[1][2]; zero_acc<1, 2>(af); zero_acc<1, 2>(ab);
        mma_nt<1, 2>(af, A1 + (16 * mt) * 200 + 64, 200, KE + (32 * ntp) * 72, 72, 64, fr, fq);
        mma_nt<1, 2>(ab, A1 + (16 * mt) * 200 + 128, 200, KE + 4608 + (32 * ntp) * 72, 72, 64, fr, fq);
#pragma unroll
        for (int i = 0; i < 4; ++i) { const int idx = (i * 512 + tid) * 8, e = idx >> 7, dd = idx & 127; *(LAS u32x4*)(STb + e * 136 + dd) = stv[i]; }
#pragma unroll
        for (int nt = 0; nt < 2; ++nt)
#pragma unroll
            for (int j = 0; j < 4; ++j) { const int i = 16 * mt + fq * 4 + j, jj = (2 * ntp + nt) * 16 + fr;
                const float p = (jj <= i ? af[0][nt][j] : 0.f) + (jj >= i ? ab[0][nt][j] : 0.f); A1[i * 200 + jj] = (bf16_t)f2bf(p); }
    }
    __syncthreads();
    {
        const int mt = w & 3, nh = w >> 2;
        f32x4 acc[1][4]; zero_acc<1, 4>(acc);
        mma_nt<1, 4>(acc, A1 + (16 * mt) * 200, 200, VTb + (64 * nh) * 72, 72, 64, fr, fq);
        mma_nt<1, 4>(acc, A1 + (16 * mt) * 200 + 64, 200, STb + (64 * nh) * 136, 136, 128, fr, fq);
        float ss[4];
#pragma unroll
        for (int j = 0; j < 4; ++j) { float s = 0.f;
#pragma unroll
            for (int nt = 0; nt < 4; ++nt) s += acc[0][nt][j] * acc[0][nt][j];
            s += __shfl_xor(s, 1); s += __shfl_xor(s, 2); s += __shfl_xor(s, 4); s += __shfl_xor(s, 8); ss[j] = s; }
        if (fr == 0) {
#pragma unroll
            for (int j = 0; j < 4; ++j) RS[nh * 64 + 16 * mt + fq * 4 + j] = ss[j]; }
        __syncthreads();
        bf16_t* cat = (bf16_t*)(P.ws + WS_CAT);
#pragma unroll
        for (int j = 0; j < 4; ++j) { const int i = 16 * mt + fq * 4 + j; const float rinv = 1.0f / sqrtf((RS[i] + RS[64 + i]) * (1.0f / 128.0f) + NORM_EPS);
#pragma unroll
            for (int nt = 0; nt < 4; ++nt) { const int e = nh * 64 + nt * 16 + fr; const float r_ = bf2f(RT[i * 136 + e]);
                const float o = acc[0][nt][j] * rinv * ngv[nt] * (r_ * sigmoidf_(r_)); cat[(size_t)(row0 + i) * D + 256 + 128 * h + e] = (bf16_t)f2bf(o); } }
    }
}

__device__ __forceinline__ void conv_unit(const Frame& F, const Params& P, int l, int rowbase, int Ls, int t0) {
    const bf16_t* pb = (const bf16_t*)(P.ws + WS_PBUF);
    LAS bf16_t* Y = (LAS bf16_t*)(F.lds);
    LAS float* Z = (LAS float*)(F.lds + 49152);
    const int tid = F.tid;
    {
        u32x4 av[6], gv[6];
#pragma unroll
        for (int i = 0; i < 6; ++i) { const int ch = tid + 512 * i, r = ch >> 5, cc = (ch & 31) * 8, t = t0 - 15 + r;
            av[i] = (u32x4){0u, 0u, 0u, 0u}; gv[i] = av[i];
            if (ch < 94 * 32 && t >= 0 && t < Ls) { const size_t rb = (size_t)(rowbase + t) * INP; av[i] = *(const u32x4*)(pb + rb + C_CA + cc); gv[i] = *(const u32x4*)(pb + rb + C_CG + cc); } }
#pragma unroll
        for (int i = 0; i < 6; ++i) { const int ch = tid + 512 * i, r = ch >> 5, cc = (ch & 31) * 8; const u32x4 a = av[i], g = gv[i]; u32x4 o;
            o.x = pk2(bflo(a.x) * sigmoidf_(bflo(g.x)), bfhi(a.x) * sigmoidf_(bfhi(g.x))); o.y = pk2(bflo(a.y) * sigmoidf_(bflo(g.y)), bfhi(a.y) * sigmoidf_(bfhi(g.y)));
            o.z = pk2(bflo(a.z) * sigmoidf_(bflo(g.z)), bfhi(a.z) * sigmoidf_(bfhi(g.z))); o.w = pk2(bflo(a.w) * sigmoidf_(bflo(g.w)), bfhi(a.w) * sigmoidf_(bfhi(g.w)));
            if (ch < 94 * 32) *(LAS u32x4*)(Y + r * 256 + cc) = o; }
    }
    const int c = tid & 255, half = tid >> 8; const float* cw = P.in[14] + (size_t)l * 31 * 256 + c; const float cb = P.in[15][(size_t)l * 256 + c];
    float wv[31];
#pragma unroll
    for (int j = 0; j < 31; ++j) wv[j] = cw[j * 256];
    const f32x4 lng = *(const f32x4*)(P.in[16] + (size_t)l * 256 + 4 * F.lane), lnb = *(const f32x4*)(P.in[17] + (size_t)l * 256 + 4 * F.lane);
    __syncthreads();
    { float yv[62];
#pragma unroll
      for (int r = 0; r < 62; ++r) yv[r] = bf2f(Y[(half * 32 + r) * 256 + c]);
#pragma unroll
      for (int tt = 0; tt < 32; ++tt) { float z = cb;
#pragma unroll
          for (int j = 0; j < 31; ++j) z += wv[j] * yv[tt + j];
          Z[(half * 32 + tt) * 256 + c] = z; } }
    __syncthreads();
    { bf16_t* cat = (bf16_t*)(P.ws + WS_CAT);
#pragma unroll 2
      for (int i = 0; i < 8; ++i) { const int t = F.wave * 8 + i; const f32x4 z = *(const LAS f32x4*)(Z + t * 256 + 4 * F.lane);
          const float mean = wave_sum((z.x + z.y) + (z.z + z.w)) * (1.0f / 256.0f); const f32x4 zc = z - mean;
          const float var = wave_sum((zc.x * zc.x + zc.y * zc.y) + (zc.z * zc.z + zc.w * zc.w)) * (1.0f / 256.0f); const float rstd = 1.0f / sqrtf(var + NORM_EPS);
          const f32x4 y = zc * rstd * lng + lnb; u32x2 o; o.x = pk2(y.x * sigmoidf_(y.x), y.y * sigmoidf_(y.y)); o.y = pk2(y.z * sigmoidf_(y.z), y.w * sigmoidf_(y.w));
          *(u32x2*)(cat + (size_t)(rowbase + t0 + t) * D + 768 + 4 * F.lane) = o; } }
    __syncthreads();
}

template <int R, int NP>
__device__ __forceinline__ void fourier_f1_unit(const Frame& F, const Params& P, int rowbase, int rstride, int h, const bf16_t* tab, int orow0, float oscale) {
    const bf16_t* pb = (const bf16_t*)(P.ws + WS_PBUF); const bf16_t* cm3 = (const bf16_t*)(P.ws + WS_CM3);
    constexpr int LZ = R + 8, MT0 = 4 * NP, NTW = R / 128, MTW = R / 128;
    LAS bf16_t* U = (LAS bf16_t*)(F.lds); LAS bf16_t* CM = U + R * 72; LAS bf16_t* ZT = CM + 64 * NP * 72;
    const int tid = F.tid, fr = F.lane & 15, fq = F.lane >> 4, w = F.wave;
    bf16x8 tcp[4], tsp[4];
    if constexpr (R == 128) {
#pragma unroll
        for (int k = 0; k < 4; ++k) { tcp[k] = *(const bf16x8*)(tab + (size_t)(w * 16 + fr) * R + k * 32 + fq * 8); tsp[k] = *(const bf16x8*)(tab + (size_t)R * R + (size_t)(w * 16 + fr) * R + k * 32 + fq * 8); } }
    { constexpr int NU = R * 8 / NTHREADS, NC = (64 * NP * 8 + NTHREADS - 1) / NTHREADS; u32x4 uv[NU], cv[NC];
#pragma unroll
      for (int i = 0; i < NU; ++i) { const int ch = tid + NTHREADS * i, a = ch >> 3, c8 = (ch & 7) * 8; uv[i] = *(const u32x4*)(pb + (size_t)(rowbase + a * rstride) * INP + C_FOUR + 64 * h + c8); }
#pragma unroll
      for (int i = 0; i < NC; ++i) { const int ch = tid + NTHREADS * i, m = ch >> 3, c8 = (ch & 7) * 8; cv[i] = (ch < 64 * NP * 8) ? *(const u32x4*)(cm3 + m * 64 + c8) : (u32x4){0u, 0u, 0u, 0u}; }
#pragma unroll
      for (int i = 0; i < NU; ++i) { const int ch = tid + NTHREADS * i, a = ch >> 3, c8 = (ch & 7) * 8; *(LAS u32x4*)(U + a * 72 + c8) = uv[i]; }
#pragma unroll
      for (int i = 0; i < NC; ++i) { const int ch = tid + NTHREADS * i, m = ch >> 3, c8 = (ch & 7) * 8; if (ch < 64 * NP * 8) *(LAS u32x4*)(CM + m * 72 + c8) = cv[i]; } }
    __syncthreads();
    {
        f32x4 acc[MT0][NTW]; zero_acc<MT0, NTW>(acc);
        mma_nt<MT0, NTW>(acc, CM, 72, U + (w * NTW * 16) * 72, 72, 64, fr, fq);
#pragma unroll
        for (int mt = 0; mt < MT0; ++mt)
#pragma unroll
            for (int nt = 0; nt < NTW; ++nt)
#pragma unroll
                for (int j = 0; j < 4; ++j) ZT[(mt * 16 + fq * 4 + j) * LZ + (w * NTW + nt) * 16 + fr] = (bf16_t)f2bf(acc[mt][nt][j]);
    }
    __syncthreads();
    {
        f32x4 are[MTW][4], aim[MTW][4]; zero_acc<MTW, 4>(are); zero_acc<MTW, 4>(aim);
        const int m0 = w * MTW * 16;
#pragma unroll
        for (int k0 = 0; k0 < R; k0 += 32) {
            bf16x8 tc[MTW], ts[MTW];
#pragma unroll
            for (int mi = 0; mi < MTW; ++mi) { if constexpr (R == 128) { tc[mi] = tcp[k0 / 32]; ts[mi] = tsp[k0 / 32]; } else { tc[mi] = *(const bf16x8*)(tab + (size_t)(m0 + mi * 16 + fr) * R + k0 + fq * 8); ts[mi] = *(const bf16x8*)(tab + (size_t)R * R + (size_t)(m0 + mi * 16 + fr) * R + k0 + fq * 8); } }
#pragma unroll
            for (int nt = 0; nt < 4; ++nt) {
                const bf16x8 zr = *(const LAS bf16x8*)(ZT + (nt * 16 + fr) * LZ + k0 + fq * 8), zi = *(const LAS bf16x8*)(ZT + (64 + nt * 16 + fr) * LZ + k0 + fq * 8);
#pragma unroll
                for (int mi = 0; mi < MTW; ++mi) { are[mi][nt] = __builtin_amdgcn_mfma_f32_16x16x32_bf16(tc[mi], zr, are[mi][nt], 0, 0, 0); are[mi][nt] = __builtin_amdgcn_mfma_f32_16x16x32_bf16(ts[mi], zi, are[mi][nt], 0, 0, 0); }
                if constexpr (NP == 3) { const bf16x8 nzr = *(const LAS bf16x8*)(ZT + (128 + nt * 16 + fr) * LZ + k0 + fq * 8);
#pragma unroll
                    for (int mi = 0; mi < MTW; ++mi) { aim[mi][nt] = __builtin_amdgcn_mfma_f32_16x16x32_bf16(tc[mi], zi, aim[mi][nt], 0, 0, 0); aim[mi][nt] = __builtin_amdgcn_mfma_f32_16x16x32_bf16(ts[mi], nzr, aim[mi][nt], 0, 0, 0); } }
            }
        }
#pragma unroll
        for (int mi = 0; mi < MTW; ++mi)
#pragma unroll
            for (int nt = 0; nt < 4; ++nt)
#pragma unroll
                for (int j = 0; j < 4; ++j) { const int m = m0 + mi * 16 + fq * 4 + j, k2 = nt * 16 + fr;
                    if constexpr (NP == 3) { unsigned* t2 = (unsigned*)(P.ws + WS_T2); t2[(size_t)(orow0 + 128 * m) * 256 + h * 64 + k2] = pk2(are[mi][nt][j], aim[mi][nt][j]); }
                    else { bf16_t* cat = (bf16_t*)(P.ws + WS_CAT); cat[(size_t)(orow0 + m) * D + h * 64 + k2] = (bf16_t)f2bf(are[mi][nt][j] * oscale); } }
    }
    __syncthreads();
}

constexpr int F2_X = 0, F2_T = 67584;
__device__ __forceinline__ void fourier_f2_tables(const Frame& F, const Params& P) {
    const bf16_t* tf2 = (const bf16_t*)(P.ws + WS_TF2); LAS bf16_t* T = (LAS bf16_t*)(F.lds + F2_T);
#pragma unroll
    for (int i = 0; i < 8; ++i) { const int ch = F.tid + 512 * i, r = ch >> 4, c8 = (ch & 15) * 8; *(LAS u32x4*)(T + r * 136 + c8) = *(const u32x4*)(tf2 + r * 128 + c8); }
    __syncthreads();
}
__device__ __forceinline__ void fourier_f2_unit(const Frame& F, const Params& P, int b, int d, int hp) {
    const bf16_t* t2 = (const bf16_t*)(P.ws + WS_T2);
    LAS bf16_t* X = (LAS bf16_t*)(F.lds + F2_X); const LAS bf16_t* T = (const LAS bf16_t*)(F.lds + F2_T);
    const int tid = F.tid, fr = F.lane & 15, fq = F.lane >> 4, w = F.wave;
    { u32x4 xv[8];
#pragma unroll
      for (int i = 0; i < 8; ++i) { const int ch = tid + 512 * i, n = ch >> 5, c8 = (ch & 31) * 8; xv[i] = *(const u32x4*)(t2 + (size_t)(b * SEQ + 128 * d + n) * 512 + hp * 256 + c8); }
#pragma unroll
      for (int i = 0; i < 8; ++i) { const int ch = tid + 512 * i, n = ch >> 5, c8 = (ch & 31) * 8; *(LAS u32x4*)(X + n * 264 + c8) = xv[i]; } }
    __syncthreads();
    f32x4 acc[8];
#pragma unroll
    for (int mt = 0; mt < 8; ++mt) acc[mt] = (f32x4){0.f, 0.f, 0.f, 0.f};
#pragma unroll
    for (int k0 = 0; k0 < 128; k0 += 32) {
        bf16x8 xr, xi;
#pragma unroll
        for (int jj = 0; jj < 8; ++jj) { const unsigned wd = *(const LAS unsigned*)(X + (k0 + fq * 8 + jj) * 264 + 2 * (w * 16 + fr)); xr[jj] = (short)(wd & 0xffffu); xi[jj] = (short)(wd >> 16); }
#pragma unroll
        for (int mt = 0; mt < 8; ++mt) { const bf16x8 tc = *(const LAS bf16x8*)(T + (mt * 16 + fr) * 136 + k0 + fq * 8), ts = *(const LAS bf16x8*)(T + (128 + mt * 16 + fr) * 136 + k0 + fq * 8);
            acc[mt] = __builtin_amdgcn_mfma_f32_16x16x32_bf16(tc, xr, acc[mt], 0, 0, 0); acc[mt] = __builtin_amdgcn_mfma_f32_16x16x32_bf16(ts, xi, acc[mt], 0, 0, 0); }
    }
    bf16_t* cat = (bf16_t*)(P.ws + WS_CAT);
#pragma unroll
    for (int mt = 0; mt < 8; ++mt)
#pragma unroll
        for (int j = 0; j < 4; ++j) { const int c = mt * 16 + fq * 4 + j; cat[(size_t)(b * SEQ + 128 * c + d) * D + hp * 128 + w * 16 + fr] = (bf16_t)f2bf(acc[mt][j] * (1.0f / 1024.0f)); }
    __syncthreads();
}

constexpr int AX_LCNT = AUX_OFF, AX_GBASE = AUX_OFF + 128, AX_LE = AUX_OFF + 256, AX_LP = AUX_OFF + 256 + 2560;
constexpr int LC_BAR = LCTL_OFF, LC_TS = LCTL_OFF + 64;

__device__ __forceinline__ void phase_route(const Frame& F, const Params& P, int l, int ntok) {
    unsigned char* ws = P.ws;
    LAS float* RWT = (LAS float*)(F.lds);
    volatile LAS int* lcnt = (volatile LAS int*)(F.lds + AX_LCNT); volatile LAS int* gbase = (volatile LAS int*)(F.lds + AX_GBASE);
    volatile LAS int* LE = (volatile LAS int*)(F.lds + AX_LE); volatile LAS int* LP = (volatile LAS int*)(F.lds + AX_LP);
    const int tid = F.tid, lane = F.lane;
    const int tpb = (ntok + F.G - 1) / F.G, tb = F.bid * tpb, te = (tb + tpb < ntok) ? tb + tpb : ntok;
    { const float* rw = P.in[19] + (size_t)l * D * NE;
#pragma unroll 1
      for (int i0 = 0; i0 < 64; i0 += 16) { float tv[16];
#pragma unroll
          for (int i = 0; i < 16; ++i) tv[i] = rw[tid + NTHREADS * (i0 + i)];
#pragma unroll
          for (int i = 0; i < 16; ++i) { const int idx = tid + NTHREADS * (i0 + i), k = idx >> 5, e = idx & 31; RWT[e * 1024 + k] = tv[i]; } } }
    if (tid < 32) lcnt[tid] = 0;
    __syncthreads();
    const float* xres = (const float*)(ws + WS_XRES); bf16_t* hb = (bf16_t*)(ws + WS_HBUF);
    const float* g2 = P.in[5] + (size_t)l * D; const float* rb = P.in[20] + (size_t)l * NE;
    float* aprob = (float*)(ws + WS_APROB);
    f32x4 xn[4];
    if (tb + F.wave < te) {
#pragma unroll
        for (int j = 0; j < 4; ++j) xn[j] = *(const f32x4*)(xres + (size_t)(tb + F.wave) * D + 4 * lane + 256 * j); }
    for (int tl = F.wave; tb + tl < te; tl += NWAVES) {
        const int m = tb + tl; const int v = (m >= NLAT) ? 2 : (m >= SEQ ? 1 : 0);
        const float* mf = (const float*)(ws + WS_MODF) + ((size_t)l * 3 + v) * 6144;
        f32x4 x[4]; float ss = 0.f;
#pragma unroll
        for (int j = 0; j < 4; ++j) { x[j] = xn[j]; ss += (x[j].x * x[j].x + x[j].y * x[j].y) + (x[j].z * x[j].z + x[j].w * x[j].w); }
        if (m + NWAVES < te) {
#pragma unroll
            for (int j = 0; j < 4; ++j) xn[j] = *(const f32x4*)(xres + (size_t)(m + NWAVES) * D + 4 * lane + 256 * j); }
        const float rstd = 1.0f / sqrtf(wave_sum(ss) * (1.0f / D) + NORM_EPS);
#pragma unroll
        for (int j = 0; j < 4; ++j) { const int c = 4 * lane + 256 * j; const f32x4 gv = *(const f32x4*)(g2 + c), sh = *(const f32x4*)(mf + 3 * 1024 + c), sc = *(const f32x4*)(mf + 4 * 1024 + c);
            x[j] = (x[j] * rstd) * gv * (sc + 1.0f) + sh; u32x2 o; o.x = pk2(x[j].x, x[j].y); o.y = pk2(x[j].z, x[j].w); *(u32x2*)(hb + (size_t)m * D + c) = o; }
        float pv[32];
#pragma unroll
        for (int e = 0; e < 32; ++e) { float s = 0.f;
#pragma unroll
            for (int j = 0; j < 4; ++j) { const f32x4 wv = *(const LAS f32x4*)(RWT + e * 1024 + 4 * lane + 256 * j); s += (x[j].x * wv.x + x[j].y * wv.y) + (x[j].z * wv.z + x[j].w * wv.w); }
            pv[e] = s; }
        { const bool hi = (lane & 32) != 0;
#pragma unroll
          for (int i = 0; i < 16; ++i) { const float a = pv[i], b = pv[i + 16]; const float send = hi ? a : b, keep = hi ? b : a; pv[i] = keep + __shfl_xor(send, 32); } }
        { const bool hi = (lane & 16) != 0;
#pragma unroll
          for (int i = 0; i < 8; ++i) { const float a = pv[i], b = pv[i + 8]; const float send = hi ? a : b, keep = hi ? b : a; pv[i] = keep + __shfl_xor(send, 16); } }
        { const bool hi = (lane & 8) != 0;
#pragma unroll
          for (int i = 0; i < 4; ++i) { const float a = pv[i], b = pv[i + 4]; const float send = hi ? a : b, keep = hi ? b : a; pv[i] = keep + __shfl_xor(send, 8); } }
        { const bool hi = (lane & 4) != 0;
#pragma unroll
          for (int i = 0; i < 2; ++i) { const float a = pv[i], b = pv[i + 2]; const float send = hi ? a : b, keep = hi ? b : a; pv[i] = keep + __shfl_xor(send, 4); } }
        { const bool hi = (lane & 2) != 0; const float a = pv[0], b = pv[1]; const float send = hi ? a : b, keep = hi ? b : a; pv[0] = keep + __shfl_xor(send, 2); }
        const float mine = pv[0] + __shfl_xor(pv[0], 1);
        float lg[32];
#pragma unroll
        for (int e = 0; e < 32; ++e) lg[e] = __shfl(mine, 2 * e) + rb[e];
        unsigned taken = 0u; int bidx[4]; float bval[4];
#pragma unroll
        for (int k = 0; k < 4; ++k) { float best = -INFINITY; int bi = 0;
#pragma unroll
            for (int e = 0; e < 32; ++e) { const bool c = (((taken >> e) & 1u) == 0u) && (lg[e] > best); best = c ? lg[e] : best; bi = c ? e : bi; }
            taken |= 1u << bi; bidx[k] = bi; bval[k] = best; }
        float ex[4], sum = 0.f;
#pragma unroll
        for (int k = 0; k < 4; ++k) { ex[k] = __expf(bval[k] - bval[0]); sum += ex[k]; }
        if (lane == 0) {
#pragma unroll
            for (int k = 0; k < 4; ++k) { const int lp = __hip_atomic_fetch_add((LAS int*)(F.lds + AX_LCNT) + bidx[k], 1, __ATOMIC_RELAXED, __HIP_MEMORY_SCOPE_WORKGROUP);
                LE[tl * 4 + k] = bidx[k]; LP[tl * 4 + k] = lp; aprob[(size_t)m * 4 + k] = ex[k] / sum; } }
    }
    __syncthreads();
    if (tid < 32) gbase[tid] = (int)__hip_atomic_fetch_add((unsigned*)(ws + WS_CTL) + CW_CNT + l * 64 + tid, (unsigned)lcnt[tid], __ATOMIC_RELAXED, __HIP_MEMORY_SCOPE_AGENT);
    __syncthreads();
    int* aexp = (int*)(ws + WS_AEXP); int* apos = (int*)(ws + WS_APOS);
    for (int i = tid; i < (te - tb) * 4; i += NTHREADS) { const int e = LE[i]; aexp[(size_t)tb * 4 + i] = e; apos[(size_t)tb * 4 + i] = gbase[e] + LP[i]; }
    __syncthreads();
}

__device__ __forceinline__ void phase_gather(const Frame& F, const Params& P, int l, int ntok) {
    unsigned char* ws = P.ws;
    volatile LAS int* TS = (volatile LAS int*)(F.lds + LC_TS);
    if (F.tid < 64) { const int e = F.lane & 31;
        const unsigned c = __hip_atomic_load((unsigned*)(ws + WS_CTL) + CW_CNT + l * 64 + e, __ATOMIC_RELAXED, __HIP_MEMORY_SCOPE_AGENT);
        int incl = (int)((c + 255u) >> 8);
#pragma unroll
        for (int o = 1; o < 32; o <<= 1) { const int v = __shfl_up(incl, o); if (e >= o) incl += v; }
        if (F.lane < 32) TS[e + 1] = incl;
        if (F.lane == 0) TS[0] = 0; }
    __syncthreads();
    const int gw = F.bid * NWAVES + F.wave, NGW = F.G * NWAVES;
    const int* aexp = (const int*)(ws + WS_AEXP); const int* apos = (const int*)(ws + WS_APOS); int* aslot = (int*)(ws + WS_ASLOT);
    const bf16_t* hb = (const bf16_t*)(ws + WS_HBUF); bf16_t* xb = (bf16_t*)(ws + WS_XB);
    for (int cidx = gw; cidx < ntok / 16; cidx += NGW) {
        const int a0 = cidx * 64; const int e = aexp[a0 + F.lane]; const int rowl = TS[e] * 256 + apos[a0 + F.lane];
        aslot[a0 + F.lane] = rowl;
#pragma unroll 1
        for (int t4 = 0; t4 < 16; t4 += 4) {
            u32x4 v0[4], v1[4];
#pragma unroll
            for (int q = 0; q < 4; ++q) { const u32x4* src = (const u32x4*)(hb + (size_t)(a0 / 4 + t4 + q) * D); v0[q] = src[F.lane]; v1[q] = src[F.lane + 64]; }
#pragma unroll
            for (int q = 0; q < 4; ++q)
#pragma unroll
                for (int k = 0; k < 4; ++k) { const int row = __shfl(rowl, (t4 + q) * 4 + k); u32x4* dst = (u32x4*)(xb + (size_t)row * D); dst[F.lane] = v0[q]; dst[F.lane + 64] = v1[q]; }
        }
    }
}

__device__ __forceinline__ void phase_combine(const Frame& F, const Params& P, int l, int ntok, bool last) {
    unsigned char* ws = P.ws;
    const int gw = F.bid * NWAVES + F.wave, NGW = F.G * NWAVES, lane = F.lane;
    float* xres = (float*)(ws + WS_XRES); const bf16_t* yb = (const bf16_t*)(ws + WS_YB);
    const int* aslot = (const int*)(ws + WS_ASLOT); const float* aprob = (const float*)(ws + WS_APROB);
    int sl_n[4]; float pr_n[4];
    if (gw < ntok) {
#pragma unroll
        for (int k = 0; k < 4; ++k) { sl_n[k] = aslot[(size_t)gw * 4 + k]; pr_n[k] = aprob[(size_t)gw * 4 + k]; } }
    for (int m = gw; m < ntok; m += NGW) {
        const int v = (m >= NLAT) ? 2 : (m >= SEQ ? 1 : 0);
        const float* mf = (const float*)(ws + WS_MODF) + ((size_t)l * 3 + v) * 6144;
        int sl[4]; float pr[4];
#pragma unroll
        for (int k = 0; k < 4; ++k) { sl[k] = sl_n[k]; pr[k] = pr_n[k]; }
        u32x2 wv[4][4]; f32x4 xo[4], g5[4];
#pragma unroll
        for (int k = 0; k < 4; ++k)
#pragma unroll
            for (int j = 0; j < 4; ++j) wv[k][j] = *(const u32x2*)(yb + (size_t)sl[k] * D + 4 * lane + 256 * j);
#pragma unroll
        for (int j = 0; j < 4; ++j) { const int c = 4 * lane + 256 * j; xo[j] = *(const f32x4*)(xres + (size_t)m * D + c); g5[j] = *(const f32x4*)(mf + 5 * 1024 + c); }
        if (m + NGW < ntok) {
#pragma unroll
            for (int k = 0; k < 4; ++k) { sl_n[k] = aslot[(size_t)(m + NGW) * 4 + k]; pr_n[k] = aprob[(size_t)(m + NGW) * 4 + k]; } }
        f32x4 y[4];
#pragma unroll
        for (int j = 0; j < 4; ++j) y[j] = (f32x4){0.f, 0.f, 0.f, 0.f};
#pragma unroll
        for (int k = 0; k < 4; ++k)
#pragma unroll
            for (int j = 0; j < 4; ++j) y[j] += (f32x4){bflo(wv[k][j].x), bfhi(wv[k][j].x), bflo(wv[k][j].y), bfhi(wv[k][j].y)} * pr[k];
        f32x4 x[4];
#pragma unroll
        for (int j = 0; j < 4; ++j) x[j] = xo[j] + g5[j] * y[j];
        if (!last) {
#pragma unroll
            for (int j = 0; j < 4; ++j) *(f32x4*)(xres + (size_t)m * D + 4 * lane + 256 * j) = x[j];
            const float* mn = (const float*)(ws + WS_MODF) + ((size_t)(l + 1) * 3 + v) * 6144;
            norm_row_store(x, P.in[4] + (size_t)(l + 1) * D, mn, mn + 1024, (bf16_t*)(ws + WS_HBUF) + (size_t)m * D, lane, false, P, 0, 0);
        } else {
            float ss = 0.f;
#pragma unroll
            for (int j = 0; j < 4; ++j) ss += (x[j].x * x[j].x + x[j].y * x[j].y) + (x[j].z * x[j].z + x[j].w * x[j].w);
            const float rstd = 1.0f / sqrtf(wave_sum(ss) * (1.0f / D) + NORM_EPS);
#pragma unroll
            for (int j = 0; j < 4; ++j) { const int c = 4 * lane + 256 * j; *(f32x4*)(P.out + (size_t)m * D + c) = (x[j] * rstd) * *(const f32x4*)(P.in[25] + c); }
        }
    }
}

#ifndef REP_PRO
#define REP_PRO 1
#endif
#ifndef REP_GEMM1
#define REP_GEMM1 1
#endif
#ifndef REP_G1U
#define REP_G1U 1
#endif
#ifndef REP_F1U
#define REP_F1U 1
#endif
#ifndef REP_CONV
#define REP_CONV 1
#endif
#ifndef REP_F2U
#define REP_F2U 1
#endif
#ifndef REP_G3U
#define REP_G3U 1
#endif
#ifndef REP_GU
#define REP_GU 1
#endif
#ifndef REP_DN
#define REP_DN 1
#endif
#ifndef REP_GATH
#define REP_GATH 1
#endif
__global__ void __launch_bounds__(NTHREADS, 2) mega_fwd(Params P0) {
    extern __shared__ __attribute__((aligned(16))) unsigned char lds_raw[];
    Frame F0; F0.lds = (LAS unsigned char*)lds_raw; F0.tid = threadIdx.x; F0.lane = F0.tid & 63; F0.wave = __builtin_amdgcn_readfirstlane(F0.tid >> 6); F0.G = gridDim.x; F0.bid = blockIdx.x;
#define KAS __attribute__((address_space(4)))
    struct ParamsK { const GAS float* in[26]; GAS float* out; GAS unsigned char* ws; };
#define PHASE_ENV() Frame F = F0; asm volatile("" : "+v"(F.tid)); F.lane = F.tid & 63; F.wave = __builtin_amdgcn_readfirstlane(F.tid >> 6); asm volatile("" : "+s"(F.bid), "+s"(F.G)); \
    const KAS ParamsK* kp_ = (const KAS ParamsK*)__builtin_amdgcn_kernarg_segment_ptr(); asm volatile("" : "+s"(kp_)); Params P; \
    _Pragma("unroll") for (int i_ = 0; i_ < 26; ++i_) P.in[i_] = (const float*)kp_->in[i_]; \
    P.out = (float*)kp_->out; P.ws = (unsigned char*)kp_->ws; unsigned char* ws = P.ws; (void)ws;
    { PHASE_ENV();
    for (int u = F.tid; u < (LDS_BYTES - LCTL_OFF) / 4; u += NTHREADS) ((LAS unsigned*)(F.lds + LCTL_OFF))[u] = 0u;
    __syncthreads();
    }
    { PHASE_ENV(); (void)xcd_barrier_post((unsigned*)(ws + WS_CTL) + CW_BAR, (volatile LAS unsigned*)(F.lds + LC_BAR)); }
#define GRID_BAR() do { PHASE_ENV(); XcdBarrier b_; b_.bar = (unsigned*)(ws + WS_CTL) + CW_BAR; b_.x = xb_xcc_id(); b_.st = (volatile LAS unsigned*)(F.lds + LC_BAR); xcd_barrier(b_); } while (0)

    for (int rep = 0; rep < REP_PRO; ++rep) { PHASE_ENV(); phase_prologue(F, P); }
    GRID_BAR();
    { PHASE_ENV(); phase_p1(F, P); }
    GRID_BAR();

    for (int l = 0; l < DEPTH; ++l) {
        const bool last = (l == DEPTH - 1);
        for (int rep = 0; rep < REP_GEMM1; ++rep) { PHASE_ENV(); pg8::Gemm g{(const bf16_t*)(ws + WS_HBUF), (const bf16_t*)(ws + WS_WIN) + (size_t)l * INP * D, NTOK, INP, D};
          pg8::StaticOrder S; S.init(NTOK, INP, F.G, F.bid);
          pg8::EpiStoreBf16 E{(bf16_t*)(ws + WS_PBUF), INP};
          pg8::gemm_phase<pg8::EpiStoreBf16, pg8::StaticOrder>(F.lds, g, S, E, F.tid); }
        GRID_BAR();
        for (int rep = 0; rep < REP_G1U; ++rep) { PHASE_ENV();
        for (int u = F.bid; u < 2080; u += F.G) { int row0, h;
            if (u < 2048) { const int bh = u >> 8, n = u & 255; h = bh & 3; row0 = (bh >> 2) * SEQ + 64 * n; }
            else { const int q = u - 2048, bh = q >> 2, n = q & 3; h = bh & 3; row0 = NLAT + (bh >> 2) * CTXL + 64 * n; }
            gla_g1_unit(F, P, l, row0, h, u); }
        __syncthreads(); }
        for (int rep = 0; rep < REP_F1U; ++rep) { PHASE_ENV();
        for (int u = F.bid; u < 1024; u += F.G) { const int b = u >> 9, nlo = (u >> 2) & 127, h = u & 3;
            fourier_f1_unit<128, 3>(F, P, b * SEQ + nlo, 128, h, (const bf16_t*)(ws + WS_TLAT) + (size_t)nlo * 32768, b * SEQ + nlo, 1.0f); }
        }
        { PHASE_ENV();
        if (!last) for (int u = F.bid; u < 8; u += F.G) { const int b = u >> 2, h = u & 3;
            fourier_f1_unit<256, 2>(F, P, NLAT + b * CTXL, 1, h, (const bf16_t*)(ws + WS_TCTX), NLAT + b * CTXL, 1.0f / 128.0f); }
        }
        for (int rep = 0; rep < REP_CONV; ++rep) { PHASE_ENV();
        for (int u = F.bid; u < (last ? 512 : 520); u += F.G) {
            if (u < 512) conv_unit(F, P, l, 64 * u, 64, 0);
            else { const int q = u - 512; conv_unit(F, P, l, NLAT + (q >> 2) * CTXL, CTXL, 64 * (q & 3)); } } }
        GRID_BAR();
        { PHASE_ENV(); gla_scan(F, P); }
        for (int rep = 0; rep < REP_F2U; ++rep) { PHASE_ENV();
        fourier_f2_tables(F, P);
        for (int u = F.bid; u < 512; u += F.G) fourier_f2_unit(F, P, u >> 8, (u >> 1) & 127, u & 1); }
        GRID_BAR();
        for (int rep = 0; rep < REP_G3U; ++rep) { PHASE_ENV();
        for (int u = F.bid; u < (last ? 2048 : 2080); u += F.G) { int row0, h;
            if (u < 2048) { const int bh = u >> 8, n = u & 255; h = bh & 3; row0 = (bh >> 2) * SEQ + 64 * n; }
            else { const int q = u - 2048, bh = q >> 2, n = q & 3; h = bh & 3; row0 = NLAT + (bh >> 2) * CTXL + 64 * n; }
            gla_g3_unit(F, P, l, row0, h, u); }
        __syncthreads(); }
        GRID_BAR();
        { PHASE_ENV(); const int M2 = last ? NLAT : NTOK;
          pg8::Gemm g{(const bf16_t*)(ws + WS_CAT), (const bf16_t*)(ws + WS_WOUT) + (size_t)l * D * D, M2, D, D};
          pg8::StaticOrder S; S.init(M2, D, F.G, F.bid);
          pg8::EpiResid E{(float*)(ws + WS_XRES), (const float*)(ws + WS_MODF) + (size_t)l * 3 * 6144};
          pg8::gemm_phase<pg8::EpiResid, pg8::StaticOrder>(F.lds, g, S, E, F.tid); }
        GRID_BAR();
        const int ntok = last ? NLAT : NTOK;
        { PHASE_ENV(); phase_route(F, P, l, ntok); }
        GRID_BAR();
        for (int rep = 0; rep < REP_GATH; ++rep) { PHASE_ENV(); phase_gather(F, P, l, ntok); }
        GRID_BAR();
        for (int rep = 0; rep < REP_GU; ++rep) { PHASE_ENV(); const volatile LAS int* TS = (const volatile LAS int*)(F.lds + LC_TS);
          pg8::Gemm g{(const bf16_t*)(ws + WS_XB), (const bf16_t*)(ws + WS_WGU) + (size_t)l * NE * 2048 * D, 0, 2048, D};
          pg8::MoeOrder S{8, F.G, F.bid, TS[NE], TS};
          pg8::EpiGateUp E{(bf16_t*)(ws + WS_ACT), P.in[22] + (size_t)l * NE * 2048};
          pg8::gemm_phase<pg8::EpiGateUp, pg8::MoeOrder>(F.lds, g, S, E, F.tid); }
        GRID_BAR();
        for (int rep = 0; rep < REP_DN; ++rep) { PHASE_ENV(); const volatile LAS int* TS = (const volatile LAS int*)(F.lds + LC_TS);
          pg8::Gemm g{(const bf16_t*)(ws + WS_ACT), (const bf16_t*)(ws + WS_WDN) + (size_t)l * NE * D * DFF, 0, D, DFF};
          pg8::MoeOrder S{4, F.G, F.bid, TS[NE], TS};
          pg8::EpiDown E{(bf16_t*)(ws + WS_YB), P.in[24] + (size_t)l * NE * D};
          pg8::gemm_phase<pg8::EpiDown, pg8::MoeOrder>(F.lds, g, S, E, F.tid); }
        GRID_BAR();
        { PHASE_ENV(); phase_combine(F, P, l, ntok, last); }
        if (!last) GRID_BAR();
    }
}

extern "C" void kernel_launch(void* const* d_in, const int* in_sizes, int n_in, void* d_out, int out_size, void* d_ws, size_t ws_size, hipStream_t stream) {
    static int grid = 0;
    if (grid == 0) {
        if (n_in != 26 || ws_size < WS_END) { fprintf(stderr, "kernel_launch: unexpected n_in %d or ws_size %zu (need %zu)\n", n_in, ws_size, (size_t)WS_END); grid = -1; return; }
        int dev = 0, cus = 0, per_cu = 0;
        if (hipGetDevice(&dev) != hipSuccess || hipDeviceGetAttribute(&cus, hipDeviceAttributeMultiprocessorCount, dev) != hipSuccess) { grid = -1; return; }
        if (hipFuncSetAttribute((const void*)mega_fwd, hipFuncAttributeMaxDynamicSharedMemorySize, LDS_BYTES) != hipSuccess) { fprintf(stderr, "kernel_launch: hipFuncSetAttribute failed\n"); grid = -1; return; }
        if (hipOccupancyMaxActiveBlocksPerMultiprocessor(&per_cu, (const void*)mega_fwd, NTHREADS, LDS_BYTES) != hipSuccess || per_cu < 1) { fprintf(stderr, "kernel_launch: occupancy query says %d\n", per_cu); }
        (void)hipGetLastError();
        grid = cus;
    }
    if (grid < 0) return;
    (void)hipMemsetAsync((char*)d_ws + WS_CTL, 0, CTL_ZERO_BYTES, stream);
    Params p{};
    for (int i = 0; i < 26; ++i) p.in[i] = (const float*)d_in[i];
    p.out = (float*)d_out; p.ws = (unsigned char*)d_ws;
    hipLaunchKernelGGL(mega_fwd, dim3(grid), dim3(NTHREADS), LDS_BYTES, stream, p);
}
```

```cpp
#include <hip/hip_runtime.h>
#include <cstdio>
#include <cstdint>

#define LAS __attribute__((address_space(3)))
#define GAS __attribute__((address_space(1)))
typedef unsigned short bf16_t;
typedef short bf16x8 __attribute__((ext_vector_type(8)));
typedef float f32x4 __attribute__((ext_vector_type(4)));
typedef float f32x2 __attribute__((ext_vector_type(2)));
typedef unsigned u32x4 __attribute__((ext_vector_type(4)));
typedef unsigned u32x2 __attribute__((ext_vector_type(2)));

constexpr int D = 1024, NBATCH = 2, SEQ = 16384, NLAT = NBATCH * SEQ, CTXL = 256, NCTX = NBATCH * CTXL, NTOK = NLAT + NCTX, DEPTH = 2;
constexpr int INW = 2336, INP = 2560;
constexpr int C_FOUR = 0, C_Q = 256, C_K = 512, C_V = 768, C_R = 1280, C_GF = 1792, C_GB = 1808, C_CA = 1824, C_CG = 2080;
constexpr int NE = 32, TOPK = 4, DFF = 1024;
constexpr int MAXROWS = NTOK * TOPK + NE * 256;
constexpr float NORM_EPS = 1e-6f;
constexpr int NTHREADS = 512, NWAVES = 8;

constexpr size_t MiB = 1u << 20;
constexpr size_t WS_CTL = 0, CTL_ZERO_BYTES = 1 * MiB;
constexpr size_t WS_MODP = 1 * MiB;
constexpr size_t WS_MODF = 3 * MiB;
constexpr size_t WS_RW = 3 * MiB + 512 * 1024;
constexpr size_t WS_CM3 = 4 * MiB;
constexpr size_t WS_TF2 = 4 * MiB + 65536;
constexpr size_t WS_TCTX = 4 * MiB + 262144;
constexpr size_t WS_TLAT = 5 * MiB;
constexpr size_t WS_WIN = 13 * MiB;
constexpr size_t WS_WOUT = 23 * MiB;
constexpr size_t WS_WGU = 27 * MiB;
constexpr size_t WS_WDN = 283 * MiB;
constexpr size_t WS_XRES = 411 * MiB;
constexpr size_t WS_HBUF = 541 * MiB;
constexpr size_t WS_PBUF = 606 * MiB;
constexpr size_t WS_CAT = 769 * MiB;
constexpr size_t WS_T2 = 834 * MiB;
constexpr size_t WS_STATE = 866 * MiB;
constexpr size_t WS_DECAY = 996 * MiB;
constexpr size_t WS_AEXP = 998 * MiB, WS_APOS = 999 * MiB, WS_APROB = 1000 * MiB, WS_ASLOT = 1001 * MiB;
constexpr size_t WS_XB = 1002 * MiB, WS_ACT = 1278 * MiB, WS_YB = 1554 * MiB, WS_END = 1830 * MiB;
constexpr int CW_BAR = 4096, CW_CNT = 16384;

constexpr int RING_BYTES = 131072;
constexpr int AUX_OFF = RING_BYTES;
constexpr int LCTL_OFF = RING_BYTES + 8192;
constexpr int LDS_BYTES = 147456;

__device__ __forceinline__ unsigned f2bf(float f) { unsigned u = __builtin_bit_cast(unsigned, f); return (u + 0x7fffu + ((u >> 16) & 1u)) >> 16; }
__device__ __forceinline__ unsigned pk2(float lo, float hi) { return f2bf(lo) | (f2bf(hi) << 16); }
__device__ __forceinline__ float bf2f(unsigned b) { return __builtin_bit_cast(float, b << 16); }
__device__ __forceinline__ float bflo(unsigned w) { return __builtin_bit_cast(float, w << 16); }
__device__ __forceinline__ float bfhi(unsigned w) { return __builtin_bit_cast(float, w & 0xffff0000u); }
__device__ __forceinline__ float wave_sum(float v) {
#pragma unroll
    for (int o = 1; o < 64; o <<= 1) v += __shfl_xor(v, o);
    return v;
}
__device__ __forceinline__ float sigmoidf_(float x) { return __builtin_amdgcn_rcpf(1.0f + __expf(-x)); }

#define XB_TMO      128
#define XB_XCNT(j)  (256  + 64 * (j))
#define XB_XSUB(j)  (1280 + 64 * (j))
#define XB_XGEN(j)  (2304 + 64 * (j))
#define XB_TOP      3328
#define XB_TOPGEN   3392
#define XCD_BAR_WORDS 3456
#define XB_SPIN_CAP (1u << 22)

__device__ __forceinline__ unsigned xb_ld(unsigned* p)              { return __hip_atomic_load(p, __ATOMIC_RELAXED, __HIP_MEMORY_SCOPE_AGENT); }
__device__ __forceinline__ unsigned xb_add(unsigned* p, unsigned v) { return __hip_atomic_fetch_add(p, v, __ATOMIC_RELAXED, __HIP_MEMORY_SCOPE_AGENT); }
__device__ __forceinline__ unsigned xb_xcc_id() { return (unsigned)__builtin_amdgcn_s_getreg((3 << 11) | 20) & 0xFu; }
#define XB_SPIN(cond, bar) do { unsigned _sp = 0; while (cond) { __builtin_amdgcn_s_sleep(1); \
    if ((++_sp & 255u) == 0u) { if (xb_ld(&(bar)[XB_TMO])) break; if (_sp > XB_SPIN_CAP) { atomicAdd(&(bar)[XB_TMO], 1u); break; } } } } while (0)

struct XcdBarrier { unsigned* bar; unsigned x; volatile LAS unsigned* st; };

__device__ __forceinline__ XcdBarrier xcd_barrier_post(unsigned* bar, volatile LAS unsigned* st) {
    XcdBarrier b; b.bar = bar; b.x = xb_xcc_id(); b.st = st;
    if (threadIdx.x == 0) (void)xb_add(&bar[XB_XCNT(b.x)], 1u);
    return b;
}
__device__ __forceinline__ void xcd_barrier_complete(unsigned* bar, unsigned x, unsigned& nloc, unsigned& nx) {
    const unsigned G = gridDim.x * gridDim.y * gridDim.z;
    unsigned sum, cnt, mine, sp = 0u;
    for (;;) {
        sum = 0u; cnt = 0u; mine = 0u;
#pragma unroll
        for (unsigned j = 0; j < 16; ++j) { const unsigned c = xb_ld(&bar[XB_XCNT(j)]); sum += c; cnt += (c > 0u) ? 1u : 0u; mine = (j == x) ? c : mine; }
        if (sum == G) break;
        __builtin_amdgcn_s_sleep(1);
        if ((++sp & 255u) == 0u) { if (xb_ld(&bar[XB_TMO])) break; if (sp > XB_SPIN_CAP) { atomicAdd(&bar[XB_TMO], 1u); break; } }
    }
    nloc = mine > 0u ? mine : 1u; nx = cnt > 0u ? cnt : 1u;
}
__device__ __forceinline__ void xcd_barrier(const XcdBarrier& b) {
    asm volatile("s_waitcnt vmcnt(0)" ::: "memory");
    __syncthreads();
    if (threadIdx.x == 0) {
        unsigned* bar = b.bar;
        __builtin_amdgcn_s_waitcnt(0);
        unsigned nloc = b.st[0], nx = b.st[1];
        if (nloc == 0u) { xcd_barrier_complete(bar, b.x, nloc, nx); b.st[0] = nloc; b.st[1] = nx; }
        const unsigned old = xb_add(&bar[XB_XSUB(b.x)], 1u);
        const unsigned gen = old / nloc;
        if (old + 1u == (gen + 1u) * nloc) {
            __builtin_amdgcn_fence(__ATOMIC_RELEASE, "agent");
            asm volatile("s_waitcnt vmcnt(0)" ::: "memory");
            const unsigned og = xb_add(&bar[XB_TOP], 1u);
            const unsigned tg = og / nx;
            if (og + 1u == (tg + 1u) * nx) xb_add(&bar[XB_TOPGEN], 1u);
            else XB_SPIN(xb_ld(&bar[XB_TOPGEN]) == tg, bar);
            __builtin_amdgcn_fence(__ATOMIC_ACQUIRE, "agent");
            xb_add(&bar[XB_XGEN(b.x)], 1u);
            asm volatile("s_waitcnt vmcnt(0)" ::: "memory");
        } else {
            XB_SPIN(xb_ld(&bar[XB_XGEN(b.x)]) == gen, bar);
            __builtin_amdgcn_fence(__ATOMIC_ACQUIRE, "agent");
            asm volatile("s_waitcnt vmcnt(0)" ::: "memory");
        }
    }
    __syncthreads();
}

namespace pg8 {
constexpr int BM = 256, BK = 64, HALF = 128, HTB = HALF * BK * 2, STAGE_BYTES = 8 * HTB, NXCD = 8, WGM = 8;
__host__ __device__ __forceinline__ int lds_byte(int r, int c) { const int st = (r >> 4) * 2 + (c >> 5), rr = r & 15, cc = c & 31, ob = rr * 64 + cc * 2; return st * 1024 + (ob ^ (((ob >> 9) & 1) << 5)); }
__host__ __device__ __forceinline__ void stage_rc(int b, int& R, int& C) { const int st = b / 1024, sb = b % 1024, swz = sb ^ (((sb >> 9) & 1) << 5); R = (st >> 1) * 16 + swz / 64; C = (st & 1) * 32 + (swz % 64) / 2; }
__host__ __device__ __forceinline__ int perm32(int rho) { const int n = rho >> 4, i = rho & 15; return 8 * (i >> 2) + 4 * n + (i & 3); }

struct Unit { int pm, pn, lbase, nvalid; };
struct Gemm { const bf16_t* A; const bf16_t* Bt; int M, N, K; };

struct StaticOrder {
    int nM, nN, nwg, G, c;
    __device__ void init(int M, int N, int G_, int c_) { nM = M / BM; nN = N / BM; nwg = nM * nN; G = G_; c = c_; }
    __device__ bool next(int i, Unit& u) const {
        const long L = (long)i * G + c; if (L >= nwg) return false;
        int wgid = (int)L; { const int q = nwg / NXCD, r = nwg % NXCD, xcd = wgid % NXCD, off = wgid / NXCD; wgid = (xcd < r ? xcd * (q + 1) : r * (q + 1) + (xcd - r) * q) + off; }
        const int nig = WGM * nN, gid = wgid / nig, fm = gid * WGM, gsz = (nM - fm) < WGM ? (nM - fm) : WGM;
        u.pm = fm + ((wgid % nig) % gsz); u.pn = (wgid % nig) / gsz; u.lbase = 0; u.nvalid = 0; return true;
    }
};
struct MoeOrder {
    int nN, G, c, MT; const volatile LAS int* ts;
    __device__ bool next(int i, Unit& u) const {
        const long L = (G % 8 == 0) ? ((long)i * G + (long)(c & 7) * (G >> 3) + (c >> 3)) : ((long)i * G + c);
        if (L >= (long)MT * nN) return false;
        const int mt = (int)(L / nN), pl = (int)(L % nN);
        const int lane = threadIdx.x & 63;
        const unsigned long long bal = __ballot(lane >= 1 && lane < NE && ts[lane] <= mt);
        const int e = __popcll(bal);
        const int j = mt - ts[e];
        u.pm = mt; u.pn = e * nN + pl; u.lbase = e * NTOK + j * 256; u.nvalid = ts[64 + e] - j * 256; return true;
    }
};

__device__ __forceinline__ unsigned cvt_pk_bf16(float lo, float hi) { unsigned r; asm volatile("v_cvt_pk_bf16_f32 %0, %1, %2" : "=v"(r) : "v"(lo), "v"(hi)); return r; }

struct EpiStoreBf16 {
    static constexpr bool PERM = true;
    bf16_t* O; int ldc;
    __device__ __forceinline__ void operator()(const f32x4 (&acc)[2][2][4][2], const Unit& u, int wr, int wc, int fr, int fq) const {
        const int row0 = u.pm * BM + wr * 64 + fr; const int col0 = u.pn * BM + wc * 32 + 8 * fq;
#pragma unroll
        for (int ai = 0; ai < 2; ++ai)
#pragma unroll
            for (int m = 0; m < 4; ++m) { bf16_t* rowp = O + (size_t)(row0 + ai * HALF + m * 16) * ldc + col0;
#pragma unroll
                for (int bj = 0; bj < 2; ++bj) { const f32x4 v0 = acc[ai][bj][m][0], v1 = acc[ai][bj][m][1];
                    u32x4 w; w.x = cvt_pk_bf16(v0[0], v0[1]); w.y = cvt_pk_bf16(v0[2], v0[3]); w.z = cvt_pk_bf16(v1[0], v1[1]); w.w = cvt_pk_bf16(v1[2], v1[3]);
                    *(u32x4*)(rowp + bj * HALF) = w; } }
    }
};
struct EpiResid {
    static constexpr bool PERM = false;
    float* X; const float* modf;
    __device__ __forceinline__ void operator()(const f32x4 (&acc)[2][2][4][2], const Unit& u, int wr, int wc, int fr, int fq) const {
        const int row0 = u.pm * BM + wr * 64 + fr, col0 = u.pn * BM + wc * 32 + 4 * fq;
        const int v = (u.pm >= NLAT / BM) ? 2 : (u.pm >= SEQ / BM ? 1 : 0);
        const float* gv = modf + (size_t)v * 6144 + 2 * 1024;
        f32x4 bv[2][2];
#pragma unroll
        for (int bj = 0; bj < 2; ++bj)
#pragma unroll
            for (int n = 0; n < 2; ++n) bv[bj][n] = *(const f32x4*)(gv + col0 + bj * HALF + n * 16);
#pragma unroll
        for (int ai = 0; ai < 2; ++ai) {
            f32x4 xv[4][2][2];
#pragma unroll
            for (int m = 0; m < 4; ++m) { const float* rowp = X + (size_t)(row0 + ai * HALF + m * 16) * D + col0;
#pragma unroll
                for (int bj = 0; bj < 2; ++bj)
#pragma unroll
                    for (int n = 0; n < 2; ++n) xv[m][bj][n] = *(const f32x4*)(rowp + bj * HALF + n * 16); }
#pragma unroll
            for (int m = 0; m < 4; ++m) { float* rowp = X + (size_t)(row0 + ai * HALF + m * 16) * D + col0;
#pragma unroll
                for (int bj = 0; bj < 2; ++bj)
#pragma unroll
                    for (int n = 0; n < 2; ++n) *(f32x4*)(rowp + bj * HALF + n * 16) = xv[m][bj][n] + bv[bj][n] * acc[ai][bj][m][n]; }
        }
    }
};
struct EpiGateUp {
    static constexpr bool PERM = true;
    bf16_t* O; const float* bgu;
    __device__ __forceinline__ void operator()(const f32x4 (&acc)[2][2][4][2], const Unit& u, int wr, int wc, int fr, int fq) const {
        const int e = u.pn >> 3, pl = u.pn & 7;
        const int row0 = u.pm * BM + wr * 64 + fr; const int cl = pl * 128 + wc * 32 + 8 * fq;
        const float* bg = bgu + (size_t)e * 2048 + cl; const float* bu = bg + 1024;
        f32x4 g0 = *(const f32x4*)bg, g1 = *(const f32x4*)(bg + 4), u0 = *(const f32x4*)bu, u1 = *(const f32x4*)(bu + 4);
#pragma unroll
        for (int ai = 0; ai < 2; ++ai)
#pragma unroll
            for (int m = 0; m < 4; ++m) { bf16_t* rowp = O + (size_t)(row0 + ai * HALF + m * 16) * DFF + cl;
                float r[8];
#pragma unroll
                for (int n = 0; n < 2; ++n) { const f32x4 gb = n ? g1 : g0, ub = n ? u1 : u0; const f32x4 ga = acc[ai][0][m][n] + gb, ua = acc[ai][1][m][n] + ub;
#pragma unroll
                    for (int j = 0; j < 4; ++j) { const float gate = fminf(ga[j], 7.0f), up = fminf(fmaxf(ua[j], -7.0f), 7.0f);
                        r[n * 4 + j] = gate * __builtin_amdgcn_rcpf(1.0f + __expf(-1.702f * gate)) * (up + 1.0f); } }
                u32x4 w; w.x = cvt_pk_bf16(r[0], r[1]); w.y = cvt_pk_bf16(r[2], r[3]); w.z = cvt_pk_bf16(r[4], r[5]); w.w = cvt_pk_bf16(r[6], r[7]);
                *(u32x4*)rowp = w; }
    }
};
struct EpiDown {
    static constexpr bool PERM = true;
    bf16_t* O; const float* bdn;
    __device__ __forceinline__ void operator()(const f32x4 (&acc)[2][2][4][2], const Unit& u, int wr, int wc, int fr, int fq) const {
        const int e = u.pn >> 2, pl = u.pn & 3;
        const int row0 = u.pm * BM + wr * 64 + fr; const int col0 = pl * BM + wc * 32 + 8 * fq;
        f32x4 bv[2][2];
#pragma unroll
        for (int bj = 0; bj < 2; ++bj)
#pragma unroll
            for (int n = 0; n < 2; ++n) bv[bj][n] = *(const f32x4*)(bdn + (size_t)e * 1024 + col0 + bj * HALF + 4 * n);
#pragma unroll
        for (int ai = 0; ai < 2; ++ai)
#pragma unroll
            for (int m = 0; m < 4; ++m) { bf16_t* rowp = O + (size_t)(row0 + ai * HALF + m * 16) * D + col0;
#pragma unroll
                for (int bj = 0; bj < 2; ++bj) { const f32x4 v0 = acc[ai][bj][m][0] + bv[bj][0], v1 = acc[ai][bj][m][1] + bv[bj][1];
                    u32x4 w; w.x = cvt_pk_bf16(v0[0], v0[1]); w.y = cvt_pk_bf16(v0[2], v0[3]); w.z = cvt_pk_bf16(v1[0], v1[1]); w.w = cvt_pk_bf16(v1[2], v1[3]);
                    *(u32x4*)(rowp + bj * HALF) = w; } }
    }
};

template <class Epi, class Sched, bool ALIGN_EPI = true, bool SP2 = true>
__device__ __forceinline__ void gemm_phase(LAS unsigned char* lds, const Gemm g, const Sched& S, const Epi& E, const int tid) {
    const int wid = __builtin_amdgcn_readfirstlane(tid >> 6), lane = tid & 63, wr = wid >> 2, wc = wid & 3, fr = lane & 15, fq = lane >> 4;
    const int K = g.K, nt = K / BK;
    unsigned voffA[2], voffB[2];
#pragma unroll
    for (int i = 0; i < 2; ++i) { int R, C; stage_rc(tid * 16 + i * 8192, R, C); const int Rb = Epi::PERM ? ((R & ~31) + perm32(R & 31)) : R;
        voffA[i] = (unsigned)(R * K + C) * 2u; voffB[i] = (unsigned)(Rb * K + C) * 2u; }
    const size_t kstep = (size_t)(BK * 2);
    const size_t hstep = (size_t)HALF * K * 2;
    const size_t tstep = 2 * hstep;
    const unsigned ldsw = (unsigned)wid * 1024u;
    const int aoff = lds_byte(wr * 64 + fr, fq * 8), boff = lds_byte(wc * 32 + fr, fq * 8);
#define PG8_SA(b, h) (((b) * 2 + (h)) * HTB)
#define PG8_SB(b, h) ((4 + (b) * 2 + (h)) * HTB)
#define PG8_STAGE(bufoff, gbase, voff) do { _Pragma("unroll") for (int _i = 0; _i < 2; ++_i) \
        __builtin_amdgcn_global_load_lds((const unsigned*)((const char*)(gbase) + (voff)[_i]), (LAS unsigned*)(lds + (bufoff) + ldsw + _i * 8192), 16, 0, 0); } while (0)
#define PG8_LDA(dst, b, h) do { _Pragma("unroll") for (int m = 0; m < 4; ++m) _Pragma("unroll") for (int k = 0; k < 2; ++k) dst[m][k] = *(const LAS bf16x8*)(lds + PG8_SA(b, h) + aoff + m * 2048 + k * 1024); } while (0)
#define PG8_LDB(dst, b, h) do { _Pragma("unroll") for (int n = 0; n < 2; ++n) _Pragma("unroll") for (int k = 0; k < 2; ++k) dst[n][k] = *(const LAS bf16x8*)(lds + PG8_SB(b, h) + boff + n * 2048 + k * 1024); } while (0)
#define PG8_MMA(ai, bj, At, Bt) do { __builtin_amdgcn_s_setprio(1); _Pragma("unroll") for (int m = 0; m < 4; ++m) _Pragma("unroll") for (int n = 0; n < 2; ++n) _Pragma("unroll") for (int k = 0; k < 2; ++k) \
        acc[ai][bj][m][n] = __builtin_amdgcn_mfma_f32_16x16x32_bf16(Bt[n][k], At[m][k], acc[ai][bj][m][n], 0, 0, 0); __builtin_amdgcn_s_setprio(0); } while (0)
#define PG8_WAIT_V(n) asm volatile("s_waitcnt vmcnt(" #n ")" ::: "memory")
#define PG8_WAIT_L(n) asm volatile("s_waitcnt lgkmcnt(" #n ")" ::: "memory")
#define PG8_BAR __builtin_amdgcn_s_barrier()
#define PG8_SCHED __builtin_amdgcn_sched_barrier(0)
    Unit cur, nxt; int ui = 0;
    if (!S.next(0, cur)) return;
    f32x4 acc[2][2][4][2];
#pragma unroll
    for (int a = 0; a < 2; ++a)
#pragma unroll
        for (int b = 0; b < 2; ++b)
#pragma unroll
            for (int m = 0; m < 4; ++m)
#pragma unroll
                for (int n = 0; n < 2; ++n) acc[a][b][m][n] = (f32x4){0.f, 0.f, 0.f, 0.f};
    bf16x8 At[4][2], B0[2][2], B1[2][2];
    const char* cA = (const char*)g.A + (size_t)cur.pm * tstep; const char* cB = (const char*)g.Bt + (size_t)cur.pn * tstep;
    if constexpr (SP2) {
        PG8_STAGE(PG8_SB(0, 0), cB, voffB); PG8_STAGE(PG8_SB(0, 1), cB + hstep, voffB); PG8_STAGE(PG8_SA(0, 0), cA, voffA); PG8_STAGE(PG8_SA(0, 1), cA + hstep, voffA);
        if (wr == 1) PG8_BAR;
        PG8_WAIT_V(2); PG8_BAR;
        PG8_STAGE(PG8_SB(1, 0), cB + kstep, voffB); PG8_STAGE(PG8_SA(1, 0), cA + kstep, voffA); PG8_STAGE(PG8_SB(1, 1), cB + hstep + kstep, voffB);
        PG8_WAIT_V(6); PG8_BAR;
    } else {
        PG8_STAGE(PG8_SB(0, 0), cB, voffB); PG8_STAGE(PG8_SA(0, 0), cA, voffA); PG8_STAGE(PG8_SB(0, 1), cB + hstep, voffB); PG8_STAGE(PG8_SA(0, 1), cA + hstep, voffA);
        if (wr == 1) PG8_BAR;
        PG8_WAIT_V(4); PG8_BAR;
        PG8_STAGE(PG8_SB(1, 0), cB + kstep, voffB); PG8_STAGE(PG8_SA(1, 0), cA + kstep, voffA); PG8_STAGE(PG8_SB(1, 1), cB + hstep + kstep, voffB);
        PG8_WAIT_V(6); PG8_BAR;
    }
    for (;;) {
        const bool has_next = S.next(ui + 1, nxt);
        const char* nA = has_next ? (const char*)g.A + (size_t)nxt.pm * tstep : cA; const char* nB = has_next ? (const char*)g.Bt + (size_t)nxt.pn * tstep : cB;
        for (int t = 0; t < nt; t += 2) {
            const bool last = (t == nt - 2);
            const char* a1 = cA + (size_t)(t + 1) * kstep;
            const char* a2 = last ? nA : cA + (size_t)(t + 2) * kstep; const char* b2 = last ? nB : cB + (size_t)(t + 2) * kstep;
            const char* a3 = a2 + kstep; const char* b3 = b2 + kstep;
            if constexpr (SP2) {
            PG8_LDB(B0, 0, 0); PG8_LDB(B1, 0, 1); PG8_SCHED; PG8_LDA(At, 0, 0); PG8_STAGE(PG8_SA(1, 1), a1 + hstep, voffA);
            PG8_WAIT_V(8); PG8_WAIT_L(0); PG8_BAR; PG8_MMA(0, 0, At, B0); PG8_MMA(0, 1, At, B1); PG8_BAR; PG8_SCHED;
            PG8_LDA(At, 0, 1); PG8_STAGE(PG8_SB(0, 0), b2, voffB); PG8_STAGE(PG8_SB(0, 1), b2 + hstep, voffB); PG8_STAGE(PG8_SA(0, 0), a2, voffA);
            PG8_WAIT_V(8); PG8_WAIT_L(0); PG8_BAR; PG8_MMA(1, 0, At, B0); PG8_MMA(1, 1, At, B1); PG8_BAR; PG8_SCHED;
            PG8_LDB(B0, 1, 0); PG8_LDB(B1, 1, 1); PG8_SCHED; PG8_LDA(At, 1, 0); PG8_STAGE(PG8_SA(0, 1), a2 + hstep, voffA);
            PG8_WAIT_V(8); PG8_WAIT_L(0); PG8_BAR; PG8_MMA(0, 0, At, B0); PG8_MMA(0, 1, At, B1); PG8_BAR; PG8_SCHED;
            PG8_LDA(At, 1, 1); PG8_STAGE(PG8_SB(1, 0), b3, voffB); PG8_STAGE(PG8_SB(1, 1), b3 + hstep, voffB); PG8_STAGE(PG8_SA(1, 0), a3, voffA);
            PG8_WAIT_V(8); PG8_WAIT_L(0); PG8_BAR; PG8_MMA(1, 0, At, B0); PG8_MMA(1, 1, At, B1); PG8_BAR; PG8_SCHED;
            } else {
            PG8_LDB(B0, 0, 0); PG8_SCHED; PG8_LDA(At, 0, 0); PG8_STAGE(PG8_SA(1, 1), a1 + hstep, voffA);
            PG8_WAIT_L(8); PG8_BAR; PG8_WAIT_L(0); PG8_MMA(0, 0, At, B0); PG8_BAR; PG8_SCHED;
            PG8_LDB(B1, 0, 1); PG8_STAGE(PG8_SB(0, 0), b2, voffB);
            PG8_BAR; PG8_WAIT_L(0); PG8_MMA(0, 1, At, B1); PG8_BAR;
            PG8_LDA(At, 0, 1); PG8_STAGE(PG8_SA(0, 0), a2, voffA);
            PG8_BAR; PG8_WAIT_L(0); PG8_MMA(1, 0, At, B0); PG8_BAR; PG8_SCHED;
            PG8_STAGE(PG8_SB(0, 1), b2 + hstep, voffB);
            PG8_WAIT_V(6); PG8_BAR; PG8_MMA(1, 1, At, B1); PG8_BAR;
            PG8_LDB(B0, 1, 0); PG8_SCHED; PG8_LDA(At, 1, 0); PG8_STAGE(PG8_SA(0, 1), a2 + hstep, voffA);
            PG8_WAIT_L(8); PG8_BAR; PG8_WAIT_L(0); PG8_MMA(0, 0, At, B0); PG8_BAR; PG8_SCHED;
            PG8_LDB(B1, 1, 1); PG8_STAGE(PG8_SB(1, 0), b3, voffB);
            PG8_BAR; PG8_WAIT_L(0); PG8_MMA(0, 1, At, B1); PG8_BAR;
            PG8_LDA(At, 1, 1); PG8_STAGE(PG8_SA(1, 0), a3, voffA);
            PG8_BAR; PG8_WAIT_L(0); PG8_MMA(1, 0, At, B0); PG8_BAR; PG8_SCHED;
            PG8_STAGE(PG8_SB(1, 1), b3 + hstep, voffB);
            PG8_WAIT_V(6); PG8_BAR; PG8_MMA(1, 1, At, B1); PG8_BAR;
            }
        }
        if constexpr (ALIGN_EPI) { if (wr == 0) PG8_BAR; }
        E(acc, cur, wr, wc, fr, fq);
        if (!has_next) break;
#pragma unroll
        for (int a = 0; a < 2; ++a)
#pragma unroll
            for (int b = 0; b < 2; ++b)
#pragma unroll
                for (int m = 0; m < 4; ++m)
#pragma unroll
                    for (int n = 0; n < 2; ++n) acc[a][b][m][n] = (f32x4){0.f, 0.f, 0.f, 0.f};
        cur = nxt; cA = nA; cB = nB; ++ui;
        if constexpr (ALIGN_EPI) { if (wr == 1) PG8_BAR; }
    }
    PG8_WAIT_V(0);
    if constexpr (!ALIGN_EPI) { if (wr == 0) PG8_BAR; }
    PG8_BAR;
#undef PG8_SA
#undef PG8_SB
#undef PG8_STAGE
#undef PG8_LDA
#undef PG8_LDB
#undef PG8_MMA
#undef PG8_WAIT_V
#undef PG8_WAIT_L
#undef PG8_BAR
#undef PG8_SCHED
}

template <class Epi, class Sched>
__device__ __forceinline__ void gemm_phase_gather(LAS unsigned char* lds, const Gemm g, const int* list, const Sched& S, const Epi& E, const int tid) {
    const int wid = __builtin_amdgcn_readfirstlane(tid >> 6), lane = tid & 63, wr = wid >> 2, wc = wid & 3, fr = lane & 15, fq = lane >> 4;
    const int K = g.K, nt = K / BK;
    unsigned voffB[2]; int rA[2]; unsigned cA2[2];
#pragma unroll
    for (int i = 0; i < 2; ++i) { int R, C; stage_rc(tid * 16 + i * 8192, R, C); const int Rb = Epi::PERM ? ((R & ~31) + perm32(R & 31)) : R;
        rA[i] = R; cA2[i] = (unsigned)C * 2u; voffB[i] = (unsigned)(Rb * K + C) * 2u; }
    const size_t kstep = (size_t)(BK * 2);
    const size_t hstep = (size_t)HALF * K * 2;
    const size_t tstep = 2 * hstep;
    const unsigned ldsw = (unsigned)wid * 1024u;
    const int aoff = lds_byte(wr * 64 + fr, fq * 8), boff = lds_byte(wc * 32 + fr, fq * 8);
#define PG8_SA(b, h) (((b) * 2 + (h)) * HTB)
#define PG8_SB(b, h) ((4 + (b) * 2 + (h)) * HTB)
#define PG8_STAGE(bufoff, gbase, voff) do { _Pragma("unroll") for (int _i = 0; _i < 2; ++_i) \
        __builtin_amdgcn_global_load_lds((const unsigned*)((const char*)(gbase) + (voff)[_i]), (LAS unsigned*)(lds + (bufoff) + ldsw + _i * 8192), 16, 0, 0); } while (0)
#define PG8_LDA(dst, b, h) do { _Pragma("unroll") for (int m = 0; m < 4; ++m) _Pragma("unroll") for (int k = 0; k < 2; ++k) dst[m][k] = *(const LAS bf16x8*)(lds + PG8_SA(b, h) + aoff + m * 2048 + k * 1024); } while (0)
#define PG8_LDB(dst, b, h) do { _Pragma("unroll") for (int n = 0; n < 2; ++n) _Pragma("unroll") for (int k = 0; k < 2; ++k) dst[n][k] = *(const LAS bf16x8*)(lds + PG8_SB(b, h) + boff + n * 2048 + k * 1024); } while (0)
#define PG8_MMA(ai, bj, At, Bt) do { __builtin_amdgcn_s_setprio(1); _Pragma("unroll") for (int m = 0; m < 4; ++m) _Pragma("unroll") for (int n = 0; n < 2; ++n) _Pragma("unroll") for (int k = 0; k < 2; ++k) \
        acc[ai][bj][m][n] = __builtin_amdgcn_mfma_f32_16x16x32_bf16(Bt[n][k], At[m][k], acc[ai][bj][m][n], 0, 0, 0); __builtin_amdgcn_s_setprio(0); } while (0)
#define PG8_WAIT_V(n) asm volatile("s_waitcnt vmcnt(" #n ")" ::: "memory")
#define PG8_WAIT_L(n) asm volatile("s_waitcnt lgkmcnt(" #n ")" ::: "memory")
#define PG8_BAR __builtin_amdgcn_s_barrier()
#define PG8_SCHED __builtin_amdgcn_sched_barrier(0)
#define PG8_LOADTOK(u, vo) do { _Pragma("unroll") for (int _h = 0; _h < 2; ++_h) _Pragma("unroll") for (int _i = 0; _i < 2; ++_i) { const int _r = _h * HALF + rA[_i]; \
        const int _tok = (_r < (u).nvalid) ? list[(u).lbase + _r] : 0; (vo)[_h][_i] = (unsigned)_tok * (unsigned)(K * 2) + cA2[_i]; } } while (0)
    Unit cur, nxt; int ui = 0;
    if (!S.next(0, cur)) return;
    f32x4 acc[2][2][4][2];
#pragma unroll
    for (int a = 0; a < 2; ++a)
#pragma unroll
        for (int b = 0; b < 2; ++b)
#pragma unroll
            for (int m = 0; m < 4; ++m)
#pragma unroll
                for (int n = 0; n < 2; ++n) acc[a][b][m][n] = (f32x4){0.f, 0.f, 0.f, 0.f};
    bf16x8 At[4][2], B0[2][2], B1[2][2];
    unsigned vc[2][2], vn[2][2];
    PG8_LOADTOK(cur, vc);
    const char* gA = (const char*)g.A; const char* cB = (const char*)g.Bt + (size_t)cur.pn * tstep;
    PG8_STAGE(PG8_SB(0, 0), cB, voffB); PG8_STAGE(PG8_SB(0, 1), cB + hstep, voffB); PG8_STAGE(PG8_SA(0, 0), gA, vc[0]); PG8_STAGE(PG8_SA(0, 1), gA, vc[1]);
    if (wr == 1) PG8_BAR;
    PG8_WAIT_V(2); PG8_BAR;
    PG8_STAGE(PG8_SB(1, 0), cB + kstep, voffB); PG8_STAGE(PG8_SA(1, 0), gA + kstep, vc[0]); PG8_STAGE(PG8_SB(1, 1), cB + hstep + kstep, voffB);
    PG8_WAIT_V(6); PG8_BAR;
    for (;;) {
        const bool has_next = S.next(ui + 1, nxt);
        if (has_next) { PG8_LOADTOK(nxt, vn); }
        const char* nB = has_next ? (const char*)g.Bt + (size_t)nxt.pn * tstep : cB;
        for (int t = 0; t < nt; t += 2) {
            const bool last = (t == nt - 2);
            const char* a1 = gA + (size_t)(t + 1) * kstep;
            const char* b2 = last ? nB : cB + (size_t)(t + 2) * kstep; const char* b3 = b2 + kstep;
            const char* a2 = last ? gA : gA + (size_t)(t + 2) * kstep; const char* a3 = a2 + kstep;
            PG8_LDB(B0, 0, 0); PG8_LDB(B1, 0, 1); PG8_SCHED; PG8_LDA(At, 0, 0); PG8_STAGE(PG8_SA(1, 1), a1, vc[1]);
            if (last && has_next) {
#pragma unroll
                for (int _h = 0; _h < 2; ++_h)
#pragma unroll
                    for (int _i = 0; _i < 2; ++_i) vc[_h][_i] = vn[_h][_i]; }
            PG8_WAIT_V(8); PG8_WAIT_L(0); PG8_BAR; PG8_MMA(0, 0, At, B0); PG8_MMA(0, 1, At, B1); PG8_BAR; PG8_SCHED;
            PG8_LDA(At, 0, 1); PG8_STAGE(PG8_SB(0, 0), b2, voffB); PG8_STAGE(PG8_SB(0, 1), b2 + hstep, voffB); PG8_STAGE(PG8_SA(0, 0), a2, vc[0]);
            PG8_WAIT_V(8); PG8_WAIT_L(0); PG8_BAR; PG8_MMA(1, 0, At, B0); PG8_MMA(1, 1, At, B1); PG8_BAR; PG8_SCHED;
            PG8_LDB(B0, 1, 0); PG8_LDB(B1, 1, 1); PG8_SCHED; PG8_LDA(At, 1, 0); PG8_STAGE(PG8_SA(0, 1), a2, vc[1]);
            PG8_WAIT_V(8); PG8_WAIT_L(0); PG8_BAR; PG8_MMA(0, 0, At, B0); PG8_MMA(0, 1, At, B1); PG8_BAR; PG8_SCHED;
            PG8_LDA(At, 1, 1); PG8_STAGE(PG8_SB(1, 0), b3, voffB); PG8_STAGE(PG8_SB(1, 1), b3 + hstep, voffB); PG8_STAGE(PG8_SA(1, 0), a3, vc[0]);
            PG8_WAIT_V(8); PG8_WAIT_L(0); PG8_BAR; PG8_MMA(1, 0, At, B0); PG8_MMA(1, 1, At, B1); PG8_BAR; PG8_SCHED;
        }
        if (wr == 0) PG8_BAR;
        E(acc, cur, wr, wc, fr, fq);
        if (!has_next) break;
#pragma unroll
        for (int a = 0; a < 2; ++a)
#pragma unroll
            for (int b = 0; b < 2; ++b)
#pragma unroll
                for (int m = 0; m < 4; ++m)
#pragma unroll
                    for (int n = 0; n < 2; ++n) acc[a][b][m][n] = (f32x4){0.f, 0.f, 0.f, 0.f};
        cur = nxt; cB = nB; ++ui;
        if (wr == 1) PG8_BAR;
    }
    PG8_WAIT_V(0);
    PG8_BAR;
#undef PG8_SA
#undef PG8_SB
#undef PG8_STAGE
#undef PG8_LDA
#undef PG8_LDB
#undef PG8_MMA
#undef PG8_WAIT_V
#undef PG8_WAIT_L
#undef PG8_BAR
#undef PG8_SCHED
#undef PG8_LOADTOK
}
}

struct Params {
    const float* in[26];
    float* out;
    unsigned char* ws;
};
struct Frame {
    LAS unsigned char* lds;
    int tid, lane, wave, G, bid;
};

template <int MT, int NT>
__device__ __forceinline__ void mma_nt(f32x4 (&acc)[MT][NT], const LAS bf16_t* A, int lda, const LAS bf16_t* B, int ldb, int K, int fr, int fq) {
    for (int k0 = 0; k0 < K; k0 += 32) {
        bf16x8 a[MT], b[NT];
#pragma unroll
        for (int m = 0; m < MT; ++m) a[m] = *(const LAS bf16x8*)(A + (m * 16 + fr) * lda + k0 + fq * 8);
#pragma unroll
        for (int n = 0; n < NT; ++n) b[n] = *(const LAS bf16x8*)(B + (n * 16 + fr) * ldb + k0 + fq * 8);
#pragma unroll
        for (int m = 0; m < MT; ++m)
#pragma unroll
            for (int n = 0; n < NT; ++n) acc[m][n] = __builtin_amdgcn_mfma_f32_16x16x32_bf16(a[m], b[n], acc[m][n], 0, 0, 0);
    }
}
template <int MT, int NT> __device__ __forceinline__ void zero_acc(f32x4 (&acc)[MT][NT]) {
#pragma unroll
    for (int m = 0; m < MT; ++m)
#pragma unroll
        for (int n = 0; n < NT; ++n) acc[m][n] = (f32x4){0.f, 0.f, 0.f, 0.f};
}

__device__ __forceinline__ void p0_transpose_item(const float* W, int K, int N, bf16_t* WT, int k0, int n0, int orow0, LAS float* scr, int lane) {
    float tv[32];
#pragma unroll
    for (int i = 0; i < 32; ++i) { const int kk = 2 * i + (lane >> 5); tv[i] = W[(size_t)(k0 + kk) * N + n0 + (lane & 31)]; }
#pragma unroll
    for (int i = 0; i < 32; ++i) { const int kk = 2 * i + (lane >> 5); scr[kk * 33 + (lane & 31)] = tv[i]; }
    asm volatile("s_waitcnt lgkmcnt(0)" ::: "memory");
    const int c = lane & 7;
#pragma unroll
    for (int j = 0; j < 4; ++j) { const int n = (lane >> 3) + 8 * j; const LAS float* s = scr + (8 * c) * 33 + n;
        u32x4 o; o.x = pk2(s[0 * 33], s[1 * 33]); o.y = pk2(s[2 * 33], s[3 * 33]); o.z = pk2(s[4 * 33], s[5 * 33]); o.w = pk2(s[6 * 33], s[7 * 33]);
        *(u32x4*)(WT + (size_t)(orow0 + n) * K + k0 + 8 * c) = o; }
    asm volatile("s_waitcnt lgkmcnt(0)" ::: "memory");
}

__device__ __forceinline__ void phase_prologue(const Frame& F, const Params& P) {
    unsigned char* ws = P.ws;
    LAS float* scr = (LAS float*)(F.lds + F.wave * 16384);
    const int gw = F.bid * NWAVES + F.wave, NGW = F.G * NWAVES;
    constexpr int I_IN = 16 * 73, I_OUT = 16 * 32, I_GU = 16 * 64, I_DN = 16 * 32;
    constexpr int PER_LAYER = I_IN + I_OUT + NE * I_GU + NE * I_DN;
    for (int it = gw; it < DEPTH * PER_LAYER; it += NGW) {
        const int l = it / PER_LAYER; int r = it % PER_LAYER;
        if (r < I_IN) { const int kb = r / 73, nb = r % 73;
            p0_transpose_item(P.in[8] + (size_t)l * D * INW, D, INW, (bf16_t*)(ws + WS_WIN) + (size_t)l * INP * D, 64 * kb, 32 * nb, 32 * nb, scr, F.lane); continue; }
        r -= I_IN;
        if (r < I_OUT) { const int kb = r / 32, nb = r % 32;
            p0_transpose_item(P.in[18] + (size_t)l * D * D, D, D, (bf16_t*)(ws + WS_WOUT) + (size_t)l * D * D, 64 * kb, 32 * nb, 32 * nb, scr, F.lane); continue; }
        r -= I_OUT;
        if (r < NE * I_GU) { const int e = r / I_GU, q = r % I_GU, kb = q / 64, nb = q % 64; const int n0 = 32 * nb;
            const int j = n0 & 1023, orow = 256 * (j >> 7) + (n0 >= 1024 ? 128 : 0) + (j & 127);
            p0_transpose_item(P.in[21] + ((size_t)l * NE + e) * D * 2048, D, 2048, (bf16_t*)(ws + WS_WGU) + ((size_t)l * NE + e) * 2048 * D, 64 * kb, n0, orow, scr, F.lane); continue; }
        r -= NE * I_GU;
        { const int e = r / I_DN, q = r % I_DN, kb = q / 32, nb = q % 32;
            p0_transpose_item(P.in[23] + ((size_t)l * NE + e) * DFF * D, DFF, D, (bf16_t*)(ws + WS_WDN) + ((size_t)l * NE + e) * D * DFF, 64 * kb, 32 * nb, 32 * nb, scr, F.lane); }
    }
    {
        const int gt = F.bid * NTHREADS + F.tid, NGT = F.G * NTHREADS;
        constexpr int PADV = (INP - INW) * D / 8;
        for (int i = gt; i < DEPTH * PADV; i += NGT) { const int l = i / PADV, q = i % PADV;
            *((u32x4*)((bf16_t*)(ws + WS_WIN) + (size_t)l * INP * D + (size_t)INW * D) + q) = (u32x4){0u, 0u, 0u, 0u}; }
        bf16_t* cm3 = (bf16_t*)(ws + WS_CM3);
        for (int i = gt; i < 192 * 64; i += NGT) { const int m = i >> 6, n2 = i & 63, part = m >> 6, k2 = m & 63; const int ph = (k2 * n2) & 63;
            float s, c; sincospif((float)ph * (1.0f / 32.0f), &s, &c); const float v = part == 0 ? c : (part == 1 ? -s : -c); cm3[i] = (bf16_t)f2bf(v); }
        bf16_t* rwt = (bf16_t*)(ws + WS_RW);
        for (int i = gt; i < DEPTH * NE * D; i += NGT) { const int l = i / (NE * D), q = i % (NE * D), k = q >> 5, e = q & 31;
            const float w = P.in[19][(size_t)l * D * NE + q]; const unsigned hi = f2bf(w); const unsigned lo = f2bf(w - bf2f(hi));
            rwt[((size_t)l * 2 + 0) * NE * D + e * D + k] = (bf16_t)hi; rwt[((size_t)l * 2 + 1) * NE * D + e * D + k] = (bf16_t)lo; }
        bf16_t* tf2 = (bf16_t*)(ws + WS_TF2);
        for (int i = gt; i < 128 * 128; i += NGT) { const int c_ = i >> 7, n = i & 127; const int ph = (c_ * n) & 127;
            float s, c; sincospif((float)ph * (1.0f / 64.0f), &s, &c); tf2[i] = (bf16_t)f2bf(c); tf2[128 * 128 + i] = (bf16_t)f2bf(s); }
        bf16_t* tctx = (bf16_t*)(ws + WS_TCTX);
        for (int i = gt; i < 256 * 256; i += NGT) { const int k1 = i >> 8, n = i & 255; const int ph = (k1 * n) & 255;
            float s, c; sincospif((float)ph * (1.0f / 128.0f), &s, &c); tctx[i] = (bf16_t)f2bf(c); tctx[256 * 256 + i] = (bf16_t)f2bf(s); }
        bf16_t* tlat = (bf16_t*)(ws + WS_TLAT);
        for (int i = gt; i < 128 * 128 * 128; i += NGT) { const int nlo = i >> 14, d = (i >> 7) & 127, a = i & 127; const int ph = (d * (nlo + 128 * a)) & 16383;
            float s, c; sincospif((float)ph * (1.0f / 8192.0f), &s, &c);
            tlat[(size_t)nlo * 32768 + d * 128 + a] = (bf16_t)f2bf(c); tlat[(size_t)nlo * 32768 + 16384 + d * 128 + a] = (bf16_t)f2bf(s); }
    }
    for (int it = gw; it < DEPTH * 24 * 8; it += NGW) {
        const int l = it / 192, q = it % 192, cb = q >> 3, ks = q & 7;
        const float* wm = P.in[6] + (size_t)l * D * 6144 + (size_t)(ks * 128) * 6144 + cb * 256 + 4 * F.lane;
        f32x4 a0 = {0.f, 0.f, 0.f, 0.f}, a1 = a0, a2 = a0;
#pragma unroll 4
        for (int k = 0; k < 128; ++k) { const int kk = ks * 128 + k;
            const float c0 = P.in[1][kk], c1 = P.in[1][D + kk], c2 = P.in[3][kk];
            const float s0 = c0 * sigmoidf_(c0), s1 = c1 * sigmoidf_(c1), s2 = c2 * sigmoidf_(c2);
            const f32x4 w = *(const f32x4*)(wm + (size_t)k * 6144);
            a0 += w * s0; a1 += w * s1; a2 += w * s2; }
        float* mp = (float*)(ws + WS_MODP) + ((size_t)(l * 8 + ks) * 3) * 6144 + cb * 256 + 4 * F.lane;
        *(f32x4*)(mp) = a0; *(f32x4*)(mp + 6144) = a1; *(f32x4*)(mp + 2 * 6144) = a2;
    }
}

__device__ __forceinline__ f32x4 mod_from_partials(const Params& P, int l, int v, int c4) {
    f32x4 s = *(const f32x4*)(P.in[7] + (size_t)l * 6144 + c4);
    const float* mp = (const float*)(P.ws + WS_MODP) + ((size_t)(l * 8) * 3 + v) * 6144 + c4;
#pragma unroll
    for (int ks = 0; ks < 8; ++ks) s += *(const f32x4*)(mp + (size_t)ks * 3 * 6144);
    return s;
}

__device__ __forceinline__ void norm_row_store(const f32x4 (&x)[4], const float* g, const f32x4 (&shv)[4], const f32x4 (&scv)[4], bf16_t* orow, int lane) {
    float ss = 0.f;
#pragma unroll
    for (int j = 0; j < 4; ++j) ss += (x[j].x * x[j].x + x[j].y * x[j].y) + (x[j].z * x[j].z + x[j].w * x[j].w);
    const float rstd = 1.0f / sqrtf(wave_sum(ss) * (1.0f / D) + NORM_EPS);
#pragma unroll
    for (int j = 0; j < 4; ++j) { const int c = 4 * lane + 256 * j;
        const f32x4 gv = *(const f32x4*)(g + c);
        const f32x4 y = (x[j] * rstd) * gv * (scv[j] + 1.0f) + shv[j];
        u32x2 o; o.x = pk2(y.x, y.y); o.y = pk2(y.z, y.w);
        *(u32x2*)(orow + c) = o; }
}

__device__ __forceinline__ void phase_p1(const Frame& F, const Params& P) {
    unsigned char* ws = P.ws;
    const int gt = F.bid * NTHREADS + F.tid, NGT = F.G * NTHREADS;
    float* modf = (float*)(ws + WS_MODF);
    for (int i = gt; i < DEPTH * 3 * 1536; i += NGT) { const int l = i / 4608, q = i % 4608, v = q / 1536, c4 = (q % 1536) * 4;
        *(f32x4*)(modf + ((size_t)l * 3 + v) * 6144 + c4) = mod_from_partials(P, l, v, c4); }
    const int gw = F.bid * NWAVES + F.wave, NGW = F.G * NWAVES;
    float* xres = (float*)(ws + WS_XRES); bf16_t* hb = (bf16_t*)(ws + WS_HBUF);
    int cur_v = -1; f32x4 shv[4], scv[4];
    for (int m = gw; m < NTOK; m += NGW) {
        const float* src = (m < NLAT) ? (P.in[0] + (size_t)m * D) : (P.in[2] + (size_t)(m - NLAT) * D);
        const int v = (m >= NLAT) ? 2 : (m >= SEQ ? 1 : 0);
        f32x4 x[4];
#pragma unroll
        for (int j = 0; j < 4; ++j) x[j] = *(const f32x4*)(src + 4 * F.lane + 256 * j);
        if (v != cur_v) { cur_v = v;
#pragma unroll
            for (int j = 0; j < 4; ++j) { const int c = 4 * F.lane + 256 * j; shv[j] = mod_from_partials(P, 0, v, c); scv[j] = mod_from_partials(P, 0, v, 1024 + c); } }
#pragma unroll
        for (int j = 0; j < 4; ++j) *(f32x4*)(xres + (size_t)m * D + 4 * F.lane + 256 * j) = x[j];
        norm_row_store(x, P.in[4], shv, scv, hb + (size_t)m * D, F.lane);
    }
}

constexpr int GL_GT = 0;
constexpr int GL_A1 = 34816, GL_KE = 60416, GL_VTB = 78848, GL_RS = 97280, GL_RT = 97792;
constexpr int GL_KDT = 34816, GL_VT = 53248;

__device__ __forceinline__ float logsigmoidf_(float x) { return fminf(x, 0.f) - __logf(1.0f + __expf(-fabsf(x))); }
__device__ __forceinline__ float bfel(const u32x4& v, int j) { const unsigned w = (j < 2) ? v.x : (j < 4 ? v.y : (j < 6 ? v.z : v.w)); return (j & 1) ? bfhi(w) : bflo(w); }
__device__ __forceinline__ unsigned short bfraw(const u32x4& v, int j) { const unsigned w = (j < 2) ? v.x : (j < 4 ? v.y : (j < 6 ? v.z : v.w)); return (unsigned short)((j & 1) ? (w >> 16) : (w & 0xffffu)); }

struct GateRegs { u32x4 lr[2]; float wg[4]; float bg; };
__device__ __forceinline__ GateRegs gla_load_gate_regs(const Frame& F, const Params& P, int l, int row0, int h) {
    const bf16_t* pb = (const bf16_t*)(P.ws + WS_PBUF); GateRegs g;
    const int dir = F.wave >> 2, dbase = (F.wave & 3) * 16, lane = F.lane, t = dir ? 63 - lane : lane;
    const bf16_t* lrp = pb + (size_t)(row0 + t) * INP + C_GF + dir * 16;
    g.lr[0] = *(const u32x4*)lrp; g.lr[1] = *(const u32x4*)(lrp + 8);
    const float* wgp = (dir ? P.in[11] : P.in[9]) + (size_t)l * 16 * 256 + 64 * h + dbase;
#pragma unroll
    for (int q = 0; q < 4; ++q) { const int idx = lane * 4 + q, r = idx >> 4, i = idx & 15; g.wg[q] = wgp[r * 256 + i]; }
    g.bg = (dir ? P.in[12] : P.in[10])[(size_t)l * 256 + 64 * h + dbase + (lane & 15)];
    return g;
}
__device__ __forceinline__ float rdlane(float v, int srcLane) { return __builtin_bit_cast(float, __builtin_amdgcn_readlane(__builtin_bit_cast(int, v), srcLane)); }
#define DPP_ADD(v, ctrl, rmask) v += __builtin_bit_cast(float, __builtin_amdgcn_update_dpp(0, __builtin_bit_cast(int, v), ctrl, rmask, 0xf, false))
__device__ __forceinline__ float wave_scan_incl(float v) {
    DPP_ADD(v, 0x111, 0xf); DPP_ADD(v, 0x112, 0xf); DPP_ADD(v, 0x114, 0xf); DPP_ADD(v, 0x118, 0xf); DPP_ADD(v, 0x142, 0xa); DPP_ADD(v, 0x143, 0xc);
    return v;
}
__device__ __forceinline__ void gla_gates(const Frame& F, const GateRegs& gr) {
    LAS float* GT = (LAS float*)(F.lds + GL_GT);
    const int dir = F.wave >> 2, dbase = (F.wave & 3) * 16, lane = F.lane, t = dir ? 63 - lane : lane;
    float lr[16];
#pragma unroll
    for (int j = 0; j < 8; ++j) { lr[j] = bfel(gr.lr[0], j); lr[8 + j] = bfel(gr.lr[1], j); }
#pragma unroll
    for (int i = 0; i < 16; ++i) {
        float pre = rdlane(gr.bg, i);
#pragma unroll
        for (int r = 0; r < 16; ++r) { const int idx = r * 16 + i; pre += lr[r] * rdlane(gr.wg[idx & 3], idx >> 2); }
        const float g = wave_scan_incl(logsigmoidf_(pre) * (1.0f / 16.0f));
        GT[(dir * 64 + dbase + i) * 65 + t] = g;
    }
}

__device__ __forceinline__ void gla_g1_unit(const Frame& F, const Params& P, int l, int row0, int h, int unit) {
    const bf16_t* pb = (const bf16_t*)(P.ws + WS_PBUF);
    const int tid = F.tid, row = F.lane, c8 = F.wave * 8;
    const GateRegs gr = gla_load_gate_regs(F, P, l, row0, h);
    const u32x4 kv = *(const u32x4*)(pb + (size_t)(row0 + row) * INP + C_K + 64 * h + c8);
    u32x4 vv[2];
#pragma unroll
    for (int i = 0; i < 2; ++i) { const int vr = F.lane, vc = (F.wave + 8 * i) * 8; vv[i] = *(const u32x4*)(pb + (size_t)(row0 + vr) * INP + C_V + 128 * h + vc); }
    gla_gates(F, gr);
    __syncthreads();
    LAS float* GT = (LAS float*)(F.lds + GL_GT);
    LAS bf16_t* KDT = (LAS bf16_t*)(F.lds + GL_KDT); LAS bf16_t* VT = (LAS bf16_t*)(F.lds + GL_VT);
#pragma unroll
    for (int j = 0; j < 8; ++j) { const int d = c8 + j; const float k_ = bfel(kv, j);
        KDT[d * 72 + row] = (bf16_t)f2bf(k_ * __expf(GT[d * 65 + 63] - GT[d * 65 + row])); KDT[(64 + d) * 72 + row] = (bf16_t)f2bf(k_ * __expf(GT[(64 + d) * 65] - GT[(64 + d) * 65 + row])); }
#pragma unroll
    for (int i = 0; i < 2; ++i) { const int vr = F.lane, vc = (F.wave + 8 * i) * 8;
#pragma unroll
        for (int j = 0; j < 8; ++j) VT[(vc + j) * 72 + vr] = bfraw(vv[i], j); }
    if (tid < 128) ((float*)(P.ws + WS_DECAY))[(size_t)unit * 128 + tid] = __expf(tid < 64 ? GT[tid * 65 + 63] : GT[tid * 65]);
    __syncthreads();
    const int fr = F.lane & 15, fq = F.lane >> 4, w = F.wave;
    f32x4 acc[1][8]; zero_acc<1, 8>(acc);
    mma_nt<1, 8>(acc, KDT + (16 * w) * 72, 72, VT, 72, 64, fr, fq);
    bf16_t* st = (bf16_t*)(P.ws + WS_STATE) + (size_t)unit * 16384;
#pragma unroll
    for (int nt = 0; nt < 8; ++nt) { u32x2 o; o.x = pk2(acc[0][nt][0], acc[0][nt][1]); o.y = pk2(acc[0][nt][2], acc[0][nt][3]); *(u32x2*)(st + (nt * 16 + fr) * 128 + 16 * w + fq * 4) = o; }
}

__device__ __forceinline__ void gla_scan(const Frame& F, const Params& P) {
    unsigned* stt = (unsigned*)(P.ws + WS_STATE); const float* dec = (const float*)(P.ws + WS_DECAY);
    if (F.tid >= 256) return;
    for (int gid = F.bid * 256 + F.tid; gid < 8 * 128 * 64; gid += F.G * 256) {
        const int dp = gid & 63, e = (gid >> 6) & 127, bh = gid >> 13, dir = dp >> 5;
        const int latb = bh * 256, ctxb = 2048 + bh * 4;
        auto unit_of = [&](int p) { return dir == 0 ? (p < 4 ? ctxb + p : latb + (p - 4)) : (p < 4 ? ctxb + 3 - p : latb + 255 - (p - 4)); };
        float s0 = 0.f, s1 = 0.f;
        unsigned dA[10], dB[10]; f32x2 cA[10], cB[10];
#pragma unroll
        for (int i = 0; i < 10; ++i) { const int u = unit_of(i); dA[i] = stt[((size_t)u * 128 + e) * 64 + dp]; cA[i] = *(const f32x2*)(dec + (size_t)u * 128 + 2 * dp); }
        for (int p0 = 0; p0 < 260; p0 += 20) {
#pragma unroll
            for (int i = 0; i < 10; ++i) { const int u = unit_of(p0 + 10 + i); dB[i] = stt[((size_t)u * 128 + e) * 64 + dp]; cB[i] = *(const f32x2*)(dec + (size_t)u * 128 + 2 * dp); }
#pragma unroll
            for (int i = 0; i < 10; ++i) { const int u = unit_of(p0 + i); stt[((size_t)u * 128 + e) * 64 + dp] = pk2(s0, s1); s0 = cA[i].x * s0 + bflo(dA[i]); s1 = cA[i].y * s1 + bfhi(dA[i]); }
            if (p0 + 20 < 260) {
#pragma unroll
                for (int i = 0; i < 10; ++i) { const int u = unit_of(p0 + 20 + i); dA[i] = stt[((size_t)u * 128 + e) * 64 + dp]; cA[i] = *(const f32x2*)(dec + (size_t)u * 128 + 2 * dp); } }
#pragma unroll
            for (int i = 0; i < 10; ++i) { const int u = unit_of(p0 + 10 + i); stt[((size_t)u * 128 + e) * 64 + dp] = pk2(s0, s1); s0 = cB[i].x * s0 + bflo(dB[i]); s1 = cB[i].y * s1 + bfhi(dB[i]); }
        }
    }
}

__device__ __forceinline__ void gla_g3_unit(const Frame& F, const Params& P, int l, int row0, int h, int unit) {
    const bf16_t* pb = (const bf16_t*)(P.ws + WS_PBUF);
    const int tid = F.tid, fr = F.lane & 15, fq = F.lane >> 4, w = F.wave, row = F.lane, c8 = F.wave * 8;
    const GateRegs gr = gla_load_gate_regs(F, P, l, row0, h);
    const u32x4 qv = *(const u32x4*)(pb + (size_t)(row0 + row) * INP + C_Q + 64 * h + c8), kv = *(const u32x4*)(pb + (size_t)(row0 + row) * INP + C_K + 64 * h + c8);
    u32x4 vv[2], rv[2], stv[4];
#pragma unroll
    for (int i = 0; i < 2; ++i) { const int vr = F.lane, vc = (F.wave + 8 * i) * 8; const bf16_t* rp = pb + (size_t)(row0 + vr) * INP + 128 * h + vc; vv[i] = *(const u32x4*)(rp + C_V); rv[i] = *(const u32x4*)(rp + C_R); }
    { const bf16_t* st = (const bf16_t*)(P.ws + WS_STATE) + (size_t)unit * 16384;
#pragma unroll
      for (int i = 0; i < 4; ++i) stv[i] = *(const u32x4*)(st + (i * 512 + tid) * 8); }
    const float* ng = P.in[13] + (size_t)l * 128;
    float ngv[4];
#pragma unroll
    for (int nt = 0; nt < 4; ++nt) ngv[nt] = ng[(w >> 2) * 64 + nt * 16 + fr];
    gla_gates(F, gr);
    __syncthreads();
    LAS float* GT = (LAS float*)(F.lds + GL_GT);
    LAS bf16_t* A1 = (LAS bf16_t*)(F.lds + GL_A1); LAS bf16_t* KE = (LAS bf16_t*)(F.lds + GL_KE); LAS bf16_t* VTb = (LAS bf16_t*)(F.lds + GL_VTB); LAS bf16_t* STb = (LAS bf16_t*)(F.lds + GL_GT);
    LAS float* RS = (LAS float*)(F.lds + GL_RS); LAS bf16_t* RT = (LAS bf16_t*)(F.lds + GL_RT);
    { float qf[8], qb[8], kf[8], kb[8];
#pragma unroll
      for (int j = 0; j < 8; ++j) { const float q_ = bfel(qv, j) * 0.125f, k_ = bfel(kv, j); const float bf_ = GT[(c8 + j) * 65 + row], bb_ = GT[(64 + c8 + j) * 65 + row];
          qf[j] = q_ * __expf(bf_); qb[j] = q_ * __expf(bb_); kf[j] = k_ * __expf(-bf_); kb[j] = k_ * __expf(-bb_); }
      *(LAS u32x4*)(A1 + row * 200 + 64 + c8) = (u32x4){pk2(qf[0], qf[1]), pk2(qf[2], qf[3]), pk2(qf[4], qf[5]), pk2(qf[6], qf[7])};
      *(LAS u32x4*)(A1 + row * 200 + 128 + c8) = (u32x4){pk2(qb[0], qb[1]), pk2(qb[2], qb[3]), pk2(qb[4], qb[5]), pk2(qb[6], qb[7])};
      *(LAS u32x4*)(KE + row * 72 + c8) = (u32x4){pk2(kf[0], kf[1]), pk2(kf[2], kf[3]), pk2(kf[4], kf[5]), pk2(kf[6], kf[7])};
      *(LAS u32x4*)(KE + 4608 + row * 72 + c8) = (u32x4){pk2(kb[0], kb[1]), pk2(kb[2], kb[3]), pk2(kb[4], kb[5]), pk2(kb[6], kb[7])}; }
#pragma unroll
    for (int i = 0; i < 2; ++i) { const int vr = F.lane, vc = (F.wave + 8 * i) * 8; *(LAS u32x4*)(RT + vr * 136 + vc) = rv[i];
#pragma unroll
        for (int j = 0; j < 8; ++j) VTb[(vc + j) * 72 + vr] = bfraw(vv[i], j); }
    __syncthreads();
    {
        const int mt = w & 3, ntp = w >> 2;
        f32x4 af[1][2], ab[1][2]; zero_acc<1, 2>(af); zero_acc<1, 2>(ab);
        mma_nt<1, 2>(af, A1 + (16 * mt) * 200 + 64, 200, KE + (32 * ntp) * 72, 72, 64, fr, fq);
        mma_nt<1, 2>(ab, A1 + (16 * mt) * 200 + 128, 200, KE + 4608 + (32 * ntp) * 72, 72, 64, fr, fq);
#pragma unroll
        for (int i = 0; i < 4; ++i) { const int idx = (i * 512 + tid) * 8, e = idx >> 7, dd = idx & 127; *(LAS u32x4*)(STb + e * 136 + dd) = stv[i]; }
#pragma unroll
        for (int nt = 0; nt < 2; ++nt)
#pragma unroll
            for (int j = 0; j < 4; ++j) { const int i = 16 * mt + fq * 4 + j, jj = (2 * ntp + nt) * 16 + fr;
                const float p = (jj <= i ? af[0][nt][j] : 0.f) + (jj >= i ? ab[0][nt][j] : 0.f); A1[i * 200 + jj] = (bf16_t)f2bf(p); }
    }
    __syncthreads();
    {
        const int mt = w & 3, nh = w >> 2;
        f32x4 acc[1][4]; zero_acc<1, 4>(acc);
        mma_nt<1, 4>(acc, A1 + (16 * mt) * 200, 200, VTb + (64 * nh) * 72, 72, 64, fr, fq);
        mma_nt<1, 4>(acc, A1 + (16 * mt) * 200 + 64, 200, STb + (64 * nh) * 136, 136, 128, fr, fq);
        float ss[4];
#pragma unroll
        for (int j = 0; j < 4; ++j) { float s = 0.f;
#pragma unroll
            for (int nt = 0; nt < 4; ++nt) s += acc[0][nt][j] * acc[0][nt][j];
            s += __shfl_xor(s, 1); s += __shfl_xor(s, 2); s += __shfl_xor(s, 4); s += __shfl_xor(s, 8); ss[j] = s; }
        if (fr == 0) {
#pragma unroll
            for (int j = 0; j < 4; ++j) RS[nh * 64 + 16 * mt + fq * 4 + j] = ss[j]; }
        __syncthreads();
        bf16_t* cat = (bf16_t*)(P.ws + WS_CAT);
#pragma unroll
        for (int j = 0; j < 4; ++j) { const int i = 16 * mt + fq * 4 + j; const float rinv = 1.0f / sqrtf((RS[i] + RS[64 + i]) * (1.0f / 128.0f) + NORM_EPS);
#pragma unroll
            for (int nt = 0; nt < 4; ++nt) { const int e = nh * 64 + nt * 16 + fr; const float r_ = bf2f(RT[i * 136 + e]);
                const float o = acc[0][nt][j] * rinv * ngv[nt] * (r_ * sigmoidf_(r_)); cat[(size_t)(row0 + i) * D + 256 + 128 * h + e] = (bf16_t)f2bf(o); } }
    }
}

__device__ __forceinline__ void conv_unit(const Frame& F, const Params& P, int l, int rowbase, int Ls, int t0) {
    const bf16_t* pb = (const bf16_t*)(P.ws + WS_PBUF);
    LAS bf16_t* Y = (LAS bf16_t*)(F.lds);
    LAS float* Z = (LAS float*)(F.lds + 49152);
    const int tid = F.tid;
    {
        u32x4 av[6], gv[6];
#pragma unroll
        for (int i = 0; i < 6; ++i) { const int ch = tid + 512 * i, r = ch >> 5, cc = (ch & 31) * 8, t = t0 - 15 + r;
            av[i] = (u32x4){0u, 0u, 0u, 0u}; gv[i] = av[i];
            if (ch < 94 * 32 && t >= 0 && t < Ls) { const size_t rb = (size_t)(rowbase + t) * INP; av[i] = *(const u32x4*)(pb + rb + C_CA + cc); gv[i] = *(const u32x4*)(pb + rb + C_CG + cc); } }
#pragma unroll
        for (int i = 0; i < 6; ++i) { const int ch = tid + 512 * i, r = ch >> 5, cc = (ch & 31) * 8; const u32x4 a = av[i], g = gv[i]; u32x4 o;
            o.x = pk2(bflo(a.x) * sigmoidf_(bflo(g.x)), bfhi(a.x) * sigmoidf_(bfhi(g.x))); o.y = pk2(bflo(a.y) * sigmoidf_(bflo(g.y)), bfhi(a.y) * sigmoidf_(bfhi(g.y)));
            o.z = pk2(bflo(a.z) * sigmoidf_(bflo(g.z)), bfhi(a.z) * sigmoidf_(bfhi(g.z))); o.w = pk2(bflo(a.w) * sigmoidf_(bflo(g.w)), bfhi(a.w) * sigmoidf_(bfhi(g.w)));
            if (ch < 94 * 32) *(LAS u32x4*)(Y + r * 256 + cc) = o; }
    }
    const int c = tid & 255, half = tid >> 8; const float* cw = P.in[14] + (size_t)l * 31 * 256 + c; const float cb = P.in[15][(size_t)l * 256 + c];
    float wv[31];
#pragma unroll
    for (int j = 0; j < 31; ++j) wv[j] = cw[j * 256];
    const f32x4 lng = *(const f32x4*)(P.in[16] + (size_t)l * 256 + 4 * F.lane), lnb = *(const f32x4*)(P.in[17] + (size_t)l * 256 + 4 * F.lane);
    __syncthreads();
    { float yv[62];
#pragma unroll
      for (int r = 0; r < 62; ++r) yv[r] = bf2f(Y[(half * 32 + r) * 256 + c]);
#pragma unroll
      for (int tt = 0; tt < 32; ++tt) { float z = cb;
#pragma unroll
          for (int j = 0; j < 31; ++j) z += wv[j] * yv[tt + j];
          Z[(half * 32 + tt) * 256 + c] = z; } }
    __syncthreads();
    { bf16_t* cat = (bf16_t*)(P.ws + WS_CAT);
#pragma unroll 2
      for (int i = 0; i < 8; ++i) { const int t = F.wave * 8 + i; const f32x4 z = *(const LAS f32x4*)(Z + t * 256 + 4 * F.lane);
          const float mean = wave_sum((z.x + z.y) + (z.z + z.w)) * (1.0f / 256.0f); const f32x4 zc = z - mean;
          const float var = wave_sum((zc.x * zc.x + zc.y * zc.y) + (zc.z * zc.z + zc.w * zc.w)) * (1.0f / 256.0f); const float rstd = 1.0f / sqrtf(var + NORM_EPS);
          const f32x4 y = zc * rstd * lng + lnb; u32x2 o; o.x = pk2(y.x * sigmoidf_(y.x), y.y * sigmoidf_(y.y)); o.y = pk2(y.z * sigmoidf_(y.z), y.w * sigmoidf_(y.w));
          *(u32x2*)(cat + (size_t)(rowbase + t0 + t) * D + 768 + 4 * F.lane) = o; } }
    __syncthreads();
}

template <int R, int NP>
__device__ __forceinline__ void fourier_f1_unit(const Frame& F, const Params& P, int rowbase, int rstride, int h, const bf16_t* tab, int orow0, float oscale) {
    const bf16_t* pb = (const bf16_t*)(P.ws + WS_PBUF); const bf16_t* cm3 = (const bf16_t*)(P.ws + WS_CM3);
    constexpr int LZ = R + 8, MT0 = 4 * NP, NTW = R / 128, MTW = R / 128;
    LAS bf16_t* U = (LAS bf16_t*)(F.lds); LAS bf16_t* CM = U + R * 72; LAS bf16_t* ZT = CM + 64 * NP * 72;
    const int tid = F.tid, fr = F.lane & 15, fq = F.lane >> 4, w = F.wave;
    bf16x8 tcp[4], tsp[4];
    if constexpr (R == 128) {
#pragma unroll
        for (int k = 0; k < 4; ++k) { tcp[k] = *(const bf16x8*)(tab + (size_t)(w * 16 + fr) * R + k * 32 + fq * 8); tsp[k] = *(const bf16x8*)(tab + (size_t)R * R + (size_t)(w * 16 + fr) * R + k * 32 + fq * 8); } }
    { constexpr int NU = R * 8 / NTHREADS, NC = (64 * NP * 8 + NTHREADS - 1) / NTHREADS; u32x4 uv[NU], cv[NC];
#pragma unroll
      for (int i = 0; i < NU; ++i) { const int ch = tid + NTHREADS * i, a = ch >> 3, c8 = (ch & 7) * 8; uv[i] = *(const u32x4*)(pb + (size_t)(rowbase + a * rstride) * INP + C_FOUR + 64 * h + c8); }
#pragma unroll
      for (int i = 0; i < NC; ++i) { const int ch = tid + NTHREADS * i, m = ch >> 3, c8 = (ch & 7) * 8; cv[i] = (ch < 64 * NP * 8) ? *(const u32x4*)(cm3 + m * 64 + c8) : (u32x4){0u, 0u, 0u, 0u}; }
#pragma unroll
      for (int i = 0; i < NU; ++i) { const int ch = tid + NTHREADS * i, a = ch >> 3, c8 = (ch & 7) * 8; *(LAS u32x4*)(U + a * 72 + c8) = uv[i]; }
#pragma unroll
      for (int i = 0; i < NC; ++i) { const int ch = tid + NTHREADS * i, m = ch >> 3, c8 = (ch & 7) * 8; if (ch < 64 * NP * 8) *(LAS u32x4*)(CM + m * 72 + c8) = cv[i]; } }
    __syncthreads();
    {
        f32x4 acc[MT0][NTW]; zero_acc<MT0, NTW>(acc);
        mma_nt<MT0, NTW>(acc, CM, 72, U + (w * NTW * 16) * 72, 72, 64, fr, fq);
#pragma unroll
        for (int mt = 0; mt < MT0; ++mt)
#pragma unroll
            for (int nt = 0; nt < NTW; ++nt)
#pragma unroll
                for (int j = 0; j < 4; ++j) ZT[(mt * 16 + fq * 4 + j) * LZ + (w * NTW + nt) * 16 + fr] = (bf16_t)f2bf(acc[mt][nt][j]);
    }
    __syncthreads();
    {
        f32x4 are[MTW][4], aim[MTW][4]; zero_acc<MTW, 4>(are); zero_acc<MTW, 4>(aim);
        const int m0 = w * MTW * 16;
#pragma unroll
        for (int k0 = 0; k0 < R; k0 += 32) {
            bf16x8 tc[MTW], ts[MTW];
#pragma unroll
            for (int mi = 0; mi < MTW; ++mi) { if constexpr (R == 128) { tc[mi] = tcp[k0 / 32]; ts[mi] = tsp[k0 / 32]; } else { tc[mi] = *(const bf16x8*)(tab + (size_t)(m0 + mi * 16 + fr) * R + k0 + fq * 8); ts[mi] = *(const bf16x8*)(tab + (size_t)R * R + (size_t)(m0 + mi * 16 + fr) * R + k0 + fq * 8); } }
#pragma unroll
            for (int nt = 0; nt < 4; ++nt) {
                const bf16x8 zr = *(const LAS bf16x8*)(ZT + (nt * 16 + fr) * LZ + k0 + fq * 8), zi = *(const LAS bf16x8*)(ZT + (64 + nt * 16 + fr) * LZ + k0 + fq * 8);
#pragma unroll
                for (int mi = 0; mi < MTW; ++mi) { are[mi][nt] = __builtin_amdgcn_mfma_f32_16x16x32_bf16(tc[mi], zr, are[mi][nt], 0, 0, 0); are[mi][nt] = __builtin_amdgcn_mfma_f32_16x16x32_bf16(ts[mi], zi, are[mi][nt], 0, 0, 0); }
                if constexpr (NP == 3) { const bf16x8 nzr = *(const LAS bf16x8*)(ZT + (128 + nt * 16 + fr) * LZ + k0 + fq * 8);
#pragma unroll
                    for (int mi = 0; mi < MTW; ++mi) { aim[mi][nt] = __builtin_amdgcn_mfma_f32_16x16x32_bf16(tc[mi], zi, aim[mi][nt], 0, 0, 0); aim[mi][nt] = __builtin_amdgcn_mfma_f32_16x16x32_bf16(ts[mi], nzr, aim[mi][nt], 0, 0, 0); } }
            }
        }
#pragma unroll
        for (int mi = 0; mi < MTW; ++mi)
#pragma unroll
            for (int nt = 0; nt < 4; ++nt)
#pragma unroll
                for (int j = 0; j < 4; ++j) { const int m = m0 + mi * 16 + fq * 4 + j, k2 = nt * 16 + fr;
                    if constexpr (NP == 3) { unsigned* t2 = (unsigned*)(P.ws + WS_T2); t2[(size_t)(orow0 + 128 * m) * 256 + h * 64 + k2] = pk2(are[mi][nt][j], aim[mi][nt][j]); }
                    else { bf16_t* cat = (bf16_t*)(P.ws + WS_CAT); cat[(size_t)(orow0 + m) * D + h * 64 + k2] = (bf16_t)f2bf(are[mi][nt][j] * oscale); } }
    }
    __syncthreads();
}

constexpr int F2_X = 0, F2_T = 67584;
__device__ __forceinline__ void fourier_f2_tables(const Frame& F, const Params& P) {
    const bf16_t* tf2 = (const bf16_t*)(P.ws + WS_TF2); LAS bf16_t* T = (LAS bf16_t*)(F.lds + F2_T);
#pragma unroll
    for (int i = 0; i < 8; ++i) { const int ch = F.tid + 512 * i, r = ch >> 4, c8 = (ch & 15) * 8; *(LAS u32x4*)(T + r * 136 + c8) = *(const u32x4*)(tf2 + r * 128 + c8); }
    __syncthreads();
}
__device__ __forceinline__ void fourier_f2_unit(const Frame& F, const Params& P, int b, int d, int hp) {
    const bf16_t* t2 = (const bf16_t*)(P.ws + WS_T2);
    LAS bf16_t* X = (LAS bf16_t*)(F.lds + F2_X); const LAS bf16_t* T = (const LAS bf16_t*)(F.lds + F2_T);
    const int tid = F.tid, fr = F.lane & 15, fq = F.lane >> 4, w = F.wave;
    { u32x4 xv[8];
#pragma unroll
      for (int i = 0; i < 8; ++i) { const int ch = tid + 512 * i, n = ch >> 5, c8 = (ch & 31) * 8; xv[i] = *(const u32x4*)(t2 + (size_t)(b * SEQ + 128 * d + n) * 512 + hp * 256 + c8); }
#pragma unroll
      for (int i = 0; i < 8; ++i) { const int ch = tid + 512 * i, n = ch >> 5, c8 = (ch & 31) * 8; *(LAS u32x4*)(X + n * 264 + c8) = xv[i]; } }
    __syncthreads();
    f32x4 acc[8];
#pragma unroll
    for (int mt = 0; mt < 8; ++mt) acc[mt] = (f32x4){0.f, 0.f, 0.f, 0.f};
#pragma unroll
    for (int k0 = 0; k0 < 128; k0 += 32) {
        bf16x8 xr, xi;
#pragma unroll
        for (int jj = 0; jj < 8; ++jj) { const unsigned wd = *(const LAS unsigned*)(X + (k0 + fq * 8 + jj) * 264 + 2 * (w * 16 + fr)); xr[jj] = (short)(wd & 0xffffu); xi[jj] = (short)(wd >> 16); }
#pragma unroll
        for (int mt = 0; mt < 8; ++mt) { const bf16x8 tc = *(const LAS bf16x8*)(T + (mt * 16 + fr) * 136 + k0 + fq * 8), ts = *(const LAS bf16x8*)(T + (128 + mt * 16 + fr) * 136 + k0 + fq * 8);
            acc[mt] = __builtin_amdgcn_mfma_f32_16x16x32_bf16(tc, xr, acc[mt], 0, 0, 0); acc[mt] = __builtin_amdgcn_mfma_f32_16x16x32_bf16(ts, xi, acc[mt], 0, 0, 0); }
    }
    bf16_t* cat = (bf16_t*)(P.ws + WS_CAT);
#pragma unroll
    for (int mt = 0; mt < 8; ++mt)
#pragma unroll
        for (int j = 0; j < 4; ++j) { const int c = mt * 16 + fq * 4 + j; cat[(size_t)(b * SEQ + 128 * c + d) * D + hp * 128 + w * 16 + fr] = (bf16_t)f2bf(acc[mt][j] * (1.0f / 1024.0f)); }
    __syncthreads();
}

constexpr int AX_LCNT = AUX_OFF, AX_GBASE = AUX_OFF + 128, AX_LE = AUX_OFF + 256, AX_LP = AUX_OFF + 256 + 2560;
constexpr int LC_BAR = LCTL_OFF, LC_TS = LCTL_OFF + 64;

constexpr int RT_GS = 0, RT_SSQ = 24576, RT_AT = 25600, RT_PL = 95232;
__device__ __forceinline__ void phase_route(const Frame& F, const Params& P, int l, int ntok) {
    unsigned char* ws = P.ws;
    LAS float* GS = (LAS float*)(F.lds + RT_GS); LAS float* SSQ = (LAS float*)(F.lds + RT_SSQ); LAS float* PL = (LAS float*)(F.lds + RT_PL);
    volatile LAS int* lcnt = (volatile LAS int*)(F.lds + AX_LCNT); volatile LAS int* gbase = (volatile LAS int*)(F.lds + AX_GBASE);
    volatile LAS int* LE = (volatile LAS int*)(F.lds + AX_LE); volatile LAS int* LP = (volatile LAS int*)(F.lds + AX_LP);
    const int tid = F.tid, lane = F.lane, w = F.wave, fr = lane & 15, fq = lane >> 4, ts = lane >> 2, kq = lane & 3, kbase = 128 * w + 32 * kq;
    LAS bf16_t* AT = (LAS bf16_t*)(F.lds + RT_AT) + w * (2 * 16 * 136);
    const int tpb = (ntok + F.G - 1) / F.G, tb = F.bid * tpb, te = (tb + tpb < ntok) ? tb + tpb : ntok, ntile = (te - tb + 15) >> 4;
    { const float* g2 = P.in[5] + (size_t)l * D;
      for (int i = tid; i < 3 * 1024; i += NTHREADS) { const int v = i >> 10, k = i & 1023; const float* mf = (const float*)(ws + WS_MODF) + ((size_t)l * 3 + v) * 6144;
          GS[(v * 2 + 0) * 1024 + k] = g2[k] * (1.0f + mf[4 * 1024 + k]); GS[(v * 2 + 1) * 1024 + k] = mf[3 * 1024 + k]; } }
    if (tid < 32) lcnt[tid] = 0;
    bf16x8 bh[4][2], bl[4][2];
    { const bf16_t* rwh = (const bf16_t*)(ws + WS_RW) + (size_t)l * 2 * NE * D; const bf16_t* rwl = rwh + NE * D;
#pragma unroll
      for (int sk = 0; sk < 4; ++sk)
#pragma unroll
          for (int nt = 0; nt < 2; ++nt) { const int off = (nt * 16 + fr) * D + 128 * w + 32 * sk + 8 * fq; bh[sk][nt] = *(const bf16x8*)(rwh + off); bl[sk][nt] = *(const bf16x8*)(rwl + off); } }
    const float* xres = (const float*)(ws + WS_XRES); bf16_t* hb = (bf16_t*)(ws + WS_HBUF);
    const float rbias = P.in[20][(size_t)l * NE + (lane & 31)];
    float* aprob = (float*)(ws + WS_APROB);
    f32x4 xn[8];
    { const int m = tb + ts;
#pragma unroll
      for (int j = 0; j < 8; ++j) xn[j] = (m < te) ? *(const f32x4*)(xres + (size_t)m * D + kbase + 4 * j) : (f32x4){0.f, 0.f, 0.f, 0.f}; }
    __syncthreads();
    for (int it = 0; it < ntile; ++it) {
        const int buf = it & 1; const int m = tb + 16 * it + ts; const bool valid = m < te; const int v = (m >= NLAT) ? 2 : (m >= SEQ ? 1 : 0);
        f32x4 x[8]; float ss = 0.f;
#pragma unroll
        for (int j = 0; j < 8; ++j) { x[j] = xn[j]; ss += (x[j].x * x[j].x + x[j].y * x[j].y) + (x[j].z * x[j].z + x[j].w * x[j].w); }
        if (it + 1 < ntile) { const int mn = m + 16;
#pragma unroll
            for (int j = 0; j < 8; ++j) xn[j] = (mn < te) ? *(const f32x4*)(xres + (size_t)mn * D + kbase + 4 * j) : (f32x4){0.f, 0.f, 0.f, 0.f}; }
        ss += __shfl_xor(ss, 1); ss += __shfl_xor(ss, 2);
        if (kq == 0) SSQ[(buf * 8 + w) * 16 + ts] = ss;
        __syncthreads();
        float tot = 0.f;
#pragma unroll
        for (int q = 0; q < 8; ++q) tot += SSQ[(buf * 8 + q) * 16 + ts];
        const float rstd = 1.0f / sqrtf(tot * (1.0f / D) + NORM_EPS);
        {
            unsigned hw[16], lw[16];
#pragma unroll
            for (int j = 0; j < 8; ++j) { const f32x4 gs = *(const LAS f32x4*)(GS + (v * 2 + 0) * 1024 + kbase + 4 * j), sh = *(const LAS f32x4*)(GS + (v * 2 + 1) * 1024 + kbase + 4 * j);
                const f32x4 h = (x[j] * rstd) * gs + sh;
                const unsigned h0 = f2bf(h.x), h1 = f2bf(h.y), h2 = f2bf(h.z), h3 = f2bf(h.w);
                hw[2 * j] = h0 | (h1 << 16); hw[2 * j + 1] = h2 | (h3 << 16);
                lw[2 * j] = pk2(h.x - bf2f(h0), h.y - bf2f(h1)); lw[2 * j + 1] = pk2(h.z - bf2f(h2), h.w - bf2f(h3)); }
            if (valid) {
#pragma unroll
                for (int c = 0; c < 4; ++c) *(u32x4*)(hb + (size_t)m * D + kbase + 8 * c) = (u32x4){hw[4 * c], hw[4 * c + 1], hw[4 * c + 2], hw[4 * c + 3]}; }
#pragma unroll
            for (int c = 0; c < 4; ++c) { *(LAS u32x4*)(AT + ts * 136 + 32 * kq + 8 * c) = (u32x4){hw[4 * c], hw[4 * c + 1], hw[4 * c + 2], hw[4 * c + 3]};
                *(LAS u32x4*)(AT + 16 * 136 + ts * 136 + 32 * kq + 8 * c) = (u32x4){lw[4 * c], lw[4 * c + 1], lw[4 * c + 2], lw[4 * c + 3]}; }
        }
        f32x4 acc[2]; acc[0] = (f32x4){0.f, 0.f, 0.f, 0.f}; acc[1] = acc[0];
#pragma unroll
        for (int sk = 0; sk < 4; ++sk) { const bf16x8 ah = *(const LAS bf16x8*)(AT + fr * 136 + 32 * sk + 8 * fq), al = *(const LAS bf16x8*)(AT + 16 * 136 + fr * 136 + 32 * sk + 8 * fq);
#pragma unroll
            for (int nt = 0; nt < 2; ++nt) { acc[nt] = __builtin_amdgcn_mfma_f32_16x16x32_bf16(ah, bh[sk][nt], acc[nt], 0, 0, 0); acc[nt] = __builtin_amdgcn_mfma_f32_16x16x32_bf16(ah, bl[sk][nt], acc[nt], 0, 0, 0);
                acc[nt] = __builtin_amdgcn_mfma_f32_16x16x32_bf16(al, bh[sk][nt], acc[nt], 0, 0, 0); } }
#pragma unroll
        for (int nt = 0; nt < 2; ++nt)
#pragma unroll
            for (int j = 0; j < 4; ++j) PL[((buf * 8 + w) * 16 + fq * 4 + j) * 33 + nt * 16 + fr] = acc[nt][j];
        __syncthreads();
        {
            const int tt = 2 * w + (lane >> 5), e = lane & 31, mt = tb + 16 * it + tt;
            float lg = rbias;
#pragma unroll
            for (int q = 0; q < 8; ++q) lg += PL[((buf * 8 + q) * 16 + tt) * 33 + e];
            float bval[4]; int bidx[4]; float cur = lg;
#pragma unroll
            for (int k = 0; k < 4; ++k) { float bv = cur; int bi = e;
#pragma unroll
                for (int o = 1; o < 32; o <<= 1) { const float ov = __shfl_xor(bv, o); const int oi = __shfl_xor(bi, o); const bool take = (ov > bv) || (ov == bv && oi < bi); bv = take ? ov : bv; bi = take ? oi : bi; }
                bval[k] = bv; bidx[k] = bi; if (e == bi) cur = -INFINITY; }
            float ex[4], sum = 0.f;
#pragma unroll
            for (int k = 0; k < 4; ++k) { ex[k] = __expf(bval[k] - bval[0]); sum += ex[k]; }
            if (e == 0 && mt < te) { const int tl = 16 * it + tt;
#pragma unroll
                for (int k = 0; k < 4; ++k) { const int lp = __hip_atomic_fetch_add((LAS int*)(F.lds + AX_LCNT) + bidx[k], 1, __ATOMIC_RELAXED, __HIP_MEMORY_SCOPE_WORKGROUP);
                    LE[tl * 4 + k] = bidx[k]; LP[tl * 4 + k] = lp; aprob[(size_t)mt * 4 + k] = ex[k] / sum; } }
        }
    }
    __syncthreads();
    if (tid < 32) gbase[tid] = (int)__hip_atomic_fetch_add((unsigned*)(ws + WS_CTL) + CW_CNT + l * 64 + tid, (unsigned)lcnt[tid], __ATOMIC_RELAXED, __HIP_MEMORY_SCOPE_AGENT);
    __syncthreads();
    int* aexp = (int*)(ws + WS_AEXP); int* apos = (int*)(ws + WS_APOS);
    int* elist = (int*)(ws + WS_XB);
    for (int i = tid; i < (te - tb) * 4; i += NTHREADS) { const int e = LE[i]; const int pos = gbase[e] + LP[i]; aexp[(size_t)tb * 4 + i] = e; apos[(size_t)tb * 4 + i] = pos; elist[(size_t)e * NTOK + pos] = tb + (i >> 2); }
    __syncthreads();
}

__device__ __forceinline__ void moe_prep(const Frame& F, const Params& P, int l) {
    unsigned char* ws = P.ws;
    volatile LAS int* TS = (volatile LAS int*)(F.lds + LC_TS);
    if (F.tid < 64) { const int e = F.lane & 31;
        const unsigned c = __hip_atomic_load((unsigned*)(ws + WS_CTL) + CW_CNT + l * 64 + e, __ATOMIC_RELAXED, __HIP_MEMORY_SCOPE_AGENT);
        int incl = (int)((c + 255u) >> 8);
#pragma unroll
        for (int o = 1; o < 32; o <<= 1) { const int v = __shfl_up(incl, o); if (e >= o) incl += v; }
        if (F.lane < 32) { TS[e + 1] = incl; TS[64 + e] = (int)c; }
        if (F.lane == 0) TS[0] = 0; }
    __syncthreads();
}

__device__ __forceinline__ void phase_combine(const Frame& F, const Params& P, int l, int ntok, bool last) {
    unsigned char* ws = P.ws;
    const int gw = F.bid * NWAVES + F.wave, NGW = F.G * NWAVES, lane = F.lane;
    float* xres = (float*)(ws + WS_XRES); const bf16_t* yb = (const bf16_t*)(ws + WS_YB);
    const int* aexp = (const int*)(ws + WS_AEXP); const int* apos = (const int*)(ws + WS_APOS); const float* aprob = (const float*)(ws + WS_APROB);
    const volatile LAS int* TS = (const volatile LAS int*)(F.lds + LC_TS);
    int sl_n[4]; float pr_n[4];
    if (gw < ntok) {
#pragma unroll
        for (int k = 0; k < 4; ++k) { sl_n[k] = TS[aexp[(size_t)gw * 4 + k]] * 256 + apos[(size_t)gw * 4 + k]; pr_n[k] = aprob[(size_t)gw * 4 + k]; } }
    for (int m = gw; m < ntok; m += NGW) {
        const int v = (m >= NLAT) ? 2 : (m >= SEQ ? 1 : 0);
        const float* mf = (const float*)(ws + WS_MODF) + ((size_t)l * 3 + v) * 6144;
        int sl[4]; float pr[4];
#pragma unroll
        for (int k = 0; k < 4; ++k) { sl[k] = sl_n[k]; pr[k] = pr_n[k]; }
        u32x2 wv[4][4]; f32x4 xo[4], g5[4];
#pragma unroll
        for (int k = 0; k < 4; ++k)
#pragma unroll
            for (int j = 0; j < 4; ++j) wv[k][j] = *(const u32x2*)(yb + (size_t)sl[k] * D + 4 * lane + 256 * j);
#pragma unroll
        for (int j = 0; j < 4; ++j) { const int c = 4 * lane + 256 * j; xo[j] = *(const f32x4*)(xres + (size_t)m * D + c); g5[j] = *(const f32x4*)(mf + 5 * 1024 + c); }
        if (m + NGW < ntok) {
#pragma unroll
            for (int k = 0; k < 4; ++k) { sl_n[k] = TS[aexp[(size_t)(m + NGW) * 4 + k]] * 256 + apos[(size_t)(m + NGW) * 4 + k]; pr_n[k] = aprob[(size_t)(m + NGW) * 4 + k]; } }
        f32x4 y[4];
#pragma unroll
        for (int j = 0; j < 4; ++j) y[j] = (f32x4){0.f, 0.f, 0.f, 0.f};
#pragma unroll
        for (int k = 0; k < 4; ++k)
#pragma unroll
            for (int j = 0; j < 4; ++j) y[j] += (f32x4){bflo(wv[k][j].x), bfhi(wv[k][j].x), bflo(wv[k][j].y), bfhi(wv[k][j].y)} * pr[k];
        f32x4 x[4];
#pragma unroll
        for (int j = 0; j < 4; ++j) x[j] = xo[j] + g5[j] * y[j];
        if (!last) {
#pragma unroll
            for (int j = 0; j < 4; ++j) *(f32x4*)(xres + (size_t)m * D + 4 * lane + 256 * j) = x[j];
            const float* mn = (const float*)(ws + WS_MODF) + ((size_t)(l + 1) * 3 + v) * 6144; f32x4 shv[4], scv[4];
#pragma unroll
            for (int j = 0; j < 4; ++j) { shv[j] = *(const f32x4*)(mn + 4 * lane + 256 * j); scv[j] = *(const f32x4*)(mn + 1024 + 4 * lane + 256 * j); }
            norm_row_store(x, P.in[4] + (size_t)(l + 1) * D, shv, scv, (bf16_t*)(ws + WS_HBUF) + (size_t)m * D, lane);
        } else {
            float ss = 0.f;
#pragma unroll
            for (int j = 0; j < 4; ++j) ss += (x[j].x * x[j].x + x[j].y * x[j].y) + (x[j].z * x[j].z + x[j].w * x[j].w);
            const float rstd = 1.0f / sqrtf(wave_sum(ss) * (1.0f / D) + NORM_EPS);
#pragma unroll
            for (int j = 0; j < 4; ++j) { const int c = 4 * lane + 256 * j; *(f32x4*)(P.out + (size_t)m * D + c) = (x[j] * rstd) * *(const f32x4*)(P.in[25] + c); }
        }
    }
}

#ifndef REP_PRO
#define REP_PRO 1
#endif
#ifndef REP_GEMM1
#define REP_GEMM1 1
#endif
#ifndef REP_G1U
#define REP_G1U 1
#endif
#ifndef REP_F1U
#define REP_F1U 1
#endif
#ifndef REP_CONV
#define REP_CONV 1
#endif
#ifndef REP_F2U
#define REP_F2U 1
#endif
#ifndef REP_G3U
#define REP_G3U 1
#endif
#ifndef REP_GU
#define REP_GU 1
#endif
#ifndef REP_DN
#define REP_DN 1
#endif
#ifndef REP_GATH
#define REP_GATH 1
#endif
__global__ void __launch_bounds__(NTHREADS, 2) mega_fwd(Params P0) {
    extern __shared__ __attribute__((aligned(16))) unsigned char lds_raw[];
    Frame F0; F0.lds = (LAS unsigned char*)lds_raw; F0.tid = threadIdx.x; F0.lane = F0.tid & 63; F0.wave = __builtin_amdgcn_readfirstlane(F0.tid >> 6); F0.G = gridDim.x; F0.bid = blockIdx.x;
#define KAS __attribute__((address_space(4)))
    struct ParamsK { const GAS float* in[26]; GAS float* out; GAS unsigned char* ws; };
#define PHASE_ENV() Frame F = F0; asm volatile("" : "+v"(F.tid)); F.lane = F.tid & 63; F.wave = __builtin_amdgcn_readfirstlane(F.tid >> 6); asm volatile("" : "+s"(F.bid), "+s"(F.G)); \
    const KAS ParamsK* kp_ = (const KAS ParamsK*)__builtin_amdgcn_kernarg_segment_ptr(); asm volatile("" : "+s"(kp_)); Params P; \
    _Pragma("unroll") for (int i_ = 0; i_ < 26; ++i_) P.in[i_] = (const float*)kp_->in[i_]; \
    P.out = (float*)kp_->out; P.ws = (unsigned char*)kp_->ws; unsigned char* ws = P.ws; (void)ws;
    { PHASE_ENV();
    for (int u = F.tid; u < (LDS_BYTES - LCTL_OFF) / 4; u += NTHREADS) ((LAS unsigned*)(F.lds + LCTL_OFF))[u] = 0u;
    __syncthreads();
    }
    { PHASE_ENV(); (void)xcd_barrier_post((unsigned*)(ws + WS_CTL) + CW_BAR, (volatile LAS unsigned*)(F.lds + LC_BAR)); }
#define GRID_BAR() do { PHASE_ENV(); XcdBarrier b_; b_.bar = (unsigned*)(ws + WS_CTL) + CW_BAR; b_.x = xb_xcc_id(); b_.st = (volatile LAS unsigned*)(F.lds + LC_BAR); xcd_barrier(b_); } while (0)

    for (int rep = 0; rep < REP_PRO; ++rep) { PHASE_ENV(); phase_prologue(F, P); }
    GRID_BAR();
    { PHASE_ENV(); phase_p1(F, P); }
    GRID_BAR();

    for (int l = 0; l < DEPTH; ++l) {
        const bool last = (l == DEPTH - 1);
        for (int rep = 0; rep < REP_GEMM1; ++rep) { PHASE_ENV(); pg8::Gemm g{(const bf16_t*)(ws + WS_HBUF), (const bf16_t*)(ws + WS_WIN) + (size_t)l * INP * D, NTOK, INP, D};
          pg8::StaticOrder S; S.init(NTOK, INP, F.G, F.bid);
          pg8::EpiStoreBf16 E{(bf16_t*)(ws + WS_PBUF), INP};
          pg8::gemm_phase<pg8::EpiStoreBf16, pg8::StaticOrder>(F.lds, g, S, E, F.tid); }
        GRID_BAR();
        for (int rep = 0; rep < REP_G1U; ++rep) { PHASE_ENV();
        for (int u = F.bid; u < 2080; u += F.G) { int row0, h;
            if (u < 2048) { const int bh = u >> 8, n = u & 255; h = bh & 3; row0 = (bh >> 2) * SEQ + 64 * n; }
            else { const int q = u - 2048, bh = q >> 2, n = q & 3; h = bh & 3; row0 = NLAT + (bh >> 2) * CTXL + 64 * n; }
            gla_g1_unit(F, P, l, row0, h, u); }
        __syncthreads(); }
        for (int rep = 0; rep < REP_F1U; ++rep) { PHASE_ENV();
        for (int u = F.bid; u < 1024; u += F.G) { const int b = u >> 9, nlo = (u >> 2) & 127, h = u & 3;
            fourier_f1_unit<128, 3>(F, P, b * SEQ + nlo, 128, h, (const bf16_t*)(ws + WS_TLAT) + (size_t)nlo * 32768, b * SEQ + nlo, 1.0f); }
        }
        { PHASE_ENV();
        if (!last) for (int u = F.bid; u < 8; u += F.G) { const int b = u >> 2, h = u & 3;
            fourier_f1_unit<256, 2>(F, P, NLAT + b * CTXL, 1, h, (const bf16_t*)(ws + WS_TCTX), NLAT + b * CTXL, 1.0f / 128.0f); }
        }
        for (int rep = 0; rep < REP_CONV; ++rep) { PHASE_ENV();
        for (int u = F.bid; u < (last ? 512 : 520); u += F.G) {
            if (u < 512) conv_unit(F, P, l, 64 * u, 64, 0);
            else { const int q = u - 512; conv_unit(F, P, l, NLAT + (q >> 2) * CTXL, CTXL, 64 * (q & 3)); } } }
        GRID_BAR();
        { PHASE_ENV(); gla_scan(F, P); }
        for (int rep = 0; rep < REP_F2U; ++rep) { PHASE_ENV();
        fourier_f2_tables(F, P);
        for (int u = F.bid; u < 512; u += F.G) fourier_f2_unit(F, P, u >> 8, (u >> 1) & 127, u & 1); }
        GRID_BAR();
        for (int rep = 0; rep < REP_G3U; ++rep) { PHASE_ENV();
        for (int u = F.bid; u < (last ? 2048 : 2080); u += F.G) { int row0, h;
            if (u < 2048) { const int bh = u >> 8, n = u & 255; h = bh & 3; row0 = (bh >> 2) * SEQ + 64 * n; }
            else { const int q = u - 2048, bh = q >> 2, n = q & 3; h = bh & 3; row0 = NLAT + (bh >> 2) * CTXL + 64 * n; }
            gla_g3_unit(F, P, l, row0, h, u); }
        __syncthreads(); }
        GRID_BAR();
        { PHASE_ENV(); const int M2 = last ? NLAT : NTOK;
          pg8::Gemm g{(const bf16_t*)(ws + WS_CAT), (const bf16_t*)(ws + WS_WOUT) + (size_t)l * D * D, M2, D, D};
          pg8::StaticOrder S; S.init(M2, D, F.G, F.bid);
          pg8::EpiResid E{(float*)(ws + WS_XRES), (const float*)(ws + WS_MODF) + (size_t)l * 3 * 6144};
          pg8::gemm_phase<pg8::EpiResid, pg8::StaticOrder>(F.lds, g, S, E, F.tid); }
        GRID_BAR();
        const int ntok = last ? NLAT : NTOK;
        { PHASE_ENV(); phase_route(F, P, l, ntok); }
        GRID_BAR();
        for (int rep = 0; rep < REP_GU; ++rep) { PHASE_ENV(); moe_prep(F, P, l); const volatile LAS int* TS = (const volatile LAS int*)(F.lds + LC_TS);
          pg8::Gemm g{(const bf16_t*)(ws + WS_HBUF), (const bf16_t*)(ws + WS_WGU) + (size_t)l * NE * 2048 * D, 0, 2048, D};
          pg8::MoeOrder S{8, F.G, F.bid, TS[NE], TS};
          pg8::EpiGateUp E{(bf16_t*)(ws + WS_ACT), P.in[22] + (size_t)l * NE * 2048};
          pg8::gemm_phase_gather<pg8::EpiGateUp, pg8::MoeOrder>(F.lds, g, (const int*)(ws + WS_XB), S, E, F.tid); }
        GRID_BAR();
        for (int rep = 0; rep < REP_DN; ++rep) { PHASE_ENV(); const volatile LAS int* TS = (const volatile LAS int*)(F.lds + LC_TS);
          pg8::Gemm g{(const bf16_t*)(ws + WS_ACT), (const bf16_t*)(ws + WS_WDN) + (size_t)l * NE * D * DFF, 0, D, DFF};
          pg8::MoeOrder S{4, F.G, F.bid, TS[NE], TS};
          pg8::EpiDown E{(bf16_t*)(ws + WS_YB), P.in[24] + (size_t)l * NE * D};
          pg8::gemm_phase<pg8::EpiDown, pg8::MoeOrder>(F.lds, g, S, E, F.tid); }
        GRID_BAR();
        { PHASE_ENV(); phase_combine(F, P, l, ntok, last); }
        if (!last) GRID_BAR();
    }
}

extern "C" void kernel_launch(void* const* d_in, const int* in_sizes, int n_in, void* d_out, int out_size, void* d_ws, size_t ws_size, hipStream_t stream) {
    static int grid = 0;
    if (grid == 0) {
        if (n_in != 26 || ws_size < WS_END) { fprintf(stderr, "kernel_launch: unexpected n_in %d or ws_size %zu (need %zu)\n", n_in, ws_size, (size_t)WS_END); grid = -1; return; }
        int dev = 0, cus = 0, per_cu = 0;
        if (hipGetDevice(&dev) != hipSuccess || hipDeviceGetAttribute(&cus, hipDeviceAttributeMultiprocessorCount, dev) != hipSuccess) { grid = -1; return; }
        if (hipFuncSetAttribute((const void*)mega_fwd, hipFuncAttributeMaxDynamicSharedMemorySize, LDS_BYTES) != hipSuccess) { fprintf(stderr, "kernel_launch: hipFuncSetAttribute failed\n"); grid = -1; return; }
        if (hipOccupancyMaxActiveBlocksPerMultiprocessor(&per_cu, (const void*)mega_fwd, NTHREADS, LDS_BYTES) != hipSuccess || per_cu < 1) { fprintf(stderr, "kernel_launch: occupancy query says %d\n", per_cu); }
        (void)hipGetLastError();
        grid = cus;
    }
    if (grid < 0) return;
    (void)hipMemsetAsync((char*)d_ws + WS_CTL, 0, CTL_ZERO_BYTES, stream);
    Params p{};
    for (int i = 0; i < 26; ++i) p.in[i] = (const float*)d_in[i];
    p.out = (float*)d_out; p.ws = (unsigned char*)d_ws;
    hipLaunchKernelGGL(mega_fwd, dim3(grid), dim3(NTHREADS), LDS_BYTES, stream, p);
}
```

```cpp
#include <hip/hip_runtime.h>
#include <cstdio>
#include <cstdint>

#define LAS __attribute__((address_space(3)))
#define GAS __attribute__((address_space(1)))
typedef unsigned short bf16_t;
typedef short bf16x8 __attribute__((ext_vector_type(8)));
typedef float f32x4 __attribute__((ext_vector_type(4)));
typedef float f32x2 __attribute__((ext_vector_type(2)));
typedef unsigned u32x4 __attribute__((ext_vector_type(4)));
typedef unsigned u32x2 __attribute__((ext_vector_type(2)));

constexpr int D = 1024, NBATCH = 2, SEQ = 16384, NLAT = NBATCH * SEQ, CTXL = 256, NCTX = NBATCH * CTXL, NTOK = NLAT + NCTX, DEPTH = 2;
constexpr int INW = 2336, INP = 2304;
constexpr int C_FOUR = 0, C_Q = 256, C_K = 512, C_V = 768, C_R = 1280, C_CA = 1792, C_CG = 2048;
constexpr int NE = 32, TOPK = 4, DFF = 1024;
constexpr int MAXROWS = NTOK * TOPK + NE * 256;
constexpr float NORM_EPS = 1e-6f;
constexpr int NTHREADS = 512, NWAVES = 8;

constexpr size_t MiB = 1u << 20;
constexpr size_t WS_CTL = 0, CTL_ZERO_BYTES = 1 * MiB;
constexpr size_t WS_MODP = 1 * MiB;
constexpr size_t WS_MODF = 3 * MiB;
constexpr size_t WS_RW = 3 * MiB + 512 * 1024;
constexpr size_t WS_WGT = 3 * MiB + 768 * 1024;
constexpr size_t WS_CM3 = 4 * MiB;
constexpr size_t WS_TF2 = 4 * MiB + 65536;
constexpr size_t WS_TCTX = 4 * MiB + 262144;
constexpr size_t WS_TLAT = 5 * MiB;
constexpr size_t WS_WIN = 13 * MiB;
constexpr size_t WS_WOUT = 23 * MiB;
constexpr size_t WS_WGU = 27 * MiB;
constexpr size_t WS_WDN = 283 * MiB;
constexpr size_t WS_XRES = 411 * MiB;
constexpr size_t WS_HBUF = 541 * MiB;
constexpr size_t WS_PBUF = 606 * MiB;
constexpr size_t WS_CAT = 769 * MiB;
constexpr size_t WS_T2 = 834 * MiB;
constexpr size_t WS_STATE = 866 * MiB;
constexpr size_t WS_DECAY = 996 * MiB;
constexpr size_t WS_AEXP = 998 * MiB, WS_APOS = 999 * MiB, WS_APROB = 1000 * MiB, WS_ASLOT = 1001 * MiB;
constexpr size_t WS_LRB = 1018 * MiB;
constexpr size_t WS_XB = 1002 * MiB, WS_ACT = 1278 * MiB, WS_YB = 1554 * MiB, WS_END = 1830 * MiB;
constexpr int CW_BAR = 4096, CW_CNT = 16384;

constexpr int RING_BYTES = 131072;
constexpr int AUX_OFF = RING_BYTES;
constexpr int LCTL_OFF = RING_BYTES + 8192;
constexpr int LDS_BYTES = 147456;

__device__ __forceinline__ unsigned f2bf(float f) { unsigned u = __builtin_bit_cast(unsigned, f); return (u + 0x7fffu + ((u >> 16) & 1u)) >> 16; }
__device__ __forceinline__ unsigned pk2(float lo, float hi) { return f2bf(lo) | (f2bf(hi) << 16); }
__device__ __forceinline__ float bf2f(unsigned b) { return __builtin_bit_cast(float, b << 16); }
__device__ __forceinline__ float bflo(unsigned w) { return __builtin_bit_cast(float, w << 16); }
__device__ __forceinline__ float bfhi(unsigned w) { return __builtin_bit_cast(float, w & 0xffff0000u); }
__device__ __forceinline__ float wave_sum(float v) {
#pragma unroll
    for (int o = 1; o < 64; o <<= 1) v += __shfl_xor(v, o);
    return v;
}
__device__ __forceinline__ float sigmoidf_(float x) { return __builtin_amdgcn_rcpf(1.0f + __expf(-x)); }

#define XB_TMO      128
#define XB_XCNT(j)  (256  + 64 * (j))
#define XB_XSUB(j)  (1280 + 64 * (j))
#define XB_XGEN(j)  (2304 + 64 * (j))
#define XB_TOP      3328
#define XB_TOPGEN   3392
#define XCD_BAR_WORDS 3456
#define XB_SPIN_CAP (1u << 22)

__device__ __forceinline__ unsigned xb_ld(unsigned* p)              { return __hip_atomic_load(p, __ATOMIC_RELAXED, __HIP_MEMORY_SCOPE_AGENT); }
__device__ __forceinline__ unsigned xb_add(unsigned* p, unsigned v) { return __hip_atomic_fetch_add(p, v, __ATOMIC_RELAXED, __HIP_MEMORY_SCOPE_AGENT); }
__device__ __forceinline__ unsigned xb_xcc_id() { return (unsigned)__builtin_amdgcn_s_getreg((3 << 11) | 20) & 0xFu; }
#define XB_SPIN(cond, bar) do { unsigned _sp = 0; while (cond) { __builtin_amdgcn_s_sleep(1); \
    if ((++_sp & 255u) == 0u) { if (xb_ld(&(bar)[XB_TMO])) break; if (_sp > XB_SPIN_CAP) { atomicAdd(&(bar)[XB_TMO], 1u); break; } } } } while (0)

struct XcdBarrier { unsigned* bar; unsigned x; volatile LAS unsigned* st; };

__device__ __forceinline__ XcdBarrier xcd_barrier_post(unsigned* bar, volatile LAS unsigned* st) {
    XcdBarrier b; b.bar = bar; b.x = xb_xcc_id(); b.st = st;
    if (threadIdx.x == 0) (void)xb_add(&bar[XB_XCNT(b.x)], 1u);
    return b;
}
__device__ __forceinline__ void xcd_barrier_complete(unsigned* bar, unsigned x, unsigned& nloc, unsigned& nx) {
    const unsigned G = gridDim.x * gridDim.y * gridDim.z;
    unsigned sum, cnt, mine, sp = 0u;
    for (;;) {
        sum = 0u; cnt = 0u; mine = 0u;
#pragma unroll
        for (unsigned j = 0; j < 16; ++j) { const unsigned c = xb_ld(&bar[XB_XCNT(j)]); sum += c; cnt += (c > 0u) ? 1u : 0u; mine = (j == x) ? c : mine; }
        if (sum == G) break;
        __builtin_amdgcn_s_sleep(1);
        if ((++sp & 255u) == 0u) { if (xb_ld(&bar[XB_TMO])) break; if (sp > XB_SPIN_CAP) { atomicAdd(&bar[XB_TMO], 1u); break; } }
    }
    nloc = mine > 0u ? mine : 1u; nx = cnt > 0u ? cnt : 1u;
}
__device__ __forceinline__ void xcd_barrier(const XcdBarrier& b) {
    asm volatile("s_waitcnt vmcnt(0)" ::: "memory");
    __syncthreads();
    if (threadIdx.x == 0) {
        unsigned* bar = b.bar;
        __builtin_amdgcn_s_waitcnt(0);
        unsigned nloc = b.st[0], nx = b.st[1];
        if (nloc == 0u) { xcd_barrier_complete(bar, b.x, nloc, nx); b.st[0] = nloc; b.st[1] = nx; }
        const unsigned old = xb_add(&bar[XB_XSUB(b.x)], 1u);
        const unsigned gen = old / nloc;
        if (old + 1u == (gen + 1u) * nloc) {
            __builtin_amdgcn_fence(__ATOMIC_RELEASE, "agent");
            asm volatile("s_waitcnt vmcnt(0)" ::: "memory");
            const unsigned og = xb_add(&bar[XB_TOP], 1u);
            const unsigned tg = og / nx;
            if (og + 1u == (tg + 1u) * nx) xb_add(&bar[XB_TOPGEN], 1u);
            else XB_SPIN(xb_ld(&bar[XB_TOPGEN]) == tg, bar);
            __builtin_amdgcn_fence(__ATOMIC_ACQUIRE, "agent");
            xb_add(&bar[XB_XGEN(b.x)], 1u);
            asm volatile("s_waitcnt vmcnt(0)" ::: "memory");
        } else {
            XB_SPIN(xb_ld(&bar[XB_XGEN(b.x)]) == gen, bar);
            __builtin_amdgcn_fence(__ATOMIC_ACQUIRE, "agent");
            asm volatile("s_waitcnt vmcnt(0)" ::: "memory");
        }
    }
    __syncthreads();
}

namespace pg8 {
constexpr int BM = 256, BK = 64, HALF = 128, HTB = HALF * BK * 2, STAGE_BYTES = 8 * HTB, NXCD = 8, WGM = 8;
__host__ __device__ __forceinline__ int lds_byte(int r, int c) { const int st = (r >> 4) * 2 + (c >> 5), rr = r & 15, cc = c & 31, ob = rr * 64 + cc * 2; return st * 1024 + (ob ^ (((ob >> 9) & 1) << 5)); }
__host__ __device__ __forceinline__ void stage_rc(int b, int& R, int& C) { const int st = b / 1024, sb = b % 1024, swz = sb ^ (((sb >> 9) & 1) << 5); R = (st >> 1) * 16 + swz / 64; C = (st & 1) * 32 + (swz % 64) / 2; }
__host__ __device__ __forceinline__ int perm32(int rho) { const int n = rho >> 4, i = rho & 15; return 8 * (i >> 2) + 4 * n + (i & 3); }

struct Unit { int pm, pn, lbase, nvalid; };
struct Gemm { const bf16_t* A; const bf16_t* Bt; int M, N, K; };

struct StaticOrder {
    int nM, nN, nwg, G, c;
    __device__ void init(int M, int N, int G_, int c_) { nM = M / BM; nN = N / BM; nwg = nM * nN; G = G_; c = c_; }
    __device__ bool next(int i, Unit& u) const {
        const long L = (long)i * G + c; if (L >= nwg) return false;
        int wgid = (int)L; { const int q = nwg / NXCD, r = nwg % NXCD, xcd = wgid % NXCD, off = wgid / NXCD; wgid = (xcd < r ? xcd * (q + 1) : r * (q + 1) + (xcd - r) * q) + off; }
        const int nig = WGM * nN, gid = wgid / nig, fm = gid * WGM, gsz = (nM - fm) < WGM ? (nM - fm) : WGM;
        u.pm = fm + ((wgid % nig) % gsz); u.pn = (wgid % nig) / gsz; u.lbase = 0; u.nvalid = 0; return true;
    }
};
struct MoeOrder {
    int nN, G, c, MT; const volatile LAS int* ts;
    __device__ bool next(int i, Unit& u) const {
        const long L = (G % 8 == 0) ? ((long)i * G + (long)(c & 7) * (G >> 3) + (c >> 3)) : ((long)i * G + c);
        if (L >= (long)MT * nN) return false;
        const int mt = (int)(L / nN), pl = (int)(L % nN);
        const int lane = threadIdx.x & 63;
        const unsigned long long bal = __ballot(lane >= 1 && lane < NE && ts[lane] <= mt);
        const int e = __popcll(bal);
        const int j = mt - ts[e];
        u.pm = mt; u.pn = e * nN + pl; u.lbase = e * NTOK + j * 256; u.nvalid = ts[64 + e] - j * 256; return true;
    }
};

__device__ __forceinline__ unsigned cvt_pk_bf16(float lo, float hi) { unsigned r; asm volatile("v_cvt_pk_bf16_f32 %0, %1, %2" : "=v"(r) : "v"(lo), "v"(hi)); return r; }

struct EpiStoreBf16 {
    static constexpr bool PERM = true;
    bf16_t* O; int ldc;
    __device__ __forceinline__ void operator()(const f32x4 (&acc)[2][2][4][2], const Unit& u, int wr, int wc, int fr, int fq) const {
        const int row0 = u.pm * BM + wr * 64 + fr; const int col0 = u.pn * BM + wc * 32 + 8 * fq;
#pragma unroll
        for (int ai = 0; ai < 2; ++ai)
#pragma unroll
            for (int m = 0; m < 4; ++m) { bf16_t* rowp = O + (size_t)(row0 + ai * HALF + m * 16) * ldc + col0;
#pragma unroll
                for (int bj = 0; bj < 2; ++bj) { const f32x4 v0 = acc[ai][bj][m][0], v1 = acc[ai][bj][m][1];
                    u32x4 w; w.x = cvt_pk_bf16(v0[0], v0[1]); w.y = cvt_pk_bf16(v0[2], v0[3]); w.z = cvt_pk_bf16(v1[0], v1[1]); w.w = cvt_pk_bf16(v1[2], v1[3]);
                    *(u32x4*)(rowp + bj * HALF) = w; } }
    }
};
struct EpiResid {
    static constexpr bool PERM = false;
    float* X; const float* Xs; const float* modf;
    __device__ __forceinline__ void operator()(const f32x4 (&acc)[2][2][4][2], const Unit& u, int wr, int wc, int fr, int fq) const {
        const int row0 = u.pm * BM + wr * 64 + fr, col0 = u.pn * BM + wc * 32 + 4 * fq;
        const int v = (u.pm >= NLAT / BM) ? 2 : (u.pm >= SEQ / BM ? 1 : 0);
        const float* gv = modf + (size_t)v * 6144 + 2 * 1024;
        f32x4 bv[2][2];
#pragma unroll
        for (int bj = 0; bj < 2; ++bj)
#pragma unroll
            for (int n = 0; n < 2; ++n) bv[bj][n] = *(const f32x4*)(gv + col0 + bj * HALF + n * 16);
#pragma unroll
        for (int ai = 0; ai < 2; ++ai) {
            f32x4 xv[4][2][2];
#pragma unroll
            for (int m = 0; m < 4; ++m) { const float* rowp = Xs + (size_t)(row0 + ai * HALF + m * 16) * D + col0;
#pragma unroll
                for (int bj = 0; bj < 2; ++bj)
#pragma unroll
                    for (int n = 0; n < 2; ++n) xv[m][bj][n] = *(const f32x4*)(rowp + bj * HALF + n * 16); }
#pragma unroll
            for (int m = 0; m < 4; ++m) { float* rowp = X + (size_t)(row0 + ai * HALF + m * 16) * D + col0;
#pragma unroll
                for (int bj = 0; bj < 2; ++bj)
#pragma unroll
                    for (int n = 0; n < 2; ++n) *(f32x4*)(rowp + bj * HALF + n * 16) = xv[m][bj][n] + bv[bj][n] * acc[ai][bj][m][n]; }
        }
    }
};
struct EpiGateUp {
    static constexpr bool PERM = true;
    bf16_t* O; const float* bgu;
    __device__ __forceinline__ void operator()(const f32x4 (&acc)[2][2][4][2], const Unit& u, int wr, int wc, int fr, int fq) const {
        const int e = u.pn >> 3, pl = u.pn & 7;
        const int row0 = u.pm * BM + wr * 64 + fr; const int cl = pl * 128 + wc * 32 + 8 * fq;
        const float* bg = bgu + (size_t)e * 2048 + cl; const float* bu = bg + 1024;
        f32x4 g0 = *(const f32x4*)bg, g1 = *(const f32x4*)(bg + 4), u0 = *(const f32x4*)bu, u1 = *(const f32x4*)(bu + 4);
#pragma unroll
        for (int ai = 0; ai < 2; ++ai)
#pragma unroll
            for (int m = 0; m < 4; ++m) { bf16_t* rowp = O + (size_t)(row0 + ai * HALF + m * 16) * DFF + cl;
                float r[8];
#pragma unroll
                for (int n = 0; n < 2; ++n) { const f32x4 gb = n ? g1 : g0, ub = n ? u1 : u0; const f32x4 ga = acc[ai][0][m][n] + gb, ua = acc[ai][1][m][n] + ub;
#pragma unroll
                    for (int j = 0; j < 4; ++j) { const float gate = fminf(ga[j], 7.0f), up = fminf(fmaxf(ua[j], -7.0f), 7.0f);
                        r[n * 4 + j] = gate * __builtin_amdgcn_rcpf(1.0f + __expf(-1.702f * gate)) * (up + 1.0f); } }
                u32x4 w; w.x = cvt_pk_bf16(r[0], r[1]); w.y = cvt_pk_bf16(r[2], r[3]); w.z = cvt_pk_bf16(r[4], r[5]); w.w = cvt_pk_bf16(r[6], r[7]);
                *(u32x4*)rowp = w; }
    }
};
struct EpiDown {
    static constexpr bool PERM = true;
    bf16_t* O; const float* bdn;
    __device__ __forceinline__ void operator()(const f32x4 (&acc)[2][2][4][2], const Unit& u, int wr, int wc, int fr, int fq) const {
        const int e = u.pn >> 2, pl = u.pn & 3;
        const int row0 = u.pm * BM + wr * 64 + fr; const int col0 = pl * BM + wc * 32 + 8 * fq;
        f32x4 bv[2][2];
#pragma unroll
        for (int bj = 0; bj < 2; ++bj)
#pragma unroll
            for (int n = 0; n < 2; ++n) bv[bj][n] = *(const f32x4*)(bdn + (size_t)e * 1024 + col0 + bj * HALF + 4 * n);
#pragma unroll
        for (int ai = 0; ai < 2; ++ai)
#pragma unroll
            for (int m = 0; m < 4; ++m) { bf16_t* rowp = O + (size_t)(row0 + ai * HALF + m * 16) * D + col0;
#pragma unroll
                for (int bj = 0; bj < 2; ++bj) { const f32x4 v0 = acc[ai][bj][m][0] + bv[bj][0], v1 = acc[ai][bj][m][1] + bv[bj][1];
                    u32x4 w; w.x = cvt_pk_bf16(v0[0], v0[1]); w.y = cvt_pk_bf16(v0[2], v0[3]); w.z = cvt_pk_bf16(v1[0], v1[1]); w.w = cvt_pk_bf16(v1[2], v1[3]);
                    *(u32x4*)(rowp + bj * HALF) = w; } }
    }
};

template <class Epi, class Sched, bool ALIGN_EPI = true, bool SP2 = true>
__device__ __forceinline__ void gemm_phase(LAS unsigned char* lds, const Gemm g, const Sched& S, const Epi& E, const int tid) {
    const int wid = __builtin_amdgcn_readfirstlane(tid >> 6), lane = tid & 63, wr = wid >> 2, wc = wid & 3, fr = lane & 15, fq = lane >> 4;
    const int K = g.K, nt = K / BK;
    unsigned voffA[2], voffB[2];
#pragma unroll
    for (int i = 0; i < 2; ++i) { int R, C; stage_rc(tid * 16 + i * 8192, R, C); const int Rb = Epi::PERM ? ((R & ~31) + perm32(R & 31)) : R;
        voffA[i] = (unsigned)(R * K + C) * 2u; voffB[i] = (unsigned)(Rb * K + C) * 2u; }
    const size_t kstep = (size_t)(BK * 2);
    const size_t hstep = (size_t)HALF * K * 2;
    const size_t tstep = 2 * hstep;
    const unsigned ldsw = (unsigned)wid * 1024u;
    const int aoff = lds_byte(wr * 64 + fr, fq * 8), boff = lds_byte(wc * 32 + fr, fq * 8);
#define PG8_SA(b, h) (((b) * 2 + (h)) * HTB)
#define PG8_SB(b, h) ((4 + (b) * 2 + (h)) * HTB)
#define PG8_STAGE(bufoff, gbase, voff) do { _Pragma("unroll") for (int _i = 0; _i < 2; ++_i) \
        __builtin_amdgcn_global_load_lds((const unsigned*)((const char*)(gbase) + (voff)[_i]), (LAS unsigned*)(lds + (bufoff) + ldsw + _i * 8192), 16, 0, 0); } while (0)
#define PG8_LDA(dst, b, h) do { _Pragma("unroll") for (int m = 0; m < 4; ++m) _Pragma("unroll") for (int k = 0; k < 2; ++k) dst[m][k] = *(const LAS bf16x8*)(lds + PG8_SA(b, h) + aoff + m * 2048 + k * 1024); } while (0)
#define PG8_LDB(dst, b, h) do { _Pragma("unroll") for (int n = 0; n < 2; ++n) _Pragma("unroll") for (int k = 0; k < 2; ++k) dst[n][k] = *(const LAS bf16x8*)(lds + PG8_SB(b, h) + boff + n * 2048 + k * 1024); } while (0)
#define PG8_MMA(ai, bj, At, Bt) do { __builtin_amdgcn_s_setprio(1); _Pragma("unroll") for (int m = 0; m < 4; ++m) _Pragma("unroll") for (int n = 0; n < 2; ++n) _Pragma("unroll") for (int k = 0; k < 2; ++k) \
        acc[ai][bj][m][n] = __builtin_amdgcn_mfma_f32_16x16x32_bf16(Bt[n][k], At[m][k], acc[ai][bj][m][n], 0, 0, 0); __builtin_amdgcn_s_setprio(0); } while (0)
#define PG8_WAIT_V(n) asm volatile("s_waitcnt vmcnt(" #n ")" ::: "memory")
#define PG8_WAIT_L(n) asm volatile("s_waitcnt lgkmcnt(" #n ")" ::: "memory")
#define PG8_BAR __builtin_amdgcn_s_barrier()
#define PG8_SCHED __builtin_amdgcn_sched_barrier(0)
    Unit cur, nxt; int ui = 0;
    if (!S.next(0, cur)) return;
    f32x4 acc[2][2][4][2];
#pragma unroll
    for (int a = 0; a < 2; ++a)
#pragma unroll
        for (int b = 0; b < 2; ++b)
#pragma unroll
            for (int m = 0; m < 4; ++m)
#pragma unroll
                for (int n = 0; n < 2; ++n) acc[a][b][m][n] = (f32x4){0.f, 0.f, 0.f, 0.f};
    bf16x8 At[4][2], B0[2][2], B1[2][2];
    const char* cA = (const char*)g.A + (size_t)cur.pm * tstep; const char* cB = (const char*)g.Bt + (size_t)cur.pn * tstep;
    if constexpr (SP2) {
        PG8_STAGE(PG8_SB(0, 0), cB, voffB); PG8_STAGE(PG8_SB(0, 1), cB + hstep, voffB); PG8_STAGE(PG8_SA(0, 0), cA, voffA); PG8_STAGE(PG8_SA(0, 1), cA + hstep, voffA);
        if (wr == 1) PG8_BAR;
        PG8_WAIT_V(2); PG8_BAR;
        PG8_STAGE(PG8_SB(1, 0), cB + kstep, voffB); PG8_STAGE(PG8_SA(1, 0), cA + kstep, voffA); PG8_STAGE(PG8_SB(1, 1), cB + hstep + kstep, voffB);
        PG8_WAIT_V(6); PG8_BAR;
    } else {
        PG8_STAGE(PG8_SB(0, 0), cB, voffB); PG8_STAGE(PG8_SA(0, 0), cA, voffA); PG8_STAGE(PG8_SB(0, 1), cB + hstep, voffB); PG8_STAGE(PG8_SA(0, 1), cA + hstep, voffA);
        if (wr == 1) PG8_BAR;
        PG8_WAIT_V(4); PG8_BAR;
        PG8_STAGE(PG8_SB(1, 0), cB + kstep, voffB); PG8_STAGE(PG8_SA(1, 0), cA + kstep, voffA); PG8_STAGE(PG8_SB(1, 1), cB + hstep + kstep, voffB);
        PG8_WAIT_V(6); PG8_BAR;
    }
    for (;;) {
        const bool has_next = S.next(ui + 1, nxt);
        const char* nA = has_next ? (const char*)g.A + (size_t)nxt.pm * tstep : cA; const char* nB = has_next ? (const char*)g.Bt + (size_t)nxt.pn * tstep : cB;
        for (int t = 0; t < nt; t += 2) {
            const bool last = (t == nt - 2);
            const char* a1 = cA + (size_t)(t + 1) * kstep;
            const char* a2 = last ? nA : cA + (size_t)(t + 2) * kstep; const char* b2 = last ? nB : cB + (size_t)(t + 2) * kstep;
            const char* a3 = a2 + kstep; const char* b3 = b2 + kstep;
            if constexpr (SP2) {
            PG8_LDB(B0, 0, 0); PG8_LDB(B1, 0, 1); PG8_SCHED; PG8_LDA(At, 0, 0); PG8_STAGE(PG8_SA(1, 1), a1 + hstep, voffA);
            PG8_WAIT_V(8); PG8_WAIT_L(0); PG8_BAR; PG8_MMA(0, 0, At, B0); PG8_MMA(0, 1, At, B1); PG8_BAR; PG8_SCHED;
            PG8_LDA(At, 0, 1); PG8_STAGE(PG8_SB(0, 0), b2, voffB); PG8_STAGE(PG8_SB(0, 1), b2 + hstep, voffB); PG8_STAGE(PG8_SA(0, 0), a2, voffA);
            PG8_WAIT_V(8); PG8_WAIT_L(0); PG8_BAR; PG8_MMA(1, 0, At, B0); PG8_MMA(1, 1, At, B1); PG8_BAR; PG8_SCHED;
            PG8_LDB(B0, 1, 0); PG8_LDB(B1, 1, 1); PG8_SCHED; PG8_LDA(At, 1, 0); PG8_STAGE(PG8_SA(0, 1), a2 + hstep, voffA);
            PG8_WAIT_V(8); PG8_WAIT_L(0); PG8_BAR; PG8_MMA(0, 0, At, B0); PG8_MMA(0, 1, At, B1); PG8_BAR; PG8_SCHED;
            PG8_LDA(At, 1, 1); PG8_STAGE(PG8_SB(1, 0), b3, voffB); PG8_STAGE(PG8_SB(1, 1), b3 + hstep, voffB); PG8_STAGE(PG8_SA(1, 0), a3, voffA);
            PG8_WAIT_V(8); PG8_WAIT_L(0); PG8_BAR; PG8_MMA(1, 0, At, B0); PG8_MMA(1, 1, At, B1); PG8_BAR; PG8_SCHED;
            } else {
            PG8_LDB(B0, 0, 0); PG8_SCHED; PG8_LDA(At, 0, 0); PG8_STAGE(PG8_SA(1, 1), a1 + hstep, voffA);
            PG8_WAIT_L(8); PG8_BAR; PG8_WAIT_L(0); PG8_MMA(0, 0, At, B0); PG8_BAR; PG8_SCHED;
            PG8_LDB(B1, 0, 1); PG8_STAGE(PG8_SB(0, 0), b2, voffB);
            PG8_BAR; PG8_WAIT_L(0); PG8_MMA(0, 1, At, B1); PG8_BAR;
            PG8_LDA(At, 0, 1); PG8_STAGE(PG8_SA(0, 0), a2, voffA);
            PG8_BAR; PG8_WAIT_L(0); PG8_MMA(1, 0, At, B0); PG8_BAR; PG8_SCHED;
            PG8_STAGE(PG8_SB(0, 1), b2 + hstep, voffB);
            PG8_WAIT_V(6); PG8_BAR; PG8_MMA(1, 1, At, B1); PG8_BAR;
            PG8_LDB(B0, 1, 0); PG8_SCHED; PG8_LDA(At, 1, 0); PG8_STAGE(PG8_SA(0, 1), a2 + hstep, voffA);
            PG8_WAIT_L(8); PG8_BAR; PG8_WAIT_L(0); PG8_MMA(0, 0, At, B0); PG8_BAR; PG8_SCHED;
            PG8_LDB(B1, 1, 1); PG8_STAGE(PG8_SB(1, 0), b3, voffB);
            PG8_BAR; PG8_WAIT_L(0); PG8_MMA(0, 1, At, B1); PG8_BAR;
            PG8_LDA(At, 1, 1); PG8_STAGE(PG8_SA(1, 0), a3, voffA);
            PG8_BAR; PG8_WAIT_L(0); PG8_MMA(1, 0, At, B0); PG8_BAR; PG8_SCHED;
            PG8_STAGE(PG8_SB(1, 1), b3 + hstep, voffB);
            PG8_WAIT_V(6); PG8_BAR; PG8_MMA(1, 1, At, B1); PG8_BAR;
            }
        }
        if constexpr (ALIGN_EPI) { if (wr == 0) PG8_BAR; }
        E(acc, cur, wr, wc, fr, fq);
        if (!has_next) break;
#pragma unroll
        for (int a = 0; a < 2; ++a)
#pragma unroll
            for (int b = 0; b < 2; ++b)
#pragma unroll
                for (int m = 0; m < 4; ++m)
#pragma unroll
                    for (int n = 0; n < 2; ++n) acc[a][b][m][n] = (f32x4){0.f, 0.f, 0.f, 0.f};
        cur = nxt; cA = nA; cB = nB; ++ui;
        if constexpr (ALIGN_EPI) { if (wr == 1) PG8_BAR; }
    }
    PG8_WAIT_V(0);
    if constexpr (!ALIGN_EPI) { if (wr == 0) PG8_BAR; }
    PG8_BAR;
#undef PG8_SA
#undef PG8_SB
#undef PG8_STAGE
#undef PG8_LDA
#undef PG8_LDB
#undef PG8_MMA
#undef PG8_WAIT_V
#undef PG8_WAIT_L
#undef PG8_BAR
#undef PG8_SCHED
}

template <class Epi, class Sched>
__device__ __forceinline__ void gemm_phase_gather(LAS unsigned char* lds, const Gemm g, const int* list, const Sched& S, const Epi& E, const int tid) {
    const int wid = __builtin_amdgcn_readfirstlane(tid >> 6), lane = tid & 63, wr = wid >> 2, wc = wid & 3, fr = lane & 15, fq = lane >> 4;
    const int K = g.K, nt = K / BK;
    unsigned voffB[2]; int rA[2]; unsigned cA2[2];
#pragma unroll
    for (int i = 0; i < 2; ++i) { int R, C; stage_rc(tid * 16 + i * 8192, R, C); const int Rb = Epi::PERM ? ((R & ~31) + perm32(R & 31)) : R;
        rA[i] = R; cA2[i] = (unsigned)C * 2u; voffB[i] = (unsigned)(Rb * K + C) * 2u; }
    const size_t kstep = (size_t)(BK * 2);
    const size_t hstep = (size_t)HALF * K * 2;
    const size_t tstep = 2 * hstep;
    const unsigned ldsw = (unsigned)wid * 1024u;
    const int aoff = lds_byte(wr * 64 + fr, fq * 8), boff = lds_byte(wc * 32 + fr, fq * 8);
#define PG8_SA(b, h) (((b) * 2 + (h)) * HTB)
#define PG8_SB(b, h) ((4 + (b) * 2 + (h)) * HTB)
#define PG8_STAGE(bufoff, gbase, voff) do { _Pragma("unroll") for (int _i = 0; _i < 2; ++_i) \
        __builtin_amdgcn_global_load_lds((const unsigned*)((const char*)(gbase) + (voff)[_i]), (LAS unsigned*)(lds + (bufoff) + ldsw + _i * 8192), 16, 0, 0); } while (0)
#define PG8_LDA(dst, b, h) do { _Pragma("unroll") for (int m = 0; m < 4; ++m) _Pragma("unroll") for (int k = 0; k < 2; ++k) dst[m][k] = *(const LAS bf16x8*)(lds + PG8_SA(b, h) + aoff + m * 2048 + k * 1024); } while (0)
#define PG8_LDB(dst, b, h) do { _Pragma("unroll") for (int n = 0; n < 2; ++n) _Pragma("unroll") for (int k = 0; k < 2; ++k) dst[n][k] = *(const LAS bf16x8*)(lds + PG8_SB(b, h) + boff + n * 2048 + k * 1024); } while (0)
#define PG8_MMA(ai, bj, At, Bt) do { __builtin_amdgcn_s_setprio(1); _Pragma("unroll") for (int m = 0; m < 4; ++m) _Pragma("unroll") for (int n = 0; n < 2; ++n) _Pragma("unroll") for (int k = 0; k < 2; ++k) \
        acc[ai][bj][m][n] = __builtin_amdgcn_mfma_f32_16x16x32_bf16(Bt[n][k], At[m][k], acc[ai][bj][m][n], 0, 0, 0); __builtin_amdgcn_s_setprio(0); } while (0)
#define PG8_WAIT_V(n) asm volatile("s_waitcnt vmcnt(" #n ")" ::: "memory")
#define PG8_WAIT_L(n) asm volatile("s_waitcnt lgkmcnt(" #n ")" ::: "memory")
#define PG8_BAR __builtin_amdgcn_s_barrier()
#define PG8_SCHED __builtin_amdgcn_sched_barrier(0)
#define PG8_LOADTOK(u, vo) do { _Pragma("unroll") for (int _h = 0; _h < 2; ++_h) _Pragma("unroll") for (int _i = 0; _i < 2; ++_i) { const int _r = _h * HALF + rA[_i]; \
        const int _tok = (_r < (u).nvalid) ? list[(u).lbase + _r] : 0; (vo)[_h][_i] = (unsigned)_tok * (unsigned)(K * 2) + cA2[_i]; } } while (0)
    Unit cur, nxt; int ui = 0;
    if (!S.next(0, cur)) return;
    f32x4 acc[2][2][4][2];
#pragma unroll
    for (int a = 0; a < 2; ++a)
#pragma unroll
        for (int b = 0; b < 2; ++b)
#pragma unroll
            for (int m = 0; m < 4; ++m)
#pragma unroll
                for (int n = 0; n < 2; ++n) acc[a][b][m][n] = (f32x4){0.f, 0.f, 0.f, 0.f};
    bf16x8 At[4][2], B0[2][2], B1[2][2];
    unsigned vc[2][2], vn[2][2];
    PG8_LOADTOK(cur, vc);
    const char* gA = (const char*)g.A; const char* cB = (const char*)g.Bt + (size_t)cur.pn * tstep;
    PG8_STAGE(PG8_SB(0, 0), cB, voffB); PG8_STAGE(PG8_SB(0, 1), cB + hstep, voffB); PG8_STAGE(PG8_SA(0, 0), gA, vc[0]); PG8_STAGE(PG8_SA(0, 1), gA, vc[1]);
    if (wr == 1) PG8_BAR;
    PG8_WAIT_V(2); PG8_BAR;
    PG8_STAGE(PG8_SB(1, 0), cB + kstep, voffB); PG8_STAGE(PG8_SA(1, 0), gA + kstep, vc[0]); PG8_STAGE(PG8_SB(1, 1), cB + hstep + kstep, voffB);
    PG8_WAIT_V(6); PG8_BAR;
    for (;;) {
        const bool has_next = S.next(ui + 1, nxt);
        if (has_next) { PG8_LOADTOK(nxt, vn); }
        const char* nB = has_next ? (const char*)g.Bt + (size_t)nxt.pn * tstep : cB;
        for (int t = 0; t < nt; t += 2) {
            const bool last = (t == nt - 2);
            const char* a1 = gA + (size_t)(t + 1) * kstep;
            const char* b2 = last ? nB : cB + (size_t)(t + 2) * kstep; const char* b3 = b2 + kstep;
            const char* a2 = last ? gA : gA + (size_t)(t + 2) * kstep; const char* a3 = a2 + kstep;
            PG8_LDB(B0, 0, 0); PG8_LDB(B1, 0, 1); PG8_SCHED; PG8_LDA(At, 0, 0); PG8_STAGE(PG8_SA(1, 1), a1, vc[1]);
            if (last && has_next) {
#pragma unroll
                for (int _h = 0; _h < 2; ++_h)
#pragma unroll
                    for (int _i = 0; _i < 2; ++_i) vc[_h][_i] = vn[_h][_i]; }
            PG8_WAIT_V(8); PG8_WAIT_L(0); PG8_BAR; PG8_MMA(0, 0, At, B0); PG8_MMA(0, 1, At, B1); PG8_BAR; PG8_SCHED;
            PG8_LDA(At, 0, 1); PG8_STAGE(PG8_SB(0, 0), b2, voffB); PG8_STAGE(PG8_SB(0, 1), b2 + hstep, voffB); PG8_STAGE(PG8_SA(0, 0), a2, vc[0]);
            PG8_WAIT_V(8); PG8_WAIT_L(0); PG8_BAR; PG8_MMA(1, 0, At, B0); PG8_MMA(1, 1, At, B1); PG8_BAR; PG8_SCHED;
            PG8_LDB(B0, 1, 0); PG8_LDB(B1, 1, 1); PG8_SCHED; PG8_LDA(At, 1, 0); PG8_STAGE(PG8_SA(0, 1), a2, vc[1]);
            PG8_WAIT_V(8); PG8_WAIT_L(0); PG8_BAR; PG8_MMA(0, 0, At, B0); PG8_MMA(0, 1, At, B1); PG8_BAR; PG8_SCHED;
            PG8_LDA(At, 1, 1); PG8_STAGE(PG8_SB(1, 0), b3, voffB); PG8_STAGE(PG8_SB(1, 1), b3 + hstep, voffB); PG8_STAGE(PG8_SA(1, 0), a3, vc[0]);
            PG8_WAIT_V(8); PG8_WAIT_L(0); PG8_BAR; PG8_MMA(1, 0, At, B0); PG8_MMA(1, 1, At, B1); PG8_BAR; PG8_SCHED;
        }
        if (wr == 0) PG8_BAR;
        E(acc, cur, wr, wc, fr, fq);
        if (!has_next) break;
#pragma unroll
        for (int a = 0; a < 2; ++a)
#pragma unroll
            for (int b = 0; b < 2; ++b)
#pragma unroll
                for (int m = 0; m < 4; ++m)
#pragma unroll
                    for (int n = 0; n < 2; ++n) acc[a][b][m][n] = (f32x4){0.f, 0.f, 0.f, 0.f};
        cur = nxt; cB = nB; ++ui;
        if (wr == 1) PG8_BAR;
    }
    PG8_WAIT_V(0);
    PG8_BAR;
#undef PG8_SA
#undef PG8_SB
#undef PG8_STAGE
#undef PG8_LDA
#undef PG8_LDB
#undef PG8_MMA
#undef PG8_WAIT_V
#undef PG8_WAIT_L
#undef PG8_BAR
#undef PG8_SCHED
#undef PG8_LOADTOK
}
}

struct Params {
    const float* in[26];
    float* out;
    unsigned char* ws;
};
struct Frame {
    LAS unsigned char* lds;
    int tid, lane, wave, G, bid;
};

template <int MT, int NT>
__device__ __forceinline__ void mma_nt(f32x4 (&acc)[MT][NT], const LAS bf16_t* A, int lda, const LAS bf16_t* B, int ldb, int K, int fr, int fq) {
    for (int k0 = 0; k0 < K; k0 += 32) {
        bf16x8 a[MT], b[NT];
#pragma unroll
        for (int m = 0; m < MT; ++m) a[m] = *(const LAS bf16x8*)(A + (m * 16 + fr) * lda + k0 + fq * 8);
#pragma unroll
        for (int n = 0; n < NT; ++n) b[n] = *(const LAS bf16x8*)(B + (n * 16 + fr) * ldb + k0 + fq * 8);
#pragma unroll
        for (int m = 0; m < MT; ++m)
#pragma unroll
            for (int n = 0; n < NT; ++n) acc[m][n] = __builtin_amdgcn_mfma_f32_16x16x32_bf16(a[m], b[n], acc[m][n], 0, 0, 0);
    }
}
template <int MT, int NT> __device__ __forceinline__ void zero_acc(f32x4 (&acc)[MT][NT]) {
#pragma unroll
    for (int m = 0; m < MT; ++m)
#pragma unroll
        for (int n = 0; n < NT; ++n) acc[m][n] = (f32x4){0.f, 0.f, 0.f, 0.f};
}

constexpr int SK_A = 0, SK_B = 69632;
template <class Epi>
__device__ __forceinline__ void skinny_unit(const Frame& F, const bf16_t* A, const bf16_t* Bt, const Epi& E) {
    LAS bf16_t* As = (LAS bf16_t*)(F.lds + SK_A); LAS bf16_t* Bs = (LAS bf16_t*)(F.lds + SK_B);
    const int tid = F.tid, fr = F.lane & 15, fq = F.lane >> 4, w = F.wave;
    f32x4 acc[2][2]; zero_acc<2, 2>(acc);
    u32x4 av[8], bv;
#pragma unroll
    for (int i = 0; i < 8; ++i) { const int ch = tid + NTHREADS * i, r = ch >> 4, c8 = (ch & 15) * 8; av[i] = *(const u32x4*)(A + (size_t)r * D + c8); }
    { const int r = tid >> 4, c8 = (tid & 15) * 8; bv = *(const u32x4*)(Bt + (size_t)r * D + c8); }
    for (int kc = 0; kc < 8; ++kc) {
        __syncthreads();
#pragma unroll
        for (int i = 0; i < 8; ++i) { const int ch = tid + NTHREADS * i, r = ch >> 4, c8 = (ch & 15) * 8; *(LAS u32x4*)(As + r * 136 + c8) = av[i]; }
        { const int r = tid >> 4, c8 = (tid & 15) * 8; *(LAS u32x4*)(Bs + r * 136 + c8) = bv; }
        if (kc + 1 < 8) {
#pragma unroll
            for (int i = 0; i < 8; ++i) { const int ch = tid + NTHREADS * i, r = ch >> 4, c8 = (ch & 15) * 8; av[i] = *(const u32x4*)(A + (size_t)r * D + (kc + 1) * 128 + c8); }
            { const int r = tid >> 4, c8 = (tid & 15) * 8; bv = *(const u32x4*)(Bt + (size_t)r * D + (kc + 1) * 128 + c8); } }
        __syncthreads();
        mma_nt<2, 2>(acc, As + (32 * w) * 136, 136, Bs, 136, 128, fr, fq);
    }
#pragma unroll
    for (int mt = 0; mt < 2; ++mt)
#pragma unroll
        for (int nt = 0; nt < 2; ++nt)
#pragma unroll
            for (int j = 0; j < 4; ++j) E(32 * w + mt * 16 + fq * 4 + j, nt * 16 + fr, acc[mt][nt][j]);
    __syncthreads();
}
struct SkEpiBf16 { bf16_t* O; int ldc; __device__ __forceinline__ void operator()(int r, int c, float v) const { O[(size_t)r * ldc + c] = (bf16_t)f2bf(v); } };
struct SkEpiResid { float* X; const float* Xs; const float* gate; __device__ __forceinline__ void operator()(int r, int c, float v) const { X[(size_t)r * D + c] = Xs[(size_t)r * D + c] + gate[c] * v; } };

__device__ __forceinline__ void p0_transpose_item(const float* W, int K, int N, bf16_t* WT, int k0, int n0, int orow0, LAS float* scr, int lane) {
    float tv[32];
#pragma unroll
    for (int i = 0; i < 32; ++i) { const int kk = 2 * i + (lane >> 5); tv[i] = W[(size_t)(k0 + kk) * N + n0 + (lane & 31)]; }
#pragma unroll
    for (int i = 0; i < 32; ++i) { const int kk = 2 * i + (lane >> 5); scr[kk * 33 + (lane & 31)] = tv[i]; }
    asm volatile("s_waitcnt lgkmcnt(0)" ::: "memory");
    const int c = lane & 7;
#pragma unroll
    for (int j = 0; j < 4; ++j) { const int n = (lane >> 3) + 8 * j; const LAS float* s = scr + (8 * c) * 33 + n;
        u32x4 o; o.x = pk2(s[0 * 33], s[1 * 33]); o.y = pk2(s[2 * 33], s[3 * 33]); o.z = pk2(s[4 * 33], s[5 * 33]); o.w = pk2(s[6 * 33], s[7 * 33]);
        *(u32x4*)(WT + (size_t)(orow0 + n) * K + k0 + 8 * c) = o; }
    asm volatile("s_waitcnt lgkmcnt(0)" ::: "memory");
}

__device__ __forceinline__ void phase_prologue(const Frame& F, const Params& P) {
    unsigned char* ws = P.ws;
    LAS float* scr = (LAS float*)(F.lds + F.wave * 16384);
    const int gw = F.bid * NWAVES + F.wave, NGW = F.G * NWAVES;
    constexpr int I_IN = 16 * 73, I_OUT = 16 * 32, I_GU = 16 * 64, I_DN = 16 * 32;
    constexpr int PER_LAYER = I_IN + I_OUT + NE * I_GU + NE * I_DN;
    for (int it = gw; it < DEPTH * PER_LAYER; it += NGW) {
        const int l = it / PER_LAYER; int r = it % PER_LAYER;
        if (r < I_IN) { const int kb = r / 73, nb = r % 73;
            if (nb == 56) p0_transpose_item(P.in[8] + (size_t)l * D * INW, D, INW, (bf16_t*)(ws + WS_WGT) + (size_t)l * 32 * D, 64 * kb, 32 * nb, 0, scr, F.lane);
            else p0_transpose_item(P.in[8] + (size_t)l * D * INW, D, INW, (bf16_t*)(ws + WS_WIN) + (size_t)l * INP * D, 64 * kb, 32 * nb, nb < 56 ? 32 * nb : 32 * (nb - 1), scr, F.lane);
            continue; }
        r -= I_IN;
        if (r < I_OUT) { const int kb = r / 32, nb = r % 32;
            p0_transpose_item(P.in[18] + (size_t)l * D * D, D, D, (bf16_t*)(ws + WS_WOUT) + (size_t)l * D * D, 64 * kb, 32 * nb, 32 * nb, scr, F.lane); continue; }
        r -= I_OUT;
        if (r < NE * I_GU) { const int e = r / I_GU, q = r % I_GU, kb = q / 64, nb = q % 64; const int n0 = 32 * nb;
            const int j = n0 & 1023, orow = 256 * (j >> 7) + (n0 >= 1024 ? 128 : 0) + (j & 127);
            p0_transpose_item(P.in[21] + ((size_t)l * NE + e) * D * 2048, D, 2048, (bf16_t*)(ws + WS_WGU) + ((size_t)l * NE + e) * 2048 * D, 64 * kb, n0, orow, scr, F.lane); continue; }
        r -= NE * I_GU;
        { const int e = r / I_DN, q = r % I_DN, kb = q / 32, nb = q % 32;
            p0_transpose_item(P.in[23] + ((size_t)l * NE + e) * DFF * D, DFF, D, (bf16_t*)(ws + WS_WDN) + ((size_t)l * NE + e) * D * DFF, 64 * kb, 32 * nb, 32 * nb, scr, F.lane); }
    }
    {
        const int gt = F.bid * NTHREADS + F.tid, NGT = F.G * NTHREADS;
        bf16_t* cm3 = (bf16_t*)(ws + WS_CM3);
        for (int i = gt; i < 192 * 64; i += NGT) { const int m = i >> 6, n2 = i & 63, part = m >> 6, k2 = m & 63; const int ph = (k2 * n2) & 63;
            float s, c; sincospif((float)ph * (1.0f / 32.0f), &s, &c); const float v = part == 0 ? c : (part == 1 ? -s : -c); cm3[i] = (bf16_t)f2bf(v); }
        bf16_t* rwt = (bf16_t*)(ws + WS_RW);
        for (int i = gt; i < DEPTH * NE * D; i += NGT) { const int l = i / (NE * D), q = i % (NE * D), k = q >> 5, e = q & 31;
            const float w = P.in[19][(size_t)l * D * NE + q]; const unsigned hi = f2bf(w); const unsigned lo = f2bf(w - bf2f(hi));
            rwt[((size_t)l * 2 + 0) * NE * D + e * D + k] = (bf16_t)hi; rwt[((size_t)l * 2 + 1) * NE * D + e * D + k] = (bf16_t)lo; }
        bf16_t* tf2 = (bf16_t*)(ws + WS_TF2);
        for (int i = gt; i < 128 * 128; i += NGT) { const int c_ = i >> 7, n = i & 127; const int ph = (c_ * n) & 127;
            float s, c; sincospif((float)ph * (1.0f / 64.0f), &s, &c); tf2[i] = (bf16_t)f2bf(c); tf2[128 * 128 + i] = (bf16_t)f2bf(s); }
        bf16_t* tctx = (bf16_t*)(ws + WS_TCTX);
        for (int i = gt; i < 256 * 256; i += NGT) { const int k1 = i >> 8, n = i & 255; const int ph = (k1 * n) & 255;
            float s, c; sincospif((float)ph * (1.0f / 128.0f), &s, &c); tctx[i] = (bf16_t)f2bf(c); tctx[256 * 256 + i] = (bf16_t)f2bf(s); }
        bf16_t* tlat = (bf16_t*)(ws + WS_TLAT);
        for (int i = gt; i < 128 * 128 * 128; i += NGT) { const int nlo = i >> 14, d = (i >> 7) & 127, a = i & 127; const int ph = (d * (nlo + 128 * a)) & 16383;
            float s, c; sincospif((float)ph * (1.0f / 8192.0f), &s, &c);
            tlat[(size_t)nlo * 32768 + d * 128 + a] = (bf16_t)f2bf(c); tlat[(size_t)nlo * 32768 + 16384 + d * 128 + a] = (bf16_t)f2bf(s); }
    }
    for (int it = gw; it < DEPTH * 24 * 8; it += NGW) {
        const int l = it / 192, q = it % 192, cb = q >> 3, ks = q & 7;
        const float* wm = P.in[6] + (size_t)l * D * 6144 + (size_t)(ks * 128) * 6144 + cb * 256 + 4 * F.lane;
        f32x4 a0 = {0.f, 0.f, 0.f, 0.f}, a1 = a0, a2 = a0;
#pragma unroll 4
        for (int k = 0; k < 128; ++k) { const int kk = ks * 128 + k;
            const float c0 = P.in[1][kk], c1 = P.in[1][D + kk], c2 = P.in[3][kk];
            const float s0 = c0 * sigmoidf_(c0), s1 = c1 * sigmoidf_(c1), s2 = c2 * sigmoidf_(c2);
            const f32x4 w = *(const f32x4*)(wm + (size_t)k * 6144);
            a0 += w * s0; a1 += w * s1; a2 += w * s2; }
        float* mp = (float*)(ws + WS_MODP) + ((size_t)(l * 8 + ks) * 3) * 6144 + cb * 256 + 4 * F.lane;
        *(f32x4*)(mp) = a0; *(f32x4*)(mp + 6144) = a1; *(f32x4*)(mp + 2 * 6144) = a2;
    }
}

__device__ __forceinline__ f32x4 mod_from_partials(const Params& P, int l, int v, int c4) {
    f32x4 s = *(const f32x4*)(P.in[7] + (size_t)l * 6144 + c4);
    const float* mp = (const float*)(P.ws + WS_MODP) + ((size_t)(l * 8) * 3 + v) * 6144 + c4;
#pragma unroll
    for (int ks = 0; ks < 8; ++ks) s += *(const f32x4*)(mp + (size_t)ks * 3 * 6144);
    return s;
}

__device__ __forceinline__ void norm_row_store(const f32x4 (&x)[4], const float* g, const f32x4 (&shv)[4], const f32x4 (&scv)[4], bf16_t* orow, int lane) {
    float ss = 0.f;
#pragma unroll
    for (int j = 0; j < 4; ++j) ss += (x[j].x * x[j].x + x[j].y * x[j].y) + (x[j].z * x[j].z + x[j].w * x[j].w);
    const float rstd = 1.0f / sqrtf(wave_sum(ss) * (1.0f / D) + NORM_EPS);
#pragma unroll
    for (int j = 0; j < 4; ++j) { const int c = 4 * lane + 256 * j;
        const f32x4 gv = *(const f32x4*)(g + c);
        const f32x4 y = (x[j] * rstd) * gv * (scv[j] + 1.0f) + shv[j];
        u32x2 o; o.x = pk2(y.x, y.y); o.y = pk2(y.z, y.w);
        *(u32x2*)(orow + c) = o; }
}

__device__ __forceinline__ void phase_p1(const Frame& F, const Params& P) {
    unsigned char* ws = P.ws;
    const int gt = F.bid * NTHREADS + F.tid, NGT = F.G * NTHREADS;
    float* modf = (float*)(ws + WS_MODF);
    for (int i = gt; i < DEPTH * 3 * 1536; i += NGT) { const int l = i / 4608, q = i % 4608, v = q / 1536, c4 = (q % 1536) * 4;
        *(f32x4*)(modf + ((size_t)l * 3 + v) * 6144 + c4) = mod_from_partials(P, l, v, c4); }
    const int gw = F.bid * NWAVES + F.wave, NGW = F.G * NWAVES;
    bf16_t* hb = (bf16_t*)(ws + WS_HBUF);
    int cur_v = -1; f32x4 shv[4], scv[4];
    for (int m = gw; m < NTOK; m += NGW) {
        const float* src = (m < NLAT) ? (P.in[0] + (size_t)m * D) : (P.in[2] + (size_t)(m - NLAT) * D);
        const int v = (m >= NLAT) ? 2 : (m >= SEQ ? 1 : 0);
        f32x4 x[4];
#pragma unroll
        for (int j = 0; j < 4; ++j) x[j] = *(const f32x4*)(src + 4 * F.lane + 256 * j);
        if (v != cur_v) { cur_v = v;
#pragma unroll
            for (int j = 0; j < 4; ++j) { const int c = 4 * F.lane + 256 * j; shv[j] = mod_from_partials(P, 0, v, c); scv[j] = mod_from_partials(P, 0, v, 1024 + c); } }
        norm_row_store(x, P.in[4], shv, scv, hb + (size_t)m * D, F.lane);
    }
}

constexpr int GL_GT = 0;
constexpr int GL_A1 = 34816, GL_KE = 60416, GL_VTB = 78848, GL_RS = 97280, GL_RT = 97792;
constexpr int GL_KDT = 34816, GL_VT = 53248;

__device__ __forceinline__ float logsigmoidf_(float x) { return fminf(x, 0.f) - __logf(1.0f + __expf(-fabsf(x))); }
__device__ __forceinline__ float bfel(const u32x4& v, int j) { const unsigned w = (j < 2) ? v.x : (j < 4 ? v.y : (j < 6 ? v.z : v.w)); return (j & 1) ? bfhi(w) : bflo(w); }
__device__ __forceinline__ unsigned short bfraw(const u32x4& v, int j) { const unsigned w = (j < 2) ? v.x : (j < 4 ? v.y : (j < 6 ? v.z : v.w)); return (unsigned short)((j & 1) ? (w >> 16) : (w & 0xffffu)); }

struct GateRegs { bf16x8 a[4]; bf16x8 b; float bg; };
__device__ __forceinline__ GateRegs gla_load_gate_regs(const Frame& F, const Params& P, int l, int row0, int h) {
    GateRegs g;
    const int dir = F.wave >> 2, dbase = (F.wave & 3) * 16, fr = F.lane & 15, fq = F.lane >> 4;
    const bf16x8 z8 = {0, 0, 0, 0, 0, 0, 0, 0};
    const bf16_t* lrb = (const bf16_t*)(P.ws + WS_LRB);
#pragma unroll
    for (int mt = 0; mt < 4; ++mt) g.a[mt] = (fq < 2) ? *(const bf16x8*)(lrb + (size_t)(row0 + mt * 16 + fr) * 32 + dir * 16 + fq * 8) : z8;
    const float* wgp = (dir ? P.in[11] : P.in[9]) + (size_t)l * 16 * 256 + 64 * h + dbase + fr;
    g.b = z8;
    if (fq < 2) {
#pragma unroll
        for (int j = 0; j < 8; ++j) g.b[j] = (short)f2bf(wgp[(fq * 8 + j) * 256]); }
    g.bg = (dir ? P.in[12] : P.in[10])[(size_t)l * 256 + 64 * h + dbase + fr];
    return g;
}
__device__ __forceinline__ void gla_gates(const Frame& F, const GateRegs& gr) {
    LAS float* GT = (LAS float*)(F.lds + GL_GT);
    const int dir = F.wave >> 2, dbase = (F.wave & 3) * 16, lane = F.lane, fr = lane & 15, fq = lane >> 4;
    float p[4][4]; float T[4];
#pragma unroll
    for (int mt = 0; mt < 4; ++mt) { const f32x4 acc = __builtin_amdgcn_mfma_f32_16x16x32_bf16(gr.a[mt], gr.b, (f32x4){0.f, 0.f, 0.f, 0.f}, 0, 0, 0);
#pragma unroll
        for (int j = 0; j < 4; ++j) p[mt][j] = logsigmoidf_(acc[j] + gr.bg) * (1.0f / 16.0f); }
    if (dir == 0) {
#pragma unroll
        for (int mt = 0; mt < 4; ++mt) { p[mt][1] += p[mt][0]; p[mt][2] += p[mt][1]; p[mt][3] += p[mt][2]; T[mt] = p[mt][3]; }
        float base = 0.f;
#pragma unroll
        for (int mt = 0; mt < 4; ++mt) { float inc = T[mt]; float v = __shfl_up(inc, 16); inc += (fq >= 1) ? v : 0.f; v = __shfl_up(inc, 32); inc += (fq >= 2) ? v : 0.f;
            const float off = base + (inc - T[mt]); const float ct = __shfl(inc, 48 + fr);
#pragma unroll
            for (int j = 0; j < 4; ++j) GT[(dbase + fr) * 65 + mt * 16 + fq * 4 + j] = off + p[mt][j];
            base += ct; }
    } else {
#pragma unroll
        for (int mt = 0; mt < 4; ++mt) { p[mt][2] += p[mt][3]; p[mt][1] += p[mt][2]; p[mt][0] += p[mt][1]; T[mt] = p[mt][0]; }
        float base = 0.f;
#pragma unroll
        for (int mt = 3; mt >= 0; --mt) { float inc = T[mt]; float v = __shfl_down(inc, 16); inc += (fq <= 2) ? v : 0.f; v = __shfl_down(inc, 32); inc += (fq <= 1) ? v : 0.f;
            const float off = base + (inc - T[mt]); const float ct = __shfl(inc, fr);
#pragma unroll
            for (int j = 0; j < 4; ++j) GT[(64 + dbase + fr) * 65 + mt * 16 + fq * 4 + j] = off + p[mt][j];
            base += ct; }
    }
}

__device__ __forceinline__ void gla_g1_unit(const Frame& F, const Params& P, int l, int row0, int h, int unit) {
    const bf16_t* pb = (const bf16_t*)(P.ws + WS_PBUF);
    const int tid = F.tid, row = F.lane, c8 = F.wave * 8;
    const GateRegs gr = gla_load_gate_regs(F, P, l, row0, h);
    const u32x4 kv = *(const u32x4*)(pb + (size_t)(row0 + row) * INP + C_K + 64 * h + c8);
    u32x4 vv[2];
#pragma unroll
    for (int i = 0; i < 2; ++i) { const int vr = F.lane, vc = (F.wave + 8 * i) * 8; vv[i] = *(const u32x4*)(pb + (size_t)(row0 + vr) * INP + C_V + 128 * h + vc); }
    gla_gates(F, gr);
    __syncthreads();
    LAS float* GT = (LAS float*)(F.lds + GL_GT);
    LAS bf16_t* KDT = (LAS bf16_t*)(F.lds + GL_KDT); LAS bf16_t* VT = (LAS bf16_t*)(F.lds + GL_VT);
#pragma unroll
    for (int j = 0; j < 8; ++j) { const int d = c8 + j; const float k_ = bfel(kv, j);
        KDT[d * 72 + row] = (bf16_t)f2bf(k_ * __expf(GT[d * 65 + 63] - GT[d * 65 + row])); KDT[(64 + d) * 72 + row] = (bf16_t)f2bf(k_ * __expf(GT[(64 + d) * 65] - GT[(64 + d) * 65 + row])); }
#pragma unroll
    for (int i = 0; i < 2; ++i) { const int vr = F.lane, vc = (F.wave + 8 * i) * 8;
#pragma unroll
        for (int j = 0; j < 8; ++j) VT[(vc + j) * 72 + vr] = bfraw(vv[i], j); }
    if (tid < 128) ((float*)(P.ws + WS_DECAY))[(size_t)unit * 128 + tid] = __expf(tid < 64 ? GT[tid * 65 + 63] : GT[tid * 65]);
    __syncthreads();
    const int fr = F.lane & 15, fq = F.lane >> 4, w = F.wave;
    f32x4 acc[1][8]; zero_acc<1, 8>(acc);
    mma_nt<1, 8>(acc, KDT + (16 * w) * 72, 72, VT, 72, 64, fr, fq);
    bf16_t* st = (bf16_t*)(P.ws + WS_STATE) + (size_t)unit * 16384;
#pragma unroll
    for (int nt = 0; nt < 8; ++nt) { u32x2 o; o.x = pk2(acc[0][nt][0], acc[0][nt][1]); o.y = pk2(acc[0][nt][2], acc[0][nt][3]); *(u32x2*)(st + (nt * 16 + fr) * 128 + 16 * w + fq * 4) = o; }
}

__device__ __forceinline__ void gla_scan(const Frame& F, const Params& P) {
    unsigned* stt = (unsigned*)(P.ws + WS_STATE); const float* dec = (const float*)(P.ws + WS_DECAY);
    if (F.tid >= 256) return;
    for (int gid = F.bid * 256 + F.tid; gid < 8 * 128 * 64; gid += F.G * 256) {
        const int dp = gid & 63, e = (gid >> 6) & 127, bh = gid >> 13, dir = dp >> 5;
        const int latb = bh * 256, ctxb = 2048 + bh * 4;
        auto unit_of = [&](int p) { return dir == 0 ? (p < 4 ? ctxb + p : latb + (p - 4)) : (p < 4 ? ctxb + 3 - p : latb + 255 - (p - 4)); };
        float s0 = 0.f, s1 = 0.f;
        unsigned dA[10], dB[10]; f32x2 cA[10], cB[10];
#pragma unroll
        for (int i = 0; i < 10; ++i) { const int u = unit_of(i); dA[i] = stt[((size_t)u * 128 + e) * 64 + dp]; cA[i] = *(const f32x2*)(dec + (size_t)u * 128 + 2 * dp); }
        for (int p0 = 0; p0 < 260; p0 += 20) {
#pragma unroll
            for (int i = 0; i < 10; ++i) { const int u = unit_of(p0 + 10 + i); dB[i] = stt[((size_t)u * 128 + e) * 64 + dp]; cB[i] = *(const f32x2*)(dec + (size_t)u * 128 + 2 * dp); }
#pragma unroll
            for (int i = 0; i < 10; ++i) { const int u = unit_of(p0 + i); stt[((size_t)u * 128 + e) * 64 + dp] = pk2(s0, s1); s0 = cA[i].x * s0 + bflo(dA[i]); s1 = cA[i].y * s1 + bfhi(dA[i]); }
            if (p0 + 20 < 260) {
#pragma unroll
                for (int i = 0; i < 10; ++i) { const int u = unit_of(p0 + 20 + i); dA[i] = stt[((size_t)u * 128 + e) * 64 + dp]; cA[i] = *(const f32x2*)(dec + (size_t)u * 128 + 2 * dp); } }
#pragma unroll
            for (int i = 0; i < 10; ++i) { const int u = unit_of(p0 + 10 + i); stt[((size_t)u * 128 + e) * 64 + dp] = pk2(s0, s1); s0 = cB[i].x * s0 + bflo(dB[i]); s1 = cB[i].y * s1 + bfhi(dB[i]); }
        }
    }
}

__device__ __forceinline__ void gla_g3_unit(const Frame& F, const Params& P, int l, int row0, int h, int unit) {
    const bf16_t* pb = (const bf16_t*)(P.ws + WS_PBUF);
    const int tid = F.tid, fr = F.lane & 15, fq = F.lane >> 4, w = F.wave, row = F.lane, c8 = F.wave * 8;
    const GateRegs gr = gla_load_gate_regs(F, P, l, row0, h);
    const u32x4 qv = *(const u32x4*)(pb + (size_t)(row0 + row) * INP + C_Q + 64 * h + c8), kv = *(const u32x4*)(pb + (size_t)(row0 + row) * INP + C_K + 64 * h + c8);
    u32x4 vv[2], rv[2], stv[4];
#pragma unroll
    for (int i = 0; i < 2; ++i) { const int vr = F.lane, vc = (F.wave + 8 * i) * 8; const bf16_t* rp = pb + (size_t)(row0 + vr) * INP + 128 * h + vc; vv[i] = *(const u32x4*)(rp + C_V); rv[i] = *(const u32x4*)(rp + C_R); }
    { const bf16_t* st = (const bf16_t*)(P.ws + WS_STATE) + (size_t)unit * 16384;
#pragma unroll
      for (int i = 0; i < 4; ++i) stv[i] = *(const u32x4*)(st + (i * 512 + tid) * 8); }
    const float* ng = P.in[13] + (size_t)l * 128;
    float ngv[4];
#pragma unroll
    for (int nt = 0; nt < 4; ++nt) ngv[nt] = ng[(w >> 2) * 64 + nt * 16 + fr];
    gla_gates(F, gr);
    __syncthreads();
    LAS float* GT = (LAS float*)(F.lds + GL_GT);
    LAS bf16_t* A1 = (LAS bf16_t*)(F.lds + GL_A1); LAS bf16_t* KE = (LAS bf16_t*)(F.lds + GL_KE); LAS bf16_t* VTb = (LAS bf16_t*)(F.lds + GL_VTB); LAS bf16_t* STb = (LAS bf16_t*)(F.lds + GL_GT);
    LAS float* RS = (LAS float*)(F.lds + GL_RS); LAS bf16_t* RT = (LAS bf16_t*)(F.lds + GL_RT);
    { float qf[8], qb[8], kf[8], kb[8];
#pragma unroll
      for (int j = 0; j < 8; ++j) { const float q_ = bfel(qv, j) * 0.125f, k_ = bfel(kv, j); const float bf_ = GT[(c8 + j) * 65 + row], bb_ = GT[(64 + c8 + j) * 65 + row];
          qf[j] = q_ * __expf(bf_); qb[j] = q_ * __expf(bb_); kf[j] = k_ * __expf(-bf_); kb[j] = k_ * __expf(-bb_); }
      *(LAS u32x4*)(A1 + row * 200 + 64 + c8) = (u32x4){pk2(qf[0], qf[1]), pk2(qf[2], qf[3]), pk2(qf[4], qf[5]), pk2(qf[6], qf[7])};
      *(LAS u32x4*)(A1 + row * 200 + 128 + c8) = (u32x4){pk2(qb[0], qb[1]), pk2(qb[2], qb[3]), pk2(qb[4], qb[5]), pk2(qb[6], qb[7])};
      *(LAS u32x4*)(KE + row * 72 + c8) = (u32x4){pk2(kf[0], kf[1]), pk2(kf[2], kf[3]), pk2(kf[4], kf[5]), pk2(kf[6], kf[7])};
      *(LAS u32x4*)(KE + 4608 + row * 72 + c8) = (u32x4){pk2(kb[0], kb[1]), pk2(kb[2], kb[3]), pk2(kb[4], kb[5]), pk2(kb[6], kb[7])}; }
#pragma unroll
    for (int i = 0; i < 2; ++i) { const int vr = F.lane, vc = (F.wave + 8 * i) * 8; *(LAS u32x4*)(RT + vr * 136 + vc) = rv[i];
#pragma unroll
        for (int j = 0; j < 8; ++j) VTb[(vc + j) * 72 + vr] = bfraw(vv[i], j); }
    __syncthreads();
    {
        const int mt = w & 3, ntp = w >> 2;
        f32x4 af[1][2], ab[1][2]; zero_acc<1, 2>(af); zero_acc<1, 2>(ab);
        mma_nt<1, 2>(af, A1 + (16 * mt) * 200 + 64, 200, KE + (32 * ntp) * 72, 72, 64, fr, fq);
        mma_nt<1, 2>(ab, A1 + (16 * mt) * 200 + 128, 200, KE + 4608 + (32 * ntp) * 72, 72, 64, fr, fq);
#pragma unroll
        for (int i = 0; i < 4; ++i) { const int idx = (i * 512 + tid) * 8, e = idx >> 7, dd = idx & 127; *(LAS u32x4*)(STb + e * 136 + dd) = stv[i]; }
#pragma unroll
        for (int nt = 0; nt < 2; ++nt)
#pragma unroll
            for (int j = 0; j < 4; ++j) { const int i = 16 * mt + fq * 4 + j, jj = (2 * ntp + nt) * 16 + fr;
                const float p = (jj <= i ? af[0][nt][j] : 0.f) + (jj >= i ? ab[0][nt][j] : 0.f); A1[i * 200 + jj] = (bf16_t)f2bf(p); }
    }
    __syncthreads();
    {
        const int mt = w & 3, nh = w >> 2;
        f32x4 acc[1][4]; zero_acc<1, 4>(acc);
        mma_nt<1, 4>(acc, A1 + (16 * mt) * 200, 200, VTb + (64 * nh) * 72, 72, 64, fr, fq);
        mma_nt<1, 4>(acc, A1 + (16 * mt) * 200 + 64, 200, STb + (64 * nh) * 136, 136, 128, fr, fq);
        float ss[4];
#pragma unroll
        for (int j = 0; j < 4; ++j) { float s = 0.f;
#pragma unroll
            for (int nt = 0; nt < 4; ++nt) s += acc[0][nt][j] * acc[0][nt][j];
            s += __shfl_xor(s, 1); s += __shfl_xor(s, 2); s += __shfl_xor(s, 4); s += __shfl_xor(s, 8); ss[j] = s; }
        if (fr == 0) {
#pragma unroll
            for (int j = 0; j < 4; ++j) RS[nh * 64 + 16 * mt + fq * 4 + j] = ss[j]; }
        __syncthreads();
        bf16_t* cat = (bf16_t*)(P.ws + WS_CAT);
#pragma unroll
        for (int j = 0; j < 4; ++j) { const int i = 16 * mt + fq * 4 + j; const float rinv = 1.0f / sqrtf((RS[i] + RS[64 + i]) * (1.0f / 128.0f) + NORM_EPS);
#pragma unroll
            for (int nt = 0; nt < 4; ++nt) { const int e = nh * 64 + nt * 16 + fr; const float r_ = bf2f(RT[i * 136 + e]);
                const float o = acc[0][nt][j] * rinv * ngv[nt] * (r_ * sigmoidf_(r_)); cat[(size_t)(row0 + i) * D + 256 + 128 * h + e] = (bf16_t)f2bf(o); } }
    }
}

__device__ __forceinline__ void conv_unit(const Frame& F, const Params& P, int l, int rowbase, int Ls, int t0) {
    const bf16_t* pb = (const bf16_t*)(P.ws + WS_PBUF);
    LAS bf16_t* Y = (LAS bf16_t*)(F.lds);
    LAS float* Z = (LAS float*)(F.lds + 49152);
    const int tid = F.tid;
    {
        u32x4 av[6], gv[6];
#pragma unroll
        for (int i = 0; i < 6; ++i) { const int ch = tid + 512 * i, r = ch >> 5, cc = (ch & 31) * 8, t = t0 - 15 + r;
            av[i] = (u32x4){0u, 0u, 0u, 0u}; gv[i] = av[i];
            if (ch < 94 * 32 && t >= 0 && t < Ls) { const size_t rb = (size_t)(rowbase + t) * INP; av[i] = *(const u32x4*)(pb + rb + C_CA + cc); gv[i] = *(const u32x4*)(pb + rb + C_CG + cc); } }
#pragma unroll
        for (int i = 0; i < 6; ++i) { const int ch = tid + 512 * i, r = ch >> 5, cc = (ch & 31) * 8; const u32x4 a = av[i], g = gv[i]; u32x4 o;
            o.x = pk2(bflo(a.x) * sigmoidf_(bflo(g.x)), bfhi(a.x) * sigmoidf_(bfhi(g.x))); o.y = pk2(bflo(a.y) * sigmoidf_(bflo(g.y)), bfhi(a.y) * sigmoidf_(bfhi(g.y)));
            o.z = pk2(bflo(a.z) * sigmoidf_(bflo(g.z)), bfhi(a.z) * sigmoidf_(bfhi(g.z))); o.w = pk2(bflo(a.w) * sigmoidf_(bflo(g.w)), bfhi(a.w) * sigmoidf_(bfhi(g.w)));
            if (ch < 94 * 32) *(LAS u32x4*)(Y + r * 256 + cc) = o; }
    }
    const int c = tid & 255, half = tid >> 8; const float* cw = P.in[14] + (size_t)l * 31 * 256 + c; const float cb = P.in[15][(size_t)l * 256 + c];
    float wv[31];
#pragma unroll
    for (int j = 0; j < 31; ++j) wv[j] = cw[j * 256];
    const f32x4 lng = *(const f32x4*)(P.in[16] + (size_t)l * 256 + 4 * F.lane), lnb = *(const f32x4*)(P.in[17] + (size_t)l * 256 + 4 * F.lane);
    __syncthreads();
    { float yv[62];
#pragma unroll
      for (int r = 0; r < 62; ++r) yv[r] = bf2f(Y[(half * 32 + r) * 256 + c]);
#pragma unroll
      for (int tt = 0; tt < 32; ++tt) { float z = cb;
#pragma unroll
          for (int j = 0; j < 31; ++j) z += wv[j] * yv[tt + j];
          Z[(half * 32 + tt) * 256 + c] = z; } }
    __syncthreads();
    { bf16_t* cat = (bf16_t*)(P.ws + WS_CAT);
#pragma unroll 2
      for (int i = 0; i < 8; ++i) { const int t = F.wave * 8 + i; const f32x4 z = *(const LAS f32x4*)(Z + t * 256 + 4 * F.lane);
          const float mean = wave_sum((z.x + z.y) + (z.z + z.w)) * (1.0f / 256.0f); const f32x4 zc = z - mean;
          const float var = wave_sum((zc.x * zc.x + zc.y * zc.y) + (zc.z * zc.z + zc.w * zc.w)) * (1.0f / 256.0f); const float rstd = 1.0f / sqrtf(var + NORM_EPS);
          const f32x4 y = zc * rstd * lng + lnb; u32x2 o; o.x = pk2(y.x * sigmoidf_(y.x), y.y * sigmoidf_(y.y)); o.y = pk2(y.z * sigmoidf_(y.z), y.w * sigmoidf_(y.w));
          *(u32x2*)(cat + (size_t)(rowbase + t0 + t) * D + 768 + 4 * F.lane) = o; } }
    __syncthreads();
}

template <int R, int NP>
__device__ __forceinline__ void fourier_f1_unit(const Frame& F, const Params& P, int rowbase, int rstride, int h, const bf16_t* tab, int orow0, float oscale) {
    const bf16_t* pb = (const bf16_t*)(P.ws + WS_PBUF); const bf16_t* cm3 = (const bf16_t*)(P.ws + WS_CM3);
    constexpr int LZ = R + 8, MT0 = 4 * NP, NTW = R / 128, MTW = R / 128;
    LAS bf16_t* U = (LAS bf16_t*)(F.lds); LAS bf16_t* CM = U + R * 72; LAS bf16_t* ZT = CM + 64 * NP * 72;
    const int tid = F.tid, fr = F.lane & 15, fq = F.lane >> 4, w = F.wave;
    bf16x8 tcp[4], tsp[4];
    if constexpr (R == 128) {
#pragma unroll
        for (int k = 0; k < 4; ++k) { tcp[k] = *(const bf16x8*)(tab + (size_t)(w * 16 + fr) * R + k * 32 + fq * 8); tsp[k] = *(const bf16x8*)(tab + (size_t)R * R + (size_t)(w * 16 + fr) * R + k * 32 + fq * 8); } }
    { constexpr int NU = R * 8 / NTHREADS, NC = (64 * NP * 8 + NTHREADS - 1) / NTHREADS; u32x4 uv[NU], cv[NC];
#pragma unroll
      for (int i = 0; i < NU; ++i) { const int ch = tid + NTHREADS * i, a = ch >> 3, c8 = (ch & 7) * 8; uv[i] = *(const u32x4*)(pb + (size_t)(rowbase + a * rstride) * INP + C_FOUR + 64 * h + c8); }
#pragma unroll
      for (int i = 0; i < NC; ++i) { const int ch = tid + NTHREADS * i, m = ch >> 3, c8 = (ch & 7) * 8; cv[i] = (ch < 64 * NP * 8) ? *(const u32x4*)(cm3 + m * 64 + c8) : (u32x4){0u, 0u, 0u, 0u}; }
#pragma unroll
      for (int i = 0; i < NU; ++i) { const int ch = tid + NTHREADS * i, a = ch >> 3, c8 = (ch & 7) * 8; *(LAS u32x4*)(U + a * 72 + c8) = uv[i]; }
#pragma unroll
      for (int i = 0; i < NC; ++i) { const int ch = tid + NTHREADS * i, m = ch >> 3, c8 = (ch & 7) * 8; if (ch < 64 * NP * 8) *(LAS u32x4*)(CM + m * 72 + c8) = cv[i]; } }
    __syncthreads();
    {
        f32x4 acc[MT0][NTW]; zero_acc<MT0, NTW>(acc);
        mma_nt<MT0, NTW>(acc, CM, 72, U + (w * NTW * 16) * 72, 72, 64, fr, fq);
#pragma unroll
        for (int mt = 0; mt < MT0; ++mt)
#pragma unroll
            for (int nt = 0; nt < NTW; ++nt)
#pragma unroll
                for (int j = 0; j < 4; ++j) ZT[(mt * 16 + fq * 4 + j) * LZ + (w * NTW + nt) * 16 + fr] = (bf16_t)f2bf(acc[mt][nt][j]);
    }
    __syncthreads();
    {
        f32x4 are[MTW][4], aim[MTW][4]; zero_acc<MTW, 4>(are); zero_acc<MTW, 4>(aim);
        const int m0 = w * MTW * 16;
#pragma unroll
        for (int k0 = 0; k0 < R; k0 += 32) {
            bf16x8 tc[MTW], ts[MTW];
#pragma unroll
            for (int mi = 0; mi < MTW; ++mi) { if constexpr (R == 128) { tc[mi] = tcp[k0 / 32]; ts[mi] = tsp[k0 / 32]; } else { tc[mi] = *(const bf16x8*)(tab + (size_t)(m0 + mi * 16 + fr) * R + k0 + fq * 8); ts[mi] = *(const bf16x8*)(tab + (size_t)R * R + (size_t)(m0 + mi * 16 + fr) * R + k0 + fq * 8); } }
#pragma unroll
            for (int nt = 0; nt < 4; ++nt) {
                const bf16x8 zr = *(const LAS bf16x8*)(ZT + (nt * 16 + fr) * LZ + k0 + fq * 8), zi = *(const LAS bf16x8*)(ZT + (64 + nt * 16 + fr) * LZ + k0 + fq * 8);
#pragma unroll
                for (int mi = 0; mi < MTW; ++mi) { are[mi][nt] = __builtin_amdgcn_mfma_f32_16x16x32_bf16(tc[mi], zr, are[mi][nt], 0, 0, 0); are[mi][nt] = __builtin_amdgcn_mfma_f32_16x16x32_bf16(ts[mi], zi, are[mi][nt], 0, 0, 0); }
                if constexpr (NP == 3) { const bf16x8 nzr = *(const LAS bf16x8*)(ZT + (128 + nt * 16 + fr) * LZ + k0 + fq * 8);
#pragma unroll
                    for (int mi = 0; mi < MTW; ++mi) { aim[mi][nt] = __builtin_amdgcn_mfma_f32_16x16x32_bf16(tc[mi], zi, aim[mi][nt], 0, 0, 0); aim[mi][nt] = __builtin_amdgcn_mfma_f32_16x16x32_bf16(ts[mi], nzr, aim[mi][nt], 0, 0, 0); } }
            }
        }
#pragma unroll
        for (int mi = 0; mi < MTW; ++mi)
#pragma unroll
            for (int nt = 0; nt < 4; ++nt)
#pragma unroll
                for (int j = 0; j < 4; ++j) { const int m = m0 + mi * 16 + fq * 4 + j, k2 = nt * 16 + fr;
                    if constexpr (NP == 3) { unsigned* t2 = (unsigned*)(P.ws + WS_T2); t2[(size_t)(orow0 + 128 * m) * 256 + h * 64 + k2] = pk2(are[mi][nt][j], aim[mi][nt][j]); }
                    else { bf16_t* cat = (bf16_t*)(P.ws + WS_CAT); cat[(size_t)(orow0 + m) * D + h * 64 + k2] = (bf16_t)f2bf(are[mi][nt][j] * oscale); } }
    }
    __syncthreads();
}

constexpr int F2_X = 0, F2_T = 67584;
__device__ __forceinline__ void fourier_f2_tables(const Frame& F, const Params& P) {
    const bf16_t* tf2 = (const bf16_t*)(P.ws + WS_TF2); LAS bf16_t* T = (LAS bf16_t*)(F.lds + F2_T);
#pragma unroll
    for (int i = 0; i < 8; ++i) { const int ch = F.tid + 512 * i, r = ch >> 4, c8 = (ch & 15) * 8; *(LAS u32x4*)(T + r * 136 + c8) = *(const u32x4*)(tf2 + r * 128 + c8); }
    __syncthreads();
}
__device__ __forceinline__ void fourier_f2_unit(const Frame& F, const Params& P, int b, int d, int hp) {
    const bf16_t* t2 = (const bf16_t*)(P.ws + WS_T2);
    LAS bf16_t* X = (LAS bf16_t*)(F.lds + F2_X); const LAS bf16_t* T = (const LAS bf16_t*)(F.lds + F2_T);
    const int tid = F.tid, fr = F.lane & 15, fq = F.lane >> 4, w = F.wave;
    { u32x4 xv[8];
#pragma unroll
      for (int i = 0; i < 8; ++i) { const int ch = tid + 512 * i, n = ch >> 5, c8 = (ch & 31) * 8; xv[i] = *(const u32x4*)(t2 + (size_t)(b * SEQ + 128 * d + n) * 512 + hp * 256 + c8); }
#pragma unroll
      for (int i = 0; i < 8; ++i) { const int ch = tid + 512 * i, n = ch >> 5, c8 = (ch & 31) * 8; *(LAS u32x4*)(X + n * 264 + c8) = xv[i]; } }
    __syncthreads();
    f32x4 acc[8];
#pragma unroll
    for (int mt = 0; mt < 8; ++mt) acc[mt] = (f32x4){0.f, 0.f, 0.f, 0.f};
#pragma unroll
    for (int k0 = 0; k0 < 128; k0 += 32) {
        bf16x8 xr, xi;
#pragma unroll
        for (int jj = 0; jj < 8; ++jj) { const unsigned wd = *(const LAS unsigned*)(X + (k0 + fq * 8 + jj) * 264 + 2 * (w * 16 + fr)); xr[jj] = (short)(wd & 0xffffu); xi[jj] = (short)(wd >> 16); }
#pragma unroll
        for (int mt = 0; mt < 8; ++mt) { const bf16x8 tc = *(const LAS bf16x8*)(T + (mt * 16 + fr) * 136 + k0 + fq * 8), ts = *(const LAS bf16x8*)(T + (128 + mt * 16 + fr) * 136 + k0 + fq * 8);
            acc[mt] = __builtin_amdgcn_mfma_f32_16x16x32_bf16(tc, xr, acc[mt], 0, 0, 0); acc[mt] = __builtin_amdgcn_mfma_f32_16x16x32_bf16(ts, xi, acc[mt], 0, 0, 0); }
    }
    bf16_t* cat = (bf16_t*)(P.ws + WS_CAT);
#pragma unroll
    for (int mt = 0; mt < 8; ++mt)
#pragma unroll
        for (int j = 0; j < 4; ++j) { const int c = mt * 16 + fq * 4 + j; cat[(size_t)(b * SEQ + 128 * c + d) * D + hp * 128 + w * 16 + fr] = (bf16_t)f2bf(acc[mt][j] * (1.0f / 1024.0f)); }
    __syncthreads();
}

constexpr int AX_LCNT = AUX_OFF, AX_GBASE = AUX_OFF + 128, AX_LE = AUX_OFF + 256, AX_LP = AUX_OFF + 256 + 2560;
constexpr int LC_BAR = LCTL_OFF, LC_TS = LCTL_OFF + 64;

constexpr int RT_GS = 0, RT_SSQ = 24576, RT_AT = 25600, RT_PL = 95232;
__device__ __forceinline__ void phase_route(const Frame& F, const Params& P, int l, int ntok) {
    unsigned char* ws = P.ws;
    LAS float* GS = (LAS float*)(F.lds + RT_GS); LAS float* SSQ = (LAS float*)(F.lds + RT_SSQ); LAS float* PL = (LAS float*)(F.lds + RT_PL);
    volatile LAS int* lcnt = (volatile LAS int*)(F.lds + AX_LCNT); volatile LAS int* gbase = (volatile LAS int*)(F.lds + AX_GBASE);
    volatile LAS int* LE = (volatile LAS int*)(F.lds + AX_LE); volatile LAS int* LP = (volatile LAS int*)(F.lds + AX_LP);
    const int tid = F.tid, lane = F.lane, w = F.wave, fr = lane & 15, fq = lane >> 4, ts = lane >> 2, kq = lane & 3, kbase = 128 * w + 32 * kq;
    LAS bf16_t* AT = (LAS bf16_t*)(F.lds + RT_AT) + w * (2 * 16 * 136);
    const int tpb = (ntok + F.G - 1) / F.G, tb = F.bid * tpb, te = (tb + tpb < ntok) ? tb + tpb : ntok, ntile = (te - tb + 15) >> 4;
    { const float* g2 = P.in[5] + (size_t)l * D;
      for (int i = tid; i < 3 * 1024; i += NTHREADS) { const int v = i >> 10, k = i & 1023; const float* mf = (const float*)(ws + WS_MODF) + ((size_t)l * 3 + v) * 6144;
          GS[(v * 2 + 0) * 1024 + k] = g2[k] * (1.0f + mf[4 * 1024 + k]); GS[(v * 2 + 1) * 1024 + k] = mf[3 * 1024 + k]; } }
    if (tid < 32) lcnt[tid] = 0;
    bf16x8 bh[4][2], bl[4][2];
    { const bf16_t* rwh = (const bf16_t*)(ws + WS_RW) + (size_t)l * 2 * NE * D; const bf16_t* rwl = rwh + NE * D;
#pragma unroll
      for (int sk = 0; sk < 4; ++sk)
#pragma unroll
          for (int nt = 0; nt < 2; ++nt) { const int off = (nt * 16 + fr) * D + 128 * w + 32 * sk + 8 * fq; bh[sk][nt] = *(const bf16x8*)(rwh + off); bl[sk][nt] = *(const bf16x8*)(rwl + off); } }
    const float* xres = (const float*)(ws + WS_XRES); bf16_t* hb = (bf16_t*)(ws + WS_HBUF);
    const float rbias = P.in[20][(size_t)l * NE + (lane & 31)];
    float* aprob = (float*)(ws + WS_APROB);
    f32x4 xn[8];
    { const int m = tb + ts;
#pragma unroll
      for (int j = 0; j < 8; ++j) xn[j] = (m < te) ? *(const f32x4*)(xres + (size_t)m * D + kbase + 4 * j) : (f32x4){0.f, 0.f, 0.f, 0.f}; }
    __syncthreads();
    for (int it = 0; it < ntile; ++it) {
        const int buf = it & 1; const int m = tb + 16 * it + ts; const bool valid = m < te; const int v = (m >= NLAT) ? 2 : (m >= SEQ ? 1 : 0);
        f32x4 x[8]; float ss = 0.f;
#pragma unroll
        for (int j = 0; j < 8; ++j) { x[j] = xn[j]; ss += (x[j].x * x[j].x + x[j].y * x[j].y) + (x[j].z * x[j].z + x[j].w * x[j].w); }
        if (it + 1 < ntile) { const int mn = m + 16;
#pragma unroll
            for (int j = 0; j < 8; ++j) xn[j] = (mn < te) ? *(const f32x4*)(xres + (size_t)mn * D + kbase + 4 * j) : (f32x4){0.f, 0.f, 0.f, 0.f}; }
        ss += __shfl_xor(ss, 1); ss += __shfl_xor(ss, 2);
        if (kq == 0) SSQ[(buf * 8 + w) * 16 + ts] = ss;
        __syncthreads();
        float tot = 0.f;
#pragma unroll
        for (int q = 0; q < 8; ++q) tot += SSQ[(buf * 8 + q) * 16 + ts];
        const float rstd = 1.0f / sqrtf(tot * (1.0f / D) + NORM_EPS);
        {
            unsigned hw[16], lw[16];
#pragma unroll
            for (int j = 0; j < 8; ++j) { const f32x4 gs = *(const LAS f32x4*)(GS + (v * 2 + 0) * 1024 + kbase + 4 * j), sh = *(const LAS f32x4*)(GS + (v * 2 + 1) * 1024 + kbase + 4 * j);
                const f32x4 h = (x[j] * rstd) * gs + sh;
                const unsigned h0 = f2bf(h.x), h1 = f2bf(h.y), h2 = f2bf(h.z), h3 = f2bf(h.w);
                hw[2 * j] = h0 | (h1 << 16); hw[2 * j + 1] = h2 | (h3 << 16);
                lw[2 * j] = pk2(h.x - bf2f(h0), h.y - bf2f(h1)); lw[2 * j + 1] = pk2(h.z - bf2f(h2), h.w - bf2f(h3)); }
            if (valid) {
#pragma unroll
                for (int c = 0; c < 4; ++c) *(u32x4*)(hb + (size_t)m * D + kbase + 8 * c) = (u32x4){hw[4 * c], hw[4 * c + 1], hw[4 * c + 2], hw[4 * c + 3]}; }
#pragma unroll
            for (int c = 0; c < 4; ++c) { *(LAS u32x4*)(AT + ts * 136 + 32 * kq + 8 * c) = (u32x4){hw[4 * c], hw[4 * c + 1], hw[4 * c + 2], hw[4 * c + 3]};
                *(LAS u32x4*)(AT + 16 * 136 + ts * 136 + 32 * kq + 8 * c) = (u32x4){lw[4 * c], lw[4 * c + 1], lw[4 * c + 2], lw[4 * c + 3]}; }
        }
        f32x4 acc[2]; acc[0] = (f32x4){0.f, 0.f, 0.f, 0.f}; acc[1] = acc[0];
#pragma unroll
        for (int sk = 0; sk < 4; ++sk) { const bf16x8 ah = *(const LAS bf16x8*)(AT + fr * 136 + 32 * sk + 8 * fq), al = *(const LAS bf16x8*)(AT + 16 * 136 + fr * 136 + 32 * sk + 8 * fq);
#pragma unroll
            for (int nt = 0; nt < 2; ++nt) { acc[nt] = __builtin_amdgcn_mfma_f32_16x16x32_bf16(ah, bh[sk][nt], acc[nt], 0, 0, 0); acc[nt] = __builtin_amdgcn_mfma_f32_16x16x32_bf16(ah, bl[sk][nt], acc[nt], 0, 0, 0);
                acc[nt] = __builtin_amdgcn_mfma_f32_16x16x32_bf16(al, bh[sk][nt], acc[nt], 0, 0, 0); } }
#pragma unroll
        for (int nt = 0; nt < 2; ++nt)
#pragma unroll
            for (int j = 0; j < 4; ++j) PL[((buf * 8 + w) * 16 + fq * 4 + j) * 33 + nt * 16 + fr] = acc[nt][j];
        __syncthreads();
        {
            const int tt = 2 * w + (lane >> 5), e = lane & 31, mt = tb + 16 * it + tt;
            float lg = rbias;
#pragma unroll
            for (int q = 0; q < 8; ++q) lg += PL[((buf * 8 + q) * 16 + tt) * 33 + e];
            float bval[4]; int bidx[4]; float cur = lg;
#pragma unroll
            for (int k = 0; k < 4; ++k) { float bv = cur; int bi = e;
#pragma unroll
                for (int o = 1; o < 32; o <<= 1) { const float ov = __shfl_xor(bv, o); const int oi = __shfl_xor(bi, o); const bool take = (ov > bv) || (ov == bv && oi < bi); bv = take ? ov : bv; bi = take ? oi : bi; }
                bval[k] = bv; bidx[k] = bi; if (e == bi) cur = -INFINITY; }
            float ex[4], sum = 0.f;
#pragma unroll
            for (int k = 0; k < 4; ++k) { ex[k] = __expf(bval[k] - bval[0]); sum += ex[k]; }
            if (e == 0 && mt < te) { const int tl = 16 * it + tt;
#pragma unroll
                for (int k = 0; k < 4; ++k) { const int lp = __hip_atomic_fetch_add((LAS int*)(F.lds + AX_LCNT) + bidx[k], 1, __ATOMIC_RELAXED, __HIP_MEMORY_SCOPE_WORKGROUP);
                    LE[tl * 4 + k] = bidx[k]; LP[tl * 4 + k] = lp; aprob[(size_t)mt * 4 + k] = ex[k] / sum; } }
        }
    }
    __syncthreads();
    if (tid < 32) gbase[tid] = (int)__hip_atomic_fetch_add((unsigned*)(ws + WS_CTL) + CW_CNT + l * 64 + tid, (unsigned)lcnt[tid], __ATOMIC_RELAXED, __HIP_MEMORY_SCOPE_AGENT);
    __syncthreads();
    int* aexp = (int*)(ws + WS_AEXP); int* apos = (int*)(ws + WS_APOS);
    int* elist = (int*)(ws + WS_XB);
    for (int i = tid; i < (te - tb) * 4; i += NTHREADS) { const int e = LE[i]; const int pos = gbase[e] + LP[i]; aexp[(size_t)tb * 4 + i] = e; apos[(size_t)tb * 4 + i] = pos; elist[(size_t)e * NTOK + pos] = tb + (i >> 2); }
    __syncthreads();
}

__device__ __forceinline__ void moe_prep(const Frame& F, const Params& P, int l) {
    unsigned char* ws = P.ws;
    volatile LAS int* TS = (volatile LAS int*)(F.lds + LC_TS);
    if (F.tid < 64) { const int e = F.lane & 31;
        const unsigned c = __hip_atomic_load((unsigned*)(ws + WS_CTL) + CW_CNT + l * 64 + e, __ATOMIC_RELAXED, __HIP_MEMORY_SCOPE_AGENT);
        int incl = (int)((c + 255u) >> 8);
#pragma unroll
        for (int o = 1; o < 32; o <<= 1) { const int v = __shfl_up(incl, o); if (e >= o) incl += v; }
        if (F.lane < 32) { TS[e + 1] = incl; TS[64 + e] = (int)c; }
        if (F.lane == 0) TS[0] = 0; }
    __syncthreads();
}

__device__ __forceinline__ void phase_combine(const Frame& F, const Params& P, int l, int ntok, bool last) {
    unsigned char* ws = P.ws;
    const int gw = F.bid * NWAVES + F.wave, NGW = F.G * NWAVES, lane = F.lane;
    float* xres = (float*)(ws + WS_XRES); const bf16_t* yb = (const bf16_t*)(ws + WS_YB);
    const int* aexp = (const int*)(ws + WS_AEXP); const int* apos = (const int*)(ws + WS_APOS); const float* aprob = (const float*)(ws + WS_APROB);
    const volatile LAS int* TS = (const volatile LAS int*)(F.lds + LC_TS);
    int sl_n[4]; float pr_n[4];
    if (gw < ntok) {
#pragma unroll
        for (int k = 0; k < 4; ++k) { sl_n[k] = TS[aexp[(size_t)gw * 4 + k]] * 256 + apos[(size_t)gw * 4 + k]; pr_n[k] = aprob[(size_t)gw * 4 + k]; } }
    for (int m = gw; m < ntok; m += NGW) {
        const int v = (m >= NLAT) ? 2 : (m >= SEQ ? 1 : 0);
        const float* mf = (const float*)(ws + WS_MODF) + ((size_t)l * 3 + v) * 6144;
        int sl[4]; float pr[4];
#pragma unroll
        for (int k = 0; k < 4; ++k) { sl[k] = sl_n[k]; pr[k] = pr_n[k]; }
        u32x2 wv[4][4]; f32x4 xo[4], g5[4];
#pragma unroll
        for (int k = 0; k < 4; ++k)
#pragma unroll
            for (int j = 0; j < 4; ++j) wv[k][j] = *(const u32x2*)(yb + (size_t)sl[k] * D + 4 * lane + 256 * j);
#pragma unroll
        for (int j = 0; j < 4; ++j) { const int c = 4 * lane + 256 * j; xo[j] = *(const f32x4*)(xres + (size_t)m * D + c); g5[j] = *(const f32x4*)(mf + 5 * 1024 + c); }
        if (m + NGW < ntok) {
#pragma unroll
            for (int k = 0; k < 4; ++k) { sl_n[k] = TS[aexp[(size_t)(m + NGW) * 4 + k]] * 256 + apos[(size_t)(m + NGW) * 4 + k]; pr_n[k] = aprob[(size_t)(m + NGW) * 4 + k]; } }
        f32x4 y[4];
#pragma unroll
        for (int j = 0; j < 4; ++j) y[j] = (f32x4){0.f, 0.f, 0.f, 0.f};
#pragma unroll
        for (int k = 0; k < 4; ++k)
#pragma unroll
            for (int j = 0; j < 4; ++j) y[j] += (f32x4){bflo(wv[k][j].x), bfhi(wv[k][j].x), bflo(wv[k][j].y), bfhi(wv[k][j].y)} * pr[k];
        f32x4 x[4];
#pragma unroll
        for (int j = 0; j < 4; ++j) x[j] = xo[j] + g5[j] * y[j];
        if (!last) {
#pragma unroll
            for (int j = 0; j < 4; ++j) *(f32x4*)(xres + (size_t)m * D + 4 * lane + 256 * j) = x[j];
            const float* mn = (const float*)(ws + WS_MODF) + ((size_t)(l + 1) * 3 + v) * 6144; f32x4 shv[4], scv[4];
#pragma unroll
            for (int j = 0; j < 4; ++j) { shv[j] = *(const f32x4*)(mn + 4 * lane + 256 * j); scv[j] = *(const f32x4*)(mn + 1024 + 4 * lane + 256 * j); }
            norm_row_store(x, P.in[4] + (size_t)(l + 1) * D, shv, scv, (bf16_t*)(ws + WS_HBUF) + (size_t)m * D, lane);
        } else {
            float ss = 0.f;
#pragma unroll
            for (int j = 0; j < 4; ++j) ss += (x[j].x * x[j].x + x[j].y * x[j].y) + (x[j].z * x[j].z + x[j].w * x[j].w);
            const float rstd = 1.0f / sqrtf(wave_sum(ss) * (1.0f / D) + NORM_EPS);
#pragma unroll
            for (int j = 0; j < 4; ++j) { const int c = 4 * lane + 256 * j; *(f32x4*)(P.out + (size_t)m * D + c) = (x[j] * rstd) * *(const f32x4*)(P.in[25] + c); }
        }
    }
}

#ifndef REP_PRO
#define REP_PRO 1
#endif
#ifndef REP_GEMM1
#define REP_GEMM1 1
#endif
#ifndef REP_G1U
#define REP_G1U 1
#endif
#ifndef REP_F1U
#define REP_F1U 1
#endif
#ifndef REP_CONV
#define REP_CONV 1
#endif
#ifndef REP_F2U
#define REP_F2U 1
#endif
#ifndef REP_G3U
#define REP_G3U 1
#endif
#ifndef REP_GU
#define REP_GU 1
#endif
#ifndef REP_DN
#define REP_DN 1
#endif
#ifndef REP_GATH
#define REP_GATH 1
#endif
__global__ void __launch_bounds__(NTHREADS, 2) mega_fwd(Params P0) {
    extern __shared__ __attribute__((aligned(16))) unsigned char lds_raw[];
    Frame F0; F0.lds = (LAS unsigned char*)lds_raw; F0.tid = threadIdx.x; F0.lane = F0.tid & 63; F0.wave = __builtin_amdgcn_readfirstlane(F0.tid >> 6); F0.G = gridDim.x; F0.bid = blockIdx.x;
#define KAS __attribute__((address_space(4)))
    struct ParamsK { const GAS float* in[26]; GAS float* out; GAS unsigned char* ws; };
#define PHASE_ENV() Frame F = F0; asm volatile("" : "+v"(F.tid)); F.lane = F.tid & 63; F.wave = __builtin_amdgcn_readfirstlane(F.tid >> 6); asm volatile("" : "+s"(F.bid), "+s"(F.G)); \
    const KAS ParamsK* kp_ = (const KAS ParamsK*)__builtin_amdgcn_kernarg_segment_ptr(); asm volatile("" : "+s"(kp_)); Params P; \
    _Pragma("unroll") for (int i_ = 0; i_ < 26; ++i_) P.in[i_] = (const float*)kp_->in[i_]; \
    P.out = (float*)kp_->out; P.ws = (unsigned char*)kp_->ws; unsigned char* ws = P.ws; (void)ws;
    { PHASE_ENV();
    for (int u = F.tid; u < (LDS_BYTES - LCTL_OFF) / 4; u += NTHREADS) ((LAS unsigned*)(F.lds + LCTL_OFF))[u] = 0u;
    __syncthreads();
    }
    { PHASE_ENV(); (void)xcd_barrier_post((unsigned*)(ws + WS_CTL) + CW_BAR, (volatile LAS unsigned*)(F.lds + LC_BAR)); }
#define GRID_BAR() do { PHASE_ENV(); XcdBarrier b_; b_.bar = (unsigned*)(ws + WS_CTL) + CW_BAR; b_.x = xb_xcc_id(); b_.st = (volatile LAS unsigned*)(F.lds + LC_BAR); xcd_barrier(b_); } while (0)

    for (int rep = 0; rep < REP_PRO; ++rep) { PHASE_ENV(); phase_prologue(F, P); }
    GRID_BAR();
    { PHASE_ENV(); phase_p1(F, P); }
    GRID_BAR();

    for (int l = 0; l < DEPTH; ++l) {
        const bool last = (l == DEPTH - 1);
        for (int rep = 0; rep < REP_GEMM1; ++rep) { PHASE_ENV(); pg8::Gemm g{(const bf16_t*)(ws + WS_HBUF), (const bf16_t*)(ws + WS_WIN) + (size_t)l * INP * D, NTOK, INP, D};
          pg8::StaticOrder S; S.init(NTOK, INP, F.G, F.bid);
          pg8::EpiStoreBf16 E{(bf16_t*)(ws + WS_PBUF), INP};
          pg8::gemm_phase<pg8::EpiStoreBf16, pg8::StaticOrder>(F.lds, g, S, E, F.tid);
          const int nun = (NTOK / 256) * (INP / 256), rr = nun % F.G, first = (rr == 0) ? 0 : rr, nidle = F.G - first;
          if (F.bid >= first) for (int t = F.bid - first; t < NTOK / 256; t += nidle) {
              SkEpiBf16 SE{(bf16_t*)(ws + WS_LRB) + (size_t)t * 256 * 32, 32};
              skinny_unit(F, (const bf16_t*)(ws + WS_HBUF) + (size_t)t * 256 * D, (const bf16_t*)(ws + WS_WGT) + (size_t)l * 32 * D, SE); } }
        GRID_BAR();
        for (int rep = 0; rep < REP_G1U; ++rep) { PHASE_ENV();
        for (int u = F.bid; u < 2080; u += F.G) { int row0, h;
            if (u < 2048) { const int bh = u >> 8, n = u & 255; h = bh & 3; row0 = (bh >> 2) * SEQ + 64 * n; }
            else { const int q = u - 2048, bh = q >> 2, n = q & 3; h = bh & 3; row0 = NLAT + (bh >> 2) * CTXL + 64 * n; }
            gla_g1_unit(F, P, l, row0, h, u); }
        __syncthreads(); }
        for (int rep = 0; rep < REP_F1U; ++rep) { PHASE_ENV();
        for (int u = F.bid; u < 1024; u += F.G) { const int b = u >> 9, nlo = (u >> 2) & 127, h = u & 3;
            fourier_f1_unit<128, 3>(F, P, b * SEQ + nlo, 128, h, (const bf16_t*)(ws + WS_TLAT) + (size_t)nlo * 32768, b * SEQ + nlo, 1.0f); }
        }
        { PHASE_ENV();
        if (!last) for (int u = F.bid; u < 8; u += F.G) { const int b = u >> 2, h = u & 3;
            fourier_f1_unit<256, 2>(F, P, NLAT + b * CTXL, 1, h, (const bf16_t*)(ws + WS_TCTX), NLAT + b * CTXL, 1.0f / 128.0f); }
        }
        for (int rep = 0; rep < REP_CONV; ++rep) { PHASE_ENV();
        for (int u = F.bid; u < (last ? 512 : 520); u += F.G) {
            if (u < 512) conv_unit(F, P, l, 64 * u, 64, 0);
            else { const int q = u - 512; conv_unit(F, P, l, NLAT + (q >> 2) * CTXL, CTXL, 64 * (q & 3)); } } }
        GRID_BAR();
        { PHASE_ENV(); gla_scan(F, P); }
        for (int rep = 0; rep < REP_F2U; ++rep) { PHASE_ENV();
        fourier_f2_tables(F, P);
        for (int u = F.bid; u < 512; u += F.G) fourier_f2_unit(F, P, u >> 8, (u >> 1) & 127, u & 1); }
        GRID_BAR();
        for (int rep = 0; rep < REP_G3U; ++rep) { PHASE_ENV();
        for (int u = F.bid; u < (last ? 2048 : 2080); u += F.G) { int row0, h;
            if (u < 2048) { const int bh = u >> 8, n = u & 255; h = bh & 3; row0 = (bh >> 2) * SEQ + 64 * n; }
            else { const int q = u - 2048, bh = q >> 2, n = q & 3; h = bh & 3; row0 = NLAT + (bh >> 2) * CTXL + 64 * n; }
            gla_g3_unit(F, P, l, row0, h, u); }
        __syncthreads(); }
        GRID_BAR();
        { PHASE_ENV(); const int M2 = NLAT;
          pg8::Gemm g{(const bf16_t*)(ws + WS_CAT), (const bf16_t*)(ws + WS_WOUT) + (size_t)l * D * D, M2, D, D};
          pg8::StaticOrder S; S.init(M2, D, F.G, F.bid);
          pg8::EpiResid E{(float*)(ws + WS_XRES), (l == 0) ? P.in[0] : (const float*)(ws + WS_XRES), (const float*)(ws + WS_MODF) + (size_t)l * 3 * 6144};
          pg8::gemm_phase<pg8::EpiResid, pg8::StaticOrder>(F.lds, g, S, E, F.tid);
          if (!last) for (int t = F.bid; t < 2 * 32; t += F.G) { const int pm = NLAT / 256 + (t >> 5), nt32 = t & 31;
              SkEpiResid SE{(float*)(ws + WS_XRES) + (size_t)pm * 256 * D + nt32 * 32, P.in[2] + (size_t)(pm - NLAT / 256) * 256 * D + nt32 * 32, (const float*)(ws + WS_MODF) + ((size_t)l * 3 + 2) * 6144 + 2 * 1024 + nt32 * 32};
              skinny_unit(F, (const bf16_t*)(ws + WS_CAT) + (size_t)pm * 256 * D, (const bf16_t*)(ws + WS_WOUT) + (size_t)l * D * D + (size_t)nt32 * 32 * D, SE); } }
        GRID_BAR();
        const int ntok = last ? NLAT : NTOK;
        { PHASE_ENV(); phase_route(F, P, l, ntok); }
        GRID_BAR();
        for (int rep = 0; rep < REP_GU; ++rep) { PHASE_ENV(); moe_prep(F, P, l); const volatile LAS int* TS = (const volatile LAS int*)(F.lds + LC_TS);
          pg8::Gemm g{(const bf16_t*)(ws + WS_HBUF), (const bf16_t*)(ws + WS_WGU) + (size_t)l * NE * 2048 * D, 0, 2048, D};
          pg8::MoeOrder S{8, F.G, F.bid, TS[NE], TS};
          pg8::EpiGateUp E{(bf16_t*)(ws + WS_ACT), P.in[22] + (size_t)l * NE * 2048};
          pg8::gemm_phase_gather<pg8::EpiGateUp, pg8::MoeOrder>(F.lds, g, (const int*)(ws + WS_XB), S, E, F.tid); }
        GRID_BAR();
        for (int rep = 0; rep < REP_DN; ++rep) { PHASE_ENV(); const volatile LAS int* TS = (const volatile LAS int*)(F.lds + LC_TS);
          pg8::Gemm g{(const bf16_t*)(ws + WS_ACT), (const bf16_t*)(ws + WS_WDN) + (size_t)l * NE * D * DFF, 0, D, DFF};
          pg8::MoeOrder S{4, F.G, F.bid, TS[NE], TS};
          pg8::EpiDown E{(bf16_t*)(ws + WS_YB), P.in[24] + (size_t)l * NE * D};
          pg8::gemm_phase<pg8::EpiDown, pg8::MoeOrder>(F.lds, g, S, E, F.tid); }
        GRID_BAR();
        { PHASE_ENV(); phase_combine(F, P, l, ntok, last); }
        if (!last) GRID_BAR();
    }
}

extern "C" void kernel_launch(void* const* d_in, const int* in_sizes, int n_in, void* d_out, int out_size, void* d_ws, size_t ws_size, hipStream_t stream) {
    static int grid = 0;
    if (grid == 0) {
        if (n_in != 26 || ws_size < WS_END) { fprintf(stderr, "kernel_launch: unexpected n_in %d or ws_size %zu (need %zu)\n", n_in, ws_size, (size_t)WS_END); grid = -1; return; }
        int dev = 0, cus = 0, per_cu = 0;
        if (hipGetDevice(&dev) != hipSuccess || hipDeviceGetAttribute(&cus, hipDeviceAttributeMultiprocessorCount, dev) != hipSuccess) { grid = -1; return; }
        if (hipFuncSetAttribute((const void*)mega_fwd, hipFuncAttributeMaxDynamicSharedMemorySize, LDS_BYTES) != hipSuccess) { fprintf(stderr, "kernel_launch: hipFuncSetAttribute failed\n"); grid = -1; return; }
        if (hipOccupancyMaxActiveBlocksPerMultiprocessor(&per_cu, (const void*)mega_fwd, NTHREADS, LDS_BYTES) != hipSuccess || per_cu < 1) { fprintf(stderr, "kernel_launch: occupancy query says %d\n", per_cu); }
        (void)hipGetLastError();
        grid = cus;
    }
    if (grid < 0) return;
    (void)hipMemsetAsync((char*)d_ws + WS_CTL, 0, CTL_ZERO_BYTES, stream);
    Params p{};
    for (int i = 0; i < 26; ++i) p.in[i] = (const float*)d_in[i];
    p.out = (float*)d_out; p.ws = (unsigned char*)d_ws;
    hipLaunchKernelGGL(mega_fwd, dim3(grid), dim3(NTHREADS), LDS_BYTES, stream, p);
}
```

```cpp
#include <hip/hip_runtime.h>
#include <cstdio>
#include <cstdint>

#define LAS __attribute__((address_space(3)))
#define GAS __attribute__((address_space(1)))
typedef unsigned short bf16_t;
typedef short bf16x8 __attribute__((ext_vector_type(8)));
typedef float f32x4 __attribute__((ext_vector_type(4)));
typedef float f32x2 __attribute__((ext_vector_type(2)));
typedef unsigned u32x4 __attribute__((ext_vector_type(4)));
typedef unsigned u32x2 __attribute__((ext_vector_type(2)));

constexpr int D = 1024, NBATCH = 2, SEQ = 16384, NLAT = NBATCH * SEQ, CTXL = 256, NCTX = NBATCH * CTXL, NTOK = NLAT + NCTX, DEPTH = 2;
constexpr int INW = 2336, INP = 2304;
constexpr int C_FOUR = 0, C_Q = 256, C_K = 512, C_V = 768, C_R = 1280, C_CA = 1792, C_CG = 2048;
constexpr int NE = 32, TOPK = 4, DFF = 1024;
constexpr int MAXROWS = NTOK * TOPK + NE * 256;
constexpr float NORM_EPS = 1e-6f;
constexpr int NTHREADS = 512, NWAVES = 8;

constexpr size_t MiB = 1u << 20;
constexpr size_t WS_CTL = 0, CTL_ZERO_BYTES = 1 * MiB;
constexpr size_t WS_MODP = 1 * MiB;
constexpr size_t WS_MODF = 3 * MiB;
constexpr size_t WS_RW = 3 * MiB + 512 * 1024;
constexpr size_t WS_WGT = 3 * MiB + 768 * 1024;
constexpr size_t WS_CM3 = 4 * MiB;
constexpr size_t WS_TF2 = 4 * MiB + 65536;
constexpr size_t WS_TCTX = 4 * MiB + 262144;
constexpr size_t WS_TLAT = 5 * MiB;
constexpr size_t WS_WIN = 13 * MiB;
constexpr size_t WS_WOUT = 23 * MiB;
constexpr size_t WS_WGU = 27 * MiB;
constexpr size_t WS_WDN = 283 * MiB;
constexpr size_t WS_XRES = 411 * MiB;
constexpr size_t WS_HBUF = 541 * MiB;
constexpr size_t WS_PBUF = 606 * MiB;
constexpr size_t WS_CAT = 769 * MiB;
constexpr size_t WS_T2 = 834 * MiB;
constexpr size_t WS_STATE = 866 * MiB;
constexpr size_t WS_DECAY = 996 * MiB;
constexpr size_t WS_AEXP = 998 * MiB, WS_APOS = 999 * MiB, WS_APROB = 1000 * MiB, WS_ASLOT = 1001 * MiB;
constexpr size_t WS_XB8 = 1106 * MiB;
constexpr size_t WS_HB8 = 1066 * MiB;
constexpr bool F8_LAYER[2] = {true, true};
constexpr size_t WS_LRB = 1018 * MiB;
constexpr size_t WS_XB = 1002 * MiB, WS_ACT = 1278 * MiB, WS_YB = 1554 * MiB, WS_END = 1830 * MiB;
constexpr int CW_BAR = 4096, CW_CNT = 16384;

constexpr int RING_BYTES = 131072;
constexpr int AUX_OFF = RING_BYTES;
constexpr int LCTL_OFF = RING_BYTES + 8192;
constexpr int LDS_BYTES = 147456;

__device__ __forceinline__ unsigned f2bf(float f) { unsigned u = __builtin_bit_cast(unsigned, f); return (u + 0x7fffu + ((u >> 16) & 1u)) >> 16; }
__device__ __forceinline__ unsigned pk2(float lo, float hi) { return f2bf(lo) | (f2bf(hi) << 16); }
__device__ __forceinline__ float bf2f(unsigned b) { return __builtin_bit_cast(float, b << 16); }
__device__ __forceinline__ float bflo(unsigned w) { return __builtin_bit_cast(float, w << 16); }
__device__ __forceinline__ float bfhi(unsigned w) { return __builtin_bit_cast(float, w & 0xffff0000u); }
__device__ __forceinline__ float wave_sum(float v) {
#pragma unroll
    for (int o = 1; o < 64; o <<= 1) v += __shfl_xor(v, o);
    return v;
}
__device__ __forceinline__ float sigmoidf_(float x) { return __builtin_amdgcn_rcpf(1.0f + __expf(-x)); }

#define XB_TMO      128
#define XB_XCNT(j)  (256  + 64 * (j))
#define XB_XSUB(j)  (1280 + 64 * (j))
#define XB_XGEN(j)  (2304 + 64 * (j))
#define XB_TOP      3328
#define XB_TOPGEN   3392
#define XCD_BAR_WORDS 3456
#define XB_SPIN_CAP (1u << 22)

__device__ __forceinline__ unsigned xb_ld(unsigned* p)              { return __hip_atomic_load(p, __ATOMIC_RELAXED, __HIP_MEMORY_SCOPE_AGENT); }
__device__ __forceinline__ unsigned xb_add(unsigned* p, unsigned v) { return __hip_atomic_fetch_add(p, v, __ATOMIC_RELAXED, __HIP_MEMORY_SCOPE_AGENT); }
__device__ __forceinline__ unsigned xb_xcc_id() { return (unsigned)__builtin_amdgcn_s_getreg((3 << 11) | 20) & 0xFu; }
#define XB_SPIN(cond, bar) do { unsigned _sp = 0; while (cond) { __builtin_amdgcn_s_sleep(1); \
    if ((++_sp & 255u) == 0u) { if (xb_ld(&(bar)[XB_TMO])) break; if (_sp > XB_SPIN_CAP) { atomicAdd(&(bar)[XB_TMO], 1u); break; } } } } while (0)

struct XcdBarrier { unsigned* bar; unsigned x; volatile LAS unsigned* st; };

__device__ __forceinline__ XcdBarrier xcd_barrier_post(unsigned* bar, volatile LAS unsigned* st) {
    XcdBarrier b; b.bar = bar; b.x = xb_xcc_id(); b.st = st;
    if (threadIdx.x == 0) (void)xb_add(&bar[XB_XCNT(b.x)], 1u);
    return b;
}
__device__ __forceinline__ void xcd_barrier_complete(unsigned* bar, unsigned x, unsigned& nloc, unsigned& nx) {
    const unsigned G = gridDim.x * gridDim.y * gridDim.z;
    unsigned sum, cnt, mine, sp = 0u;
    for (;;) {
        sum = 0u; cnt = 0u; mine = 0u;
#pragma unroll
        for (unsigned j = 0; j < 16; ++j) { const unsigned c = xb_ld(&bar[XB_XCNT(j)]); sum += c; cnt += (c > 0u) ? 1u : 0u; mine = (j == x) ? c : mine; }
        if (sum == G) break;
        __builtin_amdgcn_s_sleep(1);
        if ((++sp & 255u) == 0u) { if (xb_ld(&bar[XB_TMO])) break; if (sp > XB_SPIN_CAP) { atomicAdd(&bar[XB_TMO], 1u); break; } }
    }
    nloc = mine > 0u ? mine : 1u; nx = cnt > 0u ? cnt : 1u;
}
__device__ __forceinline__ void xcd_barrier(const XcdBarrier& b) {
    asm volatile("s_waitcnt vmcnt(0)" ::: "memory");
    __syncthreads();
    if (threadIdx.x == 0) {
        unsigned* bar = b.bar;
        __builtin_amdgcn_s_waitcnt(0);
        unsigned nloc = b.st[0], nx = b.st[1];
        if (nloc == 0u) { xcd_barrier_complete(bar, b.x, nloc, nx); b.st[0] = nloc; b.st[1] = nx; }
        const unsigned old = xb_add(&bar[XB_XSUB(b.x)], 1u);
        const unsigned gen = old / nloc;
        if (old + 1u == (gen + 1u) * nloc) {
            __builtin_amdgcn_fence(__ATOMIC_RELEASE, "agent");
            asm volatile("s_waitcnt vmcnt(0)" ::: "memory");
            const unsigned og = xb_add(&bar[XB_TOP], 1u);
            const unsigned tg = og / nx;
            if (og + 1u == (tg + 1u) * nx) xb_add(&bar[XB_TOPGEN], 1u);
            else XB_SPIN(xb_ld(&bar[XB_TOPGEN]) == tg, bar);
            __builtin_amdgcn_fence(__ATOMIC_ACQUIRE, "agent");
            xb_add(&bar[XB_XGEN(b.x)], 1u);
            asm volatile("s_waitcnt vmcnt(0)" ::: "memory");
        } else {
            XB_SPIN(xb_ld(&bar[XB_XGEN(b.x)]) == gen, bar);
            __builtin_amdgcn_fence(__ATOMIC_ACQUIRE, "agent");
            asm volatile("s_waitcnt vmcnt(0)" ::: "memory");
        }
    }
    __syncthreads();
}

namespace pg8 {
constexpr int BM = 256, BK = 64, HALF = 128, HTB = HALF * BK * 2, STAGE_BYTES = 8 * HTB, NXCD = 8, WGM = 8;
__host__ __device__ __forceinline__ int lds_byte(int r, int c) { const int st = (r >> 4) * 2 + (c >> 5), rr = r & 15, cc = c & 31, ob = rr * 64 + cc * 2; return st * 1024 + (ob ^ (((ob >> 9) & 1) << 5)); }
__host__ __device__ __forceinline__ void stage_rc(int b, int& R, int& C) { const int st = b / 1024, sb = b % 1024, swz = sb ^ (((sb >> 9) & 1) << 5); R = (st >> 1) * 16 + swz / 64; C = (st & 1) * 32 + (swz % 64) / 2; }
__host__ __device__ __forceinline__ int perm32(int rho) { const int n = rho >> 4, i = rho & 15; return 8 * (i >> 2) + 4 * n + (i & 3); }

struct Unit { int pm, pn, lbase, nvalid; };
struct Gemm { const bf16_t* A; const bf16_t* Bt; int M, N, K; };

struct StaticOrder {
    int nM, nN, nwg, G, c;
    __device__ void init(int M, int N, int G_, int c_) { nM = M / BM; nN = N / BM; nwg = nM * nN; G = G_; c = c_; }
    __device__ bool next(int i, Unit& u) const {
        const long L = (long)i * G + c; if (L >= nwg) return false;
        int wgid = (int)L; { const int q = nwg / NXCD, r = nwg % NXCD, xcd = wgid % NXCD, off = wgid / NXCD; wgid = (xcd < r ? xcd * (q + 1) : r * (q + 1) + (xcd - r) * q) + off; }
        const int nig = WGM * nN, gid = wgid / nig, fm = gid * WGM, gsz = (nM - fm) < WGM ? (nM - fm) : WGM;
        u.pm = fm + ((wgid % nig) % gsz); u.pn = (wgid % nig) / gsz; u.lbase = 0; u.nvalid = 0; return true;
    }
};
struct MoeOrder {
    int nN, G, c, MT; const volatile LAS int* ts;
    __device__ bool next(int i, Unit& u) const {
        const long L = (G % 8 == 0) ? ((long)i * G + (long)(c & 7) * (G >> 3) + (c >> 3)) : ((long)i * G + c);
        if (L >= (long)MT * nN) return false;
        const int mt = (int)(L / nN), pl = (int)(L % nN);
        const int lane = threadIdx.x & 63;
        const unsigned long long bal = __ballot(lane >= 1 && lane < NE && ts[lane] <= mt);
        const int e = __popcll(bal);
        const int j = mt - ts[e];
        u.pm = mt; u.pn = e * nN + pl; u.lbase = e * NTOK + j * 256; u.nvalid = ts[64 + e] - j * 256; return true;
    }
};

__device__ __forceinline__ unsigned cvt_pk_bf16(float lo, float hi) { unsigned r; asm volatile("v_cvt_pk_bf16_f32 %0, %1, %2" : "=v"(r) : "v"(lo), "v"(hi)); return r; }

struct EpiStoreBf16 {
    static constexpr bool PERM = true;
    bf16_t* O; int ldc;
    __device__ __forceinline__ void operator()(const f32x4 (&acc)[2][2][4][2], const Unit& u, int wr, int wc, int fr, int fq) const {
        const int row0 = u.pm * BM + wr * 64 + fr; const int col0 = u.pn * BM + wc * 32 + 8 * fq;
#pragma unroll
        for (int ai = 0; ai < 2; ++ai)
#pragma unroll
            for (int m = 0; m < 4; ++m) { bf16_t* rowp = O + (size_t)(row0 + ai * HALF + m * 16) * ldc + col0;
#pragma unroll
                for (int bj = 0; bj < 2; ++bj) { const f32x4 v0 = acc[ai][bj][m][0], v1 = acc[ai][bj][m][1];
                    u32x4 w; w.x = cvt_pk_bf16(v0[0], v0[1]); w.y = cvt_pk_bf16(v0[2], v0[3]); w.z = cvt_pk_bf16(v1[0], v1[1]); w.w = cvt_pk_bf16(v1[2], v1[3]);
                    *(u32x4*)(rowp + bj * HALF) = w; } }
    }
};
struct EpiResid {
    static constexpr bool PERM = false;
    float* X; const float* Xs; const float* modf;
    __device__ __forceinline__ void operator()(const f32x4 (&acc)[2][2][4][2], const Unit& u, int wr, int wc, int fr, int fq) const {
        const int row0 = u.pm * BM + wr * 64 + fr, col0 = u.pn * BM + wc * 32 + 4 * fq;
        const int v = (u.pm >= NLAT / BM) ? 2 : (u.pm >= SEQ / BM ? 1 : 0);
        const float* gv = modf + (size_t)v * 6144 + 2 * 1024;
        f32x4 bv[2][2];
#pragma unroll
        for (int bj = 0; bj < 2; ++bj)
#pragma unroll
            for (int n = 0; n < 2; ++n) bv[bj][n] = *(const f32x4*)(gv + col0 + bj * HALF + n * 16);
#pragma unroll
        for (int ai = 0; ai < 2; ++ai) {
            f32x4 xv[4][2][2];
#pragma unroll
            for (int m = 0; m < 4; ++m) { const float* rowp = Xs + (size_t)(row0 + ai * HALF + m * 16) * D + col0;
#pragma unroll
                for (int bj = 0; bj < 2; ++bj)
#pragma unroll
                    for (int n = 0; n < 2; ++n) xv[m][bj][n] = *(const f32x4*)(rowp + bj * HALF + n * 16); }
#pragma unroll
            for (int m = 0; m < 4; ++m) { float* rowp = X + (size_t)(row0 + ai * HALF + m * 16) * D + col0;
#pragma unroll
                for (int bj = 0; bj < 2; ++bj)
#pragma unroll
                    for (int n = 0; n < 2; ++n) *(f32x4*)(rowp + bj * HALF + n * 16) = xv[m][bj][n] + bv[bj][n] * acc[ai][bj][m][n]; }
        }
    }
};
struct EpiGateUp {
    static constexpr bool PERM = true;
    bf16_t* O; const float* bgu;
    __device__ __forceinline__ void operator()(const f32x4 (&acc)[2][2][4][2], const Unit& u, int wr, int wc, int fr, int fq) const {
        const int e = u.pn >> 3, pl = u.pn & 7;
        const int row0 = u.pm * BM + wr * 64 + fr; const int cl = pl * 128 + wc * 32 + 8 * fq;
        const float* bg = bgu + (size_t)e * 2048 + cl; const float* bu = bg + 1024;
        f32x4 g0 = *(const f32x4*)bg, g1 = *(const f32x4*)(bg + 4), u0 = *(const f32x4*)bu, u1 = *(const f32x4*)(bu + 4);
#pragma unroll
        for (int ai = 0; ai < 2; ++ai)
#pragma unroll
            for (int m = 0; m < 4; ++m) { bf16_t* rowp = O + (size_t)(row0 + ai * HALF + m * 16) * DFF + cl;
                float r[8];
#pragma unroll
                for (int n = 0; n < 2; ++n) { const f32x4 gb = n ? g1 : g0, ub = n ? u1 : u0; const f32x4 ga = acc[ai][0][m][n] + gb, ua = acc[ai][1][m][n] + ub;
#pragma unroll
                    for (int j = 0; j < 4; ++j) { const float gate = fminf(ga[j], 7.0f), up = fminf(fmaxf(ua[j], -7.0f), 7.0f);
                        r[n * 4 + j] = gate * __builtin_amdgcn_rcpf(1.0f + __expf(-1.702f * gate)) * (up + 1.0f); } }
                u32x4 w; w.x = cvt_pk_bf16(r[0], r[1]); w.y = cvt_pk_bf16(r[2], r[3]); w.z = cvt_pk_bf16(r[4], r[5]); w.w = cvt_pk_bf16(r[6], r[7]);
                *(u32x4*)rowp = w; }
    }
};
struct EpiDown {
    static constexpr bool PERM = true;
    bf16_t* O; const float* bdn;
    __device__ __forceinline__ void operator()(const f32x4 (&acc)[2][2][4][2], const Unit& u, int wr, int wc, int fr, int fq) const {
        const int e = u.pn >> 2, pl = u.pn & 3;
        const int row0 = u.pm * BM + wr * 64 + fr; const int col0 = pl * BM + wc * 32 + 8 * fq;
        f32x4 bv[2][2];
#pragma unroll
        for (int bj = 0; bj < 2; ++bj)
#pragma unroll
            for (int n = 0; n < 2; ++n) bv[bj][n] = *(const f32x4*)(bdn + (size_t)e * 1024 + col0 + bj * HALF + 4 * n);
#pragma unroll
        for (int ai = 0; ai < 2; ++ai)
#pragma unroll
            for (int m = 0; m < 4; ++m) { bf16_t* rowp = O + (size_t)(row0 + ai * HALF + m * 16) * D + col0;
#pragma unroll
                for (int bj = 0; bj < 2; ++bj) { const f32x4 v0 = acc[ai][bj][m][0] + bv[bj][0], v1 = acc[ai][bj][m][1] + bv[bj][1];
                    u32x4 w; w.x = cvt_pk_bf16(v0[0], v0[1]); w.y = cvt_pk_bf16(v0[2], v0[3]); w.z = cvt_pk_bf16(v1[0], v1[1]); w.w = cvt_pk_bf16(v1[2], v1[3]);
                    *(u32x4*)(rowp + bj * HALF) = w; } }
    }
};

__device__ __forceinline__ unsigned pk4_fp8(float a, float b, float c, float d) { unsigned w = 0u; w = __builtin_amdgcn_cvt_pk_fp8_f32(a, b, w, false); w = __builtin_amdgcn_cvt_pk_fp8_f32(c, d, w, true); return w; }
struct EpiGateUp8 {
    static constexpr bool PERM = true;
    unsigned char* O; const float* bgu;
    __device__ __forceinline__ void operator()(const f32x4 (&acc)[2][2][4][2], const Unit& u, int wr, int wc, int fr, int fq) const {
        const int e = u.pn >> 3, pl = u.pn & 7;
        const int row0 = u.pm * BM + wr * 64 + fr; const int cl = pl * 128 + wc * 32 + 8 * fq;
        const float* bg = bgu + (size_t)e * 2048 + cl; const float* bu = bg + 1024;
        f32x4 g0 = *(const f32x4*)bg, g1 = *(const f32x4*)(bg + 4), u0 = *(const f32x4*)bu, u1 = *(const f32x4*)(bu + 4);
#pragma unroll
        for (int ai = 0; ai < 2; ++ai)
#pragma unroll
            for (int m = 0; m < 4; ++m) { unsigned char* rowp = O + (size_t)(row0 + ai * HALF + m * 16) * DFF + cl;
                float r[8];
#pragma unroll
                for (int n = 0; n < 2; ++n) { const f32x4 gb = n ? g1 : g0, ub = n ? u1 : u0; const f32x4 ga = acc[ai][0][m][n] * 0.015625f + gb, ua = acc[ai][1][m][n] * 0.015625f + ub;
#pragma unroll
                    for (int j = 0; j < 4; ++j) { const float gate = fminf(ga[j], 7.0f), up = fminf(fmaxf(ua[j], -7.0f), 7.0f);
                        r[n * 4 + j] = gate * __builtin_amdgcn_rcpf(1.0f + __expf(-1.702f * gate)) * (up + 1.0f); } }
                u32x2 w; w.x = pk4_fp8(r[0], r[1], r[2], r[3]); w.y = pk4_fp8(r[4], r[5], r[6], r[7]);
                *(u32x2*)rowp = w; }
    }
};
struct EpiDown8 {
    static constexpr bool PERM = true;
    bf16_t* O; const float* bdn;
    __device__ __forceinline__ void operator()(const f32x4 (&acc)[2][2][4][2], const Unit& u, int wr, int wc, int fr, int fq) const {
        const int e = u.pn >> 2, pl = u.pn & 3;
        const int row0 = u.pm * BM + wr * 64 + fr; const int col0 = pl * BM + wc * 32 + 8 * fq;
        f32x4 bv[2][2];
#pragma unroll
        for (int bj = 0; bj < 2; ++bj)
#pragma unroll
            for (int n = 0; n < 2; ++n) bv[bj][n] = *(const f32x4*)(bdn + (size_t)e * 1024 + col0 + bj * HALF + 4 * n);
#pragma unroll
        for (int ai = 0; ai < 2; ++ai)
#pragma unroll
            for (int m = 0; m < 4; ++m) { bf16_t* rowp = O + (size_t)(row0 + ai * HALF + m * 16) * D + col0;
#pragma unroll
                for (int bj = 0; bj < 2; ++bj) { const f32x4 v0 = acc[ai][bj][m][0] * 0.015625f + bv[bj][0], v1 = acc[ai][bj][m][1] * 0.015625f + bv[bj][1];
                    u32x4 w; w.x = cvt_pk_bf16(v0[0], v0[1]); w.y = cvt_pk_bf16(v0[2], v0[3]); w.z = cvt_pk_bf16(v1[0], v1[1]); w.w = cvt_pk_bf16(v1[2], v1[3]);
                    *(u32x4*)(rowp + bj * HALF) = w; } }
    }
};

typedef int i32x8 __attribute__((ext_vector_type(8)));
typedef int i32x4 __attribute__((ext_vector_type(4)));
__device__ __forceinline__ i32x8 cat8(const bf16x8 lo, const bf16x8 hi) { const i32x4 a = __builtin_bit_cast(i32x4, lo), b = __builtin_bit_cast(i32x4, hi); return __builtin_shufflevector(a, b, 0, 1, 2, 3, 4, 5, 6, 7); }
template <class Epi, class Sched, bool ALIGN_EPI = true, bool SP2 = true, bool F8 = false>
__device__ __forceinline__ void gemm_phase(LAS unsigned char* lds, const Gemm g, const Sched& S, const Epi& E, const int tid) {
    const int wid = __builtin_amdgcn_readfirstlane(tid >> 6), lane = tid & 63, wr = wid >> 2, wc = wid & 3, fr = lane & 15, fq = lane >> 4;
    const int K = g.K, nt = K / BK;
    unsigned voffA[2], voffB[2];
#pragma unroll
    for (int i = 0; i < 2; ++i) { int R, C; stage_rc(tid * 16 + i * 8192, R, C); const int Rb = Epi::PERM ? ((R & ~31) + perm32(R & 31)) : R;
        voffA[i] = (unsigned)(R * K + C) * 2u; voffB[i] = (unsigned)(Rb * K + C) * 2u; }
    const size_t kstep = (size_t)(BK * 2);
    const size_t hstep = (size_t)HALF * K * 2;
    const size_t tstep = 2 * hstep;
    const unsigned ldsw = (unsigned)wid * 1024u;
    const int aoff = lds_byte(wr * 64 + fr, fq * 8), boff = lds_byte(wc * 32 + fr, fq * 8);
#define PG8_SA(b, h) (((b) * 2 + (h)) * HTB)
#define PG8_SB(b, h) ((4 + (b) * 2 + (h)) * HTB)
#define PG8_STAGE(bufoff, gbase, voff) do { _Pragma("unroll") for (int _i = 0; _i < 2; ++_i) \
        __builtin_amdgcn_global_load_lds((const unsigned*)((const char*)(gbase) + (voff)[_i]), (LAS unsigned*)(lds + (bufoff) + ldsw + _i * 8192), 16, 0, 0); } while (0)
#define PG8_LDA(dst, b, h) do { _Pragma("unroll") for (int m = 0; m < 4; ++m) { if constexpr (F8) dst##8[m] = cat8(*(const LAS bf16x8*)(lds + PG8_SA(b, h) + aoff + m * 2048), *(const LAS bf16x8*)(lds + PG8_SA(b, h) + aoff + m * 2048 + 1024)); \
        else { _Pragma("unroll") for (int k = 0; k < 2; ++k) dst[m][k] = *(const LAS bf16x8*)(lds + PG8_SA(b, h) + aoff + m * 2048 + k * 1024); } } } while (0)
#define PG8_LDB(dst, b, h) do { _Pragma("unroll") for (int n = 0; n < 2; ++n) { if constexpr (F8) dst##8[n] = cat8(*(const LAS bf16x8*)(lds + PG8_SB(b, h) + boff + n * 2048), *(const LAS bf16x8*)(lds + PG8_SB(b, h) + boff + n * 2048 + 1024)); \
        else { _Pragma("unroll") for (int k = 0; k < 2; ++k) dst[n][k] = *(const LAS bf16x8*)(lds + PG8_SB(b, h) + boff + n * 2048 + k * 1024); } } } while (0)
#define PG8_MMA(ai, bj, At, Bt) do { __builtin_amdgcn_s_setprio(1); \
        if constexpr (F8) { _Pragma("unroll") for (int m = 0; m < 4; ++m) _Pragma("unroll") for (int n = 0; n < 2; ++n) \
            acc[ai][bj][m][n] = __builtin_amdgcn_mfma_scale_f32_16x16x128_f8f6f4(Bt##8[n], At##8[m], acc[ai][bj][m][n], 0, 0, 0, 0x7f7f7f7f, 0, 0x7f7f7f7f); \
            _Pragma("unroll") for (int m = 0; m < 4; ++m) _Pragma("unroll") for (int n = 0; n < 2; ++n) asm volatile("" : "+v"(acc[ai][bj][m][n])); } \
        else { _Pragma("unroll") for (int m = 0; m < 4; ++m) _Pragma("unroll") for (int n = 0; n < 2; ++n) _Pragma("unroll") for (int k = 0; k < 2; ++k) \
            acc[ai][bj][m][n] = __builtin_amdgcn_mfma_f32_16x16x32_bf16(Bt[n][k], At[m][k], acc[ai][bj][m][n], 0, 0, 0); } \
        __builtin_amdgcn_s_setprio(0); } while (0)
#define PG8_WAIT_V(n) asm volatile("s_waitcnt vmcnt(" #n ")" ::: "memory")
#define PG8_WAIT_L(n) asm volatile("s_waitcnt lgkmcnt(" #n ")" ::: "memory")
#define PG8_BAR __builtin_amdgcn_s_barrier()
#define PG8_SCHED __builtin_amdgcn_sched_barrier(0)
    Unit cur, nxt; int ui = 0;
    if (!S.next(0, cur)) return;
    f32x4 acc[2][2][4][2];
#pragma unroll
    for (int a = 0; a < 2; ++a)
#pragma unroll
        for (int b = 0; b < 2; ++b)
#pragma unroll
            for (int m = 0; m < 4; ++m)
#pragma unroll
                for (int n = 0; n < 2; ++n) acc[a][b][m][n] = (f32x4){0.f, 0.f, 0.f, 0.f};
    bf16x8 At[4][2], B0[2][2], B1[2][2]; i32x8 At8[4], B08[2], B18[2];
    const char* cA = (const char*)g.A + (size_t)cur.pm * tstep; const char* cB = (const char*)g.Bt + (size_t)cur.pn * tstep;
    if constexpr (SP2) {
        PG8_STAGE(PG8_SB(0, 0), cB, voffB); PG8_STAGE(PG8_SB(0, 1), cB + hstep, voffB); PG8_STAGE(PG8_SA(0, 0), cA, voffA); PG8_STAGE(PG8_SA(0, 1), cA + hstep, voffA);
        if (wr == 1) PG8_BAR;
        PG8_WAIT_V(2); PG8_BAR;
        PG8_STAGE(PG8_SB(1, 0), cB + kstep, voffB); PG8_STAGE(PG8_SA(1, 0), cA + kstep, voffA); PG8_STAGE(PG8_SB(1, 1), cB + hstep + kstep, voffB);
        PG8_WAIT_V(6); PG8_BAR;
    } else {
        PG8_STAGE(PG8_SB(0, 0), cB, voffB); PG8_STAGE(PG8_SA(0, 0), cA, voffA); PG8_STAGE(PG8_SB(0, 1), cB + hstep, voffB); PG8_STAGE(PG8_SA(0, 1), cA + hstep, voffA);
        if (wr == 1) PG8_BAR;
        PG8_WAIT_V(4); PG8_BAR;
        PG8_STAGE(PG8_SB(1, 0), cB + kstep, voffB); PG8_STAGE(PG8_SA(1, 0), cA + kstep, voffA); PG8_STAGE(PG8_SB(1, 1), cB + hstep + kstep, voffB);
        PG8_WAIT_V(6); PG8_BAR;
    }
    for (;;) {
        const bool has_next = S.next(ui + 1, nxt);
        const char* nA = has_next ? (const char*)g.A + (size_t)nxt.pm * tstep : cA; const char* nB = has_next ? (const char*)g.Bt + (size_t)nxt.pn * tstep : cB;
        for (int t = 0; t < nt; t += 2) {
            const bool last = (t == nt - 2);
            const char* a1 = cA + (size_t)(t + 1) * kstep;
            const char* a2 = last ? nA : cA + (size_t)(t + 2) * kstep; const char* b2 = last ? nB : cB + (size_t)(t + 2) * kstep;
            const char* a3 = a2 + kstep; const char* b3 = b2 + kstep;
            if constexpr (SP2) {
            PG8_LDB(B0, 0, 0); PG8_LDB(B1, 0, 1); PG8_SCHED; PG8_LDA(At, 0, 0); PG8_STAGE(PG8_SA(1, 1), a1 + hstep, voffA);
            PG8_WAIT_V(8); PG8_WAIT_L(0); PG8_BAR; PG8_MMA(0, 0, At, B0); PG8_MMA(0, 1, At, B1); PG8_BAR; PG8_SCHED;
            PG8_LDA(At, 0, 1); PG8_STAGE(PG8_SB(0, 0), b2, voffB); PG8_STAGE(PG8_SB(0, 1), b2 + hstep, voffB); PG8_STAGE(PG8_SA(0, 0), a2, voffA);
            PG8_WAIT_V(8); PG8_WAIT_L(0); PG8_BAR; PG8_MMA(1, 0, At, B0); PG8_MMA(1, 1, At, B1); PG8_BAR; PG8_SCHED;
            PG8_LDB(B0, 1, 0); PG8_LDB(B1, 1, 1); PG8_SCHED; PG8_LDA(At, 1, 0); PG8_STAGE(PG8_SA(0, 1), a2 + hstep, voffA);
            PG8_WAIT_V(8); PG8_WAIT_L(0); PG8_BAR; PG8_MMA(0, 0, At, B0); PG8_MMA(0, 1, At, B1); PG8_BAR; PG8_SCHED;
            PG8_LDA(At, 1, 1); PG8_STAGE(PG8_SB(1, 0), b3, voffB); PG8_STAGE(PG8_SB(1, 1), b3 + hstep, voffB); PG8_STAGE(PG8_SA(1, 0), a3, voffA);
            PG8_WAIT_V(8); PG8_WAIT_L(0); PG8_BAR; PG8_MMA(1, 0, At, B0); PG8_MMA(1, 1, At, B1); PG8_BAR; PG8_SCHED;
            } else {
            PG8_LDB(B0, 0, 0); PG8_SCHED; PG8_LDA(At, 0, 0); PG8_STAGE(PG8_SA(1, 1), a1 + hstep, voffA);
            PG8_WAIT_L(8); PG8_BAR; PG8_WAIT_L(0); PG8_MMA(0, 0, At, B0); PG8_BAR; PG8_SCHED;
            PG8_LDB(B1, 0, 1); PG8_STAGE(PG8_SB(0, 0), b2, voffB);
            PG8_BAR; PG8_WAIT_L(0); PG8_MMA(0, 1, At, B1); PG8_BAR;
            PG8_LDA(At, 0, 1); PG8_STAGE(PG8_SA(0, 0), a2, voffA);
            PG8_BAR; PG8_WAIT_L(0); PG8_MMA(1, 0, At, B0); PG8_BAR; PG8_SCHED;
            PG8_STAGE(PG8_SB(0, 1), b2 + hstep, voffB);
            PG8_WAIT_V(6); PG8_BAR; PG8_MMA(1, 1, At, B1); PG8_BAR;
            PG8_LDB(B0, 1, 0); PG8_SCHED; PG8_LDA(At, 1, 0); PG8_STAGE(PG8_SA(0, 1), a2 + hstep, voffA);
            PG8_WAIT_L(8); PG8_BAR; PG8_WAIT_L(0); PG8_MMA(0, 0, At, B0); PG8_BAR; PG8_SCHED;
            PG8_LDB(B1, 1, 1); PG8_STAGE(PG8_SB(1, 0), b3, voffB);
            PG8_BAR; PG8_WAIT_L(0); PG8_MMA(0, 1, At, B1); PG8_BAR;
            PG8_LDA(At, 1, 1); PG8_STAGE(PG8_SA(1, 0), a3, voffA);
            PG8_BAR; PG8_WAIT_L(0); PG8_MMA(1, 0, At, B0); PG8_BAR; PG8_SCHED;
            PG8_STAGE(PG8_SB(1, 1), b3 + hstep, voffB);
            PG8_WAIT_V(6); PG8_BAR; PG8_MMA(1, 1, At, B1); PG8_BAR;
            }
        }
        if constexpr (ALIGN_EPI) { if (wr == 0) PG8_BAR; }
        E(acc, cur, wr, wc, fr, fq);
        if (!has_next) break;
#pragma unroll
        for (int a = 0; a < 2; ++a)
#pragma unroll
            for (int b = 0; b < 2; ++b)
#pragma unroll
                for (int m = 0; m < 4; ++m)
#pragma unroll
                    for (int n = 0; n < 2; ++n) acc[a][b][m][n] = (f32x4){0.f, 0.f, 0.f, 0.f};
        cur = nxt; cA = nA; cB = nB; ++ui;
        if constexpr (ALIGN_EPI) { if (wr == 1) PG8_BAR; }
    }
    PG8_WAIT_V(0);
    if constexpr (!ALIGN_EPI) { if (wr == 0) PG8_BAR; }
    PG8_BAR;
#undef PG8_SA
#undef PG8_SB
#undef PG8_STAGE
#undef PG8_LDA
#undef PG8_LDB
#undef PG8_MMA
#undef PG8_WAIT_V
#undef PG8_WAIT_L
#undef PG8_BAR
#undef PG8_SCHED
}

template <class Epi, class Sched, bool F8 = false>
__device__ __forceinline__ void gemm_phase_gather(LAS unsigned char* lds, const Gemm g, const int* list, const Sched& S, const Epi& E, const int tid) {
    const int wid = __builtin_amdgcn_readfirstlane(tid >> 6), lane = tid & 63, wr = wid >> 2, wc = wid & 3, fr = lane & 15, fq = lane >> 4;
    const int K = g.K, nt = K / BK;
    unsigned voffB0, cA2;
    { int R, C; stage_rc(tid * 16, R, C); const int Rb = Epi::PERM ? ((R & ~31) + perm32(R & 31)) : R; cA2 = (unsigned)C * 2u; voffB0 = (unsigned)(Rb * K + C) * 2u; }
    const unsigned voffB[2] = {voffB0, voffB0 + (unsigned)(64 * K * 2)};
    const size_t kstep = (size_t)(BK * 2);
    const size_t hstep = (size_t)HALF * K * 2;
    const size_t tstep = 2 * hstep;
    const unsigned ldsw = (unsigned)wid * 1024u;
    const int aoff = lds_byte(wr * 64 + fr, fq * 8), boff = lds_byte(wc * 32 + fr, fq * 8);
#define PG8_SA(b, h) (((b) * 2 + (h)) * HTB)
#define PG8_SB(b, h) ((4 + (b) * 2 + (h)) * HTB)
#define PG8_STAGE(bufoff, gbase, voff) do { _Pragma("unroll") for (int _i = 0; _i < 2; ++_i) \
        __builtin_amdgcn_global_load_lds((const unsigned*)((const char*)(gbase) + (voff)[_i]), (LAS unsigned*)(lds + (bufoff) + ldsw + _i * 8192), 16, 0, 0); } while (0)
#define PG8_LDA(dst, b, h) do { _Pragma("unroll") for (int m = 0; m < 4; ++m) { if constexpr (F8) dst##8[m] = cat8(*(const LAS bf16x8*)(lds + PG8_SA(b, h) + aoff + m * 2048), *(const LAS bf16x8*)(lds + PG8_SA(b, h) + aoff + m * 2048 + 1024)); \
        else { _Pragma("unroll") for (int k = 0; k < 2; ++k) dst[m][k] = *(const LAS bf16x8*)(lds + PG8_SA(b, h) + aoff + m * 2048 + k * 1024); } } } while (0)
#define PG8_LDB(dst, b, h) do { _Pragma("unroll") for (int n = 0; n < 2; ++n) { if constexpr (F8) dst##8[n] = cat8(*(const LAS bf16x8*)(lds + PG8_SB(b, h) + boff + n * 2048), *(const LAS bf16x8*)(lds + PG8_SB(b, h) + boff + n * 2048 + 1024)); \
        else { _Pragma("unroll") for (int k = 0; k < 2; ++k) dst[n][k] = *(const LAS bf16x8*)(lds + PG8_SB(b, h) + boff + n * 2048 + k * 1024); } } } while (0)
#define PG8_MMA(ai, bj, At, Bt) do { __builtin_amdgcn_s_setprio(1); \
        if constexpr (F8) { _Pragma("unroll") for (int m = 0; m < 4; ++m) _Pragma("unroll") for (int n = 0; n < 2; ++n) \
            acc[ai][bj][m][n] = __builtin_amdgcn_mfma_scale_f32_16x16x128_f8f6f4(Bt##8[n], At##8[m], acc[ai][bj][m][n], 0, 0, 0, 0x7f7f7f7f, 0, 0x7f7f7f7f); \
            _Pragma("unroll") for (int m = 0; m < 4; ++m) _Pragma("unroll") for (int n = 0; n < 2; ++n) asm volatile("" : "+v"(acc[ai][bj][m][n])); } \
        else { _Pragma("unroll") for (int m = 0; m < 4; ++m) _Pragma("unroll") for (int n = 0; n < 2; ++n) _Pragma("unroll") for (int k = 0; k < 2; ++k) \
            acc[ai][bj][m][n] = __builtin_amdgcn_mfma_f32_16x16x32_bf16(Bt[n][k], At[m][k], acc[ai][bj][m][n], 0, 0, 0); } \
        __builtin_amdgcn_s_setprio(0); } while (0)
#define PG8_WAIT_V(n) asm volatile("s_waitcnt vmcnt(" #n ")" ::: "memory")
#define PG8_WAIT_L(n) asm volatile("s_waitcnt lgkmcnt(" #n ")" ::: "memory")
#define PG8_BAR __builtin_amdgcn_s_barrier()
#define PG8_SCHED __builtin_amdgcn_sched_barrier(0)
#define PG8_LOADTOK(u, vo) do { int _ra0, _ra1, _c; stage_rc(tid * 16, _ra0, _c); stage_rc(tid * 16 + 8192, _ra1, _c); _Pragma("unroll") for (int _h = 0; _h < 2; ++_h) { const int _r0 = _h * HALF + _ra0, _r1 = _h * HALF + _ra1; \
        const unsigned _t0 = (_r0 < (u).nvalid) ? (unsigned)list[(u).lbase + _r0] : 0u, _t1 = (_r1 < (u).nvalid) ? (unsigned)list[(u).lbase + _r1] : 0u; (vo)[_h] = _t0 | (_t1 << 16); } } while (0)
#define PG8_STAGE_A(bufoff, gbase, pk) do { _Pragma("unroll") for (int _i = 0; _i < 2; ++_i) { const unsigned _off = (((pk) >> (16 * _i)) & 0xffffu) * (unsigned)(K * 2) + cA2; \
        __builtin_amdgcn_global_load_lds((const unsigned*)((const char*)(gbase) + _off), (LAS unsigned*)(lds + (bufoff) + ldsw + _i * 8192), 16, 0, 0); } } while (0)
    Unit cur, nxt; int ui = 0;
    if (!S.next(0, cur)) return;
    f32x4 acc[2][2][4][2];
#pragma unroll
    for (int a = 0; a < 2; ++a)
#pragma unroll
        for (int b = 0; b < 2; ++b)
#pragma unroll
            for (int m = 0; m < 4; ++m)
#pragma unroll
                for (int n = 0; n < 2; ++n) acc[a][b][m][n] = (f32x4){0.f, 0.f, 0.f, 0.f};
    bf16x8 At[4][2], B0[2][2], B1[2][2]; i32x8 At8[4], B08[2], B18[2];
    unsigned vc[2], vn[2];
    PG8_LOADTOK(cur, vc);
    const char* gA = (const char*)g.A; const char* cB = (const char*)g.Bt + (size_t)cur.pn * tstep;
    PG8_STAGE(PG8_SB(0, 0), cB, voffB); PG8_STAGE(PG8_SB(0, 1), cB + hstep, voffB); PG8_STAGE_A(PG8_SA(0, 0), gA, vc[0]); PG8_STAGE_A(PG8_SA(0, 1), gA, vc[1]);
    if (wr == 1) PG8_BAR;
    PG8_WAIT_V(2); PG8_BAR;
    PG8_STAGE(PG8_SB(1, 0), cB + kstep, voffB); PG8_STAGE_A(PG8_SA(1, 0), gA + kstep, vc[0]); PG8_STAGE(PG8_SB(1, 1), cB + hstep + kstep, voffB);
    PG8_WAIT_V(6); PG8_BAR;
    for (;;) {
        const bool has_next = S.next(ui + 1, nxt);
        if (has_next) { PG8_LOADTOK(nxt, vn); }
        const char* nB = has_next ? (const char*)g.Bt + (size_t)nxt.pn * tstep : cB;
        for (int t = 0; t < nt; t += 2) {
            const bool last = (t == nt - 2);
            const char* a1 = gA + (size_t)(t + 1) * kstep;
            const char* b2 = last ? nB : cB + (size_t)(t + 2) * kstep; const char* b3 = b2 + kstep;
            const char* a2 = last ? gA : gA + (size_t)(t + 2) * kstep; const char* a3 = a2 + kstep;
            PG8_LDB(B0, 0, 0); PG8_LDB(B1, 0, 1); PG8_SCHED; PG8_LDA(At, 0, 0); PG8_STAGE_A(PG8_SA(1, 1), a1, vc[1]);
            if (last && has_next) {
                vc[0] = vn[0]; vc[1] = vn[1]; }
            PG8_WAIT_V(8); PG8_WAIT_L(0); PG8_BAR; PG8_MMA(0, 0, At, B0); PG8_MMA(0, 1, At, B1); PG8_BAR; PG8_SCHED;
            PG8_LDA(At, 0, 1); PG8_STAGE(PG8_SB(0, 0), b2, voffB); PG8_STAGE(PG8_SB(0, 1), b2 + hstep, voffB); PG8_STAGE_A(PG8_SA(0, 0), a2, vc[0]);
            PG8_WAIT_V(8); PG8_WAIT_L(0); PG8_BAR; PG8_MMA(1, 0, At, B0); PG8_MMA(1, 1, At, B1); PG8_BAR; PG8_SCHED;
            PG8_LDB(B0, 1, 0); PG8_LDB(B1, 1, 1); PG8_SCHED; PG8_LDA(At, 1, 0); PG8_STAGE_A(PG8_SA(0, 1), a2, vc[1]);
            PG8_WAIT_V(8); PG8_WAIT_L(0); PG8_BAR; PG8_MMA(0, 0, At, B0); PG8_MMA(0, 1, At, B1); PG8_BAR; PG8_SCHED;
            PG8_LDA(At, 1, 1); PG8_STAGE(PG8_SB(1, 0), b3, voffB); PG8_STAGE(PG8_SB(1, 1), b3 + hstep, voffB); PG8_STAGE_A(PG8_SA(1, 0), a3, vc[0]);
            PG8_WAIT_V(8); PG8_WAIT_L(0); PG8_BAR; PG8_MMA(1, 0, At, B0); PG8_MMA(1, 1, At, B1); PG8_BAR; PG8_SCHED;
        }
        if (wr == 0) PG8_BAR;
        E(acc, cur, wr, wc, fr, fq);
        if (!has_next) break;
#pragma unroll
        for (int a = 0; a < 2; ++a)
#pragma unroll
            for (int b = 0; b < 2; ++b)
#pragma unroll
                for (int m = 0; m < 4; ++m)
#pragma unroll
                    for (int n = 0; n < 2; ++n) acc[a][b][m][n] = (f32x4){0.f, 0.f, 0.f, 0.f};
        cur = nxt; cB = nB; ++ui;
        if (wr == 1) PG8_BAR;
    }
    PG8_WAIT_V(0);
    PG8_BAR;
#undef PG8_SA
#undef PG8_SB
#undef PG8_STAGE
#undef PG8_LDA
#undef PG8_LDB
#undef PG8_MMA
#undef PG8_WAIT_V
#undef PG8_WAIT_L
#undef PG8_BAR
#undef PG8_SCHED
#undef PG8_STAGE_A
#undef PG8_LOADTOK
}
}

struct Params {
    const float* in[26];
    float* out;
    unsigned char* ws;
};
struct Frame {
    LAS unsigned char* lds;
    int tid, lane, wave, G, bid;
};

template <int MT, int NT>
__device__ __forceinline__ void mma_nt(f32x4 (&acc)[MT][NT], const LAS bf16_t* A, int lda, const LAS bf16_t* B, int ldb, int K, int fr, int fq) {
    for (int k0 = 0; k0 < K; k0 += 32) {
        bf16x8 a[MT], b[NT];
#pragma unroll
        for (int m = 0; m < MT; ++m) a[m] = *(const LAS bf16x8*)(A + (m * 16 + fr) * lda + k0 + fq * 8);
#pragma unroll
        for (int n = 0; n < NT; ++n) b[n] = *(const LAS bf16x8*)(B + (n * 16 + fr) * ldb + k0 + fq * 8);
#pragma unroll
        for (int m = 0; m < MT; ++m)
#pragma unroll
            for (int n = 0; n < NT; ++n) acc[m][n] = __builtin_amdgcn_mfma_f32_16x16x32_bf16(a[m], b[n], acc[m][n], 0, 0, 0);
    }
}
template <int MT, int NT> __device__ __forceinline__ void zero_acc(f32x4 (&acc)[MT][NT]) {
#pragma unroll
    for (int m = 0; m < MT; ++m)
#pragma unroll
        for (int n = 0; n < NT; ++n) acc[m][n] = (f32x4){0.f, 0.f, 0.f, 0.f};
}

constexpr int SK_A = 0, SK_B = 69632;
template <class Epi>
__device__ __forceinline__ void skinny_unit(const Frame& F, const bf16_t* A, const bf16_t* Bt, const Epi& E) {
    LAS bf16_t* As = (LAS bf16_t*)(F.lds + SK_A); LAS bf16_t* Bs = (LAS bf16_t*)(F.lds + SK_B);
    const int tid = F.tid, fr = F.lane & 15, fq = F.lane >> 4, w = F.wave;
    f32x4 acc[2][2]; zero_acc<2, 2>(acc);
    u32x4 av[8], bv;
#pragma unroll
    for (int i = 0; i < 8; ++i) { const int ch = tid + NTHREADS * i, r = ch >> 4, c8 = (ch & 15) * 8; av[i] = *(const u32x4*)(A + (size_t)r * D + c8); }
    { const int r = tid >> 4, c8 = (tid & 15) * 8; bv = *(const u32x4*)(Bt + (size_t)r * D + c8); }
    for (int kc = 0; kc < 8; ++kc) {
        __syncthreads();
#pragma unroll
        for (int i = 0; i < 8; ++i) { const int ch = tid + NTHREADS * i, r = ch >> 4, c8 = (ch & 15) * 8; *(LAS u32x4*)(As + r * 136 + c8) = av[i]; }
        { const int r = tid >> 4, c8 = (tid & 15) * 8; *(LAS u32x4*)(Bs + r * 136 + c8) = bv; }
        if (kc + 1 < 8) {
#pragma unroll
            for (int i = 0; i < 8; ++i) { const int ch = tid + NTHREADS * i, r = ch >> 4, c8 = (ch & 15) * 8; av[i] = *(const u32x4*)(A + (size_t)r * D + (kc + 1) * 128 + c8); }
            { const int r = tid >> 4, c8 = (tid & 15) * 8; bv = *(const u32x4*)(Bt + (size_t)r * D + (kc + 1) * 128 + c8); } }
        __syncthreads();
        mma_nt<2, 2>(acc, As + (32 * w) * 136, 136, Bs, 136, 128, fr, fq);
    }
#pragma unroll
    for (int mt = 0; mt < 2; ++mt)
#pragma unroll
        for (int nt = 0; nt < 2; ++nt)
#pragma unroll
            for (int j = 0; j < 4; ++j) E(32 * w + mt * 16 + fq * 4 + j, nt * 16 + fr, acc[mt][nt][j]);
    __syncthreads();
}
struct SkEpiBf16 { bf16_t* O; int ldc; __device__ __forceinline__ void operator()(int r, int c, float v) const { O[(size_t)r * ldc + c] = (bf16_t)f2bf(v); } };
struct SkEpiResid { float* X; const float* Xs; const float* gate; __device__ __forceinline__ void operator()(int r, int c, float v) const { X[(size_t)r * D + c] = Xs[(size_t)r * D + c] + gate[c] * v; } };

__device__ __forceinline__ void p0_transpose_item(const float* W, int K, int N, bf16_t* WT, int k0, int n0, int orow0, LAS float* scr, int lane) {
    float tv[32];
#pragma unroll
    for (int i = 0; i < 32; ++i) { const int kk = 2 * i + (lane >> 5); tv[i] = W[(size_t)(k0 + kk) * N + n0 + (lane & 31)]; }
#pragma unroll
    for (int i = 0; i < 32; ++i) { const int kk = 2 * i + (lane >> 5); scr[kk * 33 + (lane & 31)] = tv[i]; }
    asm volatile("s_waitcnt lgkmcnt(0)" ::: "memory");
    const int c = lane & 7;
#pragma unroll
    for (int j = 0; j < 4; ++j) { const int n = (lane >> 3) + 8 * j; const LAS float* s = scr + (8 * c) * 33 + n;
        u32x4 o; o.x = pk2(s[0 * 33], s[1 * 33]); o.y = pk2(s[2 * 33], s[3 * 33]); o.z = pk2(s[4 * 33], s[5 * 33]); o.w = pk2(s[6 * 33], s[7 * 33]);
        *(u32x4*)(WT + (size_t)(orow0 + n) * K + k0 + 8 * c) = o; }
    asm volatile("s_waitcnt lgkmcnt(0)" ::: "memory");
}

using pg8::pk4_fp8;
__device__ __forceinline__ void p0_transpose_item8(const float* W, int K, int N, unsigned char* WT8, int k0, int n0, int orow0, LAS float* scr, int lane) {
    float tv[32];
#pragma unroll
    for (int i = 0; i < 32; ++i) { const int kk = 2 * i + (lane >> 5); tv[i] = W[(size_t)(k0 + kk) * N + n0 + (lane & 31)]; }
#pragma unroll
    for (int i = 0; i < 32; ++i) { const int kk = 2 * i + (lane >> 5); scr[kk * 33 + (lane & 31)] = tv[i]; }
    asm volatile("s_waitcnt lgkmcnt(0)" ::: "memory");
    const int c = lane & 3;
#pragma unroll
    for (int j = 0; j < 2; ++j) { const int n = (lane >> 2) + 16 * j; const LAS float* sp = scr + (16 * c) * 33 + n;
        u32x4 o; o.x = pk4_fp8(64.f * sp[0 * 33], 64.f * sp[1 * 33], 64.f * sp[2 * 33], 64.f * sp[3 * 33]); o.y = pk4_fp8(64.f * sp[4 * 33], 64.f * sp[5 * 33], 64.f * sp[6 * 33], 64.f * sp[7 * 33]);
        o.z = pk4_fp8(64.f * sp[8 * 33], 64.f * sp[9 * 33], 64.f * sp[10 * 33], 64.f * sp[11 * 33]); o.w = pk4_fp8(64.f * sp[12 * 33], 64.f * sp[13 * 33], 64.f * sp[14 * 33], 64.f * sp[15 * 33]);
        *(u32x4*)(WT8 + (size_t)(orow0 + n) * K + k0 + 16 * c) = o; }
    asm volatile("s_waitcnt lgkmcnt(0)" ::: "memory");
}

__device__ __forceinline__ void phase_prologue(const Frame& F, const Params& P) {
    unsigned char* ws = P.ws;
    LAS float* scr = (LAS float*)(F.lds + F.wave * 16384);
    const int gw = F.bid * NWAVES + F.wave, NGW = F.G * NWAVES;
    constexpr int I_IN = 16 * 73, I_OUT = 16 * 32, I_GU = 16 * 64, I_DN = 16 * 32;
    constexpr int PER_LAYER = I_IN + I_OUT + NE * I_GU + NE * I_DN;
    for (int it = gw; it < DEPTH * PER_LAYER; it += NGW) {
        const int l = it / PER_LAYER; int r = it % PER_LAYER;
        if (r < I_IN) { const int kb = r / 73, nb = r % 73;
            if (nb == 56) p0_transpose_item(P.in[8] + (size_t)l * D * INW, D, INW, (bf16_t*)(ws + WS_WGT) + (size_t)l * 32 * D, 64 * kb, 32 * nb, 0, scr, F.lane);
            else p0_transpose_item(P.in[8] + (size_t)l * D * INW, D, INW, (bf16_t*)(ws + WS_WIN) + (size_t)l * INP * D, 64 * kb, 32 * nb, nb < 56 ? 32 * nb : 32 * (nb - 1), scr, F.lane);
            continue; }
        r -= I_IN;
        if (r < I_OUT) { const int kb = r / 32, nb = r % 32;
            p0_transpose_item(P.in[18] + (size_t)l * D * D, D, D, (bf16_t*)(ws + WS_WOUT) + (size_t)l * D * D, 64 * kb, 32 * nb, 32 * nb, scr, F.lane); continue; }
        r -= I_OUT;
        if (r < NE * I_GU) { const int e = r / I_GU, q = r % I_GU, kb = q / 64, nb = q % 64; const int n0 = 32 * nb;
            const int j = n0 & 1023, orow = 256 * (j >> 7) + (n0 >= 1024 ? 128 : 0) + (j & 127);
            if (F8_LAYER[l]) p0_transpose_item8(P.in[21] + ((size_t)l * NE + e) * D * 2048, D, 2048, ws + WS_WGU + (size_t)l * NE * 2048 * D * 2 + (size_t)e * 2048 * D, 64 * kb, n0, orow, scr, F.lane);
            else p0_transpose_item(P.in[21] + ((size_t)l * NE + e) * D * 2048, D, 2048, (bf16_t*)(ws + WS_WGU) + ((size_t)l * NE + e) * 2048 * D, 64 * kb, n0, orow, scr, F.lane);
            continue; }
        r -= NE * I_GU;
        { const int e = r / I_DN, q = r % I_DN, kb = q / 32, nb = q % 32;
            if (F8_LAYER[l]) p0_transpose_item8(P.in[23] + ((size_t)l * NE + e) * DFF * D, DFF, D, ws + WS_WDN + (size_t)l * NE * D * DFF * 2 + (size_t)e * D * DFF, 64 * kb, 32 * nb, 32 * nb, scr, F.lane);
            else p0_transpose_item(P.in[23] + ((size_t)l * NE + e) * DFF * D, DFF, D, (bf16_t*)(ws + WS_WDN) + ((size_t)l * NE + e) * D * DFF, 64 * kb, 32 * nb, 32 * nb, scr, F.lane); }
    }
    {
        const int gt = F.bid * NTHREADS + F.tid, NGT = F.G * NTHREADS;
        bf16_t* cm3 = (bf16_t*)(ws + WS_CM3);
        for (int i = gt; i < 192 * 64; i += NGT) { const int m = i >> 6, n2 = i & 63, part = m >> 6, k2 = m & 63; const int ph = (k2 * n2) & 63;
            float s, c; sincospif((float)ph * (1.0f / 32.0f), &s, &c); const float v = part == 0 ? c : (part == 1 ? -s : -c); cm3[i] = (bf16_t)f2bf(v); }
        bf16_t* rwt = (bf16_t*)(ws + WS_RW);
        for (int i = gt; i < DEPTH * NE * D; i += NGT) { const int l = i / (NE * D), q = i % (NE * D), k = q >> 5, e = q & 31;
            const float w = P.in[19][(size_t)l * D * NE + q]; const unsigned hi = f2bf(w); const unsigned lo = f2bf(w - bf2f(hi));
            rwt[((size_t)l * 2 + 0) * NE * D + e * D + k] = (bf16_t)hi; rwt[((size_t)l * 2 + 1) * NE * D + e * D + k] = (bf16_t)lo; }
        bf16_t* tf2 = (bf16_t*)(ws + WS_TF2);
        for (int i = gt; i < 128 * 128; i += NGT) { const int c_ = i >> 7, n = i & 127; const int ph = (c_ * n) & 127;
            float s, c; sincospif((float)ph * (1.0f / 64.0f), &s, &c); tf2[i] = (bf16_t)f2bf(c); tf2[128 * 128 + i] = (bf16_t)f2bf(s); }
        bf16_t* tctx = (bf16_t*)(ws + WS_TCTX);
        for (int i = gt; i < 256 * 256; i += NGT) { const int k1 = i >> 8, n = i & 255; const int ph = (k1 * n) & 255;
            float s, c; sincospif((float)ph * (1.0f / 128.0f), &s, &c); tctx[i] = (bf16_t)f2bf(c); tctx[256 * 256 + i] = (bf16_t)f2bf(s); }
        bf16_t* tlat = (bf16_t*)(ws + WS_TLAT);
        for (int i = gt; i < 128 * 128 * 128; i += NGT) { const int nlo = i >> 14, d = (i >> 7) & 127, a = i & 127; const int ph = (d * (nlo + 128 * a)) & 16383;
            float s, c; sincospif((float)ph * (1.0f / 8192.0f), &s, &c);
            tlat[(size_t)nlo * 32768 + d * 128 + a] = (bf16_t)f2bf(c); tlat[(size_t)nlo * 32768 + 16384 + d * 128 + a] = (bf16_t)f2bf(s); }
    }
    for (int it = gw; it < DEPTH * 24 * 8; it += NGW) {
        const int l = it / 192, q = it % 192, cb = q >> 3, ks = q & 7;
        const float* wm = P.in[6] + (size_t)l * D * 6144 + (size_t)(ks * 128) * 6144 + cb * 256 + 4 * F.lane;
        f32x4 a0 = {0.f, 0.f, 0.f, 0.f}, a1 = a0, a2 = a0;
#pragma unroll 4
        for (int k = 0; k < 128; ++k) { const int kk = ks * 128 + k;
            const float c0 = P.in[1][kk], c1 = P.in[1][D + kk], c2 = P.in[3][kk];
            const float s0 = c0 * sigmoidf_(c0), s1 = c1 * sigmoidf_(c1), s2 = c2 * sigmoidf_(c2);
            const f32x4 w = *(const f32x4*)(wm + (size_t)k * 6144);
            a0 += w * s0; a1 += w * s1; a2 += w * s2; }
        float* mp = (float*)(ws + WS_MODP) + ((size_t)(l * 8 + ks) * 3) * 6144 + cb * 256 + 4 * F.lane;
        *(f32x4*)(mp) = a0; *(f32x4*)(mp + 6144) = a1; *(f32x4*)(mp + 2 * 6144) = a2;
    }
}

__device__ __forceinline__ f32x4 mod_from_partials(const Params& P, int l, int v, int c4) {
    f32x4 s = *(const f32x4*)(P.in[7] + (size_t)l * 6144 + c4);
    const float* mp = (const float*)(P.ws + WS_MODP) + ((size_t)(l * 8) * 3 + v) * 6144 + c4;
#pragma unroll
    for (int ks = 0; ks < 8; ++ks) s += *(const f32x4*)(mp + (size_t)ks * 3 * 6144);
    return s;
}

__device__ __forceinline__ void norm_row_store(const f32x4 (&x)[4], const float* g, const f32x4 (&shv)[4], const f32x4 (&scv)[4], bf16_t* orow, int lane) {
    float ss = 0.f;
#pragma unroll
    for (int j = 0; j < 4; ++j) ss += (x[j].x * x[j].x + x[j].y * x[j].y) + (x[j].z * x[j].z + x[j].w * x[j].w);
    const float rstd = 1.0f / sqrtf(wave_sum(ss) * (1.0f / D) + NORM_EPS);
#pragma unroll
    for (int j = 0; j < 4; ++j) { const int c = 4 * lane + 256 * j;
        const f32x4 gv = *(const f32x4*)(g + c);
        const f32x4 y = (x[j] * rstd) * gv * (scv[j] + 1.0f) + shv[j];
        u32x2 o; o.x = pk2(y.x, y.y); o.y = pk2(y.z, y.w);
        *(u32x2*)(orow + c) = o; }
}

__device__ __forceinline__ void phase_p1(const Frame& F, const Params& P) {
    unsigned char* ws = P.ws;
    const int gt = F.bid * NTHREADS + F.tid, NGT = F.G * NTHREADS;
    float* modf = (float*)(ws + WS_MODF);
    for (int i = gt; i < DEPTH * 3 * 1536; i += NGT) { const int l = i / 4608, q = i % 4608, v = q / 1536, c4 = (q % 1536) * 4;
        *(f32x4*)(modf + ((size_t)l * 3 + v) * 6144 + c4) = mod_from_partials(P, l, v, c4); }
    const int gw = F.bid * NWAVES + F.wave, NGW = F.G * NWAVES;
    bf16_t* hb = (bf16_t*)(ws + WS_HBUF);
    int cur_v = -1; f32x4 shv[4], scv[4], xn[4];
    auto rowp = [&](int m) { return (m < NLAT) ? (P.in[0] + (size_t)m * D) : (P.in[2] + (size_t)(m - NLAT) * D); };
    if (gw < NTOK) {
#pragma unroll
        for (int j = 0; j < 4; ++j) xn[j] = *(const f32x4*)(rowp(gw) + 4 * F.lane + 256 * j); }
    for (int m = gw; m < NTOK; m += NGW) {
        const int v = (m >= NLAT) ? 2 : (m >= SEQ ? 1 : 0);
        f32x4 x[4];
#pragma unroll
        for (int j = 0; j < 4; ++j) x[j] = xn[j];
        if (m + NGW < NTOK) {
#pragma unroll
            for (int j = 0; j < 4; ++j) xn[j] = *(const f32x4*)(rowp(m + NGW) + 4 * F.lane + 256 * j); }
        if (v != cur_v) { cur_v = v;
#pragma unroll
            for (int j = 0; j < 4; ++j) { const int c = 4 * F.lane + 256 * j; shv[j] = mod_from_partials(P, 0, v, c); scv[j] = mod_from_partials(P, 0, v, 1024 + c); } }
        norm_row_store(x, P.in[4], shv, scv, hb + (size_t)m * D, F.lane);
    }
}

constexpr int GL_GT = 0;
constexpr int GL_A1 = 34816, GL_KE = 60416, GL_VTB = 78848, GL_RS = 97280, GL_RT = 97792;
constexpr int GL_KDT = 34816, GL_VT = 53248;

__device__ __forceinline__ float logsigmoidf_(float x) { return fminf(x, 0.f) - __logf(1.0f + __expf(-fabsf(x))); }
__device__ __forceinline__ float bfel(const u32x4& v, int j) { const unsigned w = (j < 2) ? v.x : (j < 4 ? v.y : (j < 6 ? v.z : v.w)); return (j & 1) ? bfhi(w) : bflo(w); }
__device__ __forceinline__ unsigned short bfraw(const u32x4& v, int j) { const unsigned w = (j < 2) ? v.x : (j < 4 ? v.y : (j < 6 ? v.z : v.w)); return (unsigned short)((j & 1) ? (w >> 16) : (w & 0xffffu)); }

struct GateRegs { bf16x8 a[4]; bf16x8 b; float bg; };
__device__ __forceinline__ GateRegs gla_load_gate_regs(const Frame& F, const Params& P, int l, int row0, int h) {
    GateRegs g;
    const int dir = F.wave >> 2, dbase = (F.wave & 3) * 16, fr = F.lane & 15, fq = F.lane >> 4;
    const bf16x8 z8 = {0, 0, 0, 0, 0, 0, 0, 0};
    const bf16_t* lrb = (const bf16_t*)(P.ws + WS_LRB);
#pragma unroll
    for (int mt = 0; mt < 4; ++mt) g.a[mt] = (fq < 2) ? *(const bf16x8*)(lrb + (size_t)(row0 + mt * 16 + fr) * 32 + dir * 16 + fq * 8) : z8;
    const float* wgp = (dir ? P.in[11] : P.in[9]) + (size_t)l * 16 * 256 + 64 * h + dbase + fr;
    g.b = z8;
    if (fq < 2) {
#pragma unroll
        for (int j = 0; j < 8; ++j) g.b[j] = (short)f2bf(wgp[(fq * 8 + j) * 256]); }
    g.bg = (dir ? P.in[12] : P.in[10])[(size_t)l * 256 + 64 * h + dbase + fr];
    return g;
}
__device__ __forceinline__ void gla_gates(const Frame& F, const GateRegs& gr) {
    LAS float* GT = (LAS float*)(F.lds + GL_GT);
    const int dir = F.wave >> 2, dbase = (F.wave & 3) * 16, lane = F.lane, fr = lane & 15, fq = lane >> 4;
    float p[4][4]; float T[4];
#pragma unroll
    for (int mt = 0; mt < 4; ++mt) { const f32x4 acc = __builtin_amdgcn_mfma_f32_16x16x32_bf16(gr.a[mt], gr.b, (f32x4){0.f, 0.f, 0.f, 0.f}, 0, 0, 0);
#pragma unroll
        for (int j = 0; j < 4; ++j) p[mt][j] = logsigmoidf_(acc[j] + gr.bg) * (1.0f / 16.0f); }
    if (dir == 0) {
#pragma unroll
        for (int mt = 0; mt < 4; ++mt) { p[mt][1] += p[mt][0]; p[mt][2] += p[mt][1]; p[mt][3] += p[mt][2]; T[mt] = p[mt][3]; }
        float base = 0.f;
#pragma unroll
        for (int mt = 0; mt < 4; ++mt) { float inc = T[mt]; float v = __shfl_up(inc, 16); inc += (fq >= 1) ? v : 0.f; v = __shfl_up(inc, 32); inc += (fq >= 2) ? v : 0.f;
            const float off = base + (inc - T[mt]); const float ct = __shfl(inc, 48 + fr);
#pragma unroll
            for (int j = 0; j < 4; ++j) GT[(dbase + fr) * 65 + mt * 16 + fq * 4 + j] = off + p[mt][j];
            base += ct; }
    } else {
#pragma unroll
        for (int mt = 0; mt < 4; ++mt) { p[mt][2] += p[mt][3]; p[mt][1] += p[mt][2]; p[mt][0] += p[mt][1]; T[mt] = p[mt][0]; }
        float base = 0.f;
#pragma unroll
        for (int mt = 3; mt >= 0; --mt) { float inc = T[mt]; float v = __shfl_down(inc, 16); inc += (fq <= 2) ? v : 0.f; v = __shfl_down(inc, 32); inc += (fq <= 1) ? v : 0.f;
            const float off = base + (inc - T[mt]); const float ct = __shfl(inc, fr);
#pragma unroll
            for (int j = 0; j < 4; ++j) GT[(64 + dbase + fr) * 65 + mt * 16 + fq * 4 + j] = off + p[mt][j];
            base += ct; }
    }
}

__device__ __forceinline__ void gla_g1_unit(const Frame& F, const Params& P, int l, int row0, int h, int unit) {
    const bf16_t* pb = (const bf16_t*)(P.ws + WS_PBUF);
    const int tid = F.tid, row = F.lane, c8 = F.wave * 8;
    const GateRegs gr = gla_load_gate_regs(F, P, l, row0, h);
    const u32x4 kv = *(const u32x4*)(pb + (size_t)(row0 + row) * INP + C_K + 64 * h + c8);
    u32x4 vv[2];
#pragma unroll
    for (int i = 0; i < 2; ++i) { const int vr = F.lane, vc = (F.wave + 8 * i) * 8; vv[i] = *(const u32x4*)(pb + (size_t)(row0 + vr) * INP + C_V + 128 * h + vc); }
    gla_gates(F, gr);
    __syncthreads();
    LAS float* GT = (LAS float*)(F.lds + GL_GT);
    LAS bf16_t* KDT = (LAS bf16_t*)(F.lds + GL_KDT); LAS bf16_t* VT = (LAS bf16_t*)(F.lds + GL_VT);
#pragma unroll
    for (int j = 0; j < 8; ++j) { const int d = c8 + j; const float k_ = bfel(kv, j);
        KDT[d * 72 + row] = (bf16_t)f2bf(k_ * __expf(GT[d * 65 + 63] - GT[d * 65 + row])); KDT[(64 + d) * 72 + row] = (bf16_t)f2bf(k_ * __expf(GT[(64 + d) * 65] - GT[(64 + d) * 65 + row])); }
#pragma unroll
    for (int i = 0; i < 2; ++i) { const int vr = F.lane, vc = (F.wave + 8 * i) * 8;
#pragma unroll
        for (int j = 0; j < 8; ++j) VT[(vc + j) * 72 + vr] = bfraw(vv[i], j); }
    if (tid < 128) ((float*)(P.ws + WS_DECAY))[(size_t)unit * 128 + tid] = __expf(tid < 64 ? GT[tid * 65 + 63] : GT[tid * 65]);
    __syncthreads();
    const int fr = F.lane & 15, fq = F.lane >> 4, w = F.wave;
    f32x4 acc[1][8]; zero_acc<1, 8>(acc);
    mma_nt<1, 8>(acc, KDT + (16 * w) * 72, 72, VT, 72, 64, fr, fq);
    bf16_t* st = (bf16_t*)(P.ws + WS_STATE) + (size_t)unit * 16384;
#pragma unroll
    for (int nt = 0; nt < 8; ++nt) { u32x2 o; o.x = pk2(acc[0][nt][0], acc[0][nt][1]); o.y = pk2(acc[0][nt][2], acc[0][nt][3]); *(u32x2*)(st + (nt * 16 + fr) * 128 + 16 * w + fq * 4) = o; }
}

__device__ __forceinline__ void gla_scan(const Frame& F, const Params& P) {
    unsigned* stt = (unsigned*)(P.ws + WS_STATE); const float* dec = (const float*)(P.ws + WS_DECAY);
    if (F.tid >= 256) return;
    for (int gid = F.bid * 256 + F.tid; gid < 8 * 128 * 64; gid += F.G * 256) {
        const int dp = gid & 63, e = (gid >> 6) & 127, bh = gid >> 13, dir = dp >> 5;
        const int latb = bh * 256, ctxb = 2048 + bh * 4;
        auto unit_of = [&](int p) { return dir == 0 ? (p < 4 ? ctxb + p : latb + (p - 4)) : (p < 4 ? ctxb + 3 - p : latb + 255 - (p - 4)); };
        float s0 = 0.f, s1 = 0.f;
        unsigned dA[10], dB[10]; f32x2 cA[10], cB[10];
#pragma unroll
        for (int i = 0; i < 10; ++i) { const int u = unit_of(i); dA[i] = stt[((size_t)u * 128 + e) * 64 + dp]; cA[i] = *(const f32x2*)(dec + (size_t)u * 128 + 2 * dp); }
        for (int p0 = 0; p0 < 260; p0 += 20) {
#pragma unroll
            for (int i = 0; i < 10; ++i) { const int u = unit_of(p0 + 10 + i); dB[i] = stt[((size_t)u * 128 + e) * 64 + dp]; cB[i] = *(const f32x2*)(dec + (size_t)u * 128 + 2 * dp); }
#pragma unroll
            for (int i = 0; i < 10; ++i) { const int u = unit_of(p0 + i); stt[((size_t)u * 128 + e) * 64 + dp] = pk2(s0, s1); s0 = cA[i].x * s0 + bflo(dA[i]); s1 = cA[i].y * s1 + bfhi(dA[i]); }
            if (p0 + 20 < 260) {
#pragma unroll
                for (int i = 0; i < 10; ++i) { const int u = unit_of(p0 + 20 + i); dA[i] = stt[((size_t)u * 128 + e) * 64 + dp]; cA[i] = *(const f32x2*)(dec + (size_t)u * 128 + 2 * dp); } }
#pragma unroll
            for (int i = 0; i < 10; ++i) { const int u = unit_of(p0 + 10 + i); stt[((size_t)u * 128 + e) * 64 + dp] = pk2(s0, s1); s0 = cB[i].x * s0 + bflo(dB[i]); s1 = cB[i].y * s1 + bfhi(dB[i]); }
        }
    }
}

__device__ __forceinline__ void gla_g3_unit(const Frame& F, const Params& P, int l, int row0, int h, int unit) {
    const bf16_t* pb = (const bf16_t*)(P.ws + WS_PBUF);
    const int tid = F.tid, fr = F.lane & 15, fq = F.lane >> 4, w = F.wave, row = F.lane, c8 = F.wave * 8;
    const GateRegs gr = gla_load_gate_regs(F, P, l, row0, h);
    const u32x4 qv = *(const u32x4*)(pb + (size_t)(row0 + row) * INP + C_Q + 64 * h + c8), kv = *(const u32x4*)(pb + (size_t)(row0 + row) * INP + C_K + 64 * h + c8);
    u32x4 vv[2], rv[2], stv[4];
#pragma unroll
    for (int i = 0; i < 2; ++i) { const int vr = F.lane, vc = (F.wave + 8 * i) * 8; const bf16_t* rp = pb + (size_t)(row0 + vr) * INP + 128 * h + vc; vv[i] = *(const u32x4*)(rp + C_V); rv[i] = *(const u32x4*)(rp + C_R); }
    { const bf16_t* st = (const bf16_t*)(P.ws + WS_STATE) + (size_t)unit * 16384;
#pragma unroll
      for (int i = 0; i < 4; ++i) stv[i] = *(const u32x4*)(st + (i * 512 + tid) * 8); }
    const float* ng = P.in[13] + (size_t)l * 128;
    float ngv[4];
#pragma unroll
    for (int nt = 0; nt < 4; ++nt) ngv[nt] = ng[(w >> 2) * 64 + nt * 16 + fr];
    gla_gates(F, gr);
    __syncthreads();
    LAS float* GT = (LAS float*)(F.lds + GL_GT);
    LAS bf16_t* A1 = (LAS bf16_t*)(F.lds + GL_A1); LAS bf16_t* KE = (LAS bf16_t*)(F.lds + GL_KE); LAS bf16_t* VTb = (LAS bf16_t*)(F.lds + GL_VTB); LAS bf16_t* STb = (LAS bf16_t*)(F.lds + GL_GT);
    LAS float* RS = (LAS float*)(F.lds + GL_RS); LAS bf16_t* RT = (LAS bf16_t*)(F.lds + GL_RT);
    { float qf[8], qb[8], kf[8], kb[8];
#pragma unroll
      for (int j = 0; j < 8; ++j) { const float q_ = bfel(qv, j) * 0.125f, k_ = bfel(kv, j); const float bf_ = GT[(c8 + j) * 65 + row], bb_ = GT[(64 + c8 + j) * 65 + row];
          qf[j] = q_ * __expf(bf_); qb[j] = q_ * __expf(bb_); kf[j] = k_ * __expf(-bf_); kb[j] = k_ * __expf(-bb_); }
      *(LAS u32x4*)(A1 + row * 200 + 64 + c8) = (u32x4){pk2(qf[0], qf[1]), pk2(qf[2], qf[3]), pk2(qf[4], qf[5]), pk2(qf[6], qf[7])};
      *(LAS u32x4*)(A1 + row * 200 + 128 + c8) = (u32x4){pk2(qb[0], qb[1]), pk2(qb[2], qb[3]), pk2(qb[4], qb[5]), pk2(qb[6], qb[7])};
      *(LAS u32x4*)(KE + row * 72 + c8) = (u32x4){pk2(kf[0], kf[1]), pk2(kf[2], kf[3]), pk2(kf[4], kf[5]), pk2(kf[6], kf[7])};
      *(LAS u32x4*)(KE + 4608 + row * 72 + c8) = (u32x4){pk2(kb[0], kb[1]), pk2(kb[2], kb[3]), pk2(kb[4], kb[5]), pk2(kb[6], kb[7])}; }
#pragma unroll
    for (int i = 0; i < 2; ++i) { const int vr = F.lane, vc = (F.wave + 8 * i) * 8; *(LAS u32x4*)(RT + vr * 136 + vc) = rv[i];
#pragma unroll
        for (int j = 0; j < 8; ++j) VTb[(vc + j) * 72 + vr] = bfraw(vv[i], j); }
    __syncthreads();
    {
        const int mt = w & 3, ntp = w >> 2;
        f32x4 af[1][2], ab[1][2]; zero_acc<1, 2>(af); zero_acc<1, 2>(ab);
        mma_nt<1, 2>(af, A1 + (16 * mt) * 200 + 64, 200, KE + (32 * ntp) * 72, 72, 64, fr, fq);
        mma_nt<1, 2>(ab, A1 + (16 * mt) * 200 + 128, 200, KE + 4608 + (32 * ntp) * 72, 72, 64, fr, fq);
#pragma unroll
        for (int i = 0; i < 4; ++i) { const int idx = (i * 512 + tid) * 8, e = idx >> 7, dd = idx & 127; *(LAS u32x4*)(STb + e * 136 + dd) = stv[i]; }
#pragma unroll
        for (int nt = 0; nt < 2; ++nt)
#pragma unroll
            for (int j = 0; j < 4; ++j) { const int i = 16 * mt + fq * 4 + j, jj = (2 * ntp + nt) * 16 + fr;
                const float p = (jj <= i ? af[0][nt][j] : 0.f) + (jj >= i ? ab[0][nt][j] : 0.f); A1[i * 200 + jj] = (bf16_t)f2bf(p); }
    }
    __syncthreads();
    {
        const int mt = w & 3, nh = w >> 2;
        f32x4 acc[1][4]; zero_acc<1, 4>(acc);
        mma_nt<1, 4>(acc, A1 + (16 * mt) * 200, 200, VTb + (64 * nh) * 72, 72, 64, fr, fq);
        mma_nt<1, 4>(acc, A1 + (16 * mt) * 200 + 64, 200, STb + (64 * nh) * 136, 136, 128, fr, fq);
        float ss[4];
#pragma unroll
        for (int j = 0; j < 4; ++j) { float s = 0.f;
#pragma unroll
            for (int nt = 0; nt < 4; ++nt) s += acc[0][nt][j] * acc[0][nt][j];
            s += __shfl_xor(s, 1); s += __shfl_xor(s, 2); s += __shfl_xor(s, 4); s += __shfl_xor(s, 8); ss[j] = s; }
        if (fr == 0) {
#pragma unroll
            for (int j = 0; j < 4; ++j) RS[nh * 64 + 16 * mt + fq * 4 + j] = ss[j]; }
        __syncthreads();
        bf16_t* cat = (bf16_t*)(P.ws + WS_CAT);
#pragma unroll
        for (int j = 0; j < 4; ++j) { const int i = 16 * mt + fq * 4 + j; const float rinv = 1.0f / sqrtf((RS[i] + RS[64 + i]) * (1.0f / 128.0f) + NORM_EPS);
#pragma unroll
            for (int nt = 0; nt < 4; ++nt) { const int e = nh * 64 + nt * 16 + fr; const float r_ = bf2f(RT[i * 136 + e]);
                const float o = acc[0][nt][j] * rinv * ngv[nt] * (r_ * sigmoidf_(r_)); cat[(size_t)(row0 + i) * D + 256 + 128 * h + e] = (bf16_t)f2bf(o); } }
    }
}

__device__ __forceinline__ void conv_unit(const Frame& F, const Params& P, int l, int rowbase, int Ls, int t0) {
    const bf16_t* pb = (const bf16_t*)(P.ws + WS_PBUF);
    LAS bf16_t* Y = (LAS bf16_t*)(F.lds);
    LAS float* Z = (LAS float*)(F.lds + 49152);
    const int tid = F.tid;
    {
        u32x4 av[6], gv[6];
#pragma unroll
        for (int i = 0; i < 6; ++i) { const int ch = tid + 512 * i, r = ch >> 5, cc = (ch & 31) * 8, t = t0 - 15 + r;
            av[i] = (u32x4){0u, 0u, 0u, 0u}; gv[i] = av[i];
            if (ch < 94 * 32 && t >= 0 && t < Ls) { const size_t rb = (size_t)(rowbase + t) * INP; av[i] = *(const u32x4*)(pb + rb + C_CA + cc); gv[i] = *(const u32x4*)(pb + rb + C_CG + cc); } }
#pragma unroll
        for (int i = 0; i < 6; ++i) { const int ch = tid + 512 * i, r = ch >> 5, cc = (ch & 31) * 8; const u32x4 a = av[i], g = gv[i]; u32x4 o;
            o.x = pk2(bflo(a.x) * sigmoidf_(bflo(g.x)), bfhi(a.x) * sigmoidf_(bfhi(g.x))); o.y = pk2(bflo(a.y) * sigmoidf_(bflo(g.y)), bfhi(a.y) * sigmoidf_(bfhi(g.y)));
            o.z = pk2(bflo(a.z) * sigmoidf_(bflo(g.z)), bfhi(a.z) * sigmoidf_(bfhi(g.z))); o.w = pk2(bflo(a.w) * sigmoidf_(bflo(g.w)), bfhi(a.w) * sigmoidf_(bfhi(g.w)));
            if (ch < 94 * 32) *(LAS u32x4*)(Y + r * 256 + cc) = o; }
    }
    const int c2 = (tid & 127) * 2, qtr = tid >> 7; const float* cw = P.in[14] + (size_t)l * 31 * 256 + c2; const f32x2 cb = *(const f32x2*)(P.in[15] + (size_t)l * 256 + c2);
    f32x2 wv[31];
#pragma unroll
    for (int j = 0; j < 31; ++j) wv[j] = *(const f32x2*)(cw + j * 256);
    const f32x4 lng = *(const f32x4*)(P.in[16] + (size_t)l * 256 + 4 * F.lane), lnb = *(const f32x4*)(P.in[17] + (size_t)l * 256 + 4 * F.lane);
    __syncthreads();
#pragma unroll 1
    for (int hp = 0; hp < 2; ++hp) { f32x2 yv[38]; const int rb = qtr * 16 + hp * 8;
#pragma unroll
      for (int r = 0; r < 38; ++r) { const unsigned wd = *(const LAS unsigned*)(Y + (rb + r) * 256 + c2); yv[r] = (f32x2){bflo(wd), bfhi(wd)}; }
#pragma unroll
      for (int tt = 0; tt < 8; ++tt) { f32x2 z = cb;
#pragma unroll
          for (int j = 0; j < 31; ++j) z += wv[j] * yv[tt + j];
          *(LAS f32x2*)(Z + (rb + tt) * 256 + c2) = z; } }
    __syncthreads();
    { bf16_t* cat = (bf16_t*)(P.ws + WS_CAT);
#pragma unroll 2
      for (int i = 0; i < 8; ++i) { const int t = F.wave * 8 + i; const f32x4 z = *(const LAS f32x4*)(Z + t * 256 + 4 * F.lane);
          const float mean = wave_sum((z.x + z.y) + (z.z + z.w)) * (1.0f / 256.0f); const f32x4 zc = z - mean;
          const float var = wave_sum((zc.x * zc.x + zc.y * zc.y) + (zc.z * zc.z + zc.w * zc.w)) * (1.0f / 256.0f); const float rstd = 1.0f / sqrtf(var + NORM_EPS);
          const f32x4 y = zc * rstd * lng + lnb; u32x2 o; o.x = pk2(y.x * sigmoidf_(y.x), y.y * sigmoidf_(y.y)); o.y = pk2(y.z * sigmoidf_(y.z), y.w * sigmoidf_(y.w));
          *(u32x2*)(cat + (size_t)(rowbase + t0 + t) * D + 768 + 4 * F.lane) = o; } }
    __syncthreads();
}

template <int R, int NP>
__device__ __forceinline__ void fourier_f1_unit(const Frame& F, const Params& P, int rowbase, int rstride, int h, const bf16_t* tab, int orow0, float oscale) {
    const bf16_t* pb = (const bf16_t*)(P.ws + WS_PBUF); const bf16_t* cm3 = (const bf16_t*)(P.ws + WS_CM3);
    constexpr int LZ = R + 8, MT0 = 4 * NP, NTW = R / 128, MTW = R / 128;
    LAS bf16_t* U = (LAS bf16_t*)(F.lds); LAS bf16_t* CM = U + R * 72; LAS bf16_t* ZT = CM + 64 * NP * 72;
    const int tid = F.tid, fr = F.lane & 15, fq = F.lane >> 4, w = F.wave;
    bf16x8 tcp[4], tsp[4];
    if constexpr (R == 128) {
#pragma unroll
        for (int k = 0; k < 4; ++k) { tcp[k] = *(const bf16x8*)(tab + (size_t)(w * 16 + fr) * R + k * 32 + fq * 8); tsp[k] = *(const bf16x8*)(tab + (size_t)R * R + (size_t)(w * 16 + fr) * R + k * 32 + fq * 8); } }
    { constexpr int NU = R * 8 / NTHREADS, NC = (64 * NP * 8 + NTHREADS - 1) / NTHREADS; u32x4 uv[NU], cv[NC];
#pragma unroll
      for (int i = 0; i < NU; ++i) { const int ch = tid + NTHREADS * i, a = ch >> 3, c8 = (ch & 7) * 8; uv[i] = *(const u32x4*)(pb + (size_t)(rowbase + a * rstride) * INP + C_FOUR + 64 * h + c8); }
#pragma unroll
      for (int i = 0; i < NC; ++i) { const int ch = tid + NTHREADS * i, m = ch >> 3, c8 = (ch & 7) * 8; cv[i] = (ch < 64 * NP * 8) ? *(const u32x4*)(cm3 + m * 64 + c8) : (u32x4){0u, 0u, 0u, 0u}; }
#pragma unroll
      for (int i = 0; i < NU; ++i) { const int ch = tid + NTHREADS * i, a = ch >> 3, c8 = (ch & 7) * 8; *(LAS u32x4*)(U + a * 72 + c8) = uv[i]; }
#pragma unroll
      for (int i = 0; i < NC; ++i) { const int ch = tid + NTHREADS * i, m = ch >> 3, c8 = (ch & 7) * 8; if (ch < 64 * NP * 8) *(LAS u32x4*)(CM + m * 72 + c8) = cv[i]; } }
    __syncthreads();
    {
        f32x4 acc[MT0][NTW]; zero_acc<MT0, NTW>(acc);
        mma_nt<MT0, NTW>(acc, CM, 72, U + (w * NTW * 16) * 72, 72, 64, fr, fq);
#pragma unroll
        for (int mt = 0; mt < MT0; ++mt)
#pragma unroll
            for (int nt = 0; nt < NTW; ++nt)
#pragma unroll
                for (int j = 0; j < 4; ++j) ZT[(mt * 16 + fq * 4 + j) * LZ + (w * NTW + nt) * 16 + fr] = (bf16_t)f2bf(acc[mt][nt][j]);
    }
    __syncthreads();
    {
        f32x4 are[MTW][4], aim[MTW][4]; zero_acc<MTW, 4>(are); zero_acc<MTW, 4>(aim);
        const int m0 = w * MTW * 16;
#pragma unroll
        for (int k0 = 0; k0 < R; k0 += 32) {
            bf16x8 tc[MTW], ts[MTW];
#pragma unroll
            for (int mi = 0; mi < MTW; ++mi) { if constexpr (R == 128) { tc[mi] = tcp[k0 / 32]; ts[mi] = tsp[k0 / 32]; } else { tc[mi] = *(const bf16x8*)(tab + (size_t)(m0 + mi * 16 + fr) * R + k0 + fq * 8); ts[mi] = *(const bf16x8*)(tab + (size_t)R * R + (size_t)(m0 + mi * 16 + fr) * R + k0 + fq * 8); } }
#pragma unroll
            for (int nt = 0; nt < 4; ++nt) {
                const bf16x8 zr = *(const LAS bf16x8*)(ZT + (nt * 16 + fr) * LZ + k0 + fq * 8), zi = *(const LAS bf16x8*)(ZT + (64 + nt * 16 + fr) * LZ + k0 + fq * 8);
#pragma unroll
                for (int mi = 0; mi < MTW; ++mi) { are[mi][nt] = __builtin_amdgcn_mfma_f32_16x16x32_bf16(tc[mi], zr, are[mi][nt], 0, 0, 0); are[mi][nt] = __builtin_amdgcn_mfma_f32_16x16x32_bf16(ts[mi], zi, are[mi][nt], 0, 0, 0); }
                if constexpr (NP == 3) { const bf16x8 nzr = *(const LAS bf16x8*)(ZT + (128 + nt * 16 + fr) * LZ + k0 + fq * 8);
#pragma unroll
                    for (int mi = 0; mi < MTW; ++mi) { aim[mi][nt] = __builtin_amdgcn_mfma_f32_16x16x32_bf16(tc[mi], zi, aim[mi][nt], 0, 0, 0); aim[mi][nt] = __builtin_amdgcn_mfma_f32_16x16x32_bf16(ts[mi], nzr, aim[mi][nt], 0, 0, 0); } }
            }
        }
#pragma unroll
        for (int mi = 0; mi < MTW; ++mi)
#pragma unroll
            for (int nt = 0; nt < 4; ++nt)
#pragma unroll
                for (int j = 0; j < 4; ++j) { const int m = m0 + mi * 16 + fq * 4 + j, k2 = nt * 16 + fr;
                    if constexpr (NP == 3) { unsigned* t2 = (unsigned*)(P.ws + WS_T2); t2[(size_t)(orow0 + 128 * m) * 256 + h * 64 + k2] = pk2(are[mi][nt][j], aim[mi][nt][j]); }
                    else { bf16_t* cat = (bf16_t*)(P.ws + WS_CAT); cat[(size_t)(orow0 + m) * D + h * 64 + k2] = (bf16_t)f2bf(are[mi][nt][j] * oscale); } }
    }
    __syncthreads();
}

constexpr int F2_X = 0, F2_T = 67584;
__device__ __forceinline__ void fourier_f2_tables(const Frame& F, const Params& P) {
    const bf16_t* tf2 = (const bf16_t*)(P.ws + WS_TF2); LAS bf16_t* T = (LAS bf16_t*)(F.lds + F2_T);
#pragma unroll
    for (int i = 0; i < 8; ++i) { const int ch = F.tid + 512 * i, r = ch >> 4, c8 = (ch & 15) * 8; *(LAS u32x4*)(T + r * 136 + c8) = *(const u32x4*)(tf2 + r * 128 + c8); }
    __syncthreads();
}
__device__ __forceinline__ void fourier_f2_unit(const Frame& F, const Params& P, int b, int d, int hp) {
    const bf16_t* t2 = (const bf16_t*)(P.ws + WS_T2);
    LAS bf16_t* X = (LAS bf16_t*)(F.lds + F2_X); const LAS bf16_t* T = (const LAS bf16_t*)(F.lds + F2_T);
    const int tid = F.tid, fr = F.lane & 15, fq = F.lane >> 4, w = F.wave;
    { u32x4 xv[8];
#pragma unroll
      for (int i = 0; i < 8; ++i) { const int ch = tid + 512 * i, n = ch >> 5, c8 = (ch & 31) * 8; xv[i] = *(const u32x4*)(t2 + (size_t)(b * SEQ + 128 * d + n) * 512 + hp * 256 + c8); }
#pragma unroll
      for (int i = 0; i < 8; ++i) { const int ch = tid + 512 * i, n = ch >> 5, c8 = (ch & 31) * 8; *(LAS u32x4*)(X + n * 264 + c8) = xv[i]; } }
    __syncthreads();
    f32x4 acc[8];
#pragma unroll
    for (int mt = 0; mt < 8; ++mt) acc[mt] = (f32x4){0.f, 0.f, 0.f, 0.f};
#pragma unroll
    for (int k0 = 0; k0 < 128; k0 += 32) {
        bf16x8 xr, xi;
#pragma unroll
        for (int jj = 0; jj < 8; ++jj) { const unsigned wd = *(const LAS unsigned*)(X + (k0 + fq * 8 + jj) * 264 + 2 * (w * 16 + fr)); xr[jj] = (short)(wd & 0xffffu); xi[jj] = (short)(wd >> 16); }
#pragma unroll
        for (int mt = 0; mt < 8; ++mt) { const bf16x8 tc = *(const LAS bf16x8*)(T + (mt * 16 + fr) * 136 + k0 + fq * 8), ts = *(const LAS bf16x8*)(T + (128 + mt * 16 + fr) * 136 + k0 + fq * 8);
            acc[mt] = __builtin_amdgcn_mfma_f32_16x16x32_bf16(tc, xr, acc[mt], 0, 0, 0); acc[mt] = __builtin_amdgcn_mfma_f32_16x16x32_bf16(ts, xi, acc[mt], 0, 0, 0); }
    }
    bf16_t* cat = (bf16_t*)(P.ws + WS_CAT);
#pragma unroll
    for (int mt = 0; mt < 8; ++mt)
#pragma unroll
        for (int j = 0; j < 4; ++j) { const int c = mt * 16 + fq * 4 + j; cat[(size_t)(b * SEQ + 128 * c + d) * D + hp * 128 + w * 16 + fr] = (bf16_t)f2bf(acc[mt][j] * (1.0f / 1024.0f)); }
    __syncthreads();
}

constexpr int AX_LCNT = AUX_OFF, AX_GBASE = AUX_OFF + 128, AX_LE = AUX_OFF + 256, AX_LP = AUX_OFF + 256 + 2560;
constexpr int LC_BAR = LCTL_OFF, LC_TS = LCTL_OFF + 64;

constexpr int RT_GS = 0, RT_SSQ = 24576, RT_AT = 25600, RT_PL = 95232;
__device__ __forceinline__ void phase_route(const Frame& F, const Params& P, int l, int ntok) {
    unsigned char* ws = P.ws;
    LAS float* GS = (LAS float*)(F.lds + RT_GS); LAS float* SSQ = (LAS float*)(F.lds + RT_SSQ); LAS float* PL = (LAS float*)(F.lds + RT_PL);
    volatile LAS int* lcnt = (volatile LAS int*)(F.lds + AX_LCNT); volatile LAS int* gbase = (volatile LAS int*)(F.lds + AX_GBASE);
    volatile LAS int* LE = (volatile LAS int*)(F.lds + AX_LE); volatile LAS int* LP = (volatile LAS int*)(F.lds + AX_LP);
    const int tid = F.tid, lane = F.lane, w = F.wave, fr = lane & 15, fq = lane >> 4, ts = lane >> 2, kq = lane & 3, kbase = 128 * w + 32 * kq;
    LAS bf16_t* AT = (LAS bf16_t*)(F.lds + RT_AT) + w * (2 * 16 * 136);
    const int tpb = (ntok + F.G - 1) / F.G, tb = F.bid * tpb, te = (tb + tpb < ntok) ? tb + tpb : ntok, ntile = (te - tb + 15) >> 4;
    { const float* g2 = P.in[5] + (size_t)l * D;
      for (int i = tid; i < 3 * 1024; i += NTHREADS) { const int v = i >> 10, k = i & 1023; const float* mf = (const float*)(ws + WS_MODF) + ((size_t)l * 3 + v) * 6144;
          GS[(v * 2 + 0) * 1024 + k] = g2[k] * (1.0f + mf[4 * 1024 + k]); GS[(v * 2 + 1) * 1024 + k] = mf[3 * 1024 + k]; } }
    if (tid < 32) lcnt[tid] = 0;
    bf16x8 bh[4][2], bl[4][2];
    { const bf16_t* rwh = (const bf16_t*)(ws + WS_RW) + (size_t)l * 2 * NE * D; const bf16_t* rwl = rwh + NE * D;
#pragma unroll
      for (int sk = 0; sk < 4; ++sk)
#pragma unroll
          for (int nt = 0; nt < 2; ++nt) { const int off = (nt * 16 + fr) * D + 128 * w + 32 * sk + 8 * fq; bh[sk][nt] = *(const bf16x8*)(rwh + off); bl[sk][nt] = *(const bf16x8*)(rwl + off); } }
    const float* xres = (const float*)(ws + WS_XRES); bf16_t* hb = (bf16_t*)(ws + WS_HBUF);
    const float rbias = P.in[20][(size_t)l * NE + (lane & 31)];
    float* aprob = (float*)(ws + WS_APROB);
    f32x4 xn[8];
    { const int m = tb + ts;
#pragma unroll
      for (int j = 0; j < 8; ++j) xn[j] = (m < te) ? *(const f32x4*)(xres + (size_t)m * D + kbase + 4 * j) : (f32x4){0.f, 0.f, 0.f, 0.f}; }
    __syncthreads();
    for (int it = 0; it < ntile; ++it) {
        const int buf = it & 1; const int m = tb + 16 * it + ts; const bool valid = m < te; const int v = (m >= NLAT) ? 2 : (m >= SEQ ? 1 : 0);
        f32x4 x[8]; float ss = 0.f;
#pragma unroll
        for (int j = 0; j < 8; ++j) { x[j] = xn[j]; ss += (x[j].x * x[j].x + x[j].y * x[j].y) + (x[j].z * x[j].z + x[j].w * x[j].w); }
        if (it + 1 < ntile) { const int mn = m + 16;
#pragma unroll
            for (int j = 0; j < 8; ++j) xn[j] = (mn < te) ? *(const f32x4*)(xres + (size_t)mn * D + kbase + 4 * j) : (f32x4){0.f, 0.f, 0.f, 0.f}; }
        ss += __shfl_xor(ss, 1); ss += __shfl_xor(ss, 2);
        if (kq == 0) SSQ[(buf * 8 + w) * 16 + ts] = ss;
        __syncthreads();
        float tot = 0.f;
#pragma unroll
        for (int q = 0; q < 8; ++q) tot += SSQ[(buf * 8 + q) * 16 + ts];
        const float rstd = 1.0f / sqrtf(tot * (1.0f / D) + NORM_EPS);
        {
            unsigned hw[16], lw[16];
#pragma unroll
            for (int j = 0; j < 8; ++j) { const f32x4 gs = *(const LAS f32x4*)(GS + (v * 2 + 0) * 1024 + kbase + 4 * j), sh = *(const LAS f32x4*)(GS + (v * 2 + 1) * 1024 + kbase + 4 * j);
                const f32x4 h = (x[j] * rstd) * gs + sh;
                const unsigned h0 = f2bf(h.x), h1 = f2bf(h.y), h2 = f2bf(h.z), h3 = f2bf(h.w);
                hw[2 * j] = h0 | (h1 << 16); hw[2 * j + 1] = h2 | (h3 << 16);
                lw[2 * j] = pk2(h.x - bf2f(h0), h.y - bf2f(h1)); lw[2 * j + 1] = pk2(h.z - bf2f(h2), h.w - bf2f(h3)); }
            if (valid) {
                if (F8_LAYER[l]) { unsigned char* hb8 = ws + WS_HB8 + (size_t)m * D + kbase;
#pragma unroll
                    for (int c = 0; c < 2; ++c) { u32x4 o;
                        o.x = pk4_fp8(bflo(hw[8 * c + 0]) + bflo(lw[8 * c + 0]), bfhi(hw[8 * c + 0]) + bfhi(lw[8 * c + 0]), bflo(hw[8 * c + 1]) + bflo(lw[8 * c + 1]), bfhi(hw[8 * c + 1]) + bfhi(lw[8 * c + 1]));
                        o.y = pk4_fp8(bflo(hw[8 * c + 2]) + bflo(lw[8 * c + 2]), bfhi(hw[8 * c + 2]) + bfhi(lw[8 * c + 2]), bflo(hw[8 * c + 3]) + bflo(lw[8 * c + 3]), bfhi(hw[8 * c + 3]) + bfhi(lw[8 * c + 3]));
                        o.z = pk4_fp8(bflo(hw[8 * c + 4]) + bflo(lw[8 * c + 4]), bfhi(hw[8 * c + 4]) + bfhi(lw[8 * c + 4]), bflo(hw[8 * c + 5]) + bflo(lw[8 * c + 5]), bfhi(hw[8 * c + 5]) + bfhi(lw[8 * c + 5]));
                        o.w = pk4_fp8(bflo(hw[8 * c + 6]) + bflo(lw[8 * c + 6]), bfhi(hw[8 * c + 6]) + bfhi(lw[8 * c + 6]), bflo(hw[8 * c + 7]) + bflo(lw[8 * c + 7]), bfhi(hw[8 * c + 7]) + bfhi(lw[8 * c + 7]));
                        *(u32x4*)(hb8 + 16 * c) = o; } }
#pragma unroll
                for (int c = 0; c < 4; ++c) *(u32x4*)(hb + (size_t)m * D + kbase + 8 * c) = (u32x4){hw[4 * c], hw[4 * c + 1], hw[4 * c + 2], hw[4 * c + 3]}; }
#pragma unroll
            for (int c = 0; c < 4; ++c) { *(LAS u32x4*)(AT + ts * 136 + 32 * kq + 8 * c) = (u32x4){hw[4 * c], hw[4 * c + 1], hw[4 * c + 2], hw[4 * c + 3]};
                *(LAS u32x4*)(AT + 16 * 136 + ts * 136 + 32 * kq + 8 * c) = (u32x4){lw[4 * c], lw[4 * c + 1], lw[4 * c + 2], lw[4 * c + 3]}; }
        }
        f32x4 acc[2]; acc[0] = (f32x4){0.f, 0.f, 0.f, 0.f}; acc[1] = acc[0];
#pragma unroll
        for (int sk = 0; sk < 4; ++sk) { const bf16x8 ah = *(const LAS bf16x8*)(AT + fr * 136 + 32 * sk + 8 * fq), al = *(const LAS bf16x8*)(AT + 16 * 136 + fr * 136 + 32 * sk + 8 * fq);
#pragma unroll
            for (int nt = 0; nt < 2; ++nt) { acc[nt] = __builtin_amdgcn_mfma_f32_16x16x32_bf16(ah, bh[sk][nt], acc[nt], 0, 0, 0); acc[nt] = __builtin_amdgcn_mfma_f32_16x16x32_bf16(ah, bl[sk][nt], acc[nt], 0, 0, 0);
                acc[nt] = __builtin_amdgcn_mfma_f32_16x16x32_bf16(al, bh[sk][nt], acc[nt], 0, 0, 0); } }
#pragma unroll
        for (int nt = 0; nt < 2; ++nt)
#pragma unroll
            for (int j = 0; j < 4; ++j) PL[((buf * 8 + w) * 16 + fq * 4 + j) * 33 + nt * 16 + fr] = acc[nt][j];
        __syncthreads();
        {
            const int tt = 2 * w + (lane >> 5), e = lane & 31, mt = tb + 16 * it + tt;
            float lg = rbias;
#pragma unroll
            for (int q = 0; q < 8; ++q) lg += PL[((buf * 8 + q) * 16 + tt) * 33 + e];
            float bval[4]; int bidx[4]; float cur = lg;
#pragma unroll
            for (int k = 0; k < 4; ++k) { float bv = cur; int bi = e;
#pragma unroll
                for (int o = 1; o < 32; o <<= 1) { const float ov = __shfl_xor(bv, o); const int oi = __shfl_xor(bi, o); const bool take = (ov > bv) || (ov == bv && oi < bi); bv = take ? ov : bv; bi = take ? oi : bi; }
                bval[k] = bv; bidx[k] = bi; if (e == bi) cur = -INFINITY; }
            float ex[4], sum = 0.f;
#pragma unroll
            for (int k = 0; k < 4; ++k) { ex[k] = __expf(bval[k] - bval[0]); sum += ex[k]; }
            if (e == 0 && mt < te) { const int tl = 16 * it + tt;
#pragma unroll
                for (int k = 0; k < 4; ++k) { const int lp = __hip_atomic_fetch_add((LAS int*)(F.lds + AX_LCNT) + bidx[k], 1, __ATOMIC_RELAXED, __HIP_MEMORY_SCOPE_WORKGROUP);
                    LE[tl * 4 + k] = bidx[k]; LP[tl * 4 + k] = lp; aprob[(size_t)mt * 4 + k] = ex[k] / sum; } }
        }
    }
    __syncthreads();
    if (tid < 32) gbase[tid] = (int)__hip_atomic_fetch_add((unsigned*)(ws + WS_CTL) + CW_CNT + l * 64 + tid, (unsigned)lcnt[tid], __ATOMIC_RELAXED, __HIP_MEMORY_SCOPE_AGENT);
    __syncthreads();
    int* aexp = (int*)(ws + WS_AEXP); int* apos = (int*)(ws + WS_APOS);
    int* elist = (int*)(ws + WS_XB);
    for (int i = tid; i < (te - tb) * 4; i += NTHREADS) { const int e = LE[i]; const int pos = gbase[e] + LP[i]; aexp[(size_t)tb * 4 + i] = e; apos[(size_t)tb * 4 + i] = pos; elist[(size_t)e * NTOK + pos] = tb + (i >> 2); }
    __syncthreads();
}

__device__ __forceinline__ void moe_prep(const Frame& F, const Params& P, int l) {
    unsigned char* ws = P.ws;
    volatile LAS int* TS = (volatile LAS int*)(F.lds + LC_TS);
    if (F.tid < 64) { const int e = F.lane & 31;
        const unsigned c = __hip_atomic_load((unsigned*)(ws + WS_CTL) + CW_CNT + l * 64 + e, __ATOMIC_RELAXED, __HIP_MEMORY_SCOPE_AGENT);
        int incl = (int)((c + 255u) >> 8);
#pragma unroll
        for (int o = 1; o < 32; o <<= 1) { const int v = __shfl_up(incl, o); if (e >= o) incl += v; }
        if (F.lane < 32) { TS[e + 1] = incl; TS[64 + e] = (int)c; }
        if (F.lane == 0) TS[0] = 0; }
    __syncthreads();
}

__device__ __forceinline__ void phase_gather8(const Frame& F, const Params& P, int l, int ntok) {
    unsigned char* ws = P.ws;
    moe_prep(F, P, l);
    const volatile LAS int* TS = (const volatile LAS int*)(F.lds + LC_TS);
    const int gw = F.bid * NWAVES + F.wave, NGW = F.G * NWAVES;
    const int* aexp = (const int*)(ws + WS_AEXP); const int* apos = (const int*)(ws + WS_APOS);
    const unsigned char* hb8 = ws + WS_HB8; unsigned char* xb8 = ws + WS_XB8;
    for (int cidx = gw; cidx < ntok / 16; cidx += NGW) {
        const int a0 = cidx * 64; const int e = aexp[a0 + F.lane]; const int rowl = TS[e] * 256 + apos[a0 + F.lane];
#pragma unroll 1
        for (int t4 = 0; t4 < 16; t4 += 4) {
            u32x4 v0[4];
#pragma unroll
            for (int q = 0; q < 4; ++q) v0[q] = ((const u32x4*)(hb8 + (size_t)(a0 / 4 + t4 + q) * D))[F.lane];
#pragma unroll
            for (int q = 0; q < 4; ++q)
#pragma unroll
                for (int k = 0; k < 4; ++k) { const int row = __shfl(rowl, (t4 + q) * 4 + k); ((u32x4*)(xb8 + (size_t)row * D))[F.lane] = v0[q]; }
        }
    }
}

__device__ __forceinline__ void phase_combine(const Frame& F, const Params& P, int l, int ntok, bool last) {
    unsigned char* ws = P.ws;
    const int gw = F.bid * NWAVES + F.wave, NGW = F.G * NWAVES, lane = F.lane;
    float* xres = (float*)(ws + WS_XRES); const bf16_t* yb = (const bf16_t*)(ws + WS_YB);
    const int* aexp = (const int*)(ws + WS_AEXP); const int* apos = (const int*)(ws + WS_APOS); const float* aprob = (const float*)(ws + WS_APROB);
    const volatile LAS int* TS = (const volatile LAS int*)(F.lds + LC_TS);
    int sl_n[4]; float pr_n[4];
    if (gw < ntok) {
#pragma unroll
        for (int k = 0; k < 4; ++k) { sl_n[k] = TS[aexp[(size_t)gw * 4 + k]] * 256 + apos[(size_t)gw * 4 + k]; pr_n[k] = aprob[(size_t)gw * 4 + k]; } }
    for (int m = gw; m < ntok; m += NGW) {
        const int v = (m >= NLAT) ? 2 : (m >= SEQ ? 1 : 0);
        const float* mf = (const float*)(ws + WS_MODF) + ((size_t)l * 3 + v) * 6144;
        int sl[4]; float pr[4];
#pragma unroll
        for (int k = 0; k < 4; ++k) { sl[k] = sl_n[k]; pr[k] = pr_n[k]; }
        u32x2 wv[4][4]; f32x4 xo[4], g5[4];
#pragma unroll
        for (int k = 0; k < 4; ++k)
#pragma unroll
            for (int j = 0; j < 4; ++j) wv[k][j] = *(const u32x2*)(yb + (size_t)sl[k] * D + 4 * lane + 256 * j);
#pragma unroll
        for (int j = 0; j < 4; ++j) { const int c = 4 * lane + 256 * j; xo[j] = *(const f32x4*)(xres + (size_t)m * D + c); g5[j] = *(const f32x4*)(mf + 5 * 1024 + c); }
        if (m + NGW < ntok) {
#pragma unroll
            for (int k = 0; k < 4; ++k) { sl_n[k] = TS[aexp[(size_t)(m + NGW) * 4 + k]] * 256 + apos[(size_t)(m + NGW) * 4 + k]; pr_n[k] = aprob[(size_t)(m + NGW) * 4 + k]; } }
        f32x4 y[4];
#pragma unroll
        for (int j = 0; j < 4; ++j) y[j] = (f32x4){0.f, 0.f, 0.f, 0.f};
#pragma unroll
        for (int k = 0; k < 4; ++k)
#pragma unroll
            for (int j = 0; j < 4; ++j) y[j] += (f32x4){bflo(wv[k][j].x), bfhi(wv[k][j].x), bflo(wv[k][j].y), bfhi(wv[k][j].y)} * pr[k];
        f32x4 x[4];
#pragma unroll
        for (int j = 0; j < 4; ++j) x[j] = xo[j] + g5[j] * y[j];
        if (!last) {
#pragma unroll
            for (int j = 0; j < 4; ++j) *(f32x4*)(xres + (size_t)m * D + 4 * lane + 256 * j) = x[j];
            const float* mn = (const float*)(ws + WS_MODF) + ((size_t)(l + 1) * 3 + v) * 6144; f32x4 shv[4], scv[4];
#pragma unroll
            for (int j = 0; j < 4; ++j) { shv[j] = *(const f32x4*)(mn + 4 * lane + 256 * j); scv[j] = *(const f32x4*)(mn + 1024 + 4 * lane + 256 * j); }
            norm_row_store(x, P.in[4] + (size_t)(l + 1) * D, shv, scv, (bf16_t*)(ws + WS_HBUF) + (size_t)m * D, lane);
        } else {
            float ss = 0.f;
#pragma unroll
            for (int j = 0; j < 4; ++j) ss += (x[j].x * x[j].x + x[j].y * x[j].y) + (x[j].z * x[j].z + x[j].w * x[j].w);
            const float rstd = 1.0f / sqrtf(wave_sum(ss) * (1.0f / D) + NORM_EPS);
#pragma unroll
            for (int j = 0; j < 4; ++j) { const int c = 4 * lane + 256 * j; *(f32x4*)(P.out + (size_t)m * D + c) = (x[j] * rstd) * *(const f32x4*)(P.in[25] + c); }
        }
    }
}

#ifndef REP_PRO
#define REP_PRO 1
#endif
#ifndef REP_GEMM1
#define REP_GEMM1 1
#endif
#ifndef REP_G1U
#define REP_G1U 1
#endif
#ifndef REP_F1U
#define REP_F1U 1
#endif
#ifndef REP_CONV
#define REP_CONV 1
#endif
#ifndef REP_F2U
#define REP_F2U 1
#endif
#ifndef REP_G3U
#define REP_G3U 1
#endif
#ifndef REP_GU
#define REP_GU 1
#endif
#ifndef REP_DN
#define REP_DN 1
#endif
#ifndef REP_GATH
#define REP_GATH 1
#endif
__global__ void __launch_bounds__(NTHREADS, 2) mega_fwd(Params P0) {
    extern __shared__ __attribute__((aligned(16))) unsigned char lds_raw[];
    Frame F0; F0.lds = (LAS unsigned char*)lds_raw; F0.tid = threadIdx.x; F0.lane = F0.tid & 63; F0.wave = __builtin_amdgcn_readfirstlane(F0.tid >> 6); F0.G = gridDim.x; F0.bid = blockIdx.x;
#define KAS __attribute__((address_space(4)))
    struct ParamsK { const GAS float* in[26]; GAS float* out; GAS unsigned char* ws; };
#define PHASE_ENV() Frame F = F0; asm volatile("" : "+v"(F.tid)); F.lane = F.tid & 63; F.wave = __builtin_amdgcn_readfirstlane(F.tid >> 6); asm volatile("" : "+s"(F.bid), "+s"(F.G)); \
    const KAS ParamsK* kp_ = (const KAS ParamsK*)__builtin_amdgcn_kernarg_segment_ptr(); asm volatile("" : "+s"(kp_)); Params P; \
    _Pragma("unroll") for (int i_ = 0; i_ < 26; ++i_) P.in[i_] = (const float*)kp_->in[i_]; \
    P.out = (float*)kp_->out; P.ws = (unsigned char*)kp_->ws; unsigned char* ws = P.ws; (void)ws;
    { PHASE_ENV();
    for (int u = F.tid; u < (LDS_BYTES - LCTL_OFF) / 4; u += NTHREADS) ((LAS unsigned*)(F.lds + LCTL_OFF))[u] = 0u;
    __syncthreads();
    }
    { PHASE_ENV(); (void)xcd_barrier_post((unsigned*)(ws + WS_CTL) + CW_BAR, (volatile LAS unsigned*)(F.lds + LC_BAR)); }
#define GRID_BAR() do { PHASE_ENV(); XcdBarrier b_; b_.bar = (unsigned*)(ws + WS_CTL) + CW_BAR; b_.x = xb_xcc_id(); b_.st = (volatile LAS unsigned*)(F.lds + LC_BAR); xcd_barrier(b_); } while (0)

    for (int rep = 0; rep < REP_PRO; ++rep) { PHASE_ENV(); phase_prologue(F, P); }
    GRID_BAR();
    { PHASE_ENV(); phase_p1(F, P); }
    GRID_BAR();

    {
        constexpr int l = 0; constexpr bool last = (l == DEPTH - 1);
        for (int rep = 0; rep < REP_GEMM1; ++rep) { PHASE_ENV(); pg8::Gemm g{(const bf16_t*)(ws + WS_HBUF), (const bf16_t*)(ws + WS_WIN) + (size_t)l * INP * D, NTOK, INP, D};
          pg8::StaticOrder S; S.init(NTOK, INP, F.G, F.bid);
          pg8::EpiStoreBf16 E{(bf16_t*)(ws + WS_PBUF), INP};
          pg8::gemm_phase<pg8::EpiStoreBf16, pg8::StaticOrder>(F.lds, g, S, E, F.tid);
          const int nun = (NTOK / 256) * (INP / 256), rr = nun % F.G, first = (rr == 0) ? 0 : rr, nidle = F.G - first;
          if (F.bid >= first) for (int t = F.bid - first; t < NTOK / 256; t += nidle) {
              SkEpiBf16 SE{(bf16_t*)(ws + WS_LRB) + (size_t)t * 256 * 32, 32};
              skinny_unit(F, (const bf16_t*)(ws + WS_HBUF) + (size_t)t * 256 * D, (const bf16_t*)(ws + WS_WGT) + (size_t)l * 32 * D, SE); } }
        GRID_BAR();
        for (int rep = 0; rep < REP_G1U; ++rep) { PHASE_ENV();
        for (int u = F.bid; u < 2080; u += F.G) { int row0, h;
            if (u < 2048) { const int bh = u >> 8, n = u & 255; h = bh & 3; row0 = (bh >> 2) * SEQ + 64 * n; }
            else { const int q = u - 2048, bh = q >> 2, n = q & 3; h = bh & 3; row0 = NLAT + (bh >> 2) * CTXL + 64 * n; }
            gla_g1_unit(F, P, l, row0, h, u); }
        __syncthreads(); }
        for (int rep = 0; rep < REP_F1U; ++rep) { PHASE_ENV();
        for (int u = F.bid; u < 1024; u += F.G) { const int b = u >> 9, nlo = (u >> 2) & 127, h = u & 3;
            fourier_f1_unit<128, 3>(F, P, b * SEQ + nlo, 128, h, (const bf16_t*)(ws + WS_TLAT) + (size_t)nlo * 32768, b * SEQ + nlo, 1.0f); }
        }
        { PHASE_ENV();
        if (!last) for (int u = (F.bid + F.G - 32) % F.G; u < 8; u += F.G) { const int b = u >> 2, h = u & 3;
            fourier_f1_unit<256, 2>(F, P, NLAT + b * CTXL, 1, h, (const bf16_t*)(ws + WS_TCTX), NLAT + b * CTXL, 1.0f / 128.0f); }
        }
        for (int rep = 0; rep < REP_CONV; ++rep) { PHASE_ENV();
        for (int u = F.bid; u < 512 + F.G; u += F.G) {
            int rowbase = 64 * u, Ls = 64, t0 = 0;
            if (u >= 512) { const int q = (u - 512) - 40; if (last || q < 0 || q >= 8) break; rowbase = NLAT + (q >> 2) * CTXL; Ls = CTXL; t0 = 64 * (q & 3); }
            conv_unit(F, P, l, rowbase, Ls, t0); } }
        GRID_BAR();
        { PHASE_ENV(); gla_scan(F, P); }
        for (int rep = 0; rep < REP_F2U; ++rep) { PHASE_ENV();
        fourier_f2_tables(F, P);
        for (int u = F.bid; u < 512; u += F.G) fourier_f2_unit(F, P, u >> 8, (u >> 1) & 127, u & 1); }
        GRID_BAR();
        for (int rep = 0; rep < REP_G3U; ++rep) { PHASE_ENV();
        for (int u = F.bid; u < (last ? 2048 : 2080); u += F.G) { int row0, h;
            if (u < 2048) { const int bh = u >> 8, n = u & 255; h = bh & 3; row0 = (bh >> 2) * SEQ + 64 * n; }
            else { const int q = u - 2048, bh = q >> 2, n = q & 3; h = bh & 3; row0 = NLAT + (bh >> 2) * CTXL + 64 * n; }
            gla_g3_unit(F, P, l, row0, h, u); }
        __syncthreads(); }
        GRID_BAR();
        { PHASE_ENV(); const int M2 = NLAT;
          pg8::Gemm g{(const bf16_t*)(ws + WS_CAT), (const bf16_t*)(ws + WS_WOUT) + (size_t)l * D * D, M2, D, D};
          pg8::StaticOrder S; S.init(M2, D, F.G, F.bid);
          pg8::EpiResid E{(float*)(ws + WS_XRES), (l == 0) ? P.in[0] : (const float*)(ws + WS_XRES), (const float*)(ws + WS_MODF) + (size_t)l * 3 * 6144};
          pg8::gemm_phase<pg8::EpiResid, pg8::StaticOrder>(F.lds, g, S, E, F.tid);
          if (!last) for (int t = F.bid; t < 2 * 32; t += F.G) { const int pm = NLAT / 256 + (t >> 5), nt32 = t & 31;
              SkEpiResid SE{(float*)(ws + WS_XRES) + (size_t)pm * 256 * D + nt32 * 32, P.in[2] + (size_t)(pm - NLAT / 256) * 256 * D + nt32 * 32, (const float*)(ws + WS_MODF) + ((size_t)l * 3 + 2) * 6144 + 2 * 1024 + nt32 * 32};
              skinny_unit(F, (const bf16_t*)(ws + WS_CAT) + (size_t)pm * 256 * D, (const bf16_t*)(ws + WS_WOUT) + (size_t)l * D * D + (size_t)nt32 * 32 * D, SE); } }
        GRID_BAR();
        const int ntok = last ? NLAT : NTOK;
        { PHASE_ENV(); phase_route(F, P, l, ntok); }
        GRID_BAR();
        if constexpr (F8_LAYER[l]) { { PHASE_ENV(); phase_gather8(F, P, l, ntok); } GRID_BAR(); }
        for (int rep = 0; rep < REP_GU; ++rep) { PHASE_ENV(); moe_prep(F, P, l); const volatile LAS int* TS = (const volatile LAS int*)(F.lds + LC_TS);
          pg8::MoeOrder S{8, F.G, F.bid, TS[NE], TS};
          if constexpr (F8_LAYER[l]) {
              pg8::Gemm g{(const bf16_t*)(ws + WS_XB8), (const bf16_t*)(ws + WS_WGU + (size_t)l * NE * 2048 * D * 2), 0, 2048, D / 2};
              pg8::EpiGateUp8 E{ws + WS_ACT, P.in[22] + (size_t)l * NE * 2048};
              pg8::gemm_phase<pg8::EpiGateUp8, pg8::MoeOrder, true, true, true>(F.lds, g, S, E, F.tid);
          } else {
              pg8::Gemm g{(const bf16_t*)(ws + WS_HBUF), (const bf16_t*)(ws + WS_WGU) + (size_t)l * NE * 2048 * D, 0, 2048, D};
              pg8::EpiGateUp E{(bf16_t*)(ws + WS_ACT), P.in[22] + (size_t)l * NE * 2048};
              pg8::gemm_phase_gather<pg8::EpiGateUp, pg8::MoeOrder>(F.lds, g, (const int*)(ws + WS_XB), S, E, F.tid); } }
        GRID_BAR();
        for (int rep = 0; rep < REP_DN; ++rep) { PHASE_ENV(); const volatile LAS int* TS = (const volatile LAS int*)(F.lds + LC_TS);
          pg8::MoeOrder S{4, F.G, F.bid, TS[NE], TS};
          if constexpr (F8_LAYER[l]) {
              pg8::Gemm g{(const bf16_t*)(ws + WS_ACT), (const bf16_t*)(ws + WS_WDN + (size_t)l * NE * D * DFF * 2), 0, D, DFF / 2};
              pg8::EpiDown8 E{(bf16_t*)(ws + WS_YB), P.in[24] + (size_t)l * NE * D};
              pg8::gemm_phase<pg8::EpiDown8, pg8::MoeOrder, true, true, true>(F.lds, g, S, E, F.tid);
          } else {
              pg8::Gemm g{(const bf16_t*)(ws + WS_ACT), (const bf16_t*)(ws + WS_WDN) + (size_t)l * NE * D * DFF, 0, D, DFF};
              pg8::EpiDown E{(bf16_t*)(ws + WS_YB), P.in[24] + (size_t)l * NE * D};
              pg8::gemm_phase<pg8::EpiDown, pg8::MoeOrder>(F.lds, g, S, E, F.tid); } }
        GRID_BAR();
        { PHASE_ENV(); phase_combine(F, P, l, ntok, last); }
        if (!last) GRID_BAR();
    }
    {
        constexpr int l = 1; constexpr bool last = (l == DEPTH - 1);
        for (int rep = 0; rep < REP_GEMM1; ++rep) { PHASE_ENV(); pg8::Gemm g{(const bf16_t*)(ws + WS_HBUF), (const bf16_t*)(ws + WS_WIN) + (size_t)l * INP * D, NTOK, INP, D};
          pg8::StaticOrder S; S.init(NTOK, INP, F.G, F.bid);
          pg8::EpiStoreBf16 E{(bf16_t*)(ws + WS_PBUF), INP};
          pg8::gemm_phase<pg8::EpiStoreBf16, pg8::StaticOrder>(F.lds, g, S, E, F.tid);
          const int nun = (NTOK / 256) * (INP / 256), rr = nun % F.G, first = (rr == 0) ? 0 : rr, nidle = F.G - first;
          if (F.bid >= first) for (int t = F.bid - first; t < NTOK / 256; t += nidle) {
              SkEpiBf16 SE{(bf16_t*)(ws + WS_LRB) + (size_t)t * 256 * 32, 32};
              skinny_unit(F, (const bf16_t*)(ws + WS_HBUF) + (size_t)t * 256 * D, (const bf16_t*)(ws + WS_WGT) + (size_t)l * 32 * D, SE); } }
        GRID_BAR();
        for (int rep = 0; rep < REP_G1U; ++rep) { PHASE_ENV();
        for (int u = F.bid; u < 2080; u += F.G) { int row0, h;
            if (u < 2048) { const int bh = u >> 8, n = u & 255; h = bh & 3; row0 = (bh >> 2) * SEQ + 64 * n; }
            else { const int q = u - 2048, bh = q >> 2, n = q & 3; h = bh & 3; row0 = NLAT + (bh >> 2) * CTXL + 64 * n; }
            gla_g1_unit(F, P, l, row0, h, u); }
        __syncthreads(); }
        for (int rep = 0; rep < REP_F1U; ++rep) { PHASE_ENV();
        for (int u = F.bid; u < 1024; u += F.G) { const int b = u >> 9, nlo = (u >> 2) & 127, h = u & 3;
            fourier_f1_unit<128, 3>(F, P, b * SEQ + nlo, 128, h, (const bf16_t*)(ws + WS_TLAT) + (size_t)nlo * 32768, b * SEQ + nlo, 1.0f); }
        }
        { PHASE_ENV();
        if (!last) for (int u = (F.bid + F.G - 32) % F.G; u < 8; u += F.G) { const int b = u >> 2, h = u & 3;
            fourier_f1_unit<256, 2>(F, P, NLAT + b * CTXL, 1, h, (const bf16_t*)(ws + WS_TCTX), NLAT + b * CTXL, 1.0f / 128.0f); }
        }
        for (int rep = 0; rep < REP_CONV; ++rep) { PHASE_ENV();
        for (int u = F.bid; u < 512 + F.G; u += F.G) {
            int rowbase = 64 * u, Ls = 64, t0 = 0;
            if (u >= 512) { const int q = (u - 512) - 40; if (last || q < 0 || q >= 8) break; rowbase = NLAT + (q >> 2) * CTXL; Ls = CTXL; t0 = 64 * (q & 3); }
            conv_unit(F, P, l, rowbase, Ls, t0); } }
        GRID_BAR();
        { PHASE_ENV(); gla_scan(F, P); }
        for (int rep = 0; rep < REP_F2U; ++rep) { PHASE_ENV();
        fourier_f2_tables(F, P);
        for (int u = F.bid; u < 512; u += F.G) fourier_f2_unit(F, P, u >> 8, (u >> 1) & 127, u & 1); }
        GRID_BAR();
        for (int rep = 0; rep < REP_G3U; ++rep) { PHASE_ENV();
        for (int u = F.bid; u < (last ? 2048 : 2080); u += F.G) { int row0, h;
            if (u < 2048) { const int bh = u >> 8, n = u & 255; h = bh & 3; row0 = (bh >> 2) * SEQ + 64 * n; }
            else { const int q = u - 2048, bh = q >> 2, n = q & 3; h = bh & 3; row0 = NLAT + (bh >> 2) * CTXL + 64 * n; }
            gla_g3_unit(F, P, l, row0, h, u); }
        __syncthreads(); }
        GRID_BAR();
        { PHASE_ENV(); const int M2 = NLAT;
          pg8::Gemm g{(const bf16_t*)(ws + WS_CAT), (const bf16_t*)(ws + WS_WOUT) + (size_t)l * D * D, M2, D, D};
          pg8::StaticOrder S; S.init(M2, D, F.G, F.bid);
          pg8::EpiResid E{(float*)(ws + WS_XRES), (l == 0) ? P.in[0] : (const float*)(ws + WS_XRES), (const float*)(ws + WS_MODF) + (size_t)l * 3 * 6144};
          pg8::gemm_phase<pg8::EpiResid, pg8::StaticOrder>(F.lds, g, S, E, F.tid);
          if (!last) for (int t = F.bid; t < 2 * 32; t += F.G) { const int pm = NLAT / 256 + (t >> 5), nt32 = t & 31;
              SkEpiResid SE{(float*)(ws + WS_XRES) + (size_t)pm * 256 * D + nt32 * 32, P.in[2] + (size_t)(pm - NLAT / 256) * 256 * D + nt32 * 32, (const float*)(ws + WS_MODF) + ((size_t)l * 3 + 2) * 6144 + 2 * 1024 + nt32 * 32};
              skinny_unit(F, (const bf16_t*)(ws + WS_CAT) + (size_t)pm * 256 * D, (const bf16_t*)(ws + WS_WOUT) + (size_t)l * D * D + (size_t)nt32 * 32 * D, SE); } }
        GRID_BAR();
        const int ntok = last ? NLAT : NTOK;
        { PHASE_ENV(); phase_route(F, P, l, ntok); }
        GRID_BAR();
        if constexpr (F8_LAYER[l]) { { PHASE_ENV(); phase_gather8(F, P, l, ntok); } GRID_BAR(); }
        for (int rep = 0; rep < REP_GU; ++rep) { PHASE_ENV(); moe_prep(F, P, l); const volatile LAS int* TS = (const volatile LAS int*)(F.lds + LC_TS);
          pg8::MoeOrder S{8, F.G, F.bid, TS[NE], TS};
          if constexpr (F8_LAYER[l]) {
              pg8::Gemm g{(const bf16_t*)(ws + WS_XB8), (const bf16_t*)(ws + WS_WGU + (size_t)l * NE * 2048 * D * 2), 0, 2048, D / 2};
              pg8::EpiGateUp8 E{ws + WS_ACT, P.in[22] + (size_t)l * NE * 2048};
              pg8::gemm_phase<pg8::EpiGateUp8, pg8::MoeOrder, true, true, true>(F.lds, g, S, E, F.tid);
          } else {
              pg8::Gemm g{(const bf16_t*)(ws + WS_HBUF), (const bf16_t*)(ws + WS_WGU) + (size_t)l * NE * 2048 * D, 0, 2048, D};
              pg8::EpiGateUp E{(bf16_t*)(ws + WS_ACT), P.in[22] + (size_t)l * NE * 2048};
              pg8::gemm_phase_gather<pg8::EpiGateUp, pg8::MoeOrder>(F.lds, g, (const int*)(ws + WS_XB), S, E, F.tid); } }
        GRID_BAR();
        for (int rep = 0; rep < REP_DN; ++rep) { PHASE_ENV(); const volatile LAS int* TS = (const volatile LAS int*)(F.lds + LC_TS);
          pg8::MoeOrder S{4, F.G, F.bid, TS[NE], TS};
          if constexpr (F8_LAYER[l]) {
              pg8::Gemm g{(const bf16_t*)(ws + WS_ACT), (const bf16_t*)(ws + WS_WDN + (size_t)l * NE * D * DFF * 2), 0, D, DFF / 2};
              pg8::EpiDown8 E{(bf16_t*)(ws + WS_YB), P.in[24] + (size_t)l * NE * D};
              pg8::gemm_phase<pg8::EpiDown8, pg8::MoeOrder, true, true, true>(F.lds, g, S, E, F.tid);
          } else {
              pg8::Gemm g{(const bf16_t*)(ws + WS_ACT), (const bf16_t*)(ws + WS_WDN) + (size_t)l * NE * D * DFF, 0, D, DFF};
              pg8::EpiDown E{(bf16_t*)(ws + WS_YB), P.in[24] + (size_t)l * NE * D};
              pg8::gemm_phase<pg8::EpiDown, pg8::MoeOrder>(F.lds, g, S, E, F.tid); } }
        GRID_BAR();
        { PHASE_ENV(); phase_combine(F, P, l, ntok, last); }
        if (!last) GRID_BAR();
    }
}

extern "C" void kernel_launch(void* const* d_in, const int* in_sizes, int n_in, void* d_out, int out_size, void* d_ws, size_t ws_size, hipStream_t stream) {
    static int grid = 0;
    if (grid == 0) {
        if (n_in != 26 || ws_size < WS_END) { fprintf(stderr, "kernel_launch: unexpected n_in %d or ws_size %zu (need %zu)\n", n_in, ws_size, (size_t)WS_END); grid = -1; return; }
        int dev = 0, cus = 0, per_cu = 0;
        if (hipGetDevice(&dev) != hipSuccess || hipDeviceGetAttribute(&cus, hipDeviceAttributeMultiprocessorCount, dev) != hipSuccess) { grid = -1; return; }
        if (hipFuncSetAttribute((const void*)mega_fwd, hipFuncAttributeMaxDynamicSharedMemorySize, LDS_BYTES) != hipSuccess) { fprintf(stderr, "kernel_launch: hipFuncSetAttribute failed\n"); grid = -1; return; }
        if (hipOccupancyMaxActiveBlocksPerMultiprocessor(&per_cu, (const void*)mega_fwd, NTHREADS, LDS_BYTES) != hipSuccess || per_cu < 1) { fprintf(stderr, "kernel_launch: occupancy query says %d\n", per_cu); }
        (void)hipGetLastError();
        grid = cus;
    }
    if (grid < 0) return;
    (void)hipMemsetAsync((char*)d_ws + WS_CTL, 0, CTL_ZERO_BYTES, stream);
    Params p{};
    for (int i = 0; i < 26; ++i) p.in[i] = (const float*)d_in[i];
    p.out = (float*)d_out; p.ws = (unsigned char*)d_ws;
    hipLaunchKernelGGL(mega_fwd, dim3(grid), dim3(NTHREADS), LDS_BYTES, stream, p);
}
```

```cpp
#include <hip/hip_runtime.h>
#include <cstdio>
#include <cstdint>

#define LAS __attribute__((address_space(3)))
#define GAS __attribute__((address_space(1)))
typedef unsigned short bf16_t;
typedef short bf16x8 __attribute__((ext_vector_type(8)));
typedef float f32x4 __attribute__((ext_vector_type(4)));
typedef float f32x2 __attribute__((ext_vector_type(2)));
typedef unsigned u32x4 __attribute__((ext_vector_type(4)));
typedef unsigned u32x2 __attribute__((ext_vector_type(2)));

constexpr int D = 1024, NBATCH = 2, SEQ = 16384, NLAT = NBATCH * SEQ, CTXL = 256, NCTX = NBATCH * CTXL, NTOK = NLAT + NCTX, DEPTH = 2;
constexpr int INW = 2336, INP = 2304;
constexpr int C_FOUR = 0, C_Q = 256, C_K = 512, C_V = 768, C_R = 1280, C_CA = 1792, C_CG = 2048;
constexpr int NE = 32, TOPK = 4, DFF = 1024;
constexpr int MAXROWS = NTOK * TOPK + NE * 256;
constexpr float NORM_EPS = 1e-6f;
constexpr int NTHREADS = 512, NWAVES = 8;

constexpr size_t MiB = 1u << 20;
constexpr size_t WS_CTL = 0, CTL_ZERO_BYTES = 1 * MiB;
constexpr size_t WS_MODP = 1 * MiB;
constexpr size_t WS_MODF = 3 * MiB;
constexpr size_t WS_RW = 3 * MiB + 512 * 1024;
constexpr size_t WS_WGT = 3 * MiB + 768 * 1024;
constexpr size_t WS_CM3 = 4 * MiB;
constexpr size_t WS_TF2 = 4 * MiB + 65536;
constexpr size_t WS_TCTX = 4 * MiB + 262144;
constexpr size_t WS_TLAT = 5 * MiB;
constexpr size_t WS_WIN = 13 * MiB;
constexpr size_t WS_WOUT = 23 * MiB;
constexpr size_t WS_WGU = 27 * MiB;
constexpr size_t WS_WDN = 283 * MiB;
constexpr size_t WS_XRES = 411 * MiB;
constexpr size_t WS_HBUF = 541 * MiB;
constexpr size_t WS_PBUF = 606 * MiB;
constexpr size_t WS_CAT = 769 * MiB;
constexpr size_t WS_T2 = 834 * MiB;
constexpr size_t WS_STATE = 866 * MiB;
constexpr size_t WS_DECAY = 996 * MiB;
constexpr size_t WS_AEXP = 998 * MiB, WS_APOS = 999 * MiB, WS_APROB = 1000 * MiB, WS_ASLOT = 1001 * MiB;
constexpr size_t WS_XB8 = 1106 * MiB;
constexpr size_t WS_HB8 = 1066 * MiB;
constexpr bool F8_LAYER[2] = {true, true};
constexpr size_t WS_LRB = 1018 * MiB;
constexpr size_t WS_XB = 1002 * MiB, WS_ACT = 1278 * MiB, WS_YB = 1554 * MiB, WS_END = 1830 * MiB;
constexpr int CW_BAR = 4096, CW_CNT = 16384;

constexpr int RING_BYTES = 131072;
constexpr int AUX_OFF = RING_BYTES;
constexpr int LCTL_OFF = RING_BYTES + 8192;
constexpr int LDS_BYTES = 147456;

__device__ __forceinline__ unsigned f2bf(float f) { unsigned u = __builtin_bit_cast(unsigned, f); return (u + 0x7fffu + ((u >> 16) & 1u)) >> 16; }
__device__ __forceinline__ unsigned pk2(float lo, float hi) { return f2bf(lo) | (f2bf(hi) << 16); }
__device__ __forceinline__ float bf2f(unsigned b) { return __builtin_bit_cast(float, b << 16); }
__device__ __forceinline__ float bflo(unsigned w) { return __builtin_bit_cast(float, w << 16); }
__device__ __forceinline__ float bfhi(unsigned w) { return __builtin_bit_cast(float, w & 0xffff0000u); }
__device__ __forceinline__ float wave_sum(float v) {
#pragma unroll
    for (int o = 1; o < 64; o <<= 1) v += __shfl_xor(v, o);
    return v;
}
__device__ __forceinline__ float sigmoidf_(float x) { return __builtin_amdgcn_rcpf(1.0f + __expf(-x)); }

#define XB_TMO      128
#define XB_XCNT(j)  (256  + 64 * (j))
#define XB_XSUB(j)  (1280 + 64 * (j))
#define XB_XGEN(j)  (2304 + 64 * (j))
#define XB_TOP      3328
#define XB_TOPGEN   3392
#define XCD_BAR_WORDS 3456
#define XB_SPIN_CAP (1u << 22)

__device__ __forceinline__ unsigned xb_ld(unsigned* p)              { return __hip_atomic_load(p, __ATOMIC_RELAXED, __HIP_MEMORY_SCOPE_AGENT); }
__device__ __forceinline__ unsigned xb_add(unsigned* p, unsigned v) { return __hip_atomic_fetch_add(p, v, __ATOMIC_RELAXED, __HIP_MEMORY_SCOPE_AGENT); }
__device__ __forceinline__ unsigned xb_xcc_id() { return (unsigned)__builtin_amdgcn_s_getreg((3 << 11) | 20) & 0xFu; }
#define XB_SPIN(cond, bar) do { unsigned _sp = 0; while (cond) { __builtin_amdgcn_s_sleep(1); \
    if ((++_sp & 255u) == 0u) { if (xb_ld(&(bar)[XB_TMO])) break; if (_sp > XB_SPIN_CAP) { atomicAdd(&(bar)[XB_TMO], 1u); break; } } } } while (0)

struct XcdBarrier { unsigned* bar; unsigned x; volatile LAS unsigned* st; };

__device__ __forceinline__ XcdBarrier xcd_barrier_post(unsigned* bar, volatile LAS unsigned* st) {
    XcdBarrier b; b.bar = bar; b.x = xb_xcc_id(); b.st = st;
    if (threadIdx.x == 0) (void)xb_add(&bar[XB_XCNT(b.x)], 1u);
    return b;
}
__device__ __forceinline__ void xcd_barrier_complete(unsigned* bar, unsigned x, unsigned& nloc, unsigned& nx) {
    const unsigned G = gridDim.x * gridDim.y * gridDim.z;
    unsigned sum, cnt, mine, sp = 0u;
    for (;;) {
        sum = 0u; cnt = 0u; mine = 0u;
#pragma unroll
        for (unsigned j = 0; j < 16; ++j) { const unsigned c = xb_ld(&bar[XB_XCNT(j)]); sum += c; cnt += (c > 0u) ? 1u : 0u; mine = (j == x) ? c : mine; }
        if (sum == G) break;
        __builtin_amdgcn_s_sleep(1);
        if ((++sp & 255u) == 0u) { if (xb_ld(&bar[XB_TMO])) break; if (sp > XB_SPIN_CAP) { atomicAdd(&bar[XB_TMO], 1u); break; } }
    }
    nloc = mine > 0u ? mine : 1u; nx = cnt > 0u ? cnt : 1u;
}
__device__ __forceinline__ void xcd_barrier(const XcdBarrier& b) {
    asm volatile("s_waitcnt vmcnt(0)" ::: "memory");
    __syncthreads();
    if (threadIdx.x == 0) {
        unsigned* bar = b.bar;
        __builtin_amdgcn_s_waitcnt(0);
        unsigned nloc = b.st[0], nx = b.st[1];
        if (nloc == 0u) { xcd_barrier_complete(bar, b.x, nloc, nx); b.st[0] = nloc; b.st[1] = nx; }
        const unsigned old = xb_add(&bar[XB_XSUB(b.x)], 1u);
        const unsigned gen = old / nloc;
        if (old + 1u == (gen + 1u) * nloc) {
            __builtin_amdgcn_fence(__ATOMIC_RELEASE, "agent");
            asm volatile("s_waitcnt vmcnt(0)" ::: "memory");
            const unsigned og = xb_add(&bar[XB_TOP], 1u);
            const unsigned tg = og / nx;
            if (og + 1u == (tg + 1u) * nx) xb_add(&bar[XB_TOPGEN], 1u);
            else XB_SPIN(xb_ld(&bar[XB_TOPGEN]) == tg, bar);
            __builtin_amdgcn_fence(__ATOMIC_ACQUIRE, "agent");
            xb_add(&bar[XB_XGEN(b.x)], 1u);
            asm volatile("s_waitcnt vmcnt(0)" ::: "memory");
        } else {
            XB_SPIN(xb_ld(&bar[XB_XGEN(b.x)]) == gen, bar);
            __builtin_amdgcn_fence(__ATOMIC_ACQUIRE, "agent");
            asm volatile("s_waitcnt vmcnt(0)" ::: "memory");
        }
    }
    __syncthreads();
}

namespace pg8 {
constexpr int BM = 256, BK = 64, HALF = 128, HTB = HALF * BK * 2, STAGE_BYTES = 8 * HTB, NXCD = 8, WGM = 8;
__host__ __device__ __forceinline__ int lds_byte(int r, int c) { const int st = (r >> 4) * 2 + (c >> 5), rr = r & 15, cc = c & 31, ob = rr * 64 + cc * 2; return st * 1024 + (ob ^ (((ob >> 9) & 1) << 5)); }
__host__ __device__ __forceinline__ void stage_rc(int b, int& R, int& C) { const int st = b / 1024, sb = b % 1024, swz = sb ^ (((sb >> 9) & 1) << 5); R = (st >> 1) * 16 + swz / 64; C = (st & 1) * 32 + (swz % 64) / 2; }
__host__ __device__ __forceinline__ int perm32(int rho) { const int n = rho >> 4, i = rho & 15; return 8 * (i >> 2) + 4 * n + (i & 3); }

struct Unit { int pm, pn, lbase, nvalid; };
struct Gemm { const bf16_t* A; const bf16_t* Bt; int M, N, K; };

struct StaticOrder {
    int nM, nN, nwg, G, c;
    __device__ void init(int M, int N, int G_, int c_) { nM = M / BM; nN = N / BM; nwg = nM * nN; G = G_; c = c_; }
    __device__ bool next(int i, Unit& u) const {
        const long L = (long)i * G + c; if (L >= nwg) return false;
        int wgid = (int)L; { const int q = nwg / NXCD, r = nwg % NXCD, xcd = wgid % NXCD, off = wgid / NXCD; wgid = (xcd < r ? xcd * (q + 1) : r * (q + 1) + (xcd - r) * q) + off; }
        const int nig = WGM * nN, gid = wgid / nig, fm = gid * WGM, gsz = (nM - fm) < WGM ? (nM - fm) : WGM;
        u.pm = fm + ((wgid % nig) % gsz); u.pn = (wgid % nig) / gsz; u.lbase = 0; u.nvalid = 0; return true;
    }
};
struct MoeOrder {
    int nN, G, c, MT; const volatile LAS int* ts;
    __device__ bool next(int i, Unit& u) const {
        const long L = (G % 8 == 0) ? ((long)i * G + (long)(c & 7) * (G >> 3) + (c >> 3)) : ((long)i * G + c);
        if (L >= (long)MT * nN) return false;
        const int mt = (int)(L / nN), pl = (int)(L % nN);
        const int lane = threadIdx.x & 63;
        const unsigned long long bal = __ballot(lane >= 1 && lane < NE && ts[lane] <= mt);
        const int e = __popcll(bal);
        const int j = mt - ts[e];
        u.pm = mt; u.pn = e * nN + pl; u.lbase = e * NTOK + j * 256; u.nvalid = ts[64 + e] - j * 256; return true;
    }
};

__device__ __forceinline__ unsigned cvt_pk_bf16(float lo, float hi) { unsigned r; asm volatile("v_cvt_pk_bf16_f32 %0, %1, %2" : "=v"(r) : "v"(lo), "v"(hi)); return r; }

struct EpiStoreBf16 {
    static constexpr bool PERM = true;
    bf16_t* O; int ldc;
    __device__ __forceinline__ void operator()(const f32x4 (&acc)[2][2][4][2], const Unit& u, int wr, int wc, int fr, int fq) const {
        const int row0 = u.pm * BM + wr * 64 + fr; const int col0 = u.pn * BM + wc * 32 + 8 * fq;
#pragma unroll
        for (int ai = 0; ai < 2; ++ai)
#pragma unroll
            for (int m = 0; m < 4; ++m) { bf16_t* rowp = O + (size_t)(row0 + ai * HALF + m * 16) * ldc + col0;
#pragma unroll
                for (int bj = 0; bj < 2; ++bj) { const f32x4 v0 = acc[ai][bj][m][0], v1 = acc[ai][bj][m][1];
                    u32x4 w; w.x = cvt_pk_bf16(v0[0], v0[1]); w.y = cvt_pk_bf16(v0[2], v0[3]); w.z = cvt_pk_bf16(v1[0], v1[1]); w.w = cvt_pk_bf16(v1[2], v1[3]);
                    *(u32x4*)(rowp + bj * HALF) = w; } }
    }
};
struct EpiResid {
    static constexpr bool PERM = false;
    float* X; const float* Xs; const float* modf;
    __device__ __forceinline__ void operator()(const f32x4 (&acc)[2][2][4][2], const Unit& u, int wr, int wc, int fr, int fq) const {
        const int row0 = u.pm * BM + wr * 64 + fr, col0 = u.pn * BM + wc * 32 + 4 * fq;
        const int v = (u.pm >= NLAT / BM) ? 2 : (u.pm >= SEQ / BM ? 1 : 0);
        const float* gv = modf + (size_t)v * 6144 + 2 * 1024;
        f32x4 bv[2][2];
#pragma unroll
        for (int bj = 0; bj < 2; ++bj)
#pragma unroll
            for (int n = 0; n < 2; ++n) bv[bj][n] = *(const f32x4*)(gv + col0 + bj * HALF + n * 16);
#pragma unroll
        for (int ai = 0; ai < 2; ++ai) {
            f32x4 xv[4][2][2];
#pragma unroll
            for (int m = 0; m < 4; ++m) { const float* rowp = Xs + (size_t)(row0 + ai * HALF + m * 16) * D + col0;
#pragma unroll
                for (int bj = 0; bj < 2; ++bj)
#pragma unroll
                    for (int n = 0; n < 2; ++n) xv[m][bj][n] = *(const f32x4*)(rowp + bj * HALF + n * 16); }
#pragma unroll
            for (int m = 0; m < 4; ++m) { float* rowp = X + (size_t)(row0 + ai * HALF + m * 16) * D + col0;
#pragma unroll
                for (int bj = 0; bj < 2; ++bj)
#pragma unroll
                    for (int n = 0; n < 2; ++n) *(f32x4*)(rowp + bj * HALF + n * 16) = xv[m][bj][n] + bv[bj][n] * acc[ai][bj][m][n]; }
        }
    }
};
struct EpiGateUp {
    static constexpr bool PERM = true;
    bf16_t* O; const float* bgu;
    __device__ __forceinline__ void operator()(const f32x4 (&acc)[2][2][4][2], const Unit& u, int wr, int wc, int fr, int fq) const {
        const int e = u.pn >> 3, pl = u.pn & 7;
        const int row0 = u.pm * BM + wr * 64 + fr; const int cl = pl * 128 + wc * 32 + 8 * fq;
        const float* bg = bgu + (size_t)e * 2048 + cl; const float* bu = bg + 1024;
        f32x4 g0 = *(const f32x4*)bg, g1 = *(const f32x4*)(bg + 4), u0 = *(const f32x4*)bu, u1 = *(const f32x4*)(bu + 4);
#pragma unroll
        for (int ai = 0; ai < 2; ++ai)
#pragma unroll
            for (int m = 0; m < 4; ++m) { bf16_t* rowp = O + (size_t)(row0 + ai * HALF + m * 16) * DFF + cl;
                float r[8];
#pragma unroll
                for (int n = 0; n < 2; ++n) { const f32x4 gb = n ? g1 : g0, ub = n ? u1 : u0; const f32x4 ga = acc[ai][0][m][n] + gb, ua = acc[ai][1][m][n] + ub;
#pragma unroll
                    for (int j = 0; j < 4; ++j) { const float gate = fminf(ga[j], 7.0f), up = fminf(fmaxf(ua[j], -7.0f), 7.0f);
                        r[n * 4 + j] = gate * __builtin_amdgcn_rcpf(1.0f + __expf(-1.702f * gate)) * (up + 1.0f); } }
                u32x4 w; w.x = cvt_pk_bf16(r[0], r[1]); w.y = cvt_pk_bf16(r[2], r[3]); w.z = cvt_pk_bf16(r[4], r[5]); w.w = cvt_pk_bf16(r[6], r[7]);
                *(u32x4*)rowp = w; }
    }
};
struct EpiDown {
    static constexpr bool PERM = true;
    bf16_t* O; const float* bdn;
    __device__ __forceinline__ void operator()(const f32x4 (&acc)[2][2][4][2], const Unit& u, int wr, int wc, int fr, int fq) const {
        const int e = u.pn >> 2, pl = u.pn & 3;
        const int row0 = u.pm * BM + wr * 64 + fr; const int col0 = pl * BM + wc * 32 + 8 * fq;
        f32x4 bv[2][2];
#pragma unroll
        for (int bj = 0; bj < 2; ++bj)
#pragma unroll
            for (int n = 0; n < 2; ++n) bv[bj][n] = *(const f32x4*)(bdn + (size_t)e * 1024 + col0 + bj * HALF + 4 * n);
#pragma unroll
        for (int ai = 0; ai < 2; ++ai)
#pragma unroll
            for (int m = 0; m < 4; ++m) { bf16_t* rowp = O + (size_t)(row0 + ai * HALF + m * 16) * D + col0;
#pragma unroll
                for (int bj = 0; bj < 2; ++bj) { const f32x4 v0 = acc[ai][bj][m][0] + bv[bj][0], v1 = acc[ai][bj][m][1] + bv[bj][1];
                    u32x4 w; w.x = cvt_pk_bf16(v0[0], v0[1]); w.y = cvt_pk_bf16(v0[2], v0[3]); w.z = cvt_pk_bf16(v1[0], v1[1]); w.w = cvt_pk_bf16(v1[2], v1[3]);
                    *(u32x4*)(rowp + bj * HALF) = w; } }
    }
};

__device__ __forceinline__ unsigned pk4_fp8(float a, float b, float c, float d) { unsigned w = 0u; w = __builtin_amdgcn_cvt_pk_fp8_f32(a, b, w, false); w = __builtin_amdgcn_cvt_pk_fp8_f32(c, d, w, true); return w; }
struct EpiGateUp8 {
    static constexpr bool PERM = true;
    unsigned char* O; const float* bgu;
    __device__ __forceinline__ void operator()(const f32x4 (&acc)[2][2][4][2], const Unit& u, int wr, int wc, int fr, int fq) const {
        const int e = u.pn >> 3, pl = u.pn & 7;
        const int row0 = u.pm * BM + wr * 64 + fr; const int cl = pl * 128 + wc * 32 + 8 * fq;
        const float* bg = bgu + (size_t)e * 2048 + cl; const float* bu = bg + 1024;
        f32x4 g0 = *(const f32x4*)bg, g1 = *(const f32x4*)(bg + 4), u0 = *(const f32x4*)bu, u1 = *(const f32x4*)(bu + 4);
#pragma unroll
        for (int ai = 0; ai < 2; ++ai)
#pragma unroll
            for (int m = 0; m < 4; ++m) { unsigned char* rowp = O + (size_t)(row0 + ai * HALF + m * 16) * DFF + cl;
                float r[8];
#pragma unroll
                for (int n = 0; n < 2; ++n) { const f32x4 gb = n ? g1 : g0, ub = n ? u1 : u0; const f32x4 ga = acc[ai][0][m][n] * 0.015625f + gb, ua = acc[ai][1][m][n] * 0.015625f + ub;
#pragma unroll
                    for (int j = 0; j < 4; ++j) { const float gate = fminf(ga[j], 7.0f), up = fminf(fmaxf(ua[j], -7.0f), 7.0f);
                        r[n * 4 + j] = gate * __builtin_amdgcn_rcpf(1.0f + __expf(-1.702f * gate)) * (up + 1.0f); } }
                u32x2 w; w.x = pk4_fp8(r[0], r[1], r[2], r[3]); w.y = pk4_fp8(r[4], r[5], r[6], r[7]);
                *(u32x2*)rowp = w; }
    }
};
struct EpiDown8 {
    static constexpr bool PERM = true;
    unsigned char* O; const float* bdn;
    __device__ __forceinline__ void operator()(const f32x4 (&acc)[2][2][4][2], const Unit& u, int wr, int wc, int fr, int fq) const {
        const int e = u.pn >> 2, pl = u.pn & 3;
        const int row0 = u.pm * BM + wr * 64 + fr; const int col0 = pl * BM + wc * 32 + 8 * fq;
        f32x4 bv[2][2];
#pragma unroll
        for (int bj = 0; bj < 2; ++bj)
#pragma unroll
            for (int n = 0; n < 2; ++n) bv[bj][n] = *(const f32x4*)(bdn + (size_t)e * 1024 + col0 + bj * HALF + 4 * n);
#pragma unroll
        for (int ai = 0; ai < 2; ++ai)
#pragma unroll
            for (int m = 0; m < 4; ++m) { unsigned char* rowp = O + (size_t)(row0 + ai * HALF + m * 16) * D + col0;
#pragma unroll
                for (int bj = 0; bj < 2; ++bj) { const f32x4 v0 = acc[ai][bj][m][0] * 0.015625f + bv[bj][0], v1 = acc[ai][bj][m][1] * 0.015625f + bv[bj][1];
                    u32x2 w; w.x = pk4_fp8(v0[0], v0[1], v0[2], v0[3]); w.y = pk4_fp8(v1[0], v1[1], v1[2], v1[3]);
                    *(u32x2*)(rowp + bj * HALF) = w; } }
    }
};

typedef int i32x8 __attribute__((ext_vector_type(8)));
typedef int i32x4 __attribute__((ext_vector_type(4)));
__device__ __forceinline__ i32x8 cat8(const bf16x8 lo, const bf16x8 hi) { const i32x4 a = __builtin_bit_cast(i32x4, lo), b = __builtin_bit_cast(i32x4, hi); return __builtin_shufflevector(a, b, 0, 1, 2, 3, 4, 5, 6, 7); }
template <class Epi, class Sched, bool ALIGN_EPI = true, bool SP2 = true, bool F8 = false>
__device__ __forceinline__ void gemm_phase(LAS unsigned char* lds, const Gemm g, const Sched& S, const Epi& E, const int tid) {
    const int wid = __builtin_amdgcn_readfirstlane(tid >> 6), lane = tid & 63, wr = wid >> 2, wc = wid & 3, fr = lane & 15, fq = lane >> 4;
    const int K = g.K, nt = K / BK;
    unsigned voffA[2], voffB[2];
#pragma unroll
    for (int i = 0; i < 2; ++i) { int R, C; stage_rc(tid * 16 + i * 8192, R, C); const int Rb = Epi::PERM ? ((R & ~31) + perm32(R & 31)) : R;
        voffA[i] = (unsigned)(R * K + C) * 2u; voffB[i] = (unsigned)(Rb * K + C) * 2u; }
    const size_t kstep = (size_t)(BK * 2);
    const size_t hstep = (size_t)HALF * K * 2;
    const size_t tstep = 2 * hstep;
    const unsigned ldsw = (unsigned)wid * 1024u;
    const int aoff = lds_byte(wr * 64 + fr, fq * 8), boff = lds_byte(wc * 32 + fr, fq * 8);
#define PG8_SA(b, h) (((b) * 2 + (h)) * HTB)
#define PG8_SB(b, h) ((4 + (b) * 2 + (h)) * HTB)
#define PG8_STAGE(bufoff, gbase, voff) do { _Pragma("unroll") for (int _i = 0; _i < 2; ++_i) \
        __builtin_amdgcn_global_load_lds((const unsigned*)((const char*)(gbase) + (voff)[_i]), (LAS unsigned*)(lds + (bufoff) + ldsw + _i * 8192), 16, 0, 0); } while (0)
#define PG8_LDA(dst, b, h) do { _Pragma("unroll") for (int m = 0; m < 4; ++m) { if constexpr (F8) dst##8[m] = cat8(*(const LAS bf16x8*)(lds + PG8_SA(b, h) + aoff + m * 2048), *(const LAS bf16x8*)(lds + PG8_SA(b, h) + aoff + m * 2048 + 1024)); \
        else { _Pragma("unroll") for (int k = 0; k < 2; ++k) dst[m][k] = *(const LAS bf16x8*)(lds + PG8_SA(b, h) + aoff + m * 2048 + k * 1024); } } } while (0)
#define PG8_LDB(dst, b, h) do { _Pragma("unroll") for (int n = 0; n < 2; ++n) { if constexpr (F8) dst##8[n] = cat8(*(const LAS bf16x8*)(lds + PG8_SB(b, h) + boff + n * 2048), *(const LAS bf16x8*)(lds + PG8_SB(b, h) + boff + n * 2048 + 1024)); \
        else { _Pragma("unroll") for (int k = 0; k < 2; ++k) dst[n][k] = *(const LAS bf16x8*)(lds + PG8_SB(b, h) + boff + n * 2048 + k * 1024); } } } while (0)
#define PG8_MMA(ai, bj, At, Bt) do { __builtin_amdgcn_s_setprio(1); \
        if constexpr (F8) { _Pragma("unroll") for (int m = 0; m < 4; ++m) _Pragma("unroll") for (int n = 0; n < 2; ++n) \
            acc[ai][bj][m][n] = __builtin_amdgcn_mfma_scale_f32_16x16x128_f8f6f4(Bt##8[n], At##8[m], acc[ai][bj][m][n], 0, 0, 0, 0x7f7f7f7f, 0, 0x7f7f7f7f); \
            _Pragma("unroll") for (int m = 0; m < 4; ++m) _Pragma("unroll") for (int n = 0; n < 2; ++n) asm volatile("" : "+v"(acc[ai][bj][m][n])); } \
        else { _Pragma("unroll") for (int m = 0; m < 4; ++m) _Pragma("unroll") for (int n = 0; n < 2; ++n) _Pragma("unroll") for (int k = 0; k < 2; ++k) \
            acc[ai][bj][m][n] = __builtin_amdgcn_mfma_f32_16x16x32_bf16(Bt[n][k], At[m][k], acc[ai][bj][m][n], 0, 0, 0); } \
        __builtin_amdgcn_s_setprio(0); } while (0)
#define PG8_WAIT_V(n) asm volatile("s_waitcnt vmcnt(" #n ")" ::: "memory")
#define PG8_WAIT_L(n) asm volatile("s_waitcnt lgkmcnt(" #n ")" ::: "memory")
#define PG8_BAR __builtin_amdgcn_s_barrier()
#define PG8_SCHED __builtin_amdgcn_sched_barrier(0)
    Unit cur, nxt; int ui = 0;
    if (!S.next(0, cur)) return;
    f32x4 acc[2][2][4][2];
#pragma unroll
    for (int a = 0; a < 2; ++a)
#pragma unroll
        for (int b = 0; b < 2; ++b)
#pragma unroll
            for (int m = 0; m < 4; ++m)
#pragma unroll
                for (int n = 0; n < 2; ++n) acc[a][b][m][n] = (f32x4){0.f, 0.f, 0.f, 0.f};
    bf16x8 At[4][2], B0[2][2], B1[2][2]; i32x8 At8[4], B08[2], B18[2];
    const char* cA = (const char*)g.A + (size_t)cur.pm * tstep; const char* cB = (const char*)g.Bt + (size_t)cur.pn * tstep;
    if constexpr (SP2) {
        PG8_STAGE(PG8_SB(0, 0), cB, voffB); PG8_STAGE(PG8_SB(0, 1), cB + hstep, voffB); PG8_STAGE(PG8_SA(0, 0), cA, voffA); PG8_STAGE(PG8_SA(0, 1), cA + hstep, voffA);
        if (wr == 1) PG8_BAR;
        PG8_WAIT_V(2); PG8_BAR;
        PG8_STAGE(PG8_SB(1, 0), cB + kstep, voffB); PG8_STAGE(PG8_SA(1, 0), cA + kstep, voffA); PG8_STAGE(PG8_SB(1, 1), cB + hstep + kstep, voffB);
        PG8_WAIT_V(6); PG8_BAR;
    } else {
        PG8_STAGE(PG8_SB(0, 0), cB, voffB); PG8_STAGE(PG8_SA(0, 0), cA, voffA); PG8_STAGE(PG8_SB(0, 1), cB + hstep, voffB); PG8_STAGE(PG8_SA(0, 1), cA + hstep, voffA);
        if (wr == 1) PG8_BAR;
        PG8_WAIT_V(4); PG8_BAR;
        PG8_STAGE(PG8_SB(1, 0), cB + kstep, voffB); PG8_STAGE(PG8_SA(1, 0), cA + kstep, voffA); PG8_STAGE(PG8_SB(1, 1), cB + hstep + kstep, voffB);
        PG8_WAIT_V(6); PG8_BAR;
    }
    for (;;) {
        const bool has_next = S.next(ui + 1, nxt);
        const char* nA = has_next ? (const char*)g.A + (size_t)nxt.pm * tstep : cA; const char* nB = has_next ? (const char*)g.Bt + (size_t)nxt.pn * tstep : cB;
        for (int t = 0; t < nt; t += 2) {
            const bool last = (t == nt - 2);
            const char* a1 = cA + (size_t)(t + 1) * kstep;
            const char* a2 = last ? nA : cA + (size_t)(t + 2) * kstep; const char* b2 = last ? nB : cB + (size_t)(t + 2) * kstep;
            const char* a3 = a2 + kstep; const char* b3 = b2 + kstep;
            if constexpr (SP2) {
            PG8_LDB(B0, 0, 0); PG8_LDB(B1, 0, 1); PG8_SCHED; PG8_LDA(At, 0, 0); PG8_STAGE(PG8_SA(1, 1), a1 + hstep, voffA);
            PG8_WAIT_V(8); PG8_WAIT_L(0); PG8_BAR; PG8_MMA(0, 0, At, B0); PG8_MMA(0, 1, At, B1); PG8_BAR; PG8_SCHED;
            PG8_LDA(At, 0, 1); PG8_STAGE(PG8_SB(0, 0), b2, voffB); PG8_STAGE(PG8_SB(0, 1), b2 + hstep, voffB); PG8_STAGE(PG8_SA(0, 0), a2, voffA);
            PG8_WAIT_V(8); PG8_WAIT_L(0); PG8_BAR; PG8_MMA(1, 0, At, B0); PG8_MMA(1, 1, At, B1); PG8_BAR; PG8_SCHED;
            PG8_LDB(B0, 1, 0); PG8_LDB(B1, 1, 1); PG8_SCHED; PG8_LDA(At, 1, 0); PG8_STAGE(PG8_SA(0, 1), a2 + hstep, voffA);
            PG8_WAIT_V(8); PG8_WAIT_L(0); PG8_BAR; PG8_MMA(0, 0, At, B0); PG8_MMA(0, 1, At, B1); PG8_BAR; PG8_SCHED;
            PG8_LDA(At, 1, 1); PG8_STAGE(PG8_SB(1, 0), b3, voffB); PG8_STAGE(PG8_SB(1, 1), b3 + hstep, voffB); PG8_STAGE(PG8_SA(1, 0), a3, voffA);
            PG8_WAIT_V(8); PG8_WAIT_L(0); PG8_BAR; PG8_MMA(1, 0, At, B0); PG8_MMA(1, 1, At, B1); PG8_BAR; PG8_SCHED;
            } else {
            PG8_LDB(B0, 0, 0); PG8_SCHED; PG8_LDA(At, 0, 0); PG8_STAGE(PG8_SA(1, 1), a1 + hstep, voffA);
            PG8_WAIT_L(8); PG8_BAR; PG8_WAIT_L(0); PG8_MMA(0, 0, At, B0); PG8_BAR; PG8_SCHED;
            PG8_LDB(B1, 0, 1); PG8_STAGE(PG8_SB(0, 0), b2, voffB);
            PG8_BAR; PG8_WAIT_L(0); PG8_MMA(0, 1, At, B1); PG8_BAR;
            PG8_LDA(At, 0, 1); PG8_STAGE(PG8_SA(0, 0), a2, voffA);
            PG8_BAR; PG8_WAIT_L(0); PG8_MMA(1, 0, At, B0); PG8_BAR; PG8_SCHED;
            PG8_STAGE(PG8_SB(0, 1), b2 + hstep, voffB);
            PG8_WAIT_V(6); PG8_BAR; PG8_MMA(1, 1, At, B1); PG8_BAR;
            PG8_LDB(B0, 1, 0); PG8_SCHED; PG8_LDA(At, 1, 0); PG8_STAGE(PG8_SA(0, 1), a2 + hstep, voffA);
            PG8_WAIT_L(8); PG8_BAR; PG8_WAIT_L(0); PG8_MMA(0, 0, At, B0); PG8_BAR; PG8_SCHED;
            PG8_LDB(B1, 1, 1); PG8_STAGE(PG8_SB(1, 0), b3, voffB);
            PG8_BAR; PG8_WAIT_L(0); PG8_MMA(0, 1, At, B1); PG8_BAR;
            PG8_LDA(At, 1, 1); PG8_STAGE(PG8_SA(1, 0), a3, voffA);
            PG8_BAR; PG8_WAIT_L(0); PG8_MMA(1, 0, At, B0); PG8_BAR; PG8_SCHED;
            PG8_STAGE(PG8_SB(1, 1), b3 + hstep, voffB);
            PG8_WAIT_V(6); PG8_BAR; PG8_MMA(1, 1, At, B1); PG8_BAR;
            }
        }
        if constexpr (ALIGN_EPI) { if (wr == 0) PG8_BAR; }
        E(acc, cur, wr, wc, fr, fq);
        if (!has_next) break;
#pragma unroll
        for (int a = 0; a < 2; ++a)
#pragma unroll
            for (int b = 0; b < 2; ++b)
#pragma unroll
                for (int m = 0; m < 4; ++m)
#pragma unroll
                    for (int n = 0; n < 2; ++n) acc[a][b][m][n] = (f32x4){0.f, 0.f, 0.f, 0.f};
        cur = nxt; cA = nA; cB = nB; ++ui;
        if constexpr (ALIGN_EPI) { if (wr == 1) PG8_BAR; }
    }
    PG8_WAIT_V(0);
    if constexpr (!ALIGN_EPI) { if (wr == 0) PG8_BAR; }
    PG8_BAR;
#undef PG8_SA
#undef PG8_SB
#undef PG8_STAGE
#undef PG8_LDA
#undef PG8_LDB
#undef PG8_MMA
#undef PG8_WAIT_V
#undef PG8_WAIT_L
#undef PG8_BAR
#undef PG8_SCHED
}

template <class Epi, class Sched, bool F8 = false>
__device__ __forceinline__ void gemm_phase_gather(LAS unsigned char* lds, const Gemm g, const int* list, const Sched& S, const Epi& E, const int tid) {
    const int wid = __builtin_amdgcn_readfirstlane(tid >> 6), lane = tid & 63, wr = wid >> 2, wc = wid & 3, fr = lane & 15, fq = lane >> 4;
    const int K = g.K, nt = K / BK;
    unsigned voffB0, cA2;
    { int R, C; stage_rc(tid * 16, R, C); const int Rb = Epi::PERM ? ((R & ~31) + perm32(R & 31)) : R; cA2 = (unsigned)C * 2u; voffB0 = (unsigned)(Rb * K + C) * 2u; }
    const unsigned voffB[2] = {voffB0, voffB0 + (unsigned)(64 * K * 2)};
    const size_t kstep = (size_t)(BK * 2);
    const size_t hstep = (size_t)HALF * K * 2;
    const size_t tstep = 2 * hstep;
    const unsigned ldsw = (unsigned)wid * 1024u;
    const int aoff = lds_byte(wr * 64 + fr, fq * 8), boff = lds_byte(wc * 32 + fr, fq * 8);
#define PG8_SA(b, h) (((b) * 2 + (h)) * HTB)
#define PG8_SB(b, h) ((4 + (b) * 2 + (h)) * HTB)
#define PG8_STAGE(bufoff, gbase, voff) do { _Pragma("unroll") for (int _i = 0; _i < 2; ++_i) \
        __builtin_amdgcn_global_load_lds((const unsigned*)((const char*)(gbase) + (voff)[_i]), (LAS unsigned*)(lds + (bufoff) + ldsw + _i * 8192), 16, 0, 0); } while (0)
#define PG8_LDA(dst, b, h) do { _Pragma("unroll") for (int m = 0; m < 4; ++m) { if constexpr (F8) dst##8[m] = cat8(*(const LAS bf16x8*)(lds + PG8_SA(b, h) + aoff + m * 2048), *(const LAS bf16x8*)(lds + PG8_SA(b, h) + aoff + m * 2048 + 1024)); \
        else { _Pragma("unroll") for (int k = 0; k < 2; ++k) dst[m][k] = *(const LAS bf16x8*)(lds + PG8_SA(b, h) + aoff + m * 2048 + k * 1024); } } } while (0)
#define PG8_LDB(dst, b, h) do { _Pragma("unroll") for (int n = 0; n < 2; ++n) { if constexpr (F8) dst##8[n] = cat8(*(const LAS bf16x8*)(lds + PG8_SB(b, h) + boff + n * 2048), *(const LAS bf16x8*)(lds + PG8_SB(b, h) + boff + n * 2048 + 1024)); \
        else { _Pragma("unroll") for (int k = 0; k < 2; ++k) dst[n][k] = *(const LAS bf16x8*)(lds + PG8_SB(b, h) + boff + n * 2048 + k * 1024); } } } while (0)
#define PG8_MMA(ai, bj, At, Bt) do { __builtin_amdgcn_s_setprio(1); \
        if constexpr (F8) { _Pragma("unroll") for (int m = 0; m < 4; ++m) _Pragma("unroll") for (int n = 0; n < 2; ++n) \
            acc[ai][bj][m][n] = __builtin_amdgcn_mfma_scale_f32_16x16x128_f8f6f4(Bt##8[n], At##8[m], acc[ai][bj][m][n], 0, 0, 0, 0x7f7f7f7f, 0, 0x7f7f7f7f); \
            _Pragma("unroll") for (int m = 0; m < 4; ++m) _Pragma("unroll") for (int n = 0; n < 2; ++n) asm volatile("" : "+v"(acc[ai][bj][m][n])); } \
        else { _Pragma("unroll") for (int m = 0; m < 4; ++m) _Pragma("unroll") for (int n = 0; n < 2; ++n) _Pragma("unroll") for (int k = 0; k < 2; ++k) \
            acc[ai][bj][m][n] = __builtin_amdgcn_mfma_f32_16x16x32_bf16(Bt[n][k], At[m][k], acc[ai][bj][m][n], 0, 0, 0); } \
        __builtin_amdgcn_s_setprio(0); } while (0)
#define PG8_WAIT_V(n) asm volatile("s_waitcnt vmcnt(" #n ")" ::: "memory")
#define PG8_WAIT_L(n) asm volatile("s_waitcnt lgkmcnt(" #n ")" ::: "memory")
#define PG8_BAR __builtin_amdgcn_s_barrier()
#define PG8_SCHED __builtin_amdgcn_sched_barrier(0)
#define PG8_LOADTOK(u, vo) do { int _ra0, _ra1, _c; stage_rc(tid * 16, _ra0, _c); stage_rc(tid * 16 + 8192, _ra1, _c); _Pragma("unroll") for (int _h = 0; _h < 2; ++_h) { const int _r0 = _h * HALF + _ra0, _r1 = _h * HALF + _ra1; \
        const unsigned _t0 = (_r0 < (u).nvalid) ? (unsigned)list[(u).lbase + _r0] : 0u, _t1 = (_r1 < (u).nvalid) ? (unsigned)list[(u).lbase + _r1] : 0u; (vo)[_h] = _t0 | (_t1 << 16); } } while (0)
#define PG8_STAGE_A(bufoff, gbase, pk) do { _Pragma("unroll") for (int _i = 0; _i < 2; ++_i) { const unsigned _off = (((pk) >> (16 * _i)) & 0xffffu) * (unsigned)(K * 2) + cA2; \
        __builtin_amdgcn_global_load_lds((const unsigned*)((const char*)(gbase) + _off), (LAS unsigned*)(lds + (bufoff) + ldsw + _i * 8192), 16, 0, 0); } } while (0)
    Unit cur, nxt; int ui = 0;
    if (!S.next(0, cur)) return;
    f32x4 acc[2][2][4][2];
#pragma unroll
    for (int a = 0; a < 2; ++a)
#pragma unroll
        for (int b = 0; b < 2; ++b)
#pragma unroll
            for (int m = 0; m < 4; ++m)
#pragma unroll
                for (int n = 0; n < 2; ++n) acc[a][b][m][n] = (f32x4){0.f, 0.f, 0.f, 0.f};
    bf16x8 At[4][2], B0[2][2], B1[2][2]; i32x8 At8[4], B08[2], B18[2];
    unsigned vc[2], vn[2];
    PG8_LOADTOK(cur, vc);
    const char* gA = (const char*)g.A; const char* cB = (const char*)g.Bt + (size_t)cur.pn * tstep;
    PG8_STAGE(PG8_SB(0, 0), cB, voffB); PG8_STAGE(PG8_SB(0, 1), cB + hstep, voffB); PG8_STAGE_A(PG8_SA(0, 0), gA, vc[0]); PG8_STAGE_A(PG8_SA(0, 1), gA, vc[1]);
    if (wr == 1) PG8_BAR;
    PG8_WAIT_V(2); PG8_BAR;
    PG8_STAGE(PG8_SB(1, 0), cB + kstep, voffB); PG8_STAGE_A(PG8_SA(1, 0), gA + kstep, vc[0]); PG8_STAGE(PG8_SB(1, 1), cB + hstep + kstep, voffB);
    PG8_WAIT_V(6); PG8_BAR;
    for (;;) {
        const bool has_next = S.next(ui + 1, nxt);
        if (has_next) { PG8_LOADTOK(nxt, vn); }
        const char* nB = has_next ? (const char*)g.Bt + (size_t)nxt.pn * tstep : cB;
        for (int t = 0; t < nt; t += 2) {
            const bool last = (t == nt - 2);
            const char* a1 = gA + (size_t)(t + 1) * kstep;
            const char* b2 = last ? nB : cB + (size_t)(t + 2) * kstep; const char* b3 = b2 + kstep;
            const char* a2 = last ? gA : gA + (size_t)(t + 2) * kstep; const char* a3 = a2 + kstep;
            PG8_LDB(B0, 0, 0); PG8_LDB(B1, 0, 1); PG8_SCHED; PG8_LDA(At, 0, 0); PG8_STAGE_A(PG8_SA(1, 1), a1, vc[1]);
            if (last && has_next) {
                vc[0] = vn[0]; vc[1] = vn[1]; }
            PG8_WAIT_V(8); PG8_WAIT_L(0); PG8_BAR; PG8_MMA(0, 0, At, B0); PG8_MMA(0, 1, At, B1); PG8_BAR; PG8_SCHED;
            PG8_LDA(At, 0, 1); PG8_STAGE(PG8_SB(0, 0), b2, voffB); PG8_STAGE(PG8_SB(0, 1), b2 + hstep, voffB); PG8_STAGE_A(PG8_SA(0, 0), a2, vc[0]);
            PG8_WAIT_V(8); PG8_WAIT_L(0); PG8_BAR; PG8_MMA(1, 0, At, B0); PG8_MMA(1, 1, At, B1); PG8_BAR; PG8_SCHED;
            PG8_LDB(B0, 1, 0); PG8_LDB(B1, 1, 1); PG8_SCHED; PG8_LDA(At, 1, 0); PG8_STAGE_A(PG8_SA(0, 1), a2, vc[1]);
            PG8_WAIT_V(8); PG8_WAIT_L(0); PG8_BAR; PG8_MMA(0, 0, At, B0); PG8_MMA(0, 1, At, B1); PG8_BAR; PG8_SCHED;
            PG8_LDA(At, 1, 1); PG8_STAGE(PG8_SB(1, 0), b3, voffB); PG8_STAGE(PG8_SB(1, 1), b3 + hstep, voffB); PG8_STAGE_A(PG8_SA(1, 0), a3, vc[0]);
            PG8_WAIT_V(8); PG8_WAIT_L(0); PG8_BAR; PG8_MMA(1, 0, At, B0); PG8_MMA(1, 1, At, B1); PG8_BAR; PG8_SCHED;
        }
        if (wr == 0) PG8_BAR;
        E(acc, cur, wr, wc, fr, fq);
        if (!has_next) break;
#pragma unroll
        for (int a = 0; a < 2; ++a)
#pragma unroll
            for (int b = 0; b < 2; ++b)
#pragma unroll
                for (int m = 0; m < 4; ++m)
#pragma unroll
                    for (int n = 0; n < 2; ++n) acc[a][b][m][n] = (f32x4){0.f, 0.f, 0.f, 0.f};
        cur = nxt; cB = nB; ++ui;
        if (wr == 1) PG8_BAR;
    }
    PG8_WAIT_V(0);
    PG8_BAR;
#undef PG8_SA
#undef PG8_SB
#undef PG8_STAGE
#undef PG8_LDA
#undef PG8_LDB
#undef PG8_MMA
#undef PG8_WAIT_V
#undef PG8_WAIT_L
#undef PG8_BAR
#undef PG8_SCHED
#undef PG8_STAGE_A
#undef PG8_LOADTOK
}
}

struct Params {
    const float* in[26];
    float* out;
    unsigned char* ws;
};
struct Frame {
    LAS unsigned char* lds;
    int tid, lane, wave, G, bid;
};

template <int MT, int NT>
__device__ __forceinline__ void mma_nt(f32x4 (&acc)[MT][NT], const LAS bf16_t* A, int lda, const LAS bf16_t* B, int ldb, int K, int fr, int fq) {
    for (int k0 = 0; k0 < K; k0 += 32) {
        bf16x8 a[MT], b[NT];
#pragma unroll
        for (int m = 0; m < MT; ++m) a[m] = *(const LAS bf16x8*)(A + (m * 16 + fr) * lda + k0 + fq * 8);
#pragma unroll
        for (int n = 0; n < NT; ++n) b[n] = *(const LAS bf16x8*)(B + (n * 16 + fr) * ldb + k0 + fq * 8);
#pragma unroll
        for (int m = 0; m < MT; ++m)
#pragma unroll
            for (int n = 0; n < NT; ++n) acc[m][n] = __builtin_amdgcn_mfma_f32_16x16x32_bf16(a[m], b[n], acc[m][n], 0, 0, 0);
    }
}
template <int MT, int NT> __device__ __forceinline__ void zero_acc(f32x4 (&acc)[MT][NT]) {
#pragma unroll
    for (int m = 0; m < MT; ++m)
#pragma unroll
        for (int n = 0; n < NT; ++n) acc[m][n] = (f32x4){0.f, 0.f, 0.f, 0.f};
}

constexpr int SK_A = 0, SK_B = 69632;
template <class Epi>
__device__ __forceinline__ void skinny_unit(const Frame& F, const bf16_t* A, const bf16_t* Bt, const Epi& E) {
    LAS bf16_t* As = (LAS bf16_t*)(F.lds + SK_A); LAS bf16_t* Bs = (LAS bf16_t*)(F.lds + SK_B);
    const int tid = F.tid, fr = F.lane & 15, fq = F.lane >> 4, w = F.wave;
    f32x4 acc[2][2]; zero_acc<2, 2>(acc);
    u32x4 av[8], bv;
#pragma unroll
    for (int i = 0; i < 8; ++i) { const int ch = tid + NTHREADS * i, r = ch >> 4, c8 = (ch & 15) * 8; av[i] = *(const u32x4*)(A + (size_t)r * D + c8); }
    { const int r = tid >> 4, c8 = (tid & 15) * 8; bv = *(const u32x4*)(Bt + (size_t)r * D + c8); }
    for (int kc = 0; kc < 8; ++kc) {
        __syncthreads();
#pragma unroll
        for (int i = 0; i < 8; ++i) { const int ch = tid + NTHREADS * i, r = ch >> 4, c8 = (ch & 15) * 8; *(LAS u32x4*)(As + r * 136 + c8) = av[i]; }
        { const int r = tid >> 4, c8 = (tid & 15) * 8; *(LAS u32x4*)(Bs + r * 136 + c8) = bv; }
        if (kc + 1 < 8) {
#pragma unroll
            for (int i = 0; i < 8; ++i) { const int ch = tid + NTHREADS * i, r = ch >> 4, c8 = (ch & 15) * 8; av[i] = *(const u32x4*)(A + (size_t)r * D + (kc + 1) * 128 + c8); }
            { const int r = tid >> 4, c8 = (tid & 15) * 8; bv = *(const u32x4*)(Bt + (size_t)r * D + (kc + 1) * 128 + c8); } }
        __syncthreads();
        mma_nt<2, 2>(acc, As + (32 * w) * 136, 136, Bs, 136, 128, fr, fq);
    }
#pragma unroll
    for (int mt = 0; mt < 2; ++mt)
#pragma unroll
        for (int nt = 0; nt < 2; ++nt)
#pragma unroll
            for (int j = 0; j < 4; ++j) E(32 * w + mt * 16 + fq * 4 + j, nt * 16 + fr, acc[mt][nt][j]);
    __syncthreads();
}
struct SkEpiBf16 { bf16_t* O; int ldc; __device__ __forceinline__ void operator()(int r, int c, float v) const { O[(size_t)r * ldc + c] = (bf16_t)f2bf(v); } };
struct SkEpiResid { float* X; const float* Xs; const float* gate; __device__ __forceinline__ void operator()(int r, int c, float v) const { X[(size_t)r * D + c] = Xs[(size_t)r * D + c] + gate[c] * v; } };

__device__ __forceinline__ void p0_transpose_item(const float* W, int K, int N, bf16_t* WT, int k0, int n0, int orow0, LAS float* scr, int lane) {
    float tv[32];
#pragma unroll
    for (int i = 0; i < 32; ++i) { const int kk = 2 * i + (lane >> 5); tv[i] = W[(size_t)(k0 + kk) * N + n0 + (lane & 31)]; }
#pragma unroll
    for (int i = 0; i < 32; ++i) { const int kk = 2 * i + (lane >> 5); scr[kk * 33 + (lane & 31)] = tv[i]; }
    asm volatile("s_waitcnt lgkmcnt(0)" ::: "memory");
    const int c = lane & 7;
#pragma unroll
    for (int j = 0; j < 4; ++j) { const int n = (lane >> 3) + 8 * j; const LAS float* s = scr + (8 * c) * 33 + n;
        u32x4 o; o.x = pk2(s[0 * 33], s[1 * 33]); o.y = pk2(s[2 * 33], s[3 * 33]); o.z = pk2(s[4 * 33], s[5 * 33]); o.w = pk2(s[6 * 33], s[7 * 33]);
        *(u32x4*)(WT + (size_t)(orow0 + n) * K + k0 + 8 * c) = o; }
    asm volatile("s_waitcnt lgkmcnt(0)" ::: "memory");
}

using pg8::pk4_fp8;
__device__ __forceinline__ void p0_transpose_item8(const float* W, int K, int N, unsigned char* WT8, int k0, int n0, int orow0, LAS float* scr, int lane) {
    float tv[32];
#pragma unroll
    for (int i = 0; i < 32; ++i) { const int kk = 2 * i + (lane >> 5); tv[i] = W[(size_t)(k0 + kk) * N + n0 + (lane & 31)]; }
#pragma unroll
    for (int i = 0; i < 32; ++i) { const int kk = 2 * i + (lane >> 5); scr[kk * 33 + (lane & 31)] = tv[i]; }
    asm volatile("s_waitcnt lgkmcnt(0)" ::: "memory");
    const int c = lane & 3;
#pragma unroll
    for (int j = 0; j < 2; ++j) { const int n = (lane >> 2) + 16 * j; const LAS float* sp = scr + (16 * c) * 33 + n;
        u32x4 o; o.x = pk4_fp8(64.f * sp[0 * 33], 64.f * sp[1 * 33], 64.f * sp[2 * 33], 64.f * sp[3 * 33]); o.y = pk4_fp8(64.f * sp[4 * 33], 64.f * sp[5 * 33], 64.f * sp[6 * 33], 64.f * sp[7 * 33]);
        o.z = pk4_fp8(64.f * sp[8 * 33], 64.f * sp[9 * 33], 64.f * sp[10 * 33], 64.f * sp[11 * 33]); o.w = pk4_fp8(64.f * sp[12 * 33], 64.f * sp[13 * 33], 64.f * sp[14 * 33], 64.f * sp[15 * 33]);
        *(u32x4*)(WT8 + (size_t)(orow0 + n) * K + k0 + 16 * c) = o; }
    asm volatile("s_waitcnt lgkmcnt(0)" ::: "memory");
}

constexpr int WT_I_IN = 16 * 73, WT_I_OUT = 16 * 32, WT_I_GU = 16 * 64, WT_I_DN = 16 * 32;
constexpr int WT_PER_LAYER = WT_I_IN + WT_I_OUT + NE * WT_I_GU + NE * WT_I_DN;
constexpr int WT_DEF0_LO = WT_PER_LAYER + WT_I_IN + WT_I_OUT + NE * WT_I_GU, WT_DEF0_HI = 2 * WT_PER_LAYER;
constexpr int WT_DEF1_LO = WT_PER_LAYER + WT_I_IN + WT_I_OUT, WT_DEF1_HI = WT_DEF1_LO + 16 * WT_I_GU;
__device__ __forceinline__ void weight_item(const Params& P, int it, LAS float* scr, int lane) {
    unsigned char* ws = P.ws;
    const int l = it / WT_PER_LAYER; int r = it % WT_PER_LAYER;
    if (r < WT_I_IN) { const int kb = r / 73, nb = r % 73;
        if (nb == 56) p0_transpose_item(P.in[8] + (size_t)l * D * INW, D, INW, (bf16_t*)(ws + WS_WGT) + (size_t)l * 32 * D, 64 * kb, 32 * nb, 0, scr, lane);
        else p0_transpose_item(P.in[8] + (size_t)l * D * INW, D, INW, (bf16_t*)(ws + WS_WIN) + (size_t)l * INP * D, 64 * kb, 32 * nb, nb < 56 ? 32 * nb : 32 * (nb - 1), scr, lane);
        return; }
    r -= WT_I_IN;
    if (r < WT_I_OUT) { const int kb = r / 32, nb = r % 32;
        p0_transpose_item(P.in[18] + (size_t)l * D * D, D, D, (bf16_t*)(ws + WS_WOUT) + (size_t)l * D * D, 64 * kb, 32 * nb, 32 * nb, scr, lane); return; }
    r -= WT_I_OUT;
    if (r < NE * WT_I_GU) { const int e = r / WT_I_GU, q = r % WT_I_GU, kb = q / 64, nb = q % 64; const int n0 = 32 * nb;
        const int j = n0 & 1023, orow = 256 * (j >> 7) + (n0 >= 1024 ? 128 : 0) + (j & 127);
        if (F8_LAYER[l]) p0_transpose_item8(P.in[21] + ((size_t)l * NE + e) * D * 2048, D, 2048, ws + WS_WGU + (size_t)l * NE * 2048 * D * 2 + (size_t)e * 2048 * D, 64 * kb, n0, orow, scr, lane);
        else p0_transpose_item(P.in[21] + ((size_t)l * NE + e) * D * 2048, D, 2048, (bf16_t*)(ws + WS_WGU) + ((size_t)l * NE + e) * 2048 * D, 64 * kb, n0, orow, scr, lane);
        return; }
    r -= NE * WT_I_GU;
    { const int e = r / WT_I_DN, q = r % WT_I_DN, kb = q / 32, nb = q % 32;
        if (F8_LAYER[l]) p0_transpose_item8(P.in[23] + ((size_t)l * NE + e) * DFF * D, DFF, D, ws + WS_WDN + (size_t)l * NE * D * DFF * 2 + (size_t)e * D * DFF, 64 * kb, 32 * nb, 32 * nb, scr, lane);
        else p0_transpose_item(P.in[23] + ((size_t)l * NE + e) * DFF * D, DFF, D, (bf16_t*)(ws + WS_WDN) + ((size_t)l * NE + e) * D * DFF, 64 * kb, 32 * nb, 32 * nb, scr, lane); }
}

__device__ __forceinline__ void phase_prologue(const Frame& F, const Params& P) {
    unsigned char* ws = P.ws;
    LAS float* scr = (LAS float*)(F.lds + F.wave * 16384);
    const int gw = F.bid * NWAVES + F.wave, NGW = F.G * NWAVES;
    for (int it = gw; it < DEPTH * WT_PER_LAYER; it += NGW) {
        if ((it >= WT_DEF0_LO && it < WT_DEF0_HI) || (it >= WT_DEF1_LO && it < WT_DEF1_HI)) continue;
        weight_item(P, it, scr, F.lane);
    }
    {
        const int gt = F.bid * NTHREADS + F.tid, NGT = F.G * NTHREADS;
        bf16_t* cm3 = (bf16_t*)(ws + WS_CM3);
        for (int i = gt; i < 192 * 64; i += NGT) { const int m = i >> 6, n2 = i & 63, part = m >> 6, k2 = m & 63; const int ph = (k2 * n2) & 63;
            float s, c; sincospif((float)ph * (1.0f / 32.0f), &s, &c); const float v = part == 0 ? c : (part == 1 ? -s : -c); cm3[i] = (bf16_t)f2bf(v); }
        bf16_t* rwt = (bf16_t*)(ws + WS_RW);
        for (int i = gt; i < DEPTH * NE * D; i += NGT) { const int l = i / (NE * D), q = i % (NE * D), k = q >> 5, e = q & 31;
            const float w = P.in[19][(size_t)l * D * NE + q]; const unsigned hi = f2bf(w); const unsigned lo = f2bf(w - bf2f(hi));
            rwt[((size_t)l * 2 + 0) * NE * D + e * D + k] = (bf16_t)hi; rwt[((size_t)l * 2 + 1) * NE * D + e * D + k] = (bf16_t)lo; }
        bf16_t* tf2 = (bf16_t*)(ws + WS_TF2);
        for (int i = gt; i < 128 * 128; i += NGT) { const int c_ = i >> 7, n = i & 127; const int ph = (c_ * n) & 127;
            float s, c; sincospif((float)ph * (1.0f / 64.0f), &s, &c); tf2[i] = (bf16_t)f2bf(c); tf2[128 * 128 + i] = (bf16_t)f2bf(s); }
        bf16_t* tctx = (bf16_t*)(ws + WS_TCTX);
        for (int i = gt; i < 256 * 256; i += NGT) { const int k1 = i >> 8, n = i & 255; const int ph = (k1 * n) & 255;
            float s, c; sincospif((float)ph * (1.0f / 128.0f), &s, &c); tctx[i] = (bf16_t)f2bf(c); tctx[256 * 256 + i] = (bf16_t)f2bf(s); }
        bf16_t* tlat = (bf16_t*)(ws + WS_TLAT);
        for (int i = gt; i < 128 * 128 * 128; i += NGT) { const int nlo = i >> 14, d = (i >> 7) & 127, a = i & 127; const int ph = (d * (nlo + 128 * a)) & 16383;
            float s, c; sincospif((float)ph * (1.0f / 8192.0f), &s, &c);
            tlat[(size_t)nlo * 32768 + d * 128 + a] = (bf16_t)f2bf(c); tlat[(size_t)nlo * 32768 + 16384 + d * 128 + a] = (bf16_t)f2bf(s); }
    }
    for (int it = gw; it < DEPTH * 24 * 8; it += NGW) {
        const int l = it / 192, q = it % 192, cb = q >> 3, ks = q & 7;
        const float* wm = P.in[6] + (size_t)l * D * 6144 + (size_t)(ks * 128) * 6144 + cb * 256 + 4 * F.lane;
        f32x4 a0 = {0.f, 0.f, 0.f, 0.f}, a1 = a0, a2 = a0;
#pragma unroll 4
        for (int k = 0; k < 128; ++k) { const int kk = ks * 128 + k;
            const float c0 = P.in[1][kk], c1 = P.in[1][D + kk], c2 = P.in[3][kk];
            const float s0 = c0 * sigmoidf_(c0), s1 = c1 * sigmoidf_(c1), s2 = c2 * sigmoidf_(c2);
            const f32x4 w = *(const f32x4*)(wm + (size_t)k * 6144);
            a0 += w * s0; a1 += w * s1; a2 += w * s2; }
        float* mp = (float*)(ws + WS_MODP) + ((size_t)(l * 8 + ks) * 3) * 6144 + cb * 256 + 4 * F.lane;
        *(f32x4*)(mp) = a0; *(f32x4*)(mp + 6144) = a1; *(f32x4*)(mp + 2 * 6144) = a2;
    }
}

__device__ __forceinline__ f32x4 mod_from_partials(const Params& P, int l, int v, int c4) {
    f32x4 s = *(const f32x4*)(P.in[7] + (size_t)l * 6144 + c4);
    const float* mp = (const float*)(P.ws + WS_MODP) + ((size_t)(l * 8) * 3 + v) * 6144 + c4;
#pragma unroll
    for (int ks = 0; ks < 8; ++ks) s += *(const f32x4*)(mp + (size_t)ks * 3 * 6144);
    return s;
}

__device__ __forceinline__ void norm_row_store(const f32x4 (&x)[4], const float* g, const f32x4 (&shv)[4], const f32x4 (&scv)[4], bf16_t* orow, int lane) {
    float ss = 0.f;
#pragma unroll
    for (int j = 0; j < 4; ++j) ss += (x[j].x * x[j].x + x[j].y * x[j].y) + (x[j].z * x[j].z + x[j].w * x[j].w);
    const float rstd = 1.0f / sqrtf(wave_sum(ss) * (1.0f / D) + NORM_EPS);
#pragma unroll
    for (int j = 0; j < 4; ++j) { const int c = 4 * lane + 256 * j;
        const f32x4 gv = *(const f32x4*)(g + c);
        const f32x4 y = (x[j] * rstd) * gv * (scv[j] + 1.0f) + shv[j];
        u32x2 o; o.x = pk2(y.x, y.y); o.y = pk2(y.z, y.w);
        *(u32x2*)(orow + c) = o; }
}

__device__ __forceinline__ void phase_p1(const Frame& F, const Params& P) {
    unsigned char* ws = P.ws;
    const int gt = F.bid * NTHREADS + F.tid, NGT = F.G * NTHREADS;
    float* modf = (float*)(ws + WS_MODF);
    for (int i = gt; i < DEPTH * 3 * 1536; i += NGT) { const int l = i / 4608, q = i % 4608, v = q / 1536, c4 = (q % 1536) * 4;
        *(f32x4*)(modf + ((size_t)l * 3 + v) * 6144 + c4) = mod_from_partials(P, l, v, c4); }
    const int gw = F.bid * NWAVES + F.wave, NGW = F.G * NWAVES;
    bf16_t* hb = (bf16_t*)(ws + WS_HBUF);
    int cur_v = -1; f32x4 shv[4], scv[4], xn[4];
    auto rowp = [&](int m) { return (m < NLAT) ? (P.in[0] + (size_t)m * D) : (P.in[2] + (size_t)(m - NLAT) * D); };
    if (gw < NTOK) {
#pragma unroll
        for (int j = 0; j < 4; ++j) xn[j] = *(const f32x4*)(rowp(gw) + 4 * F.lane + 256 * j); }
    for (int m = gw; m < NTOK; m += NGW) {
        const int v = (m >= NLAT) ? 2 : (m >= SEQ ? 1 : 0);
        f32x4 x[4];
#pragma unroll
        for (int j = 0; j < 4; ++j) x[j] = xn[j];
        if (m + NGW < NTOK) {
#pragma unroll
            for (int j = 0; j < 4; ++j) xn[j] = *(const f32x4*)(rowp(m + NGW) + 4 * F.lane + 256 * j); }
        if (v != cur_v) { cur_v = v;
#pragma unroll
            for (int j = 0; j < 4; ++j) { const int c = 4 * F.lane + 256 * j; shv[j] = mod_from_partials(P, 0, v, c); scv[j] = mod_from_partials(P, 0, v, 1024 + c); } }
        norm_row_store(x, P.in[4], shv, scv, hb + (size_t)m * D, F.lane);
    }
}

constexpr int GL_GT = 0;
constexpr int GL_A1 = 34816, GL_KE = 60416, GL_VTB = 78848, GL_RS = 97280, GL_RT = 97792;
constexpr int GL_KDT = 34816, GL_VT = 53248;

__device__ __forceinline__ float logsigmoidf_(float x) { return fminf(x, 0.f) - __logf(1.0f + __expf(-fabsf(x))); }
__device__ __forceinline__ float bfel(const u32x4& v, int j) { const unsigned w = (j < 2) ? v.x : (j < 4 ? v.y : (j < 6 ? v.z : v.w)); return (j & 1) ? bfhi(w) : bflo(w); }
__device__ __forceinline__ unsigned short bfraw(const u32x4& v, int j) { const unsigned w = (j < 2) ? v.x : (j < 4 ? v.y : (j < 6 ? v.z : v.w)); return (unsigned short)((j & 1) ? (w >> 16) : (w & 0xffffu)); }

struct GateRegs { bf16x8 a[4]; bf16x8 b; float bg; };
__device__ __forceinline__ GateRegs gla_load_gate_regs(const Frame& F, const Params& P, int l, int row0, int h) {
    GateRegs g;
    const int dir = F.wave >> 2, dbase = (F.wave & 3) * 16, fr = F.lane & 15, fq = F.lane >> 4;
    const bf16x8 z8 = {0, 0, 0, 0, 0, 0, 0, 0};
    const bf16_t* lrb = (const bf16_t*)(P.ws + WS_LRB);
#pragma unroll
    for (int mt = 0; mt < 4; ++mt) g.a[mt] = (fq < 2) ? *(const bf16x8*)(lrb + (size_t)(row0 + mt * 16 + fr) * 32 + dir * 16 + fq * 8) : z8;
    const float* wgp = (dir ? P.in[11] : P.in[9]) + (size_t)l * 16 * 256 + 64 * h + dbase + fr;
    g.b = z8;
    if (fq < 2) {
#pragma unroll
        for (int j = 0; j < 8; ++j) g.b[j] = (short)f2bf(wgp[(fq * 8 + j) * 256]); }
    g.bg = (dir ? P.in[12] : P.in[10])[(size_t)l * 256 + 64 * h + dbase + fr];
    return g;
}
__device__ __forceinline__ void gla_gates(const Frame& F, const GateRegs& gr) {
    LAS float* GT = (LAS float*)(F.lds + GL_GT);
    const int dir = F.wave >> 2, dbase = (F.wave & 3) * 16, lane = F.lane, fr = lane & 15, fq = lane >> 4;
    float p[4][4]; float T[4];
#pragma unroll
    for (int mt = 0; mt < 4; ++mt) { const f32x4 acc = __builtin_amdgcn_mfma_f32_16x16x32_bf16(gr.a[mt], gr.b, (f32x4){0.f, 0.f, 0.f, 0.f}, 0, 0, 0);
#pragma unroll
        for (int j = 0; j < 4; ++j) p[mt][j] = logsigmoidf_(acc[j] + gr.bg) * (1.0f / 16.0f); }
    if (dir == 0) {
#pragma unroll
        for (int mt = 0; mt < 4; ++mt) { p[mt][1] += p[mt][0]; p[mt][2] += p[mt][1]; p[mt][3] += p[mt][2]; T[mt] = p[mt][3]; }
        float base = 0.f;
#pragma unroll
        for (int mt = 0; mt < 4; ++mt) { float inc = T[mt]; float v = __shfl_up(inc, 16); inc += (fq >= 1) ? v : 0.f; v = __shfl_up(inc, 32); inc += (fq >= 2) ? v : 0.f;
            const float off = base + (inc - T[mt]); const float ct = __shfl(inc, 48 + fr);
#pragma unroll
            for (int j = 0; j < 4; ++j) GT[(dbase + fr) * 65 + mt * 16 + fq * 4 + j] = off + p[mt][j];
            base += ct; }
    } else {
#pragma unroll
        for (int mt = 0; mt < 4; ++mt) { p[mt][2] += p[mt][3]; p[mt][1] += p[mt][2]; p[mt][0] += p[mt][1]; T[mt] = p[mt][0]; }
        float base = 0.f;
#pragma unroll
        for (int mt = 3; mt >= 0; --mt) { float inc = T[mt]; float v = __shfl_down(inc, 16); inc += (fq <= 2) ? v : 0.f; v = __shfl_down(inc, 32); inc += (fq <= 1) ? v : 0.f;
            const float off = base + (inc - T[mt]); const float ct = __shfl(inc, fr);
#pragma unroll
            for (int j = 0; j < 4; ++j) GT[(64 + dbase + fr) * 65 + mt * 16 + fq * 4 + j] = off + p[mt][j];
            base += ct; }
    }
}

__device__ __forceinline__ void gla_g1_unit(const Frame& F, const Params& P, int l, int row0, int h, int unit) {
    const bf16_t* pb = (const bf16_t*)(P.ws + WS_PBUF);
    const int tid = F.tid, row = F.lane, c8 = F.wave * 8;
    const GateRegs gr = gla_load_gate_regs(F, P, l, row0, h);
    const u32x4 kv = *(const u32x4*)(pb + (size_t)(row0 + row) * INP + C_K + 64 * h + c8);
    u32x4 vv[2];
#pragma unroll
    for (int i = 0; i < 2; ++i) { const int vr = F.lane, vc = (F.wave + 8 * i) * 8; vv[i] = *(const u32x4*)(pb + (size_t)(row0 + vr) * INP + C_V + 128 * h + vc); }
    gla_gates(F, gr);
    __syncthreads();
    LAS float* GT = (LAS float*)(F.lds + GL_GT);
    LAS bf16_t* KDT = (LAS bf16_t*)(F.lds + GL_KDT); LAS bf16_t* VT = (LAS bf16_t*)(F.lds + GL_VT);
#pragma unroll
    for (int j = 0; j < 8; ++j) { const int d = c8 + j; const float k_ = bfel(kv, j);
        KDT[d * 72 + row] = (bf16_t)f2bf(k_ * __expf(GT[d * 65 + 63] - GT[d * 65 + row])); KDT[(64 + d) * 72 + row] = (bf16_t)f2bf(k_ * __expf(GT[(64 + d) * 65] - GT[(64 + d) * 65 + row])); }
#pragma unroll
    for (int i = 0; i < 2; ++i) { const int vr = F.lane, vc = (F.wave + 8 * i) * 8;
#pragma unroll
        for (int j = 0; j < 8; ++j) VT[(vc + j) * 72 + vr] = bfraw(vv[i], j); }
    if (tid < 128) ((float*)(P.ws + WS_DECAY))[(size_t)unit * 128 + tid] = __expf(tid < 64 ? GT[tid * 65 + 63] : GT[tid * 65]);
    __syncthreads();
    const int fr = F.lane & 15, fq = F.lane >> 4, w = F.wave;
    f32x4 acc[1][8]; zero_acc<1, 8>(acc);
    mma_nt<1, 8>(acc, KDT + (16 * w) * 72, 72, VT, 72, 64, fr, fq);
    bf16_t* st = (bf16_t*)(P.ws + WS_STATE) + (size_t)unit * 16384;
#pragma unroll
    for (int nt = 0; nt < 8; ++nt) { u32x2 o; o.x = pk2(acc[0][nt][0], acc[0][nt][1]); o.y = pk2(acc[0][nt][2], acc[0][nt][3]); *(u32x2*)(st + (nt * 16 + fr) * 128 + 16 * w + fq * 4) = o; }
}

__device__ __forceinline__ void gla_scan(const Frame& F, const Params& P, int def_lo, int def_hi) {
    unsigned* stt = (unsigned*)(P.ws + WS_STATE); const float* dec = (const float*)(P.ws + WS_DECAY);
    if (F.tid >= 256) {
        LAS float* scr = (LAS float*)(F.lds + F.wave * 16384);
        for (int it = def_lo + F.bid * 4 + (F.wave - 4); it < def_hi; it += F.G * 4) weight_item(P, it, scr, F.lane);
        return; }
    for (int gid = F.bid * 256 + F.tid; gid < 8 * 128 * 64; gid += F.G * 256) {
        const int dp = gid & 63, e = (gid >> 6) & 127, bh = gid >> 13, dir = dp >> 5;
        const int latb = bh * 256, ctxb = 2048 + bh * 4;
        auto unit_of = [&](int p) { return dir == 0 ? (p < 4 ? ctxb + p : latb + (p - 4)) : (p < 4 ? ctxb + 3 - p : latb + 255 - (p - 4)); };
        float s0 = 0.f, s1 = 0.f;
        unsigned dA[10], dB[10]; f32x2 cA[10], cB[10];
#pragma unroll
        for (int i = 0; i < 10; ++i) { const int u = unit_of(i); dA[i] = stt[((size_t)u * 128 + e) * 64 + dp]; cA[i] = *(const f32x2*)(dec + (size_t)u * 128 + 2 * dp); }
        for (int p0 = 0; p0 < 260; p0 += 20) {
#pragma unroll
            for (int i = 0; i < 10; ++i) { const int u = unit_of(p0 + 10 + i); dB[i] = stt[((size_t)u * 128 + e) * 64 + dp]; cB[i] = *(const f32x2*)(dec + (size_t)u * 128 + 2 * dp); }
#pragma unroll
            for (int i = 0; i < 10; ++i) { const int u = unit_of(p0 + i); stt[((size_t)u * 128 + e) * 64 + dp] = pk2(s0, s1); s0 = cA[i].x * s0 + bflo(dA[i]); s1 = cA[i].y * s1 + bfhi(dA[i]); }
            if (p0 + 20 < 260) {
#pragma unroll
                for (int i = 0; i < 10; ++i) { const int u = unit_of(p0 + 20 + i); dA[i] = stt[((size_t)u * 128 + e) * 64 + dp]; cA[i] = *(const f32x2*)(dec + (size_t)u * 128 + 2 * dp); } }
#pragma unroll
            for (int i = 0; i < 10; ++i) { const int u = unit_of(p0 + 10 + i); stt[((size_t)u * 128 + e) * 64 + dp] = pk2(s0, s1); s0 = cB[i].x * s0 + bflo(dB[i]); s1 = cB[i].y * s1 + bfhi(dB[i]); }
        }
    }
}

__device__ __forceinline__ void gla_g3_unit(const Frame& F, const Params& P, int l, int row0, int h, int unit) {
    const bf16_t* pb = (const bf16_t*)(P.ws + WS_PBUF);
    const int tid = F.tid, fr = F.lane & 15, fq = F.lane >> 4, w = F.wave, row = F.lane, c8 = F.wave * 8;
    const GateRegs gr = gla_load_gate_regs(F, P, l, row0, h);
    const u32x4 qv = *(const u32x4*)(pb + (size_t)(row0 + row) * INP + C_Q + 64 * h + c8), kv = *(const u32x4*)(pb + (size_t)(row0 + row) * INP + C_K + 64 * h + c8);
    u32x4 vv[2], rv[2], stv[4];
#pragma unroll
    for (int i = 0; i < 2; ++i) { const int vr = F.lane, vc = (F.wave + 8 * i) * 8; const bf16_t* rp = pb + (size_t)(row0 + vr) * INP + 128 * h + vc; vv[i] = *(const u32x4*)(rp + C_V); rv[i] = *(const u32x4*)(rp + C_R); }
    { const bf16_t* st = (const bf16_t*)(P.ws + WS_STATE) + (size_t)unit * 16384;
#pragma unroll
      for (int i = 0; i < 4; ++i) stv[i] = *(const u32x4*)(st + (i * 512 + tid) * 8); }
    const float* ng = P.in[13] + (size_t)l * 128;
    float ngv[4];
#pragma unroll
    for (int nt = 0; nt < 4; ++nt) ngv[nt] = ng[(w >> 2) * 64 + nt * 16 + fr];
    gla_gates(F, gr);
    __syncthreads();
    LAS float* GT = (LAS float*)(F.lds + GL_GT);
    LAS bf16_t* A1 = (LAS bf16_t*)(F.lds + GL_A1); LAS bf16_t* KE = (LAS bf16_t*)(F.lds + GL_KE); LAS bf16_t* VTb = (LAS bf16_t*)(F.lds + GL_VTB); LAS bf16_t* STb = (LAS bf16_t*)(F.lds + GL_GT);
    LAS float* RS = (LAS float*)(F.lds + GL_RS); LAS bf16_t* RT = (LAS bf16_t*)(F.lds + GL_RT);
    { float qf[8], qb[8], kf[8], kb[8];
#pragma unroll
      for (int j = 0; j < 8; ++j) { const float q_ = bfel(qv, j) * 0.125f, k_ = bfel(kv, j); const float bf_ = GT[(c8 + j) * 65 + row], bb_ = GT[(64 + c8 + j) * 65 + row];
          qf[j] = q_ * __expf(bf_); qb[j] = q_ * __expf(bb_); kf[j] = k_ * __expf(-bf_); kb[j] = k_ * __expf(-bb_); }
      *(LAS u32x4*)(A1 + row * 200 + 64 + c8) = (u32x4){pk2(qf[0], qf[1]), pk2(qf[2], qf[3]), pk2(qf[4], qf[5]), pk2(qf[6], qf[7])};
      *(LAS u32x4*)(A1 + row * 200 + 128 + c8) = (u32x4){pk2(qb[0], qb[1]), pk2(qb[2], qb[3]), pk2(qb[4], qb[5]), pk2(qb[6], qb[7])};
      *(LAS u32x4*)(KE + row * 72 + c8) = (u32x4){pk2(kf[0], kf[1]), pk2(kf[2], kf[3]), pk2(kf[4], kf[5]), pk2(kf[6], kf[7])};
      *(LAS u32x4*)(KE + 4608 + row * 72 + c8) = (u32x4){pk2(kb[0], kb[1]), pk2(kb[2], kb[3]), pk2(kb[4], kb[5]), pk2(kb[6], kb[7])}; }
#pragma unroll
    for (int i = 0; i < 2; ++i) { const int vr = F.lane, vc = (F.wave + 8 * i) * 8; *(LAS u32x4*)(RT + vr * 136 + vc) = rv[i];
#pragma unroll
        for (int j = 0; j < 8; ++j) VTb[(vc + j) * 72 + vr] = bfraw(vv[i], j); }
    __syncthreads();
    {
        const int mt = w & 3, ntp = w >> 2;
        f32x4 af[1][2], ab[1][2]; zero_acc<1, 2>(af); zero_acc<1, 2>(ab);
        mma_nt<1, 2>(af, A1 + (16 * mt) * 200 + 64, 200, KE + (32 * ntp) * 72, 72, 64, fr, fq);
        mma_nt<1, 2>(ab, A1 + (16 * mt) * 200 + 128, 200, KE + 4608 + (32 * ntp) * 72, 72, 64, fr, fq);
#pragma unroll
        for (int i = 0; i < 4; ++i) { const int idx = (i * 512 + tid) * 8, e = idx >> 7, dd = idx & 127; *(LAS u32x4*)(STb + e * 136 + dd) = stv[i]; }
#pragma unroll
        for (int nt = 0; nt < 2; ++nt)
#pragma unroll
            for (int j = 0; j < 4; ++j) { const int i = 16 * mt + fq * 4 + j, jj = (2 * ntp + nt) * 16 + fr;
                const float p = (jj <= i ? af[0][nt][j] : 0.f) + (jj >= i ? ab[0][nt][j] : 0.f); A1[i * 200 + jj] = (bf16_t)f2bf(p); }
    }
    __syncthreads();
    {
        const int mt = w & 3, nh = w >> 2;
        f32x4 acc[1][4]; zero_acc<1, 4>(acc);
        mma_nt<1, 4>(acc, A1 + (16 * mt) * 200, 200, VTb + (64 * nh) * 72, 72, 64, fr, fq);
        mma_nt<1, 4>(acc, A1 + (16 * mt) * 200 + 64, 200, STb + (64 * nh) * 136, 136, 128, fr, fq);
        float ss[4];
#pragma unroll
        for (int j = 0; j < 4; ++j) { float s = 0.f;
#pragma unroll
            for (int nt = 0; nt < 4; ++nt) s += acc[0][nt][j] * acc[0][nt][j];
            s += __shfl_xor(s, 1); s += __shfl_xor(s, 2); s += __shfl_xor(s, 4); s += __shfl_xor(s, 8); ss[j] = s; }
        if (fr == 0) {
#pragma unroll
            for (int j = 0; j < 4; ++j) RS[nh * 64 + 16 * mt + fq * 4 + j] = ss[j]; }
        __syncthreads();
        bf16_t* cat = (bf16_t*)(P.ws + WS_CAT);
#pragma unroll
        for (int j = 0; j < 4; ++j) { const int i = 16 * mt + fq * 4 + j; const float rinv = 1.0f / sqrtf((RS[i] + RS[64 + i]) * (1.0f / 128.0f) + NORM_EPS);
#pragma unroll
            for (int nt = 0; nt < 4; ++nt) { const int e = nh * 64 + nt * 16 + fr; const float r_ = bf2f(RT[i * 136 + e]);
                const float o = acc[0][nt][j] * rinv * ngv[nt] * (r_ * sigmoidf_(r_)); cat[(size_t)(row0 + i) * D + 256 + 128 * h + e] = (bf16_t)f2bf(o); } }
    }
}

__device__ __forceinline__ void conv_unit(const Frame& F, const Params& P, int l, int rowbase, int Ls, int t0) {
    const bf16_t* pb = (const bf16_t*)(P.ws + WS_PBUF);
    LAS bf16_t* Y = (LAS bf16_t*)(F.lds);
    LAS float* Z = (LAS float*)(F.lds + 49152);
    const int tid = F.tid;
    {
        u32x4 av[6], gv[6];
#pragma unroll
        for (int i = 0; i < 6; ++i) { const int ch = tid + 512 * i, r = ch >> 5, cc = (ch & 31) * 8, t = t0 - 15 + r;
            av[i] = (u32x4){0u, 0u, 0u, 0u}; gv[i] = av[i];
            if (ch < 94 * 32 && t >= 0 && t < Ls) { const size_t rb = (size_t)(rowbase + t) * INP; av[i] = *(const u32x4*)(pb + rb + C_CA + cc); gv[i] = *(const u32x4*)(pb + rb + C_CG + cc); } }
#pragma unroll
        for (int i = 0; i < 6; ++i) { const int ch = tid + 512 * i, r = ch >> 5, cc = (ch & 31) * 8; const u32x4 a = av[i], g = gv[i]; u32x4 o;
            o.x = pk2(bflo(a.x) * sigmoidf_(bflo(g.x)), bfhi(a.x) * sigmoidf_(bfhi(g.x))); o.y = pk2(bflo(a.y) * sigmoidf_(bflo(g.y)), bfhi(a.y) * sigmoidf_(bfhi(g.y)));
            o.z = pk2(bflo(a.z) * sigmoidf_(bflo(g.z)), bfhi(a.z) * sigmoidf_(bfhi(g.z))); o.w = pk2(bflo(a.w) * sigmoidf_(bflo(g.w)), bfhi(a.w) * sigmoidf_(bfhi(g.w)));
            if (ch < 94 * 32) *(LAS u32x4*)(Y + r * 256 + cc) = o; }
    }
    const int c2 = (tid & 127) * 2, qtr = tid >> 7; const float* cw = P.in[14] + (size_t)l * 31 * 256 + c2; const f32x2 cb = *(const f32x2*)(P.in[15] + (size_t)l * 256 + c2);
    f32x2 wv[31];
#pragma unroll
    for (int j = 0; j < 31; ++j) wv[j] = *(const f32x2*)(cw + j * 256);
    const f32x4 lng = *(const f32x4*)(P.in[16] + (size_t)l * 256 + 4 * F.lane), lnb = *(const f32x4*)(P.in[17] + (size_t)l * 256 + 4 * F.lane);
    __syncthreads();
#pragma unroll 1
    for (int hp = 0; hp < 2; ++hp) { f32x2 yv[38]; const int rb = qtr * 16 + hp * 8;
#pragma unroll
      for (int r = 0; r < 38; ++r) { const unsigned wd = *(const LAS unsigned*)(Y + (rb + r) * 256 + c2); yv[r] = (f32x2){bflo(wd), bfhi(wd)}; }
#pragma unroll
      for (int tt = 0; tt < 8; ++tt) { f32x2 z = cb;
#pragma unroll
          for (int j = 0; j < 31; ++j) z += wv[j] * yv[tt + j];
          *(LAS f32x2*)(Z + (rb + tt) * 256 + c2) = z; } }
    __syncthreads();
    { bf16_t* cat = (bf16_t*)(P.ws + WS_CAT);
#pragma unroll 2
      for (int i = 0; i < 8; ++i) { const int t = F.wave * 8 + i; const f32x4 z = *(const LAS f32x4*)(Z + t * 256 + 4 * F.lane);
          const float mean = wave_sum((z.x + z.y) + (z.z + z.w)) * (1.0f / 256.0f); const f32x4 zc = z - mean;
          const float var = wave_sum((zc.x * zc.x + zc.y * zc.y) + (zc.z * zc.z + zc.w * zc.w)) * (1.0f / 256.0f); const float rstd = 1.0f / sqrtf(var + NORM_EPS);
          const f32x4 y = zc * rstd * lng + lnb; u32x2 o; o.x = pk2(y.x * sigmoidf_(y.x), y.y * sigmoidf_(y.y)); o.y = pk2(y.z * sigmoidf_(y.z), y.w * sigmoidf_(y.w));
          *(u32x2*)(cat + (size_t)(rowbase + t0 + t) * D + 768 + 4 * F.lane) = o; } }
    __syncthreads();
}

template <int R, int NP>
__device__ __forceinline__ void fourier_f1_unit(const Frame& F, const Params& P, int rowbase, int rstride, int h, const bf16_t* tab, int orow0, float oscale) {
    const bf16_t* pb = (const bf16_t*)(P.ws + WS_PBUF); const bf16_t* cm3 = (const bf16_t*)(P.ws + WS_CM3);
    constexpr int LZ = R + 8, MT0 = 4 * NP, NTW = R / 128, MTW = R / 128;
    LAS bf16_t* U = (LAS bf16_t*)(F.lds); LAS bf16_t* CM = U + R * 72; LAS bf16_t* ZT = CM + 64 * NP * 72;
    const int tid = F.tid, fr = F.lane & 15, fq = F.lane >> 4, w = F.wave;
    bf16x8 tcp[4], tsp[4];
    if constexpr (R == 128) {
#pragma unroll
        for (int k = 0; k < 4; ++k) { tcp[k] = *(const bf16x8*)(tab + (size_t)(w * 16 + fr) * R + k * 32 + fq * 8); tsp[k] = *(const bf16x8*)(tab + (size_t)R * R + (size_t)(w * 16 + fr) * R + k * 32 + fq * 8); } }
    { constexpr int NU = R * 8 / NTHREADS, NC = (64 * NP * 8 + NTHREADS - 1) / NTHREADS; u32x4 uv[NU], cv[NC];
#pragma unroll
      for (int i = 0; i < NU; ++i) { const int ch = tid + NTHREADS * i, a = ch >> 3, c8 = (ch & 7) * 8; uv[i] = *(const u32x4*)(pb + (size_t)(rowbase + a * rstride) * INP + C_FOUR + 64 * h + c8); }
#pragma unroll
      for (int i = 0; i < NC; ++i) { const int ch = tid + NTHREADS * i, m = ch >> 3, c8 = (ch & 7) * 8; cv[i] = (ch < 64 * NP * 8) ? *(const u32x4*)(cm3 + m * 64 + c8) : (u32x4){0u, 0u, 0u, 0u}; }
#pragma unroll
      for (int i = 0; i < NU; ++i) { const int ch = tid + NTHREADS * i, a = ch >> 3, c8 = (ch & 7) * 8; *(LAS u32x4*)(U + a * 72 + c8) = uv[i]; }
#pragma unroll
      for (int i = 0; i < NC; ++i) { const int ch = tid + NTHREADS * i, m = ch >> 3, c8 = (ch & 7) * 8; if (ch < 64 * NP * 8) *(LAS u32x4*)(CM + m * 72 + c8) = cv[i]; } }
    __syncthreads();
    {
        f32x4 acc[MT0][NTW]; zero_acc<MT0, NTW>(acc);
        mma_nt<MT0, NTW>(acc, CM, 72, U + (w * NTW * 16) * 72, 72, 64, fr, fq);
#pragma unroll
        for (int mt = 0; mt < MT0; ++mt)
#pragma unroll
            for (int nt = 0; nt < NTW; ++nt)
#pragma unroll
                for (int j = 0; j < 4; ++j) ZT[(mt * 16 + fq * 4 + j) * LZ + (w * NTW + nt) * 16 + fr] = (bf16_t)f2bf(acc[mt][nt][j]);
    }
    __syncthreads();
    {
        f32x4 are[MTW][4], aim[MTW][4]; zero_acc<MTW, 4>(are); zero_acc<MTW, 4>(aim);
        const int m0 = w * MTW * 16;
#pragma unroll
        for (int k0 = 0; k0 < R; k0 += 32) {
            bf16x8 tc[MTW], ts[MTW];
#pragma unroll
            for (int mi = 0; mi < MTW; ++mi) { if constexpr (R == 128) { tc[mi] = tcp[k0 / 32]; ts[mi] = tsp[k0 / 32]; } else { tc[mi] = *(const bf16x8*)(tab + (size_t)(m0 + mi * 16 + fr) * R + k0 + fq * 8); ts[mi] = *(const bf16x8*)(tab + (size_t)R * R + (size_t)(m0 + mi * 16 + fr) * R + k0 + fq * 8); } }
#pragma unroll
            for (int nt = 0; nt < 4; ++nt) {
                const bf16x8 zr = *(const LAS bf16x8*)(ZT + (nt * 16 + fr) * LZ + k0 + fq * 8), zi = *(const LAS bf16x8*)(ZT + (64 + nt * 16 + fr) * LZ + k0 + fq * 8);
#pragma unroll
                for (int mi = 0; mi < MTW; ++mi) { are[mi][nt] = __builtin_amdgcn_mfma_f32_16x16x32_bf16(tc[mi], zr, are[mi][nt], 0, 0, 0); are[mi][nt] = __builtin_amdgcn_mfma_f32_16x16x32_bf16(ts[mi], zi, are[mi][nt], 0, 0, 0); }
                if constexpr (NP == 3) { const bf16x8 nzr = *(const LAS bf16x8*)(ZT + (128 + nt * 16 + fr) * LZ + k0 + fq * 8);
#pragma unroll
                    for (int mi = 0; mi < MTW; ++mi) { aim[mi][nt] = __builtin_amdgcn_mfma_f32_16x16x32_bf16(tc[mi], zi, aim[mi][nt], 0, 0, 0); aim[mi][nt] = __builtin_amdgcn_mfma_f32_16x16x32_bf16(ts[mi], nzr, aim[mi][nt], 0, 0, 0); } }
            }
        }
#pragma unroll
        for (int mi = 0; mi < MTW; ++mi)
#pragma unroll
            for (int nt = 0; nt < 4; ++nt)
#pragma unroll
                for (int j = 0; j < 4; ++j) { const int m = m0 + mi * 16 + fq * 4 + j, k2 = nt * 16 + fr;
                    if constexpr (NP == 3) { unsigned* t2 = (unsigned*)(P.ws + WS_T2); t2[(size_t)(orow0 + 128 * m) * 256 + h * 64 + k2] = pk2(are[mi][nt][j], aim[mi][nt][j]); }
                    else { bf16_t* cat = (bf16_t*)(P.ws + WS_CAT); cat[(size_t)(orow0 + m) * D + h * 64 + k2] = (bf16_t)f2bf(are[mi][nt][j] * oscale); } }
    }
    __syncthreads();
}

constexpr int F2_X = 0, F2_T = 67584;
__device__ __forceinline__ void fourier_f2_tables(const Frame& F, const Params& P) {
    const bf16_t* tf2 = (const bf16_t*)(P.ws + WS_TF2); LAS bf16_t* T = (LAS bf16_t*)(F.lds + F2_T);
#pragma unroll
    for (int i = 0; i < 8; ++i) { const int ch = F.tid + 512 * i, r = ch >> 4, c8 = (ch & 15) * 8; *(LAS u32x4*)(T + r * 136 + c8) = *(const u32x4*)(tf2 + r * 128 + c8); }
    __syncthreads();
}
__device__ __forceinline__ void fourier_f2_unit(const Frame& F, const Params& P, int b, int d, int hp) {
    const bf16_t* t2 = (const bf16_t*)(P.ws + WS_T2);
    LAS bf16_t* X = (LAS bf16_t*)(F.lds + F2_X); const LAS bf16_t* T = (const LAS bf16_t*)(F.lds + F2_T);
    const int tid = F.tid, fr = F.lane & 15, fq = F.lane >> 4, w = F.wave;
    { u32x4 xv[8];
#pragma unroll
      for (int i = 0; i < 8; ++i) { const int ch = tid + 512 * i, n = ch >> 5, c8 = (ch & 31) * 8; xv[i] = *(const u32x4*)(t2 + (size_t)(b * SEQ + 128 * d + n) * 512 + hp * 256 + c8); }
#pragma unroll
      for (int i = 0; i < 8; ++i) { const int ch = tid + 512 * i, n = ch >> 5, c8 = (ch & 31) * 8; *(LAS u32x4*)(X + n * 264 + c8) = xv[i]; } }
    __syncthreads();
    f32x4 acc[8];
#pragma unroll
    for (int mt = 0; mt < 8; ++mt) acc[mt] = (f32x4){0.f, 0.f, 0.f, 0.f};
#pragma unroll
    for (int k0 = 0; k0 < 128; k0 += 32) {
        bf16x8 xr, xi;
#pragma unroll
        for (int jj = 0; jj < 8; ++jj) { const unsigned wd = *(const LAS unsigned*)(X + (k0 + fq * 8 + jj) * 264 + 2 * (w * 16 + fr)); xr[jj] = (short)(wd & 0xffffu); xi[jj] = (short)(wd >> 16); }
#pragma unroll
        for (int mt = 0; mt < 8; ++mt) { const bf16x8 tc = *(const LAS bf16x8*)(T + (mt * 16 + fr) * 136 + k0 + fq * 8), ts = *(const LAS bf16x8*)(T + (128 + mt * 16 + fr) * 136 + k0 + fq * 8);
            acc[mt] = __builtin_amdgcn_mfma_f32_16x16x32_bf16(tc, xr, acc[mt], 0, 0, 0); acc[mt] = __builtin_amdgcn_mfma_f32_16x16x32_bf16(ts, xi, acc[mt], 0, 0, 0); }
    }
    bf16_t* cat = (bf16_t*)(P.ws + WS_CAT);
#pragma unroll
    for (int mt = 0; mt < 8; ++mt)
#pragma unroll
        for (int j = 0; j < 4; ++j) { const int c = mt * 16 + fq * 4 + j; cat[(size_t)(b * SEQ + 128 * c + d) * D + hp * 128 + w * 16 + fr] = (bf16_t)f2bf(acc[mt][j] * (1.0f / 1024.0f)); }
    __syncthreads();
}

constexpr int AX_LCNT = AUX_OFF, AX_GBASE = AUX_OFF + 128, AX_LE = AUX_OFF + 256, AX_LP = AUX_OFF + 256 + 2560;
constexpr int LC_BAR = LCTL_OFF, LC_TS = LCTL_OFF + 64;

constexpr int RT_GS = 0, RT_SSQ = 24576, RT_AT = 25600, RT_PL = 95232;
__device__ __forceinline__ void phase_route(const Frame& F, const Params& P, int l, int ntok) {
    unsigned char* ws = P.ws;
    LAS float* GS = (LAS float*)(F.lds + RT_GS); LAS float* SSQ = (LAS float*)(F.lds + RT_SSQ); LAS float* PL = (LAS float*)(F.lds + RT_PL);
    volatile LAS int* lcnt = (volatile LAS int*)(F.lds + AX_LCNT); volatile LAS int* gbase = (volatile LAS int*)(F.lds + AX_GBASE);
    volatile LAS int* LE = (volatile LAS int*)(F.lds + AX_LE); volatile LAS int* LP = (volatile LAS int*)(F.lds + AX_LP);
    const int tid = F.tid, lane = F.lane, w = F.wave, fr = lane & 15, fq = lane >> 4, ts = lane >> 2, kq = lane & 3, kbase = 128 * w + 32 * kq;
    LAS bf16_t* AT = (LAS bf16_t*)(F.lds + RT_AT) + w * (2 * 16 * 136);
    const int tpb = (ntok + F.G - 1) / F.G, tb = F.bid * tpb, te = (tb + tpb < ntok) ? tb + tpb : ntok, ntile = (te - tb + 15) >> 4;
    { const float* g2 = P.in[5] + (size_t)l * D;
      for (int i = tid; i < 3 * 1024; i += NTHREADS) { const int v = i >> 10, k = i & 1023; const float* mf = (const float*)(ws + WS_MODF) + ((size_t)l * 3 + v) * 6144;
          GS[(v * 2 + 0) * 1024 + k] = g2[k] * (1.0f + mf[4 * 1024 + k]); GS[(v * 2 + 1) * 1024 + k] = mf[3 * 1024 + k]; } }
    if (tid < 32) lcnt[tid] = 0;
    bf16x8 bh[4][2], bl[4][2];
    { const bf16_t* rwh = (const bf16_t*)(ws + WS_RW) + (size_t)l * 2 * NE * D; const bf16_t* rwl = rwh + NE * D;
#pragma unroll
      for (int sk = 0; sk < 4; ++sk)
#pragma unroll
          for (int nt = 0; nt < 2; ++nt) { const int off = (nt * 16 + fr) * D + 128 * w + 32 * sk + 8 * fq; bh[sk][nt] = *(const bf16x8*)(rwh + off); bl[sk][nt] = *(const bf16x8*)(rwl + off); } }
    const float* xres = (const float*)(ws + WS_XRES); bf16_t* hb = (bf16_t*)(ws + WS_HBUF);
    const float rbias = P.in[20][(size_t)l * NE + (lane & 31)];
    float* aprob = (float*)(ws + WS_APROB);
    f32x4 xn[8];
    { const int m = tb + ts;
#pragma unroll
      for (int j = 0; j < 8; ++j) xn[j] = (m < te) ? *(const f32x4*)(xres + (size_t)m * D + kbase + 4 * j) : (f32x4){0.f, 0.f, 0.f, 0.f}; }
    __syncthreads();
    for (int it = 0; it < ntile; ++it) {
        const int buf = it & 1; const int m = tb + 16 * it + ts; const bool valid = m < te; const int v = (m >= NLAT) ? 2 : (m >= SEQ ? 1 : 0);
        f32x4 x[8]; float ss = 0.f;
#pragma unroll
        for (int j = 0; j < 8; ++j) { x[j] = xn[j]; ss += (x[j].x * x[j].x + x[j].y * x[j].y) + (x[j].z * x[j].z + x[j].w * x[j].w); }
        if (it + 1 < ntile) { const int mn = m + 16;
#pragma unroll
            for (int j = 0; j < 8; ++j) xn[j] = (mn < te) ? *(const f32x4*)(xres + (size_t)mn * D + kbase + 4 * j) : (f32x4){0.f, 0.f, 0.f, 0.f}; }
        ss += __shfl_xor(ss, 1); ss += __shfl_xor(ss, 2);
        if (kq == 0) SSQ[(buf * 8 + w) * 16 + ts] = ss;
        __syncthreads();
        float tot = 0.f;
#pragma unroll
        for (int q = 0; q < 8; ++q) tot += SSQ[(buf * 8 + q) * 16 + ts];
        const float rstd = 1.0f / sqrtf(tot * (1.0f / D) + NORM_EPS);
        {
            unsigned hw[16], lw[16];
#pragma unroll
            for (int j = 0; j < 8; ++j) { const f32x4 gs = *(const LAS f32x4*)(GS + (v * 2 + 0) * 1024 + kbase + 4 * j), sh = *(const LAS f32x4*)(GS + (v * 2 + 1) * 1024 + kbase + 4 * j);
                const f32x4 h = (x[j] * rstd) * gs + sh;
                const unsigned h0 = f2bf(h.x), h1 = f2bf(h.y), h2 = f2bf(h.z), h3 = f2bf(h.w);
                hw[2 * j] = h0 | (h1 << 16); hw[2 * j + 1] = h2 | (h3 << 16);
                lw[2 * j] = pk2(h.x - bf2f(h0), h.y - bf2f(h1)); lw[2 * j + 1] = pk2(h.z - bf2f(h2), h.w - bf2f(h3)); }
            if (valid) {
                if (F8_LAYER[l]) { unsigned char* hb8 = ws + WS_HB8 + (size_t)m * D + kbase;
#pragma unroll
                    for (int c = 0; c < 2; ++c) { u32x4 o;
                        o.x = pk4_fp8(bflo(hw[8 * c + 0]) + bflo(lw[8 * c + 0]), bfhi(hw[8 * c + 0]) + bfhi(lw[8 * c + 0]), bflo(hw[8 * c + 1]) + bflo(lw[8 * c + 1]), bfhi(hw[8 * c + 1]) + bfhi(lw[8 * c + 1]));
                        o.y = pk4_fp8(bflo(hw[8 * c + 2]) + bflo(lw[8 * c + 2]), bfhi(hw[8 * c + 2]) + bfhi(lw[8 * c + 2]), bflo(hw[8 * c + 3]) + bflo(lw[8 * c + 3]), bfhi(hw[8 * c + 3]) + bfhi(lw[8 * c + 3]));
                        o.z = pk4_fp8(bflo(hw[8 * c + 4]) + bflo(lw[8 * c + 4]), bfhi(hw[8 * c + 4]) + bfhi(lw[8 * c + 4]), bflo(hw[8 * c + 5]) + bflo(lw[8 * c + 5]), bfhi(hw[8 * c + 5]) + bfhi(lw[8 * c + 5]));
                        o.w = pk4_fp8(bflo(hw[8 * c + 6]) + bflo(lw[8 * c + 6]), bfhi(hw[8 * c + 6]) + bfhi(lw[8 * c + 6]), bflo(hw[8 * c + 7]) + bflo(lw[8 * c + 7]), bfhi(hw[8 * c + 7]) + bfhi(lw[8 * c + 7]));
                        *(u32x4*)(hb8 + 16 * c) = o; } }
                if (!F8_LAYER[l]) {
#pragma unroll
                    for (int c = 0; c < 4; ++c) *(u32x4*)(hb + (size_t)m * D + kbase + 8 * c) = (u32x4){hw[4 * c], hw[4 * c + 1], hw[4 * c + 2], hw[4 * c + 3]}; } }
#pragma unroll
            for (int c = 0; c < 4; ++c) { *(LAS u32x4*)(AT + ts * 136 + 32 * kq + 8 * c) = (u32x4){hw[4 * c], hw[4 * c + 1], hw[4 * c + 2], hw[4 * c + 3]};
                *(LAS u32x4*)(AT + 16 * 136 + ts * 136 + 32 * kq + 8 * c) = (u32x4){lw[4 * c], lw[4 * c + 1], lw[4 * c + 2], lw[4 * c + 3]}; }
        }
        f32x4 acc[2]; acc[0] = (f32x4){0.f, 0.f, 0.f, 0.f}; acc[1] = acc[0];
#pragma unroll
        for (int sk = 0; sk < 4; ++sk) { const bf16x8 ah = *(const LAS bf16x8*)(AT + fr * 136 + 32 * sk + 8 * fq), al = *(const LAS bf16x8*)(AT + 16 * 136 + fr * 136 + 32 * sk + 8 * fq);
#pragma unroll
            for (int nt = 0; nt < 2; ++nt) { acc[nt] = __builtin_amdgcn_mfma_f32_16x16x32_bf16(ah, bh[sk][nt], acc[nt], 0, 0, 0); acc[nt] = __builtin_amdgcn_mfma_f32_16x16x32_bf16(ah, bl[sk][nt], acc[nt], 0, 0, 0);
                acc[nt] = __builtin_amdgcn_mfma_f32_16x16x32_bf16(al, bh[sk][nt], acc[nt], 0, 0, 0); } }
#pragma unroll
        for (int nt = 0; nt < 2; ++nt)
#pragma unroll
            for (int j = 0; j < 4; ++j) PL[((buf * 8 + w) * 16 + fq * 4 + j) * 33 + nt * 16 + fr] = acc[nt][j];
        __syncthreads();
        {
            const int tt = 2 * w + (lane >> 5), e = lane & 31, mt = tb + 16 * it + tt;
            float lg = rbias;
#pragma unroll
            for (int q = 0; q < 8; ++q) lg += PL[((buf * 8 + q) * 16 + tt) * 33 + e];
            float bval[4]; int bidx[4]; float cur = lg;
#pragma unroll
            for (int k = 0; k < 4; ++k) { float bv = cur; int bi = e;
#pragma unroll
                for (int o = 1; o < 32; o <<= 1) { const float ov = __shfl_xor(bv, o); const int oi = __shfl_xor(bi, o); const bool take = (ov > bv) || (ov == bv && oi < bi); bv = take ? ov : bv; bi = take ? oi : bi; }
                bval[k] = bv; bidx[k] = bi; if (e == bi) cur = -INFINITY; }
            float ex[4], sum = 0.f;
#pragma unroll
            for (int k = 0; k < 4; ++k) { ex[k] = __expf(bval[k] - bval[0]); sum += ex[k]; }
            if (e == 0 && mt < te) { const int tl = 16 * it + tt;
#pragma unroll
                for (int k = 0; k < 4; ++k) { const int lp = __hip_atomic_fetch_add((LAS int*)(F.lds + AX_LCNT) + bidx[k], 1, __ATOMIC_RELAXED, __HIP_MEMORY_SCOPE_WORKGROUP);
                    LE[tl * 4 + k] = bidx[k]; LP[tl * 4 + k] = lp; aprob[(size_t)mt * 4 + k] = ex[k] / sum; } }
        }
    }
    __syncthreads();
    if (tid < 32) gbase[tid] = (int)__hip_atomic_fetch_add((unsigned*)(ws + WS_CTL) + CW_CNT + l * 64 + tid, (unsigned)lcnt[tid], __ATOMIC_RELAXED, __HIP_MEMORY_SCOPE_AGENT);
    __syncthreads();
    int* aexp = (int*)(ws + WS_AEXP); int* apos = (int*)(ws + WS_APOS);
    int* elist = (int*)(ws + WS_XB);
    for (int i = tid; i < (te - tb) * 4; i += NTHREADS) { const int e = LE[i]; const int pos = gbase[e] + LP[i]; aexp[(size_t)tb * 4 + i] = e; apos[(size_t)tb * 4 + i] = pos; elist[(size_t)e * NTOK + pos] = tb + (i >> 2); }
    __syncthreads();
}

__device__ __forceinline__ void moe_prep(const Frame& F, const Params& P, int l) {
    unsigned char* ws = P.ws;
    volatile LAS int* TS = (volatile LAS int*)(F.lds + LC_TS);
    if (F.tid < 64) { const int e = F.lane & 31;
        const unsigned c = __hip_atomic_load((unsigned*)(ws + WS_CTL) + CW_CNT + l * 64 + e, __ATOMIC_RELAXED, __HIP_MEMORY_SCOPE_AGENT);
        int incl = (int)((c + 255u) >> 8);
#pragma unroll
        for (int o = 1; o < 32; o <<= 1) { const int v = __shfl_up(incl, o); if (e >= o) incl += v; }
        if (F.lane < 32) { TS[e + 1] = incl; TS[64 + e] = (int)c; }
        if (F.lane == 0) TS[0] = 0; }
    __syncthreads();
}

__device__ __forceinline__ void phase_gather8(const Frame& F, const Params& P, int l, int ntok) {
    unsigned char* ws = P.ws;
    moe_prep(F, P, l);
    const volatile LAS int* TS = (const volatile LAS int*)(F.lds + LC_TS);
    const int gw = F.bid * NWAVES + F.wave, NGW = F.G * NWAVES;
    const int* aexp = (const int*)(ws + WS_AEXP); const int* apos = (const int*)(ws + WS_APOS);
    const unsigned char* hb8 = ws + WS_HB8; unsigned char* xb8 = ws + WS_XB8;
    for (int cidx = gw; cidx < ntok / 16; cidx += NGW) {
        const int a0 = cidx * 64; const int e = aexp[a0 + F.lane]; const int rowl = TS[e] * 256 + apos[a0 + F.lane];
#pragma unroll 1
        for (int t4 = 0; t4 < 16; t4 += 4) {
            u32x4 v0[4];
#pragma unroll
            for (int q = 0; q < 4; ++q) v0[q] = ((const u32x4*)(hb8 + (size_t)(a0 / 4 + t4 + q) * D))[F.lane];
#pragma unroll
            for (int q = 0; q < 4; ++q)
#pragma unroll
                for (int k = 0; k < 4; ++k) { const int row = __shfl(rowl, (t4 + q) * 4 + k); ((u32x4*)(xb8 + (size_t)row * D))[F.lane] = v0[q]; }
        }
    }
}

__device__ __forceinline__ void phase_combine(const Frame& F, const Params& P, int l, int ntok, bool last) {
    unsigned char* ws = P.ws;
    const int gw = F.bid * NWAVES + F.wave, NGW = F.G * NWAVES, lane = F.lane;
    float* xres = (float*)(ws + WS_XRES); const bf16_t* yb = (const bf16_t*)(ws + WS_YB); const unsigned char* yb8 = ws + WS_YB;
    const int* aexp = (const int*)(ws + WS_AEXP); const int* apos = (const int*)(ws + WS_APOS); const float* aprob = (const float*)(ws + WS_APROB);
    const volatile LAS int* TS = (const volatile LAS int*)(F.lds + LC_TS);
    int sl_n[4]; float pr_n[4];
    if (gw < ntok) {
#pragma unroll
        for (int k = 0; k < 4; ++k) { sl_n[k] = TS[aexp[(size_t)gw * 4 + k]] * 256 + apos[(size_t)gw * 4 + k]; pr_n[k] = aprob[(size_t)gw * 4 + k]; } }
    for (int m = gw; m < ntok; m += NGW) {
        const int v = (m >= NLAT) ? 2 : (m >= SEQ ? 1 : 0);
        const float* mf = (const float*)(ws + WS_MODF) + ((size_t)l * 3 + v) * 6144;
        int sl[4]; float pr[4];
#pragma unroll
        for (int k = 0; k < 4; ++k) { sl[k] = sl_n[k]; pr[k] = pr_n[k]; }
        u32x2 wv[4][4]; f32x4 xo[4], g5[4];
#pragma unroll
        for (int k = 0; k < 4; ++k)
#pragma unroll
            for (int j = 0; j < 4; ++j) { if (F8_LAYER[l]) { wv[k][j].x = *(const unsigned*)(yb8 + (size_t)sl[k] * D + 4 * lane + 256 * j); wv[k][j].y = 0u; } else wv[k][j] = *(const u32x2*)(yb + (size_t)sl[k] * D + 4 * lane + 256 * j); }
#pragma unroll
        for (int j = 0; j < 4; ++j) { const int c = 4 * lane + 256 * j; xo[j] = *(const f32x4*)(xres + (size_t)m * D + c); g5[j] = *(const f32x4*)(mf + 5 * 1024 + c); }
        if (m + NGW < ntok) {
#pragma unroll
            for (int k = 0; k < 4; ++k) { sl_n[k] = TS[aexp[(size_t)(m + NGW) * 4 + k]] * 256 + apos[(size_t)(m + NGW) * 4 + k]; pr_n[k] = aprob[(size_t)(m + NGW) * 4 + k]; } }
        f32x4 y[4];
#pragma unroll
        for (int j = 0; j < 4; ++j) y[j] = (f32x4){0.f, 0.f, 0.f, 0.f};
#pragma unroll
        for (int k = 0; k < 4; ++k)
#pragma unroll
            for (int j = 0; j < 4; ++j) { if (F8_LAYER[l]) { const f32x2 lo = __builtin_amdgcn_cvt_pk_f32_fp8(wv[k][j].x, false), hi = __builtin_amdgcn_cvt_pk_f32_fp8(wv[k][j].x, true); y[j] += (f32x4){lo.x, lo.y, hi.x, hi.y} * pr[k]; }
                else y[j] += (f32x4){bflo(wv[k][j].x), bfhi(wv[k][j].x), bflo(wv[k][j].y), bfhi(wv[k][j].y)} * pr[k]; }
        f32x4 x[4];
#pragma unroll
        for (int j = 0; j < 4; ++j) x[j] = xo[j] + g5[j] * y[j];
        if (!last) {
#pragma unroll
            for (int j = 0; j < 4; ++j) *(f32x4*)(xres + (size_t)m * D + 4 * lane + 256 * j) = x[j];
            const float* mn = (const float*)(ws + WS_MODF) + ((size_t)(l + 1) * 3 + v) * 6144; f32x4 shv[4], scv[4];
#pragma unroll
            for (int j = 0; j < 4; ++j) { shv[j] = *(const f32x4*)(mn + 4 * lane + 256 * j); scv[j] = *(const f32x4*)(mn + 1024 + 4 * lane + 256 * j); }
            norm_row_store(x, P.in[4] + (size_t)(l + 1) * D, shv, scv, (bf16_t*)(ws + WS_HBUF) + (size_t)m * D, lane);
        } else {
            float ss = 0.f;
#pragma unroll
            for (int j = 0; j < 4; ++j) ss += (x[j].x * x[j].x + x[j].y * x[j].y) + (x[j].z * x[j].z + x[j].w * x[j].w);
            const float rstd = 1.0f / sqrtf(wave_sum(ss) * (1.0f / D) + NORM_EPS);
#pragma unroll
            for (int j = 0; j < 4; ++j) { const int c = 4 * lane + 256 * j; *(f32x4*)(P.out + (size_t)m * D + c) = (x[j] * rstd) * *(const f32x4*)(P.in[25] + c); }
        }
    }
}

#ifndef REP_PRO
#define REP_PRO 1
#endif
#ifndef REP_GEMM1
#define REP_GEMM1 1
#endif
#ifndef REP_G1U
#define REP_G1U 1
#endif
#ifndef REP_F1U
#define REP_F1U 1
#endif
#ifndef REP_CONV
#define REP_CONV 1
#endif
#ifndef REP_F2U
#define REP_F2U 1
#endif
#ifndef REP_G3U
#define REP_G3U 1
#endif
#ifndef REP_GU
#define REP_GU 1
#endif
#ifndef REP_DN
#define REP_DN 1
#endif
#ifndef REP_GATH
#define REP_GATH 1
#endif
__global__ void __launch_bounds__(NTHREADS, 2) mega_fwd(Params P0) {
    extern __shared__ __attribute__((aligned(16))) unsigned char lds_raw[];
    Frame F0; F0.lds = (LAS unsigned char*)lds_raw; F0.tid = threadIdx.x; F0.lane = F0.tid & 63; F0.wave = __builtin_amdgcn_readfirstlane(F0.tid >> 6); F0.G = gridDim.x; F0.bid = blockIdx.x;
#define KAS __attribute__((address_space(4)))
    struct ParamsK { const GAS float* in[26]; GAS float* out; GAS unsigned char* ws; };
#define PHASE_ENV() Frame F = F0; asm volatile("" : "+v"(F.tid)); F.lane = F.tid & 63; F.wave = __builtin_amdgcn_readfirstlane(F.tid >> 6); asm volatile("" : "+s"(F.bid), "+s"(F.G)); \
    const KAS ParamsK* kp_ = (const KAS ParamsK*)__builtin_amdgcn_kernarg_segment_ptr(); asm volatile("" : "+s"(kp_)); Params P; \
    _Pragma("unroll") for (int i_ = 0; i_ < 26; ++i_) P.in[i_] = (const float*)kp_->in[i_]; \
    P.out = (float*)kp_->out; P.ws = (unsigned char*)kp_->ws; unsigned char* ws = P.ws; (void)ws;
    { PHASE_ENV();
    for (int u = F.tid; u < (LDS_BYTES - LCTL_OFF) / 4; u += NTHREADS) ((LAS unsigned*)(F.lds + LCTL_OFF))[u] = 0u;
    __syncthreads();
    }
    { PHASE_ENV(); (void)xcd_barrier_post((unsigned*)(ws + WS_CTL) + CW_BAR, (volatile LAS unsigned*)(F.lds + LC_BAR)); }
#define GRID_BAR() do { PHASE_ENV(); XcdBarrier b_; b_.bar = (unsigned*)(ws + WS_CTL) + CW_BAR; b_.x = xb_xcc_id(); b_.st = (volatile LAS unsigned*)(F.lds + LC_BAR); xcd_barrier(b_); } while (0)

    for (int rep = 0; rep < REP_PRO; ++rep) { PHASE_ENV(); phase_prologue(F, P); }
    GRID_BAR();
    { PHASE_ENV(); phase_p1(F, P); }
    GRID_BAR();

    {
        constexpr int l = 0; constexpr bool last = (l == DEPTH - 1);
        for (int rep = 0; rep < REP_GEMM1; ++rep) { PHASE_ENV(); pg8::Gemm g{(const bf16_t*)(ws + WS_HBUF), (const bf16_t*)(ws + WS_WIN) + (size_t)l * INP * D, NTOK, INP, D};
          pg8::StaticOrder S; S.init(NTOK, INP, F.G, F.bid);
          pg8::EpiStoreBf16 E{(bf16_t*)(ws + WS_PBUF), INP};
          pg8::gemm_phase<pg8::EpiStoreBf16, pg8::StaticOrder>(F.lds, g, S, E, F.tid);
          const int nun = (NTOK / 256) * (INP / 256), rr = nun % F.G, first = (rr == 0) ? 0 : rr, nidle = F.G - first;
          if (F.bid >= first) for (int t = F.bid - first; t < NTOK / 256; t += nidle) {
              SkEpiBf16 SE{(bf16_t*)(ws + WS_LRB) + (size_t)t * 256 * 32, 32};
              skinny_unit(F, (const bf16_t*)(ws + WS_HBUF) + (size_t)t * 256 * D, (const bf16_t*)(ws + WS_WGT) + (size_t)l * 32 * D, SE); } }
        GRID_BAR();
        for (int rep = 0; rep < REP_G1U; ++rep) { PHASE_ENV();
        for (int u = F.bid; u < 2080; u += F.G) { int row0, h;
            if (u < 2048) { const int bh = u >> 8, n = u & 255; h = bh & 3; row0 = (bh >> 2) * SEQ + 64 * n; }
            else { const int q = u - 2048, bh = q >> 2, n = q & 3; h = bh & 3; row0 = NLAT + (bh >> 2) * CTXL + 64 * n; }
            gla_g1_unit(F, P, l, row0, h, u); }
        __syncthreads(); }
        for (int rep = 0; rep < REP_F1U; ++rep) { PHASE_ENV();
        for (int u = F.bid; u < 1024; u += F.G) { const int b = u >> 9, nlo = (u >> 2) & 127, h = u & 3;
            fourier_f1_unit<128, 3>(F, P, b * SEQ + nlo, 128, h, (const bf16_t*)(ws + WS_TLAT) + (size_t)nlo * 32768, b * SEQ + nlo, 1.0f); }
        }
        { PHASE_ENV();
        if (!last) for (int u = (F.bid + F.G - 32) % F.G; u < 8; u += F.G) { const int b = u >> 2, h = u & 3;
            fourier_f1_unit<256, 2>(F, P, NLAT + b * CTXL, 1, h, (const bf16_t*)(ws + WS_TCTX), NLAT + b * CTXL, 1.0f / 128.0f); }
        }
        for (int rep = 0; rep < REP_CONV; ++rep) { PHASE_ENV();
        for (int u = F.bid; u < 512 + F.G; u += F.G) {
            int rowbase = 64 * u, Ls = 64, t0 = 0;
            if (u >= 512) { const int q = (u - 512) - 40; if (last || q < 0 || q >= 8) break; rowbase = NLAT + (q >> 2) * CTXL; Ls = CTXL; t0 = 64 * (q & 3); }
            conv_unit(F, P, l, rowbase, Ls, t0); } }
        GRID_BAR();
        { PHASE_ENV(); gla_scan(F, P, WT_DEF0_LO, WT_DEF0_HI); __syncthreads(); }
        for (int rep = 0; rep < REP_F2U; ++rep) { PHASE_ENV();
        fourier_f2_tables(F, P);
        for (int u = F.bid; u < 512; u += F.G) fourier_f2_unit(F, P, u >> 8, (u >> 1) & 127, u & 1); }
        GRID_BAR();
        for (int rep = 0; rep < REP_G3U; ++rep) { PHASE_ENV();
        for (int u = F.bid; u < (last ? 2048 : 2080); u += F.G) { int row0, h;
            if (u < 2048) { const int bh = u >> 8, n = u & 255; h = bh & 3; row0 = (bh >> 2) * SEQ + 64 * n; }
            else { const int q = u - 2048, bh = q >> 2, n = q & 3; h = bh & 3; row0 = NLAT + (bh >> 2) * CTXL + 64 * n; }
            gla_g3_unit(F, P, l, row0, h, u); }
        __syncthreads(); }
        GRID_BAR();
        { PHASE_ENV(); const int M2 = NLAT;
          pg8::Gemm g{(const bf16_t*)(ws + WS_CAT), (const bf16_t*)(ws + WS_WOUT) + (size_t)l * D * D, M2, D, D};
          pg8::StaticOrder S; S.init(M2, D, F.G, F.bid);
          pg8::EpiResid E{(float*)(ws + WS_XRES), (l == 0) ? P.in[0] : (const float*)(ws + WS_XRES), (const float*)(ws + WS_MODF) + (size_t)l * 3 * 6144};
          pg8::gemm_phase<pg8::EpiResid, pg8::StaticOrder>(F.lds, g, S, E, F.tid);
          if (!last) for (int t = F.bid; t < 2 * 32; t += F.G) { const int pm = NLAT / 256 + (t >> 5), nt32 = t & 31;
              SkEpiResid SE{(float*)(ws + WS_XRES) + (size_t)pm * 256 * D + nt32 * 32, P.in[2] + (size_t)(pm - NLAT / 256) * 256 * D + nt32 * 32, (const float*)(ws + WS_MODF) + ((size_t)l * 3 + 2) * 6144 + 2 * 1024 + nt32 * 32};
              skinny_unit(F, (const bf16_t*)(ws + WS_CAT) + (size_t)pm * 256 * D, (const bf16_t*)(ws + WS_WOUT) + (size_t)l * D * D + (size_t)nt32 * 32 * D, SE); } }
        GRID_BAR();
        const int ntok = last ? NLAT : NTOK;
        { PHASE_ENV(); phase_route(F, P, l, ntok); }
        GRID_BAR();
        if constexpr (F8_LAYER[l]) { { PHASE_ENV(); phase_gather8(F, P, l, ntok); } GRID_BAR(); }
        for (int rep = 0; rep < REP_GU; ++rep) { PHASE_ENV(); moe_prep(F, P, l); const volatile LAS int* TS = (const volatile LAS int*)(F.lds + LC_TS);
          pg8::MoeOrder S{8, F.G, F.bid, TS[NE], TS};
          if constexpr (F8_LAYER[l]) {
              pg8::Gemm g{(const bf16_t*)(ws + WS_XB8), (const bf16_t*)(ws + WS_WGU + (size_t)l * NE * 2048 * D * 2), 0, 2048, D / 2};
              pg8::EpiGateUp8 E{ws + WS_ACT, P.in[22] + (size_t)l * NE * 2048};
              pg8::gemm_phase<pg8::EpiGateUp8, pg8::MoeOrder, true, true, true>(F.lds, g, S, E, F.tid);
          } else {
              pg8::Gemm g{(const bf16_t*)(ws + WS_HBUF), (const bf16_t*)(ws + WS_WGU) + (size_t)l * NE * 2048 * D, 0, 2048, D};
              pg8::EpiGateUp E{(bf16_t*)(ws + WS_ACT), P.in[22] + (size_t)l * NE * 2048};
              pg8::gemm_phase_gather<pg8::EpiGateUp, pg8::MoeOrder>(F.lds, g, (const int*)(ws + WS_XB), S, E, F.tid); } }
        GRID_BAR();
        for (int rep = 0; rep < REP_DN; ++rep) { PHASE_ENV(); const volatile LAS int* TS = (const volatile LAS int*)(F.lds + LC_TS);
          pg8::MoeOrder S{4, F.G, F.bid, TS[NE], TS};
          if constexpr (F8_LAYER[l]) {
              pg8::Gemm g{(const bf16_t*)(ws + WS_ACT), (const bf16_t*)(ws + WS_WDN + (size_t)l * NE * D * DFF * 2), 0, D, DFF / 2};
              pg8::EpiDown8 E{ws + WS_YB, P.in[24] + (size_t)l * NE * D};
              pg8::gemm_phase<pg8::EpiDown8, pg8::MoeOrder, true, true, true>(F.lds, g, S, E, F.tid);
          } else {
              pg8::Gemm g{(const bf16_t*)(ws + WS_ACT), (const bf16_t*)(ws + WS_WDN) + (size_t)l * NE * D * DFF, 0, D, DFF};
              pg8::EpiDown E{(bf16_t*)(ws + WS_YB), P.in[24] + (size_t)l * NE * D};
              pg8::gemm_phase<pg8::EpiDown, pg8::MoeOrder>(F.lds, g, S, E, F.tid); } }
        GRID_BAR();
        { PHASE_ENV(); phase_combine(F, P, l, ntok, last); }
        if (!last) GRID_BAR();
    }
    {
        constexpr int l = 1; constexpr bool last = (l == DEPTH - 1);
        for (int rep = 0; rep < REP_GEMM1; ++rep) { PHASE_ENV(); pg8::Gemm g{(const bf16_t*)(ws + WS_HBUF), (const bf16_t*)(ws + WS_WIN) + (size_t)l * INP * D, NTOK, INP, D};
          pg8::StaticOrder S; S.init(NTOK, INP, F.G, F.bid);
          pg8::EpiStoreBf16 E{(bf16_t*)(ws + WS_PBUF), INP};
          pg8::gemm_phase<pg8::EpiStoreBf16, pg8::StaticOrder>(F.lds, g, S, E, F.tid);
          const int nun = (NTOK / 256) * (INP / 256), rr = nun % F.G, first = (rr == 0) ? 0 : rr, nidle = F.G - first;
          if (F.bid >= first) for (int t = F.bid - first; t < NTOK / 256; t += nidle) {
              SkEpiBf16 SE{(bf16_t*)(ws + WS_LRB) + (size_t)t * 256 * 32, 32};
              skinny_unit(F, (const bf16_t*)(ws + WS_HBUF) + (size_t)t * 256 * D, (const bf16_t*)(ws + WS_WGT) + (size_t)l * 32 * D, SE); } }
        GRID_BAR();
        for (int rep = 0; rep < REP_G1U; ++rep) { PHASE_ENV();
        for (int u = F.bid; u < 2080; u += F.G) { int row0, h;
            if (u < 2048) { const int bh = u >> 8, n = u & 255; h = bh & 3; row0 = (bh >> 2) * SEQ + 64 * n; }
            else { const int q = u - 2048, bh = q >> 2, n = q & 3; h = bh & 3; row0 = NLAT + (bh >> 2) * CTXL + 64 * n; }
            gla_g1_unit(F, P, l, row0, h, u); }
        __syncthreads(); }
        for (int rep = 0; rep < REP_F1U; ++rep) { PHASE_ENV();
        for (int u = F.bid; u < 1024; u += F.G) { const int b = u >> 9, nlo = (u >> 2) & 127, h = u & 3;
            fourier_f1_unit<128, 3>(F, P, b * SEQ + nlo, 128, h, (const bf16_t*)(ws + WS_TLAT) + (size_t)nlo * 32768, b * SEQ + nlo, 1.0f); }
        }
        { PHASE_ENV();
        if (!last) for (int u = (F.bid + F.G - 32) % F.G; u < 8; u += F.G) { const int b = u >> 2, h = u & 3;
            fourier_f1_unit<256, 2>(F, P, NLAT + b * CTXL, 1, h, (const bf16_t*)(ws + WS_TCTX), NLAT + b * CTXL, 1.0f / 128.0f); }
        }
        for (int rep = 0; rep < REP_CONV; ++rep) { PHASE_ENV();
        for (int u = F.bid; u < 512 + F.G; u += F.G) {
            int rowbase = 64 * u, Ls = 64, t0 = 0;
            if (u >= 512) { const int q = (u - 512) - 40; if (last || q < 0 || q >= 8) break; rowbase = NLAT + (q >> 2) * CTXL; Ls = CTXL; t0 = 64 * (q & 3); }
            conv_unit(F, P, l, rowbase, Ls, t0); } }
        GRID_BAR();
        { PHASE_ENV(); gla_scan(F, P, WT_DEF1_LO, WT_DEF1_HI); __syncthreads(); }
        for (int rep = 0; rep < REP_F2U; ++rep) { PHASE_ENV();
        fourier_f2_tables(F, P);
        for (int u = F.bid; u < 512; u += F.G) fourier_f2_unit(F, P, u >> 8, (u >> 1) & 127, u & 1); }
        GRID_BAR();
        for (int rep = 0; rep < REP_G3U; ++rep) { PHASE_ENV();
        for (int u = F.bid; u < (last ? 2048 : 2080); u += F.G) { int row0, h;
            if (u < 2048) { const int bh = u >> 8, n = u & 255; h = bh & 3; row0 = (bh >> 2) * SEQ + 64 * n; }
            else { const int q = u - 2048, bh = q >> 2, n = q & 3; h = bh & 3; row0 = NLAT + (bh >> 2) * CTXL + 64 * n; }
            gla_g3_unit(F, P, l, row0, h, u); }
        __syncthreads(); }
        GRID_BAR();
        { PHASE_ENV(); const int M2 = NLAT;
          pg8::Gemm g{(const bf16_t*)(ws + WS_CAT), (const bf16_t*)(ws + WS_WOUT) + (size_t)l * D * D, M2, D, D};
          pg8::StaticOrder S; S.init(M2, D, F.G, F.bid);
          pg8::EpiResid E{(float*)(ws + WS_XRES), (l == 0) ? P.in[0] : (const float*)(ws + WS_XRES), (const float*)(ws + WS_MODF) + (size_t)l * 3 * 6144};
          pg8::gemm_phase<pg8::EpiResid, pg8::StaticOrder>(F.lds, g, S, E, F.tid);
          if (!last) for (int t = F.bid; t < 2 * 32; t += F.G) { const int pm = NLAT / 256 + (t >> 5), nt32 = t & 31;
              SkEpiResid SE{(float*)(ws + WS_XRES) + (size_t)pm * 256 * D + nt32 * 32, P.in[2] + (size_t)(pm - NLAT / 256) * 256 * D + nt32 * 32, (const float*)(ws + WS_MODF) + ((size_t)l * 3 + 2) * 6144 + 2 * 1024 + nt32 * 32};
              skinny_unit(F, (const bf16_t*)(ws + WS_CAT) + (size_t)pm * 256 * D, (const bf16_t*)(ws + WS_WOUT) + (size_t)l * D * D + (size_t)nt32 * 32 * D, SE); } }
        GRID_BAR();
        const int ntok = last ? NLAT : NTOK;
        { PHASE_ENV(); phase_route(F, P, l, ntok); }
        GRID_BAR();
        if constexpr (F8_LAYER[l]) { { PHASE_ENV(); phase_gather8(F, P, l, ntok); } GRID_BAR(); }
        for (int rep = 0; rep < REP_GU; ++rep) { PHASE_ENV(); moe_prep(F, P, l); const volatile LAS int* TS = (const volatile LAS int*)(F.lds + LC_TS);
          pg8::MoeOrder S{8, F.G, F.bid, TS[NE], TS};
          if constexpr (F8_LAYER[l]) {
              pg8::Gemm g{(const bf16_t*)(ws + WS_XB8), (const bf16_t*)(ws + WS_WGU + (size_t)l * NE * 2048 * D * 2), 0, 2048, D / 2};
              pg8::EpiGateUp8 E{ws + WS_ACT, P.in[22] + (size_t)l * NE * 2048};
              pg8::gemm_phase<pg8::EpiGateUp8, pg8::MoeOrder, true, true, true>(F.lds, g, S, E, F.tid);
          } else {
              pg8::Gemm g{(const bf16_t*)(ws + WS_HBUF), (const bf16_t*)(ws + WS_WGU) + (size_t)l * NE * 2048 * D, 0, 2048, D};
              pg8::EpiGateUp E{(bf16_t*)(ws + WS_ACT), P.in[22] + (size_t)l * NE * 2048};
              pg8::gemm_phase_gather<pg8::EpiGateUp, pg8::MoeOrder>(F.lds, g, (const int*)(ws + WS_XB), S, E, F.tid); } }
        GRID_BAR();
        for (int rep = 0; rep < REP_DN; ++rep) { PHASE_ENV(); const volatile LAS int* TS = (const volatile LAS int*)(F.lds + LC_TS);
          pg8::MoeOrder S{4, F.G, F.bid, TS[NE], TS};
          if constexpr (F8_LAYER[l]) {
              pg8::Gemm g{(const bf16_t*)(ws + WS_ACT), (const bf16_t*)(ws + WS_WDN + (size_t)l * NE * D * DFF * 2), 0, D, DFF / 2};
              pg8::EpiDown8 E{ws + WS_YB, P.in[24] + (size_t)l * NE * D};
              pg8::gemm_phase<pg8::EpiDown8, pg8::MoeOrder, true, true, true>(F.lds, g, S, E, F.tid);
          } else {
              pg8::Gemm g{(const bf16_t*)(ws + WS_ACT), (const bf16_t*)(ws + WS_WDN) + (size_t)l * NE * D * DFF, 0, D, DFF};
              pg8::EpiDown E{(bf16_t*)(ws + WS_YB), P.in[24] + (size_t)l * NE * D};
              pg8::gemm_phase<pg8::EpiDown, pg8::MoeOrder>(F.lds, g, S, E, F.tid); } }
        GRID_BAR();
        { PHASE_ENV(); phase_combine(F, P, l, ntok, last); }
        if (!last) GRID_BAR();
    }
}

extern "C" void kernel_launch(void* const* d_in, const int* in_sizes, int n_in, void* d_out, int out_size, void* d_ws, size_t ws_size, hipStream_t stream) {
    static int grid = 0;
    if (grid == 0) {
        if (n_in != 26 || ws_size < WS_END) { fprintf(stderr, "kernel_launch: unexpected n_in %d or ws_size %zu (need %zu)\n", n_in, ws_size, (size_t)WS_END); grid = -1; return; }
        int dev = 0, cus = 0, per_cu = 0;
        if (hipGetDevice(&dev) != hipSuccess || hipDeviceGetAttribute(&cus, hipDeviceAttributeMultiprocessorCount, dev) != hipSuccess) { grid = -1; return; }
        if (hipFuncSetAttribute((const void*)mega_fwd, hipFuncAttributeMaxDynamicSharedMemorySize, LDS_BYTES) != hipSuccess) { fprintf(stderr, "kernel_launch: hipFuncSetAttribute failed\n"); grid = -1; return; }
        if (hipOccupancyMaxActiveBlocksPerMultiprocessor(&per_cu, (const void*)mega_fwd, NTHREADS, LDS_BYTES) != hipSuccess || per_cu < 1) { fprintf(stderr, "kernel_launch: occupancy query says %d\n", per_cu); }
        (void)hipGetLastError();
        grid = cus;
    }
    if (grid < 0) return;
    (void)hipMemsetAsync((char*)d_ws + WS_CTL, 0, CTL_ZERO_BYTES, stream);
    Params p{};
    for (int i = 0; i < 26; ++i) p.in[i] = (const float*)d_in[i];
    p.out = (float*)d_out; p.ws = (unsigned char*)d_ws;
    hipLaunchKernelGGL(mega_fwd, dim3(grid), dim3(NTHREADS), LDS_BYTES, stream, p);
}
```

```cpp
#include <hip/hip_runtime.h>
#include <cstdio>
#include <cstdint>

#define LAS __attribute__((address_space(3)))
#define GAS __attribute__((address_space(1)))
typedef unsigned short bf16_t;
typedef short bf16x8 __attribute__((ext_vector_type(8)));
typedef float f32x4 __attribute__((ext_vector_type(4)));
typedef float f32x2 __attribute__((ext_vector_type(2)));
typedef unsigned u32x4 __attribute__((ext_vector_type(4)));
typedef unsigned u32x2 __attribute__((ext_vector_type(2)));

constexpr int D = 1024, NBATCH = 2, SEQ = 16384, NLAT = NBATCH * SEQ, CTXL = 256, NCTX = NBATCH * CTXL, NTOK = NLAT + NCTX, DEPTH = 2;
constexpr int INW = 2336, INP = 2304;
constexpr int C_FOUR = 0, C_Q = 256, C_K = 512, C_V = 768, C_R = 1280, C_CA = 1792, C_CG = 2048;
constexpr int NE = 32, TOPK = 4, DFF = 1024;
constexpr int MAXROWS = NTOK * TOPK + NE * 256;
constexpr float NORM_EPS = 1e-6f;
constexpr int NTHREADS = 512, NWAVES = 8;

constexpr size_t MiB = 1u << 20;
constexpr size_t WS_CTL = 0, CTL_ZERO_BYTES = 1 * MiB;
constexpr size_t WS_MODP = 1 * MiB;
constexpr size_t WS_MODF = 3 * MiB;
constexpr size_t WS_RW = 3 * MiB + 512 * 1024;
constexpr size_t WS_WGT = 3 * MiB + 768 * 1024;
constexpr size_t WS_CM3 = 4 * MiB;
constexpr size_t WS_TF2 = 4 * MiB + 65536;
constexpr size_t WS_TCTX = 4 * MiB + 262144;
constexpr size_t WS_TLAT = 5 * MiB;
constexpr size_t WS_WIN = 13 * MiB;
constexpr size_t WS_WOUT = 23 * MiB;
constexpr size_t WS_WGU = 27 * MiB;
constexpr size_t WS_WDN = 283 * MiB;
constexpr size_t WS_XRES = 411 * MiB;
constexpr size_t WS_HBUF = 541 * MiB;
constexpr size_t WS_PBUF = 606 * MiB;
constexpr size_t WS_CAT = 769 * MiB;
constexpr size_t WS_T2 = 834 * MiB;
constexpr size_t WS_STATE = 866 * MiB;
constexpr size_t WS_DECAY = 996 * MiB;
constexpr size_t WS_AEXP = 998 * MiB, WS_APOS = 999 * MiB, WS_APROB = 1000 * MiB, WS_ASLOT = 1001 * MiB;
constexpr size_t WS_XB8 = 1106 * MiB;
constexpr size_t WS_HB8 = 1066 * MiB;
constexpr bool F8_LAYER[2] = {true, true};
constexpr size_t WS_LRB = 1018 * MiB;
constexpr size_t WS_XB = 1002 * MiB, WS_ACT = 1278 * MiB, WS_YB = 1554 * MiB, WS_END = 1830 * MiB;
constexpr int CW_BAR = 4096, CW_CNT = 16384;

constexpr int RING_BYTES = 131072;
constexpr int AUX_OFF = RING_BYTES;
constexpr int LCTL_OFF = RING_BYTES + 8192;
constexpr int LDS_BYTES = 147456;

__device__ __forceinline__ unsigned f2bf(float f) { unsigned u = __builtin_bit_cast(unsigned, f); return (u + 0x7fffu + ((u >> 16) & 1u)) >> 16; }
__device__ __forceinline__ unsigned pk2(float lo, float hi) { return f2bf(lo) | (f2bf(hi) << 16); }
__device__ __forceinline__ float bf2f(unsigned b) { return __builtin_bit_cast(float, b << 16); }
__device__ __forceinline__ float bflo(unsigned w) { return __builtin_bit_cast(float, w << 16); }
__device__ __forceinline__ float bfhi(unsigned w) { return __builtin_bit_cast(float, w & 0xffff0000u); }
__device__ __forceinline__ float wave_sum(float v) {
#pragma unroll
    for (int o = 1; o < 64; o <<= 1) v += __shfl_xor(v, o);
    return v;
}
__device__ __forceinline__ float sigmoidf_(float x) { return __builtin_amdgcn_rcpf(1.0f + __expf(-x)); }

#define XB_TMO      128
#define XB_XCNT(j)  (256  + 64 * (j))
#define XB_XSUB(j)  (1280 + 64 * (j))
#define XB_XGEN(j)  (2304 + 64 * (j))
#define XB_TOP      3328
#define XB_TOPGEN   3392
#define XCD_BAR_WORDS 3456
#define XB_SPIN_CAP (1u << 22)

__device__ __forceinline__ unsigned xb_ld(unsigned* p)              { return __hip_atomic_load(p, __ATOMIC_RELAXED, __HIP_MEMORY_SCOPE_AGENT); }
__device__ __forceinline__ unsigned xb_add(unsigned* p, unsigned v) { return __hip_atomic_fetch_add(p, v, __ATOMIC_RELAXED, __HIP_MEMORY_SCOPE_AGENT); }
__device__ __forceinline__ unsigned xb_xcc_id() { return (unsigned)__builtin_amdgcn_s_getreg((3 << 11) | 20) & 0xFu; }
#define XB_SPIN(cond, bar) do { unsigned _sp = 0; while (cond) { __builtin_amdgcn_s_sleep(1); \
    if ((++_sp & 255u) == 0u) { if (xb_ld(&(bar)[XB_TMO])) break; if (_sp > XB_SPIN_CAP) { atomicAdd(&(bar)[XB_TMO], 1u); break; } } } } while (0)

struct XcdBarrier { unsigned* bar; unsigned x; volatile LAS unsigned* st; };

__device__ __forceinline__ XcdBarrier xcd_barrier_post(unsigned* bar, volatile LAS unsigned* st) {
    XcdBarrier b; b.bar = bar; b.x = xb_xcc_id(); b.st = st;
    if (threadIdx.x == 0) (void)xb_add(&bar[XB_XCNT(b.x)], 1u);
    return b;
}
__device__ __forceinline__ void xcd_barrier_complete(unsigned* bar, unsigned x, unsigned& nloc, unsigned& nx) {
    const unsigned G = gridDim.x * gridDim.y * gridDim.z;
    unsigned sum, cnt, mine, sp = 0u;
    for (;;) {
        sum = 0u; cnt = 0u; mine = 0u;
#pragma unroll
        for (unsigned j = 0; j < 16; ++j) { const unsigned c = xb_ld(&bar[XB_XCNT(j)]); sum += c; cnt += (c > 0u) ? 1u : 0u; mine = (j == x) ? c : mine; }
        if (sum == G) break;
        __builtin_amdgcn_s_sleep(1);
        if ((++sp & 255u) == 0u) { if (xb_ld(&bar[XB_TMO])) break; if (sp > XB_SPIN_CAP) { atomicAdd(&bar[XB_TMO], 1u); break; } }
    }
    nloc = mine > 0u ? mine : 1u; nx = cnt > 0u ? cnt : 1u;
}
__device__ __forceinline__ void xcd_barrier(const XcdBarrier& b) {
    asm volatile("s_waitcnt vmcnt(0)" ::: "memory");
    __syncthreads();
    if (threadIdx.x == 0) {
        unsigned* bar = b.bar;
        __builtin_amdgcn_s_waitcnt(0);
        unsigned nloc = b.st[0], nx = b.st[1];
        if (nloc == 0u) { xcd_barrier_complete(bar, b.x, nloc, nx); b.st[0] = nloc; b.st[1] = nx; }
        const unsigned old = xb_add(&bar[XB_XSUB(b.x)], 1u);
        const unsigned gen = old / nloc;
        if (old + 1u == (gen + 1u) * nloc) {
            __builtin_amdgcn_fence(__ATOMIC_RELEASE, "agent");
            asm volatile("s_waitcnt vmcnt(0)" ::: "memory");
            const unsigned og = xb_add(&bar[XB_TOP], 1u);
            const unsigned tg = og / nx;
            if (og + 1u == (tg + 1u) * nx) xb_add(&bar[XB_TOPGEN], 1u);
            else XB_SPIN(xb_ld(&bar[XB_TOPGEN]) == tg, bar);
            __builtin_amdgcn_fence(__ATOMIC_ACQUIRE, "agent");
            xb_add(&bar[XB_XGEN(b.x)], 1u);
            asm volatile("s_waitcnt vmcnt(0)" ::: "memory");
        } else {
            XB_SPIN(xb_ld(&bar[XB_XGEN(b.x)]) == gen, bar);
            __builtin_amdgcn_fence(__ATOMIC_ACQUIRE, "agent");
            asm volatile("s_waitcnt vmcnt(0)" ::: "memory");
        }
    }
    __syncthreads();
}

namespace pg8 {
constexpr int BM = 256, BK = 64, HALF = 128, HTB = HALF * BK * 2, STAGE_BYTES = 8 * HTB, NXCD = 8, WGM = 8;
__host__ __device__ __forceinline__ int lds_byte(int r, int c) { const int st = (r >> 4) * 2 + (c >> 5), rr = r & 15, cc = c & 31, ob = rr * 64 + cc * 2; return st * 1024 + (ob ^ (((ob >> 9) & 1) << 5)); }
__host__ __device__ __forceinline__ void stage_rc(int b, int& R, int& C) { const int st = b / 1024, sb = b % 1024, swz = sb ^ (((sb >> 9) & 1) << 5); R = (st >> 1) * 16 + swz / 64; C = (st & 1) * 32 + (swz % 64) / 2; }
__host__ __device__ __forceinline__ int perm32(int rho) { const int n = rho >> 4, i = rho & 15; return 8 * (i >> 2) + 4 * n + (i & 3); }

struct Unit { int pm, pn, lbase, nvalid; };
struct Gemm { const bf16_t* A; const bf16_t* Bt; int M, N, K; };

struct StaticOrder {
    int nM, nN, nwg, G, c;
    __device__ void init(int M, int N, int G_, int c_) { nM = M / BM; nN = N / BM; nwg = nM * nN; G = G_; c = c_; }
    __device__ bool next(int i, Unit& u) const {
        const long L = (long)i * G + c; if (L >= nwg) return false;
        int wgid = (int)L; { const int q = nwg / NXCD, r = nwg % NXCD, xcd = wgid % NXCD, off = wgid / NXCD; wgid = (xcd < r ? xcd * (q + 1) : r * (q + 1) + (xcd - r) * q) + off; }
        const int nig = WGM * nN, gid = wgid / nig, fm = gid * WGM, gsz = (nM - fm) < WGM ? (nM - fm) : WGM;
        u.pm = fm + ((wgid % nig) % gsz); u.pn = (wgid % nig) / gsz; u.lbase = 0; u.nvalid = 0; return true;
    }
};
struct MoeOrder {
    int nN, G, c, MT; const volatile LAS int* ts;
    __device__ bool next(int i, Unit& u) const {
        const long L = (G % 8 == 0) ? ((long)i * G + (long)(c & 7) * (G >> 3) + (c >> 3)) : ((long)i * G + c);
        if (L >= (long)MT * nN) return false;
        const int mt = (int)(L / nN), pl = (int)(L % nN);
        const int lane = threadIdx.x & 63;
        const unsigned long long bal = __ballot(lane >= 1 && lane < NE && ts[lane] <= mt);
        const int e = __popcll(bal);
        const int j = mt - ts[e];
        u.pm = mt; u.pn = e * nN + pl; u.lbase = e * NTOK + j * 256; u.nvalid = ts[64 + e] - j * 256; return true;
    }
};

__device__ __forceinline__ unsigned cvt_pk_bf16(float lo, float hi) { unsigned r; asm volatile("v_cvt_pk_bf16_f32 %0, %1, %2" : "=v"(r) : "v"(lo), "v"(hi)); return r; }

struct EpiStoreBf16 {
    static constexpr bool PERM = true;
    bf16_t* O; int ldc;
    __device__ __forceinline__ void operator()(const f32x4 (&acc)[2][2][4][2], const Unit& u, int wr, int wc, int fr, int fq) const {
        const int row0 = u.pm * BM + wr * 64 + fr; const int col0 = u.pn * BM + wc * 32 + 8 * fq;
#pragma unroll
        for (int ai = 0; ai < 2; ++ai)
#pragma unroll
            for (int m = 0; m < 4; ++m) { bf16_t* rowp = O + (size_t)(row0 + ai * HALF + m * 16) * ldc + col0;
#pragma unroll
                for (int bj = 0; bj < 2; ++bj) { const f32x4 v0 = acc[ai][bj][m][0], v1 = acc[ai][bj][m][1];
                    u32x4 w; w.x = cvt_pk_bf16(v0[0], v0[1]); w.y = cvt_pk_bf16(v0[2], v0[3]); w.z = cvt_pk_bf16(v1[0], v1[1]); w.w = cvt_pk_bf16(v1[2], v1[3]);
                    *(u32x4*)(rowp + bj * HALF) = w; } }
    }
};
struct EpiResid {
    static constexpr bool PERM = false;
    float* X; const float* Xs; const float* modf;
    __device__ __forceinline__ void operator()(const f32x4 (&acc)[2][2][4][2], const Unit& u, int wr, int wc, int fr, int fq) const {
        const int row0 = u.pm * BM + wr * 64 + fr, col0 = u.pn * BM + wc * 32 + 4 * fq;
        const int v = (u.pm >= NLAT / BM) ? 2 : (u.pm >= SEQ / BM ? 1 : 0);
        const float* gv = modf + (size_t)v * 6144 + 2 * 1024;
        f32x4 bv[2][2];
#pragma unroll
        for (int bj = 0; bj < 2; ++bj)
#pragma unroll
            for (int n = 0; n < 2; ++n) bv[bj][n] = *(const f32x4*)(gv + col0 + bj * HALF + n * 16);
#pragma unroll
        for (int ai = 0; ai < 2; ++ai) {
            f32x4 xv[4][2][2];
#pragma unroll
            for (int m = 0; m < 4; ++m) { const float* rowp = Xs + (size_t)(row0 + ai * HALF + m * 16) * D + col0;
#pragma unroll
                for (int bj = 0; bj < 2; ++bj)
#pragma unroll
                    for (int n = 0; n < 2; ++n) xv[m][bj][n] = *(const f32x4*)(rowp + bj * HALF + n * 16); }
#pragma unroll
            for (int m = 0; m < 4; ++m) { float* rowp = X + (size_t)(row0 + ai * HALF + m * 16) * D + col0;
#pragma unroll
                for (int bj = 0; bj < 2; ++bj)
#pragma unroll
                    for (int n = 0; n < 2; ++n) *(f32x4*)(rowp + bj * HALF + n * 16) = xv[m][bj][n] + bv[bj][n] * acc[ai][bj][m][n]; }
        }
    }
};
struct EpiGateUp {
    static constexpr bool PERM = true;
    bf16_t* O; const float* bgu;
    __device__ __forceinline__ void operator()(const f32x4 (&acc)[2][2][4][2], const Unit& u, int wr, int wc, int fr, int fq) const {
        const int e = u.pn >> 3, pl = u.pn & 7;
        const int row0 = u.pm * BM + wr * 64 + fr; const int cl = pl * 128 + wc * 32 + 8 * fq;
        const float* bg = bgu + (size_t)e * 2048 + cl; const float* bu = bg + 1024;
        f32x4 g0 = *(const f32x4*)bg, g1 = *(const f32x4*)(bg + 4), u0 = *(const f32x4*)bu, u1 = *(const f32x4*)(bu + 4);
#pragma unroll
        for (int ai = 0; ai < 2; ++ai)
#pragma unroll
            for (int m = 0; m < 4; ++m) { bf16_t* rowp = O + (size_t)(row0 + ai * HALF + m * 16) * DFF + cl;
                float r[8];
#pragma unroll
                for (int n = 0; n < 2; ++n) { const f32x4 gb = n ? g1 : g0, ub = n ? u1 : u0; const f32x4 ga = acc[ai][0][m][n] + gb, ua = acc[ai][1][m][n] + ub;
#pragma unroll
                    for (int j = 0; j < 4; ++j) { const float gate = fminf(ga[j], 7.0f), up = fminf(fmaxf(ua[j], -7.0f), 7.0f);
                        r[n * 4 + j] = gate * __builtin_amdgcn_rcpf(1.0f + __expf(-1.702f * gate)) * (up + 1.0f); } }
                u32x4 w; w.x = cvt_pk_bf16(r[0], r[1]); w.y = cvt_pk_bf16(r[2], r[3]); w.z = cvt_pk_bf16(r[4], r[5]); w.w = cvt_pk_bf16(r[6], r[7]);
                *(u32x4*)rowp = w; }
    }
};
struct EpiDown {
    static constexpr bool PERM = true;
    bf16_t* O; const float* bdn;
    __device__ __forceinline__ void operator()(const f32x4 (&acc)[2][2][4][2], const Unit& u, int wr, int wc, int fr, int fq) const {
        const int e = u.pn >> 2, pl = u.pn & 3;
        const int row0 = u.pm * BM + wr * 64 + fr; const int col0 = pl * BM + wc * 32 + 8 * fq;
        f32x4 bv[2][2];
#pragma unroll
        for (int bj = 0; bj < 2; ++bj)
#pragma unroll
            for (int n = 0; n < 2; ++n) bv[bj][n] = *(const f32x4*)(bdn + (size_t)e * 1024 + col0 + bj * HALF + 4 * n);
#pragma unroll
        for (int ai = 0; ai < 2; ++ai)
#pragma unroll
            for (int m = 0; m < 4; ++m) { bf16_t* rowp = O + (size_t)(row0 + ai * HALF + m * 16) * D + col0;
#pragma unroll
                for (int bj = 0; bj < 2; ++bj) { const f32x4 v0 = acc[ai][bj][m][0] + bv[bj][0], v1 = acc[ai][bj][m][1] + bv[bj][1];
                    u32x4 w; w.x = cvt_pk_bf16(v0[0], v0[1]); w.y = cvt_pk_bf16(v0[2], v0[3]); w.z = cvt_pk_bf16(v1[0], v1[1]); w.w = cvt_pk_bf16(v1[2], v1[3]);
                    *(u32x4*)(rowp + bj * HALF) = w; } }
    }
};

__device__ __forceinline__ unsigned pk4_fp8(float a, float b, float c, float d) { unsigned w = 0u; w = __builtin_amdgcn_cvt_pk_fp8_f32(a, b, w, false); w = __builtin_amdgcn_cvt_pk_fp8_f32(c, d, w, true); return w; }
struct EpiGateUp8 {
    static constexpr bool PERM = true;
    unsigned char* O; const float* bgu;
    __device__ __forceinline__ void operator()(const f32x4 (&acc)[2][2][4][2], const Unit& u, int wr, int wc, int fr, int fq) const {
        const int e = u.pn >> 3, pl = u.pn & 7;
        const int row0 = u.pm * BM + wr * 64 + fr; const int cl = pl * 128 + wc * 32 + 8 * fq;
        const float* bg = bgu + (size_t)e * 2048 + cl; const float* bu = bg + 1024;
        f32x4 g0 = *(const f32x4*)bg, g1 = *(const f32x4*)(bg + 4), u0 = *(const f32x4*)bu, u1 = *(const f32x4*)(bu + 4);
#pragma unroll
        for (int ai = 0; ai < 2; ++ai)
#pragma unroll
            for (int m = 0; m < 4; ++m) { unsigned char* rowp = O + (size_t)(row0 + ai * HALF + m * 16) * DFF + cl;
                float r[8];
#pragma unroll
                for (int n = 0; n < 2; ++n) { const f32x4 gb = n ? g1 : g0, ub = n ? u1 : u0;
                    const f32x4 ga = acc[ai][0][m][n] * 0.015625f + gb, ua = acc[ai][1][m][n] * 0.015625f + ub;
                    const f32x4 gate = __builtin_elementwise_min(ga, (f32x4){7.f, 7.f, 7.f, 7.f});
                    const f32x4 up1 = __builtin_elementwise_min(__builtin_elementwise_max(ua, (f32x4){-7.f, -7.f, -7.f, -7.f}), (f32x4){7.f, 7.f, 7.f, 7.f}) + 1.0f;
                    const f32x4 xa = gate * (-1.702f * 1.44269504089f);
                    f32x4 den; den.x = __builtin_amdgcn_exp2f(xa.x); den.y = __builtin_amdgcn_exp2f(xa.y); den.z = __builtin_amdgcn_exp2f(xa.z); den.w = __builtin_amdgcn_exp2f(xa.w);
                    den = den + 1.0f;
                    f32x4 rc; rc.x = __builtin_amdgcn_rcpf(den.x); rc.y = __builtin_amdgcn_rcpf(den.y); rc.z = __builtin_amdgcn_rcpf(den.z); rc.w = __builtin_amdgcn_rcpf(den.w);
                    const f32x4 o = (gate * rc) * up1;
                    r[n * 4 + 0] = o.x; r[n * 4 + 1] = o.y; r[n * 4 + 2] = o.z; r[n * 4 + 3] = o.w; }
                u32x2 w; w.x = pk4_fp8(r[0], r[1], r[2], r[3]); w.y = pk4_fp8(r[4], r[5], r[6], r[7]);
                *(u32x2*)rowp = w; }
    }
};
struct EpiDown8 {
    static constexpr bool PERM = true;
    unsigned char* O; const float* bdn;
    __device__ __forceinline__ void operator()(const f32x4 (&acc)[2][2][4][2], const Unit& u, int wr, int wc, int fr, int fq) const {
        const int e = u.pn >> 2, pl = u.pn & 3;
        const int row0 = u.pm * BM + wr * 64 + fr; const int col0 = pl * BM + wc * 32 + 8 * fq;
        f32x4 bv[2][2];
#pragma unroll
        for (int bj = 0; bj < 2; ++bj)
#pragma unroll
            for (int n = 0; n < 2; ++n) bv[bj][n] = *(const f32x4*)(bdn + (size_t)e * 1024 + col0 + bj * HALF + 4 * n);
#pragma unroll
        for (int ai = 0; ai < 2; ++ai)
#pragma unroll
            for (int m = 0; m < 4; ++m) { unsigned char* rowp = O + (size_t)(row0 + ai * HALF + m * 16) * D + col0;
#pragma unroll
                for (int bj = 0; bj < 2; ++bj) { const f32x4 v0 = acc[ai][bj][m][0] * 0.015625f + bv[bj][0], v1 = acc[ai][bj][m][1] * 0.015625f + bv[bj][1];
                    u32x2 w; w.x = pk4_fp8(v0[0], v0[1], v0[2], v0[3]); w.y = pk4_fp8(v1[0], v1[1], v1[2], v1[3]);
                    *(u32x2*)(rowp + bj * HALF) = w; } }
    }
};

typedef int i32x8 __attribute__((ext_vector_type(8)));
typedef int i32x4 __attribute__((ext_vector_type(4)));
__device__ __forceinline__ i32x8 cat8(const bf16x8 lo, const bf16x8 hi) { const i32x4 a = __builtin_bit_cast(i32x4, lo), b = __builtin_bit_cast(i32x4, hi); return __builtin_shufflevector(a, b, 0, 1, 2, 3, 4, 5, 6, 7); }
template <class Epi, class Sched, bool ALIGN_EPI = true, bool SP2 = true, bool F8 = false>
__device__ __forceinline__ void gemm_phase(LAS unsigned char* lds, const Gemm g, const Sched& S, const Epi& E, const int tid) {
    const int wid = __builtin_amdgcn_readfirstlane(tid >> 6), lane = tid & 63, wr = wid >> 2, wc = wid & 3, fr = lane & 15, fq = lane >> 4;
    const int K = g.K, nt = K / BK;
    unsigned voffA[2], voffB[2];
#pragma unroll
    for (int i = 0; i < 2; ++i) { int R, C; stage_rc(tid * 16 + i * 8192, R, C); const int Rb = Epi::PERM ? ((R & ~31) + perm32(R & 31)) : R;
        voffA[i] = (unsigned)(R * K + C) * 2u; voffB[i] = (unsigned)(Rb * K + C) * 2u; }
    const size_t kstep = (size_t)(BK * 2);
    const size_t hstep = (size_t)HALF * K * 2;
    const size_t tstep = 2 * hstep;
    const unsigned ldsw = (unsigned)wid * 1024u;
    const int aoff = lds_byte(wr * 64 + fr, fq * 8), boff = lds_byte(wc * 32 + fr, fq * 8);
#define PG8_SA(b, h) (((b) * 2 + (h)) * HTB)
#define PG8_SB(b, h) ((4 + (b) * 2 + (h)) * HTB)
#define PG8_STAGE(bufoff, gbase, voff) do { _Pragma("unroll") for (int _i = 0; _i < 2; ++_i) \
        __builtin_amdgcn_global_load_lds((const unsigned*)((const char*)(gbase) + (voff)[_i]), (LAS unsigned*)(lds + (bufoff) + ldsw + _i * 8192), 16, 0, 0); } while (0)
#define PG8_LDA(dst, b, h) do { _Pragma("unroll") for (int m = 0; m < 4; ++m) { if constexpr (F8) dst##8[m] = cat8(*(const LAS bf16x8*)(lds + PG8_SA(b, h) + aoff + m * 2048), *(const LAS bf16x8*)(lds + PG8_SA(b, h) + aoff + m * 2048 + 1024)); \
        else { _Pragma("unroll") for (int k = 0; k < 2; ++k) dst[m][k] = *(const LAS bf16x8*)(lds + PG8_SA(b, h) + aoff + m * 2048 + k * 1024); } } } while (0)
#define PG8_LDB(dst, b, h) do { _Pragma("unroll") for (int n = 0; n < 2; ++n) { if constexpr (F8) dst##8[n] = cat8(*(const LAS bf16x8*)(lds + PG8_SB(b, h) + boff + n * 2048), *(const LAS bf16x8*)(lds + PG8_SB(b, h) + boff + n * 2048 + 1024)); \
        else { _Pragma("unroll") for (int k = 0; k < 2; ++k) dst[n][k] = *(const LAS bf16x8*)(lds + PG8_SB(b, h) + boff + n * 2048 + k * 1024); } } } while (0)
#define PG8_MMA(ai, bj, At, Bt) do { __builtin_amdgcn_s_setprio(1); \
        if constexpr (F8) { _Pragma("unroll") for (int m = 0; m < 4; ++m) _Pragma("unroll") for (int n = 0; n < 2; ++n) \
            acc[ai][bj][m][n] = __builtin_amdgcn_mfma_scale_f32_16x16x128_f8f6f4(Bt##8[n], At##8[m], acc[ai][bj][m][n], 0, 0, 0, 0x7f7f7f7f, 0, 0x7f7f7f7f); \
            _Pragma("unroll") for (int m = 0; m < 4; ++m) _Pragma("unroll") for (int n = 0; n < 2; ++n) asm volatile("" : "+v"(acc[ai][bj][m][n])); } \
        else { _Pragma("unroll") for (int m = 0; m < 4; ++m) _Pragma("unroll") for (int n = 0; n < 2; ++n) _Pragma("unroll") for (int k = 0; k < 2; ++k) \
            acc[ai][bj][m][n] = __builtin_amdgcn_mfma_f32_16x16x32_bf16(Bt[n][k], At[m][k], acc[ai][bj][m][n], 0, 0, 0); } \
        __builtin_amdgcn_s_setprio(0); } while (0)
#define PG8_WAIT_V(n) asm volatile("s_waitcnt vmcnt(" #n ")" ::: "memory")
#define PG8_WAIT_L(n) asm volatile("s_waitcnt lgkmcnt(" #n ")" ::: "memory")
#define PG8_BAR __builtin_amdgcn_s_barrier()
#define PG8_SCHED __builtin_amdgcn_sched_barrier(0)
    Unit cur, nxt; int ui = 0;
    if (!S.next(0, cur)) return;
    f32x4 acc[2][2][4][2];
#pragma unroll
    for (int a = 0; a < 2; ++a)
#pragma unroll
        for (int b = 0; b < 2; ++b)
#pragma unroll
            for (int m = 0; m < 4; ++m)
#pragma unroll
                for (int n = 0; n < 2; ++n) acc[a][b][m][n] = (f32x4){0.f, 0.f, 0.f, 0.f};
    bf16x8 At[4][2], B0[2][2], B1[2][2]; i32x8 At8[4], B08[2], B18[2];
    const char* cA = (const char*)g.A + (size_t)cur.pm * tstep; const char* cB = (const char*)g.Bt + (size_t)cur.pn * tstep;
    if constexpr (SP2) {
        PG8_STAGE(PG8_SB(0, 0), cB, voffB); PG8_STAGE(PG8_SB(0, 1), cB + hstep, voffB); PG8_STAGE(PG8_SA(0, 0), cA, voffA); PG8_STAGE(PG8_SA(0, 1), cA + hstep, voffA);
        if (wr == 1) PG8_BAR;
        PG8_WAIT_V(2); PG8_BAR;
        PG8_STAGE(PG8_SB(1, 0), cB + kstep, voffB); PG8_STAGE(PG8_SA(1, 0), cA + kstep, voffA); PG8_STAGE(PG8_SB(1, 1), cB + hstep + kstep, voffB);
        PG8_WAIT_V(6); PG8_BAR;
    } else {
        PG8_STAGE(PG8_SB(0, 0), cB, voffB); PG8_STAGE(PG8_SA(0, 0), cA, voffA); PG8_STAGE(PG8_SB(0, 1), cB + hstep, voffB); PG8_STAGE(PG8_SA(0, 1), cA + hstep, voffA);
        if (wr == 1) PG8_BAR;
        PG8_WAIT_V(4); PG8_BAR;
        PG8_STAGE(PG8_SB(1, 0), cB + kstep, voffB); PG8_STAGE(PG8_SA(1, 0), cA + kstep, voffA); PG8_STAGE(PG8_SB(1, 1), cB + hstep + kstep, voffB);
        PG8_WAIT_V(6); PG8_BAR;
    }
    for (;;) {
        const bool has_next = S.next(ui + 1, nxt);
        const char* nA = has_next ? (const char*)g.A + (size_t)nxt.pm * tstep : cA; const char* nB = has_next ? (const char*)g.Bt + (size_t)nxt.pn * tstep : cB;
        for (int t = 0; t < nt; t += 2) {
            const bool last = (t == nt - 2);
            const char* a1 = cA + (size_t)(t + 1) * kstep;
            const char* a2 = last ? nA : cA + (size_t)(t + 2) * kstep; const char* b2 = last ? nB : cB + (size_t)(t + 2) * kstep;
            const char* a3 = a2 + kstep; const char* b3 = b2 + kstep;
            if constexpr (SP2) {
            PG8_LDB(B0, 0, 0); PG8_LDB(B1, 0, 1); PG8_SCHED; PG8_LDA(At, 0, 0); PG8_STAGE(PG8_SA(1, 1), a1 + hstep, voffA);
            PG8_WAIT_V(8); PG8_WAIT_L(0); PG8_BAR; PG8_MMA(0, 0, At, B0); PG8_MMA(0, 1, At, B1); PG8_BAR; PG8_SCHED;
            PG8_LDA(At, 0, 1); PG8_STAGE(PG8_SB(0, 0), b2, voffB); PG8_STAGE(PG8_SB(0, 1), b2 + hstep, voffB); PG8_STAGE(PG8_SA(0, 0), a2, voffA);
            PG8_WAIT_V(8); PG8_WAIT_L(0); PG8_BAR; PG8_MMA(1, 0, At, B0); PG8_MMA(1, 1, At, B1); PG8_BAR; PG8_SCHED;
            PG8_LDB(B0, 1, 0); PG8_LDB(B1, 1, 1); PG8_SCHED; PG8_LDA(At, 1, 0); PG8_STAGE(PG8_SA(0, 1), a2 + hstep, voffA);
            PG8_WAIT_V(8); PG8_WAIT_L(0); PG8_BAR; PG8_MMA(0, 0, At, B0); PG8_MMA(0, 1, At, B1); PG8_BAR; PG8_SCHED;
            PG8_LDA(At, 1, 1); PG8_STAGE(PG8_SB(1, 0), b3, voffB); PG8_STAGE(PG8_SB(1, 1), b3 + hstep, voffB); PG8_STAGE(PG8_SA(1, 0), a3, voffA);
            PG8_WAIT_V(8); PG8_WAIT_L(0); PG8_BAR; PG8_MMA(1, 0, At, B0); PG8_MMA(1, 1, At, B1); PG8_BAR; PG8_SCHED;
            } else {
            PG8_LDB(B0, 0, 0); PG8_SCHED; PG8_LDA(At, 0, 0); PG8_STAGE(PG8_SA(1, 1), a1 + hstep, voffA);
            PG8_WAIT_L(8); PG8_BAR; PG8_WAIT_L(0); PG8_MMA(0, 0, At, B0); PG8_BAR; PG8_SCHED;
            PG8_LDB(B1, 0, 1); PG8_STAGE(PG8_SB(0, 0), b2, voffB);
            PG8_BAR; PG8_WAIT_L(0); PG8_MMA(0, 1, At, B1); PG8_BAR;
            PG8_LDA(At, 0, 1); PG8_STAGE(PG8_SA(0, 0), a2, voffA);
            PG8_BAR; PG8_WAIT_L(0); PG8_MMA(1, 0, At, B0); PG8_BAR; PG8_SCHED;
            PG8_STAGE(PG8_SB(0, 1), b2 + hstep, voffB);
            PG8_WAIT_V(6); PG8_BAR; PG8_MMA(1, 1, At, B1); PG8_BAR;
            PG8_LDB(B0, 1, 0); PG8_SCHED; PG8_LDA(At, 1, 0); PG8_STAGE(PG8_SA(0, 1), a2 + hstep, voffA);
            PG8_WAIT_L(8); PG8_BAR; PG8_WAIT_L(0); PG8_MMA(0, 0, At, B0); PG8_BAR; PG8_SCHED;
            PG8_LDB(B1, 1, 1); PG8_STAGE(PG8_SB(1, 0), b3, voffB);
            PG8_BAR; PG8_WAIT_L(0); PG8_MMA(0, 1, At, B1); PG8_BAR;
            PG8_LDA(At, 1, 1); PG8_STAGE(PG8_SA(1, 0), a3, voffA);
            PG8_BAR; PG8_WAIT_L(0); PG8_MMA(1, 0, At, B0); PG8_BAR; PG8_SCHED;
            PG8_STAGE(PG8_SB(1, 1), b3 + hstep, voffB);
            PG8_WAIT_V(6); PG8_BAR; PG8_MMA(1, 1, At, B1); PG8_BAR;
            }
        }
        if constexpr (ALIGN_EPI) { if (wr == 0) PG8_BAR; }
        E(acc, cur, wr, wc, fr, fq);
        if (!has_next) break;
#pragma unroll
        for (int a = 0; a < 2; ++a)
#pragma unroll
            for (int b = 0; b < 2; ++b)
#pragma unroll
                for (int m = 0; m < 4; ++m)
#pragma unroll
                    for (int n = 0; n < 2; ++n) acc[a][b][m][n] = (f32x4){0.f, 0.f, 0.f, 0.f};
        cur = nxt; cA = nA; cB = nB; ++ui;
        if constexpr (ALIGN_EPI) { if (wr == 1) PG8_BAR; }
    }
    PG8_WAIT_V(0);
    if constexpr (!ALIGN_EPI) { if (wr == 0) PG8_BAR; }
    PG8_BAR;
#undef PG8_SA
#undef PG8_SB
#undef PG8_STAGE
#undef PG8_LDA
#undef PG8_LDB
#undef PG8_MMA
#undef PG8_WAIT_V
#undef PG8_WAIT_L
#undef PG8_BAR
#undef PG8_SCHED
}

template <class Epi, class Sched, bool F8 = false>
__device__ __forceinline__ void gemm_phase_gather(LAS unsigned char* lds, const Gemm g, const int* list, const Sched& S, const Epi& E, const int tid) {
    const int wid = __builtin_amdgcn_readfirstlane(tid >> 6), lane = tid & 63, wr = wid >> 2, wc = wid & 3, fr = lane & 15, fq = lane >> 4;
    const int K = g.K, nt = K / BK;
    unsigned voffB0, cA2;
    { int R, C; stage_rc(tid * 16, R, C); const int Rb = Epi::PERM ? ((R & ~31) + perm32(R & 31)) : R; cA2 = (unsigned)C * 2u; voffB0 = (unsigned)(Rb * K + C) * 2u; }
    const unsigned voffB[2] = {voffB0, voffB0 + (unsigned)(64 * K * 2)};
    const size_t kstep = (size_t)(BK * 2);
    const size_t hstep = (size_t)HALF * K * 2;
    const size_t tstep = 2 * hstep;
    const unsigned ldsw = (unsigned)wid * 1024u;
    const int aoff = lds_byte(wr * 64 + fr, fq * 8), boff = lds_byte(wc * 32 + fr, fq * 8);
#define PG8_SA(b, h) (((b) * 2 + (h)) * HTB)
#define PG8_SB(b, h) ((4 + (b) * 2 + (h)) * HTB)
#define PG8_STAGE(bufoff, gbase, voff) do { _Pragma("unroll") for (int _i = 0; _i < 2; ++_i) \
        __builtin_amdgcn_global_load_lds((const unsigned*)((const char*)(gbase) + (voff)[_i]), (LAS unsigned*)(lds + (bufoff) + ldsw + _i * 8192), 16, 0, 0); } while (0)
#define PG8_LDA(dst, b, h) do { _Pragma("unroll") for (int m = 0; m < 4; ++m) { if constexpr (F8) dst##8[m] = cat8(*(const LAS bf16x8*)(lds + PG8_SA(b, h) + aoff + m * 2048), *(const LAS bf16x8*)(lds + PG8_SA(b, h) + aoff + m * 2048 + 1024)); \
        else { _Pragma("unroll") for (int k = 0; k < 2; ++k) dst[m][k] = *(const LAS bf16x8*)(lds + PG8_SA(b, h) + aoff + m * 2048 + k * 1024); } } } while (0)
#define PG8_LDB(dst, b, h) do { _Pragma("unroll") for (int n = 0; n < 2; ++n) { if constexpr (F8) dst##8[n] = cat8(*(const LAS bf16x8*)(lds + PG8_SB(b, h) + boff + n * 2048), *(const LAS bf16x8*)(lds + PG8_SB(b, h) + boff + n * 2048 + 1024)); \
        else { _Pragma("unroll") for (int k = 0; k < 2; ++k) dst[n][k] = *(const LAS bf16x8*)(lds + PG8_SB(b, h) + boff + n * 2048 + k * 1024); } } } while (0)
#define PG8_MMA(ai, bj, At, Bt) do { __builtin_amdgcn_s_setprio(1); \
        if constexpr (F8) { _Pragma("unroll") for (int m = 0; m < 4; ++m) _Pragma("unroll") for (int n = 0; n < 2; ++n) \
            acc[ai][bj][m][n] = __builtin_amdgcn_mfma_scale_f32_16x16x128_f8f6f4(Bt##8[n], At##8[m], acc[ai][bj][m][n], 0, 0, 0, 0x7f7f7f7f, 0, 0x7f7f7f7f); \
            asm volatile("" : "+v"(acc[ai][bj][0][0]), "+v"(acc[ai][bj][0][1]), "+v"(acc[ai][bj][1][0]), "+v"(acc[ai][bj][1][1]), "+v"(acc[ai][bj][2][0]), "+v"(acc[ai][bj][2][1]), "+v"(acc[ai][bj][3][0]), "+v"(acc[ai][bj][3][1])); } \
        else { _Pragma("unroll") for (int m = 0; m < 4; ++m) _Pragma("unroll") for (int n = 0; n < 2; ++n) _Pragma("unroll") for (int k = 0; k < 2; ++k) \
            acc[ai][bj][m][n] = __builtin_amdgcn_mfma_f32_16x16x32_bf16(Bt[n][k], At[m][k], acc[ai][bj][m][n], 0, 0, 0); } \
        __builtin_amdgcn_s_setprio(0); } while (0)
#define PG8_WAIT_V(n) asm volatile("s_waitcnt vmcnt(" #n ")" ::: "memory")
#define PG8_WAIT_L(n) asm volatile("s_waitcnt lgkmcnt(" #n ")" ::: "memory")
#define PG8_BAR __builtin_amdgcn_s_barrier()
#define PG8_SCHED __builtin_amdgcn_sched_barrier(0)
#define PG8_LOADTOK(u, vo) do { int _ra0, _ra1, _c; stage_rc(tid * 16, _ra0, _c); stage_rc(tid * 16 + 8192, _ra1, _c); _Pragma("unroll") for (int _h = 0; _h < 2; ++_h) { const int _r0 = _h * HALF + _ra0, _r1 = _h * HALF + _ra1; \
        const unsigned _t0 = (_r0 < (u).nvalid) ? (unsigned)list[(u).lbase + _r0] : 0u, _t1 = (_r1 < (u).nvalid) ? (unsigned)list[(u).lbase + _r1] : 0u; (vo)[_h] = _t0 | (_t1 << 16); } } while (0)
#define PG8_STAGE_A(bufoff, gbase, pk) do { _Pragma("unroll") for (int _i = 0; _i < 2; ++_i) { const unsigned _off = (((pk) >> (16 * _i)) & 0xffffu) * (unsigned)(K * 2) + cA2; \
        __builtin_amdgcn_global_load_lds((const unsigned*)((const char*)(gbase) + _off), (LAS unsigned*)(lds + (bufoff) + ldsw + _i * 8192), 16, 0, 0); } } while (0)
    Unit cur, nxt; int ui = 0;
    if (!S.next(0, cur)) return;
    f32x4 acc[2][2][4][2];
#pragma unroll
    for (int a = 0; a < 2; ++a)
#pragma unroll
        for (int b = 0; b < 2; ++b)
#pragma unroll
            for (int m = 0; m < 4; ++m)
#pragma unroll
                for (int n = 0; n < 2; ++n) acc[a][b][m][n] = (f32x4){0.f, 0.f, 0.f, 0.f};
    bf16x8 At[4][2], B0[2][2], B1[2][2]; i32x8 At8[4], B08[2], B18[2];
    unsigned vc[2], vn[2];
    PG8_LOADTOK(cur, vc);
    const char* gA = (const char*)g.A; const char* cB = (const char*)g.Bt + (size_t)cur.pn * tstep;
    PG8_STAGE(PG8_SB(0, 0), cB, voffB); PG8_STAGE(PG8_SB(0, 1), cB + hstep, voffB); PG8_STAGE_A(PG8_SA(0, 0), gA, vc[0]); PG8_STAGE_A(PG8_SA(0, 1), gA, vc[1]);
    if (wr == 1) PG8_BAR;
    PG8_WAIT_V(2); PG8_BAR;
    PG8_STAGE(PG8_SB(1, 0), cB + kstep, voffB); PG8_STAGE_A(PG8_SA(1, 0), gA + kstep, vc[0]); PG8_STAGE(PG8_SB(1, 1), cB + hstep + kstep, voffB);
    PG8_WAIT_V(6); PG8_BAR;
    for (;;) {
        const bool has_next = S.next(ui + 1, nxt);
        if (has_next) { PG8_LOADTOK(nxt, vn); }
        const char* nB = has_next ? (const char*)g.Bt + (size_t)nxt.pn * tstep : cB;
        for (int t = 0; t < nt; t += 2) {
            const bool last = (t == nt - 2);
            const char* a1 = gA + (size_t)(t + 1) * kstep;
            const char* b2 = last ? nB : cB + (size_t)(t + 2) * kstep; const char* b3 = b2 + kstep;
            const char* a2 = last ? gA : gA + (size_t)(t + 2) * kstep; const char* a3 = a2 + kstep;
            PG8_LDB(B0, 0, 0); PG8_LDB(B1, 0, 1); PG8_SCHED; PG8_LDA(At, 0, 0); PG8_STAGE_A(PG8_SA(1, 1), a1, vc[1]);
            if (last && has_next) {
                vc[0] = vn[0]; vc[1] = vn[1]; }
            PG8_WAIT_V(8); PG8_WAIT_L(0); PG8_BAR; PG8_MMA(0, 0, At, B0); PG8_MMA(0, 1, At, B1); PG8_BAR; PG8_SCHED;
            PG8_LDA(At, 0, 1); PG8_STAGE(PG8_SB(0, 0), b2, voffB); PG8_STAGE(PG8_SB(0, 1), b2 + hstep, voffB); PG8_STAGE_A(PG8_SA(0, 0), a2, vc[0]);
            PG8_WAIT_V(8); PG8_WAIT_L(0); PG8_BAR; PG8_MMA(1, 0, At, B0); PG8_MMA(1, 1, At, B1); PG8_BAR; PG8_SCHED;
            PG8_LDB(B0, 1, 0); PG8_LDB(B1, 1, 1); PG8_SCHED; PG8_LDA(At, 1, 0); PG8_STAGE_A(PG8_SA(0, 1), a2, vc[1]);
            PG8_WAIT_V(8); PG8_WAIT_L(0); PG8_BAR; PG8_MMA(0, 0, At, B0); PG8_MMA(0, 1, At, B1); PG8_BAR; PG8_SCHED;
            PG8_LDA(At, 1, 1); PG8_STAGE(PG8_SB(1, 0), b3, voffB); PG8_STAGE(PG8_SB(1, 1), b3 + hstep, voffB); PG8_STAGE_A(PG8_SA(1, 0), a3, vc[0]);
            PG8_WAIT_V(8); PG8_WAIT_L(0); PG8_BAR; PG8_MMA(1, 0, At, B0); PG8_MMA(1, 1, At, B1); PG8_BAR; PG8_SCHED;
        }
        if (wr == 0) PG8_BAR;
        E(acc, cur, wr, wc, fr, fq);
        if (!has_next) break;
#pragma unroll
        for (int a = 0; a < 2; ++a)
#pragma unroll
            for (int b = 0; b < 2; ++b)
#pragma unroll
                for (int m = 0; m < 4; ++m)
#pragma unroll
                    for (int n = 0; n < 2; ++n) acc[a][b][m][n] = (f32x4){0.f, 0.f, 0.f, 0.f};
        cur = nxt; cB = nB; ++ui;
        if (wr == 1) PG8_BAR;
    }
    PG8_WAIT_V(0);
    PG8_BAR;
#undef PG8_SA
#undef PG8_SB
#undef PG8_STAGE
#undef PG8_LDA
#undef PG8_LDB
#undef PG8_MMA
#undef PG8_WAIT_V
#undef PG8_WAIT_L
#undef PG8_BAR
#undef PG8_SCHED
#undef PG8_STAGE_A
#undef PG8_LOADTOK
}
}

struct Params {
    const float* in[26];
    float* out;
    unsigned char* ws;
};
struct Frame {
    LAS unsigned char* lds;
    int tid, lane, wave, G, bid;
};

template <int MT, int NT>
__device__ __forceinline__ void mma_nt(f32x4 (&acc)[MT][NT], const LAS bf16_t* A, int lda, const LAS bf16_t* B, int ldb, int K, int fr, int fq) {
    for (int k0 = 0; k0 < K; k0 += 32) {
        bf16x8 a[MT], b[NT];
#pragma unroll
        for (int m = 0; m < MT; ++m) a[m] = *(const LAS bf16x8*)(A + (m * 16 + fr) * lda + k0 + fq * 8);
#pragma unroll
        for (int n = 0; n < NT; ++n) b[n] = *(const LAS bf16x8*)(B + (n * 16 + fr) * ldb + k0 + fq * 8);
#pragma unroll
        for (int m = 0; m < MT; ++m)
#pragma unroll
            for (int n = 0; n < NT; ++n) acc[m][n] = __builtin_amdgcn_mfma_f32_16x16x32_bf16(a[m], b[n], acc[m][n], 0, 0, 0);
    }
}
template <int MT, int NT> __device__ __forceinline__ void zero_acc(f32x4 (&acc)[MT][NT]) {
#pragma unroll
    for (int m = 0; m < MT; ++m)
#pragma unroll
        for (int n = 0; n < NT; ++n) acc[m][n] = (f32x4){0.f, 0.f, 0.f, 0.f};
}

constexpr int SK_A = 0, SK_B = 69632;
template <class Epi>
__device__ __forceinline__ void skinny_unit(const Frame& F, const bf16_t* A, const bf16_t* Bt, const Epi& E) {
    LAS bf16_t* As = (LAS bf16_t*)(F.lds + SK_A); LAS bf16_t* Bs = (LAS bf16_t*)(F.lds + SK_B);
    const int tid = F.tid, fr = F.lane & 15, fq = F.lane >> 4, w = F.wave;
    f32x4 acc[2][2]; zero_acc<2, 2>(acc);
    u32x4 av[8], bv;
#pragma unroll
    for (int i = 0; i < 8; ++i) { const int ch = tid + NTHREADS * i, r = ch >> 4, c8 = (ch & 15) * 8; av[i] = *(const u32x4*)(A + (size_t)r * D + c8); }
    { const int r = tid >> 4, c8 = (tid & 15) * 8; bv = *(const u32x4*)(Bt + (size_t)r * D + c8); }
    for (int kc = 0; kc < 8; ++kc) {
        __syncthreads();
#pragma unroll
        for (int i = 0; i < 8; ++i) { const int ch = tid + NTHREADS * i, r = ch >> 4, c8 = (ch & 15) * 8; *(LAS u32x4*)(As + r * 136 + c8) = av[i]; }
        { const int r = tid >> 4, c8 = (tid & 15) * 8; *(LAS u32x4*)(Bs + r * 136 + c8) = bv; }
        if (kc + 1 < 8) {
#pragma unroll
            for (int i = 0; i < 8; ++i) { const int ch = tid + NTHREADS * i, r = ch >> 4, c8 = (ch & 15) * 8; av[i] = *(const u32x4*)(A + (size_t)r * D + (kc + 1) * 128 + c8); }
            { const int r = tid >> 4, c8 = (tid & 15) * 8; bv = *(const u32x4*)(Bt + (size_t)r * D + (kc + 1) * 128 + c8); } }
        __syncthreads();
        mma_nt<2, 2>(acc, As + (32 * w) * 136, 136, Bs, 136, 128, fr, fq);
    }
#pragma unroll
    for (int mt = 0; mt < 2; ++mt)
#pragma unroll
        for (int nt = 0; nt < 2; ++nt)
#pragma unroll
            for (int j = 0; j < 4; ++j) E(32 * w + mt * 16 + fq * 4 + j, nt * 16 + fr, acc[mt][nt][j]);
    __syncthreads();
}
struct SkEpiBf16 { bf16_t* O; int ldc; __device__ __forceinline__ void operator()(int r, int c, float v) const { O[(size_t)r * ldc + c] = (bf16_t)f2bf(v); } };
struct SkEpiResid { float* X; const float* Xs; const float* gate; __device__ __forceinline__ void operator()(int r, int c, float v) const { X[(size_t)r * D + c] = Xs[(size_t)r * D + c] + gate[c] * v; } };

__device__ __forceinline__ void p0_transpose_item(const float* W, int K, int N, bf16_t* WT, int k0, int n0, int orow0, LAS float* scr, int lane) {
    float tv[32];
#pragma unroll
    for (int i = 0; i < 32; ++i) { const int kk = 2 * i + (lane >> 5); tv[i] = W[(size_t)(k0 + kk) * N + n0 + (lane & 31)]; }
#pragma unroll
    for (int i = 0; i < 32; ++i) { const int kk = 2 * i + (lane >> 5); scr[kk * 33 + (lane & 31)] = tv[i]; }
    asm volatile("s_waitcnt lgkmcnt(0)" ::: "memory");
    const int c = lane & 7;
#pragma unroll
    for (int j = 0; j < 4; ++j) { const int n = (lane >> 3) + 8 * j; const LAS float* s = scr + (8 * c) * 33 + n;
        u32x4 o; o.x = pk2(s[0 * 33], s[1 * 33]); o.y = pk2(s[2 * 33], s[3 * 33]); o.z = pk2(s[4 * 33], s[5 * 33]); o.w = pk2(s[6 * 33], s[7 * 33]);
        *(u32x4*)(WT + (size_t)(orow0 + n) * K + k0 + 8 * c) = o; }
    asm volatile("s_waitcnt lgkmcnt(0)" ::: "memory");
}

using pg8::pk4_fp8;
__device__ __forceinline__ void p0_transpose_item8(const float* W, int K, int N, unsigned char* WT8, int k0, int n0, int orow0, LAS float* scr, int lane) {
    float tv[32];
#pragma unroll
    for (int i = 0; i < 32; ++i) { const int kk = 2 * i + (lane >> 5); tv[i] = W[(size_t)(k0 + kk) * N + n0 + (lane & 31)]; }
#pragma unroll
    for (int i = 0; i < 32; ++i) { const int kk = 2 * i + (lane >> 5); scr[kk * 33 + (lane & 31)] = tv[i]; }
    asm volatile("s_waitcnt lgkmcnt(0)" ::: "memory");
    const int c = lane & 3;
#pragma unroll
    for (int j = 0; j < 2; ++j) { const int n = (lane >> 2) + 16 * j; const LAS float* sp = scr + (16 * c) * 33 + n;
        u32x4 o; o.x = pk4_fp8(64.f * sp[0 * 33], 64.f * sp[1 * 33], 64.f * sp[2 * 33], 64.f * sp[3 * 33]); o.y = pk4_fp8(64.f * sp[4 * 33], 64.f * sp[5 * 33], 64.f * sp[6 * 33], 64.f * sp[7 * 33]);
        o.z = pk4_fp8(64.f * sp[8 * 33], 64.f * sp[9 * 33], 64.f * sp[10 * 33], 64.f * sp[11 * 33]); o.w = pk4_fp8(64.f * sp[12 * 33], 64.f * sp[13 * 33], 64.f * sp[14 * 33], 64.f * sp[15 * 33]);
        *(u32x4*)(WT8 + (size_t)(orow0 + n) * K + k0 + 16 * c) = o; }
    asm volatile("s_waitcnt lgkmcnt(0)" ::: "memory");
}

constexpr int WT_I_IN = 16 * 73, WT_I_OUT = 16 * 32, WT_I_GU = 16 * 64, WT_I_DN = 16 * 32;
constexpr int WT_PER_LAYER = WT_I_IN + WT_I_OUT + NE * WT_I_GU + NE * WT_I_DN;
constexpr int WT_DEF0_LO = WT_PER_LAYER + WT_I_IN + WT_I_OUT + NE * WT_I_GU, WT_DEF0_HI = 2 * WT_PER_LAYER;
constexpr int WT_DEF1_LO = WT_PER_LAYER + WT_I_IN + WT_I_OUT, WT_DEF1_HI = WT_DEF1_LO + 16 * WT_I_GU;
__device__ __forceinline__ void weight_item(const Params& P, int it, LAS float* scr, int lane) {
    unsigned char* ws = P.ws;
    const int l = it / WT_PER_LAYER; int r = it % WT_PER_LAYER;
    if (r < WT_I_IN) { const int kb = r / 73, nb = r % 73;
        if (nb == 56) p0_transpose_item(P.in[8] + (size_t)l * D * INW, D, INW, (bf16_t*)(ws + WS_WGT) + (size_t)l * 32 * D, 64 * kb, 32 * nb, 0, scr, lane);
        else p0_transpose_item(P.in[8] + (size_t)l * D * INW, D, INW, (bf16_t*)(ws + WS_WIN) + (size_t)l * INP * D, 64 * kb, 32 * nb, nb < 56 ? 32 * nb : 32 * (nb - 1), scr, lane);
        return; }
    r -= WT_I_IN;
    if (r < WT_I_OUT) { const int kb = r / 32, nb = r % 32;
        p0_transpose_item(P.in[18] + (size_t)l * D * D, D, D, (bf16_t*)(ws + WS_WOUT) + (size_t)l * D * D, 64 * kb, 32 * nb, 32 * nb, scr, lane); return; }
    r -= WT_I_OUT;
    if (r < NE * WT_I_GU) { const int e = r / WT_I_GU, q = r % WT_I_GU, kb = q / 64, nb = q % 64; const int n0 = 32 * nb;
        const int j = n0 & 1023, orow = 256 * (j >> 7) + (n0 >= 1024 ? 128 : 0) + (j & 127);
        if (F8_LAYER[l]) p0_transpose_item8(P.in[21] + ((size_t)l * NE + e) * D * 2048, D, 2048, ws + WS_WGU + (size_t)l * NE * 2048 * D * 2 + (size_t)e * 2048 * D, 64 * kb, n0, orow, scr, lane);
        else p0_transpose_item(P.in[21] + ((size_t)l * NE + e) * D * 2048, D, 2048, (bf16_t*)(ws + WS_WGU) + ((size_t)l * NE + e) * 2048 * D, 64 * kb, n0, orow, scr, lane);
        return; }
    r -= NE * WT_I_GU;
    { const int e = r / WT_I_DN, q = r % WT_I_DN, kb = q / 32, nb = q % 32;
        if (F8_LAYER[l]) p0_transpose_item8(P.in[23] + ((size_t)l * NE + e) * DFF * D, DFF, D, ws + WS_WDN + (size_t)l * NE * D * DFF * 2 + (size_t)e * D * DFF, 64 * kb, 32 * nb, 32 * nb, scr, lane);
        else p0_transpose_item(P.in[23] + ((size_t)l * NE + e) * DFF * D, DFF, D, (bf16_t*)(ws + WS_WDN) + ((size_t)l * NE + e) * D * DFF, 64 * kb, 32 * nb, 32 * nb, scr, lane); }
}

__device__ __forceinline__ void phase_prologue(const Frame& F, const Params& P) {
    unsigned char* ws = P.ws;
    LAS float* scr = (LAS float*)(F.lds + F.wave * 16384);
    const int gw = F.bid * NWAVES + F.wave, NGW = F.G * NWAVES;
    for (int it = gw; it < DEPTH * WT_PER_LAYER; it += NGW) {
        if ((it >= WT_DEF0_LO && it < WT_DEF0_HI) || (it >= WT_DEF1_LO && it < WT_DEF1_HI)) continue;
        weight_item(P, it, scr, F.lane);
    }
    {
        const int gt = F.bid * NTHREADS + F.tid, NGT = F.G * NTHREADS;
        bf16_t* cm3 = (bf16_t*)(ws + WS_CM3);
        for (int i = gt; i < 192 * 64; i += NGT) { const int m = i >> 6, n2 = i & 63, part = m >> 6, k2 = m & 63; const int ph = (k2 * n2) & 63;
            float s, c; sincospif((float)ph * (1.0f / 32.0f), &s, &c); const float v = part == 0 ? c : (part == 1 ? -s : -c); cm3[i] = (bf16_t)f2bf(v); }
        bf16_t* rwt = (bf16_t*)(ws + WS_RW);
        for (int i = gt; i < DEPTH * NE * D; i += NGT) { const int l = i / (NE * D), q = i % (NE * D), k = q >> 5, e = q & 31;
            const float w = P.in[19][(size_t)l * D * NE + q]; const unsigned hi = f2bf(w); const unsigned lo = f2bf(w - bf2f(hi));
            rwt[((size_t)l * 2 + 0) * NE * D + e * D + k] = (bf16_t)hi; rwt[((size_t)l * 2 + 1) * NE * D + e * D + k] = (bf16_t)lo; }
        bf16_t* tf2 = (bf16_t*)(ws + WS_TF2);
        for (int i = gt; i < 128 * 128; i += NGT) { const int c_ = i >> 7, n = i & 127; const int ph = (c_ * n) & 127;
            float s, c; sincospif((float)ph * (1.0f / 64.0f), &s, &c); tf2[i] = (bf16_t)f2bf(c); tf2[128 * 128 + i] = (bf16_t)f2bf(s); }
        bf16_t* tctx = (bf16_t*)(ws + WS_TCTX);
        for (int i = gt; i < 256 * 256; i += NGT) { const int k1 = i >> 8, n = i & 255; const int ph = (k1 * n) & 255;
            float s, c; sincospif((float)ph * (1.0f / 128.0f), &s, &c); tctx[i] = (bf16_t)f2bf(c); tctx[256 * 256 + i] = (bf16_t)f2bf(s); }
        bf16_t* tlat = (bf16_t*)(ws + WS_TLAT);
        for (int i = gt; i < 128 * 128 * 128; i += NGT) { const int nlo = i >> 14, d = (i >> 7) & 127, a = i & 127; const int ph = (d * (nlo + 128 * a)) & 16383;
            float s, c; sincospif((float)ph * (1.0f / 8192.0f), &s, &c);
            tlat[(size_t)nlo * 32768 + d * 128 + a] = (bf16_t)f2bf(c); tlat[(size_t)nlo * 32768 + 16384 + d * 128 + a] = (bf16_t)f2bf(s); }
    }
    for (int it = gw; it < DEPTH * 24 * 8; it += NGW) {
        const int l = it / 192, q = it % 192, cb = q >> 3, ks = q & 7;
        const float* wm = P.in[6] + (size_t)l * D * 6144 + (size_t)(ks * 128) * 6144 + cb * 256 + 4 * F.lane;
        f32x4 a0 = {0.f, 0.f, 0.f, 0.f}, a1 = a0, a2 = a0;
#pragma unroll 4
        for (int k = 0; k < 128; ++k) { const int kk = ks * 128 + k;
            const float c0 = P.in[1][kk], c1 = P.in[1][D + kk], c2 = P.in[3][kk];
            const float s0 = c0 * sigmoidf_(c0), s1 = c1 * sigmoidf_(c1), s2 = c2 * sigmoidf_(c2);
            const f32x4 w = *(const f32x4*)(wm + (size_t)k * 6144);
            a0 += w * s0; a1 += w * s1; a2 += w * s2; }
        float* mp = (float*)(ws + WS_MODP) + ((size_t)(l * 8 + ks) * 3) * 6144 + cb * 256 + 4 * F.lane;
        *(f32x4*)(mp) = a0; *(f32x4*)(mp + 6144) = a1; *(f32x4*)(mp + 2 * 6144) = a2;
    }
}

__device__ __forceinline__ f32x4 mod_from_partials(const Params& P, int l, int v, int c4) {
    f32x4 s = *(const f32x4*)(P.in[7] + (size_t)l * 6144 + c4);
    const float* mp = (const float*)(P.ws + WS_MODP) + ((size_t)(l * 8) * 3 + v) * 6144 + c4;
#pragma unroll
    for (int ks = 0; ks < 8; ++ks) s += *(const f32x4*)(mp + (size_t)ks * 3 * 6144);
    return s;
}

__device__ __forceinline__ void norm_row_store(const f32x4 (&x)[4], const float* g, const f32x4 (&shv)[4], const f32x4 (&scv)[4], bf16_t* orow, int lane) {
    float ss = 0.f;
#pragma unroll
    for (int j = 0; j < 4; ++j) ss += (x[j].x * x[j].x + x[j].y * x[j].y) + (x[j].z * x[j].z + x[j].w * x[j].w);
    const float rstd = 1.0f / sqrtf(wave_sum(ss) * (1.0f / D) + NORM_EPS);
#pragma unroll
    for (int j = 0; j < 4; ++j) { const int c = 4 * lane + 256 * j;
        const f32x4 gv = *(const f32x4*)(g + c);
        const f32x4 y = (x[j] * rstd) * gv * (scv[j] + 1.0f) + shv[j];
        u32x2 o; o.x = pk2(y.x, y.y); o.y = pk2(y.z, y.w);
        *(u32x2*)(orow + c) = o; }
}

__device__ __forceinline__ void phase_p1(const Frame& F, const Params& P) {
    unsigned char* ws = P.ws;
    const int gt = F.bid * NTHREADS + F.tid, NGT = F.G * NTHREADS;
    float* modf = (float*)(ws + WS_MODF);
    for (int i = gt; i < DEPTH * 3 * 1536; i += NGT) { const int l = i / 4608, q = i % 4608, v = q / 1536, c4 = (q % 1536) * 4;
        *(f32x4*)(modf + ((size_t)l * 3 + v) * 6144 + c4) = mod_from_partials(P, l, v, c4); }
    const int gw = F.bid * NWAVES + F.wave, NGW = F.G * NWAVES;
    bf16_t* hb = (bf16_t*)(ws + WS_HBUF);
    int cur_v = -1; f32x4 shv[4], scv[4], xn[4];
    auto rowp = [&](int m) { return (m < NLAT) ? (P.in[0] + (size_t)m * D) : (P.in[2] + (size_t)(m - NLAT) * D); };
    if (gw < NTOK) {
#pragma unroll
        for (int j = 0; j < 4; ++j) xn[j] = *(const f32x4*)(rowp(gw) + 4 * F.lane + 256 * j); }
    for (int m = gw; m < NTOK; m += NGW) {
        const int v = (m >= NLAT) ? 2 : (m >= SEQ ? 1 : 0);
        f32x4 x[4];
#pragma unroll
        for (int j = 0; j < 4; ++j) x[j] = xn[j];
        if (m + NGW < NTOK) {
#pragma unroll
            for (int j = 0; j < 4; ++j) xn[j] = *(const f32x4*)(rowp(m + NGW) + 4 * F.lane + 256 * j); }
        if (v != cur_v) { cur_v = v;
#pragma unroll
            for (int j = 0; j < 4; ++j) { const int c = 4 * F.lane + 256 * j; shv[j] = mod_from_partials(P, 0, v, c); scv[j] = mod_from_partials(P, 0, v, 1024 + c); } }
        norm_row_store(x, P.in[4], shv, scv, hb + (size_t)m * D, F.lane);
    }
}

constexpr int GL_GT = 0;
constexpr int GL_A1 = 34816, GL_KE = 60416, GL_VTB = 78848, GL_RS = 97280, GL_RT = 97792;
constexpr int GL_KDT = 34816, GL_VT = 53248;

__device__ __forceinline__ float logsigmoidf_(float x) { return fminf(x, 0.f) - __logf(1.0f + __expf(-fabsf(x))); }
__device__ __forceinline__ float bfel(const u32x4& v, int j) { const unsigned w = (j < 2) ? v.x : (j < 4 ? v.y : (j < 6 ? v.z : v.w)); return (j & 1) ? bfhi(w) : bflo(w); }
__device__ __forceinline__ unsigned short bfraw(const u32x4& v, int j) { const unsigned w = (j < 2) ? v.x : (j < 4 ? v.y : (j < 6 ? v.z : v.w)); return (unsigned short)((j & 1) ? (w >> 16) : (w & 0xffffu)); }

struct GateRegs { bf16x8 a[4]; bf16x8 b; float bg; };
__device__ __forceinline__ GateRegs gla_load_gate_regs(const Frame& F, const Params& P, int l, int row0, int h) {
    GateRegs g;
    const int dir = F.wave >> 2, dbase = (F.wave & 3) * 16, fr = F.lane & 15, fq = F.lane >> 4;
    const bf16x8 z8 = {0, 0, 0, 0, 0, 0, 0, 0};
    const bf16_t* lrb = (const bf16_t*)(P.ws + WS_LRB);
#pragma unroll
    for (int mt = 0; mt < 4; ++mt) g.a[mt] = (fq < 2) ? *(const bf16x8*)(lrb + (size_t)(row0 + mt * 16 + fr) * 32 + dir * 16 + fq * 8) : z8;
    const float* wgp = (dir ? P.in[11] : P.in[9]) + (size_t)l * 16 * 256 + 64 * h + dbase + fr;
    g.b = z8;
    if (fq < 2) {
#pragma unroll
        for (int j = 0; j < 8; ++j) g.b[j] = (short)f2bf(wgp[(fq * 8 + j) * 256]); }
    g.bg = (dir ? P.in[12] : P.in[10])[(size_t)l * 256 + 64 * h + dbase + fr];
    return g;
}
__device__ __forceinline__ void gla_gates(const Frame& F, const GateRegs& gr) {
    LAS float* GT = (LAS float*)(F.lds + GL_GT);
    const int dir = F.wave >> 2, dbase = (F.wave & 3) * 16, lane = F.lane, fr = lane & 15, fq = lane >> 4;
    float p[4][4]; float T[4];
#pragma unroll
    for (int mt = 0; mt < 4; ++mt) { const f32x4 acc = __builtin_amdgcn_mfma_f32_16x16x32_bf16(gr.a[mt], gr.b, (f32x4){0.f, 0.f, 0.f, 0.f}, 0, 0, 0);
#pragma unroll
        for (int j = 0; j < 4; ++j) p[mt][j] = logsigmoidf_(acc[j] + gr.bg) * (1.0f / 16.0f); }
    if (dir == 0) {
#pragma unroll
        for (int mt = 0; mt < 4; ++mt) { p[mt][1] += p[mt][0]; p[mt][2] += p[mt][1]; p[mt][3] += p[mt][2]; T[mt] = p[mt][3]; }
        float base = 0.f;
#pragma unroll
        for (int mt = 0; mt < 4; ++mt) { float inc = T[mt]; float v = __shfl_up(inc, 16); inc += (fq >= 1) ? v : 0.f; v = __shfl_up(inc, 32); inc += (fq >= 2) ? v : 0.f;
            const float off = base + (inc - T[mt]); const float ct = __shfl(inc, 48 + fr);
#pragma unroll
            for (int j = 0; j < 4; ++j) GT[(dbase + fr) * 65 + mt * 16 + fq * 4 + j] = off + p[mt][j];
            base += ct; }
    } else {
#pragma unroll
        for (int mt = 0; mt < 4; ++mt) { p[mt][2] += p[mt][3]; p[mt][1] += p[mt][2]; p[mt][0] += p[mt][1]; T[mt] = p[mt][0]; }
        float base = 0.f;
#pragma unroll
        for (int mt = 3; mt >= 0; --mt) { float inc = T[mt]; float v = __shfl_down(inc, 16); inc += (fq <= 2) ? v : 0.f; v = __shfl_down(inc, 32); inc += (fq <= 1) ? v : 0.f;
            const float off = base + (inc - T[mt]); const float ct = __shfl(inc, fr);
#pragma unroll
            for (int j = 0; j < 4; ++j) GT[(64 + dbase + fr) * 65 + mt * 16 + fq * 4 + j] = off + p[mt][j];
            base += ct; }
    }
}

__device__ __forceinline__ void gla_g1_unit(const Frame& F, const Params& P, int l, int row0, int h, int unit) {
    const bf16_t* pb = (const bf16_t*)(P.ws + WS_PBUF);
    const int tid = F.tid, row = F.lane, c8 = F.wave * 8;
    const GateRegs gr = gla_load_gate_regs(F, P, l, row0, h);
    const u32x4 kv = *(const u32x4*)(pb + (size_t)(row0 + row) * INP + C_K + 64 * h + c8);
    u32x4 vv[2];
#pragma unroll
    for (int i = 0; i < 2; ++i) { const int vr = F.lane, vc = (F.wave + 8 * i) * 8; vv[i] = *(const u32x4*)(pb + (size_t)(row0 + vr) * INP + C_V + 128 * h + vc); }
    gla_gates(F, gr);
    __syncthreads();
    LAS float* GT = (LAS float*)(F.lds + GL_GT);
    LAS bf16_t* KDT = (LAS bf16_t*)(F.lds + GL_KDT); LAS bf16_t* VT = (LAS bf16_t*)(F.lds + GL_VT);
#pragma unroll
    for (int j = 0; j < 8; ++j) { const int d = c8 + j; const float k_ = bfel(kv, j);
        KDT[d * 72 + row] = (bf16_t)f2bf(k_ * __expf(GT[d * 65 + 63] - GT[d * 65 + row])); KDT[(64 + d) * 72 + row] = (bf16_t)f2bf(k_ * __expf(GT[(64 + d) * 65] - GT[(64 + d) * 65 + row])); }
#pragma unroll
    for (int i = 0; i < 2; ++i) { const int vr = F.lane, vc = (F.wave + 8 * i) * 8;
#pragma unroll
        for (int j = 0; j < 8; ++j) VT[(vc + j) * 72 + vr] = bfraw(vv[i], j); }
    if (tid < 128) ((float*)(P.ws + WS_DECAY))[(size_t)unit * 128 + tid] = __expf(tid < 64 ? GT[tid * 65 + 63] : GT[tid * 65]);
    __syncthreads();
    const int fr = F.lane & 15, fq = F.lane >> 4, w = F.wave;
    f32x4 acc[1][8]; zero_acc<1, 8>(acc);
    mma_nt<1, 8>(acc, KDT + (16 * w) * 72, 72, VT, 72, 64, fr, fq);
    bf16_t* st = (bf16_t*)(P.ws + WS_STATE) + (size_t)unit * 16384;
#pragma unroll
    for (int nt = 0; nt < 8; ++nt) { u32x2 o; o.x = pk2(acc[0][nt][0], acc[0][nt][1]); o.y = pk2(acc[0][nt][2], acc[0][nt][3]); *(u32x2*)(st + (nt * 16 + fr) * 128 + 16 * w + fq * 4) = o; }
}

__device__ __forceinline__ void gla_scan(const Frame& F, const Params& P, int def_lo, int def_hi) {
    unsigned* stt = (unsigned*)(P.ws + WS_STATE); const float* dec = (const float*)(P.ws + WS_DECAY);
    if (F.tid >= 256) {
        LAS float* scr = (LAS float*)(F.lds + F.wave * 16384);
        for (int it = def_lo + F.bid * 4 + (F.wave - 4); it < def_hi; it += F.G * 4) weight_item(P, it, scr, F.lane);
        return; }
    for (int gid = F.bid * 256 + F.tid; gid < 8 * 128 * 64; gid += F.G * 256) {
        const int dp = gid & 63, e = (gid >> 6) & 127, bh = gid >> 13, dir = dp >> 5;
        const int latb = bh * 256, ctxb = 2048 + bh * 4;
        auto unit_of = [&](int p) { return dir == 0 ? (p < 4 ? ctxb + p : latb + (p - 4)) : (p < 4 ? ctxb + 3 - p : latb + 255 - (p - 4)); };
        float s0 = 0.f, s1 = 0.f;
        unsigned dA[10], dB[10]; f32x2 cA[10], cB[10];
#pragma unroll
        for (int i = 0; i < 10; ++i) { const int u = unit_of(i); dA[i] = stt[((size_t)u * 128 + e) * 64 + dp]; cA[i] = *(const f32x2*)(dec + (size_t)u * 128 + 2 * dp); }
        for (int p0 = 0; p0 < 260; p0 += 20) {
#pragma unroll
            for (int i = 0; i < 10; ++i) { const int u = unit_of(p0 + 10 + i); dB[i] = stt[((size_t)u * 128 + e) * 64 + dp]; cB[i] = *(const f32x2*)(dec + (size_t)u * 128 + 2 * dp); }
#pragma unroll
            for (int i = 0; i < 10; ++i) { const int u = unit_of(p0 + i); stt[((size_t)u * 128 + e) * 64 + dp] = pk2(s0, s1); s0 = cA[i].x * s0 + bflo(dA[i]); s1 = cA[i].y * s1 + bfhi(dA[i]); }
            if (p0 + 20 < 260) {
#pragma unroll
                for (int i = 0; i < 10; ++i) { const int u = unit_of(p0 + 20 + i); dA[i] = stt[((size_t)u * 128 + e) * 64 + dp]; cA[i] = *(const f32x2*)(dec + (size_t)u * 128 + 2 * dp); } }
#pragma unroll
            for (int i = 0; i < 10; ++i) { const int u = unit_of(p0 + 10 + i); stt[((size_t)u * 128 + e) * 64 + dp] = pk2(s0, s1); s0 = cB[i].x * s0 + bflo(dB[i]); s1 = cB[i].y * s1 + bfhi(dB[i]); }
        }
    }
}

__device__ __forceinline__ void gla_g3_unit(const Frame& F, const Params& P, int l, int row0, int h, int unit) {
    const bf16_t* pb = (const bf16_t*)(P.ws + WS_PBUF);
    const int tid = F.tid, fr = F.lane & 15, fq = F.lane >> 4, w = F.wave, row = F.lane, c8 = F.wave * 8;
    const GateRegs gr = gla_load_gate_regs(F, P, l, row0, h);
    const u32x4 qv = *(const u32x4*)(pb + (size_t)(row0 + row) * INP + C_Q + 64 * h + c8), kv = *(const u32x4*)(pb + (size_t)(row0 + row) * INP + C_K + 64 * h + c8);
    u32x4 vv[2], rv[2], stv[4];
#pragma unroll
    for (int i = 0; i < 2; ++i) { const int vr = F.lane, vc = (F.wave + 8 * i) * 8; const bf16_t* rp = pb + (size_t)(row0 + vr) * INP + 128 * h + vc; vv[i] = *(const u32x4*)(rp + C_V); rv[i] = *(const u32x4*)(rp + C_R); }
    { const bf16_t* st = (const bf16_t*)(P.ws + WS_STATE) + (size_t)unit * 16384;
#pragma unroll
      for (int i = 0; i < 4; ++i) stv[i] = *(const u32x4*)(st + (i * 512 + tid) * 8); }
    const float* ng = P.in[13] + (size_t)l * 128;
    float ngv[4];
#pragma unroll
    for (int nt = 0; nt < 4; ++nt) ngv[nt] = ng[(w >> 2) * 64 + nt * 16 + fr];
    gla_gates(F, gr);
    __syncthreads();
    LAS float* GT = (LAS float*)(F.lds + GL_GT);
    LAS bf16_t* A1 = (LAS bf16_t*)(F.lds + GL_A1); LAS bf16_t* KE = (LAS bf16_t*)(F.lds + GL_KE); LAS bf16_t* VTb = (LAS bf16_t*)(F.lds + GL_VTB); LAS bf16_t* STb = (LAS bf16_t*)(F.lds + GL_GT);
    LAS float* RS = (LAS float*)(F.lds + GL_RS); LAS bf16_t* RT = (LAS bf16_t*)(F.lds + GL_RT);
    { float qf[8], qb[8], kf[8], kb[8];
#pragma unroll
      for (int j = 0; j < 8; ++j) { const float q_ = bfel(qv, j) * 0.125f, k_ = bfel(kv, j); const float bf_ = GT[(c8 + j) * 65 + row], bb_ = GT[(64 + c8 + j) * 65 + row];
          qf[j] = q_ * __expf(bf_); qb[j] = q_ * __expf(bb_); kf[j] = k_ * __expf(-bf_); kb[j] = k_ * __expf(-bb_); }
      *(LAS u32x4*)(A1 + row * 200 + 64 + c8) = (u32x4){pk2(qf[0], qf[1]), pk2(qf[2], qf[3]), pk2(qf[4], qf[5]), pk2(qf[6], qf[7])};
      *(LAS u32x4*)(A1 + row * 200 + 128 + c8) = (u32x4){pk2(qb[0], qb[1]), pk2(qb[2], qb[3]), pk2(qb[4], qb[5]), pk2(qb[6], qb[7])};
      *(LAS u32x4*)(KE + row * 72 + c8) = (u32x4){pk2(kf[0], kf[1]), pk2(kf[2], kf[3]), pk2(kf[4], kf[5]), pk2(kf[6], kf[7])};
      *(LAS u32x4*)(KE + 4608 + row * 72 + c8) = (u32x4){pk2(kb[0], kb[1]), pk2(kb[2], kb[3]), pk2(kb[4], kb[5]), pk2(kb[6], kb[7])}; }
#pragma unroll
    for (int i = 0; i < 2; ++i) { const int vr = F.lane, vc = (F.wave + 8 * i) * 8; *(LAS u32x4*)(RT + vr * 136 + vc) = rv[i];
#pragma unroll
        for (int j = 0; j < 8; ++j) VTb[(vc + j) * 72 + vr] = bfraw(vv[i], j); }
    __syncthreads();
    {
        const int mt = w & 3, ntp = w >> 2;
        f32x4 af[1][2], ab[1][2]; zero_acc<1, 2>(af); zero_acc<1, 2>(ab);
        mma_nt<1, 2>(af, A1 + (16 * mt) * 200 + 64, 200, KE + (32 * ntp) * 72, 72, 64, fr, fq);
        mma_nt<1, 2>(ab, A1 + (16 * mt) * 200 + 128, 200, KE + 4608 + (32 * ntp) * 72, 72, 64, fr, fq);
#pragma unroll
        for (int i = 0; i < 4; ++i) { const int idx = (i * 512 + tid) * 8, e = idx >> 7, dd = idx & 127; *(LAS u32x4*)(STb + e * 136 + dd) = stv[i]; }
#pragma unroll
        for (int nt = 0; nt < 2; ++nt)
#pragma unroll
            for (int j = 0; j < 4; ++j) { const int i = 16 * mt + fq * 4 + j, jj = (2 * ntp + nt) * 16 + fr;
                const float p = (jj <= i ? af[0][nt][j] : 0.f) + (jj >= i ? ab[0][nt][j] : 0.f); A1[i * 200 + jj] = (bf16_t)f2bf(p); }
    }
    __syncthreads();
    {
        const int mt = w & 3, nh = w >> 2;
        f32x4 acc[1][4]; zero_acc<1, 4>(acc);
        mma_nt<1, 4>(acc, A1 + (16 * mt) * 200, 200, VTb + (64 * nh) * 72, 72, 64, fr, fq);
        mma_nt<1, 4>(acc, A1 + (16 * mt) * 200 + 64, 200, STb + (64 * nh) * 136, 136, 128, fr, fq);
        float ss[4];
#pragma unroll
        for (int j = 0; j < 4; ++j) { float s = 0.f;
#pragma unroll
            for (int nt = 0; nt < 4; ++nt) s += acc[0][nt][j] * acc[0][nt][j];
            s += __shfl_xor(s, 1); s += __shfl_xor(s, 2); s += __shfl_xor(s, 4); s += __shfl_xor(s, 8); ss[j] = s; }
        if (fr == 0) {
#pragma unroll
            for (int j = 0; j < 4; ++j) RS[nh * 64 + 16 * mt + fq * 4 + j] = ss[j]; }
        __syncthreads();
        bf16_t* cat = (bf16_t*)(P.ws + WS_CAT);
#pragma unroll
        for (int j = 0; j < 4; ++j) { const int i = 16 * mt + fq * 4 + j; const float rinv = 1.0f / sqrtf((RS[i] + RS[64 + i]) * (1.0f / 128.0f) + NORM_EPS);
#pragma unroll
            for (int nt = 0; nt < 4; ++nt) { const int e = nh * 64 + nt * 16 + fr; const float r_ = bf2f(RT[i * 136 + e]);
                const float o = acc[0][nt][j] * rinv * ngv[nt] * (r_ * sigmoidf_(r_)); cat[(size_t)(row0 + i) * D + 256 + 128 * h + e] = (bf16_t)f2bf(o); } }
    }
}

__device__ __forceinline__ void conv_unit(const Frame& F, const Params& P, int l, int rowbase, int Ls, int t0) {
    const bf16_t* pb = (const bf16_t*)(P.ws + WS_PBUF);
    LAS bf16_t* Y = (LAS bf16_t*)(F.lds);
    LAS float* Z = (LAS float*)(F.lds + 49152);
    const int tid = F.tid;
    {
        u32x4 av[6], gv[6];
#pragma unroll
        for (int i = 0; i < 6; ++i) { const int ch = tid + 512 * i, r = ch >> 5, cc = (ch & 31) * 8, t = t0 - 15 + r;
            av[i] = (u32x4){0u, 0u, 0u, 0u}; gv[i] = av[i];
            if (ch < 94 * 32 && t >= 0 && t < Ls) { const size_t rb = (size_t)(rowbase + t) * INP; av[i] = *(const u32x4*)(pb + rb + C_CA + cc); gv[i] = *(const u32x4*)(pb + rb + C_CG + cc); } }
#pragma unroll
        for (int i = 0; i < 6; ++i) { const int ch = tid + 512 * i, r = ch >> 5, cc = (ch & 31) * 8; const u32x4 a = av[i], g = gv[i]; u32x4 o;
            o.x = pk2(bflo(a.x) * sigmoidf_(bflo(g.x)), bfhi(a.x) * sigmoidf_(bfhi(g.x))); o.y = pk2(bflo(a.y) * sigmoidf_(bflo(g.y)), bfhi(a.y) * sigmoidf_(bfhi(g.y)));
            o.z = pk2(bflo(a.z) * sigmoidf_(bflo(g.z)), bfhi(a.z) * sigmoidf_(bfhi(g.z))); o.w = pk2(bflo(a.w) * sigmoidf_(bflo(g.w)), bfhi(a.w) * sigmoidf_(bfhi(g.w)));
            if (ch < 94 * 32) *(LAS u32x4*)(Y + r * 256 + cc) = o; }
    }
    const int c2 = (tid & 127) * 2, qtr = tid >> 7; const float* cw = P.in[14] + (size_t)l * 31 * 256 + c2; const f32x2 cb = *(const f32x2*)(P.in[15] + (size_t)l * 256 + c2);
    f32x2 wv[31];
#pragma unroll
    for (int j = 0; j < 31; ++j) wv[j] = *(const f32x2*)(cw + j * 256);
    const f32x4 lng = *(const f32x4*)(P.in[16] + (size_t)l * 256 + 4 * F.lane), lnb = *(const f32x4*)(P.in[17] + (size_t)l * 256 + 4 * F.lane);
    __syncthreads();
#pragma unroll 1
    for (int hp = 0; hp < 2; ++hp) { f32x2 yv[38]; const int rb = qtr * 16 + hp * 8;
#pragma unroll
      for (int r = 0; r < 38; ++r) { const unsigned wd = *(const LAS unsigned*)(Y + (rb + r) * 256 + c2); yv[r] = (f32x2){bflo(wd), bfhi(wd)}; }
#pragma unroll
      for (int tt = 0; tt < 8; ++tt) { f32x2 z = cb;
#pragma unroll
          for (int j = 0; j < 31; ++j) z += wv[j] * yv[tt + j];
          *(LAS f32x2*)(Z + (rb + tt) * 256 + c2) = z; } }
    __syncthreads();
    { bf16_t* cat = (bf16_t*)(P.ws + WS_CAT);
#pragma unroll 2
      for (int i = 0; i < 8; ++i) { const int t = F.wave * 8 + i; const f32x4 z = *(const LAS f32x4*)(Z + t * 256 + 4 * F.lane);
          const float mean = wave_sum((z.x + z.y) + (z.z + z.w)) * (1.0f / 256.0f); const f32x4 zc = z - mean;
          const float var = wave_sum((zc.x * zc.x + zc.y * zc.y) + (zc.z * zc.z + zc.w * zc.w)) * (1.0f / 256.0f); const float rstd = 1.0f / sqrtf(var + NORM_EPS);
          const f32x4 y = zc * rstd * lng + lnb; u32x2 o; o.x = pk2(y.x * sigmoidf_(y.x), y.y * sigmoidf_(y.y)); o.y = pk2(y.z * sigmoidf_(y.z), y.w * sigmoidf_(y.w));
          *(u32x2*)(cat + (size_t)(rowbase + t0 + t) * D + 768 + 4 * F.lane) = o; } }
    __syncthreads();
}

template <int R, int NP>
__device__ __forceinline__ void fourier_f1_unit(const Frame& F, const Params& P, int rowbase, int rstride, int h, const bf16_t* tab, int orow0, float oscale) {
    const bf16_t* pb = (const bf16_t*)(P.ws + WS_PBUF); const bf16_t* cm3 = (const bf16_t*)(P.ws + WS_CM3);
    constexpr int LZ = R + 8, MT0 = 4 * NP, NTW = R / 128, MTW = R / 128;
    LAS bf16_t* U = (LAS bf16_t*)(F.lds); LAS bf16_t* CM = U + R * 72; LAS bf16_t* ZT = CM + 64 * NP * 72;
    const int tid = F.tid, fr = F.lane & 15, fq = F.lane >> 4, w = F.wave;
    bf16x8 tcp[4], tsp[4];
    if constexpr (R == 128) {
#pragma unroll
        for (int k = 0; k < 4; ++k) { tcp[k] = *(const bf16x8*)(tab + (size_t)(w * 16 + fr) * R + k * 32 + fq * 8); tsp[k] = *(const bf16x8*)(tab + (size_t)R * R + (size_t)(w * 16 + fr) * R + k * 32 + fq * 8); } }
    { constexpr int NU = R * 8 / NTHREADS, NC = (64 * NP * 8 + NTHREADS - 1) / NTHREADS; u32x4 uv[NU], cv[NC];
#pragma unroll
      for (int i = 0; i < NU; ++i) { const int ch = tid + NTHREADS * i, a = ch >> 3, c8 = (ch & 7) * 8; uv[i] = *(const u32x4*)(pb + (size_t)(rowbase + a * rstride) * INP + C_FOUR + 64 * h + c8); }
#pragma unroll
      for (int i = 0; i < NC; ++i) { const int ch = tid + NTHREADS * i, m = ch >> 3, c8 = (ch & 7) * 8; cv[i] = (ch < 64 * NP * 8) ? *(const u32x4*)(cm3 + m * 64 + c8) : (u32x4){0u, 0u, 0u, 0u}; }
#pragma unroll
      for (int i = 0; i < NU; ++i) { const int ch = tid + NTHREADS * i, a = ch >> 3, c8 = (ch & 7) * 8; *(LAS u32x4*)(U + a * 72 + c8) = uv[i]; }
#pragma unroll
      for (int i = 0; i < NC; ++i) { const int ch = tid + NTHREADS * i, m = ch >> 3, c8 = (ch & 7) * 8; if (ch < 64 * NP * 8) *(LAS u32x4*)(CM + m * 72 + c8) = cv[i]; } }
    __syncthreads();
    {
        f32x4 acc[MT0][NTW]; zero_acc<MT0, NTW>(acc);
        mma_nt<MT0, NTW>(acc, CM, 72, U + (w * NTW * 16) * 72, 72, 64, fr, fq);
#pragma unroll
        for (int mt = 0; mt < MT0; ++mt)
#pragma unroll
            for (int nt = 0; nt < NTW; ++nt)
#pragma unroll
                for (int j = 0; j < 4; ++j) ZT[(mt * 16 + fq * 4 + j) * LZ + (w * NTW + nt) * 16 + fr] = (bf16_t)f2bf(acc[mt][nt][j]);
    }
    __syncthreads();
    {
        f32x4 are[MTW][4], aim[MTW][4]; zero_acc<MTW, 4>(are); zero_acc<MTW, 4>(aim);
        const int m0 = w * MTW * 16;
#pragma unroll
        for (int k0 = 0; k0 < R; k0 += 32) {
            bf16x8 tc[MTW], ts[MTW];
#pragma unroll
            for (int mi = 0; mi < MTW; ++mi) { if constexpr (R == 128) { tc[mi] = tcp[k0 / 32]; ts[mi] = tsp[k0 / 32]; } else { tc[mi] = *(const bf16x8*)(tab + (size_t)(m0 + mi * 16 + fr) * R + k0 + fq * 8); ts[mi] = *(const bf16x8*)(tab + (size_t)R * R + (size_t)(m0 + mi * 16 + fr) * R + k0 + fq * 8); } }
#pragma unroll
            for (int nt = 0; nt < 4; ++nt) {
                const bf16x8 zr = *(const LAS bf16x8*)(ZT + (nt * 16 + fr) * LZ + k0 + fq * 8), zi = *(const LAS bf16x8*)(ZT + (64 + nt * 16 + fr) * LZ + k0 + fq * 8);
#pragma unroll
                for (int mi = 0; mi < MTW; ++mi) { are[mi][nt] = __builtin_amdgcn_mfma_f32_16x16x32_bf16(tc[mi], zr, are[mi][nt], 0, 0, 0); are[mi][nt] = __builtin_amdgcn_mfma_f32_16x16x32_bf16(ts[mi], zi, are[mi][nt], 0, 0, 0); }
                if constexpr (NP == 3) { const bf16x8 nzr = *(const LAS bf16x8*)(ZT + (128 + nt * 16 + fr) * LZ + k0 + fq * 8);
#pragma unroll
                    for (int mi = 0; mi < MTW; ++mi) { aim[mi][nt] = __builtin_amdgcn_mfma_f32_16x16x32_bf16(tc[mi], zi, aim[mi][nt], 0, 0, 0); aim[mi][nt] = __builtin_amdgcn_mfma_f32_16x16x32_bf16(ts[mi], nzr, aim[mi][nt], 0, 0, 0); } }
            }
        }
#pragma unroll
        for (int mi = 0; mi < MTW; ++mi)
#pragma unroll
            for (int nt = 0; nt < 4; ++nt)
#pragma unroll
                for (int j = 0; j < 4; ++j) { const int m = m0 + mi * 16 + fq * 4 + j, k2 = nt * 16 + fr;
                    if constexpr (NP == 3) { unsigned* t2 = (unsigned*)(P.ws + WS_T2); t2[(size_t)(orow0 + 128 * m) * 256 + h * 64 + k2] = pk2(are[mi][nt][j], aim[mi][nt][j]); }
                    else { bf16_t* cat = (bf16_t*)(P.ws + WS_CAT); cat[(size_t)(orow0 + m) * D + h * 64 + k2] = (bf16_t)f2bf(are[mi][nt][j] * oscale); } }
    }
    __syncthreads();
}

constexpr int F2_X = 0, F2_T = 67584;
__device__ __forceinline__ void fourier_f2_tables(const Frame& F, const Params& P) {
    const bf16_t* tf2 = (const bf16_t*)(P.ws + WS_TF2); LAS bf16_t* T = (LAS bf16_t*)(F.lds + F2_T);
#pragma unroll
    for (int i = 0; i < 8; ++i) { const int ch = F.tid + 512 * i, r = ch >> 4, c8 = (ch & 15) * 8; *(LAS u32x4*)(T + r * 136 + c8) = *(const u32x4*)(tf2 + r * 128 + c8); }
    __syncthreads();
}
__device__ __forceinline__ void fourier_f2_unit(const Frame& F, const Params& P, int b, int d, int hp) {
    const bf16_t* t2 = (const bf16_t*)(P.ws + WS_T2);
    LAS bf16_t* X = (LAS bf16_t*)(F.lds + F2_X); const LAS bf16_t* T = (const LAS bf16_t*)(F.lds + F2_T);
    const int tid = F.tid, fr = F.lane & 15, fq = F.lane >> 4, w = F.wave;
    { u32x4 xv[8];
#pragma unroll
      for (int i = 0; i < 8; ++i) { const int ch = tid + 512 * i, n = ch >> 5, c8 = (ch & 31) * 8; xv[i] = *(const u32x4*)(t2 + (size_t)(b * SEQ + 128 * d + n) * 512 + hp * 256 + c8); }
#pragma unroll
      for (int i = 0; i < 8; ++i) { const int ch = tid + 512 * i, n = ch >> 5, c8 = (ch & 31) * 8; *(LAS u32x4*)(X + n * 264 + c8) = xv[i]; } }
    __syncthreads();
    f32x4 acc[8];
#pragma unroll
    for (int mt = 0; mt < 8; ++mt) acc[mt] = (f32x4){0.f, 0.f, 0.f, 0.f};
#pragma unroll
    for (int k0 = 0; k0 < 128; k0 += 32) {
        bf16x8 xr, xi;
#pragma unroll
        for (int jj = 0; jj < 8; ++jj) { const unsigned wd = *(const LAS unsigned*)(X + (k0 + fq * 8 + jj) * 264 + 2 * (w * 16 + fr)); xr[jj] = (short)(wd & 0xffffu); xi[jj] = (short)(wd >> 16); }
#pragma unroll
        for (int mt = 0; mt < 8; ++mt) { const bf16x8 tc = *(const LAS bf16x8*)(T + (mt * 16 + fr) * 136 + k0 + fq * 8), ts = *(const LAS bf16x8*)(T + (128 + mt * 16 + fr) * 136 + k0 + fq * 8);
            acc[mt] = __builtin_amdgcn_mfma_f32_16x16x32_bf16(tc, xr, acc[mt], 0, 0, 0); acc[mt] = __builtin_amdgcn_mfma_f32_16x16x32_bf16(ts, xi, acc[mt], 0, 0, 0); }
    }
    bf16_t* cat = (bf16_t*)(P.ws + WS_CAT);
#pragma unroll
    for (int mt = 0; mt < 8; ++mt)
#pragma unroll
        for (int j = 0; j < 4; ++j) { const int c = mt * 16 + fq * 4 + j; cat[(size_t)(b * SEQ + 128 * c + d) * D + hp * 128 + w * 16 + fr] = (bf16_t)f2bf(acc[mt][j] * (1.0f / 1024.0f)); }
    __syncthreads();
}

constexpr int AX_LCNT = AUX_OFF, AX_GBASE = AUX_OFF + 128, AX_LE = AUX_OFF + 256, AX_LP = AUX_OFF + 256 + 2560;
constexpr int LC_BAR = LCTL_OFF, LC_TS = LCTL_OFF + 64;

constexpr int RT_GS = 0, RT_SSQ = 24576, RT_AT = 25600, RT_PL = 95232;
__device__ __forceinline__ void phase_route(const Frame& F, const Params& P, int l, int ntok) {
    unsigned char* ws = P.ws;
    LAS float* GS = (LAS float*)(F.lds + RT_GS); LAS float* SSQ = (LAS float*)(F.lds + RT_SSQ); LAS float* PL = (LAS float*)(F.lds + RT_PL);
    volatile LAS int* lcnt = (volatile LAS int*)(F.lds + AX_LCNT); volatile LAS int* gbase = (volatile LAS int*)(F.lds + AX_GBASE);
    volatile LAS int* LE = (volatile LAS int*)(F.lds + AX_LE); volatile LAS int* LP = (volatile LAS int*)(F.lds + AX_LP);
    const int tid = F.tid, lane = F.lane, w = F.wave, fr = lane & 15, fq = lane >> 4, ts = lane >> 2, kq = lane & 3, kbase = 128 * w + 32 * kq;
    LAS bf16_t* AT = (LAS bf16_t*)(F.lds + RT_AT) + w * (2 * 16 * 136);
    const int tpb = (ntok + F.G - 1) / F.G, tb = F.bid * tpb, te = (tb + tpb < ntok) ? tb + tpb : ntok, ntile = (te - tb + 15) >> 4;
    { const float* g2 = P.in[5] + (size_t)l * D;
      for (int i = tid; i < 3 * 1024; i += NTHREADS) { const int v = i >> 10, k = i & 1023; const float* mf = (const float*)(ws + WS_MODF) + ((size_t)l * 3 + v) * 6144;
          GS[(v * 2 + 0) * 1024 + k] = g2[k] * (1.0f + mf[4 * 1024 + k]); GS[(v * 2 + 1) * 1024 + k] = mf[3 * 1024 + k]; } }
    if (tid < 32) lcnt[tid] = 0;
    bf16x8 bh[4][2], bl[4][2];
    { const bf16_t* rwh = (const bf16_t*)(ws + WS_RW) + (size_t)l * 2 * NE * D; const bf16_t* rwl = rwh + NE * D;
#pragma unroll
      for (int sk = 0; sk < 4; ++sk)
#pragma unroll
          for (int nt = 0; nt < 2; ++nt) { const int off = (nt * 16 + fr) * D + 128 * w + 32 * sk + 8 * fq; bh[sk][nt] = *(const bf16x8*)(rwh + off); bl[sk][nt] = *(const bf16x8*)(rwl + off); } }
    const float* xres = (const float*)(ws + WS_XRES); bf16_t* hb = (bf16_t*)(ws + WS_HBUF);
    const float rbias = P.in[20][(size_t)l * NE + (lane & 31)];
    float* aprob = (float*)(ws + WS_APROB);
    f32x4 xn[8];
    { const int m = tb + ts;
#pragma unroll
      for (int j = 0; j < 8; ++j) xn[j] = (m < te) ? *(const f32x4*)(xres + (size_t)m * D + kbase + 4 * j) : (f32x4){0.f, 0.f, 0.f, 0.f}; }
    __syncthreads();
    for (int it = 0; it < ntile; ++it) {
        const int buf = it & 1; const int m = tb + 16 * it + ts; const bool valid = m < te; const int v = (m >= NLAT) ? 2 : (m >= SEQ ? 1 : 0);
        f32x4 x[8]; float ss = 0.f;
#pragma unroll
        for (int j = 0; j < 8; ++j) { x[j] = xn[j]; ss += (x[j].x * x[j].x + x[j].y * x[j].y) + (x[j].z * x[j].z + x[j].w * x[j].w); }
        if (it + 1 < ntile) { const int mn = m + 16;
#pragma unroll
            for (int j = 0; j < 8; ++j) xn[j] = (mn < te) ? *(const f32x4*)(xres + (size_t)mn * D + kbase + 4 * j) : (f32x4){0.f, 0.f, 0.f, 0.f}; }
        ss += __shfl_xor(ss, 1); ss += __shfl_xor(ss, 2);
        if (kq == 0) SSQ[(buf * 8 + w) * 16 + ts] = ss;
        __syncthreads();
        float tot = 0.f;
#pragma unroll
        for (int q = 0; q < 8; ++q) tot += SSQ[(buf * 8 + q) * 16 + ts];
        const float rstd = 1.0f / sqrtf(tot * (1.0f / D) + NORM_EPS);
        {
            unsigned hw[16], lw[16];
#pragma unroll
            for (int j = 0; j < 8; ++j) { const f32x4 gs = *(const LAS f32x4*)(GS + (v * 2 + 0) * 1024 + kbase + 4 * j), sh = *(const LAS f32x4*)(GS + (v * 2 + 1) * 1024 + kbase + 4 * j);
                const f32x4 h = (x[j] * rstd) * gs + sh;
                const unsigned h0 = f2bf(h.x), h1 = f2bf(h.y), h2 = f2bf(h.z), h3 = f2bf(h.w);
                hw[2 * j] = h0 | (h1 << 16); hw[2 * j + 1] = h2 | (h3 << 16);
                lw[2 * j] = pk2(h.x - bf2f(h0), h.y - bf2f(h1)); lw[2 * j + 1] = pk2(h.z - bf2f(h2), h.w - bf2f(h3)); }
            if (valid) {
                if (F8_LAYER[l]) { unsigned char* hb8 = ws + WS_HB8 + (size_t)m * D + kbase;
#pragma unroll
                    for (int c = 0; c < 2; ++c) { u32x4 o;
                        o.x = pk4_fp8(bflo(hw[8 * c + 0]) + bflo(lw[8 * c + 0]), bfhi(hw[8 * c + 0]) + bfhi(lw[8 * c + 0]), bflo(hw[8 * c + 1]) + bflo(lw[8 * c + 1]), bfhi(hw[8 * c + 1]) + bfhi(lw[8 * c + 1]));
                        o.y = pk4_fp8(bflo(hw[8 * c + 2]) + bflo(lw[8 * c + 2]), bfhi(hw[8 * c + 2]) + bfhi(lw[8 * c + 2]), bflo(hw[8 * c + 3]) + bflo(lw[8 * c + 3]), bfhi(hw[8 * c + 3]) + bfhi(lw[8 * c + 3]));
                        o.z = pk4_fp8(bflo(hw[8 * c + 4]) + bflo(lw[8 * c + 4]), bfhi(hw[8 * c + 4]) + bfhi(lw[8 * c + 4]), bflo(hw[8 * c + 5]) + bflo(lw[8 * c + 5]), bfhi(hw[8 * c + 5]) + bfhi(lw[8 * c + 5]));
                        o.w = pk4_fp8(bflo(hw[8 * c + 6]) + bflo(lw[8 * c + 6]), bfhi(hw[8 * c + 6]) + bfhi(lw[8 * c + 6]), bflo(hw[8 * c + 7]) + bflo(lw[8 * c + 7]), bfhi(hw[8 * c + 7]) + bfhi(lw[8 * c + 7]));
                        *(u32x4*)(hb8 + 16 * c) = o; } }
                if (!F8_LAYER[l]) {
#pragma unroll
                    for (int c = 0; c < 4; ++c) *(u32x4*)(hb + (size_t)m * D + kbase + 8 * c) = (u32x4){hw[4 * c], hw[4 * c + 1], hw[4 * c + 2], hw[4 * c + 3]}; } }
#pragma unroll
            for (int c = 0; c < 4; ++c) { *(LAS u32x4*)(AT + ts * 136 + 32 * kq + 8 * c) = (u32x4){hw[4 * c], hw[4 * c + 1], hw[4 * c + 2], hw[4 * c + 3]};
                *(LAS u32x4*)(AT + 16 * 136 + ts * 136 + 32 * kq + 8 * c) = (u32x4){lw[4 * c], lw[4 * c + 1], lw[4 * c + 2], lw[4 * c + 3]}; }
        }
        f32x4 acc[2]; acc[0] = (f32x4){0.f, 0.f, 0.f, 0.f}; acc[1] = acc[0];
#pragma unroll
        for (int sk = 0; sk < 4; ++sk) { const bf16x8 ah = *(const LAS bf16x8*)(AT + fr * 136 + 32 * sk + 8 * fq), al = *(const LAS bf16x8*)(AT + 16 * 136 + fr * 136 + 32 * sk + 8 * fq);
#pragma unroll
            for (int nt = 0; nt < 2; ++nt) { acc[nt] = __builtin_amdgcn_mfma_f32_16x16x32_bf16(ah, bh[sk][nt], acc[nt], 0, 0, 0); acc[nt] = __builtin_amdgcn_mfma_f32_16x16x32_bf16(ah, bl[sk][nt], acc[nt], 0, 0, 0);
                acc[nt] = __builtin_amdgcn_mfma_f32_16x16x32_bf16(al, bh[sk][nt], acc[nt], 0, 0, 0); } }
#pragma unroll
        for (int nt = 0; nt < 2; ++nt)
#pragma unroll
            for (int j = 0; j < 4; ++j) PL[((buf * 8 + w) * 16 + fq * 4 + j) * 33 + nt * 16 + fr] = acc[nt][j];
        __syncthreads();
        {
            const int tt = 2 * w + (lane >> 5), e = lane & 31, mt = tb + 16 * it + tt;
            float lg = rbias;
#pragma unroll
            for (int q = 0; q < 8; ++q) lg += PL[((buf * 8 + q) * 16 + tt) * 33 + e];
            float bval[4]; int bidx[4]; float cur = lg;
#pragma unroll
            for (int k = 0; k < 4; ++k) { float bv = cur; int bi = e;
#pragma unroll
                for (int o = 1; o < 32; o <<= 1) { const float ov = __shfl_xor(bv, o); const int oi = __shfl_xor(bi, o); const bool take = (ov > bv) || (ov == bv && oi < bi); bv = take ? ov : bv; bi = take ? oi : bi; }
                bval[k] = bv; bidx[k] = bi; if (e == bi) cur = -INFINITY; }
            float ex[4], sum = 0.f;
#pragma unroll
            for (int k = 0; k < 4; ++k) { ex[k] = __expf(bval[k] - bval[0]); sum += ex[k]; }
            if (e == 0 && mt < te) { const int tl = 16 * it + tt;
#pragma unroll
                for (int k = 0; k < 4; ++k) { const int lp = __hip_atomic_fetch_add((LAS int*)(F.lds + AX_LCNT) + bidx[k], 1, __ATOMIC_RELAXED, __HIP_MEMORY_SCOPE_WORKGROUP);
                    LE[tl * 4 + k] = bidx[k]; LP[tl * 4 + k] = lp; aprob[(size_t)mt * 4 + k] = ex[k] / sum; } }
        }
    }
    __syncthreads();
    if (tid < 32) gbase[tid] = (int)__hip_atomic_fetch_add((unsigned*)(ws + WS_CTL) + CW_CNT + l * 64 + tid, (unsigned)lcnt[tid], __ATOMIC_RELAXED, __HIP_MEMORY_SCOPE_AGENT);
    __syncthreads();
    int* aexp = (int*)(ws + WS_AEXP); int* apos = (int*)(ws + WS_APOS);
    int* elist = (int*)(ws + WS_XB);
    for (int i = tid; i < (te - tb) * 4; i += NTHREADS) { const int e = LE[i]; const int pos = gbase[e] + LP[i]; aexp[(size_t)tb * 4 + i] = e; apos[(size_t)tb * 4 + i] = pos; elist[(size_t)e * NTOK + pos] = tb + (i >> 2); }
    __syncthreads();
}

__device__ __forceinline__ void moe_prep(const Frame& F, const Params& P, int l) {
    unsigned char* ws = P.ws;
    volatile LAS int* TS = (volatile LAS int*)(F.lds + LC_TS);
    if (F.tid < 64) { const int e = F.lane & 31;
        const unsigned c = __hip_atomic_load((unsigned*)(ws + WS_CTL) + CW_CNT + l * 64 + e, __ATOMIC_RELAXED, __HIP_MEMORY_SCOPE_AGENT);
        int incl = (int)((c + 255u) >> 8);
#pragma unroll
        for (int o = 1; o < 32; o <<= 1) { const int v = __shfl_up(incl, o); if (e >= o) incl += v; }
        if (F.lane < 32) { TS[e + 1] = incl; TS[64 + e] = (int)c; }
        if (F.lane == 0) TS[0] = 0; }
    __syncthreads();
}

__device__ __forceinline__ void phase_gather8(const Frame& F, const Params& P, int l, int ntok) {
    unsigned char* ws = P.ws;
    moe_prep(F, P, l);
    const volatile LAS int* TS = (const volatile LAS int*)(F.lds + LC_TS);
    const int gw = F.bid * NWAVES + F.wave, NGW = F.G * NWAVES;
    const int* aexp = (const int*)(ws + WS_AEXP); const int* apos = (const int*)(ws + WS_APOS);
    const unsigned char* hb8 = ws + WS_HB8; unsigned char* xb8 = ws + WS_XB8;
    for (int cidx = gw; cidx < ntok / 16; cidx += NGW) {
        const int a0 = cidx * 64; const int e = aexp[a0 + F.lane]; const int rowl = TS[e] * 256 + apos[a0 + F.lane];
#pragma unroll 1
        for (int t4 = 0; t4 < 16; t4 += 4) {
            u32x4 v0[4];
#pragma unroll
            for (int q = 0; q < 4; ++q) v0[q] = ((const u32x4*)(hb8 + (size_t)(a0 / 4 + t4 + q) * D))[F.lane];
#pragma unroll
            for (int q = 0; q < 4; ++q)
#pragma unroll
                for (int k = 0; k < 4; ++k) { const int row = __shfl(rowl, (t4 + q) * 4 + k); ((u32x4*)(xb8 + (size_t)row * D))[F.lane] = v0[q]; }
        }
    }
}

__device__ __forceinline__ void phase_combine(const Frame& F, const Params& P, int l, int ntok, bool last) {
    unsigned char* ws = P.ws;
    const int gw = F.bid * NWAVES + F.wave, NGW = F.G * NWAVES, lane = F.lane;
    float* xres = (float*)(ws + WS_XRES); const bf16_t* yb = (const bf16_t*)(ws + WS_YB); const unsigned char* yb8 = ws + WS_YB;
    const int* aexp = (const int*)(ws + WS_AEXP); const int* apos = (const int*)(ws + WS_APOS); const float* aprob = (const float*)(ws + WS_APROB);
    const volatile LAS int* TS = (const volatile LAS int*)(F.lds + LC_TS);
    int sl_n[4]; float pr_n[4];
    if (gw < ntok) {
#pragma unroll
        for (int k = 0; k < 4; ++k) { sl_n[k] = TS[aexp[(size_t)gw * 4 + k]] * 256 + apos[(size_t)gw * 4 + k]; pr_n[k] = aprob[(size_t)gw * 4 + k]; } }
    for (int m = gw; m < ntok; m += NGW) {
        const int v = (m >= NLAT) ? 2 : (m >= SEQ ? 1 : 0);
        const float* mf = (const float*)(ws + WS_MODF) + ((size_t)l * 3 + v) * 6144;
        int sl[4]; float pr[4];
#pragma unroll
        for (int k = 0; k < 4; ++k) { sl[k] = sl_n[k]; pr[k] = pr_n[k]; }
        u32x2 wv[4][4]; f32x4 xo[4], g5[4];
#pragma unroll
        for (int k = 0; k < 4; ++k)
#pragma unroll
            for (int j = 0; j < 4; ++j) { if (F8_LAYER[l]) { wv[k][j].x = *(const unsigned*)(yb8 + (size_t)sl[k] * D + 4 * lane + 256 * j); wv[k][j].y = 0u; } else wv[k][j] = *(const u32x2*)(yb + (size_t)sl[k] * D + 4 * lane + 256 * j); }
#pragma unroll
        for (int j = 0; j < 4; ++j) { const int c = 4 * lane + 256 * j; xo[j] = *(const f32x4*)(xres + (size_t)m * D + c); g5[j] = *(const f32x4*)(mf + 5 * 1024 + c); }
        if (m + NGW < ntok) {
#pragma unroll
            for (int k = 0; k < 4; ++k) { sl_n[k] = TS[aexp[(size_t)(m + NGW) * 4 + k]] * 256 + apos[(size_t)(m + NGW) * 4 + k]; pr_n[k] = aprob[(size_t)(m + NGW) * 4 + k]; } }
        f32x4 y[4];
#pragma unroll
        for (int j = 0; j < 4; ++j) y[j] = (f32x4){0.f, 0.f, 0.f, 0.f};
#pragma unroll
        for (int k = 0; k < 4; ++k)
#pragma unroll
            for (int j = 0; j < 4; ++j) { if (F8_LAYER[l]) { const f32x2 lo = __builtin_amdgcn_cvt_pk_f32_fp8(wv[k][j].x, false), hi = __builtin_amdgcn_cvt_pk_f32_fp8(wv[k][j].x, true); y[j] += (f32x4){lo.x, lo.y, hi.x, hi.y} * pr[k]; }
                else y[j] += (f32x4){bflo(wv[k][j].x), bfhi(wv[k][j].x), bflo(wv[k][j].y), bfhi(wv[k][j].y)} * pr[k]; }
        f32x4 x[4];
#pragma unroll
        for (int j = 0; j < 4; ++j) x[j] = xo[j] + g5[j] * y[j];
        if (!last) {
#pragma unroll
            for (int j = 0; j < 4; ++j) *(f32x4*)(xres + (size_t)m * D + 4 * lane + 256 * j) = x[j];
            const float* mn = (const float*)(ws + WS_MODF) + ((size_t)(l + 1) * 3 + v) * 6144; f32x4 shv[4], scv[4];
#pragma unroll
            for (int j = 0; j < 4; ++j) { shv[j] = *(const f32x4*)(mn + 4 * lane + 256 * j); scv[j] = *(const f32x4*)(mn + 1024 + 4 * lane + 256 * j); }
            norm_row_store(x, P.in[4] + (size_t)(l + 1) * D, shv, scv, (bf16_t*)(ws + WS_HBUF) + (size_t)m * D, lane);
        } else {
            float ss = 0.f;
#pragma unroll
            for (int j = 0; j < 4; ++j) ss += (x[j].x * x[j].x + x[j].y * x[j].y) + (x[j].z * x[j].z + x[j].w * x[j].w);
            const float rstd = 1.0f / sqrtf(wave_sum(ss) * (1.0f / D) + NORM_EPS);
#pragma unroll
            for (int j = 0; j < 4; ++j) { const int c = 4 * lane + 256 * j; *(f32x4*)(P.out + (size_t)m * D + c) = (x[j] * rstd) * *(const f32x4*)(P.in[25] + c); }
        }
    }
}

#ifndef REP_PRO
#define REP_PRO 1
#endif
#ifndef REP_GEMM1
#define REP_GEMM1 1
#endif
#ifndef REP_G1U
#define REP_G1U 1
#endif
#ifndef REP_F1U
#define REP_F1U 1
#endif
#ifndef REP_CONV
#define REP_CONV 1
#endif
#ifndef REP_F2U
#define REP_F2U 1
#endif
#ifndef REP_G3U
#define REP_G3U 1
#endif
#ifndef REP_GU
#define REP_GU 1
#endif
#ifndef REP_DN
#define REP_DN 1
#endif
#ifndef REP_GATH
#define REP_GATH 1
#endif
__global__ void __launch_bounds__(NTHREADS, 2) mega_fwd(Params P0) {
    extern __shared__ __attribute__((aligned(16))) unsigned char lds_raw[];
    Frame F0; F0.lds = (LAS unsigned char*)lds_raw; F0.tid = threadIdx.x; F0.lane = F0.tid & 63; F0.wave = __builtin_amdgcn_readfirstlane(F0.tid >> 6); F0.G = gridDim.x; F0.bid = blockIdx.x;
#define KAS __attribute__((address_space(4)))
    struct ParamsK { const GAS float* in[26]; GAS float* out; GAS unsigned char* ws; };
#define PHASE_ENV() Frame F = F0; asm volatile("" : "+v"(F.tid)); F.lane = F.tid & 63; F.wave = __builtin_amdgcn_readfirstlane(F.tid >> 6); asm volatile("" : "+s"(F.bid), "+s"(F.G)); \
    const KAS ParamsK* kp_ = (const KAS ParamsK*)__builtin_amdgcn_kernarg_segment_ptr(); asm volatile("" : "+s"(kp_)); Params P; \
    _Pragma("unroll") for (int i_ = 0; i_ < 26; ++i_) P.in[i_] = (const float*)kp_->in[i_]; \
    P.out = (float*)kp_->out; P.ws = (unsigned char*)kp_->ws; unsigned char* ws = P.ws; (void)ws;
    { PHASE_ENV();
    for (int u = F.tid; u < (LDS_BYTES - LCTL_OFF) / 4; u += NTHREADS) ((LAS unsigned*)(F.lds + LCTL_OFF))[u] = 0u;
    __syncthreads();
    }
    { PHASE_ENV(); (void)xcd_barrier_post((unsigned*)(ws + WS_CTL) + CW_BAR, (volatile LAS unsigned*)(F.lds + LC_BAR)); }
#define GRID_BAR() do { PHASE_ENV(); XcdBarrier b_; b_.bar = (unsigned*)(ws + WS_CTL) + CW_BAR; b_.x = xb_xcc_id(); b_.st = (volatile LAS unsigned*)(F.lds + LC_BAR); xcd_barrier(b_); } while (0)

    for (int rep = 0; rep < REP_PRO; ++rep) { PHASE_ENV(); phase_prologue(F, P); }
    GRID_BAR();
    { PHASE_ENV(); phase_p1(F, P); }
    GRID_BAR();

    {
        constexpr int l = 0; constexpr bool last = (l == DEPTH - 1);
        for (int rep = 0; rep < REP_GEMM1; ++rep) { PHASE_ENV(); pg8::Gemm g{(const bf16_t*)(ws + WS_HBUF), (const bf16_t*)(ws + WS_WIN) + (size_t)l * INP * D, NTOK, INP, D};
          pg8::StaticOrder S; S.init(NTOK, INP, F.G, F.bid);
          pg8::EpiStoreBf16 E{(bf16_t*)(ws + WS_PBUF), INP};
          pg8::gemm_phase<pg8::EpiStoreBf16, pg8::StaticOrder>(F.lds, g, S, E, F.tid);
          const int nun = (NTOK / 256) * (INP / 256), rr = nun % F.G, first = (rr == 0) ? 0 : rr, nidle = F.G - first;
          if (F.bid >= first) for (int t = F.bid - first; t < NTOK / 256; t += nidle) {
              SkEpiBf16 SE{(bf16_t*)(ws + WS_LRB) + (size_t)t * 256 * 32, 32};
              skinny_unit(F, (const bf16_t*)(ws + WS_HBUF) + (size_t)t * 256 * D, (const bf16_t*)(ws + WS_WGT) + (size_t)l * 32 * D, SE); } }
        GRID_BAR();
        for (int rep = 0; rep < REP_G1U; ++rep) { PHASE_ENV();
        for (int u = F.bid; u < 2080; u += F.G) { int row0, h;
            if (u < 2048) { const int bh = u >> 8, n = u & 255; h = bh & 3; row0 = (bh >> 2) * SEQ + 64 * n; }
            else { const int q = u - 2048, bh = q >> 2, n = q & 3; h = bh & 3; row0 = NLAT + (bh >> 2) * CTXL + 64 * n; }
            gla_g1_unit(F, P, l, row0, h, u); }
        __syncthreads(); }
        for (int rep = 0; rep < REP_F1U; ++rep) { PHASE_ENV();
        for (int u = F.bid; u < 1024; u += F.G) { const int b = u >> 9, nlo = (u >> 2) & 127, h = u & 3;
            fourier_f1_unit<128, 3>(F, P, b * SEQ + nlo, 128, h, (const bf16_t*)(ws + WS_TLAT) + (size_t)nlo * 32768, b * SEQ + nlo, 1.0f); }
        }
        { PHASE_ENV();
        if (!last) for (int u = (F.bid + F.G - 32) % F.G; u < 8; u += F.G) { const int b = u >> 2, h = u & 3;
            fourier_f1_unit<256, 2>(F, P, NLAT + b * CTXL, 1, h, (const bf16_t*)(ws + WS_TCTX), NLAT + b * CTXL, 1.0f / 128.0f); }
        }
        for (int rep = 0; rep < REP_CONV; ++rep) { PHASE_ENV();
        for (int u = F.bid; u < 512 + F.G; u += F.G) {
            int rowbase = 64 * u, Ls = 64, t0 = 0;
            if (u >= 512) { const int q = (u - 512) - 40; if (last || q < 0 || q >= 8) break; rowbase = NLAT + (q >> 2) * CTXL; Ls = CTXL; t0 = 64 * (q & 3); }
            conv_unit(F, P, l, rowbase, Ls, t0); } }
        GRID_BAR();
        { PHASE_ENV(); gla_scan(F, P, WT_DEF0_LO, WT_DEF0_HI); __syncthreads(); }
        for (int rep = 0; rep < REP_F2U; ++rep) { PHASE_ENV();
        fourier_f2_tables(F, P);
        for (int u = F.bid; u < 512; u += F.G) fourier_f2_unit(F, P, u >> 8, (u >> 1) & 127, u & 1); }
        GRID_BAR();
        for (int rep = 0; rep < REP_G3U; ++rep) { PHASE_ENV();
        for (int u = F.bid; u < (last ? 2048 : 2080); u += F.G) { int row0, h;
            if (u < 2048) { const int bh = u >> 8, n = u & 255; h = bh & 3; row0 = (bh >> 2) * SEQ + 64 * n; }
            else { const int q = u - 2048, bh = q >> 2, n = q & 3; h = bh & 3; row0 = NLAT + (bh >> 2) * CTXL + 64 * n; }
            gla_g3_unit(F, P, l, row0, h, u); }
        __syncthreads(); }
        GRID_BAR();
        { PHASE_ENV(); const int M2 = NLAT;
          pg8::Gemm g{(const bf16_t*)(ws + WS_CAT), (const bf16_t*)(ws + WS_WOUT) + (size_t)l * D * D, M2, D, D};
          pg8::StaticOrder S; S.init(M2, D, F.G, F.bid);
          pg8::EpiResid E{(float*)(ws + WS_XRES), (l == 0) ? P.in[0] : (const float*)(ws + WS_XRES), (const float*)(ws + WS_MODF) + (size_t)l * 3 * 6144};
          pg8::gemm_phase<pg8::EpiResid, pg8::StaticOrder>(F.lds, g, S, E, F.tid);
          if (!last) for (int t = F.bid; t < 2 * 32; t += F.G) { const int pm = NLAT / 256 + (t >> 5), nt32 = t & 31;
              SkEpiResid SE{(float*)(ws + WS_XRES) + (size_t)pm * 256 * D + nt32 * 32, P.in[2] + (size_t)(pm - NLAT / 256) * 256 * D + nt32 * 32, (const float*)(ws + WS_MODF) + ((size_t)l * 3 + 2) * 6144 + 2 * 1024 + nt32 * 32};
              skinny_unit(F, (const bf16_t*)(ws + WS_CAT) + (size_t)pm * 256 * D, (const bf16_t*)(ws + WS_WOUT) + (size_t)l * D * D + (size_t)nt32 * 32 * D, SE); } }
        GRID_BAR();
        const int ntok = last ? NLAT : NTOK;
        { PHASE_ENV(); phase_route(F, P, l, ntok); }
        GRID_BAR();
        for (int rep = 0; rep < REP_GU; ++rep) { PHASE_ENV(); moe_prep(F, P, l); const volatile LAS int* TS = (const volatile LAS int*)(F.lds + LC_TS);
          pg8::MoeOrder S{8, F.G, F.bid, TS[NE], TS};
          if constexpr (F8_LAYER[l]) {
              pg8::Gemm g{(const bf16_t*)(ws + WS_HB8), (const bf16_t*)(ws + WS_WGU + (size_t)l * NE * 2048 * D * 2), 0, 2048, D / 2};
              pg8::EpiGateUp8 E{ws + WS_ACT, P.in[22] + (size_t)l * NE * 2048};
              pg8::gemm_phase_gather<pg8::EpiGateUp8, pg8::MoeOrder, true>(F.lds, g, (const int*)(ws + WS_XB), S, E, F.tid);
          } else {
              pg8::Gemm g{(const bf16_t*)(ws + WS_HBUF), (const bf16_t*)(ws + WS_WGU) + (size_t)l * NE * 2048 * D, 0, 2048, D};
              pg8::EpiGateUp E{(bf16_t*)(ws + WS_ACT), P.in[22] + (size_t)l * NE * 2048};
              pg8::gemm_phase_gather<pg8::EpiGateUp, pg8::MoeOrder>(F.lds, g, (const int*)(ws + WS_XB), S, E, F.tid); } }
        GRID_BAR();
        for (int rep = 0; rep < REP_DN; ++rep) { PHASE_ENV(); const volatile LAS int* TS = (const volatile LAS int*)(F.lds + LC_TS);
          pg8::MoeOrder S{4, F.G, F.bid, TS[NE], TS};
          if constexpr (F8_LAYER[l]) {
              pg8::Gemm g{(const bf16_t*)(ws + WS_ACT), (const bf16_t*)(ws + WS_WDN + (size_t)l * NE * D * DFF * 2), 0, D, DFF / 2};
              pg8::EpiDown8 E{ws + WS_YB, P.in[24] + (size_t)l * NE * D};
              pg8::gemm_phase<pg8::EpiDown8, pg8::MoeOrder, true, true, true>(F.lds, g, S, E, F.tid);
          } else {
              pg8::Gemm g{(const bf16_t*)(ws + WS_ACT), (const bf16_t*)(ws + WS_WDN) + (size_t)l * NE * D * DFF, 0, D, DFF};
              pg8::EpiDown E{(bf16_t*)(ws + WS_YB), P.in[24] + (size_t)l * NE * D};
              pg8::gemm_phase<pg8::EpiDown, pg8::MoeOrder>(F.lds, g, S, E, F.tid); } }
        GRID_BAR();
        { PHASE_ENV(); phase_combine(F, P, l, ntok, last); }
        if (!last) GRID_BAR();
    }
    {
        constexpr int l = 1; constexpr bool last = (l == DEPTH - 1);
        for (int rep = 0; rep < REP_GEMM1; ++rep) { PHASE_ENV(); pg8::Gemm g{(const bf16_t*)(ws + WS_HBUF), (const bf16_t*)(ws + WS_WIN) + (size_t)l * INP * D, NTOK, INP, D};
          pg8::StaticOrder S; S.init(NTOK, INP, F.G, F.bid);
          pg8::EpiStoreBf16 E{(bf16_t*)(ws + WS_PBUF), INP};
          pg8::gemm_phase<pg8::EpiStoreBf16, pg8::StaticOrder>(F.lds, g, S, E, F.tid);
          const int nun = (NTOK / 256) * (INP / 256), rr = nun % F.G, first = (rr == 0) ? 0 : rr, nidle = F.G - first;
          if (F.bid >= first) for (int t = F.bid - first; t < NTOK / 256; t += nidle) {
              SkEpiBf16 SE{(bf16_t*)(ws + WS_LRB) + (size_t)t * 256 * 32, 32};
              skinny_unit(F, (const bf16_t*)(ws + WS_HBUF) + (size_t)t * 256 * D, (const bf16_t*)(ws + WS_WGT) + (size_t)l * 32 * D, SE); } }
        GRID_BAR();
        for (int rep = 0; rep < REP_G1U; ++rep) { PHASE_ENV();
        for (int u = F.bid; u < 2080; u += F.G) { int row0, h;
            if (u < 2048) { const int bh = u >> 8, n = u & 255; h = bh & 3; row0 = (bh >> 2) * SEQ + 64 * n; }
            else { const int q = u - 2048, bh = q >> 2, n = q & 3; h = bh & 3; row0 = NLAT + (bh >> 2) * CTXL + 64 * n; }
            gla_g1_unit(F, P, l, row0, h, u); }
        __syncthreads(); }
        for (int rep = 0; rep < REP_F1U; ++rep) { PHASE_ENV();
        for (int u = F.bid; u < 1024; u += F.G) { const int b = u >> 9, nlo = (u >> 2) & 127, h = u & 3;
            fourier_f1_unit<128, 3>(F, P, b * SEQ + nlo, 128, h, (const bf16_t*)(ws + WS_TLAT) + (size_t)nlo * 32768, b * SEQ + nlo, 1.0f); }
        }
        { PHASE_ENV();
        if (!last) for (int u = (F.bid + F.G - 32) % F.G; u < 8; u += F.G) { const int b = u >> 2, h = u & 3;
            fourier_f1_unit<256, 2>(F, P, NLAT + b * CTXL, 1, h, (const bf16_t*)(ws + WS_TCTX), NLAT + b * CTXL, 1.0f / 128.0f); }
        }
        for (int rep = 0; rep < REP_CONV; ++rep) { PHASE_ENV();
        for (int u = F.bid; u < 512 + F.G; u += F.G) {
            int rowbase = 64 * u, Ls = 64, t0 = 0;
            if (u >= 512) { const int q = (u - 512) - 40; if (last || q < 0 || q >= 8) break; rowbase = NLAT + (q >> 2) * CTXL; Ls = CTXL; t0 = 64 * (q & 3); }
            conv_unit(F, P, l, rowbase, Ls, t0); } }
        GRID_BAR();
        { PHASE_ENV(); gla_scan(F, P, WT_DEF1_LO, WT_DEF1_HI); __syncthreads(); }
        for (int rep = 0; rep < REP_F2U; ++rep) { PHASE_ENV();
        fourier_f2_tables(F, P);
        for (int u = F.bid; u < 512; u += F.G) fourier_f2_unit(F, P, u >> 8, (u >> 1) & 127, u & 1); }
        GRID_BAR();
        for (int rep = 0; rep < REP_G3U; ++rep) { PHASE_ENV();
        for (int u = F.bid; u < (last ? 2048 : 2080); u += F.G) { int row0, h;
            if (u < 2048) { const int bh = u >> 8, n = u & 255; h = bh & 3; row0 = (bh >> 2) * SEQ + 64 * n; }
            else { const int q = u - 2048, bh = q >> 2, n = q & 3; h = bh & 3; row0 = NLAT + (bh >> 2) * CTXL + 64 * n; }
            gla_g3_unit(F, P, l, row0, h, u); }
        __syncthreads(); }
        GRID_BAR();
        { PHASE_ENV(); const int M2 = NLAT;
          pg8::Gemm g{(const bf16_t*)(ws + WS_CAT), (const bf16_t*)(ws + WS_WOUT) + (size_t)l * D * D, M2, D, D};
          pg8::StaticOrder S; S.init(M2, D, F.G, F.bid);
          pg8::EpiResid E{(float*)(ws + WS_XRES), (l == 0) ? P.in[0] : (const float*)(ws + WS_XRES), (const float*)(ws + WS_MODF) + (size_t)l * 3 * 6144};
          pg8::gemm_phase<pg8::EpiResid, pg8::StaticOrder>(F.lds, g, S, E, F.tid);
          if (!last) for (int t = F.bid; t < 2 * 32; t += F.G) { const int pm = NLAT / 256 + (t >> 5), nt32 = t & 31;
              SkEpiResid SE{(float*)(ws + WS_XRES) + (size_t)pm * 256 * D + nt32 * 32, P.in[2] + (size_t)(pm - NLAT / 256) * 256 * D + nt32 * 32, (const float*)(ws + WS_MODF) + ((size_t)l * 3 + 2) * 6144 + 2 * 1024 + nt32 * 32};
              skinny_unit(F, (const bf16_t*)(ws + WS_CAT) + (size_t)pm * 256 * D, (const bf16_t*)(ws + WS_WOUT) + (size_t)l * D * D + (size_t)nt32 * 32 * D, SE); } }
        GRID_BAR();
        const int ntok = last ? NLAT : NTOK;
        { PHASE_ENV(); phase_route(F, P, l, ntok); }
        GRID_BAR();
        for (int rep = 0; rep < REP_GU; ++rep) { PHASE_ENV(); moe_prep(F, P, l); const volatile LAS int* TS = (const volatile LAS int*)(F.lds + LC_TS);
          pg8::MoeOrder S{8, F.G, F.bid, TS[NE], TS};
          if constexpr (F8_LAYER[l]) {
              pg8::Gemm g{(const bf16_t*)(ws + WS_HB8), (const bf16_t*)(ws + WS_WGU + (size_t)l * NE * 2048 * D * 2), 0, 2048, D / 2};
              pg8::EpiGateUp8 E{ws + WS_ACT, P.in[22] + (size_t)l * NE * 2048};
              pg8::gemm_phase_gather<pg8::EpiGateUp8, pg8::MoeOrder, true>(F.lds, g, (const int*)(ws + WS_XB), S, E, F.tid);
          } else {
              pg8::Gemm g{(const bf16_t*)(ws + WS_HBUF), (const bf16_t*)(ws + WS_WGU) + (size_t)l * NE * 2048 * D, 0, 2048, D};
              pg8::EpiGateUp E{(bf16_t*)(ws + WS_ACT), P.in[22] + (size_t)l * NE * 2048};
              pg8::gemm_phase_gather<pg8::EpiGateUp, pg8::MoeOrder>(F.lds, g, (const int*)(ws + WS_XB), S, E, F.tid); } }
        GRID_BAR();
        for (int rep = 0; rep < REP_DN; ++rep) { PHASE_ENV(); const volatile LAS int* TS = (const volatile LAS int*)(F.lds + LC_TS);
          pg8::MoeOrder S{4, F.G, F.bid, TS[NE], TS};
          if constexpr (F8_LAYER[l]) {
              pg8::Gemm g{(const bf16_t*)(ws + WS_ACT), (const bf16_t*)(ws + WS_WDN + (size_t)l * NE * D * DFF * 2), 0, D, DFF / 2};
              pg8::EpiDown8 E{ws + WS_YB, P.in[24] + (size_t)l * NE * D};
              pg8::gemm_phase<pg8::EpiDown8, pg8::MoeOrder, true, true, true>(F.lds, g, S, E, F.tid);
          } else {
              pg8::Gemm g{(const bf16_t*)(ws + WS_ACT), (const bf16_t*)(ws + WS_WDN) + (size_t)l * NE * D * DFF, 0, D, DFF};
              pg8::EpiDown E{(bf16_t*)(ws + WS_YB), P.in[24] + (size_t)l * NE * D};
              pg8::gemm_phase<pg8::EpiDown, pg8::MoeOrder>(F.lds, g, S, E, F.tid); } }
        GRID_BAR();
        { PHASE_ENV(); phase_combine(F, P, l, ntok, last); }
        if (!last) GRID_BAR();
    }
}

extern "C" void kernel_launch(void* const* d_in, const int* in_sizes, int n_in, void* d_out, int out_size, void* d_ws, size_t ws_size, hipStream_t stream) {
    static int grid = 0;
    if (grid == 0) {
        if (n_in != 26 || ws_size < WS_END) { fprintf(stderr, "kernel_launch: unexpected n_in %d or ws_size %zu (need %zu)\n", n_in, ws_size, (size_t)WS_END); grid = -1; return; }
        int dev = 0, cus = 0, per_cu = 0;
        if (hipGetDevice(&dev) != hipSuccess || hipDeviceGetAttribute(&cus, hipDeviceAttributeMultiprocessorCount, dev) != hipSuccess) { grid = -1; return; }
        if (hipFuncSetAttribute((const void*)mega_fwd, hipFuncAttributeMaxDynamicSharedMemorySize, LDS_BYTES) != hipSuccess) { fprintf(stderr, "kernel_launch: hipFuncSetAttribute failed\n"); grid = -1; return; }
        if (hipOccupancyMaxActiveBlocksPerMultiprocessor(&per_cu, (const void*)mega_fwd, NTHREADS, LDS_BYTES) != hipSuccess || per_cu < 1) { fprintf(stderr, "kernel_launch: occupancy query says %d\n", per_cu); }
        (void)hipGetLastError();
        grid = cus;
    }
    if (grid < 0) return;
    (void)hipMemsetAsync((char*)d_ws + WS_CTL, 0, CTL_ZERO_BYTES, stream);
    Params p{};
    for (int i = 0; i < 26; ++i) p.in[i] = (const float*)d_in[i];
    p.out = (float*)d_out; p.ws = (unsigned char*)d_ws;
    hipLaunchKernelGGL(mega_fwd, dim3(grid), dim3(NTHREADS), LDS_BYTES, stream, p);
}
```

```cpp
#include <hip/hip_runtime.h>
#include <cstdio>
#include <cstdint>

#define LAS __attribute__((address_space(3)))
#define GAS __attribute__((address_space(1)))
typedef unsigned short bf16_t;
typedef short bf16x8 __attribute__((ext_vector_type(8)));
typedef float f32x4 __attribute__((ext_vector_type(4)));
typedef float f32x2 __attribute__((ext_vector_type(2)));
typedef unsigned u32x4 __attribute__((ext_vector_type(4)));
typedef unsigned u32x2 __attribute__((ext_vector_type(2)));

constexpr int D = 1024, NBATCH = 2, SEQ = 16384, NLAT = NBATCH * SEQ, CTXL = 256, NCTX = NBATCH * CTXL, NTOK = NLAT + NCTX, DEPTH = 2;
constexpr int INW = 2336, INP = 2304;
constexpr int C_FOUR = 0, C_Q = 256, C_K = 512, C_V = 768, C_R = 1280, C_CA = 1792, C_CG = 2048;
constexpr int NE = 32, TOPK = 4, DFF = 1024;
constexpr int MAXROWS = NTOK * TOPK + NE * 256;
constexpr float NORM_EPS = 1e-6f;
constexpr int NTHREADS = 512, NWAVES = 8;

constexpr size_t MiB = 1u << 20;
constexpr size_t WS_CTL = 0, CTL_ZERO_BYTES = 1 * MiB;
constexpr size_t WS_MODP = 1 * MiB;
constexpr size_t WS_MODF = 3 * MiB;
constexpr size_t WS_RW = 3 * MiB + 512 * 1024;
constexpr size_t WS_WGT = 3 * MiB + 768 * 1024;
constexpr size_t WS_CM3 = 4 * MiB;
constexpr size_t WS_TF2 = 4 * MiB + 65536;
constexpr size_t WS_TCTX = 4 * MiB + 262144;
constexpr size_t WS_TLAT = 5 * MiB;
constexpr size_t WS_WIN = 13 * MiB;
constexpr size_t WS_WOUT = 23 * MiB;
constexpr size_t WS_WGU = 27 * MiB;
constexpr size_t WS_WDN = 283 * MiB;
constexpr size_t WS_XRES = 411 * MiB;
constexpr size_t WS_HBUF = 541 * MiB;
constexpr size_t WS_PBUF = 606 * MiB;
constexpr size_t WS_CAT = 769 * MiB;
constexpr size_t WS_T2 = 834 * MiB;
constexpr size_t WS_STATE = 866 * MiB;
constexpr size_t WS_DECAY = 996 * MiB;
constexpr size_t WS_AEXP = 998 * MiB, WS_APOS = 999 * MiB, WS_APROB = 1000 * MiB, WS_ASLOT = 1001 * MiB;
constexpr size_t WS_XB8 = 1106 * MiB;
constexpr size_t WS_HB8 = 1066 * MiB;
constexpr bool F8_LAYER[2] = {true, true};
constexpr size_t WS_LRB = 1018 * MiB;
constexpr size_t WS_XB = 1002 * MiB, WS_ACT = 1278 * MiB, WS_YB = 1554 * MiB, WS_END = 1830 * MiB;
constexpr int CW_BAR = 4096, CW_CNT = 16384;

constexpr int RING_BYTES = 131072;
constexpr int AUX_OFF = RING_BYTES;
constexpr int LCTL_OFF = RING_BYTES + 8192;
constexpr int LDS_BYTES = 147456;

__device__ __forceinline__ unsigned f2bf(float f) { unsigned u = __builtin_bit_cast(unsigned, f); return (u + 0x7fffu + ((u >> 16) & 1u)) >> 16; }
__device__ __forceinline__ unsigned pk2(float lo, float hi) { return f2bf(lo) | (f2bf(hi) << 16); }
__device__ __forceinline__ float bf2f(unsigned b) { return __builtin_bit_cast(float, b << 16); }
__device__ __forceinline__ float bflo(unsigned w) { return __builtin_bit_cast(float, w << 16); }
__device__ __forceinline__ float bfhi(unsigned w) { return __builtin_bit_cast(float, w & 0xffff0000u); }
__device__ __forceinline__ float wave_sum(float v) {
#pragma unroll
    for (int o = 1; o < 64; o <<= 1) v += __shfl_xor(v, o);
    return v;
}
__device__ __forceinline__ float sigmoidf_(float x) { return __builtin_amdgcn_rcpf(1.0f + __expf(-x)); }

#define XB_TMO      128
#define XB_XCNT(j)  (256  + 64 * (j))
#define XB_XSUB(j)  (1280 + 64 * (j))
#define XB_XGEN(j)  (2304 + 64 * (j))
#define XB_TOP      3328
#define XB_TOPGEN   3392
#define XCD_BAR_WORDS 3456
#define XB_SPIN_CAP (1u << 22)

__device__ __forceinline__ unsigned xb_ld(unsigned* p)              { return __hip_atomic_load(p, __ATOMIC_RELAXED, __HIP_MEMORY_SCOPE_AGENT); }
__device__ __forceinline__ unsigned xb_add(unsigned* p, unsigned v) { return __hip_atomic_fetch_add(p, v, __ATOMIC_RELAXED, __HIP_MEMORY_SCOPE_AGENT); }
__device__ __forceinline__ unsigned xb_xcc_id() { return (unsigned)__builtin_amdgcn_s_getreg((3 << 11) | 20) & 0xFu; }
#define XB_SPIN(cond, bar) do { unsigned _sp = 0; while (cond) { __builtin_amdgcn_s_sleep(1); \
    if ((++_sp & 255u) == 0u) { if (xb_ld(&(bar)[XB_TMO])) break; if (_sp > XB_SPIN_CAP) { atomicAdd(&(bar)[XB_TMO], 1u); break; } } } } while (0)

struct XcdBarrier { unsigned* bar; unsigned x; volatile LAS unsigned* st; };

__device__ __forceinline__ XcdBarrier xcd_barrier_post(unsigned* bar, volatile LAS unsigned* st) {
    XcdBarrier b; b.bar = bar; b.x = xb_xcc_id(); b.st = st;
    if (threadIdx.x == 0) (void)xb_add(&bar[XB_XCNT(b.x)], 1u);
    return b;
}
__device__ __forceinline__ void xcd_barrier_complete(unsigned* bar, unsigned x, unsigned& nloc, unsigned& nx) {
    const unsigned G = gridDim.x * gridDim.y * gridDim.z;
    unsigned sum, cnt, mine, sp = 0u;
    for (;;) {
        sum = 0u; cnt = 0u; mine = 0u;
#pragma unroll
        for (unsigned j = 0; j < 16; ++j) { const unsigned c = xb_ld(&bar[XB_XCNT(j)]); sum += c; cnt += (c > 0u) ? 1u : 0u; mine = (j == x) ? c : mine; }
        if (sum == G) break;
        __builtin_amdgcn_s_sleep(1);
        if ((++sp & 255u) == 0u) { if (xb_ld(&bar[XB_TMO])) break; if (sp > XB_SPIN_CAP) { atomicAdd(&bar[XB_TMO], 1u); break; } }
    }
    nloc = mine > 0u ? mine : 1u; nx = cnt > 0u ? cnt : 1u;
}
__device__ __forceinline__ void xcd_barrier(const XcdBarrier& b) {
    asm volatile("s_waitcnt vmcnt(0)" ::: "memory");
    __syncthreads();
    if (threadIdx.x == 0) {
        unsigned* bar = b.bar;
        __builtin_amdgcn_s_waitcnt(0);
        unsigned nloc = b.st[0], nx = b.st[1];
        if (nloc == 0u) { xcd_barrier_complete(bar, b.x, nloc, nx); b.st[0] = nloc; b.st[1] = nx; }
        const unsigned old = xb_add(&bar[XB_XSUB(b.x)], 1u);
        const unsigned gen = old / nloc;
        if (old + 1u == (gen + 1u) * nloc) {
            __builtin_amdgcn_fence(__ATOMIC_RELEASE, "agent");
            asm volatile("s_waitcnt vmcnt(0)" ::: "memory");
            const unsigned og = xb_add(&bar[XB_TOP], 1u);
            const unsigned tg = og / nx;
            if (og + 1u == (tg + 1u) * nx) xb_add(&bar[XB_TOPGEN], 1u);
            else XB_SPIN(xb_ld(&bar[XB_TOPGEN]) == tg, bar);
            __builtin_amdgcn_fence(__ATOMIC_ACQUIRE, "agent");
            xb_add(&bar[XB_XGEN(b.x)], 1u);
            asm volatile("s_waitcnt vmcnt(0)" ::: "memory");
        } else {
            XB_SPIN(xb_ld(&bar[XB_XGEN(b.x)]) == gen, bar);
            __builtin_amdgcn_fence(__ATOMIC_ACQUIRE, "agent");
            asm volatile("s_waitcnt vmcnt(0)" ::: "memory");
        }
    }
    __syncthreads();
}

namespace pg8 {
constexpr int BM = 256, BK = 64, HALF = 128, HTB = HALF * BK * 2, STAGE_BYTES = 8 * HTB, NXCD = 8, WGM = 8;
__host__ __device__ __forceinline__ int lds_byte(int r, int c) { const int st = (r >> 4) * 2 + (c >> 5), rr = r & 15, cc = c & 31, ob = rr * 64 + cc * 2; return st * 1024 + (ob ^ (((ob >> 9) & 1) << 5)); }
__host__ __device__ __forceinline__ void stage_rc(int b, int& R, int& C) { const int st = b / 1024, sb = b % 1024, swz = sb ^ (((sb >> 9) & 1) << 5); R = (st >> 1) * 16 + swz / 64; C = (st & 1) * 32 + (swz % 64) / 2; }
__host__ __device__ __forceinline__ int perm32(int rho) { const int n = rho >> 4, i = rho & 15; return 8 * (i >> 2) + 4 * n + (i & 3); }

struct Unit { int pm, pn, lbase, nvalid; };
struct Gemm { const bf16_t* A; const bf16_t* Bt; int M, N, K; };

struct StaticOrder {
    int nM, nN, nwg, G, c;
    __device__ void init(int M, int N, int G_, int c_) { nM = M / BM; nN = N / BM; nwg = nM * nN; G = G_; c = c_; }
    __device__ bool next(int i, Unit& u) const {
        const long L = (long)i * G + c; if (L >= nwg) return false;
        int wgid = (int)L; { const int q = nwg / NXCD, r = nwg % NXCD, xcd = wgid % NXCD, off = wgid / NXCD; wgid = (xcd < r ? xcd * (q + 1) : r * (q + 1) + (xcd - r) * q) + off; }
        const int nig = WGM * nN, gid = wgid / nig, fm = gid * WGM, gsz = (nM - fm) < WGM ? (nM - fm) : WGM;
        u.pm = fm + ((wgid % nig) % gsz); u.pn = (wgid % nig) / gsz; u.lbase = 0; u.nvalid = 0; return true;
    }
};
struct MoeOrder {
    int nN, G, c, MT; const volatile LAS int* ts;
    __device__ bool next(int i, Unit& u) const {
        const long L = (G % 8 == 0) ? ((long)i * G + (long)(c & 7) * (G >> 3) + (c >> 3)) : ((long)i * G + c);
        if (L >= (long)MT * nN) return false;
        const int mt = (int)(L / nN), pl = (int)(L % nN);
        const int lane = threadIdx.x & 63;
        const unsigned long long bal = __ballot(lane >= 1 && lane < NE && ts[lane] <= mt);
        const int e = __popcll(bal);
        const int j = mt - ts[e];
        u.pm = mt; u.pn = e * nN + pl; u.lbase = e * NTOK + j * 256; u.nvalid = ts[64 + e] - j * 256; return true;
    }
};

__device__ __forceinline__ unsigned cvt_pk_bf16(float lo, float hi) { unsigned r; asm volatile("v_cvt_pk_bf16_f32 %0, %1, %2" : "=v"(r) : "v"(lo), "v"(hi)); return r; }

struct EpiStoreBf16 {
    static constexpr bool PERM = true;
    bf16_t* O; int ldc;
    __device__ __forceinline__ void operator()(const f32x4 (&acc)[2][2][4][2], const Unit& u, int wr, int wc, int fr, int fq) const {
        const int row0 = u.pm * BM + wr * 64 + fr; const int col0 = u.pn * BM + wc * 32 + 8 * fq;
#pragma unroll
        for (int ai = 0; ai < 2; ++ai)
#pragma unroll
            for (int m = 0; m < 4; ++m) { bf16_t* rowp = O + (size_t)(row0 + ai * HALF + m * 16) * ldc + col0;
#pragma unroll
                for (int bj = 0; bj < 2; ++bj) { const f32x4 v0 = acc[ai][bj][m][0], v1 = acc[ai][bj][m][1];
                    u32x4 w; w.x = cvt_pk_bf16(v0[0], v0[1]); w.y = cvt_pk_bf16(v0[2], v0[3]); w.z = cvt_pk_bf16(v1[0], v1[1]); w.w = cvt_pk_bf16(v1[2], v1[3]);
                    *(u32x4*)(rowp + bj * HALF) = w; } }
    }
};
struct EpiResid {
    static constexpr bool PERM = false;
    float* X; const float* Xs; const float* modf;
    __device__ __forceinline__ void operator()(const f32x4 (&acc)[2][2][4][2], const Unit& u, int wr, int wc, int fr, int fq) const {
        const int row0 = u.pm * BM + wr * 64 + fr, col0 = u.pn * BM + wc * 32 + 4 * fq;
        const int v = (u.pm >= NLAT / BM) ? 2 : (u.pm >= SEQ / BM ? 1 : 0);
        const float* gv = modf + (size_t)v * 6144 + 2 * 1024;
        f32x4 bv[2][2];
#pragma unroll
        for (int bj = 0; bj < 2; ++bj)
#pragma unroll
            for (int n = 0; n < 2; ++n) bv[bj][n] = *(const f32x4*)(gv + col0 + bj * HALF + n * 16);
#pragma unroll
        for (int ai = 0; ai < 2; ++ai) {
            f32x4 xv[4][2][2];
#pragma unroll
            for (int m = 0; m < 4; ++m) { const float* rowp = Xs + (size_t)(row0 + ai * HALF + m * 16) * D + col0;
#pragma unroll
                for (int bj = 0; bj < 2; ++bj)
#pragma unroll
                    for (int n = 0; n < 2; ++n) xv[m][bj][n] = *(const f32x4*)(rowp + bj * HALF + n * 16); }
#pragma unroll
            for (int m = 0; m < 4; ++m) { float* rowp = X + (size_t)(row0 + ai * HALF + m * 16) * D + col0;
#pragma unroll
                for (int bj = 0; bj < 2; ++bj)
#pragma unroll
                    for (int n = 0; n < 2; ++n) *(f32x4*)(rowp + bj * HALF + n * 16) = xv[m][bj][n] + bv[bj][n] * acc[ai][bj][m][n]; }
        }
    }
};
struct EpiGateUp {
    static constexpr bool PERM = true;
    bf16_t* O; const float* bgu;
    __device__ __forceinline__ void operator()(const f32x4 (&acc)[2][2][4][2], const Unit& u, int wr, int wc, int fr, int fq) const {
        const int e = u.pn >> 3, pl = u.pn & 7;
        const int row0 = u.pm * BM + wr * 64 + fr; const int cl = pl * 128 + wc * 32 + 8 * fq;
        const float* bg = bgu + (size_t)e * 2048 + cl; const float* bu = bg + 1024;
        f32x4 g0 = *(const f32x4*)bg, g1 = *(const f32x4*)(bg + 4), u0 = *(const f32x4*)bu, u1 = *(const f32x4*)(bu + 4);
#pragma unroll
        for (int ai = 0; ai < 2; ++ai)
#pragma unroll
            for (int m = 0; m < 4; ++m) { bf16_t* rowp = O + (size_t)(row0 + ai * HALF + m * 16) * DFF + cl;
                float r[8];
#pragma unroll
                for (int n = 0; n < 2; ++n) { const f32x4 gb = n ? g1 : g0, ub = n ? u1 : u0; const f32x4 ga = acc[ai][0][m][n] + gb, ua = acc[ai][1][m][n] + ub;
#pragma unroll
                    for (int j = 0; j < 4; ++j) { const float gate = fminf(ga[j], 7.0f), up = fminf(fmaxf(ua[j], -7.0f), 7.0f);
                        r[n * 4 + j] = gate * __builtin_amdgcn_rcpf(1.0f + __expf(-1.702f * gate)) * (up + 1.0f); } }
                u32x4 w; w.x = cvt_pk_bf16(r[0], r[1]); w.y = cvt_pk_bf16(r[2], r[3]); w.z = cvt_pk_bf16(r[4], r[5]); w.w = cvt_pk_bf16(r[6], r[7]);
                *(u32x4*)rowp = w; }
    }
};
struct EpiDown {
    static constexpr bool PERM = true;
    bf16_t* O; const float* bdn;
    __device__ __forceinline__ void operator()(const f32x4 (&acc)[2][2][4][2], const Unit& u, int wr, int wc, int fr, int fq) const {
        const int e = u.pn >> 2, pl = u.pn & 3;
        const int row0 = u.pm * BM + wr * 64 + fr; const int col0 = pl * BM + wc * 32 + 8 * fq;
        f32x4 bv[2][2];
#pragma unroll
        for (int bj = 0; bj < 2; ++bj)
#pragma unroll
            for (int n = 0; n < 2; ++n) bv[bj][n] = *(const f32x4*)(bdn + (size_t)e * 1024 + col0 + bj * HALF + 4 * n);
#pragma unroll
        for (int ai = 0; ai < 2; ++ai)
#pragma unroll
            for (int m = 0; m < 4; ++m) { bf16_t* rowp = O + (size_t)(row0 + ai * HALF + m * 16) * D + col0;
#pragma unroll
                for (int bj = 0; bj < 2; ++bj) { const f32x4 v0 = acc[ai][bj][m][0] + bv[bj][0], v1 = acc[ai][bj][m][1] + bv[bj][1];
                    u32x4 w; w.x = cvt_pk_bf16(v0[0], v0[1]); w.y = cvt_pk_bf16(v0[2], v0[3]); w.z = cvt_pk_bf16(v1[0], v1[1]); w.w = cvt_pk_bf16(v1[2], v1[3]);
                    *(u32x4*)(rowp + bj * HALF) = w; } }
    }
};

__device__ __forceinline__ unsigned pk4_fp8(float a, float b, float c, float d) { unsigned w = 0u; w = __builtin_amdgcn_cvt_pk_fp8_f32(a, b, w, false); w = __builtin_amdgcn_cvt_pk_fp8_f32(c, d, w, true); return w; }
struct EpiGateUp8 {
    static constexpr bool PERM = true;
    unsigned char* O; const float* bgu;
    __device__ __forceinline__ void operator()(const f32x4 (&acc)[2][2][4][2], const Unit& u, int wr, int wc, int fr, int fq) const {
        const int e = u.pn >> 3, pl = u.pn & 7;
        const int row0 = u.pm * BM + wr * 64 + fr; const int cl = pl * 128 + wc * 32 + 8 * fq;
        const float* bg = bgu + (size_t)e * 2048 + cl; const float* bu = bg + 1024;
        f32x4 g0 = *(const f32x4*)bg, g1 = *(const f32x4*)(bg + 4), u0 = *(const f32x4*)bu, u1 = *(const f32x4*)(bu + 4);
#pragma unroll
        for (int ai = 0; ai < 2; ++ai)
#pragma unroll
            for (int m = 0; m < 4; ++m) { unsigned char* rowp = O + (size_t)(row0 + ai * HALF + m * 16) * DFF + cl;
                float r[8];
#pragma unroll
                for (int n = 0; n < 2; ++n) { const f32x4 gb = n ? g1 : g0, ub = n ? u1 : u0;
                    const f32x4 ga = acc[ai][0][m][n] * 0.015625f + gb, ua = acc[ai][1][m][n] * 0.015625f + ub;
                    const f32x4 gate = __builtin_elementwise_min(ga, (f32x4){7.f, 7.f, 7.f, 7.f});
                    const f32x4 up1 = __builtin_elementwise_min(__builtin_elementwise_max(ua, (f32x4){-7.f, -7.f, -7.f, -7.f}), (f32x4){7.f, 7.f, 7.f, 7.f}) + 1.0f;
                    const f32x4 xa = gate * (-1.702f * 1.44269504089f);
                    f32x4 den; den.x = __builtin_amdgcn_exp2f(xa.x); den.y = __builtin_amdgcn_exp2f(xa.y); den.z = __builtin_amdgcn_exp2f(xa.z); den.w = __builtin_amdgcn_exp2f(xa.w);
                    den = den + 1.0f;
                    f32x4 rc; rc.x = __builtin_amdgcn_rcpf(den.x); rc.y = __builtin_amdgcn_rcpf(den.y); rc.z = __builtin_amdgcn_rcpf(den.z); rc.w = __builtin_amdgcn_rcpf(den.w);
                    const f32x4 o = (gate * rc) * up1;
                    r[n * 4 + 0] = o.x; r[n * 4 + 1] = o.y; r[n * 4 + 2] = o.z; r[n * 4 + 3] = o.w; }
                u32x2 w; w.x = pk4_fp8(r[0], r[1], r[2], r[3]); w.y = pk4_fp8(r[4], r[5], r[6], r[7]);
                *(u32x2*)rowp = w; }
    }
};
struct EpiDown8 {
    static constexpr bool PERM = true;
    unsigned char* O; const float* bdn;
    __device__ __forceinline__ void operator()(const f32x4 (&acc)[2][2][4][2], const Unit& u, int wr, int wc, int fr, int fq) const {
        const int e = u.pn >> 2, pl = u.pn & 3;
        const int row0 = u.pm * BM + wr * 64 + fr; const int col0 = pl * BM + wc * 32 + 8 * fq;
        f32x4 bv[2][2];
#pragma unroll
        for (int bj = 0; bj < 2; ++bj)
#pragma unroll
            for (int n = 0; n < 2; ++n) bv[bj][n] = *(const f32x4*)(bdn + (size_t)e * 1024 + col0 + bj * HALF + 4 * n);
#pragma unroll
        for (int ai = 0; ai < 2; ++ai)
#pragma unroll
            for (int m = 0; m < 4; ++m) { unsigned char* rowp = O + (size_t)(row0 + ai * HALF + m * 16) * D + col0;
#pragma unroll
                for (int bj = 0; bj < 2; ++bj) { const f32x4 v0 = acc[ai][bj][m][0] * 0.015625f + bv[bj][0], v1 = acc[ai][bj][m][1] * 0.015625f + bv[bj][1];
                    u32x2 w; w.x = pk4_fp8(v0[0], v0[1], v0[2], v0[3]); w.y = pk4_fp8(v1[0], v1[1], v1[2], v1[3]);
                    *(u32x2*)(rowp + bj * HALF) = w; } }
    }
};

typedef int i32x8 __attribute__((ext_vector_type(8)));
typedef int i32x4 __attribute__((ext_vector_type(4)));
__device__ __forceinline__ i32x8 cat8(const bf16x8 lo, const bf16x8 hi) { const i32x4 a = __builtin_bit_cast(i32x4, lo), b = __builtin_bit_cast(i32x4, hi); return __builtin_shufflevector(a, b, 0, 1, 2, 3, 4, 5, 6, 7); }
template <class Epi, class Sched, bool ALIGN_EPI = true, bool SP2 = true, bool F8 = false>
__device__ __forceinline__ void gemm_phase(LAS unsigned char* lds, const Gemm g, const Sched& S, const Epi& E, const int tid) {
    const int wid = __builtin_amdgcn_readfirstlane(tid >> 6), lane = tid & 63, wr = wid >> 2, wc = wid & 3, fr = lane & 15, fq = lane >> 4;
    const int K = g.K, nt = K / BK;
    unsigned voffA[2], voffB[2];
#pragma unroll
    for (int i = 0; i < 2; ++i) { int R, C; stage_rc(tid * 16 + i * 8192, R, C); const int Rb = Epi::PERM ? ((R & ~31) + perm32(R & 31)) : R;
        voffA[i] = (unsigned)(R * K + C) * 2u; voffB[i] = (unsigned)(Rb * K + C) * 2u; }
    const size_t kstep = (size_t)(BK * 2);
    const size_t hstep = (size_t)HALF * K * 2;
    const size_t tstep = 2 * hstep;
    const unsigned ldsw = (unsigned)wid * 1024u;
    const int aoff = lds_byte(wr * 64 + fr, fq * 8), boff = lds_byte(wc * 32 + fr, fq * 8);
#define PG8_SA(b, h) (((b) * 2 + (h)) * HTB)
#define PG8_SB(b, h) ((4 + (b) * 2 + (h)) * HTB)
#define PG8_STAGE(bufoff, gbase, voff) do { _Pragma("unroll") for (int _i = 0; _i < 2; ++_i) \
        __builtin_amdgcn_global_load_lds((const unsigned*)((const char*)(gbase) + (voff)[_i]), (LAS unsigned*)(lds + (bufoff) + ldsw + _i * 8192), 16, 0, 0); } while (0)
#define PG8_LDA(dst, b, h) do { _Pragma("unroll") for (int m = 0; m < 4; ++m) { if constexpr (F8) dst##8[m] = cat8(*(const LAS bf16x8*)(lds + PG8_SA(b, h) + aoff + m * 2048), *(const LAS bf16x8*)(lds + PG8_SA(b, h) + aoff + m * 2048 + 1024)); \
        else { _Pragma("unroll") for (int k = 0; k < 2; ++k) dst[m][k] = *(const LAS bf16x8*)(lds + PG8_SA(b, h) + aoff + m * 2048 + k * 1024); } } } while (0)
#define PG8_LDB(dst, b, h) do { _Pragma("unroll") for (int n = 0; n < 2; ++n) { if constexpr (F8) dst##8[n] = cat8(*(const LAS bf16x8*)(lds + PG8_SB(b, h) + boff + n * 2048), *(const LAS bf16x8*)(lds + PG8_SB(b, h) + boff + n * 2048 + 1024)); \
        else { _Pragma("unroll") for (int k = 0; k < 2; ++k) dst[n][k] = *(const LAS bf16x8*)(lds + PG8_SB(b, h) + boff + n * 2048 + k * 1024); } } } while (0)
#define PG8_MMA(ai, bj, At, Bt) do { __builtin_amdgcn_s_setprio(1); \
        if constexpr (F8) { _Pragma("unroll") for (int m = 0; m < 4; ++m) _Pragma("unroll") for (int n = 0; n < 2; ++n) \
            acc[ai][bj][m][n] = __builtin_amdgcn_mfma_scale_f32_16x16x128_f8f6f4(Bt##8[n], At##8[m], acc[ai][bj][m][n], 0, 0, 0, 0x7f7f7f7f, 0, 0x7f7f7f7f); \
            _Pragma("unroll") for (int m = 0; m < 4; ++m) _Pragma("unroll") for (int n = 0; n < 2; ++n) asm volatile("" : "+v"(acc[ai][bj][m][n])); } \
        else { _Pragma("unroll") for (int m = 0; m < 4; ++m) _Pragma("unroll") for (int n = 0; n < 2; ++n) _Pragma("unroll") for (int k = 0; k < 2; ++k) \
            acc[ai][bj][m][n] = __builtin_amdgcn_mfma_f32_16x16x32_bf16(Bt[n][k], At[m][k], acc[ai][bj][m][n], 0, 0, 0); } \
        __builtin_amdgcn_s_setprio(0); } while (0)
#define PG8_WAIT_V(n) asm volatile("s_waitcnt vmcnt(" #n ")" ::: "memory")
#define PG8_WAIT_L(n) asm volatile("s_waitcnt lgkmcnt(" #n ")" ::: "memory")
#define PG8_BAR __builtin_amdgcn_s_barrier()
#define PG8_SCHED __builtin_amdgcn_sched_barrier(0)
    Unit cur, nxt; int ui = 0;
    if (!S.next(0, cur)) return;
    f32x4 acc[2][2][4][2];
#pragma unroll
    for (int a = 0; a < 2; ++a)
#pragma unroll
        for (int b = 0; b < 2; ++b)
#pragma unroll
            for (int m = 0; m < 4; ++m)
#pragma unroll
                for (int n = 0; n < 2; ++n) acc[a][b][m][n] = (f32x4){0.f, 0.f, 0.f, 0.f};
    bf16x8 At[4][2], B0[2][2], B1[2][2]; i32x8 At8[4], B08[2], B18[2];
    const char* cA = (const char*)g.A + (size_t)cur.pm * tstep; const char* cB = (const char*)g.Bt + (size_t)cur.pn * tstep;
    if constexpr (SP2) {
        PG8_STAGE(PG8_SB(0, 0), cB, voffB); PG8_STAGE(PG8_SB(0, 1), cB + hstep, voffB); PG8_STAGE(PG8_SA(0, 0), cA, voffA); PG8_STAGE(PG8_SA(0, 1), cA + hstep, voffA);
        if (wr == 1) PG8_BAR;
        PG8_WAIT_V(2); PG8_BAR;
        PG8_STAGE(PG8_SB(1, 0), cB + kstep, voffB); PG8_STAGE(PG8_SA(1, 0), cA + kstep, voffA); PG8_STAGE(PG8_SB(1, 1), cB + hstep + kstep, voffB);
        PG8_WAIT_V(6); PG8_BAR;
    } else {
        PG8_STAGE(PG8_SB(0, 0), cB, voffB); PG8_STAGE(PG8_SA(0, 0), cA, voffA); PG8_STAGE(PG8_SB(0, 1), cB + hstep, voffB); PG8_STAGE(PG8_SA(0, 1), cA + hstep, voffA);
        if (wr == 1) PG8_BAR;
        PG8_WAIT_V(4); PG8_BAR;
        PG8_STAGE(PG8_SB(1, 0), cB + kstep, voffB); PG8_STAGE(PG8_SA(1, 0), cA + kstep, voffA); PG8_STAGE(PG8_SB(1, 1), cB + hstep + kstep, voffB);
        PG8_WAIT_V(6); PG8_BAR;
    }
    for (;;) {
        const bool has_next = S.next(ui + 1, nxt);
        const char* nA = has_next ? (const char*)g.A + (size_t)nxt.pm * tstep : cA; const char* nB = has_next ? (const char*)g.Bt + (size_t)nxt.pn * tstep : cB;
        for (int t = 0; t < nt; t += 2) {
            const bool last = (t == nt - 2);
            const char* a1 = cA + (size_t)(t + 1) * kstep;
            const char* a2 = last ? nA : cA + (size_t)(t + 2) * kstep; const char* b2 = last ? nB : cB + (size_t)(t + 2) * kstep;
            const char* a3 = a2 + kstep; const char* b3 = b2 + kstep;
            if constexpr (SP2) {
            PG8_LDB(B0, 0, 0); PG8_LDB(B1, 0, 1); PG8_SCHED; PG8_LDA(At, 0, 0); PG8_STAGE(PG8_SA(1, 1), a1 + hstep, voffA);
            PG8_WAIT_V(8); PG8_WAIT_L(0); PG8_BAR; PG8_MMA(0, 0, At, B0); PG8_MMA(0, 1, At, B1); PG8_BAR; PG8_SCHED;
            PG8_LDA(At, 0, 1); PG8_STAGE(PG8_SB(0, 0), b2, voffB); PG8_STAGE(PG8_SB(0, 1), b2 + hstep, voffB); PG8_STAGE(PG8_SA(0, 0), a2, voffA);
            PG8_WAIT_V(8); PG8_WAIT_L(0); PG8_BAR; PG8_MMA(1, 0, At, B0); PG8_MMA(1, 1, At, B1); PG8_BAR; PG8_SCHED;
            PG8_LDB(B0, 1, 0); PG8_LDB(B1, 1, 1); PG8_SCHED; PG8_LDA(At, 1, 0); PG8_STAGE(PG8_SA(0, 1), a2 + hstep, voffA);
            PG8_WAIT_V(8); PG8_WAIT_L(0); PG8_BAR; PG8_MMA(0, 0, At, B0); PG8_MMA(0, 1, At, B1); PG8_BAR; PG8_SCHED;
            PG8_LDA(At, 1, 1); PG8_STAGE(PG8_SB(1, 0), b3, voffB); PG8_STAGE(PG8_SB(1, 1), b3 + hstep, voffB); PG8_STAGE(PG8_SA(1, 0), a3, voffA);
            PG8_WAIT_V(8); PG8_WAIT_L(0); PG8_BAR; PG8_MMA(1, 0, At, B0); PG8_MMA(1, 1, At, B1); PG8_BAR; PG8_SCHED;
            } else {
            PG8_LDB(B0, 0, 0); PG8_SCHED; PG8_LDA(At, 0, 0); PG8_STAGE(PG8_SA(1, 1), a1 + hstep, voffA);
            PG8_WAIT_L(8); PG8_BAR; PG8_WAIT_L(0); PG8_MMA(0, 0, At, B0); PG8_BAR; PG8_SCHED;
            PG8_LDB(B1, 0, 1); PG8_STAGE(PG8_SB(0, 0), b2, voffB);
            PG8_BAR; PG8_WAIT_L(0); PG8_MMA(0, 1, At, B1); PG8_BAR;
            PG8_LDA(At, 0, 1); PG8_STAGE(PG8_SA(0, 0), a2, voffA);
            PG8_BAR; PG8_WAIT_L(0); PG8_MMA(1, 0, At, B0); PG8_BAR; PG8_SCHED;
            PG8_STAGE(PG8_SB(0, 1), b2 + hstep, voffB);
            PG8_WAIT_V(6); PG8_BAR; PG8_MMA(1, 1, At, B1); PG8_BAR;
            PG8_LDB(B0, 1, 0); PG8_SCHED; PG8_LDA(At, 1, 0); PG8_STAGE(PG8_SA(0, 1), a2 + hstep, voffA);
            PG8_WAIT_L(8); PG8_BAR; PG8_WAIT_L(0); PG8_MMA(0, 0, At, B0); PG8_BAR; PG8_SCHED;
            PG8_LDB(B1, 1, 1); PG8_STAGE(PG8_SB(1, 0), b3, voffB);
            PG8_BAR; PG8_WAIT_L(0); PG8_MMA(0, 1, At, B1); PG8_BAR;
            PG8_LDA(At, 1, 1); PG8_STAGE(PG8_SA(1, 0), a3, voffA);
            PG8_BAR; PG8_WAIT_L(0); PG8_MMA(1, 0, At, B0); PG8_BAR; PG8_SCHED;
            PG8_STAGE(PG8_SB(1, 1), b3 + hstep, voffB);
            PG8_WAIT_V(6); PG8_BAR; PG8_MMA(1, 1, At, B1); PG8_BAR;
            }
        }
        if constexpr (ALIGN_EPI) { if (wr == 0) PG8_BAR; }
        E(acc, cur, wr, wc, fr, fq);
        if (!has_next) break;
#pragma unroll
        for (int a = 0; a < 2; ++a)
#pragma unroll
            for (int b = 0; b < 2; ++b)
#pragma unroll
                for (int m = 0; m < 4; ++m)
#pragma unroll
                    for (int n = 0; n < 2; ++n) acc[a][b][m][n] = (f32x4){0.f, 0.f, 0.f, 0.f};
        cur = nxt; cA = nA; cB = nB; ++ui;
        if constexpr (ALIGN_EPI) { if (wr == 1) PG8_BAR; }
    }
    PG8_WAIT_V(0);
    if constexpr (!ALIGN_EPI) { if (wr == 0) PG8_BAR; }
    PG8_BAR;
#undef PG8_SA
#undef PG8_SB
#undef PG8_STAGE
#undef PG8_LDA
#undef PG8_LDB
#undef PG8_MMA
#undef PG8_WAIT_V
#undef PG8_WAIT_L
#undef PG8_BAR
#undef PG8_SCHED
}

template <class Epi, class Sched, bool F8 = false>
__device__ __forceinline__ void gemm_phase_gather(LAS unsigned char* lds, const Gemm g, const int* list, const Sched& S, const Epi& E, const int tid) {
    const int wid = __builtin_amdgcn_readfirstlane(tid >> 6), lane = tid & 63, wr = wid >> 2, wc = wid & 3, fr = lane & 15, fq = lane >> 4;
    const int K = g.K, nt = K / BK;
    unsigned voffB0, cA2;
    { int R, C; stage_rc(tid * 16, R, C); const int Rb = Epi::PERM ? ((R & ~31) + perm32(R & 31)) : R; cA2 = (unsigned)C * 2u; voffB0 = (unsigned)(Rb * K + C) * 2u; }
    const unsigned voffB[2] = {voffB0, voffB0 + (unsigned)(64 * K * 2)};
    const size_t kstep = (size_t)(BK * 2);
    const size_t hstep = (size_t)HALF * K * 2;
    const size_t tstep = 2 * hstep;
    const unsigned ldsw = (unsigned)wid * 1024u;
    const int aoff = lds_byte(wr * 64 + fr, fq * 8), boff = lds_byte(wc * 32 + fr, fq * 8);
#define PG8_SA(b, h) (((b) * 2 + (h)) * HTB)
#define PG8_SB(b, h) ((4 + (b) * 2 + (h)) * HTB)
#define PG8_STAGE(bufoff, gbase, voff) do { _Pragma("unroll") for (int _i = 0; _i < 2; ++_i) \
        __builtin_amdgcn_global_load_lds((const unsigned*)((const char*)(gbase) + (voff)[_i]), (LAS unsigned*)(lds + (bufoff) + ldsw + _i * 8192), 16, 0, 0); } while (0)
#define PG8_LDA(dst, b, h) do { _Pragma("unroll") for (int m = 0; m < 4; ++m) { if constexpr (F8) dst##8[m] = cat8(*(const LAS bf16x8*)(lds + PG8_SA(b, h) + aoff + m * 2048), *(const LAS bf16x8*)(lds + PG8_SA(b, h) + aoff + m * 2048 + 1024)); \
        else { _Pragma("unroll") for (int k = 0; k < 2; ++k) dst[m][k] = *(const LAS bf16x8*)(lds + PG8_SA(b, h) + aoff + m * 2048 + k * 1024); } } } while (0)
#define PG8_LDB(dst, b, h) do { _Pragma("unroll") for (int n = 0; n < 2; ++n) { if constexpr (F8) dst##8[n] = cat8(*(const LAS bf16x8*)(lds + PG8_SB(b, h) + boff + n * 2048), *(const LAS bf16x8*)(lds + PG8_SB(b, h) + boff + n * 2048 + 1024)); \
        else { _Pragma("unroll") for (int k = 0; k < 2; ++k) dst[n][k] = *(const LAS bf16x8*)(lds + PG8_SB(b, h) + boff + n * 2048 + k * 1024); } } } while (0)
#define PG8_MMA(ai, bj, At, Bt) do { __builtin_amdgcn_s_setprio(1); \
        if constexpr (F8) { _Pragma("unroll") for (int m = 0; m < 4; ++m) _Pragma("unroll") for (int n = 0; n < 2; ++n) \
            acc[ai][bj][m][n] = __builtin_amdgcn_mfma_scale_f32_16x16x128_f8f6f4(Bt##8[n], At##8[m], acc[ai][bj][m][n], 0, 0, 0, 0x7f7f7f7f, 0, 0x7f7f7f7f); \
            asm volatile("" : "+v"(acc[ai][bj][0][0]), "+v"(acc[ai][bj][0][1]), "+v"(acc[ai][bj][1][0]), "+v"(acc[ai][bj][1][1]), "+v"(acc[ai][bj][2][0]), "+v"(acc[ai][bj][2][1]), "+v"(acc[ai][bj][3][0]), "+v"(acc[ai][bj][3][1])); } \
        else { _Pragma("unroll") for (int m = 0; m < 4; ++m) _Pragma("unroll") for (int n = 0; n < 2; ++n) _Pragma("unroll") for (int k = 0; k < 2; ++k) \
            acc[ai][bj][m][n] = __builtin_amdgcn_mfma_f32_16x16x32_bf16(Bt[n][k], At[m][k], acc[ai][bj][m][n], 0, 0, 0); } \
        __builtin_amdgcn_s_setprio(0); } while (0)
#define PG8_WAIT_V(n) asm volatile("s_waitcnt vmcnt(" #n ")" ::: "memory")
#define PG8_WAIT_L(n) asm volatile("s_waitcnt lgkmcnt(" #n ")" ::: "memory")
#define PG8_BAR __builtin_amdgcn_s_barrier()
#define PG8_SCHED __builtin_amdgcn_sched_barrier(0)
#define PG8_LOADTOK(u, vo) do { int _ra0, _ra1, _c; stage_rc(tid * 16, _ra0, _c); stage_rc(tid * 16 + 8192, _ra1, _c); _Pragma("unroll") for (int _h = 0; _h < 2; ++_h) { const int _r0 = _h * HALF + _ra0, _r1 = _h * HALF + _ra1; \
        const unsigned _t0 = (_r0 < (u).nvalid) ? (unsigned)list[(u).lbase + _r0] : 0u, _t1 = (_r1 < (u).nvalid) ? (unsigned)list[(u).lbase + _r1] : 0u; (vo)[_h] = _t0 | (_t1 << 16); } } while (0)
#define PG8_STAGE_A(bufoff, gbase, pk) do { _Pragma("unroll") for (int _i = 0; _i < 2; ++_i) { const unsigned _off = (((pk) >> (16 * _i)) & 0xffffu) * (unsigned)(K * 2) + cA2; \
        __builtin_amdgcn_global_load_lds((const unsigned*)((const char*)(gbase) + _off), (LAS unsigned*)(lds + (bufoff) + ldsw + _i * 8192), 16, 0, 0); } } while (0)
    Unit cur, nxt; int ui = 0;
    if (!S.next(0, cur)) return;
    f32x4 acc[2][2][4][2];
#pragma unroll
    for (int a = 0; a < 2; ++a)
#pragma unroll
        for (int b = 0; b < 2; ++b)
#pragma unroll
            for (int m = 0; m < 4; ++m)
#pragma unroll
                for (int n = 0; n < 2; ++n) acc[a][b][m][n] = (f32x4){0.f, 0.f, 0.f, 0.f};
    bf16x8 At[4][2], B0[2][2], B1[2][2]; i32x8 At8[4], B08[2], B18[2];
    unsigned vc[2], vn[2];
    PG8_LOADTOK(cur, vc);
    const char* gA = (const char*)g.A; const char* cB = (const char*)g.Bt + (size_t)cur.pn * tstep;
    PG8_STAGE(PG8_SB(0, 0), cB, voffB); PG8_STAGE(PG8_SB(0, 1), cB + hstep, voffB); PG8_STAGE_A(PG8_SA(0, 0), gA, vc[0]); PG8_STAGE_A(PG8_SA(0, 1), gA, vc[1]);
    if (wr == 1) PG8_BAR;
    PG8_WAIT_V(2); PG8_BAR;
    PG8_STAGE(PG8_SB(1, 0), cB + kstep, voffB); PG8_STAGE_A(PG8_SA(1, 0), gA + kstep, vc[0]); PG8_STAGE(PG8_SB(1, 1), cB + hstep + kstep, voffB);
    PG8_WAIT_V(6); PG8_BAR;
    for (;;) {
        const bool has_next = S.next(ui + 1, nxt);
        if (has_next) { PG8_LOADTOK(nxt, vn); }
        const char* nB = has_next ? (const char*)g.Bt + (size_t)nxt.pn * tstep : cB;
        for (int t = 0; t < nt; t += 2) {
            const bool last = (t == nt - 2);
            const char* a1 = gA + (size_t)(t + 1) * kstep;
            const char* b2 = last ? nB : cB + (size_t)(t + 2) * kstep; const char* b3 = b2 + kstep;
            const char* a2 = last ? gA : gA + (size_t)(t + 2) * kstep; const char* a3 = a2 + kstep;
            PG8_LDB(B0, 0, 0); PG8_LDB(B1, 0, 1); PG8_SCHED; PG8_LDA(At, 0, 0); PG8_STAGE_A(PG8_SA(1, 1), a1, vc[1]);
            if (last && has_next) {
                vc[0] = vn[0]; vc[1] = vn[1]; }
            PG8_WAIT_V(8); PG8_WAIT_L(0); PG8_BAR; PG8_MMA(0, 0, At, B0); PG8_MMA(0, 1, At, B1); PG8_BAR; PG8_SCHED;
            PG8_LDA(At, 0, 1); PG8_STAGE(PG8_SB(0, 0), b2, voffB); PG8_STAGE(PG8_SB(0, 1), b2 + hstep, voffB); PG8_STAGE_A(PG8_SA(0, 0), a2, vc[0]);
            PG8_WAIT_V(8); PG8_WAIT_L(0); PG8_BAR; PG8_MMA(1, 0, At, B0); PG8_MMA(1, 1, At, B1); PG8_BAR; PG8_SCHED;
            PG8_LDB(B0, 1, 0); PG8_LDB(B1, 1, 1); PG8_SCHED; PG8_LDA(At, 1, 0); PG8_STAGE_A(PG8_SA(0, 1), a2, vc[1]);
            PG8_WAIT_V(8); PG8_WAIT_L(0); PG8_BAR; PG8_MMA(0, 0, At, B0); PG8_MMA(0, 1, At, B1); PG8_BAR; PG8_SCHED;
            PG8_LDA(At, 1, 1); PG8_STAGE(PG8_SB(1, 0), b3, voffB); PG8_STAGE(PG8_SB(1, 1), b3 + hstep, voffB); PG8_STAGE_A(PG8_SA(1, 0), a3, vc[0]);
            PG8_WAIT_V(8); PG8_WAIT_L(0); PG8_BAR; PG8_MMA(1, 0, At, B0); PG8_MMA(1, 1, At, B1); PG8_BAR; PG8_SCHED;
        }
        if (wr == 0) PG8_BAR;
        E(acc, cur, wr, wc, fr, fq);
        if (!has_next) break;
#pragma unroll
        for (int a = 0; a < 2; ++a)
#pragma unroll
            for (int b = 0; b < 2; ++b)
#pragma unroll
                for (int m = 0; m < 4; ++m)
#pragma unroll
                    for (int n = 0; n < 2; ++n) acc[a][b][m][n] = (f32x4){0.f, 0.f, 0.f, 0.f};
        cur = nxt; cB = nB; ++ui;
        if (wr == 1) PG8_BAR;
    }
    PG8_WAIT_V(0);
    PG8_BAR;
#undef PG8_SA
#undef PG8_SB
#undef PG8_STAGE
#undef PG8_LDA
#undef PG8_LDB
#undef PG8_MMA
#undef PG8_WAIT_V
#undef PG8_WAIT_L
#undef PG8_BAR
#undef PG8_SCHED
#undef PG8_STAGE_A
#undef PG8_LOADTOK
}
}

struct Params {
    const float* in[26];
    float* out;
    unsigned char* ws;
};
struct Frame {
    LAS unsigned char* lds;
    int tid, lane, wave, G, bid;
};

template <int MT, int NT>
__device__ __forceinline__ void mma_nt(f32x4 (&acc)[MT][NT], const LAS bf16_t* A, int lda, const LAS bf16_t* B, int ldb, int K, int fr, int fq) {
    for (int k0 = 0; k0 < K; k0 += 32) {
        bf16x8 a[MT], b[NT];
#pragma unroll
        for (int m = 0; m < MT; ++m) a[m] = *(const LAS bf16x8*)(A + (m * 16 + fr) * lda + k0 + fq * 8);
#pragma unroll
        for (int n = 0; n < NT; ++n) b[n] = *(const LAS bf16x8*)(B + (n * 16 + fr) * ldb + k0 + fq * 8);
#pragma unroll
        for (int m = 0; m < MT; ++m)
#pragma unroll
            for (int n = 0; n < NT; ++n) acc[m][n] = __builtin_amdgcn_mfma_f32_16x16x32_bf16(a[m], b[n], acc[m][n], 0, 0, 0);
    }
}
template <int MT, int NT> __device__ __forceinline__ void zero_acc(f32x4 (&acc)[MT][NT]) {
#pragma unroll
    for (int m = 0; m < MT; ++m)
#pragma unroll
        for (int n = 0; n < NT; ++n) acc[m][n] = (f32x4){0.f, 0.f, 0.f, 0.f};
}

constexpr int SK_A = 0, SK_B = 69632;
template <class Epi>
__device__ __forceinline__ void skinny_unit(const Frame& F, const bf16_t* A, const bf16_t* Bt, const Epi& E) {
    LAS bf16_t* As = (LAS bf16_t*)(F.lds + SK_A); LAS bf16_t* Bs = (LAS bf16_t*)(F.lds + SK_B);
    const int tid = F.tid, fr = F.lane & 15, fq = F.lane >> 4, w = F.wave;
    f32x4 acc[2][2]; zero_acc<2, 2>(acc);
    u32x4 av[8], bv;
#pragma unroll
    for (int i = 0; i < 8; ++i) { const int ch = tid + NTHREADS * i, r = ch >> 4, c8 = (ch & 15) * 8; av[i] = *(const u32x4*)(A + (size_t)r * D + c8); }
    { const int r = tid >> 4, c8 = (tid & 15) * 8; bv = *(const u32x4*)(Bt + (size_t)r * D + c8); }
    for (int kc = 0; kc < 8; ++kc) {
        __syncthreads();
#pragma unroll
        for (int i = 0; i < 8; ++i) { const int ch = tid + NTHREADS * i, r = ch >> 4, c8 = (ch & 15) * 8; *(LAS u32x4*)(As + r * 136 + c8) = av[i]; }
        { const int r = tid >> 4, c8 = (tid & 15) * 8; *(LAS u32x4*)(Bs + r * 136 + c8) = bv; }
        if (kc + 1 < 8) {
#pragma unroll
            for (int i = 0; i < 8; ++i) { const int ch = tid + NTHREADS * i, r = ch >> 4, c8 = (ch & 15) * 8; av[i] = *(const u32x4*)(A + (size_t)r * D + (kc + 1) * 128 + c8); }
            { const int r = tid >> 4, c8 = (tid & 15) * 8; bv = *(const u32x4*)(Bt + (size_t)r * D + (kc + 1) * 128 + c8); } }
        __syncthreads();
        mma_nt<2, 2>(acc, As + (32 * w) * 136, 136, Bs, 136, 128, fr, fq);
    }
#pragma unroll
    for (int mt = 0; mt < 2; ++mt)
#pragma unroll
        for (int nt = 0; nt < 2; ++nt)
#pragma unroll
            for (int j = 0; j < 4; ++j) E(32 * w + mt * 16 + fq * 4 + j, nt * 16 + fr, acc[mt][nt][j]);
    __syncthreads();
}
struct SkEpiBf16 { bf16_t* O; int ldc; __device__ __forceinline__ void operator()(int r, int c, float v) const { O[(size_t)r * ldc + c] = (bf16_t)f2bf(v); } };
struct SkEpiResid { float* X; const float* Xs; const float* gate; __device__ __forceinline__ void operator()(int r, int c, float v) const { X[(size_t)r * D + c] = Xs[(size_t)r * D + c] + gate[c] * v; } };

__device__ __forceinline__ void p0_transpose_item(const float* W, int K, int N, bf16_t* WT, int k0, int n0, int orow0, LAS float* scr, int lane) {
    float tv[32];
#pragma unroll
    for (int i = 0; i < 32; ++i) { const int kk = 2 * i + (lane >> 5); tv[i] = W[(size_t)(k0 + kk) * N + n0 + (lane & 31)]; }
#pragma unroll
    for (int i = 0; i < 32; ++i) { const int kk = 2 * i + (lane >> 5); scr[kk * 33 + (lane & 31)] = tv[i]; }
    asm volatile("s_waitcnt lgkmcnt(0)" ::: "memory");
    const int c = lane & 7;
#pragma unroll
    for (int j = 0; j < 4; ++j) { const int n = (lane >> 3) + 8 * j; const LAS float* s = scr + (8 * c) * 33 + n;
        u32x4 o; o.x = pk2(s[0 * 33], s[1 * 33]); o.y = pk2(s[2 * 33], s[3 * 33]); o.z = pk2(s[4 * 33], s[5 * 33]); o.w = pk2(s[6 * 33], s[7 * 33]);
        *(u32x4*)(WT + (size_t)(orow0 + n) * K + k0 + 8 * c) = o; }
    asm volatile("s_waitcnt lgkmcnt(0)" ::: "memory");
}

using pg8::pk4_fp8;
__device__ __forceinline__ void p0_transpose_item8(const float* W, int K, int N, unsigned char* WT8, int k0, int n0, int orow0, LAS float* scr, int lane) {
    float tv[32];
#pragma unroll
    for (int i = 0; i < 32; ++i) { const int kk = 2 * i + (lane >> 5); tv[i] = W[(size_t)(k0 + kk) * N + n0 + (lane & 31)]; }
#pragma unroll
    for (int i = 0; i < 32; ++i) { const int kk = 2 * i + (lane >> 5); scr[kk * 33 + (lane & 31)] = tv[i]; }
    asm volatile("s_waitcnt lgkmcnt(0)" ::: "memory");
    const int c = lane & 3;
#pragma unroll
    for (int j = 0; j < 2; ++j) { const int n = (lane >> 2) + 16 * j; const LAS float* sp = scr + (16 * c) * 33 + n;
        u32x4 o; o.x = pk4_fp8(64.f * sp[0 * 33], 64.f * sp[1 * 33], 64.f * sp[2 * 33], 64.f * sp[3 * 33]); o.y = pk4_fp8(64.f * sp[4 * 33], 64.f * sp[5 * 33], 64.f * sp[6 * 33], 64.f * sp[7 * 33]);
        o.z = pk4_fp8(64.f * sp[8 * 33], 64.f * sp[9 * 33], 64.f * sp[10 * 33], 64.f * sp[11 * 33]); o.w = pk4_fp8(64.f * sp[12 * 33], 64.f * sp[13 * 33], 64.f * sp[14 * 33], 64.f * sp[15 * 33]);
        *(u32x4*)(WT8 + (size_t)(orow0 + n) * K + k0 + 16 * c) = o; }
    asm volatile("s_waitcnt lgkmcnt(0)" ::: "memory");
}

constexpr int WT_I_IN = 16 * 73, WT_I_OUT = 16 * 32, WT_I_GU = 16 * 64, WT_I_DN = 16 * 32;
constexpr int WT_PER_LAYER = WT_I_IN + WT_I_OUT + NE * WT_I_GU + NE * WT_I_DN;
constexpr int WT_DEF0_LO = WT_PER_LAYER + WT_I_IN + WT_I_OUT + NE * WT_I_GU, WT_DEF0_HI = 2 * WT_PER_LAYER;
constexpr int WT_DEF1_LO = WT_PER_LAYER + WT_I_IN + WT_I_OUT, WT_DEF1_HI = WT_DEF1_LO + 16 * WT_I_GU;
__device__ __forceinline__ void weight_item(const Params& P, int it, LAS float* scr, int lane) {
    unsigned char* ws = P.ws;
    const int l = it / WT_PER_LAYER; int r = it % WT_PER_LAYER;
    if (r < WT_I_IN) { const int kb = r / 73, nb = r % 73;
        if (nb == 56) p0_transpose_item(P.in[8] + (size_t)l * D * INW, D, INW, (bf16_t*)(ws + WS_WGT) + (size_t)l * 32 * D, 64 * kb, 32 * nb, 0, scr, lane);
        else p0_transpose_item(P.in[8] + (size_t)l * D * INW, D, INW, (bf16_t*)(ws + WS_WIN) + (size_t)l * INP * D, 64 * kb, 32 * nb, nb < 56 ? 32 * nb : 32 * (nb - 1), scr, lane);
        return; }
    r -= WT_I_IN;
    if (r < WT_I_OUT) { const int kb = r / 32, nb = r % 32;
        p0_transpose_item(P.in[18] + (size_t)l * D * D, D, D, (bf16_t*)(ws + WS_WOUT) + (size_t)l * D * D, 64 * kb, 32 * nb, 32 * nb, scr, lane); return; }
    r -= WT_I_OUT;
    if (r < NE * WT_I_GU) { const int e = r / WT_I_GU, q = r % WT_I_GU, kb = q / 64, nb = q % 64; const int n0 = 32 * nb;
        const int j = n0 & 1023, orow = 256 * (j >> 7) + (n0 >= 1024 ? 128 : 0) + (j & 127);
        if (F8_LAYER[l]) p0_transpose_item8(P.in[21] + ((size_t)l * NE + e) * D * 2048, D, 2048, ws + WS_WGU + (size_t)l * NE * 2048 * D * 2 + (size_t)e * 2048 * D, 64 * kb, n0, orow, scr, lane);
        else p0_transpose_item(P.in[21] + ((size_t)l * NE + e) * D * 2048, D, 2048, (bf16_t*)(ws + WS_WGU) + ((size_t)l * NE + e) * 2048 * D, 64 * kb, n0, orow, scr, lane);
        return; }
    r -= NE * WT_I_GU;
    { const int e = r / WT_I_DN, q = r % WT_I_DN, kb = q / 32, nb = q % 32;
        if (F8_LAYER[l]) p0_transpose_item8(P.in[23] + ((size_t)l * NE + e) * DFF * D, DFF, D, ws + WS_WDN + (size_t)l * NE * D * DFF * 2 + (size_t)e * D * DFF, 64 * kb, 32 * nb, 32 * nb, scr, lane);
        else p0_transpose_item(P.in[23] + ((size_t)l * NE + e) * DFF * D, DFF, D, (bf16_t*)(ws + WS_WDN) + ((size_t)l * NE + e) * D * DFF, 64 * kb, 32 * nb, 32 * nb, scr, lane); }
}

constexpr int WT_EXP_ITEMS = NE * WT_I_GU + NE * WT_I_DN;
constexpr int GL_WT8 = 115200;
struct WtSrc { const float* W; int N, k0, n0; unsigned char* dst; };
__device__ __forceinline__ WtSrc wt_decode(const Params& P, int l, int q) {
    unsigned char* ws = P.ws; WtSrc r;
    if (q < NE * WT_I_GU) { const int e = q / WT_I_GU, t = q % WT_I_GU, kb = t / 64, nb = t % 64; const int n0 = 32 * nb; const int j = n0 & 1023, orow = 256 * (j >> 7) + (n0 >= 1024 ? 128 : 0) + (j & 127);
        r.W = P.in[21] + ((size_t)l * NE + e) * D * 2048; r.N = 2048; r.k0 = 64 * kb; r.n0 = n0; r.dst = ws + WS_WGU + (size_t)l * NE * 2048 * D * 2 + ((size_t)e * 2048 + orow) * D + 64 * kb; }
    else { const int q2 = q - NE * WT_I_GU; const int e = q2 / WT_I_DN, t = q2 % WT_I_DN, kb = t / 32, nb = t % 32;
        r.W = P.in[23] + ((size_t)l * NE + e) * DFF * D; r.N = D; r.k0 = 64 * kb; r.n0 = 32 * nb; r.dst = ws + WS_WDN + (size_t)l * NE * D * DFF * 2 + ((size_t)e * D + 32 * nb) * DFF + 64 * kb; }
    return r;
}
__device__ __forceinline__ void wt_issue(const WtSrc& r, int lane, float (&tv)[32]) {
#pragma unroll
    for (int i = 0; i < 16; ++i) { const int kk = 4 * i + 2 * (lane >> 5); tv[2 * i] = r.W[(size_t)(r.k0 + kk) * r.N + r.n0 + (lane & 31)]; tv[2 * i + 1] = r.W[(size_t)(r.k0 + kk + 1) * r.N + r.n0 + (lane & 31)]; }
}
__device__ __forceinline__ void wt_finish(const WtSrc& r, int lane, const float (&tv)[32], LAS unsigned char* scr8) {
    const int n = lane & 31;
#pragma unroll
    for (int i = 0; i < 16; ++i) { const int kk = 4 * i + 2 * (lane >> 5); const unsigned b = __builtin_amdgcn_cvt_pk_fp8_f32(64.f * tv[2 * i], 64.f * tv[2 * i + 1], 0u, false);
        *(LAS unsigned short*)(scr8 + n * 68 + kk) = (unsigned short)(b & 0xffffu); }
    asm volatile("s_waitcnt lgkmcnt(0)" ::: "memory");
#pragma unroll
    for (int c2 = 0; c2 < 2; ++c2) { const int c = lane + 64 * c2, nn = c >> 2, k16 = (c & 3) * 16; const LAS unsigned* sp = (const LAS unsigned*)(scr8 + nn * 68 + k16);
        u32x4 o; o.x = sp[0]; o.y = sp[1]; o.z = sp[2]; o.w = sp[3];
        *(u32x4*)(r.dst + (size_t)nn * 1024 + k16) = o; }
    asm volatile("s_waitcnt lgkmcnt(0)" ::: "memory");
}

__device__ __forceinline__ void phase_prologue(const Frame& F, const Params& P) {
    unsigned char* ws = P.ws;
    LAS float* scr = (LAS float*)(F.lds + F.wave * 16384);
    const int gw = F.bid * NWAVES + F.wave, NGW = F.G * NWAVES;
    for (int it = gw; it < DEPTH * (WT_I_IN + WT_I_OUT); it += NGW) { const int l = it / (WT_I_IN + WT_I_OUT), r = it % (WT_I_IN + WT_I_OUT); weight_item(P, l * WT_PER_LAYER + r, scr, F.lane); }
    {
        const int gt = F.bid * NTHREADS + F.tid, NGT = F.G * NTHREADS;
        bf16_t* cm3 = (bf16_t*)(ws + WS_CM3);
        for (int i = gt; i < 192 * 64; i += NGT) { const int m = i >> 6, n2 = i & 63, part = m >> 6, k2 = m & 63; const int ph = (k2 * n2) & 63;
            float s, c; sincospif((float)ph * (1.0f / 32.0f), &s, &c); const float v = part == 0 ? c : (part == 1 ? -s : -c); cm3[i] = (bf16_t)f2bf(v); }
        bf16_t* rwt = (bf16_t*)(ws + WS_RW);
        for (int i = gt; i < DEPTH * NE * D; i += NGT) { const int l = i / (NE * D), q = i % (NE * D), k = q >> 5, e = q & 31;
            const float w = P.in[19][(size_t)l * D * NE + q]; const unsigned hi = f2bf(w); const unsigned lo = f2bf(w - bf2f(hi));
            rwt[((size_t)l * 2 + 0) * NE * D + e * D + k] = (bf16_t)hi; rwt[((size_t)l * 2 + 1) * NE * D + e * D + k] = (bf16_t)lo; }
        bf16_t* tf2 = (bf16_t*)(ws + WS_TF2);
        for (int i = gt; i < 128 * 128; i += NGT) { const int c_ = i >> 7, n = i & 127; const int ph = (c_ * n) & 127;
            float s, c; sincospif((float)ph * (1.0f / 64.0f), &s, &c); tf2[i] = (bf16_t)f2bf(c); tf2[128 * 128 + i] = (bf16_t)f2bf(s); }
        bf16_t* tctx = (bf16_t*)(ws + WS_TCTX);
        for (int i = gt; i < 256 * 256; i += NGT) { const int k1 = i >> 8, n = i & 255; const int ph = (k1 * n) & 255;
            float s, c; sincospif((float)ph * (1.0f / 128.0f), &s, &c); tctx[i] = (bf16_t)f2bf(c); tctx[256 * 256 + i] = (bf16_t)f2bf(s); }
        bf16_t* tlat = (bf16_t*)(ws + WS_TLAT);
        for (int i = gt; i < 128 * 128 * 128; i += NGT) { const int nlo = i >> 14, d = (i >> 7) & 127, a = i & 127; const int ph = (d * (nlo + 128 * a)) & 16383;
            float s, c; sincospif((float)ph * (1.0f / 8192.0f), &s, &c);
            tlat[(size_t)nlo * 32768 + d * 128 + a] = (bf16_t)f2bf(c); tlat[(size_t)nlo * 32768 + 16384 + d * 128 + a] = (bf16_t)f2bf(s); }
    }
    for (int it = gw; it < DEPTH * 24 * 8; it += NGW) {
        const int l = it / 192, q = it % 192, cb = q >> 3, ks = q & 7;
        const float* wm = P.in[6] + (size_t)l * D * 6144 + (size_t)(ks * 128) * 6144 + cb * 256 + 4 * F.lane;
        f32x4 a0 = {0.f, 0.f, 0.f, 0.f}, a1 = a0, a2 = a0;
#pragma unroll 4
        for (int k = 0; k < 128; ++k) { const int kk = ks * 128 + k;
            const float c0 = P.in[1][kk], c1 = P.in[1][D + kk], c2 = P.in[3][kk];
            const float s0 = c0 * sigmoidf_(c0), s1 = c1 * sigmoidf_(c1), s2 = c2 * sigmoidf_(c2);
            const f32x4 w = *(const f32x4*)(wm + (size_t)k * 6144);
            a0 += w * s0; a1 += w * s1; a2 += w * s2; }
        float* mp = (float*)(ws + WS_MODP) + ((size_t)(l * 8 + ks) * 3) * 6144 + cb * 256 + 4 * F.lane;
        *(f32x4*)(mp) = a0; *(f32x4*)(mp + 6144) = a1; *(f32x4*)(mp + 2 * 6144) = a2;
    }
}

__device__ __forceinline__ f32x4 mod_from_partials(const Params& P, int l, int v, int c4) {
    f32x4 s = *(const f32x4*)(P.in[7] + (size_t)l * 6144 + c4);
    const float* mp = (const float*)(P.ws + WS_MODP) + ((size_t)(l * 8) * 3 + v) * 6144 + c4;
#pragma unroll
    for (int ks = 0; ks < 8; ++ks) s += *(const f32x4*)(mp + (size_t)ks * 3 * 6144);
    return s;
}

__device__ __forceinline__ void norm_row_store(const f32x4 (&x)[4], const float* g, const f32x4 (&shv)[4], const f32x4 (&scv)[4], bf16_t* orow, int lane) {
    float ss = 0.f;
#pragma unroll
    for (int j = 0; j < 4; ++j) ss += (x[j].x * x[j].x + x[j].y * x[j].y) + (x[j].z * x[j].z + x[j].w * x[j].w);
    const float rstd = 1.0f / sqrtf(wave_sum(ss) * (1.0f / D) + NORM_EPS);
#pragma unroll
    for (int j = 0; j < 4; ++j) { const int c = 4 * lane + 256 * j;
        const f32x4 gv = *(const f32x4*)(g + c);
        const f32x4 y = (x[j] * rstd) * gv * (scv[j] + 1.0f) + shv[j];
        u32x2 o; o.x = pk2(y.x, y.y); o.y = pk2(y.z, y.w);
        *(u32x2*)(orow + c) = o; }
}

__device__ __forceinline__ void phase_p1(const Frame& F, const Params& P) {
    unsigned char* ws = P.ws;
    const int gt = F.bid * NTHREADS + F.tid, NGT = F.G * NTHREADS;
    float* modf = (float*)(ws + WS_MODF);
    for (int i = gt; i < DEPTH * 3 * 1536; i += NGT) { const int l = i / 4608, q = i % 4608, v = q / 1536, c4 = (q % 1536) * 4;
        *(f32x4*)(modf + ((size_t)l * 3 + v) * 6144 + c4) = mod_from_partials(P, l, v, c4); }
    const int gw = F.bid * NWAVES + F.wave, NGW = F.G * NWAVES;
    bf16_t* hb = (bf16_t*)(ws + WS_HBUF);
    int cur_v = -1; f32x4 shv[4], scv[4], xn[4];
    auto rowp = [&](int m) { return (m < NLAT) ? (P.in[0] + (size_t)m * D) : (P.in[2] + (size_t)(m - NLAT) * D); };
    if (gw < NTOK) {
#pragma unroll
        for (int j = 0; j < 4; ++j) xn[j] = *(const f32x4*)(rowp(gw) + 4 * F.lane + 256 * j); }
    for (int m = gw; m < NTOK; m += NGW) {
        const int v = (m >= NLAT) ? 2 : (m >= SEQ ? 1 : 0);
        f32x4 x[4];
#pragma unroll
        for (int j = 0; j < 4; ++j) x[j] = xn[j];
        if (m + NGW < NTOK) {
#pragma unroll
            for (int j = 0; j < 4; ++j) xn[j] = *(const f32x4*)(rowp(m + NGW) + 4 * F.lane + 256 * j); }
        if (v != cur_v) { cur_v = v;
#pragma unroll
            for (int j = 0; j < 4; ++j) { const int c = 4 * F.lane + 256 * j; shv[j] = mod_from_partials(P, 0, v, c); scv[j] = mod_from_partials(P, 0, v, 1024 + c); } }
        norm_row_store(x, P.in[4], shv, scv, hb + (size_t)m * D, F.lane);
    }
}

constexpr int GL_GT = 0;
constexpr int GL_A1 = 34816, GL_KE = 60416, GL_VTB = 78848, GL_RS = 97280, GL_RT = 97792;
constexpr int GL_KDT = 34816, GL_VT = 53248;

__device__ __forceinline__ float logsigmoidf_(float x) { return fminf(x, 0.f) - __logf(1.0f + __expf(-fabsf(x))); }
__device__ __forceinline__ float bfel(const u32x4& v, int j) { const unsigned w = (j < 2) ? v.x : (j < 4 ? v.y : (j < 6 ? v.z : v.w)); return (j & 1) ? bfhi(w) : bflo(w); }
__device__ __forceinline__ unsigned short bfraw(const u32x4& v, int j) { const unsigned w = (j < 2) ? v.x : (j < 4 ? v.y : (j < 6 ? v.z : v.w)); return (unsigned short)((j & 1) ? (w >> 16) : (w & 0xffffu)); }

struct GateRegs { bf16x8 a[4]; bf16x8 b; float bg; };
__device__ __forceinline__ GateRegs gla_load_gate_regs(const Frame& F, const Params& P, int l, int row0, int h) {
    GateRegs g;
    const int dir = F.wave >> 2, dbase = (F.wave & 3) * 16, fr = F.lane & 15, fq = F.lane >> 4;
    const bf16x8 z8 = {0, 0, 0, 0, 0, 0, 0, 0};
    const bf16_t* lrb = (const bf16_t*)(P.ws + WS_LRB);
#pragma unroll
    for (int mt = 0; mt < 4; ++mt) g.a[mt] = (fq < 2) ? *(const bf16x8*)(lrb + (size_t)(row0 + mt * 16 + fr) * 32 + dir * 16 + fq * 8) : z8;
    const float* wgp = (dir ? P.in[11] : P.in[9]) + (size_t)l * 16 * 256 + 64 * h + dbase + fr;
    g.b = z8;
    if (fq < 2) {
#pragma unroll
        for (int j = 0; j < 8; ++j) g.b[j] = (short)f2bf(wgp[(fq * 8 + j) * 256]); }
    g.bg = (dir ? P.in[12] : P.in[10])[(size_t)l * 256 + 64 * h + dbase + fr];
    return g;
}
__device__ __forceinline__ void gla_gates(const Frame& F, const GateRegs& gr) {
    LAS float* GT = (LAS float*)(F.lds + GL_GT);
    const int dir = F.wave >> 2, dbase = (F.wave & 3) * 16, lane = F.lane, fr = lane & 15, fq = lane >> 4;
    float p[4][4]; float T[4];
#pragma unroll
    for (int mt = 0; mt < 4; ++mt) { const f32x4 acc = __builtin_amdgcn_mfma_f32_16x16x32_bf16(gr.a[mt], gr.b, (f32x4){0.f, 0.f, 0.f, 0.f}, 0, 0, 0);
#pragma unroll
        for (int j = 0; j < 4; ++j) p[mt][j] = logsigmoidf_(acc[j] + gr.bg) * (1.0f / 16.0f); }
    if (dir == 0) {
#pragma unroll
        for (int mt = 0; mt < 4; ++mt) { p[mt][1] += p[mt][0]; p[mt][2] += p[mt][1]; p[mt][3] += p[mt][2]; T[mt] = p[mt][3]; }
        float base = 0.f;
#pragma unroll
        for (int mt = 0; mt < 4; ++mt) { float inc = T[mt]; float v = __shfl_up(inc, 16); inc += (fq >= 1) ? v : 0.f; v = __shfl_up(inc, 32); inc += (fq >= 2) ? v : 0.f;
            const float off = base + (inc - T[mt]); const float ct = __shfl(inc, 48 + fr);
#pragma unroll
            for (int j = 0; j < 4; ++j) GT[(dbase + fr) * 65 + mt * 16 + fq * 4 + j] = off + p[mt][j];
            base += ct; }
    } else {
#pragma unroll
        for (int mt = 0; mt < 4; ++mt) { p[mt][2] += p[mt][3]; p[mt][1] += p[mt][2]; p[mt][0] += p[mt][1]; T[mt] = p[mt][0]; }
        float base = 0.f;
#pragma unroll
        for (int mt = 3; mt >= 0; --mt) { float inc = T[mt]; float v = __shfl_down(inc, 16); inc += (fq <= 2) ? v : 0.f; v = __shfl_down(inc, 32); inc += (fq <= 1) ? v : 0.f;
            const float off = base + (inc - T[mt]); const float ct = __shfl(inc, fr);
#pragma unroll
            for (int j = 0; j < 4; ++j) GT[(64 + dbase + fr) * 65 + mt * 16 + fq * 4 + j] = off + p[mt][j];
            base += ct; }
    }
}

__device__ __forceinline__ void gla_g1_unit(const Frame& F, const Params& P, int l, int row0, int h, int unit) {
    const bf16_t* pb = (const bf16_t*)(P.ws + WS_PBUF);
    const int tid = F.tid, row = F.lane, c8 = F.wave * 8;
    const GateRegs gr = gla_load_gate_regs(F, P, l, row0, h);
    const u32x4 kv = *(const u32x4*)(pb + (size_t)(row0 + row) * INP + C_K + 64 * h + c8);
    u32x4 vv[2];
#pragma unroll
    for (int i = 0; i < 2; ++i) { const int vr = F.lane, vc = (F.wave + 8 * i) * 8; vv[i] = *(const u32x4*)(pb + (size_t)(row0 + vr) * INP + C_V + 128 * h + vc); }
    gla_gates(F, gr);
    __syncthreads();
    LAS float* GT = (LAS float*)(F.lds + GL_GT);
    LAS bf16_t* KDT = (LAS bf16_t*)(F.lds + GL_KDT); LAS bf16_t* VT = (LAS bf16_t*)(F.lds + GL_VT);
#pragma unroll
    for (int j = 0; j < 8; ++j) { const int d = c8 + j; const float k_ = bfel(kv, j);
        KDT[d * 72 + row] = (bf16_t)f2bf(k_ * __expf(GT[d * 65 + 63] - GT[d * 65 + row])); KDT[(64 + d) * 72 + row] = (bf16_t)f2bf(k_ * __expf(GT[(64 + d) * 65] - GT[(64 + d) * 65 + row])); }
#pragma unroll
    for (int i = 0; i < 2; ++i) { const int vr = F.lane, vc = (F.wave + 8 * i) * 8;
#pragma unroll
        for (int j = 0; j < 8; ++j) VT[(vc + j) * 72 + vr] = bfraw(vv[i], j); }
    if (tid < 128) ((float*)(P.ws + WS_DECAY))[(size_t)unit * 128 + tid] = __expf(tid < 64 ? GT[tid * 65 + 63] : GT[tid * 65]);
    __syncthreads();
    const int fr = F.lane & 15, fq = F.lane >> 4, w = F.wave;
    f32x4 acc[1][8]; zero_acc<1, 8>(acc);
    mma_nt<1, 8>(acc, KDT + (16 * w) * 72, 72, VT, 72, 64, fr, fq);
    bf16_t* st = (bf16_t*)(P.ws + WS_STATE) + (size_t)unit * 16384;
#pragma unroll
    for (int nt = 0; nt < 8; ++nt) { u32x2 o; o.x = pk2(acc[0][nt][0], acc[0][nt][1]); o.y = pk2(acc[0][nt][2], acc[0][nt][3]); *(u32x2*)(st + (nt * 16 + fr) * 128 + 16 * w + fq * 4) = o; }
}

__device__ __forceinline__ void gla_scan(const Frame& F, const Params& P, int def_lo, int def_hi) {
    unsigned* stt = (unsigned*)(P.ws + WS_STATE); const float* dec = (const float*)(P.ws + WS_DECAY);
    if (F.tid >= 256) {
        LAS float* scr = (LAS float*)(F.lds + F.wave * 16384);
        for (int it = def_lo + F.bid * 4 + (F.wave - 4); it < def_hi; it += F.G * 4) weight_item(P, it, scr, F.lane);
        return; }
    for (int gid = F.bid * 256 + F.tid; gid < 8 * 128 * 64; gid += F.G * 256) {
        const int dp = gid & 63, e = (gid >> 6) & 127, bh = gid >> 13, dir = dp >> 5;
        const int latb = bh * 256, ctxb = 2048 + bh * 4;
        auto unit_of = [&](int p) { return dir == 0 ? (p < 4 ? ctxb + p : latb + (p - 4)) : (p < 4 ? ctxb + 3 - p : latb + 255 - (p - 4)); };
        float s0 = 0.f, s1 = 0.f;
        unsigned dA[10], dB[10]; f32x2 cA[10], cB[10];
#pragma unroll
        for (int i = 0; i < 10; ++i) { const int u = unit_of(i); dA[i] = stt[((size_t)u * 128 + e) * 64 + dp]; cA[i] = *(const f32x2*)(dec + (size_t)u * 128 + 2 * dp); }
        for (int p0 = 0; p0 < 260; p0 += 20) {
#pragma unroll
            for (int i = 0; i < 10; ++i) { const int u = unit_of(p0 + 10 + i); dB[i] = stt[((size_t)u * 128 + e) * 64 + dp]; cB[i] = *(const f32x2*)(dec + (size_t)u * 128 + 2 * dp); }
#pragma unroll
            for (int i = 0; i < 10; ++i) { const int u = unit_of(p0 + i); stt[((size_t)u * 128 + e) * 64 + dp] = pk2(s0, s1); s0 = cA[i].x * s0 + bflo(dA[i]); s1 = cA[i].y * s1 + bfhi(dA[i]); }
            if (p0 + 20 < 260) {
#pragma unroll
                for (int i = 0; i < 10; ++i) { const int u = unit_of(p0 + 20 + i); dA[i] = stt[((size_t)u * 128 + e) * 64 + dp]; cA[i] = *(const f32x2*)(dec + (size_t)u * 128 + 2 * dp); } }
#pragma unroll
            for (int i = 0; i < 10; ++i) { const int u = unit_of(p0 + 10 + i); stt[((size_t)u * 128 + e) * 64 + dp] = pk2(s0, s1); s0 = cB[i].x * s0 + bflo(dB[i]); s1 = cB[i].y * s1 + bfhi(dB[i]); }
        }
    }
}

__device__ __forceinline__ void gla_g3_unit(const Frame& F, const Params& P, int l, int row0, int h, int unit) {
    const bf16_t* pb = (const bf16_t*)(P.ws + WS_PBUF);
    const int tid = F.tid, fr = F.lane & 15, fq = F.lane >> 4, w = F.wave, row = F.lane, c8 = F.wave * 8;
    const GateRegs gr = gla_load_gate_regs(F, P, l, row0, h);
    const u32x4 qv = *(const u32x4*)(pb + (size_t)(row0 + row) * INP + C_Q + 64 * h + c8), kv = *(const u32x4*)(pb + (size_t)(row0 + row) * INP + C_K + 64 * h + c8);
    u32x4 vv[2], rv[2], stv[4];
#pragma unroll
    for (int i = 0; i < 2; ++i) { const int vr = F.lane, vc = (F.wave + 8 * i) * 8; const bf16_t* rp = pb + (size_t)(row0 + vr) * INP + 128 * h + vc; vv[i] = *(const u32x4*)(rp + C_V); rv[i] = *(const u32x4*)(rp + C_R); }
    { const bf16_t* st = (const bf16_t*)(P.ws + WS_STATE) + (size_t)unit * 16384;
#pragma unroll
      for (int i = 0; i < 4; ++i) stv[i] = *(const u32x4*)(st + (i * 512 + tid) * 8); }
    const float* ng = P.in[13] + (size_t)l * 128;
    float ngv[4];
#pragma unroll
    for (int nt = 0; nt < 4; ++nt) ngv[nt] = ng[(w >> 2) * 64 + nt * 16 + fr];
    gla_gates(F, gr);
    __syncthreads();
    LAS float* GT = (LAS float*)(F.lds + GL_GT);
    LAS bf16_t* A1 = (LAS bf16_t*)(F.lds + GL_A1); LAS bf16_t* KE = (LAS bf16_t*)(F.lds + GL_KE); LAS bf16_t* VTb = (LAS bf16_t*)(F.lds + GL_VTB); LAS bf16_t* STb = (LAS bf16_t*)(F.lds + GL_GT);
    LAS float* RS = (LAS float*)(F.lds + GL_RS); LAS bf16_t* RT = (LAS bf16_t*)(F.lds + GL_RT);
    { float qf[8], qb[8], kf[8], kb[8];
#pragma unroll
      for (int j = 0; j < 8; ++j) { const float q_ = bfel(qv, j) * 0.125f, k_ = bfel(kv, j); const float bf_ = GT[(c8 + j) * 65 + row], bb_ = GT[(64 + c8 + j) * 65 + row];
          qf[j] = q_ * __expf(bf_); qb[j] = q_ * __expf(bb_); kf[j] = k_ * __expf(-bf_); kb[j] = k_ * __expf(-bb_); }
      *(LAS u32x4*)(A1 + row * 200 + 64 + c8) = (u32x4){pk2(qf[0], qf[1]), pk2(qf[2], qf[3]), pk2(qf[4], qf[5]), pk2(qf[6], qf[7])};
      *(LAS u32x4*)(A1 + row * 200 + 128 + c8) = (u32x4){pk2(qb[0], qb[1]), pk2(qb[2], qb[3]), pk2(qb[4], qb[5]), pk2(qb[6], qb[7])};
      *(LAS u32x4*)(KE + row * 72 + c8) = (u32x4){pk2(kf[0], kf[1]), pk2(kf[2], kf[3]), pk2(kf[4], kf[5]), pk2(kf[6], kf[7])};
      *(LAS u32x4*)(KE + 4608 + row * 72 + c8) = (u32x4){pk2(kb[0], kb[1]), pk2(kb[2], kb[3]), pk2(kb[4], kb[5]), pk2(kb[6], kb[7])}; }
#pragma unroll
    for (int i = 0; i < 2; ++i) { const int vr = F.lane, vc = (F.wave + 8 * i) * 8; *(LAS u32x4*)(RT + vr * 136 + vc) = rv[i];
#pragma unroll
        for (int j = 0; j < 8; ++j) VTb[(vc + j) * 72 + vr] = bfraw(vv[i], j); }
    __syncthreads();
    {
        const int mt = w & 3, ntp = w >> 2;
        f32x4 af[1][2], ab[1][2]; zero_acc<1, 2>(af); zero_acc<1, 2>(ab);
        mma_nt<1, 2>(af, A1 + (16 * mt) * 200 + 64, 200, KE + (32 * ntp) * 72, 72, 64, fr, fq);
        mma_nt<1, 2>(ab, A1 + (16 * mt) * 200 + 128, 200, KE + 4608 + (32 * ntp) * 72, 72, 64, fr, fq);
#pragma unroll
        for (int i = 0; i < 4; ++i) { const int idx = (i * 512 + tid) * 8, e = idx >> 7, dd = idx & 127; *(LAS u32x4*)(STb + e * 136 + dd) = stv[i]; }
#pragma unroll
        for (int nt = 0; nt < 2; ++nt)
#pragma unroll
            for (int j = 0; j < 4; ++j) { const int i = 16 * mt + fq * 4 + j, jj = (2 * ntp + nt) * 16 + fr;
                const float p = (jj <= i ? af[0][nt][j] : 0.f) + (jj >= i ? ab[0][nt][j] : 0.f); A1[i * 200 + jj] = (bf16_t)f2bf(p); }
    }
    __syncthreads();
    {
        const int mt = w & 3, nh = w >> 2;
        f32x4 acc[1][4]; zero_acc<1, 4>(acc);
        mma_nt<1, 4>(acc, A1 + (16 * mt) * 200, 200, VTb + (64 * nh) * 72, 72, 64, fr, fq);
        mma_nt<1, 4>(acc, A1 + (16 * mt) * 200 + 64, 200, STb + (64 * nh) * 136, 136, 128, fr, fq);
        float ss[4];
#pragma unroll
        for (int j = 0; j < 4; ++j) { float s = 0.f;
#pragma unroll
            for (int nt = 0; nt < 4; ++nt) s += acc[0][nt][j] * acc[0][nt][j];
            s += __shfl_xor(s, 1); s += __shfl_xor(s, 2); s += __shfl_xor(s, 4); s += __shfl_xor(s, 8); ss[j] = s; }
        if (fr == 0) {
#pragma unroll
            for (int j = 0; j < 4; ++j) RS[nh * 64 + 16 * mt + fq * 4 + j] = ss[j]; }
        __syncthreads();
        bf16_t* cat = (bf16_t*)(P.ws + WS_CAT);
#pragma unroll
        for (int j = 0; j < 4; ++j) { const int i = 16 * mt + fq * 4 + j; const float rinv = 1.0f / sqrtf((RS[i] + RS[64 + i]) * (1.0f / 128.0f) + NORM_EPS);
#pragma unroll
            for (int nt = 0; nt < 4; ++nt) { const int e = nh * 64 + nt * 16 + fr; const float r_ = bf2f(RT[i * 136 + e]);
                const float o = acc[0][nt][j] * rinv * ngv[nt] * (r_ * sigmoidf_(r_)); cat[(size_t)(row0 + i) * D + 256 + 128 * h + e] = (bf16_t)f2bf(o); } }
    }
}

__device__ __forceinline__ void conv_unit(const Frame& F, const Params& P, int l, int rowbase, int Ls, int t0) {
    const bf16_t* pb = (const bf16_t*)(P.ws + WS_PBUF);
    LAS bf16_t* Y = (LAS bf16_t*)(F.lds);
    LAS float* Z = (LAS float*)(F.lds + 49152);
    const int tid = F.tid;
    {
        u32x4 av[6], gv[6];
#pragma unroll
        for (int i = 0; i < 6; ++i) { const int ch = tid + 512 * i, r = ch >> 5, cc = (ch & 31) * 8, t = t0 - 15 + r;
            av[i] = (u32x4){0u, 0u, 0u, 0u}; gv[i] = av[i];
            if (ch < 94 * 32 && t >= 0 && t < Ls) { const size_t rb = (size_t)(rowbase + t) * INP; av[i] = *(const u32x4*)(pb + rb + C_CA + cc); gv[i] = *(const u32x4*)(pb + rb + C_CG + cc); } }
#pragma unroll
        for (int i = 0; i < 6; ++i) { const int ch = tid + 512 * i, r = ch >> 5, cc = (ch & 31) * 8; const u32x4 a = av[i], g = gv[i]; u32x4 o;
            o.x = pk2(bflo(a.x) * sigmoidf_(bflo(g.x)), bfhi(a.x) * sigmoidf_(bfhi(g.x))); o.y = pk2(bflo(a.y) * sigmoidf_(bflo(g.y)), bfhi(a.y) * sigmoidf_(bfhi(g.y)));
            o.z = pk2(bflo(a.z) * sigmoidf_(bflo(g.z)), bfhi(a.z) * sigmoidf_(bfhi(g.z))); o.w = pk2(bflo(a.w) * sigmoidf_(bflo(g.w)), bfhi(a.w) * sigmoidf_(bfhi(g.w)));
            if (ch < 94 * 32) *(LAS u32x4*)(Y + r * 256 + cc) = o; }
    }
    const int c2 = (tid & 127) * 2, qtr = tid >> 7; const float* cw = P.in[14] + (size_t)l * 31 * 256 + c2; const f32x2 cb = *(const f32x2*)(P.in[15] + (size_t)l * 256 + c2);
    f32x2 wv[31];
#pragma unroll
    for (int j = 0; j < 31; ++j) wv[j] = *(const f32x2*)(cw + j * 256);
    const f32x4 lng = *(const f32x4*)(P.in[16] + (size_t)l * 256 + 4 * F.lane), lnb = *(const f32x4*)(P.in[17] + (size_t)l * 256 + 4 * F.lane);
    __syncthreads();
#pragma unroll 1
    for (int hp = 0; hp < 2; ++hp) { f32x2 yv[38]; const int rb = qtr * 16 + hp * 8;
#pragma unroll
      for (int r = 0; r < 38; ++r) { const unsigned wd = *(const LAS unsigned*)(Y + (rb + r) * 256 + c2); yv[r] = (f32x2){bflo(wd), bfhi(wd)}; }
#pragma unroll
      for (int tt = 0; tt < 8; ++tt) { f32x2 z = cb;
#pragma unroll
          for (int j = 0; j < 31; ++j) z += wv[j] * yv[tt + j];
          *(LAS f32x2*)(Z + (rb + tt) * 256 + c2) = z; } }
    __syncthreads();
    { bf16_t* cat = (bf16_t*)(P.ws + WS_CAT);
#pragma unroll 2
      for (int i = 0; i < 8; ++i) { const int t = F.wave * 8 + i; const f32x4 z = *(const LAS f32x4*)(Z + t * 256 + 4 * F.lane);
          const float mean = wave_sum((z.x + z.y) + (z.z + z.w)) * (1.0f / 256.0f); const f32x4 zc = z - mean;
          const float var = wave_sum((zc.x * zc.x + zc.y * zc.y) + (zc.z * zc.z + zc.w * zc.w)) * (1.0f / 256.0f); const float rstd = 1.0f / sqrtf(var + NORM_EPS);
          const f32x4 y = zc * rstd * lng + lnb; u32x2 o; o.x = pk2(y.x * sigmoidf_(y.x), y.y * sigmoidf_(y.y)); o.y = pk2(y.z * sigmoidf_(y.z), y.w * sigmoidf_(y.w));
          *(u32x2*)(cat + (size_t)(rowbase + t0 + t) * D + 768 + 4 * F.lane) = o; } }
    __syncthreads();
}

template <int R, int NP>
__device__ __forceinline__ void fourier_f1_unit(const Frame& F, const Params& P, int rowbase, int rstride, int h, const bf16_t* tab, int orow0, float oscale) {
    const bf16_t* pb = (const bf16_t*)(P.ws + WS_PBUF); const bf16_t* cm3 = (const bf16_t*)(P.ws + WS_CM3);
    constexpr int LZ = R + 8, MT0 = 4 * NP, NTW = R / 128, MTW = R / 128;
    LAS bf16_t* U = (LAS bf16_t*)(F.lds); LAS bf16_t* CM = U + R * 72; LAS bf16_t* ZT = CM + 64 * NP * 72;
    const int tid = F.tid, fr = F.lane & 15, fq = F.lane >> 4, w = F.wave;
    bf16x8 tcp[4], tsp[4];
    if constexpr (R == 128) {
#pragma unroll
        for (int k = 0; k < 4; ++k) { tcp[k] = *(const bf16x8*)(tab + (size_t)(w * 16 + fr) * R + k * 32 + fq * 8); tsp[k] = *(const bf16x8*)(tab + (size_t)R * R + (size_t)(w * 16 + fr) * R + k * 32 + fq * 8); } }
    { constexpr int NU = R * 8 / NTHREADS, NC = (64 * NP * 8 + NTHREADS - 1) / NTHREADS; u32x4 uv[NU], cv[NC];
#pragma unroll
      for (int i = 0; i < NU; ++i) { const int ch = tid + NTHREADS * i, a = ch >> 3, c8 = (ch & 7) * 8; uv[i] = *(const u32x4*)(pb + (size_t)(rowbase + a * rstride) * INP + C_FOUR + 64 * h + c8); }
#pragma unroll
      for (int i = 0; i < NC; ++i) { const int ch = tid + NTHREADS * i, m = ch >> 3, c8 = (ch & 7) * 8; cv[i] = (ch < 64 * NP * 8) ? *(const u32x4*)(cm3 + m * 64 + c8) : (u32x4){0u, 0u, 0u, 0u}; }
#pragma unroll
      for (int i = 0; i < NU; ++i) { const int ch = tid + NTHREADS * i, a = ch >> 3, c8 = (ch & 7) * 8; *(LAS u32x4*)(U + a * 72 + c8) = uv[i]; }
#pragma unroll
      for (int i = 0; i < NC; ++i) { const int ch = tid + NTHREADS * i, m = ch >> 3, c8 = (ch & 7) * 8; if (ch < 64 * NP * 8) *(LAS u32x4*)(CM + m * 72 + c8) = cv[i]; } }
    __syncthreads();
    {
        f32x4 acc[MT0][NTW]; zero_acc<MT0, NTW>(acc);
        mma_nt<MT0, NTW>(acc, CM, 72, U + (w * NTW * 16) * 72, 72, 64, fr, fq);
#pragma unroll
        for (int mt = 0; mt < MT0; ++mt)
#pragma unroll
            for (int nt = 0; nt < NTW; ++nt)
#pragma unroll
                for (int j = 0; j < 4; ++j) ZT[(mt * 16 + fq * 4 + j) * LZ + (w * NTW + nt) * 16 + fr] = (bf16_t)f2bf(acc[mt][nt][j]);
    }
    __syncthreads();
    {
        f32x4 are[MTW][4], aim[MTW][4]; zero_acc<MTW, 4>(are); zero_acc<MTW, 4>(aim);
        const int m0 = w * MTW * 16;
#pragma unroll
        for (int k0 = 0; k0 < R; k0 += 32) {
            bf16x8 tc[MTW], ts[MTW];
#pragma unroll
            for (int mi = 0; mi < MTW; ++mi) { if constexpr (R == 128) { tc[mi] = tcp[k0 / 32]; ts[mi] = tsp[k0 / 32]; } else { tc[mi] = *(const bf16x8*)(tab + (size_t)(m0 + mi * 16 + fr) * R + k0 + fq * 8); ts[mi] = *(const bf16x8*)(tab + (size_t)R * R + (size_t)(m0 + mi * 16 + fr) * R + k0 + fq * 8); } }
#pragma unroll
            for (int nt = 0; nt < 4; ++nt) {
                const bf16x8 zr = *(const LAS bf16x8*)(ZT + (nt * 16 + fr) * LZ + k0 + fq * 8), zi = *(const LAS bf16x8*)(ZT + (64 + nt * 16 + fr) * LZ + k0 + fq * 8);
#pragma unroll
                for (int mi = 0; mi < MTW; ++mi) { are[mi][nt] = __builtin_amdgcn_mfma_f32_16x16x32_bf16(tc[mi], zr, are[mi][nt], 0, 0, 0); are[mi][nt] = __builtin_amdgcn_mfma_f32_16x16x32_bf16(ts[mi], zi, are[mi][nt], 0, 0, 0); }
                if constexpr (NP == 3) { const bf16x8 nzr = *(const LAS bf16x8*)(ZT + (128 + nt * 16 + fr) * LZ + k0 + fq * 8);
#pragma unroll
                    for (int mi = 0; mi < MTW; ++mi) { aim[mi][nt] = __builtin_amdgcn_mfma_f32_16x16x32_bf16(tc[mi], zi, aim[mi][nt], 0, 0, 0); aim[mi][nt] = __builtin_amdgcn_mfma_f32_16x16x32_bf16(ts[mi], nzr, aim[mi][nt], 0, 0, 0); } }
            }
        }
#pragma unroll
        for (int mi = 0; mi < MTW; ++mi)
#pragma unroll
            for (int nt = 0; nt < 4; ++nt)
#pragma unroll
                for (int j = 0; j < 4; ++j) { const int m = m0 + mi * 16 + fq * 4 + j, k2 = nt * 16 + fr;
                    if constexpr (NP == 3) { unsigned* t2 = (unsigned*)(P.ws + WS_T2); t2[(size_t)(orow0 + 128 * m) * 256 + h * 64 + k2] = pk2(are[mi][nt][j], aim[mi][nt][j]); }
                    else { bf16_t* cat = (bf16_t*)(P.ws + WS_CAT); cat[(size_t)(orow0 + m) * D + h * 64 + k2] = (bf16_t)f2bf(are[mi][nt][j] * oscale); } }
    }
    __syncthreads();
}

constexpr int F2_X = 0, F2_T = 67584;
__device__ __forceinline__ void fourier_f2_tables(const Frame& F, const Params& P) {
    const bf16_t* tf2 = (const bf16_t*)(P.ws + WS_TF2); LAS bf16_t* T = (LAS bf16_t*)(F.lds + F2_T);
#pragma unroll
    for (int i = 0; i < 8; ++i) { const int ch = F.tid + 512 * i, r = ch >> 4, c8 = (ch & 15) * 8; *(LAS u32x4*)(T + r * 136 + c8) = *(const u32x4*)(tf2 + r * 128 + c8); }
    __syncthreads();
}
__device__ __forceinline__ void fourier_f2_unit(const Frame& F, const Params& P, int b, int d, int hp) {
    const bf16_t* t2 = (const bf16_t*)(P.ws + WS_T2);
    LAS bf16_t* X = (LAS bf16_t*)(F.lds + F2_X); const LAS bf16_t* T = (const LAS bf16_t*)(F.lds + F2_T);
    const int tid = F.tid, fr = F.lane & 15, fq = F.lane >> 4, w = F.wave;
    { u32x4 xv[8];
#pragma unroll
      for (int i = 0; i < 8; ++i) { const int ch = tid + 512 * i, n = ch >> 5, c8 = (ch & 31) * 8; xv[i] = *(const u32x4*)(t2 + (size_t)(b * SEQ + 128 * d + n) * 512 + hp * 256 + c8); }
#pragma unroll
      for (int i = 0; i < 8; ++i) { const int ch = tid + 512 * i, n = ch >> 5, c8 = (ch & 31) * 8; *(LAS u32x4*)(X + n * 264 + c8) = xv[i]; } }
    __syncthreads();
    f32x4 acc[8];
#pragma unroll
    for (int mt = 0; mt < 8; ++mt) acc[mt] = (f32x4){0.f, 0.f, 0.f, 0.f};
#pragma unroll
    for (int k0 = 0; k0 < 128; k0 += 32) {
        bf16x8 xr, xi;
#pragma unroll
        for (int jj = 0; jj < 8; ++jj) { const unsigned wd = *(const LAS unsigned*)(X + (k0 + fq * 8 + jj) * 264 + 2 * (w * 16 + fr)); xr[jj] = (short)(wd & 0xffffu); xi[jj] = (short)(wd >> 16); }
#pragma unroll
        for (int mt = 0; mt < 8; ++mt) { const bf16x8 tc = *(const LAS bf16x8*)(T + (mt * 16 + fr) * 136 + k0 + fq * 8), ts = *(const LAS bf16x8*)(T + (128 + mt * 16 + fr) * 136 + k0 + fq * 8);
            acc[mt] = __builtin_amdgcn_mfma_f32_16x16x32_bf16(tc, xr, acc[mt], 0, 0, 0); acc[mt] = __builtin_amdgcn_mfma_f32_16x16x32_bf16(ts, xi, acc[mt], 0, 0, 0); }
    }
    bf16_t* cat = (bf16_t*)(P.ws + WS_CAT);
#pragma unroll
    for (int mt = 0; mt < 8; ++mt)
#pragma unroll
        for (int j = 0; j < 4; ++j) { const int c = mt * 16 + fq * 4 + j; cat[(size_t)(b * SEQ + 128 * c + d) * D + hp * 128 + w * 16 + fr] = (bf16_t)f2bf(acc[mt][j] * (1.0f / 1024.0f)); }
    __syncthreads();
}

constexpr int AX_LCNT = AUX_OFF, AX_GBASE = AUX_OFF + 128, AX_LE = AUX_OFF + 256, AX_LP = AUX_OFF + 256 + 2560;
constexpr int LC_BAR = LCTL_OFF, LC_TS = LCTL_OFF + 64;

constexpr int RT_GS = 0, RT_SSQ = 24576, RT_AT = 25600, RT_PL = 95232;
__device__ __forceinline__ void phase_route(const Frame& F, const Params& P, int l, int ntok) {
    unsigned char* ws = P.ws;
    LAS float* GS = (LAS float*)(F.lds + RT_GS); LAS float* SSQ = (LAS float*)(F.lds + RT_SSQ); LAS float* PL = (LAS float*)(F.lds + RT_PL);
    volatile LAS int* lcnt = (volatile LAS int*)(F.lds + AX_LCNT); volatile LAS int* gbase = (volatile LAS int*)(F.lds + AX_GBASE);
    volatile LAS int* LE = (volatile LAS int*)(F.lds + AX_LE); volatile LAS int* LP = (volatile LAS int*)(F.lds + AX_LP);
    const int tid = F.tid, lane = F.lane, w = F.wave, fr = lane & 15, fq = lane >> 4, ts = lane >> 2, kq = lane & 3, kbase = 128 * w + 32 * kq;
    LAS bf16_t* AT = (LAS bf16_t*)(F.lds + RT_AT) + w * (2 * 16 * 136);
    const int tpb = (ntok + F.G - 1) / F.G, tb = F.bid * tpb, te = (tb + tpb < ntok) ? tb + tpb : ntok, ntile = (te - tb + 15) >> 4;
    { const float* g2 = P.in[5] + (size_t)l * D;
      for (int i = tid; i < 3 * 1024; i += NTHREADS) { const int v = i >> 10, k = i & 1023; const float* mf = (const float*)(ws + WS_MODF) + ((size_t)l * 3 + v) * 6144;
          GS[(v * 2 + 0) * 1024 + k] = g2[k] * (1.0f + mf[4 * 1024 + k]); GS[(v * 2 + 1) * 1024 + k] = mf[3 * 1024 + k]; } }
    if (tid < 32) lcnt[tid] = 0;
    bf16x8 bh[4][2], bl[4][2];
    { const bf16_t* rwh = (const bf16_t*)(ws + WS_RW) + (size_t)l * 2 * NE * D; const bf16_t* rwl = rwh + NE * D;
#pragma unroll
      for (int sk = 0; sk < 4; ++sk)
#pragma unroll
          for (int nt = 0; nt < 2; ++nt) { const int off = (nt * 16 + fr) * D + 128 * w + 32 * sk + 8 * fq; bh[sk][nt] = *(const bf16x8*)(rwh + off); bl[sk][nt] = *(const bf16x8*)(rwl + off); } }
    const float* xres = (const float*)(ws + WS_XRES); bf16_t* hb = (bf16_t*)(ws + WS_HBUF);
    const float rbias = P.in[20][(size_t)l * NE + (lane & 31)];
    float* aprob = (float*)(ws + WS_APROB);
    f32x4 xn[8];
    { const int m = tb + ts;
#pragma unroll
      for (int j = 0; j < 8; ++j) xn[j] = (m < te) ? *(const f32x4*)(xres + (size_t)m * D + kbase + 4 * j) : (f32x4){0.f, 0.f, 0.f, 0.f}; }
    __syncthreads();
    for (int it = 0; it < ntile; ++it) {
        const int buf = it & 1; const int m = tb + 16 * it + ts; const bool valid = m < te; const int v = (m >= NLAT) ? 2 : (m >= SEQ ? 1 : 0);
        f32x4 x[8]; float ss = 0.f;
#pragma unroll
        for (int j = 0; j < 8; ++j) { x[j] = xn[j]; ss += (x[j].x * x[j].x + x[j].y * x[j].y) + (x[j].z * x[j].z + x[j].w * x[j].w); }
        if (it + 1 < ntile) { const int mn = m + 16;
#pragma unroll
            for (int j = 0; j < 8; ++j) xn[j] = (mn < te) ? *(const f32x4*)(xres + (size_t)mn * D + kbase + 4 * j) : (f32x4){0.f, 0.f, 0.f, 0.f}; }
        ss += __shfl_xor(ss, 1); ss += __shfl_xor(ss, 2);
        if (kq == 0) SSQ[(buf * 8 + w) * 16 + ts] = ss;
        __syncthreads();
        float tot = 0.f;
#pragma unroll
        for (int q = 0; q < 8; ++q) tot += SSQ[(buf * 8 + q) * 16 + ts];
        const float rstd = 1.0f / sqrtf(tot * (1.0f / D) + NORM_EPS);
        {
            unsigned hw[16], lw[16];
#pragma unroll
            for (int j = 0; j < 8; ++j) { const f32x4 gs = *(const LAS f32x4*)(GS + (v * 2 + 0) * 1024 + kbase + 4 * j), sh = *(const LAS f32x4*)(GS + (v * 2 + 1) * 1024 + kbase + 4 * j);
                const f32x4 h = (x[j] * rstd) * gs + sh;
                const unsigned h0 = f2bf(h.x), h1 = f2bf(h.y), h2 = f2bf(h.z), h3 = f2bf(h.w);
                hw[2 * j] = h0 | (h1 << 16); hw[2 * j + 1] = h2 | (h3 << 16);
                lw[2 * j] = pk2(h.x - bf2f(h0), h.y - bf2f(h1)); lw[2 * j + 1] = pk2(h.z - bf2f(h2), h.w - bf2f(h3)); }
            if (valid) {
                if (F8_LAYER[l]) { unsigned char* hb8 = ws + WS_HB8 + (size_t)m * D + kbase;
#pragma unroll
                    for (int c = 0; c < 2; ++c) { u32x4 o;
                        o.x = pk4_fp8(bflo(hw[8 * c + 0]) + bflo(lw[8 * c + 0]), bfhi(hw[8 * c + 0]) + bfhi(lw[8 * c + 0]), bflo(hw[8 * c + 1]) + bflo(lw[8 * c + 1]), bfhi(hw[8 * c + 1]) + bfhi(lw[8 * c + 1]));
                        o.y = pk4_fp8(bflo(hw[8 * c + 2]) + bflo(lw[8 * c + 2]), bfhi(hw[8 * c + 2]) + bfhi(lw[8 * c + 2]), bflo(hw[8 * c + 3]) + bflo(lw[8 * c + 3]), bfhi(hw[8 * c + 3]) + bfhi(lw[8 * c + 3]));
                        o.z = pk4_fp8(bflo(hw[8 * c + 4]) + bflo(lw[8 * c + 4]), bfhi(hw[8 * c + 4]) + bfhi(lw[8 * c + 4]), bflo(hw[8 * c + 5]) + bflo(lw[8 * c + 5]), bfhi(hw[8 * c + 5]) + bfhi(lw[8 * c + 5]));
                        o.w = pk4_fp8(bflo(hw[8 * c + 6]) + bflo(lw[8 * c + 6]), bfhi(hw[8 * c + 6]) + bfhi(lw[8 * c + 6]), bflo(hw[8 * c + 7]) + bflo(lw[8 * c + 7]), bfhi(hw[8 * c + 7]) + bfhi(lw[8 * c + 7]));
                        *(u32x4*)(hb8 + 16 * c) = o; } }
                if (!F8_LAYER[l]) {
#pragma unroll
                    for (int c = 0; c < 4; ++c) *(u32x4*)(hb + (size_t)m * D + kbase + 8 * c) = (u32x4){hw[4 * c], hw[4 * c + 1], hw[4 * c + 2], hw[4 * c + 3]}; } }
#pragma unroll
            for (int c = 0; c < 4; ++c) { *(LAS u32x4*)(AT + ts * 136 + 32 * kq + 8 * c) = (u32x4){hw[4 * c], hw[4 * c + 1], hw[4 * c + 2], hw[4 * c + 3]};
                *(LAS u32x4*)(AT + 16 * 136 + ts * 136 + 32 * kq + 8 * c) = (u32x4){lw[4 * c], lw[4 * c + 1], lw[4 * c + 2], lw[4 * c + 3]}; }
        }
        f32x4 acc[2]; acc[0] = (f32x4){0.f, 0.f, 0.f, 0.f}; acc[1] = acc[0];
#pragma unroll
        for (int sk = 0; sk < 4; ++sk) { const bf16x8 ah = *(const LAS bf16x8*)(AT + fr * 136 + 32 * sk + 8 * fq), al = *(const LAS bf16x8*)(AT + 16 * 136 + fr * 136 + 32 * sk + 8 * fq);
#pragma unroll
            for (int nt = 0; nt < 2; ++nt) { acc[nt] = __builtin_amdgcn_mfma_f32_16x16x32_bf16(ah, bh[sk][nt], acc[nt], 0, 0, 0); acc[nt] = __builtin_amdgcn_mfma_f32_16x16x32_bf16(ah, bl[sk][nt], acc[nt], 0, 0, 0);
                acc[nt] = __builtin_amdgcn_mfma_f32_16x16x32_bf16(al, bh[sk][nt], acc[nt], 0, 0, 0); } }
#pragma unroll
        for (int nt = 0; nt < 2; ++nt)
#pragma unroll
            for (int j = 0; j < 4; ++j) PL[((buf * 8 + w) * 16 + fq * 4 + j) * 33 + nt * 16 + fr] = acc[nt][j];
        __syncthreads();
        {
            const int tt = 2 * w + (lane >> 5), e = lane & 31, mt = tb + 16 * it + tt;
            float lg = rbias;
#pragma unroll
            for (int q = 0; q < 8; ++q) lg += PL[((buf * 8 + q) * 16 + tt) * 33 + e];
            float bval[4]; int bidx[4]; float cur = lg;
#pragma unroll
            for (int k = 0; k < 4; ++k) { float bv = cur; int bi = e;
#pragma unroll
                for (int o = 1; o < 32; o <<= 1) { const float ov = __shfl_xor(bv, o); const int oi = __shfl_xor(bi, o); const bool take = (ov > bv) || (ov == bv && oi < bi); bv = take ? ov : bv; bi = take ? oi : bi; }
                bval[k] = bv; bidx[k] = bi; if (e == bi) cur = -INFINITY; }
            float ex[4], sum = 0.f;
#pragma unroll
            for (int k = 0; k < 4; ++k) { ex[k] = __expf(bval[k] - bval[0]); sum += ex[k]; }
            if (e == 0 && mt < te) { const int tl = 16 * it + tt;
#pragma unroll
                for (int k = 0; k < 4; ++k) { const int lp = __hip_atomic_fetch_add((LAS int*)(F.lds + AX_LCNT) + bidx[k], 1, __ATOMIC_RELAXED, __HIP_MEMORY_SCOPE_WORKGROUP);
                    LE[tl * 4 + k] = bidx[k]; LP[tl * 4 + k] = lp; aprob[(size_t)mt * 4 + k] = ex[k] / sum; } }
        }
    }
    __syncthreads();
    if (tid < 32) gbase[tid] = (int)__hip_atomic_fetch_add((unsigned*)(ws + WS_CTL) + CW_CNT + l * 64 + tid, (unsigned)lcnt[tid], __ATOMIC_RELAXED, __HIP_MEMORY_SCOPE_AGENT);
    __syncthreads();
    int* aexp = (int*)(ws + WS_AEXP); int* apos = (int*)(ws + WS_APOS);
    int* elist = (int*)(ws + WS_XB);
    for (int i = tid; i < (te - tb) * 4; i += NTHREADS) { const int e = LE[i]; const int pos = gbase[e] + LP[i]; aexp[(size_t)tb * 4 + i] = e; apos[(size_t)tb * 4 + i] = pos; elist[(size_t)e * NTOK + pos] = tb + (i >> 2); }
    __syncthreads();
}

__device__ __forceinline__ void moe_prep(const Frame& F, const Params& P, int l) {
    unsigned char* ws = P.ws;
    volatile LAS int* TS = (volatile LAS int*)(F.lds + LC_TS);
    if (F.tid < 64) { const int e = F.lane & 31;
        const unsigned c = __hip_atomic_load((unsigned*)(ws + WS_CTL) + CW_CNT + l * 64 + e, __ATOMIC_RELAXED, __HIP_MEMORY_SCOPE_AGENT);
        int incl = (int)((c + 255u) >> 8);
#pragma unroll
        for (int o = 1; o < 32; o <<= 1) { const int v = __shfl_up(incl, o); if (e >= o) incl += v; }
        if (F.lane < 32) { TS[e + 1] = incl; TS[64 + e] = (int)c; }
        if (F.lane == 0) TS[0] = 0; }
    __syncthreads();
}

__device__ __forceinline__ void phase_gather8(const Frame& F, const Params& P, int l, int ntok) {
    unsigned char* ws = P.ws;
    moe_prep(F, P, l);
    const volatile LAS int* TS = (const volatile LAS int*)(F.lds + LC_TS);
    const int gw = F.bid * NWAVES + F.wave, NGW = F.G * NWAVES;
    const int* aexp = (const int*)(ws + WS_AEXP); const int* apos = (const int*)(ws + WS_APOS);
    const unsigned char* hb8 = ws + WS_HB8; unsigned char* xb8 = ws + WS_XB8;
    for (int cidx = gw; cidx < ntok / 16; cidx += NGW) {
        const int a0 = cidx * 64; const int e = aexp[a0 + F.lane]; const int rowl = TS[e] * 256 + apos[a0 + F.lane];
#pragma unroll 1
        for (int t4 = 0; t4 < 16; t4 += 4) {
            u32x4 v0[4];
#pragma unroll
            for (int q = 0; q < 4; ++q) v0[q] = ((const u32x4*)(hb8 + (size_t)(a0 / 4 + t4 + q) * D))[F.lane];
#pragma unroll
            for (int q = 0; q < 4; ++q)
#pragma unroll
                for (int k = 0; k < 4; ++k) { const int row = __shfl(rowl, (t4 + q) * 4 + k); ((u32x4*)(xb8 + (size_t)row * D))[F.lane] = v0[q]; }
        }
    }
}

__device__ __forceinline__ void phase_combine(const Frame& F, const Params& P, int l, int ntok, bool last) {
    unsigned char* ws = P.ws;
    const int gw = F.bid * NWAVES + F.wave, NGW = F.G * NWAVES, lane = F.lane;
    float* xres = (float*)(ws + WS_XRES); const bf16_t* yb = (const bf16_t*)(ws + WS_YB); const unsigned char* yb8 = ws + WS_YB;
    const int* aexp = (const int*)(ws + WS_AEXP); const int* apos = (const int*)(ws + WS_APOS); const float* aprob = (const float*)(ws + WS_APROB);
    const volatile LAS int* TS = (const volatile LAS int*)(F.lds + LC_TS);
    int sl_n[4]; float pr_n[4];
    if (gw < ntok) {
#pragma unroll
        for (int k = 0; k < 4; ++k) { sl_n[k] = TS[aexp[(size_t)gw * 4 + k]] * 256 + apos[(size_t)gw * 4 + k]; pr_n[k] = aprob[(size_t)gw * 4 + k]; } }
    for (int m = gw; m < ntok; m += NGW) {
        const int v = (m >= NLAT) ? 2 : (m >= SEQ ? 1 : 0);
        const float* mf = (const float*)(ws + WS_MODF) + ((size_t)l * 3 + v) * 6144;
        int sl[4]; float pr[4];
#pragma unroll
        for (int k = 0; k < 4; ++k) { sl[k] = sl_n[k]; pr[k] = pr_n[k]; }
        u32x2 wv[4][4]; f32x4 xo[4], g5[4];
#pragma unroll
        for (int k = 0; k < 4; ++k)
#pragma unroll
            for (int j = 0; j < 4; ++j) { if (F8_LAYER[l]) { wv[k][j].x = *(const unsigned*)(yb8 + (size_t)sl[k] * D + 4 * lane + 256 * j); wv[k][j].y = 0u; } else wv[k][j] = *(const u32x2*)(yb + (size_t)sl[k] * D + 4 * lane + 256 * j); }
#pragma unroll
        for (int j = 0; j < 4; ++j) { const int c = 4 * lane + 256 * j; xo[j] = *(const f32x4*)(xres + (size_t)m * D + c); g5[j] = *(const f32x4*)(mf + 5 * 1024 + c); }
        if (m + NGW < ntok) {
#pragma unroll
            for (int k = 0; k < 4; ++k) { sl_n[k] = TS[aexp[(size_t)(m + NGW) * 4 + k]] * 256 + apos[(size_t)(m + NGW) * 4 + k]; pr_n[k] = aprob[(size_t)(m + NGW) * 4 + k]; } }
        f32x4 y[4];
#pragma unroll
        for (int j = 0; j < 4; ++j) y[j] = (f32x4){0.f, 0.f, 0.f, 0.f};
#pragma unroll
        for (int k = 0; k < 4; ++k)
#pragma unroll
            for (int j = 0; j < 4; ++j) { if (F8_LAYER[l]) { const f32x2 lo = __builtin_amdgcn_cvt_pk_f32_fp8(wv[k][j].x, false), hi = __builtin_amdgcn_cvt_pk_f32_fp8(wv[k][j].x, true); y[j] += (f32x4){lo.x, lo.y, hi.x, hi.y} * pr[k]; }
                else y[j] += (f32x4){bflo(wv[k][j].x), bfhi(wv[k][j].x), bflo(wv[k][j].y), bfhi(wv[k][j].y)} * pr[k]; }
        f32x4 x[4];
#pragma unroll
        for (int j = 0; j < 4; ++j) x[j] = xo[j] + g5[j] * y[j];
        if (!last) {
#pragma unroll
            for (int j = 0; j < 4; ++j) *(f32x4*)(xres + (size_t)m * D + 4 * lane + 256 * j) = x[j];
            const float* mn = (const float*)(ws + WS_MODF) + ((size_t)(l + 1) * 3 + v) * 6144; f32x4 shv[4], scv[4];
#pragma unroll
            for (int j = 0; j < 4; ++j) { shv[j] = *(const f32x4*)(mn + 4 * lane + 256 * j); scv[j] = *(const f32x4*)(mn + 1024 + 4 * lane + 256 * j); }
            norm_row_store(x, P.in[4] + (size_t)(l + 1) * D, shv, scv, (bf16_t*)(ws + WS_HBUF) + (size_t)m * D, lane);
        } else {
            float ss = 0.f;
#pragma unroll
            for (int j = 0; j < 4; ++j) ss += (x[j].x * x[j].x + x[j].y * x[j].y) + (x[j].z * x[j].z + x[j].w * x[j].w);
            const float rstd = 1.0f / sqrtf(wave_sum(ss) * (1.0f / D) + NORM_EPS);
#pragma unroll
            for (int j = 0; j < 4; ++j) { const int c = 4 * lane + 256 * j; *(f32x4*)(P.out + (size_t)m * D + c) = (x[j] * rstd) * *(const f32x4*)(P.in[25] + c); }
        }
    }
}

#ifndef REP_PRO
#define REP_PRO 1
#endif
#ifndef REP_GEMM1
#define REP_GEMM1 1
#endif
#ifndef REP_G1U
#define REP_G1U 1
#endif
#ifndef REP_F1U
#define REP_F1U 1
#endif
#ifndef REP_CONV
#define REP_CONV 1
#endif
#ifndef REP_F2U
#define REP_F2U 1
#endif
#ifndef REP_G3U
#define REP_G3U 1
#endif
#ifndef REP_GU
#define REP_GU 1
#endif
#ifndef REP_DN
#define REP_DN 1
#endif
#ifndef REP_GATH
#define REP_GATH 1
#endif
__global__ void __launch_bounds__(NTHREADS, 2) mega_fwd(Params P0) {
    extern __shared__ __attribute__((aligned(16))) unsigned char lds_raw[];
    Frame F0; F0.lds = (LAS unsigned char*)lds_raw; F0.tid = threadIdx.x; F0.lane = F0.tid & 63; F0.wave = __builtin_amdgcn_readfirstlane(F0.tid >> 6); F0.G = gridDim.x; F0.bid = blockIdx.x;
#define KAS __attribute__((address_space(4)))
    struct ParamsK { const GAS float* in[26]; GAS float* out; GAS unsigned char* ws; };
#define PHASE_ENV() Frame F = F0; asm volatile("" : "+v"(F.tid)); F.lane = F.tid & 63; F.wave = __builtin_amdgcn_readfirstlane(F.tid >> 6); asm volatile("" : "+s"(F.bid), "+s"(F.G)); \
    const KAS ParamsK* kp_ = (const KAS ParamsK*)__builtin_amdgcn_kernarg_segment_ptr(); asm volatile("" : "+s"(kp_)); Params P; \
    _Pragma("unroll") for (int i_ = 0; i_ < 26; ++i_) P.in[i_] = (const float*)kp_->in[i_]; \
    P.out = (float*)kp_->out; P.ws = (unsigned char*)kp_->ws; unsigned char* ws = P.ws; (void)ws;
    { PHASE_ENV();
    for (int u = F.tid; u < (LDS_BYTES - LCTL_OFF) / 4; u += NTHREADS) ((LAS unsigned*)(F.lds + LCTL_OFF))[u] = 0u;
    __syncthreads();
    }
    { PHASE_ENV(); (void)xcd_barrier_post((unsigned*)(ws + WS_CTL) + CW_BAR, (volatile LAS unsigned*)(F.lds + LC_BAR)); }
#define GRID_BAR() do { PHASE_ENV(); XcdBarrier b_; b_.bar = (unsigned*)(ws + WS_CTL) + CW_BAR; b_.x = xb_xcc_id(); b_.st = (volatile LAS unsigned*)(F.lds + LC_BAR); xcd_barrier(b_); } while (0)

    for (int rep = 0; rep < REP_PRO; ++rep) { PHASE_ENV(); phase_prologue(F, P); }
    GRID_BAR();
    { PHASE_ENV(); phase_p1(F, P); }
    GRID_BAR();

    {
        constexpr int l = 0; constexpr bool last = (l == DEPTH - 1);
        for (int rep = 0; rep < REP_GEMM1; ++rep) { PHASE_ENV(); pg8::Gemm g{(const bf16_t*)(ws + WS_HBUF), (const bf16_t*)(ws + WS_WIN) + (size_t)l * INP * D, NTOK, INP, D};
          pg8::StaticOrder S; S.init(NTOK, INP, F.G, F.bid);
          pg8::EpiStoreBf16 E{(bf16_t*)(ws + WS_PBUF), INP};
          pg8::gemm_phase<pg8::EpiStoreBf16, pg8::StaticOrder>(F.lds, g, S, E, F.tid);
          const int nun = (NTOK / 256) * (INP / 256), rr = nun % F.G, first = (rr == 0) ? 0 : rr, nidle = F.G - first;
          if (F.bid >= first) for (int t = F.bid - first; t < NTOK / 256; t += nidle) {
              SkEpiBf16 SE{(bf16_t*)(ws + WS_LRB) + (size_t)t * 256 * 32, 32};
              skinny_unit(F, (const bf16_t*)(ws + WS_HBUF) + (size_t)t * 256 * D, (const bf16_t*)(ws + WS_WGT) + (size_t)l * 32 * D, SE); } }
        GRID_BAR();
        for (int rep = 0; rep < REP_G1U; ++rep) { PHASE_ENV();
        { LAS unsigned char* scr8 = F.lds + GL_WT8 + F.wave * 2176; const int gw_ = F.bid * NWAVES + F.wave, NGW_ = F.G * NWAVES; int q_ = gw_;
          constexpr int QHI = 16 * WT_I_GU;
        for (int u = F.bid; u < 2080; u += F.G) { int row0, h;
            if (u < 2048) { const int bh = u >> 8, n = u & 255; h = bh & 3; row0 = (bh >> 2) * SEQ + 64 * n; }
            else { const int q = u - 2048, bh = q >> 2, n = q & 3; h = bh & 3; row0 = NLAT + (bh >> 2) * CTXL + 64 * n; }
            const bool bgw = q_ < QHI; WtSrc ws_; float tv_[32];
            if (bgw) { ws_ = wt_decode(P, l, q_); wt_issue(ws_, F.lane, tv_); }
            gla_g1_unit(F, P, l, row0, h, u);
            if (bgw) { wt_finish(ws_, F.lane, tv_, scr8); q_ += NGW_; } }
        for (; q_ < QHI; q_ += NGW_) { WtSrc ws_ = wt_decode(P, l, q_); float tv_[32]; wt_issue(ws_, F.lane, tv_); wt_finish(ws_, F.lane, tv_, scr8); } }
        __syncthreads(); }
        for (int rep = 0; rep < REP_F1U; ++rep) { PHASE_ENV();
        for (int u = F.bid; u < 1024; u += F.G) { const int b = u >> 9, nlo = (u >> 2) & 127, h = u & 3;
            fourier_f1_unit<128, 3>(F, P, b * SEQ + nlo, 128, h, (const bf16_t*)(ws + WS_TLAT) + (size_t)nlo * 32768, b * SEQ + nlo, 1.0f); }
        }
        { PHASE_ENV();
        if (!last) for (int u = (F.bid + F.G - 32) % F.G; u < 8; u += F.G) { const int b = u >> 2, h = u & 3;
            fourier_f1_unit<256, 2>(F, P, NLAT + b * CTXL, 1, h, (const bf16_t*)(ws + WS_TCTX), NLAT + b * CTXL, 1.0f / 128.0f); }
        }
        for (int rep = 0; rep < REP_CONV; ++rep) { PHASE_ENV();
        for (int u = F.bid; u < 512 + F.G; u += F.G) {
            int rowbase = 64 * u, Ls = 64, t0 = 0;
            if (u >= 512) { const int q = (u - 512) - 40; if (last || q < 0 || q >= 8) break; rowbase = NLAT + (q >> 2) * CTXL; Ls = CTXL; t0 = 64 * (q & 3); }
            conv_unit(F, P, l, rowbase, Ls, t0); } }
        GRID_BAR();
        { PHASE_ENV(); gla_scan(F, P, l * WT_PER_LAYER + WT_I_IN + WT_I_OUT + NE * WT_I_GU, (l + 1) * WT_PER_LAYER); __syncthreads(); }
        for (int rep = 0; rep < REP_F2U; ++rep) { PHASE_ENV();
        fourier_f2_tables(F, P);
        for (int u = F.bid; u < 512; u += F.G) fourier_f2_unit(F, P, u >> 8, (u >> 1) & 127, u & 1); }
        GRID_BAR();
        for (int rep = 0; rep < REP_G3U; ++rep) { PHASE_ENV();
        { LAS unsigned char* scr8 = F.lds + GL_WT8 + F.wave * 2176; const int gw_ = F.bid * NWAVES + F.wave, NGW_ = F.G * NWAVES; int q_ = 16 * WT_I_GU + gw_;
          constexpr int QHI = NE * WT_I_GU;
        for (int u = F.bid; u < (last ? 2048 : 2080); u += F.G) { int row0, h;
            if (u < 2048) { const int bh = u >> 8, n = u & 255; h = bh & 3; row0 = (bh >> 2) * SEQ + 64 * n; }
            else { const int q = u - 2048, bh = q >> 2, n = q & 3; h = bh & 3; row0 = NLAT + (bh >> 2) * CTXL + 64 * n; }
            const bool bgw = q_ < QHI; WtSrc ws_; float tv_[32];
            if (bgw) { ws_ = wt_decode(P, l, q_); wt_issue(ws_, F.lane, tv_); }
            gla_g3_unit(F, P, l, row0, h, u);
            if (bgw) { wt_finish(ws_, F.lane, tv_, scr8); q_ += NGW_; } }
        for (; q_ < QHI; q_ += NGW_) { WtSrc ws_ = wt_decode(P, l, q_); float tv_[32]; wt_issue(ws_, F.lane, tv_); wt_finish(ws_, F.lane, tv_, scr8); } }
        __syncthreads(); }
        GRID_BAR();
        { PHASE_ENV(); const int M2 = NLAT;
          pg8::Gemm g{(const bf16_t*)(ws + WS_CAT), (const bf16_t*)(ws + WS_WOUT) + (size_t)l * D * D, M2, D, D};
          pg8::StaticOrder S; S.init(M2, D, F.G, F.bid);
          pg8::EpiResid E{(float*)(ws + WS_XRES), (l == 0) ? P.in[0] : (const float*)(ws + WS_XRES), (const float*)(ws + WS_MODF) + (size_t)l * 3 * 6144};
          pg8::gemm_phase<pg8::EpiResid, pg8::StaticOrder>(F.lds, g, S, E, F.tid);
          if (!last) for (int t = F.bid; t < 2 * 32; t += F.G) { const int pm = NLAT / 256 + (t >> 5), nt32 = t & 31;
              SkEpiResid SE{(float*)(ws + WS_XRES) + (size_t)pm * 256 * D + nt32 * 32, P.in[2] + (size_t)(pm - NLAT / 256) * 256 * D + nt32 * 32, (const float*)(ws + WS_MODF) + ((size_t)l * 3 + 2) * 6144 + 2 * 1024 + nt32 * 32};
              skinny_unit(F, (const bf16_t*)(ws + WS_CAT) + (size_t)pm * 256 * D, (const bf16_t*)(ws + WS_WOUT) + (size_t)l * D * D + (size_t)nt32 * 32 * D, SE); } }
        GRID_BAR();
        const int ntok = last ? NLAT : NTOK;
        { PHASE_ENV(); phase_route(F, P, l, ntok); }
        GRID_BAR();
        for (int rep = 0; rep < REP_GU; ++rep) { PHASE_ENV(); moe_prep(F, P, l); const volatile LAS int* TS = (const volatile LAS int*)(F.lds + LC_TS);
          pg8::MoeOrder S{8, F.G, F.bid, TS[NE], TS};
          if constexpr (F8_LAYER[l]) {
              pg8::Gemm g{(const bf16_t*)(ws + WS_HB8), (const bf16_t*)(ws + WS_WGU + (size_t)l * NE * 2048 * D * 2), 0, 2048, D / 2};
              pg8::EpiGateUp8 E{ws + WS_ACT, P.in[22] + (size_t)l * NE * 2048};
              pg8::gemm_phase_gather<pg8::EpiGateUp8, pg8::MoeOrder, true>(F.lds, g, (const int*)(ws + WS_XB), S, E, F.tid);
          } else {
              pg8::Gemm g{(const bf16_t*)(ws + WS_HBUF), (const bf16_t*)(ws + WS_WGU) + (size_t)l * NE * 2048 * D, 0, 2048, D};
              pg8::EpiGateUp E{(bf16_t*)(ws + WS_ACT), P.in[22] + (size_t)l * NE * 2048};
              pg8::gemm_phase_gather<pg8::EpiGateUp, pg8::MoeOrder>(F.lds, g, (const int*)(ws + WS_XB), S, E, F.tid); } }
        GRID_BAR();
        for (int rep = 0; rep < REP_DN; ++rep) { PHASE_ENV(); const volatile LAS int* TS = (const volatile LAS int*)(F.lds + LC_TS);
          pg8::MoeOrder S{4, F.G, F.bid, TS[NE], TS};
          if constexpr (F8_LAYER[l]) {
              pg8::Gemm g{(const bf16_t*)(ws + WS_ACT), (const bf16_t*)(ws + WS_WDN + (size_t)l * NE * D * DFF * 2), 0, D, DFF / 2};
              pg8::EpiDown8 E{ws + WS_YB, P.in[24] + (size_t)l * NE * D};
              pg8::gemm_phase<pg8::EpiDown8, pg8::MoeOrder, true, true, true>(F.lds, g, S, E, F.tid);
          } else {
              pg8::Gemm g{(const bf16_t*)(ws + WS_ACT), (const bf16_t*)(ws + WS_WDN) + (size_t)l * NE * D * DFF, 0, D, DFF};
              pg8::EpiDown E{(bf16_t*)(ws + WS_YB), P.in[24] + (size_t)l * NE * D};
              pg8::gemm_phase<pg8::EpiDown, pg8::MoeOrder>(F.lds, g, S, E, F.tid); } }
        GRID_BAR();
        { PHASE_ENV(); phase_combine(F, P, l, ntok, last); }
        if (!last) GRID_BAR();
    }
    {
        constexpr int l = 1; constexpr bool last = (l == DEPTH - 1);
        for (int rep = 0; rep < REP_GEMM1; ++rep) { PHASE_ENV(); pg8::Gemm g{(const bf16_t*)(ws + WS_HBUF), (const bf16_t*)(ws + WS_WIN) + (size_t)l * INP * D, NTOK, INP, D};
          pg8::StaticOrder S; S.init(NTOK, INP, F.G, F.bid);
          pg8::EpiStoreBf16 E{(bf16_t*)(ws + WS_PBUF), INP};
          pg8::gemm_phase<pg8::EpiStoreBf16, pg8::StaticOrder>(F.lds, g, S, E, F.tid);
          const int nun = (NTOK / 256) * (INP / 256), rr = nun % F.G, first = (rr == 0) ? 0 : rr, nidle = F.G - first;
          if (F.bid >= first) for (int t = F.bid - first; t < NTOK / 256; t += nidle) {
              SkEpiBf16 SE{(bf16_t*)(ws + WS_LRB) + (size_t)t * 256 * 32, 32};
              skinny_unit(F, (const bf16_t*)(ws + WS_HBUF) + (size_t)t * 256 * D, (const bf16_t*)(ws + WS_WGT) + (size_t)l * 32 * D, SE); } }
        GRID_BAR();
        for (int rep = 0; rep < REP_G1U; ++rep) { PHASE_ENV();
        { LAS unsigned char* scr8 = F.lds + GL_WT8 + F.wave * 2176; const int gw_ = F.bid * NWAVES + F.wave, NGW_ = F.G * NWAVES; int q_ = gw_;
          constexpr int QHI = 16 * WT_I_GU;
        for (int u = F.bid; u < 2080; u += F.G) { int row0, h;
            if (u < 2048) { const int bh = u >> 8, n = u & 255; h = bh & 3; row0 = (bh >> 2) * SEQ + 64 * n; }
            else { const int q = u - 2048, bh = q >> 2, n = q & 3; h = bh & 3; row0 = NLAT + (bh >> 2) * CTXL + 64 * n; }
            const bool bgw = q_ < QHI; WtSrc ws_; float tv_[32];
            if (bgw) { ws_ = wt_decode(P, l, q_); wt_issue(ws_, F.lane, tv_); }
            gla_g1_unit(F, P, l, row0, h, u);
            if (bgw) { wt_finish(ws_, F.lane, tv_, scr8); q_ += NGW_; } }
        for (; q_ < QHI; q_ += NGW_) { WtSrc ws_ = wt_decode(P, l, q_); float tv_[32]; wt_issue(ws_, F.lane, tv_); wt_finish(ws_, F.lane, tv_, scr8); } }
        __syncthreads(); }
        for (int rep = 0; rep < REP_F1U; ++rep) { PHASE_ENV();
        for (int u = F.bid; u < 1024; u += F.G) { const int b = u >> 9, nlo = (u >> 2) & 127, h = u & 3;
            fourier_f1_unit<128, 3>(F, P, b * SEQ + nlo, 128, h, (const bf16_t*)(ws + WS_TLAT) + (size_t)nlo * 32768, b * SEQ + nlo, 1.0f); }
        }
        { PHASE_ENV();
        if (!last) for (int u = (F.bid + F.G - 32) % F.G; u < 8; u += F.G) { const int b = u >> 2, h = u & 3;
            fourier_f1_unit<256, 2>(F, P, NLAT + b * CTXL, 1, h, (const bf16_t*)(ws + WS_TCTX), NLAT + b * CTXL, 1.0f / 128.0f); }
        }
        for (int rep = 0; rep < REP_CONV; ++rep) { PHASE_ENV();
        for (int u = F.bid; u < 512 + F.G; u += F.G) {
            int rowbase = 64 * u, Ls = 64, t0 = 0;
            if (u >= 512) { const int q = (u - 512) - 40; if (last || q < 0 || q >= 8) break; rowbase = NLAT + (q >> 2) * CTXL; Ls = CTXL; t0 = 64 * (q & 3); }
            conv_unit(F, P, l, rowbase, Ls, t0); } }
        GRID_BAR();
        { PHASE_ENV(); gla_scan(F, P, l * WT_PER_LAYER + WT_I_IN + WT_I_OUT + NE * WT_I_GU, (l + 1) * WT_PER_LAYER); __syncthreads(); }
        for (int rep = 0; rep < REP_F2U; ++rep) { PHASE_ENV();
        fourier_f2_tables(F, P);
        for (int u = F.bid; u < 512; u += F.G) fourier_f2_unit(F, P, u >> 8, (u >> 1) & 127, u & 1); }
        GRID_BAR();
        for (int rep = 0; rep < REP_G3U; ++rep) { PHASE_ENV();
        { LAS unsigned char* scr8 = F.lds + GL_WT8 + F.wave * 2176; const int gw_ = F.bid * NWAVES + F.wave, NGW_ = F.G * NWAVES; int q_ = 16 * WT_I_GU + gw_;
          constexpr int QHI = NE * WT_I_GU;
        for (int u = F.bid; u < (last ? 2048 : 2080); u += F.G) { int row0, h;
            if (u < 2048) { const int bh = u >> 8, n = u & 255; h = bh & 3; row0 = (bh >> 2) * SEQ + 64 * n; }
            else { const int q = u - 2048, bh = q >> 2, n = q & 3; h = bh & 3; row0 = NLAT + (bh >> 2) * CTXL + 64 * n; }
            const bool bgw = q_ < QHI; WtSrc ws_; float tv_[32];
            if (bgw) { ws_ = wt_decode(P, l, q_); wt_issue(ws_, F.lane, tv_); }
            gla_g3_unit(F, P, l, row0, h, u);
            if (bgw) { wt_finish(ws_, F.lane, tv_, scr8); q_ += NGW_; } }
        for (; q_ < QHI; q_ += NGW_) { WtSrc ws_ = wt_decode(P, l, q_); float tv_[32]; wt_issue(ws_, F.lane, tv_); wt_finish(ws_, F.lane, tv_, scr8); } }
        __syncthreads(); }
        GRID_BAR();
        { PHASE_ENV(); const int M2 = NLAT;
          pg8::Gemm g{(const bf16_t*)(ws + WS_CAT), (const bf16_t*)(ws + WS_WOUT) + (size_t)l * D * D, M2, D, D};
          pg8::StaticOrder S; S.init(M2, D, F.G, F.bid);
          pg8::EpiResid E{(float*)(ws + WS_XRES), (l == 0) ? P.in[0] : (const float*)(ws + WS_XRES), (const float*)(ws + WS_MODF) + (size_t)l * 3 * 6144};
          pg8::gemm_phase<pg8::EpiResid, pg8::StaticOrder>(F.lds, g, S, E, F.tid);
          if (!last) for (int t = F.bid; t < 2 * 32; t += F.G) { const int pm = NLAT / 256 + (t >> 5), nt32 = t & 31;
              SkEpiResid SE{(float*)(ws + WS_XRES) + (size_t)pm * 256 * D + nt32 * 32, P.in[2] + (size_t)(pm - NLAT / 256) * 256 * D + nt32 * 32, (const float*)(ws + WS_MODF) + ((size_t)l * 3 + 2) * 6144 + 2 * 1024 + nt32 * 32};
              skinny_unit(F, (const bf16_t*)(ws + WS_CAT) + (size_t)pm * 256 * D, (const bf16_t*)(ws + WS_WOUT) + (size_t)l * D * D + (size_t)nt32 * 32 * D, SE); } }
        GRID_BAR();
        const int ntok = last ? NLAT : NTOK;
        { PHASE_ENV(); phase_route(F, P, l, ntok); }
        GRID_BAR();
        for (int rep = 0; rep < REP_GU; ++rep) { PHASE_ENV(); moe_prep(F, P, l); const volatile LAS int* TS = (const volatile LAS int*)(F.lds + LC_TS);
          pg8::MoeOrder S{8, F.G, F.bid, TS[NE], TS};
          if constexpr (F8_LAYER[l]) {
              pg8::Gemm g{(const bf16_t*)(ws + WS_HB8), (const bf16_t*)(ws + WS_WGU + (size_t)l * NE * 2048 * D * 2), 0, 2048, D / 2};
              pg8::EpiGateUp8 E{ws + WS_ACT, P.in[22] + (size_t)l * NE * 2048};
              pg8::gemm_phase_gather<pg8::EpiGateUp8, pg8::MoeOrder, true>(F.lds, g, (const int*)(ws + WS_XB), S, E, F.tid);
          } else {
              pg8::Gemm g{(const bf16_t*)(ws + WS_HBUF), (const bf16_t*)(ws + WS_WGU) + (size_t)l * NE * 2048 * D, 0, 2048, D};
              pg8::EpiGateUp E{(bf16_t*)(ws + WS_ACT), P.in[22] + (size_t)l * NE * 2048};
              pg8::gemm_phase_gather<pg8::EpiGateUp, pg8::MoeOrder>(F.lds, g, (const int*)(ws + WS_XB), S, E, F.tid); } }
        GRID_BAR();
        for (int rep = 0; rep < REP_DN; ++rep) { PHASE_ENV(); const volatile LAS int* TS = (const volatile LAS int*)(F.lds + LC_TS);
          pg8::MoeOrder S{4, F.G, F.bid, TS[NE], TS};
          if constexpr (F8_LAYER[l]) {
              pg8::Gemm g{(const bf16_t*)(ws + WS_ACT), (const bf16_t*)(ws + WS_WDN + (size_t)l * NE * D * DFF * 2), 0, D, DFF / 2};
              pg8::EpiDown8 E{ws + WS_YB, P.in[24] + (size_t)l * NE * D};
              pg8::gemm_phase<pg8::EpiDown8, pg8::MoeOrder, true, true, true>(F.lds, g, S, E, F.tid);
          } else {
              pg8::Gemm g{(const bf16_t*)(ws + WS_ACT), (const bf16_t*)(ws + WS_WDN) + (size_t)l * NE * D * DFF, 0, D, DFF};
              pg8::EpiDown E{(bf16_t*)(ws + WS_YB), P.in[24] + (size_t)l * NE * D};
              pg8::gemm_phase<pg8::EpiDown, pg8::MoeOrder>(F.lds, g, S, E, F.tid); } }
        GRID_BAR();
        { PHASE_ENV(); phase_combine(F, P, l, ntok, last); }
        if (!last) GRID_BAR();
    }
}

extern "C" void kernel_launch(void* const* d_in, const int* in_sizes, int n_in, void* d_out, int out_size, void* d_ws, size_t ws_size, hipStream_t stream) {
    static int grid = 0;
    if (grid == 0) {
        if (n_in != 26 || ws_size < WS_END) { fprintf(stderr, "kernel_launch: unexpected n_in %d or ws_size %zu (need %zu)\n", n_in, ws_size, (size_t)WS_END); grid = -1; return; }
        int dev = 0, cus = 0, per_cu = 0;
        if (hipGetDevice(&dev) != hipSuccess || hipDeviceGetAttribute(&cus, hipDeviceAttributeMultiprocessorCount, dev) != hipSuccess) { grid = -1; return; }
        if (hipFuncSetAttribute((const void*)mega_fwd, hipFuncAttributeMaxDynamicSharedMemorySize, LDS_BYTES) != hipSuccess) { fprintf(stderr, "kernel_launch: hipFuncSetAttribute failed\n"); grid = -1; return; }
        if (hipOccupancyMaxActiveBlocksPerMultiprocessor(&per_cu, (const void*)mega_fwd, NTHREADS, LDS_BYTES) != hipSuccess || per_cu < 1) { fprintf(stderr, "kernel_launch: occupancy query says %d\n", per_cu); }
        (void)hipGetLastError();
        grid = cus;
    }
    if (grid < 0) return;
    (void)hipMemsetAsync((char*)d_ws + WS_CTL, 0, CTL_ZERO_BYTES, stream);
    Params p{};
    for (int i = 0; i < 26; ++i) p.in[i] = (const float*)d_in[i];
    p.out = (float*)d_out; p.ws = (unsigned char*)d_ws;
    hipLaunchKernelGGL(mega_fwd, dim3(grid), dim3(NTHREADS), LDS_BYTES, stream, p);
}
```

```cpp
#include <hip/hip_runtime.h>
#include <cstdio>
#include <cstdint>

#define LAS __attribute__((address_space(3)))
#define GAS __attribute__((address_space(1)))
typedef unsigned short bf16_t;
typedef short bf16x8 __attribute__((ext_vector_type(8)));
typedef float f32x4 __attribute__((ext_vector_type(4)));
typedef float f32x2 __attribute__((ext_vector_type(2)));
typedef unsigned u32x4 __attribute__((ext_vector_type(4)));
typedef unsigned u32x2 __attribute__((ext_vector_type(2)));

constexpr int D = 1024, NBATCH = 2, SEQ = 16384, NLAT = NBATCH * SEQ, CTXL = 256, NCTX = NBATCH * CTXL, NTOK = NLAT + NCTX, DEPTH = 2;
constexpr int INW = 2336, INP = 2304;
constexpr int C_FOUR = 0, C_Q = 256, C_K = 512, C_V = 768, C_R = 1280, C_CA = 1792, C_CG = 2048;
constexpr int NE = 32, TOPK = 4, DFF = 1024;
constexpr int MAXROWS = NTOK * TOPK + NE * 256;
constexpr float NORM_EPS = 1e-6f;
constexpr int NTHREADS = 512, NWAVES = 8;

constexpr size_t MiB = 1u << 20;
constexpr size_t WS_CTL = 0, CTL_ZERO_BYTES = 1 * MiB;
constexpr size_t WS_MODP = 1 * MiB;
constexpr size_t WS_MODF = 3 * MiB;
constexpr size_t WS_RW = 3 * MiB + 512 * 1024;
constexpr size_t WS_WGT = 3 * MiB + 768 * 1024;
constexpr size_t WS_CM3 = 4 * MiB;
constexpr size_t WS_TF2 = 4 * MiB + 65536;
constexpr size_t WS_TCTX = 4 * MiB + 262144;
constexpr size_t WS_TLAT = 5 * MiB;
constexpr size_t WS_WIN = 13 * MiB;
constexpr size_t WS_WOUT = 23 * MiB;
constexpr size_t WS_WGU = 27 * MiB;
constexpr size_t WS_WDN = 283 * MiB;
constexpr size_t WS_XRES = 411 * MiB;
constexpr size_t WS_HBUF = 541 * MiB;
constexpr size_t WS_PBUF = 606 * MiB;
constexpr size_t WS_CAT = 769 * MiB;
constexpr size_t WS_T2 = 834 * MiB;
constexpr size_t WS_STATE = 866 * MiB;
constexpr size_t WS_DECAY = 996 * MiB;
constexpr size_t WS_AEXP = 998 * MiB, WS_APOS = 999 * MiB, WS_APROB = 1000 * MiB, WS_ASLOT = 1001 * MiB;
constexpr size_t WS_XB8 = 1106 * MiB;
constexpr size_t WS_HB8 = 1066 * MiB;
constexpr bool F8_LAYER[2] = {true, true};
constexpr bool F8_GEMM1[2] = {false, true};
constexpr size_t WS_LRB = 1018 * MiB;
constexpr size_t WS_XB = 1002 * MiB, WS_ACT = 1278 * MiB, WS_YB = 1554 * MiB, WS_END = 1830 * MiB;
constexpr int CW_BAR = 4096, CW_CNT = 16384;

constexpr int RING_BYTES = 131072;
constexpr int AUX_OFF = RING_BYTES;
constexpr int LCTL_OFF = RING_BYTES + 8192;
constexpr int LC_BIAS = LCTL_OFF + 2048;
constexpr int LDS_BYTES = 147456;

__device__ __forceinline__ unsigned pk2(float lo, float hi) { typedef __bf16 bf2_t __attribute__((ext_vector_type(2))); typedef float fl2_t __attribute__((ext_vector_type(2))); const fl2_t v = {lo, hi}; return __builtin_bit_cast(unsigned, __builtin_convertvector(v, bf2_t)); }
__device__ __forceinline__ unsigned f2bf(float f) { return pk2(f, 0.f) & 0xffffu; }
__device__ __forceinline__ float bf2f(unsigned b) { return __builtin_bit_cast(float, b << 16); }
__device__ __forceinline__ float bflo(unsigned w) { return __builtin_bit_cast(float, w << 16); }
__device__ __forceinline__ float bfhi(unsigned w) { return __builtin_bit_cast(float, w & 0xffff0000u); }
__device__ __forceinline__ float wave_sum(float v) {
#pragma unroll
    for (int o = 1; o < 64; o <<= 1) v += __shfl_xor(v, o);
    return v;
}
__device__ __forceinline__ float wave_sum_dpp(float v) {
#define WS_ROR(n) v += __builtin_bit_cast(float, __builtin_amdgcn_update_dpp(0, __builtin_bit_cast(int, v), 0x120 + (n), 0xf, 0xf, false));
    WS_ROR(8) WS_ROR(4) WS_ROR(2) WS_ROR(1)
#undef WS_ROR
    const int vi = __builtin_bit_cast(int, v);
    const float r0 = __builtin_bit_cast(float, __builtin_amdgcn_readlane(vi, 0)), r1 = __builtin_bit_cast(float, __builtin_amdgcn_readlane(vi, 16)), r2 = __builtin_bit_cast(float, __builtin_amdgcn_readlane(vi, 32)), r3 = __builtin_bit_cast(float, __builtin_amdgcn_readlane(vi, 48));
    return (r0 + r1) + (r2 + r3);
}
__device__ __forceinline__ float sigmoidf_(float x) { return __builtin_amdgcn_rcpf(1.0f + __builtin_amdgcn_exp2f(-1.44269504089f * x)); }

#define LDS_BARRIER() do { asm volatile("s_waitcnt lgkmcnt(0)" ::: "memory"); __builtin_amdgcn_s_barrier(); asm volatile("" ::: "memory"); } while (0)

#define XB_TMO      128
#define XB_XCNT(j)  (256  + 64 * (j))
#define XB_XSUB(j)  (1280 + 64 * (j))
#define XB_XGEN(j)  (2304 + 64 * (j))
#define XB_TOP      3328
#define XB_TOPGEN   3392
#define XCD_BAR_WORDS 3456
#define XB_SPIN_CAP (1u << 22)

__device__ __forceinline__ unsigned xb_ld(unsigned* p)              { return __hip_atomic_load(p, __ATOMIC_RELAXED, __HIP_MEMORY_SCOPE_AGENT); }
__device__ __forceinline__ unsigned xb_add(unsigned* p, unsigned v) { return __hip_atomic_fetch_add(p, v, __ATOMIC_RELAXED, __HIP_MEMORY_SCOPE_AGENT); }
__device__ __forceinline__ unsigned xb_xcc_id() { return (unsigned)__builtin_amdgcn_s_getreg((3 << 11) | 20) & 0xFu; }
#define XB_SPIN(cond, bar) do { unsigned _sp = 0; while (cond) { __builtin_amdgcn_s_sleep(1); \
    if ((++_sp & 255u) == 0u) { if (xb_ld(&(bar)[XB_TMO])) break; if (_sp > XB_SPIN_CAP) { atomicAdd(&(bar)[XB_TMO], 1u); break; } } } } while (0)

struct XcdBarrier { unsigned* bar; unsigned x; volatile LAS unsigned* st; };

__device__ __forceinline__ XcdBarrier xcd_barrier_post(unsigned* bar, volatile LAS unsigned* st) {
    XcdBarrier b; b.bar = bar; b.x = xb_xcc_id(); b.st = st;
    if (threadIdx.x == 0) (void)xb_add(&bar[XB_XCNT(b.x)], 1u);
    return b;
}
__device__ __forceinline__ void xcd_barrier_complete(unsigned* bar, unsigned x, unsigned& nloc, unsigned& nx) {
    const unsigned G = gridDim.x * gridDim.y * gridDim.z;
    unsigned sum, cnt, mine, sp = 0u;
    for (;;) {
        sum = 0u; cnt = 0u; mine = 0u;
#pragma unroll
        for (unsigned j = 0; j < 16; ++j) { const unsigned c = xb_ld(&bar[XB_XCNT(j)]); sum += c; cnt += (c > 0u) ? 1u : 0u; mine = (j == x) ? c : mine; }
        if (sum == G) break;
        __builtin_amdgcn_s_sleep(1);
        if ((++sp & 255u) == 0u) { if (xb_ld(&bar[XB_TMO])) break; if (sp > XB_SPIN_CAP) { atomicAdd(&bar[XB_TMO], 1u); break; } }
    }
    nloc = mine > 0u ? mine : 1u; nx = cnt > 0u ? cnt : 1u;
}
__device__ __forceinline__ void xcd_barrier(const XcdBarrier& b) {
    asm volatile("s_waitcnt vmcnt(0)" ::: "memory");
    __syncthreads();
    if (threadIdx.x == 0) {
        unsigned* bar = b.bar;
        __builtin_amdgcn_s_waitcnt(0);
        unsigned nloc = b.st[0], nx = b.st[1];
        if (nloc == 0u) { xcd_barrier_complete(bar, b.x, nloc, nx); b.st[0] = nloc; b.st[1] = nx; }
        const unsigned old = xb_add(&bar[XB_XSUB(b.x)], 1u);
        const unsigned gen = old / nloc;
        if (old + 1u == (gen + 1u) * nloc) {
            __builtin_amdgcn_fence(__ATOMIC_RELEASE, "agent");
            asm volatile("s_waitcnt vmcnt(0)" ::: "memory");
            const unsigned og = xb_add(&bar[XB_TOP], 1u);
            const unsigned tg = og / nx;
            if (og + 1u == (tg + 1u) * nx) xb_add(&bar[XB_TOPGEN], 1u);
            else XB_SPIN(xb_ld(&bar[XB_TOPGEN]) == tg, bar);
            __builtin_amdgcn_fence(__ATOMIC_ACQUIRE, "agent");
            xb_add(&bar[XB_XGEN(b.x)], 1u);
            asm volatile("s_waitcnt vmcnt(0)" ::: "memory");
        } else {
            XB_SPIN(xb_ld(&bar[XB_XGEN(b.x)]) == gen, bar);
            __builtin_amdgcn_fence(__ATOMIC_ACQUIRE, "agent");
            asm volatile("s_waitcnt vmcnt(0)" ::: "memory");
        }
    }
    __syncthreads();
}

constexpr int PB_CHUNK = 64 * INP, PB_V = 49152, PB_CA = 114688;
__device__ __forceinline__ size_t pb_addr(int row, int col) {
    const size_t cb = (size_t)(row >> 6) * PB_CHUNK; const int tl = row & 63;
    if (col < C_V) { const int comp = col >> 8, cc = col & 255; return cb + comp * 16384 + ((cc >> 6) * 64 + tl) * 64 + (cc & 63); }
    if (col < C_CA) { const int cc = col - C_V, comp = cc >> 9, c2 = cc & 511; return cb + PB_V + comp * 32768 + ((c2 >> 7) * 64 + tl) * 128 + (c2 & 127); }
    const int cc = col - C_CA, comp = cc >> 8; return cb + PB_CA + comp * 16384 + tl * 256 + (cc & 255);
}
namespace pg8 {
constexpr int BM = 256, BK = 64, HALF = 128, HTB = HALF * BK * 2, STAGE_BYTES = 8 * HTB, NXCD = 8, WGM = 8;
__host__ __device__ __forceinline__ int lds_byte(int r, int c) { const int st = (r >> 4) * 2 + (c >> 5), rr = r & 15, cc = c & 31, ob = rr * 64 + cc * 2; return st * 1024 + (ob ^ (((ob >> 9) & 1) << 5)); }
__host__ __device__ __forceinline__ void stage_rc(int b, int& R, int& C) { const int st = b / 1024, sb = b % 1024, swz = sb ^ (((sb >> 9) & 1) << 5); R = (st >> 1) * 16 + swz / 64; C = (st & 1) * 32 + (swz % 64) / 2; }
__host__ __device__ __forceinline__ int perm32(int rho) { const int n = rho >> 4, i = rho & 15; return 8 * (i >> 2) + 4 * n + (i & 3); }

struct Unit { int pm, pn, lbase, nvalid; };
struct Gemm { const bf16_t* A; const bf16_t* Bt; int M, N, K; };

struct StaticOrder {
    int nM, nN, nwg, G, c;
    __device__ void init(int M, int N, int G_, int c_) { nM = M / BM; nN = N / BM; nwg = nM * nN; G = G_; c = c_; }
    __device__ bool next(int i, Unit& u) const {
        const long L = (long)i * G + c; if (L >= nwg) return false;
        int wgid = (int)L; { const int q = nwg / NXCD, r = nwg % NXCD, xcd = wgid % NXCD, off = wgid / NXCD; wgid = (xcd < r ? xcd * (q + 1) : r * (q + 1) + (xcd - r) * q) + off; }
        const int nig = WGM * nN, gid = wgid / nig, fm = gid * WGM, gsz = (nM - fm) < WGM ? (nM - fm) : WGM;
        u.pm = fm + ((wgid % nig) % gsz); u.pn = (wgid % nig) / gsz; u.lbase = 0; u.nvalid = 0; return true;
    }
};
struct MoeOrder {
    int nN, G, c, MT; const volatile LAS int* ts;
    __device__ bool next(int i, Unit& u) const {
        const long L = (G % 8 == 0) ? ((long)i * G + (long)(c & 7) * (G >> 3) + (c >> 3)) : ((long)i * G + c);
        if (L >= (long)MT * nN) return false;
        const int mt = (int)(L / nN), pl = (int)(L % nN);
        const int lane = threadIdx.x & 63;
        const unsigned long long bal = __ballot(lane >= 1 && lane < NE && ts[lane] <= mt);
        const int e = __popcll(bal);
        const int j = mt - ts[e];
        u.pm = mt; u.pn = e * nN + pl; u.lbase = e * NTOK + j * 256; u.nvalid = ts[64 + e] - j * 256; return true;
    }
};

__device__ __forceinline__ unsigned cvt_pk_bf16(float lo, float hi) { unsigned r; asm volatile("v_cvt_pk_bf16_f32 %0, %1, %2" : "=v"(r) : "v"(lo), "v"(hi)); return r; }

struct EpiStoreBf16 {
    static constexpr bool PERM = true; static constexpr int NST = 16; static constexpr bool BIAS_DMA = false;
    bf16_t* O; int ldc;
    __device__ __forceinline__ void operator()(const f32x4 (&acc)[2][2][4][2], const Unit& u, int wr, int wc, int fr, int fq, const LAS float* bl) const {
        const int row0 = u.pm * BM + wr * 64 + fr; const int col0 = u.pn * BM + wc * 32 + 8 * fq;
#pragma unroll
        for (int ai = 0; ai < 2; ++ai)
#pragma unroll
            for (int m = 0; m < 4; ++m) {
#pragma unroll
                for (int bj = 0; bj < 2; ++bj) { const f32x4 v0 = acc[ai][bj][m][0], v1 = acc[ai][bj][m][1];
                    u32x4 w; w.x = cvt_pk_bf16(v0[0], v0[1]); w.y = cvt_pk_bf16(v0[2], v0[3]); w.z = cvt_pk_bf16(v1[0], v1[1]); w.w = cvt_pk_bf16(v1[2], v1[3]);
                    *(u32x4*)(O + pb_addr(row0 + ai * HALF + m * 16, col0 + bj * HALF)) = w; } }
    }
};
struct EpiStoreBf16S {
    static constexpr bool PERM = true; static constexpr int NST = 16; static constexpr bool BIAS_DMA = false;
    bf16_t* O; int ldc;
    __device__ __forceinline__ void operator()(const f32x4 (&acc)[2][2][4][2], const Unit& u, int wr, int wc, int fr, int fq, const LAS float* bl) const {
        const int row0 = u.pm * BM + wr * 64 + fr; const int col0 = u.pn * BM + wc * 32 + 8 * fq;
#pragma unroll
        for (int ai = 0; ai < 2; ++ai)
#pragma unroll
            for (int m = 0; m < 4; ++m) {
#pragma unroll
                for (int bj = 0; bj < 2; ++bj) { const f32x4 v0 = acc[ai][bj][m][0] * 0.015625f, v1 = acc[ai][bj][m][1] * 0.015625f;
                    u32x4 w; w.x = cvt_pk_bf16(v0[0], v0[1]); w.y = cvt_pk_bf16(v0[2], v0[3]); w.z = cvt_pk_bf16(v1[0], v1[1]); w.w = cvt_pk_bf16(v1[2], v1[3]);
                    *(u32x4*)(O + pb_addr(row0 + ai * HALF + m * 16, col0 + bj * HALF)) = w; } }
    }
};
template <bool XS_F32>
struct EpiResid {
    static constexpr bool PERM = true; static constexpr int NST = 0; static constexpr bool BIAS_DMA = false;
    bf16_t* X; const void* Xs; const float* modf;
    __device__ __forceinline__ void operator()(const f32x4 (&acc)[2][2][4][2], const Unit& u, int wr, int wc, int fr, int fq, const LAS float* bl) const {
        const int row0 = u.pm * BM + wr * 64 + fr, col0 = u.pn * BM + wc * 32 + 8 * fq;
        const int v = (u.pm >= NLAT / BM) ? 2 : (u.pm >= SEQ / BM ? 1 : 0);
        const float* gv = modf + (size_t)v * 6144 + 2 * 1024;
        f32x4 bv[2][2];
#pragma unroll
        for (int bj = 0; bj < 2; ++bj)
#pragma unroll
            for (int n = 0; n < 2; ++n) bv[bj][n] = *(const f32x4*)(gv + col0 + bj * HALF + 4 * n);
#pragma unroll
        for (int ai = 0; ai < 2; ++ai) {
            if constexpr (XS_F32) {
                f32x4 xv[4][2][2];
#pragma unroll
                for (int m = 0; m < 4; ++m) { const float* rowp = (const float*)Xs + (size_t)(row0 + ai * HALF + m * 16) * D + col0;
#pragma unroll
                    for (int bj = 0; bj < 2; ++bj)
#pragma unroll
                        for (int n = 0; n < 2; ++n) xv[m][bj][n] = *(const f32x4*)(rowp + bj * HALF + 4 * n); }
#pragma unroll
                for (int m = 0; m < 4; ++m) { bf16_t* rowp = X + (size_t)(row0 + ai * HALF + m * 16) * D + col0;
#pragma unroll
                    for (int bj = 0; bj < 2; ++bj) { const f32x4 v0 = xv[m][bj][0] + bv[bj][0] * acc[ai][bj][m][0], v1 = xv[m][bj][1] + bv[bj][1] * acc[ai][bj][m][1];
                        u32x4 w; w.x = cvt_pk_bf16(v0[0], v0[1]); w.y = cvt_pk_bf16(v0[2], v0[3]); w.z = cvt_pk_bf16(v1[0], v1[1]); w.w = cvt_pk_bf16(v1[2], v1[3]);
                        *(u32x4*)(rowp + bj * HALF) = w; } }
            } else {
                u32x4 xv[4][2];
#pragma unroll
                for (int m = 0; m < 4; ++m) { const bf16_t* rowp = (const bf16_t*)Xs + (size_t)(row0 + ai * HALF + m * 16) * D + col0;
#pragma unroll
                    for (int bj = 0; bj < 2; ++bj) xv[m][bj] = *(const u32x4*)(rowp + bj * HALF); }
#pragma unroll
                for (int m = 0; m < 4; ++m) { bf16_t* rowp = X + (size_t)(row0 + ai * HALF + m * 16) * D + col0;
#pragma unroll
                    for (int bj = 0; bj < 2; ++bj) { const u32x4 xw = xv[m][bj];
                        const f32x4 x0 = {bflo(xw.x), bfhi(xw.x), bflo(xw.y), bfhi(xw.y)}, x1 = {bflo(xw.z), bfhi(xw.z), bflo(xw.w), bfhi(xw.w)};
                        const f32x4 v0 = x0 + bv[bj][0] * acc[ai][bj][m][0], v1 = x1 + bv[bj][1] * acc[ai][bj][m][1];
                        u32x4 w; w.x = cvt_pk_bf16(v0[0], v0[1]); w.y = cvt_pk_bf16(v0[2], v0[3]); w.z = cvt_pk_bf16(v1[0], v1[1]); w.w = cvt_pk_bf16(v1[2], v1[3]);
                        *(u32x4*)(rowp + bj * HALF) = w; } }
            }
        }
    }
};
struct EpiGateUp {
    static constexpr bool PERM = true; static constexpr int NST = 0; static constexpr bool BIAS_DMA = false;
    bf16_t* O; const float* bgu;
    __device__ __forceinline__ void operator()(const f32x4 (&acc)[2][2][4][2], const Unit& u, int wr, int wc, int fr, int fq, const LAS float* bl) const {
        const int e = u.pn >> 3, pl = u.pn & 7;
        const int row0 = u.pm * BM + wr * 64 + fr; const int cl = pl * 128 + wc * 32 + 8 * fq;
        const float* bg = bgu + (size_t)e * 2048 + cl; const float* bu = bg + 1024;
        f32x4 g0 = *(const f32x4*)bg, g1 = *(const f32x4*)(bg + 4), u0 = *(const f32x4*)bu, u1 = *(const f32x4*)(bu + 4);
#pragma unroll
        for (int ai = 0; ai < 2; ++ai)
#pragma unroll
            for (int m = 0; m < 4; ++m) { bf16_t* rowp = O + (size_t)(row0 + ai * HALF + m * 16) * DFF + cl;
                float r[8];
#pragma unroll
                for (int n = 0; n < 2; ++n) { const f32x4 gb = n ? g1 : g0, ub = n ? u1 : u0; const f32x4 ga = acc[ai][0][m][n] + gb, ua = acc[ai][1][m][n] + ub;
#pragma unroll
                    for (int j = 0; j < 4; ++j) { const float gate = fminf(ga[j], 7.0f), up = fminf(fmaxf(ua[j], -7.0f), 7.0f);
                        r[n * 4 + j] = gate * __builtin_amdgcn_rcpf(1.0f + __expf(-1.702f * gate)) * (up + 1.0f); } }
                u32x4 w; w.x = cvt_pk_bf16(r[0], r[1]); w.y = cvt_pk_bf16(r[2], r[3]); w.z = cvt_pk_bf16(r[4], r[5]); w.w = cvt_pk_bf16(r[6], r[7]);
                *(u32x4*)rowp = w; }
    }
};
struct EpiDown {
    static constexpr bool PERM = true; static constexpr int NST = 0; static constexpr bool BIAS_DMA = false;
    bf16_t* O; const float* bdn;
    __device__ __forceinline__ void operator()(const f32x4 (&acc)[2][2][4][2], const Unit& u, int wr, int wc, int fr, int fq, const LAS float* bl) const {
        const int e = u.pn >> 2, pl = u.pn & 3;
        const int row0 = u.pm * BM + wr * 64 + fr; const int col0 = pl * BM + wc * 32 + 8 * fq;
        f32x4 bv[2][2];
#pragma unroll
        for (int bj = 0; bj < 2; ++bj)
#pragma unroll
            for (int n = 0; n < 2; ++n) bv[bj][n] = *(const f32x4*)(bdn + (size_t)e * 1024 + col0 + bj * HALF + 4 * n);
#pragma unroll
        for (int ai = 0; ai < 2; ++ai)
#pragma unroll
            for (int m = 0; m < 4; ++m) { bf16_t* rowp = O + (size_t)(row0 + ai * HALF + m * 16) * D + col0;
#pragma unroll
                for (int bj = 0; bj < 2; ++bj) { const f32x4 v0 = acc[ai][bj][m][0] + bv[bj][0], v1 = acc[ai][bj][m][1] + bv[bj][1];
                    u32x4 w; w.x = cvt_pk_bf16(v0[0], v0[1]); w.y = cvt_pk_bf16(v0[2], v0[3]); w.z = cvt_pk_bf16(v1[0], v1[1]); w.w = cvt_pk_bf16(v1[2], v1[3]);
                    *(u32x4*)(rowp + bj * HALF) = w; } }
    }
};

__device__ __forceinline__ unsigned pk4_fp8(float a, float b, float c, float d) { unsigned w = 0u; w = __builtin_amdgcn_cvt_pk_fp8_f32(a, b, w, false); w = __builtin_amdgcn_cvt_pk_fp8_f32(c, d, w, true); return w; }
struct EpiGateUp8 {
    static constexpr bool PERM = true; static constexpr int NST = 8; static constexpr bool BIAS_DMA = true;
    unsigned char* O; const float* bgu;
    __device__ __forceinline__ const float* bias_src(const Unit& u, int lane) const { const int e = u.pn >> 3, pl = u.pn & 7; return bgu + (size_t)e * 2048 + (lane >> 5) * 1024 + pl * 128 + (lane & 31) * 4; }
    __device__ __forceinline__ void operator()(const f32x4 (&acc)[2][2][4][2], const Unit& u, int wr, int wc, int fr, int fq, const LAS float* bl) const {
        const int e = u.pn >> 3, pl = u.pn & 7;
        const int row0 = u.pm * BM + wr * 64 + fr; const int cl = pl * 128 + wc * 32 + 8 * fq;
        (void)e; const LAS float* bgl = bl + wc * 32 + 8 * fq;
        f32x4 g0 = *(const LAS f32x4*)bgl, g1 = *(const LAS f32x4*)(bgl + 4), u0 = *(const LAS f32x4*)(bgl + 128), u1 = *(const LAS f32x4*)(bgl + 132);
#pragma unroll
        for (int ai = 0; ai < 2; ++ai)
#pragma unroll
            for (int m = 0; m < 4; ++m) { unsigned char* rowp = O + (size_t)(row0 + ai * HALF + m * 16) * DFF + cl;
                float r[8];
#pragma unroll
                for (int n = 0; n < 2; ++n) { const f32x4 gb = n ? g1 : g0, ub = n ? u1 : u0;
                    const f32x4 ga = acc[ai][0][m][n] * 0.015625f + gb, ua = acc[ai][1][m][n] * 0.015625f + ub;
                    const f32x4 gate = __builtin_elementwise_min(ga, (f32x4){7.f, 7.f, 7.f, 7.f});
                    const f32x4 up1 = __builtin_elementwise_min(__builtin_elementwise_max(ua, (f32x4){-7.f, -7.f, -7.f, -7.f}), (f32x4){7.f, 7.f, 7.f, 7.f}) + 1.0f;
                    const f32x4 xa = gate * (-1.702f * 1.44269504089f);
                    f32x4 den; den.x = __builtin_amdgcn_exp2f(xa.x); den.y = __builtin_amdgcn_exp2f(xa.y); den.z = __builtin_amdgcn_exp2f(xa.z); den.w = __builtin_amdgcn_exp2f(xa.w);
                    den = den + 1.0f;
                    f32x4 rc; rc.x = __builtin_amdgcn_rcpf(den.x); rc.y = __builtin_amdgcn_rcpf(den.y); rc.z = __builtin_amdgcn_rcpf(den.z); rc.w = __builtin_amdgcn_rcpf(den.w);
                    const f32x4 o = (gate * rc) * up1;
                    r[n * 4 + 0] = o.x; r[n * 4 + 1] = o.y; r[n * 4 + 2] = o.z; r[n * 4 + 3] = o.w; }
                u32x2 w; w.x = pk4_fp8(r[0], r[1], r[2], r[3]); w.y = pk4_fp8(r[4], r[5], r[6], r[7]);
                *(u32x2*)rowp = w; }
    }
};
struct EpiDown8 {
    static constexpr bool PERM = true; static constexpr int NST = 16; static constexpr bool BIAS_DMA = true;
    unsigned char* O; const float* bdn;
    __device__ __forceinline__ const float* bias_src(const Unit& u, int lane) const { const int e = u.pn >> 2, pl = u.pn & 3; return bdn + (size_t)e * 1024 + pl * 256 + lane * 4; }
    __device__ __forceinline__ void operator()(const f32x4 (&acc)[2][2][4][2], const Unit& u, int wr, int wc, int fr, int fq, const LAS float* bl) const {
        const int e = u.pn >> 2, pl = u.pn & 3;
        const int row0 = u.pm * BM + wr * 64 + fr; const int col0 = pl * BM + wc * 32 + 8 * fq;
        f32x4 bv[2][2];
#pragma unroll
        for (int bj = 0; bj < 2; ++bj)
#pragma unroll
            for (int n = 0; n < 2; ++n) bv[bj][n] = *(const LAS f32x4*)(bl + wc * 32 + 8 * fq + bj * HALF + 4 * n);
#pragma unroll
        for (int ai = 0; ai < 2; ++ai)
#pragma unroll
            for (int m = 0; m < 4; ++m) { unsigned char* rowp = O + (size_t)(row0 + ai * HALF + m * 16) * D + col0;
#pragma unroll
                for (int bj = 0; bj < 2; ++bj) { const f32x4 v0 = acc[ai][bj][m][0] * 0.015625f + bv[bj][0], v1 = acc[ai][bj][m][1] * 0.015625f + bv[bj][1];
                    u32x2 w; w.x = pk4_fp8(v0[0], v0[1], v0[2], v0[3]); w.y = pk4_fp8(v1[0], v1[1], v1[2], v1[3]);
                    *(u32x2*)(rowp + bj * HALF) = w; } }
    }
};

typedef int i32x8 __attribute__((ext_vector_type(8)));
typedef int i32x4 __attribute__((ext_vector_type(4)));
__device__ __forceinline__ i32x8 cat8(const bf16x8 lo, const bf16x8 hi) { const i32x4 a = __builtin_bit_cast(i32x4, lo), b = __builtin_bit_cast(i32x4, hi); return __builtin_shufflevector(a, b, 0, 1, 2, 3, 4, 5, 6, 7); }
template <class Epi, class Sched, bool ALIGN_EPI = true, bool SP2 = true, bool F8 = false>
__device__ __forceinline__ void gemm_phase(LAS unsigned char* lds, const Gemm g, const Sched& S, const Epi& E, const int tid) {
    const int wid = __builtin_amdgcn_readfirstlane(tid >> 6), lane = tid & 63, wr = wid >> 2, wc = wid & 3, fr = lane & 15, fq = lane >> 4;
    const int K = g.K, nt = K / BK;
    unsigned voffA[2], voffB[2];
#pragma unroll
    for (int i = 0; i < 2; ++i) { int R, C; stage_rc(tid * 16 + i * 8192, R, C); const int Rb = Epi::PERM ? ((R & ~31) + perm32(R & 31)) : R;
        voffA[i] = (unsigned)(R * K + C) * 2u; voffB[i] = (unsigned)(Rb * K + C) * 2u; }
    const size_t kstep = (size_t)(BK * 2);
    const size_t hstep = (size_t)HALF * K * 2;
    const size_t tstep = 2 * hstep;
    const unsigned ldsw = (unsigned)wid * 1024u;
    const int aoff = lds_byte(wr * 64 + fr, fq * 8), boff = lds_byte(wc * 32 + fr, fq * 8);
#define PG8_SA(b, h) (((b) * 2 + (h)) * HTB)
#define PG8_SB(b, h) ((4 + (b) * 2 + (h)) * HTB)
#define PG8_STAGE(bufoff, gbase, voff) do { _Pragma("unroll") for (int _i = 0; _i < 2; ++_i) \
        __builtin_amdgcn_global_load_lds((const unsigned*)((const char*)(gbase) + (voff)[_i]), (LAS unsigned*)(lds + (bufoff) + ldsw + _i * 8192), 16, 0, 0); } while (0)
#define PG8_LDA(dst, b, h) do { _Pragma("unroll") for (int m = 0; m < 4; ++m) { if constexpr (F8) dst##8[m] = cat8(*(const LAS bf16x8*)(lds + PG8_SA(b, h) + aoff + m * 2048), *(const LAS bf16x8*)(lds + PG8_SA(b, h) + aoff + m * 2048 + 1024)); \
        else { _Pragma("unroll") for (int k = 0; k < 2; ++k) dst[m][k] = *(const LAS bf16x8*)(lds + PG8_SA(b, h) + aoff + m * 2048 + k * 1024); } } } while (0)
#define PG8_LDB(dst, b, h) do { _Pragma("unroll") for (int n = 0; n < 2; ++n) { if constexpr (F8) dst##8[n] = cat8(*(const LAS bf16x8*)(lds + PG8_SB(b, h) + boff + n * 2048), *(const LAS bf16x8*)(lds + PG8_SB(b, h) + boff + n * 2048 + 1024)); \
        else { _Pragma("unroll") for (int k = 0; k < 2; ++k) dst[n][k] = *(const LAS bf16x8*)(lds + PG8_SB(b, h) + boff + n * 2048 + k * 1024); } } } while (0)
#define PG8_MMA(ai, bj, At, Bt) do { __builtin_amdgcn_s_setprio(1); \
        if constexpr (F8) { _Pragma("unroll") for (int m = 0; m < 4; ++m) _Pragma("unroll") for (int n = 0; n < 2; ++n) \
            acc[ai][bj][m][n] = __builtin_amdgcn_mfma_scale_f32_16x16x128_f8f6f4(Bt##8[n], At##8[m], acc[ai][bj][m][n], 0, 0, 0, 0x7f7f7f7f, 0, 0x7f7f7f7f); \
            _Pragma("unroll") for (int m = 0; m < 4; ++m) _Pragma("unroll") for (int n = 0; n < 2; ++n) asm volatile("" : "+v"(acc[ai][bj][m][n])); } \
        else { _Pragma("unroll") for (int m = 0; m < 4; ++m) _Pragma("unroll") for (int n = 0; n < 2; ++n) _Pragma("unroll") for (int k = 0; k < 2; ++k) \
            acc[ai][bj][m][n] = __builtin_amdgcn_mfma_f32_16x16x32_bf16(Bt[n][k], At[m][k], acc[ai][bj][m][n], 0, 0, 0); } \
        __builtin_amdgcn_s_setprio(0); } while (0)
#define PG8_WAIT_V(n) asm volatile("s_waitcnt vmcnt(" #n ")" ::: "memory")
#define PG8_WAIT_VR(rlx) do { if constexpr (Epi::NST == 16) asm volatile("s_cmp_lg_u32 %0, 0\n\ts_cbranch_scc1 .Lrlx%=\n\ts_waitcnt vmcnt(8)\n.Lrlx%=:\n\ts_waitcnt vmcnt(24)" :: "s"(rlx) : "scc", "memory"); \
        else if constexpr (Epi::NST == 8) asm volatile("s_cmp_lg_u32 %0, 0\n\ts_cbranch_scc1 .Lrlx%=\n\ts_waitcnt vmcnt(8)\n.Lrlx%=:\n\ts_waitcnt vmcnt(16)" :: "s"(rlx) : "scc", "memory"); else PG8_WAIT_V(8); } while (0)
#define PG8_WAIT_L(n) asm volatile("s_waitcnt lgkmcnt(" #n ")" ::: "memory")
#define PG8_BAR __builtin_amdgcn_s_barrier()
#define PG8_SCHED __builtin_amdgcn_sched_barrier(0)
    Unit cur, nxt; int ui = 0;
    if (!S.next(0, cur)) return;
    f32x4 acc[2][2][4][2];
#pragma unroll
    for (int a = 0; a < 2; ++a)
#pragma unroll
        for (int b = 0; b < 2; ++b)
#pragma unroll
            for (int m = 0; m < 4; ++m)
#pragma unroll
                for (int n = 0; n < 2; ++n) acc[a][b][m][n] = (f32x4){0.f, 0.f, 0.f, 0.f};
    bf16x8 At[4][2], B0[2][2], B1[2][2]; i32x8 At8[4], B08[2], B18[2];
    const char* cA = (const char*)g.A + (size_t)cur.pm * tstep; const char* cB = (const char*)g.Bt + (size_t)cur.pn * tstep;
    if constexpr (SP2) {
        PG8_STAGE(PG8_SB(0, 0), cB, voffB); PG8_STAGE(PG8_SB(0, 1), cB + hstep, voffB); PG8_STAGE(PG8_SA(0, 0), cA, voffA); PG8_STAGE(PG8_SA(0, 1), cA + hstep, voffA);
        if (wr == 1) PG8_BAR;
        PG8_WAIT_V(2); PG8_BAR;
        PG8_STAGE(PG8_SB(1, 0), cB + kstep, voffB); PG8_STAGE(PG8_SA(1, 0), cA + kstep, voffA); PG8_STAGE(PG8_SB(1, 1), cB + hstep + kstep, voffB);
        PG8_WAIT_V(6); PG8_BAR;
    } else {
        PG8_STAGE(PG8_SB(0, 0), cB, voffB); PG8_STAGE(PG8_SA(0, 0), cA, voffA); PG8_STAGE(PG8_SB(0, 1), cB + hstep, voffB); PG8_STAGE(PG8_SA(0, 1), cA + hstep, voffA);
        if (wr == 1) PG8_BAR;
        PG8_WAIT_V(4); PG8_BAR;
        PG8_STAGE(PG8_SB(1, 0), cB + kstep, voffB); PG8_STAGE(PG8_SA(1, 0), cA + kstep, voffA); PG8_STAGE(PG8_SB(1, 1), cB + hstep + kstep, voffB);
        PG8_WAIT_V(6); PG8_BAR;
    }
    for (;;) {
        const bool has_next = S.next(ui + 1, nxt);
        if constexpr (Epi::BIAS_DMA) { if (wid == 0) __builtin_amdgcn_global_load_lds((const unsigned*)E.bias_src(cur, lane), (LAS unsigned*)(lds + LC_BIAS + (ui & 1) * 1024), 16, 0, 0); }
        const char* nA = has_next ? (const char*)g.A + (size_t)nxt.pm * tstep : cA; const char* nB = has_next ? (const char*)g.Bt + (size_t)nxt.pn * tstep : cB;
        for (int t = 0; t < nt; t += 2) {
            const bool last = (t == nt - 2);
            const int rlx = __builtin_amdgcn_readfirstlane(((t == 0) && (ui > 0)) ? 1 : 0);
            const char* a1 = cA + (size_t)(t + 1) * kstep;
            const char* a2 = last ? nA : cA + (size_t)(t + 2) * kstep; const char* b2 = last ? nB : cB + (size_t)(t + 2) * kstep;
            const char* a3 = a2 + kstep; const char* b3 = b2 + kstep;
            if constexpr (SP2) {
            PG8_LDB(B0, 0, 0); PG8_LDB(B1, 0, 1); PG8_SCHED; PG8_LDA(At, 0, 0); PG8_STAGE(PG8_SA(1, 1), a1 + hstep, voffA);
            PG8_WAIT_VR(rlx); PG8_WAIT_L(0); PG8_BAR; PG8_MMA(0, 0, At, B0); PG8_MMA(0, 1, At, B1); PG8_BAR; PG8_SCHED;
            PG8_LDA(At, 0, 1); PG8_STAGE(PG8_SB(0, 0), b2, voffB); PG8_STAGE(PG8_SB(0, 1), b2 + hstep, voffB); PG8_STAGE(PG8_SA(0, 0), a2, voffA);
            PG8_WAIT_VR(rlx); PG8_WAIT_L(0); PG8_BAR; PG8_MMA(1, 0, At, B0); PG8_MMA(1, 1, At, B1); PG8_BAR; PG8_SCHED;
            PG8_LDB(B0, 1, 0); PG8_LDB(B1, 1, 1); PG8_SCHED; PG8_LDA(At, 1, 0); PG8_STAGE(PG8_SA(0, 1), a2 + hstep, voffA);
            PG8_WAIT_V(8); PG8_WAIT_L(0); PG8_BAR; PG8_MMA(0, 0, At, B0); PG8_MMA(0, 1, At, B1); PG8_BAR; PG8_SCHED;
            PG8_LDA(At, 1, 1); PG8_STAGE(PG8_SB(1, 0), b3, voffB); PG8_STAGE(PG8_SB(1, 1), b3 + hstep, voffB); PG8_STAGE(PG8_SA(1, 0), a3, voffA);
            PG8_WAIT_V(8); PG8_WAIT_L(0); PG8_BAR; PG8_MMA(1, 0, At, B0); PG8_MMA(1, 1, At, B1); PG8_BAR; PG8_SCHED;
            } else {
            PG8_LDB(B0, 0, 0); PG8_SCHED; PG8_LDA(At, 0, 0); PG8_STAGE(PG8_SA(1, 1), a1 + hstep, voffA);
            PG8_WAIT_L(8); PG8_BAR; PG8_WAIT_L(0); PG8_MMA(0, 0, At, B0); PG8_BAR; PG8_SCHED;
            PG8_LDB(B1, 0, 1); PG8_STAGE(PG8_SB(0, 0), b2, voffB);
            PG8_BAR; PG8_WAIT_L(0); PG8_MMA(0, 1, At, B1); PG8_BAR;
            PG8_LDA(At, 0, 1); PG8_STAGE(PG8_SA(0, 0), a2, voffA);
            PG8_BAR; PG8_WAIT_L(0); PG8_MMA(1, 0, At, B0); PG8_BAR; PG8_SCHED;
            PG8_STAGE(PG8_SB(0, 1), b2 + hstep, voffB);
            PG8_WAIT_V(6); PG8_BAR; PG8_MMA(1, 1, At, B1); PG8_BAR;
            PG8_LDB(B0, 1, 0); PG8_SCHED; PG8_LDA(At, 1, 0); PG8_STAGE(PG8_SA(0, 1), a2 + hstep, voffA);
            PG8_WAIT_L(8); PG8_BAR; PG8_WAIT_L(0); PG8_MMA(0, 0, At, B0); PG8_BAR; PG8_SCHED;
            PG8_LDB(B1, 1, 1); PG8_STAGE(PG8_SB(1, 0), b3, voffB);
            PG8_BAR; PG8_WAIT_L(0); PG8_MMA(0, 1, At, B1); PG8_BAR;
            PG8_LDA(At, 1, 1); PG8_STAGE(PG8_SA(1, 0), a3, voffA);
            PG8_BAR; PG8_WAIT_L(0); PG8_MMA(1, 0, At, B0); PG8_BAR; PG8_SCHED;
            PG8_STAGE(PG8_SB(1, 1), b3 + hstep, voffB);
            PG8_WAIT_V(6); PG8_BAR; PG8_MMA(1, 1, At, B1); PG8_BAR;
            }
        }
        if constexpr (ALIGN_EPI) { if (wr == 0) PG8_BAR; }
        E(acc, cur, wr, wc, fr, fq, (const LAS float*)(lds + LC_BIAS + (ui & 1) * 1024));
        if (!has_next) break;
#pragma unroll
        for (int a = 0; a < 2; ++a)
#pragma unroll
            for (int b = 0; b < 2; ++b)
#pragma unroll
                for (int m = 0; m < 4; ++m)
#pragma unroll
                    for (int n = 0; n < 2; ++n) acc[a][b][m][n] = (f32x4){0.f, 0.f, 0.f, 0.f};
        cur = nxt; cA = nA; cB = nB; ++ui;
        if constexpr (ALIGN_EPI) { if (wr == 1) PG8_BAR; }
    }
    PG8_WAIT_V(0);
    if constexpr (!ALIGN_EPI) { if (wr == 0) PG8_BAR; }
    PG8_BAR;
#undef PG8_SA
#undef PG8_SB
#undef PG8_STAGE
#undef PG8_LDA
#undef PG8_LDB
#undef PG8_MMA
#undef PG8_WAIT_V
#undef PG8_WAIT_VR
#undef PG8_WAIT_L
#undef PG8_BAR
#undef PG8_SCHED
}

template <class Epi, class Sched, bool F8 = false>
__device__ __forceinline__ void gemm_phase_gather(LAS unsigned char* lds, const Gemm g, const int* list, const Sched& S, const Epi& E, const int tid) {
    const int wid = __builtin_amdgcn_readfirstlane(tid >> 6), lane = tid & 63, wr = wid >> 2, wc = wid & 3, fr = lane & 15, fq = lane >> 4;
    const int K = g.K, nt = K / BK;
    unsigned voffB0, cA2;
    { int R, C; stage_rc(tid * 16, R, C); const int Rb = Epi::PERM ? ((R & ~31) + perm32(R & 31)) : R; cA2 = (unsigned)C * 2u; voffB0 = (unsigned)(Rb * K + C) * 2u; }
    const unsigned voffB[2] = {voffB0, voffB0 + (unsigned)(64 * K * 2)};
    const size_t kstep = (size_t)(BK * 2);
    const size_t hstep = (size_t)HALF * K * 2;
    const size_t tstep = 2 * hstep;
    const unsigned ldsw = (unsigned)wid * 1024u;
    const int aoff = lds_byte(wr * 64 + fr, fq * 8), boff = lds_byte(wc * 32 + fr, fq * 8);
#define PG8_SA(b, h) (((b) * 2 + (h)) * HTB)
#define PG8_SB(b, h) ((4 + (b) * 2 + (h)) * HTB)
#define PG8_STAGE(bufoff, gbase, voff) do { _Pragma("unroll") for (int _i = 0; _i < 2; ++_i) \
        __builtin_amdgcn_global_load_lds((const unsigned*)((const char*)(gbase) + (voff)[_i]), (LAS unsigned*)(lds + (bufoff) + ldsw + _i * 8192), 16, 0, 0); } while (0)
#define PG8_LDA(dst, b, h) do { _Pragma("unroll") for (int m = 0; m < 4; ++m) { if constexpr (F8) dst##8[m] = cat8(*(const LAS bf16x8*)(lds + PG8_SA(b, h) + aoff + m * 2048), *(const LAS bf16x8*)(lds + PG8_SA(b, h) + aoff + m * 2048 + 1024)); \
        else { _Pragma("unroll") for (int k = 0; k < 2; ++k) dst[m][k] = *(const LAS bf16x8*)(lds + PG8_SA(b, h) + aoff + m * 2048 + k * 1024); } } } while (0)
#define PG8_LDB(dst, b, h) do { _Pragma("unroll") for (int n = 0; n < 2; ++n) { if constexpr (F8) dst##8[n] = cat8(*(const LAS bf16x8*)(lds + PG8_SB(b, h) + boff + n * 2048), *(const LAS bf16x8*)(lds + PG8_SB(b, h) + boff + n * 2048 + 1024)); \
        else { _Pragma("unroll") for (int k = 0; k < 2; ++k) dst[n][k] = *(const LAS bf16x8*)(lds + PG8_SB(b, h) + boff + n * 2048 + k * 1024); } } } while (0)
#define PG8_MMA(ai, bj, At, Bt) do { __builtin_amdgcn_s_setprio(1); \
        if constexpr (F8) { _Pragma("unroll") for (int m = 0; m < 4; ++m) _Pragma("unroll") for (int n = 0; n < 2; ++n) \
            acc[ai][bj][m][n] = __builtin_amdgcn_mfma_scale_f32_16x16x128_f8f6f4(Bt##8[n], At##8[m], acc[ai][bj][m][n], 0, 0, 0, 0x7f7f7f7f, 0, 0x7f7f7f7f); \
            asm volatile("" : "+v"(acc[ai][bj][0][0]), "+v"(acc[ai][bj][0][1]), "+v"(acc[ai][bj][1][0]), "+v"(acc[ai][bj][1][1]), "+v"(acc[ai][bj][2][0]), "+v"(acc[ai][bj][2][1]), "+v"(acc[ai][bj][3][0]), "+v"(acc[ai][bj][3][1])); } \
        else { _Pragma("unroll") for (int m = 0; m < 4; ++m) _Pragma("unroll") for (int n = 0; n < 2; ++n) _Pragma("unroll") for (int k = 0; k < 2; ++k) \
            acc[ai][bj][m][n] = __builtin_amdgcn_mfma_f32_16x16x32_bf16(Bt[n][k], At[m][k], acc[ai][bj][m][n], 0, 0, 0); } \
        __builtin_amdgcn_s_setprio(0); } while (0)
#define PG8_WAIT_V(n) asm volatile("s_waitcnt vmcnt(" #n ")" ::: "memory")
#define PG8_WAIT_VR(rlx) do { if constexpr (Epi::NST == 16) asm volatile("v_cmp_ne_u32_e32 vcc, 0, %0\n\ts_cbranch_vccnz .Lrlx%=\n\ts_waitcnt vmcnt(8)\n.Lrlx%=:\n\ts_waitcnt vmcnt(24)" :: "v"(rlx) : "vcc", "memory"); \
        else if constexpr (Epi::NST == 8) asm volatile("v_cmp_ne_u32_e32 vcc, 0, %0\n\ts_cbranch_vccnz .Lrlx%=\n\ts_waitcnt vmcnt(8)\n.Lrlx%=:\n\ts_waitcnt vmcnt(16)" :: "v"(rlx) : "vcc", "memory"); else PG8_WAIT_V(8); } while (0)
#define PG8_WAIT_L(n) asm volatile("s_waitcnt lgkmcnt(" #n ")" ::: "memory")
#define PG8_BAR __builtin_amdgcn_s_barrier()
#define PG8_SCHED __builtin_amdgcn_sched_barrier(0)
#define PG8_TOKIDX(u, r) ((u).lbase + ((r) < (u).nvalid - 1 ? (r) : (u).nvalid - 1))
#define PG8_LOADTOK(u, vo) do { int _ra0, _ra1, _c; stage_rc(tid * 16, _ra0, _c); stage_rc(tid * 16 + 8192, _ra1, _c); _Pragma("unroll") for (int _h = 0; _h < 2; ++_h) { \
        const unsigned _t0 = (unsigned)list[PG8_TOKIDX(u, _h * HALF + _ra0)], _t1 = (unsigned)list[PG8_TOKIDX(u, _h * HALF + _ra1)]; (vo)[_h] = _t0 | (_t1 << 16); } } while (0)
#define PG8_TOKSLOT(k) (lds + AUX_OFF + (unsigned)wid * 1024u + (k) * 256)
#define PG8_LOADTOK_DMA(u) do { int _ra0, _ra1, _c; stage_rc(tid * 16, _ra0, _c); stage_rc(tid * 16 + 8192, _ra1, _c); _Pragma("unroll") for (int _h = 0; _h < 2; ++_h) { \
        __builtin_amdgcn_global_load_lds((const unsigned*)(list + PG8_TOKIDX(u, _h * HALF + _ra0)), (LAS unsigned*)PG8_TOKSLOT(2 * _h), 4, 0, 0); \
        __builtin_amdgcn_global_load_lds((const unsigned*)(list + PG8_TOKIDX(u, _h * HALF + _ra1)), (LAS unsigned*)PG8_TOKSLOT(2 * _h + 1), 4, 0, 0); } } while (0)
#define PG8_READTOK(vo) do { _Pragma("unroll") for (int _h = 0; _h < 2; ++_h) { const unsigned _t0 = *(const LAS unsigned*)(PG8_TOKSLOT(2 * _h) + lane * 4), _t1 = *(const LAS unsigned*)(PG8_TOKSLOT(2 * _h + 1) + lane * 4); (vo)[_h] = _t0 | (_t1 << 16); } } while (0)
#define PG8_STAGE_A(bufoff, gbase, pk) do { _Pragma("unroll") for (int _i = 0; _i < 2; ++_i) { const unsigned _off = (((pk) >> (16 * _i)) & 0xffffu) * (unsigned)(K * 2) + cA2; \
        __builtin_amdgcn_global_load_lds((const unsigned*)((const char*)(gbase) + _off), (LAS unsigned*)(lds + (bufoff) + ldsw + _i * 8192), 16, 0, 0); } } while (0)
    Unit cur, nxt; int ui = 0;
    if (!S.next(0, cur)) return;
    f32x4 acc[2][2][4][2];
#pragma unroll
    for (int a = 0; a < 2; ++a)
#pragma unroll
        for (int b = 0; b < 2; ++b)
#pragma unroll
            for (int m = 0; m < 4; ++m)
#pragma unroll
                for (int n = 0; n < 2; ++n) acc[a][b][m][n] = (f32x4){0.f, 0.f, 0.f, 0.f};
    bf16x8 At[4][2], B0[2][2], B1[2][2]; i32x8 At8[4], B08[2], B18[2];
    unsigned vc[2];
    PG8_LOADTOK(cur, vc);
    const char* gA = (const char*)g.A; const char* cB = (const char*)g.Bt + (size_t)cur.pn * tstep;
    PG8_STAGE(PG8_SB(0, 0), cB, voffB); PG8_STAGE(PG8_SB(0, 1), cB + hstep, voffB); PG8_STAGE_A(PG8_SA(0, 0), gA, vc[0]); PG8_STAGE_A(PG8_SA(0, 1), gA, vc[1]);
    if (wr == 1) PG8_BAR;
    PG8_WAIT_V(2); PG8_BAR;
    PG8_STAGE(PG8_SB(1, 0), cB + kstep, voffB); PG8_STAGE_A(PG8_SA(1, 0), gA + kstep, vc[0]); PG8_STAGE(PG8_SB(1, 1), cB + hstep + kstep, voffB);
    PG8_WAIT_V(6); PG8_BAR;
    for (;;) {
        const bool has_next = S.next(ui + 1, nxt);
        if constexpr (Epi::BIAS_DMA) { if (wid == 0) __builtin_amdgcn_global_load_lds((const unsigned*)E.bias_src(cur, lane), (LAS unsigned*)(lds + LC_BIAS + (ui & 1) * 1024), 16, 0, 0); }
        { const Unit& lu_ = has_next ? nxt : cur; PG8_LOADTOK_DMA(lu_); }
        const char* nB = has_next ? (const char*)g.Bt + (size_t)nxt.pn * tstep : cB;
        for (int t = 0; t < nt; t += 2) {
            const bool last = (t == nt - 2);
            const int rlx = ((t == 0) && (ui > 0)) ? 1 : 0;
            const char* a1 = gA + (size_t)(t + 1) * kstep;
            const char* b2 = last ? nB : cB + (size_t)(t + 2) * kstep; const char* b3 = b2 + kstep;
            const char* a2 = last ? gA : gA + (size_t)(t + 2) * kstep; const char* a3 = a2 + kstep;
            PG8_LDB(B0, 0, 0); PG8_LDB(B1, 0, 1); PG8_SCHED; PG8_LDA(At, 0, 0); PG8_STAGE_A(PG8_SA(1, 1), a1, vc[1]);
            if (last && has_next) {
                PG8_READTOK(vc); }
            PG8_WAIT_VR(rlx); PG8_WAIT_L(0); PG8_BAR; PG8_MMA(0, 0, At, B0); PG8_MMA(0, 1, At, B1); PG8_BAR; PG8_SCHED;
            PG8_LDA(At, 0, 1); PG8_STAGE(PG8_SB(0, 0), b2, voffB); PG8_STAGE(PG8_SB(0, 1), b2 + hstep, voffB); PG8_STAGE_A(PG8_SA(0, 0), a2, vc[0]);
            PG8_WAIT_VR(rlx); PG8_WAIT_L(0); PG8_BAR; PG8_MMA(1, 0, At, B0); PG8_MMA(1, 1, At, B1); PG8_BAR; PG8_SCHED;
            PG8_LDB(B0, 1, 0); PG8_LDB(B1, 1, 1); PG8_SCHED; PG8_LDA(At, 1, 0); PG8_STAGE_A(PG8_SA(0, 1), a2, vc[1]);
            PG8_WAIT_V(8); PG8_WAIT_L(0); PG8_BAR; PG8_MMA(0, 0, At, B0); PG8_MMA(0, 1, At, B1); PG8_BAR; PG8_SCHED;
            PG8_LDA(At, 1, 1); PG8_STAGE(PG8_SB(1, 0), b3, voffB); PG8_STAGE(PG8_SB(1, 1), b3 + hstep, voffB); PG8_STAGE_A(PG8_SA(1, 0), a3, vc[0]);
            PG8_WAIT_V(8); PG8_WAIT_L(0); PG8_BAR; PG8_MMA(1, 0, At, B0); PG8_MMA(1, 1, At, B1); PG8_BAR; PG8_SCHED;
        }
        if (wr == 0) PG8_BAR;
        E(acc, cur, wr, wc, fr, fq, (const LAS float*)(lds + LC_BIAS + (ui & 1) * 1024));
        if (!has_next) break;
#pragma unroll
        for (int a = 0; a < 2; ++a)
#pragma unroll
            for (int b = 0; b < 2; ++b)
#pragma unroll
                for (int m = 0; m < 4; ++m)
#pragma unroll
                    for (int n = 0; n < 2; ++n) acc[a][b][m][n] = (f32x4){0.f, 0.f, 0.f, 0.f};
        cur = nxt; cB = nB; ++ui;
        if (wr == 1) PG8_BAR;
    }
    PG8_WAIT_V(0);
    PG8_BAR;
#undef PG8_SA
#undef PG8_SB
#undef PG8_STAGE
#undef PG8_LDA
#undef PG8_LDB
#undef PG8_MMA
#undef PG8_WAIT_V
#undef PG8_WAIT_VR
#undef PG8_WAIT_L
#undef PG8_BAR
#undef PG8_SCHED
#undef PG8_STAGE_A
#undef PG8_LOADTOK
#undef PG8_LOADTOK_DMA
#undef PG8_READTOK
#undef PG8_TOKSLOT
#undef PG8_TOKIDX
}
}

struct Params {
    const float* in[26];
    float* out;
    unsigned char* ws;
};
struct Frame {
    LAS unsigned char* lds;
    int tid, lane, wave, G, bid;
};

template <int MT, int NT>
__device__ __forceinline__ void mma_nt(f32x4 (&acc)[MT][NT], const LAS bf16_t* A, int lda, const LAS bf16_t* B, int ldb, int K, int fr, int fq) {
    for (int k0 = 0; k0 < K; k0 += 32) {
        bf16x8 a[MT], b[NT];
#pragma unroll
        for (int m = 0; m < MT; ++m) a[m] = *(const LAS bf16x8*)(A + (m * 16 + fr) * lda + k0 + fq * 8);
#pragma unroll
        for (int n = 0; n < NT; ++n) b[n] = *(const LAS bf16x8*)(B + (n * 16 + fr) * ldb + k0 + fq * 8);
#pragma unroll
        for (int m = 0; m < MT; ++m)
#pragma unroll
            for (int n = 0; n < NT; ++n) acc[m][n] = __builtin_amdgcn_mfma_f32_16x16x32_bf16(a[m], b[n], acc[m][n], 0, 0, 0);
    }
}
template <int MT, int NT> __device__ __forceinline__ void zero_acc(f32x4 (&acc)[MT][NT]) {
#pragma unroll
    for (int m = 0; m < MT; ++m)
#pragma unroll
        for (int n = 0; n < NT; ++n) acc[m][n] = (f32x4){0.f, 0.f, 0.f, 0.f};
}

constexpr int SK_A = 0, SK_B = 69632;
template <class Epi>
__device__ __forceinline__ void skinny_unit(const Frame& F, const bf16_t* A, const bf16_t* Bt, const Epi& E) {
    LAS bf16_t* As = (LAS bf16_t*)(F.lds + SK_A); LAS bf16_t* Bs = (LAS bf16_t*)(F.lds + SK_B);
    const int tid = F.tid, fr = F.lane & 15, fq = F.lane >> 4, w = F.wave;
    f32x4 acc[2][2]; zero_acc<2, 2>(acc);
    u32x4 av[8], bv;
#pragma unroll
    for (int i = 0; i < 8; ++i) { const int ch = tid + NTHREADS * i, r = ch >> 4, c8 = (ch & 15) * 8; av[i] = *(const u32x4*)(A + (size_t)r * D + c8); }
    { const int r = tid >> 4, c8 = (tid & 15) * 8; bv = *(const u32x4*)(Bt + (size_t)r * D + c8); }
    for (int kc = 0; kc < 8; ++kc) {
        LDS_BARRIER();
#pragma unroll
        for (int i = 0; i < 8; ++i) { const int ch = tid + NTHREADS * i, r = ch >> 4, c8 = (ch & 15) * 8; *(LAS u32x4*)(As + r * 136 + c8) = av[i]; }
        { const int r = tid >> 4, c8 = (tid & 15) * 8; *(LAS u32x4*)(Bs + r * 136 + c8) = bv; }
        if (kc + 1 < 8) {
#pragma unroll
            for (int i = 0; i < 8; ++i) { const int ch = tid + NTHREADS * i, r = ch >> 4, c8 = (ch & 15) * 8; av[i] = *(const u32x4*)(A + (size_t)r * D + (kc + 1) * 128 + c8); }
            { const int r = tid >> 4, c8 = (tid & 15) * 8; bv = *(const u32x4*)(Bt + (size_t)r * D + (kc + 1) * 128 + c8); } }
        LDS_BARRIER();
        mma_nt<2, 2>(acc, As + (32 * w) * 136, 136, Bs, 136, 128, fr, fq);
    }
#pragma unroll
    for (int mt = 0; mt < 2; ++mt)
#pragma unroll
        for (int nt = 0; nt < 2; ++nt)
#pragma unroll
            for (int j = 0; j < 4; ++j) E(32 * w + mt * 16 + fq * 4 + j, nt * 16 + fr, acc[mt][nt][j]);
    LDS_BARRIER();
}
struct SkEpiBf16 { bf16_t* O; int ldc; __device__ __forceinline__ void operator()(int r, int c, float v) const { O[(size_t)r * ldc + c] = (bf16_t)f2bf(v); } };
struct SkEpiResid { bf16_t* X; const float* Xs; const float* gate; __device__ __forceinline__ void operator()(int r, int c, float v) const { X[(size_t)r * D + c] = (bf16_t)f2bf(Xs[(size_t)r * D + c] + gate[c] * v); } };

__device__ __forceinline__ void p0_transpose_item(const float* W, int K, int N, bf16_t* WT, int k0, int n0, int orow0, LAS float* scr, int lane) {
    float tv[32];
#pragma unroll
    for (int i = 0; i < 32; ++i) { const int kk = 2 * i + (lane >> 5); tv[i] = W[(size_t)(k0 + kk) * N + n0 + (lane & 31)]; }
#pragma unroll
    for (int i = 0; i < 32; ++i) { const int kk = 2 * i + (lane >> 5); scr[kk * 33 + (lane & 31)] = tv[i]; }
    asm volatile("s_waitcnt lgkmcnt(0)" ::: "memory");
    const int c = lane & 7;
#pragma unroll
    for (int j = 0; j < 4; ++j) { const int n = (lane >> 3) + 8 * j; const LAS float* s = scr + (8 * c) * 33 + n;
        u32x4 o; o.x = pk2(s[0 * 33], s[1 * 33]); o.y = pk2(s[2 * 33], s[3 * 33]); o.z = pk2(s[4 * 33], s[5 * 33]); o.w = pk2(s[6 * 33], s[7 * 33]);
        *(u32x4*)(WT + (size_t)(orow0 + n) * K + k0 + 8 * c) = o; }
    asm volatile("s_waitcnt lgkmcnt(0)" ::: "memory");
}

using pg8::pk4_fp8; using pg8::i32x4;
struct WtSrc { const float* W; int N, k0, n0; unsigned char* dst; };
__device__ __forceinline__ void wt_issue(const WtSrc& r, int lane, float (&tv)[32]) {
#pragma unroll
    for (int i = 0; i < 8; ++i) { const f32x4 v = *(const f32x4*)(r.W + (size_t)(r.k0 + 8 * (lane >> 3) + i) * r.N + r.n0 + 4 * (lane & 7)); tv[4 * i] = v.x; tv[4 * i + 1] = v.y; tv[4 * i + 2] = v.z; tv[4 * i + 3] = v.w; }
}
__device__ __forceinline__ void wt_finish(const WtSrc& r, int lane, const float (&tv)[32], LAS unsigned char* scr8) {
    const int kq = lane >> 3, n4 = lane & 7;
#pragma unroll
    for (int c = 0; c < 4; ++c) { u32x2 o;
        o.x = pk4_fp8(64.f * tv[0 * 4 + c], 64.f * tv[1 * 4 + c], 64.f * tv[2 * 4 + c], 64.f * tv[3 * 4 + c]); o.y = pk4_fp8(64.f * tv[4 * 4 + c], 64.f * tv[5 * 4 + c], 64.f * tv[6 * 4 + c], 64.f * tv[7 * 4 + c]);
        *(LAS u32x2*)(scr8 + (4 * n4 + c) * 72 + 8 * kq) = o; }
    asm volatile("s_waitcnt lgkmcnt(0)" ::: "memory");
#pragma unroll
    for (int c2 = 0; c2 < 2; ++c2) { const int c = lane + 64 * c2, nn = c >> 2, k16 = (c & 3) * 16; const LAS unsigned* sp = (const LAS unsigned*)(scr8 + nn * 72 + k16);
        u32x4 o; o.x = sp[0]; o.y = sp[1]; o.z = sp[2]; o.w = sp[3];
        *(u32x4*)(r.dst + (size_t)nn * 1024 + k16) = o; }
    asm volatile("s_waitcnt lgkmcnt(0)" ::: "memory");
}

__device__ __forceinline__ void p0_transpose_item8(const float* W, int K, int N, unsigned char* WT8, int k0, int n0, int orow0, LAS float* scr, int lane) {
    WtSrc r; r.W = W; r.N = N; r.k0 = k0; r.n0 = n0; r.dst = WT8 + (size_t)orow0 * K + k0;
    float tv[32]; wt_issue(r, lane, tv); wt_finish(r, lane, tv, (LAS unsigned char*)scr);
}
constexpr int WT_I_IN = 16 * 73, WT_I_OUT = 16 * 32, WT_I_GU = 16 * 64, WT_I_DN = 16 * 32;
constexpr int WT_PER_LAYER = WT_I_IN + WT_I_OUT + NE * WT_I_GU + NE * WT_I_DN;
constexpr int WT_DEF0_LO = WT_PER_LAYER + WT_I_IN + WT_I_OUT + NE * WT_I_GU, WT_DEF0_HI = 2 * WT_PER_LAYER;
constexpr int WT_DEF1_LO = WT_PER_LAYER + WT_I_IN + WT_I_OUT, WT_DEF1_HI = WT_DEF1_LO + 16 * WT_I_GU;
__device__ __forceinline__ void weight_item(const Params& P, int it, LAS float* scr, int lane) {
    unsigned char* ws = P.ws;
    const int l = it / WT_PER_LAYER; int r = it % WT_PER_LAYER;
    if (r < WT_I_IN) { const int kb = r / 73, nb = r % 73;
        if (nb == 56) p0_transpose_item(P.in[8] + (size_t)l * D * INW, D, INW, (bf16_t*)(ws + WS_WGT) + (size_t)l * 32 * D, 64 * kb, 32 * nb, 0, scr, lane);
        else if (F8_GEMM1[l]) p0_transpose_item8(P.in[8] + (size_t)l * D * INW, D, INW, ws + WS_WIN + (size_t)l * INP * D * 2, 64 * kb, 32 * nb, nb < 56 ? 32 * nb : 32 * (nb - 1), scr, lane);
        else p0_transpose_item(P.in[8] + (size_t)l * D * INW, D, INW, (bf16_t*)(ws + WS_WIN) + (size_t)l * INP * D, 64 * kb, 32 * nb, nb < 56 ? 32 * nb : 32 * (nb - 1), scr, lane);
        return; }
    r -= WT_I_IN;
    if (r < WT_I_OUT) { const int kb = r / 32, nb = r % 32;
        p0_transpose_item(P.in[18] + (size_t)l * D * D, D, D, (bf16_t*)(ws + WS_WOUT) + (size_t)l * D * D, 64 * kb, 32 * nb, 32 * nb, scr, lane); return; }
    r -= WT_I_OUT;
    if (r < NE * WT_I_GU) { const int e = r / WT_I_GU, q = r % WT_I_GU, kb = q / 64, nb = q % 64; const int n0 = 32 * nb;
        const int j = n0 & 1023, orow = 256 * (j >> 7) + (n0 >= 1024 ? 128 : 0) + (j & 127);
        if (F8_LAYER[l]) p0_transpose_item8(P.in[21] + ((size_t)l * NE + e) * D * 2048, D, 2048, ws + WS_WGU + (size_t)l * NE * 2048 * D * 2 + (size_t)e * 2048 * D, 64 * kb, n0, orow, scr, lane);
        else p0_transpose_item(P.in[21] + ((size_t)l * NE + e) * D * 2048, D, 2048, (bf16_t*)(ws + WS_WGU) + ((size_t)l * NE + e) * 2048 * D, 64 * kb, n0, orow, scr, lane);
        return; }
    r -= NE * WT_I_GU;
    { const int e = r / WT_I_DN, q = r % WT_I_DN, kb = q / 32, nb = q % 32;
        if (F8_LAYER[l]) p0_transpose_item8(P.in[23] + ((size_t)l * NE + e) * DFF * D, DFF, D, ws + WS_WDN + (size_t)l * NE * D * DFF * 2 + (size_t)e * D * DFF, 64 * kb, 32 * nb, 32 * nb, scr, lane);
        else p0_transpose_item(P.in[23] + ((size_t)l * NE + e) * DFF * D, DFF, D, (bf16_t*)(ws + WS_WDN) + ((size_t)l * NE + e) * D * DFF, 64 * kb, 32 * nb, 32 * nb, scr, lane); }
}

constexpr int WT_EXP_ITEMS = NE * WT_I_GU + NE * WT_I_DN;
constexpr int GL_WT8 = 115200;
__device__ __forceinline__ WtSrc wt_decode(const Params& P, int l, int q) {
    unsigned char* ws = P.ws; WtSrc r;
    if (q < NE * WT_I_GU) { const int e = q / WT_I_GU, t = q % WT_I_GU, kb = t / 64, nb = t % 64; const int n0 = 32 * nb; const int j = n0 & 1023, orow = 256 * (j >> 7) + (n0 >= 1024 ? 128 : 0) + (j & 127);
        r.W = P.in[21] + ((size_t)l * NE + e) * D * 2048; r.N = 2048; r.k0 = 64 * kb; r.n0 = n0; r.dst = ws + WS_WGU + (size_t)l * NE * 2048 * D * 2 + ((size_t)e * 2048 + orow) * D + 64 * kb; }
    else { const int q2 = q - NE * WT_I_GU; const int e = q2 / WT_I_DN, t = q2 % WT_I_DN, kb = t / 32, nb = t % 32;
        r.W = P.in[23] + ((size_t)l * NE + e) * DFF * D; r.N = D; r.k0 = 64 * kb; r.n0 = 32 * nb; r.dst = ws + WS_WDN + (size_t)l * NE * D * DFF * 2 + ((size_t)e * D + 32 * nb) * DFF + 64 * kb; }
    return r;
}
__device__ __forceinline__ void phase_prologue(const Frame& F, const Params& P) {
    unsigned char* ws = P.ws;
    LAS float* scr = (LAS float*)(F.lds + F.wave * 16384);
    const int gw = F.bid * NWAVES + F.wave, NGW = F.G * NWAVES;
    for (int it = gw; it < DEPTH * (WT_I_IN + WT_I_OUT); it += NGW) { const int l = it / (WT_I_IN + WT_I_OUT), r = it % (WT_I_IN + WT_I_OUT); weight_item(P, l * WT_PER_LAYER + r, scr, F.lane); }
    {
        const int gt = F.bid * NTHREADS + F.tid, NGT = F.G * NTHREADS;
        bf16_t* cm3 = (bf16_t*)(ws + WS_CM3);
        for (int i = gt; i < 192 * 64; i += NGT) { const int m = i >> 6, n2 = i & 63, part = m >> 6, k2 = m & 63; const int ph = (k2 * n2) & 63;
            float s, c; sincospif((float)ph * (1.0f / 32.0f), &s, &c); const float v = part == 0 ? c : (part == 1 ? -s : -c); cm3[i] = (bf16_t)f2bf(v); }
        bf16_t* rwt = (bf16_t*)(ws + WS_RW);
        for (int i = gt; i < DEPTH * NE * D; i += NGT) { const int l = i / (NE * D), q = i % (NE * D), k = q >> 5, e = q & 31;
            const float w = P.in[19][(size_t)l * D * NE + q]; const unsigned hi = f2bf(w); const unsigned lo = f2bf(w - bf2f(hi));
            rwt[((size_t)l * 2 + 0) * NE * D + e * D + k] = (bf16_t)hi; rwt[((size_t)l * 2 + 1) * NE * D + e * D + k] = (bf16_t)lo; }
        bf16_t* tf2 = (bf16_t*)(ws + WS_TF2);
        for (int i = gt; i < 128 * 128; i += NGT) { const int c_ = i >> 7, n = i & 127; const int ph = (c_ * n) & 127;
            float s, c; sincospif((float)ph * (1.0f / 64.0f), &s, &c); tf2[i] = (bf16_t)f2bf(c); tf2[128 * 128 + i] = (bf16_t)f2bf(s); }
        bf16_t* tctx = (bf16_t*)(ws + WS_TCTX);
        for (int i = gt; i < 256 * 256; i += NGT) { const int k1 = i >> 8, n = i & 255; const int ph = (k1 * n) & 255;
            float s, c; sincospif((float)ph * (1.0f / 128.0f), &s, &c); tctx[i] = (bf16_t)f2bf(c); tctx[256 * 256 + i] = (bf16_t)f2bf(s); }
        bf16_t* tlat = (bf16_t*)(ws + WS_TLAT);
        for (int i = gt; i < 128 * 128 * 128; i += NGT) { const int nlo = i >> 14, d = (i >> 7) & 127, a = i & 127; const int ph = (d * (nlo + 128 * a)) & 16383;
            float s, c; sincospif((float)ph * (1.0f / 8192.0f), &s, &c);
            tlat[(size_t)nlo * 32768 + d * 128 + a] = (bf16_t)f2bf(c); tlat[(size_t)nlo * 32768 + 16384 + d * 128 + a] = (bf16_t)f2bf(s); }
    }
    for (int it = F.bid + F.G * F.wave; it < DEPTH * 24 * 8; it += NGW) {
        const int l = it / 192, q = it % 192, cb = q >> 3, ks = q & 7;
        const float* wm = P.in[6] + (size_t)l * D * 6144 + (size_t)(ks * 128) * 6144 + cb * 256 + 4 * F.lane;
        f32x4 a0 = {0.f, 0.f, 0.f, 0.f}, a1 = a0, a2 = a0;
#pragma unroll 16
        for (int k = 0; k < 128; ++k) { const int kk = ks * 128 + k;
            const float c0 = P.in[1][kk], c1 = P.in[1][D + kk], c2 = P.in[3][kk];
            const float s0 = c0 * sigmoidf_(c0), s1 = c1 * sigmoidf_(c1), s2 = c2 * sigmoidf_(c2);
            const f32x4 w = *(const f32x4*)(wm + (size_t)k * 6144);
            a0 += w * s0; a1 += w * s1; a2 += w * s2; }
        float* mp = (float*)(ws + WS_MODP) + ((size_t)(l * 8 + ks) * 3) * 6144 + cb * 256 + 4 * F.lane;
        *(f32x4*)(mp) = a0; *(f32x4*)(mp + 6144) = a1; *(f32x4*)(mp + 2 * 6144) = a2;
    }
}

__device__ __forceinline__ f32x4 mod_from_partials(const Params& P, int l, int v, int c4) {
    f32x4 s = *(const f32x4*)(P.in[7] + (size_t)l * 6144 + c4);
    const float* mp = (const float*)(P.ws + WS_MODP) + ((size_t)(l * 8) * 3 + v) * 6144 + c4;
#pragma unroll
    for (int ks = 0; ks < 8; ++ks) s += *(const f32x4*)(mp + (size_t)ks * 3 * 6144);
    return s;
}

__device__ __forceinline__ void norm_row_store(const f32x4 (&x)[4], const float* g, const f32x4 (&shv)[4], const f32x4 (&scv)[4], bf16_t* orow, int lane, unsigned char* orow8 = nullptr) {
    float ss = 0.f;
#pragma unroll
    for (int j = 0; j < 4; ++j) ss += (x[j].x * x[j].x + x[j].y * x[j].y) + (x[j].z * x[j].z + x[j].w * x[j].w);
    const float rstd = 1.0f / sqrtf(wave_sum(ss) * (1.0f / D) + NORM_EPS);
#pragma unroll
    for (int j = 0; j < 4; ++j) { const int c = 4 * lane + 256 * j;
        const f32x4 gv = *(const f32x4*)(g + c);
        const f32x4 y = (x[j] * rstd) * gv * (scv[j] + 1.0f) + shv[j];
        u32x2 o; o.x = pk2(y.x, y.y); o.y = pk2(y.z, y.w);
        *(u32x2*)(orow + c) = o;
        if (orow8) *(unsigned*)(orow8 + c) = pk4_fp8(y.x, y.y, y.z, y.w); }
}

__device__ __forceinline__ void phase_p1(const Frame& F, const Params& P) {
    unsigned char* ws = P.ws;
    const int gt = F.bid * NTHREADS + F.tid, NGT = F.G * NTHREADS;
    float* modf = (float*)(ws + WS_MODF);
    for (int i = gt; i < DEPTH * 3 * 1536; i += NGT) { const int l = i / 4608, q = i % 4608, v = q / 1536, c4 = (q % 1536) * 4;
        *(f32x4*)(modf + ((size_t)l * 3 + v) * 6144 + c4) = mod_from_partials(P, l, v, c4); }
    const int gw = F.bid * NWAVES + F.wave, NGW = F.G * NWAVES;
    bf16_t* hb = (bf16_t*)(ws + WS_HBUF);
    int cur_v = -1; f32x4 shv[4], scv[4], xn[4];
    auto rowp = [&](int m) { return (m < NLAT) ? (P.in[0] + (size_t)m * D) : (P.in[2] + (size_t)(m - NLAT) * D); };
    if (gw < NTOK) {
#pragma unroll
        for (int j = 0; j < 4; ++j) xn[j] = *(const f32x4*)(rowp(gw) + 4 * F.lane + 256 * j); }
    for (int m = gw; m < NTOK; m += NGW) {
        const int v = (m >= NLAT) ? 2 : (m >= SEQ ? 1 : 0);
        f32x4 x[4];
#pragma unroll
        for (int j = 0; j < 4; ++j) x[j] = xn[j];
        if (m + NGW < NTOK) {
#pragma unroll
            for (int j = 0; j < 4; ++j) xn[j] = *(const f32x4*)(rowp(m + NGW) + 4 * F.lane + 256 * j); }
        if (v != cur_v) { cur_v = v;
#pragma unroll
            for (int j = 0; j < 4; ++j) { const int c = 4 * F.lane + 256 * j; shv[j] = mod_from_partials(P, 0, v, c); scv[j] = mod_from_partials(P, 0, v, 1024 + c); } }
        norm_row_store(x, P.in[4], shv, scv, hb + (size_t)m * D, F.lane);
    }
}

constexpr int GL_GT = 0;
constexpr int GL_A1 = 34816, GL_KE = 60416, GL_VTB = 78848, GL_RS = 97280, GL_RT = 97792;
constexpr int GL_KDT = 34816, GL_VT = 53248;

__device__ __forceinline__ float logsigmoid2f_(float x) { const float z = 1.44269504089f * x; return fminf(z, 0.f) - __builtin_amdgcn_logf(1.0f + __builtin_amdgcn_exp2f(-fabsf(z))); }
__device__ __forceinline__ float bfel(const u32x4& v, int j) { const unsigned w = (j < 2) ? v.x : (j < 4 ? v.y : (j < 6 ? v.z : v.w)); return (j & 1) ? bfhi(w) : bflo(w); }
__device__ __forceinline__ unsigned short bfraw(const u32x4& v, int j) { const unsigned w = (j < 2) ? v.x : (j < 4 ? v.y : (j < 6 ? v.z : v.w)); return (unsigned short)((j & 1) ? (w >> 16) : (w & 0xffffu)); }

struct GateRegs { bf16x8 a[4]; float bw[8]; float bg; };
__device__ __forceinline__ GateRegs gla_load_gate_regs(const Frame& F, const Params& P, int l, int row0, int h) {
    GateRegs g;
    const int dir = F.wave >> 2, dbase = (F.wave & 3) * 16, fr = F.lane & 15, fq = F.lane >> 4;
    const bf16_t* lrb = (const bf16_t*)(P.ws + WS_LRB);
#pragma unroll
    for (int mt = 0; mt < 4; ++mt) g.a[mt] = *(const bf16x8*)(lrb + (size_t)(row0 + mt * 16 + fr) * 32 + dir * 16 + (fq & 1) * 8);
    const float* wgp = (dir ? P.in[11] : P.in[9]) + (size_t)l * 16 * 256 + 64 * h + dbase + fr;
#pragma unroll
    for (int j = 0; j < 8; ++j) g.bw[j] = wgp[((fq & 1) * 8 + j) * 256];
    g.bg = (dir ? P.in[12] : P.in[10])[(size_t)l * 256 + 64 * h + dbase + fr];
    return g;
}
__device__ __forceinline__ void gla_gates(const Frame& F, const GateRegs& gr) {
    LAS float* GT = (LAS float*)(F.lds + GL_GT);
    const int dir = F.wave >> 2, dbase = (F.wave & 3) * 16, lane = F.lane, fr = lane & 15, fq = lane >> 4;
    float p[4][4]; float T[4];
    const bf16x8 z8 = {0, 0, 0, 0, 0, 0, 0, 0}; bf16x8 gb;
    { const u32x4 pb_ = {pk2(gr.bw[0], gr.bw[1]), pk2(gr.bw[2], gr.bw[3]), pk2(gr.bw[4], gr.bw[5]), pk2(gr.bw[6], gr.bw[7])}; gb = (fq < 2) ? __builtin_bit_cast(bf16x8, pb_) : z8; }
#pragma unroll
    for (int mt = 0; mt < 4; ++mt) { const f32x4 acc = __builtin_amdgcn_mfma_f32_16x16x32_bf16((fq < 2) ? gr.a[mt] : z8, gb, (f32x4){0.f, 0.f, 0.f, 0.f}, 0, 0, 0);
#pragma unroll
        for (int j = 0; j < 4; ++j) p[mt][j] = logsigmoid2f_(acc[j] + gr.bg) * (1.0f / 16.0f); }
    if (dir == 0) {
#pragma unroll
        for (int mt = 0; mt < 4; ++mt) { p[mt][1] += p[mt][0]; p[mt][2] += p[mt][1]; p[mt][3] += p[mt][2]; T[mt] = p[mt][3]; }
        float base = 0.f;
#pragma unroll
        for (int mt = 0; mt < 4; ++mt) { float inc = T[mt]; float v = __shfl_up(inc, 16); inc += (fq >= 1) ? v : 0.f; v = __shfl_up(inc, 32); inc += (fq >= 2) ? v : 0.f;
            const float off = base + (inc - T[mt]); const float ct = __shfl(inc, 48 + fr);
#pragma unroll
            for (int j = 0; j < 4; ++j) GT[(dbase + fr) * 65 + mt * 16 + fq * 4 + j] = off + p[mt][j];
            base += ct; }
    } else {
#pragma unroll
        for (int mt = 0; mt < 4; ++mt) { p[mt][2] += p[mt][3]; p[mt][1] += p[mt][2]; p[mt][0] += p[mt][1]; T[mt] = p[mt][0]; }
        float base = 0.f;
#pragma unroll
        for (int mt = 3; mt >= 0; --mt) { float inc = T[mt]; float v = __shfl_down(inc, 16); inc += (fq <= 2) ? v : 0.f; v = __shfl_down(inc, 32); inc += (fq <= 1) ? v : 0.f;
            const float off = base + (inc - T[mt]); const float ct = __shfl(inc, fr);
#pragma unroll
            for (int j = 0; j < 4; ++j) GT[(64 + dbase + fr) * 65 + mt * 16 + fq * 4 + j] = off + p[mt][j];
            base += ct; }
    }
}

__device__ __forceinline__ void gla_unit_rows(int u, int& row0, int& h) {
    if (u < 2048) { const int bh = u >> 8, n = u & 255; h = bh & 3; row0 = (bh >> 2) * SEQ + 64 * n; }
    else { const int q = u - 2048, bh = q >> 2, n = q & 3; h = bh & 3; row0 = NLAT + (bh >> 2) * CTXL + 64 * n; }
}
struct G1Ops { GateRegs gr; u32x4 kv; u32x4 vv[2]; };
struct G3Ops { GateRegs gr; u32x4 qv, kv; u32x4 vv[2], rv[2], stv[4]; };
__device__ __forceinline__ void gla_map_rm64(const Frame& F, int& row, int& c8) { row = F.tid >> 3; c8 = (F.tid & 7) * 8; }
__device__ __forceinline__ void gla_map_tr64(const Frame& F, int& row, int& c8) { row = 32 * (F.wave & 1) + (F.lane & 31); c8 = 8 * (2 * (F.wave >> 1) + (F.lane >> 5)); }
__device__ __forceinline__ void gla_map_tr128(const Frame& F, int i, int& row, int& c8) { row = 32 * i + (F.lane & 31); c8 = 8 * (2 * F.wave + (F.lane >> 5)); }
__device__ __forceinline__ void gla_map_rm128(const Frame& F, int i, int& row, int& c8) { const int id = F.tid + 512 * i; row = id >> 4; c8 = (id & 15) * 8; }
__device__ __forceinline__ void gla_load_k(const Frame& F, const Params& P, int row0, int h, u32x4& kv) { int r, c; gla_map_rm64(F, r, c);
    kv = *(const u32x4*)((const bf16_t*)(P.ws + WS_PBUF) + pb_addr(row0 + r, C_K + 64 * h + c)); }
__device__ __forceinline__ void gla_load_q(const Frame& F, const Params& P, int row0, int h, u32x4& qv) { int r, c; gla_map_rm64(F, r, c);
    qv = *(const u32x4*)((const bf16_t*)(P.ws + WS_PBUF) + pb_addr(row0 + r, C_Q + 64 * h + c)); }
__device__ __forceinline__ void gla_load_kt(const Frame& F, const Params& P, int row0, int h, u32x4& kv) { int r, c; gla_map_tr64(F, r, c);
    kv = *(const u32x4*)((const bf16_t*)(P.ws + WS_PBUF) + pb_addr(row0 + r, C_K + 64 * h + c)); }
__device__ __forceinline__ void gla_load_v(const Frame& F, const Params& P, int row0, int h, u32x4 (&v)[2]) {
#pragma unroll
    for (int i = 0; i < 2; ++i) { int r, c; gla_map_tr128(F, i, r, c); v[i] = *(const u32x4*)((const bf16_t*)(P.ws + WS_PBUF) + pb_addr(row0 + r, C_V + 128 * h + c)); } }
__device__ __forceinline__ void gla_load_r(const Frame& F, const Params& P, int row0, int h, u32x4 (&v)[2]) {
#pragma unroll
    for (int i = 0; i < 2; ++i) { int r, c; gla_map_rm128(F, i, r, c); v[i] = *(const u32x4*)((const bf16_t*)(P.ws + WS_PBUF) + pb_addr(row0 + r, C_R + 128 * h + c)); } }
__device__ __forceinline__ void gla_load_state(const Frame& F, const Params& P, int unit, u32x4 (&stv)[4]) {
    const bf16_t* st = (const bf16_t*)(P.ws + WS_STATE) + (size_t)unit * 16384;
#pragma unroll
    for (int i = 0; i < 4; ++i) stv[i] = *(const u32x4*)(st + (i * 512 + F.tid) * 8); }
__device__ __forceinline__ void gla_g1_unit(const Frame& F, const Params& P, int l, int unit, G1Ops& o, bool has_next, int nrow0, int nh) {
    const int tid = F.tid; int row, c8; gla_map_tr64(F, row, c8);
    gla_gates(F, o.gr);
    o.gr = gla_load_gate_regs(F, P, l, nrow0, nh);
    LDS_BARRIER();
    LAS float* GT = (LAS float*)(F.lds + GL_GT);
    LAS bf16_t* KDT = (LAS bf16_t*)(F.lds + GL_KDT); LAS bf16_t* VT = (LAS bf16_t*)(F.lds + GL_VT);
#pragma unroll
    for (int j = 0; j < 8; ++j) { const int d = c8 + j; const float k_ = bfel(o.kv, j);
        KDT[d * 72 + row] = (bf16_t)f2bf(k_ * __builtin_amdgcn_exp2f(GT[d * 65 + 63] - GT[d * 65 + row])); KDT[(64 + d) * 72 + row] = (bf16_t)f2bf(k_ * __builtin_amdgcn_exp2f(GT[(64 + d) * 65] - GT[(64 + d) * 65 + row])); }
    gla_load_kt(F, P, nrow0, nh, o.kv);
#pragma unroll
    for (int i = 0; i < 2; ++i) { int vr, vc; gla_map_tr128(F, i, vr, vc);
#pragma unroll
        for (int j = 0; j < 8; ++j) VT[(vc + j) * 72 + vr] = bfraw(o.vv[i], j); }
    gla_load_v(F, P, nrow0, nh, o.vv);
    if (tid < 128) ((float*)(P.ws + WS_DECAY))[(size_t)unit * 128 + tid] = __builtin_amdgcn_exp2f(tid < 64 ? GT[tid * 65 + 63] : GT[tid * 65]);
    LDS_BARRIER();
    const int fr = F.lane & 15, fq = F.lane >> 4, w = F.wave;
    f32x4 acc[1][8]; zero_acc<1, 8>(acc);
    mma_nt<1, 8>(acc, KDT + (16 * w) * 72, 72, VT, 72, 64, fr, fq);
    bf16_t* st = (bf16_t*)(P.ws + WS_STATE) + (size_t)unit * 16384;
#pragma unroll
    for (int nt = 0; nt < 8; ++nt) { u32x2 ov; ov.x = pk2(acc[0][nt][0], acc[0][nt][1]); ov.y = pk2(acc[0][nt][2], acc[0][nt][3]); *(u32x2*)(st + (nt * 16 + fr) * 128 + 16 * w + fq * 4) = ov; }
}

__device__ __forceinline__ void gla_scan(const Frame& F, const Params& P, int def_lo, int def_hi) {
    unsigned* stt = (unsigned*)(P.ws + WS_STATE); const float* dec = (const float*)(P.ws + WS_DECAY);
    if (F.tid >= 256) {
        LAS float* scr = (LAS float*)(F.lds + F.wave * 16384);
        for (int it = def_lo + F.bid * 4 + (F.wave - 4); it < def_hi; it += F.G * 4) weight_item(P, it, scr, F.lane);
        return; }
    for (int gid = F.bid * 256 + F.tid; gid < 8 * 128 * 64; gid += F.G * 256) {
        const int dp = gid & 63, e = (gid >> 6) & 127, bh = gid >> 13, dir = dp >> 5;
        const int latb = bh * 256, ctxb = 2048 + bh * 4;
        auto unit_of = [&](int p) { return dir == 0 ? (p < 4 ? ctxb + p : latb + (p - 4)) : (p < 4 ? ctxb + 3 - p : latb + 255 - (p - 4)); };
        float s0 = 0.f, s1 = 0.f;
        unsigned dA[10], dB[10]; f32x2 cA[10], cB[10];
#pragma unroll
        for (int i = 0; i < 10; ++i) { const int u = unit_of(i); dA[i] = stt[((size_t)u * 128 + e) * 64 + dp]; cA[i] = *(const f32x2*)(dec + (size_t)u * 128 + 2 * dp); }
        for (int p0 = 0; p0 < 260; p0 += 20) {
#pragma unroll
            for (int i = 0; i < 10; ++i) { const int u = unit_of(p0 + 10 + i); dB[i] = stt[((size_t)u * 128 + e) * 64 + dp]; cB[i] = *(const f32x2*)(dec + (size_t)u * 128 + 2 * dp); }
#pragma unroll
            for (int i = 0; i < 10; ++i) { const int u = unit_of(p0 + i); stt[((size_t)u * 128 + e) * 64 + dp] = pk2(s0, s1); s0 = cA[i].x * s0 + bflo(dA[i]); s1 = cA[i].y * s1 + bfhi(dA[i]); }
            if (p0 + 20 < 260) {
#pragma unroll
                for (int i = 0; i < 10; ++i) { const int u = unit_of(p0 + 20 + i); dA[i] = stt[((size_t)u * 128 + e) * 64 + dp]; cA[i] = *(const f32x2*)(dec + (size_t)u * 128 + 2 * dp); } }
#pragma unroll
            for (int i = 0; i < 10; ++i) { const int u = unit_of(p0 + 10 + i); stt[((size_t)u * 128 + e) * 64 + dp] = pk2(s0, s1); s0 = cB[i].x * s0 + bflo(dB[i]); s1 = cB[i].y * s1 + bfhi(dB[i]); }
        }
    }
}

__device__ __forceinline__ void gla_g3_unit(const Frame& F, const Params& P, int l, int row0, int h, int unit, G3Ops& o, const float (&ngv)[4], bool has_next, int nrow0, int nh, int nunit) {
    const int tid = F.tid, fr = F.lane & 15, fq = F.lane >> 4, w = F.wave; int row, c8; gla_map_rm64(F, row, c8);
    gla_gates(F, o.gr);
    o.gr = gla_load_gate_regs(F, P, l, nrow0, nh);
    LDS_BARRIER();
    LAS float* GT = (LAS float*)(F.lds + GL_GT);
    LAS bf16_t* A1 = (LAS bf16_t*)(F.lds + GL_A1); LAS bf16_t* KE = (LAS bf16_t*)(F.lds + GL_KE); LAS bf16_t* VTb = (LAS bf16_t*)(F.lds + GL_VTB); LAS bf16_t* STb = (LAS bf16_t*)(F.lds + GL_GT);
    LAS float* RS = (LAS float*)(F.lds + GL_RS); LAS bf16_t* RT = (LAS bf16_t*)(F.lds + GL_RT);
    { float qf[8], qb[8], kf[8], kb[8];
#pragma unroll
      for (int j = 0; j < 8; ++j) { const float q_ = bfel(o.qv, j) * 0.125f, k_ = bfel(o.kv, j); const float bf_ = GT[(c8 + j) * 65 + row], bb_ = GT[(64 + c8 + j) * 65 + row];
          qf[j] = q_ * __builtin_amdgcn_exp2f(bf_); qb[j] = q_ * __builtin_amdgcn_exp2f(bb_); kf[j] = k_ * __builtin_amdgcn_exp2f(-bf_); kb[j] = k_ * __builtin_amdgcn_exp2f(-bb_); }
      *(LAS u32x4*)(A1 + row * 200 + 64 + c8) = (u32x4){pk2(qf[0], qf[1]), pk2(qf[2], qf[3]), pk2(qf[4], qf[5]), pk2(qf[6], qf[7])};
      *(LAS u32x4*)(A1 + row * 200 + 128 + c8) = (u32x4){pk2(qb[0], qb[1]), pk2(qb[2], qb[3]), pk2(qb[4], qb[5]), pk2(qb[6], qb[7])};
      *(LAS u32x4*)(KE + row * 72 + c8) = (u32x4){pk2(kf[0], kf[1]), pk2(kf[2], kf[3]), pk2(kf[4], kf[5]), pk2(kf[6], kf[7])};
      *(LAS u32x4*)(KE + 4608 + row * 72 + c8) = (u32x4){pk2(kb[0], kb[1]), pk2(kb[2], kb[3]), pk2(kb[4], kb[5]), pk2(kb[6], kb[7])}; }
    gla_load_q(F, P, nrow0, nh, o.qv); gla_load_k(F, P, nrow0, nh, o.kv);
#pragma unroll
    for (int i = 0; i < 2; ++i) { int rr, rc, vr, vc; gla_map_rm128(F, i, rr, rc); gla_map_tr128(F, i, vr, vc); *(LAS u32x4*)(RT + rr * 136 + rc) = o.rv[i];
#pragma unroll
        for (int j = 0; j < 8; ++j) VTb[(vc + j) * 72 + vr] = bfraw(o.vv[i], j); }
    gla_load_v(F, P, nrow0, nh, o.vv); gla_load_r(F, P, nrow0, nh, o.rv);
    LDS_BARRIER();
    {
        const int mt = w & 3, ntp = w >> 2;
        f32x4 af[1][2], ab[1][2]; zero_acc<1, 2>(af); zero_acc<1, 2>(ab);
        mma_nt<1, 2>(af, A1 + (16 * mt) * 200 + 64, 200, KE + (32 * ntp) * 72, 72, 64, fr, fq);
        mma_nt<1, 2>(ab, A1 + (16 * mt) * 200 + 128, 200, KE + 4608 + (32 * ntp) * 72, 72, 64, fr, fq);
#pragma unroll
        for (int i = 0; i < 4; ++i) { const int idx = (i * 512 + tid) * 8, e = idx >> 7, dd = idx & 127; *(LAS u32x4*)(STb + e * 136 + dd) = o.stv[i]; }
        gla_load_state(F, P, nunit, o.stv);
#pragma unroll
        for (int nt = 0; nt < 2; ++nt)
#pragma unroll
            for (int j = 0; j < 4; ++j) { const int i = 16 * mt + fq * 4 + j, jj = (2 * ntp + nt) * 16 + fr;
                const float p = (jj <= i ? af[0][nt][j] : 0.f) + (jj >= i ? ab[0][nt][j] : 0.f); A1[i * 200 + jj] = (bf16_t)f2bf(p); }
    }
    LDS_BARRIER();
    {
        const int mt = w & 3, nh = w >> 2;
        f32x4 acc[1][4]; zero_acc<1, 4>(acc);
        mma_nt<1, 4>(acc, A1 + (16 * mt) * 200, 200, VTb + (64 * nh) * 72, 72, 64, fr, fq);
        mma_nt<1, 4>(acc, A1 + (16 * mt) * 200 + 64, 200, STb + (64 * nh) * 136, 136, 128, fr, fq);
        float ss[4];
#pragma unroll
        for (int j = 0; j < 4; ++j) { float s = 0.f;
#pragma unroll
            for (int nt = 0; nt < 4; ++nt) s += acc[0][nt][j] * acc[0][nt][j];
            s += __shfl_xor(s, 1); s += __shfl_xor(s, 2); s += __shfl_xor(s, 4); s += __shfl_xor(s, 8); ss[j] = s; }
        if (fr == 0) {
#pragma unroll
            for (int j = 0; j < 4; ++j) RS[nh * 64 + 16 * mt + fq * 4 + j] = ss[j]; }
        LDS_BARRIER();
        bf16_t* cat = (bf16_t*)(P.ws + WS_CAT);
#pragma unroll
        for (int j = 0; j < 4; ++j) { const int i = 16 * mt + fq * 4 + j; const float rinv = 1.0f / sqrtf((RS[i] + RS[64 + i]) * (1.0f / 128.0f) + NORM_EPS);
#pragma unroll
            for (int nt = 0; nt < 4; ++nt) { const int e = nh * 64 + nt * 16 + fr; const float r_ = bf2f(RT[i * 136 + e]);
                const float o = acc[0][nt][j] * rinv * ngv[nt] * (r_ * sigmoidf_(r_)); cat[(size_t)(row0 + i) * D + 256 + 128 * h + e] = (bf16_t)f2bf(o); } }
    }
}

__device__ __forceinline__ void conv_unit(const Frame& F, const Params& P, int l, int rowbase, int Ls, int t0) {
    const bf16_t* pb = (const bf16_t*)(P.ws + WS_PBUF);
    LAS bf16_t* Y = (LAS bf16_t*)(F.lds);
    LAS float* Z = (LAS float*)(F.lds + 49152);
    const int tid = F.tid;
    {
        u32x4 av[6], gv[6];
#pragma unroll
        for (int i = 0; i < 6; ++i) { const int ch = tid + 512 * i, r = ch >> 5, cc = (ch & 31) * 8, t = t0 - 15 + r;
            av[i] = (u32x4){0u, 0u, 0u, 0u}; gv[i] = av[i];
            if (ch < 94 * 32 && t >= 0 && t < Ls) { av[i] = *(const u32x4*)(pb + pb_addr(rowbase + t, C_CA + cc)); gv[i] = *(const u32x4*)(pb + pb_addr(rowbase + t, C_CG + cc)); } }
#pragma unroll
        for (int i = 0; i < 6; ++i) { const int ch = tid + 512 * i, r = ch >> 5, cc = (ch & 31) * 8; const u32x4 a = av[i], g = gv[i]; u32x4 o;
            o.x = pk2(bflo(a.x) * sigmoidf_(bflo(g.x)), bfhi(a.x) * sigmoidf_(bfhi(g.x))); o.y = pk2(bflo(a.y) * sigmoidf_(bflo(g.y)), bfhi(a.y) * sigmoidf_(bfhi(g.y)));
            o.z = pk2(bflo(a.z) * sigmoidf_(bflo(g.z)), bfhi(a.z) * sigmoidf_(bfhi(g.z))); o.w = pk2(bflo(a.w) * sigmoidf_(bflo(g.w)), bfhi(a.w) * sigmoidf_(bfhi(g.w)));
            if (ch < 94 * 32) *(LAS u32x4*)(Y + r * 256 + cc) = o; }
    }
    const int c2 = (tid & 127) * 2, qtr = tid >> 7; const float* cw = P.in[14] + (size_t)l * 31 * 256 + c2; const f32x2 cb = *(const f32x2*)(P.in[15] + (size_t)l * 256 + c2);
    f32x2 wv[31];
#pragma unroll
    for (int j = 0; j < 31; ++j) wv[j] = *(const f32x2*)(cw + j * 256);
    const f32x4 lng = *(const f32x4*)(P.in[16] + (size_t)l * 256 + 4 * F.lane), lnb = *(const f32x4*)(P.in[17] + (size_t)l * 256 + 4 * F.lane);
    LDS_BARRIER();
#pragma unroll 1
    for (int hp = 0; hp < 2; ++hp) { f32x2 yv[38]; const int rb = qtr * 16 + hp * 8;
#pragma unroll
      for (int r = 0; r < 38; ++r) { const unsigned wd = *(const LAS unsigned*)(Y + (rb + r) * 256 + c2); yv[r] = (f32x2){bflo(wd), bfhi(wd)}; }
#pragma unroll
      for (int tt = 0; tt < 8; ++tt) { f32x2 z = cb;
#pragma unroll
          for (int j = 0; j < 31; ++j) z += wv[j] * yv[tt + j];
          *(LAS f32x2*)(Z + (rb + tt) * 256 + c2) = z; } }
    LDS_BARRIER();
    { bf16_t* cat = (bf16_t*)(P.ws + WS_CAT);
#pragma unroll 2
      for (int i = 0; i < 8; ++i) { const int t = F.wave * 8 + i; const f32x4 z = *(const LAS f32x4*)(Z + t * 256 + 4 * F.lane);
          const float mean = wave_sum_dpp((z.x + z.y) + (z.z + z.w)) * (1.0f / 256.0f); const f32x4 zc = z - mean;
          const float var = wave_sum_dpp((zc.x * zc.x + zc.y * zc.y) + (zc.z * zc.z + zc.w * zc.w)) * (1.0f / 256.0f); const float rstd = 1.0f / sqrtf(var + NORM_EPS);
          const f32x4 y = zc * rstd * lng + lnb; u32x2 o; o.x = pk2(y.x * sigmoidf_(y.x), y.y * sigmoidf_(y.y)); o.y = pk2(y.z * sigmoidf_(y.z), y.w * sigmoidf_(y.w));
          *(u32x2*)(cat + (size_t)(rowbase + t0 + t) * D + 768 + 4 * F.lane) = o; } }
    LDS_BARRIER();
}

template <int R, int NP>
__device__ __forceinline__ void fourier_f1_unit(const Frame& F, const Params& P, int rowbase, int rstride, int h, const bf16_t* tab, int orow0, float oscale) {
    const bf16_t* pb = (const bf16_t*)(P.ws + WS_PBUF); const bf16_t* cm3 = (const bf16_t*)(P.ws + WS_CM3);
    constexpr int LZ = R + 8, MT0 = 4 * NP, NTW = R / 128, MTW = R / 128;
    LAS bf16_t* U = (LAS bf16_t*)(F.lds); LAS bf16_t* CM = U + R * 72; LAS bf16_t* ZT = CM + 64 * NP * 72;
    const int tid = F.tid, fr = F.lane & 15, fq = F.lane >> 4, w = F.wave;
    bf16x8 tcp[4], tsp[4];
    if constexpr (R == 128) {
#pragma unroll
        for (int k = 0; k < 4; ++k) { tcp[k] = *(const bf16x8*)(tab + (size_t)(w * 16 + fr) * R + k * 32 + fq * 8); tsp[k] = *(const bf16x8*)(tab + (size_t)R * R + (size_t)(w * 16 + fr) * R + k * 32 + fq * 8); } }
    { constexpr int NU = R * 8 / NTHREADS, NC = (64 * NP * 8 + NTHREADS - 1) / NTHREADS; u32x4 uv[NU], cv[NC];
#pragma unroll
      for (int i = 0; i < NU; ++i) { const int ch = tid + NTHREADS * i, a = ch >> 3, c8 = (ch & 7) * 8; uv[i] = *(const u32x4*)(pb + pb_addr(rowbase + a * rstride, C_FOUR + 64 * h + c8)); }
#pragma unroll
      for (int i = 0; i < NC; ++i) { const int ch = tid + NTHREADS * i, m = ch >> 3, c8 = (ch & 7) * 8; cv[i] = (ch < 64 * NP * 8) ? *(const u32x4*)(cm3 + m * 64 + c8) : (u32x4){0u, 0u, 0u, 0u}; }
#pragma unroll
      for (int i = 0; i < NU; ++i) { const int ch = tid + NTHREADS * i, a = ch >> 3, c8 = (ch & 7) * 8; *(LAS u32x4*)(U + a * 72 + c8) = uv[i]; }
#pragma unroll
      for (int i = 0; i < NC; ++i) { const int ch = tid + NTHREADS * i, m = ch >> 3, c8 = (ch & 7) * 8; if (ch < 64 * NP * 8) *(LAS u32x4*)(CM + m * 72 + c8) = cv[i]; } }
    LDS_BARRIER();
    {
        f32x4 acc[MT0][NTW]; zero_acc<MT0, NTW>(acc);
        mma_nt<MT0, NTW>(acc, CM, 72, U + (w * NTW * 16) * 72, 72, 64, fr, fq);
#pragma unroll
        for (int mt = 0; mt < MT0; ++mt)
#pragma unroll
            for (int nt = 0; nt < NTW; ++nt)
#pragma unroll
                for (int j = 0; j < 4; ++j) ZT[(mt * 16 + fq * 4 + j) * LZ + (w * NTW + nt) * 16 + fr] = (bf16_t)f2bf(acc[mt][nt][j]);
    }
    LDS_BARRIER();
    {
        f32x4 are[MTW][4], aim[MTW][4]; zero_acc<MTW, 4>(are); zero_acc<MTW, 4>(aim);
        const int m0 = w * MTW * 16;
#pragma unroll
        for (int k0 = 0; k0 < R; k0 += 32) {
            bf16x8 tc[MTW], ts[MTW];
#pragma unroll
            for (int mi = 0; mi < MTW; ++mi) { if constexpr (R == 128) { tc[mi] = tcp[k0 / 32]; ts[mi] = tsp[k0 / 32]; } else { tc[mi] = *(const bf16x8*)(tab + (size_t)(m0 + mi * 16 + fr) * R + k0 + fq * 8); ts[mi] = *(const bf16x8*)(tab + (size_t)R * R + (size_t)(m0 + mi * 16 + fr) * R + k0 + fq * 8); } }
#pragma unroll
            for (int nt = 0; nt < 4; ++nt) {
                const bf16x8 zr = *(const LAS bf16x8*)(ZT + (nt * 16 + fr) * LZ + k0 + fq * 8), zi = *(const LAS bf16x8*)(ZT + (64 + nt * 16 + fr) * LZ + k0 + fq * 8);
#pragma unroll
                for (int mi = 0; mi < MTW; ++mi) { are[mi][nt] = __builtin_amdgcn_mfma_f32_16x16x32_bf16(tc[mi], zr, are[mi][nt], 0, 0, 0); are[mi][nt] = __builtin_amdgcn_mfma_f32_16x16x32_bf16(ts[mi], zi, are[mi][nt], 0, 0, 0); }
                if constexpr (NP == 3) { const bf16x8 nzr = *(const LAS bf16x8*)(ZT + (128 + nt * 16 + fr) * LZ + k0 + fq * 8);
#pragma unroll
                    for (int mi = 0; mi < MTW; ++mi) { aim[mi][nt] = __builtin_amdgcn_mfma_f32_16x16x32_bf16(tc[mi], zi, aim[mi][nt], 0, 0, 0); aim[mi][nt] = __builtin_amdgcn_mfma_f32_16x16x32_bf16(ts[mi], nzr, aim[mi][nt], 0, 0, 0); } }
            }
        }
#pragma unroll
        for (int mi = 0; mi < MTW; ++mi)
#pragma unroll
            for (int nt = 0; nt < 4; ++nt)
#pragma unroll
                for (int j = 0; j < 4; ++j) { const int m = m0 + mi * 16 + fq * 4 + j, k2 = nt * 16 + fr;
                    if constexpr (NP == 3) { unsigned* t2 = (unsigned*)(P.ws + WS_T2); t2[(size_t)(orow0 + 128 * m) * 256 + h * 64 + k2] = pk2(are[mi][nt][j], aim[mi][nt][j]); }
                    else { bf16_t* cat = (bf16_t*)(P.ws + WS_CAT); cat[(size_t)(orow0 + m) * D + h * 64 + k2] = (bf16_t)f2bf(are[mi][nt][j] * oscale); } }
    }
    LDS_BARRIER();
}

struct F1Ops { bf16x8 tcp[4], tsp[4]; u32x4 uv[2]; };
__device__ __forceinline__ void f1_lat_load_u(const Frame& F, const Params& P, int rowbase, int h, u32x4 (&uv)[2]) {
#pragma unroll
    for (int i = 0; i < 2; ++i) { const int ch = F.tid + NTHREADS * i, a = ch >> 3, c8 = (ch & 7) * 8; uv[i] = *(const u32x4*)((const bf16_t*)(P.ws + WS_PBUF) + pb_addr(rowbase + a * 128, C_FOUR + 64 * h + c8)); } }
__device__ __forceinline__ void f1_lat_load_t(const Frame& F, const bf16_t* tab, bf16x8 (&tcp)[4], bf16x8 (&tsp)[4]) {
    const int fr = F.lane & 15, fq = F.lane >> 4, w = F.wave;
#pragma unroll
    for (int k = 0; k < 4; ++k) { tcp[k] = *(const bf16x8*)(tab + (size_t)(w * 16 + fr) * 128 + k * 32 + fq * 8); tsp[k] = *(const bf16x8*)(tab + (size_t)128 * 128 + (size_t)(w * 16 + fr) * 128 + k * 32 + fq * 8); } }
__device__ __forceinline__ void f1_lat_tables(const Frame& F, const Params& P) {
    const bf16_t* cm3 = (const bf16_t*)(P.ws + WS_CM3); LAS bf16_t* CM = (LAS bf16_t*)(F.lds) + 128 * 72;
#pragma unroll
    for (int i = 0; i < 3; ++i) { const int ch = F.tid + NTHREADS * i, m = ch >> 3, c8 = (ch & 7) * 8; *(LAS u32x4*)(CM + m * 72 + c8) = *(const u32x4*)(cm3 + m * 64 + c8); }
}
__device__ __forceinline__ void fourier_f1_lat_unit(const Frame& F, const Params& P, int h, int orow0, F1Ops& o, bool has_next, int nrowbase, int nh, const bf16_t* ntab) {
    constexpr int R = 128, LZ = R + 8;
    LAS bf16_t* U = (LAS bf16_t*)(F.lds); LAS bf16_t* CM = U + R * 72; LAS bf16_t* ZT = CM + 64 * 3 * 72;
    const int tid = F.tid, fr = F.lane & 15, fq = F.lane >> 4, w = F.wave;
#pragma unroll
    for (int i = 0; i < 2; ++i) { const int ch = tid + NTHREADS * i, a = ch >> 3, c8 = (ch & 7) * 8; *(LAS u32x4*)(U + a * 72 + c8) = o.uv[i]; }
    f1_lat_load_u(F, P, nrowbase, nh, o.uv);
    LDS_BARRIER();
    {
        f32x4 acc[12][1]; zero_acc<12, 1>(acc);
        mma_nt<12, 1>(acc, CM, 72, U + (w * 16) * 72, 72, 64, fr, fq);
#pragma unroll
        for (int mt = 0; mt < 12; ++mt)
#pragma unroll
            for (int j = 0; j < 4; ++j) ZT[(mt * 16 + fq * 4 + j) * LZ + w * 16 + fr] = (bf16_t)f2bf(acc[mt][0][j]);
    }
    LDS_BARRIER();
    {
        f32x4 are[4], aim[4];
#pragma unroll
        for (int nt = 0; nt < 4; ++nt) { are[nt] = (f32x4){0.f, 0.f, 0.f, 0.f}; aim[nt] = are[nt]; }
        const int m0 = w * 16;
#pragma unroll
        for (int k0 = 0; k0 < R; k0 += 32) {
            const bf16x8 tc = o.tcp[k0 / 32], ts = o.tsp[k0 / 32];
#pragma unroll
            for (int nt = 0; nt < 4; ++nt) {
                const bf16x8 zr = *(const LAS bf16x8*)(ZT + (nt * 16 + fr) * LZ + k0 + fq * 8), zi = *(const LAS bf16x8*)(ZT + (64 + nt * 16 + fr) * LZ + k0 + fq * 8), nzr = *(const LAS bf16x8*)(ZT + (128 + nt * 16 + fr) * LZ + k0 + fq * 8);
                are[nt] = __builtin_amdgcn_mfma_f32_16x16x32_bf16(tc, zr, are[nt], 0, 0, 0); are[nt] = __builtin_amdgcn_mfma_f32_16x16x32_bf16(ts, zi, are[nt], 0, 0, 0);
                aim[nt] = __builtin_amdgcn_mfma_f32_16x16x32_bf16(tc, zi, aim[nt], 0, 0, 0); aim[nt] = __builtin_amdgcn_mfma_f32_16x16x32_bf16(ts, nzr, aim[nt], 0, 0, 0); }
        }
        f1_lat_load_t(F, ntab, o.tcp, o.tsp);
        unsigned* t2 = (unsigned*)(P.ws + WS_T2);
#pragma unroll
        for (int nt = 0; nt < 4; ++nt)
#pragma unroll
            for (int j = 0; j < 4; ++j) { const int m = m0 + fq * 4 + j, k2 = nt * 16 + fr; t2[(size_t)(orow0 + 128 * m) * 256 + h * 64 + k2] = pk2(are[nt][j], aim[nt][j]); }
    }
    LDS_BARRIER();
}

constexpr int F2_X = 0, F2_T = 67584;
__device__ __forceinline__ void fourier_f2_tables(const Frame& F, const Params& P) {
    const bf16_t* tf2 = (const bf16_t*)(P.ws + WS_TF2); LAS bf16_t* T = (LAS bf16_t*)(F.lds + F2_T);
#pragma unroll
    for (int i = 0; i < 8; ++i) { const int ch = F.tid + 512 * i, r = ch >> 4, c8 = (ch & 15) * 8; *(LAS u32x4*)(T + r * 136 + c8) = *(const u32x4*)(tf2 + r * 128 + c8); }
    LDS_BARRIER();
}
__device__ __forceinline__ void fourier_f2_unit(const Frame& F, const Params& P, int b, int d, int hp) {
    const bf16_t* t2 = (const bf16_t*)(P.ws + WS_T2);
    LAS bf16_t* X = (LAS bf16_t*)(F.lds + F2_X); const LAS bf16_t* T = (const LAS bf16_t*)(F.lds + F2_T);
    const int tid = F.tid, fr = F.lane & 15, fq = F.lane >> 4, w = F.wave;
    { u32x4 xv[8];
#pragma unroll
      for (int i = 0; i < 8; ++i) { const int ch = tid + 512 * i, n = ch >> 5, c8 = (ch & 31) * 8; xv[i] = *(const u32x4*)(t2 + (size_t)(b * SEQ + 128 * d + n) * 512 + hp * 256 + c8); }
#pragma unroll
      for (int i = 0; i < 8; ++i) { const int ch = tid + 512 * i, n = ch >> 5, c8 = (ch & 31) * 8; *(LAS u32x4*)(X + n * 264 + c8) = xv[i]; } }
    LDS_BARRIER();
    f32x4 acc[8];
#pragma unroll
    for (int mt = 0; mt < 8; ++mt) acc[mt] = (f32x4){0.f, 0.f, 0.f, 0.f};
#pragma unroll
    for (int k0 = 0; k0 < 128; k0 += 32) {
        bf16x8 xr, xi;
#pragma unroll
        for (int jj = 0; jj < 8; ++jj) { const unsigned wd = *(const LAS unsigned*)(X + (k0 + fq * 8 + jj) * 264 + 2 * (w * 16 + fr)); xr[jj] = (short)(wd & 0xffffu); xi[jj] = (short)(wd >> 16); }
#pragma unroll
        for (int mt = 0; mt < 8; ++mt) { const bf16x8 tc = *(const LAS bf16x8*)(T + (mt * 16 + fr) * 136 + k0 + fq * 8), ts = *(const LAS bf16x8*)(T + (128 + mt * 16 + fr) * 136 + k0 + fq * 8);
            acc[mt] = __builtin_amdgcn_mfma_f32_16x16x32_bf16(tc, xr, acc[mt], 0, 0, 0); acc[mt] = __builtin_amdgcn_mfma_f32_16x16x32_bf16(ts, xi, acc[mt], 0, 0, 0); }
    }
    bf16_t* cat = (bf16_t*)(P.ws + WS_CAT);
#pragma unroll
    for (int mt = 0; mt < 8; ++mt)
#pragma unroll
        for (int j = 0; j < 4; ++j) { const int c = mt * 16 + fq * 4 + j; cat[(size_t)(b * SEQ + 128 * c + d) * D + hp * 128 + w * 16 + fr] = (bf16_t)f2bf(acc[mt][j] * (1.0f / 1024.0f)); }
    LDS_BARRIER();
}

constexpr int AX_LCNT = AUX_OFF, AX_GBASE = AUX_OFF + 128, AX_LE = AUX_OFF + 256, AX_LP = AUX_OFF + 256 + 2560;
constexpr int LC_BAR = LCTL_OFF, LC_TS = LCTL_OFF + 64;

constexpr int RT_GS = 0, RT_SSQ = 24576, RT_AT = 25600, RT_PL = 95232;
__device__ __forceinline__ void phase_route(const Frame& F, const Params& P, int l, int ntok) {
    unsigned char* ws = P.ws;
    LAS float* GS = (LAS float*)(F.lds + RT_GS); LAS float* SSQ = (LAS float*)(F.lds + RT_SSQ); LAS float* PL = (LAS float*)(F.lds + RT_PL);
    volatile LAS int* lcnt = (volatile LAS int*)(F.lds + AX_LCNT); volatile LAS int* gbase = (volatile LAS int*)(F.lds + AX_GBASE);
    volatile LAS int* LE = (volatile LAS int*)(F.lds + AX_LE); volatile LAS int* LP = (volatile LAS int*)(F.lds + AX_LP);
    const int tid = F.tid, lane = F.lane, w = F.wave, fr = lane & 15, fq = lane >> 4, ts = lane >> 2, kq = lane & 3, kbase = 128 * w + 32 * kq;
    LAS bf16_t* AT = (LAS bf16_t*)(F.lds + RT_AT) + w * (2 * 16 * 136);
    const int tpb = (ntok + F.G - 1) / F.G, tb = F.bid * tpb, te = (tb + tpb < ntok) ? tb + tpb : ntok, ntile = (te - tb + 15) >> 4;
    { const float* g2 = P.in[5] + (size_t)l * D;
      for (int i = tid; i < 3 * 1024; i += NTHREADS) { const int v = i >> 10, k = i & 1023; const float* mf = (const float*)(ws + WS_MODF) + ((size_t)l * 3 + v) * 6144;
          GS[(v * 2 + 0) * 1024 + k] = g2[k] * (1.0f + mf[4 * 1024 + k]); GS[(v * 2 + 1) * 1024 + k] = mf[3 * 1024 + k]; } }
    if (tid < 32) lcnt[tid] = 0;
    bf16x8 bh[4][2], bl[4][2];
    { const bf16_t* rwh = (const bf16_t*)(ws + WS_RW) + (size_t)l * 2 * NE * D; const bf16_t* rwl = rwh + NE * D;
#pragma unroll
      for (int sk = 0; sk < 4; ++sk)
#pragma unroll
          for (int nt = 0; nt < 2; ++nt) { const int off = (nt * 16 + fr) * D + 128 * w + 32 * sk + 8 * fq; bh[sk][nt] = *(const bf16x8*)(rwh + off); bl[sk][nt] = *(const bf16x8*)(rwl + off); } }
    const bf16_t* xres = (const bf16_t*)(ws + WS_XRES); bf16_t* hb = (bf16_t*)(ws + WS_HBUF);
    const float rbias = P.in[20][(size_t)l * NE + (lane & 31)];
    float* aprob = (float*)(ws + WS_APROB);
    u32x4 xn[4];
    { const int m = tb + ts;
#pragma unroll
      for (int j = 0; j < 4; ++j) xn[j] = (m < te) ? *(const u32x4*)(xres + (size_t)m * D + kbase + 8 * j) : (u32x4){0u, 0u, 0u, 0u}; }
    LDS_BARRIER();
    for (int it = 0; it < ntile; ++it) {
        const int buf = it & 1; const int m = tb + 16 * it + ts; const bool valid = m < te; const int v = (m >= NLAT) ? 2 : (m >= SEQ ? 1 : 0);
        f32x4 x[8]; float ss = 0.f;
#pragma unroll
        for (int j = 0; j < 8; ++j) { const u32x4 xw = xn[j >> 1]; x[j] = (j & 1) ? (f32x4){bflo(xw.z), bfhi(xw.z), bflo(xw.w), bfhi(xw.w)} : (f32x4){bflo(xw.x), bfhi(xw.x), bflo(xw.y), bfhi(xw.y)};
            ss += (x[j].x * x[j].x + x[j].y * x[j].y) + (x[j].z * x[j].z + x[j].w * x[j].w); }
        if (it + 1 < ntile) { const int mn = m + 16;
#pragma unroll
            for (int j = 0; j < 4; ++j) xn[j] = (mn < te) ? *(const u32x4*)(xres + (size_t)mn * D + kbase + 8 * j) : (u32x4){0u, 0u, 0u, 0u}; }
        ss += __shfl_xor(ss, 1); ss += __shfl_xor(ss, 2);
        if (kq == 0) SSQ[(buf * 8 + w) * 16 + ts] = ss;
        LDS_BARRIER();
        float tot = 0.f;
#pragma unroll
        for (int q = 0; q < 8; ++q) tot += SSQ[(buf * 8 + q) * 16 + ts];
        const float rstd = 1.0f / sqrtf(tot * (1.0f / D) + NORM_EPS);
        {
            unsigned hw[16], lw[16];
#pragma unroll
            for (int j = 0; j < 8; ++j) { const f32x4 gs = *(const LAS f32x4*)(GS + (v * 2 + 0) * 1024 + kbase + 4 * j), sh = *(const LAS f32x4*)(GS + (v * 2 + 1) * 1024 + kbase + 4 * j);
                const f32x4 h = (x[j] * rstd) * gs + sh;
                const unsigned h0 = f2bf(h.x), h1 = f2bf(h.y), h2 = f2bf(h.z), h3 = f2bf(h.w);
                hw[2 * j] = h0 | (h1 << 16); hw[2 * j + 1] = h2 | (h3 << 16);
                lw[2 * j] = pk2(h.x - bf2f(h0), h.y - bf2f(h1)); lw[2 * j + 1] = pk2(h.z - bf2f(h2), h.w - bf2f(h3)); }
            if (valid) {
                if (F8_LAYER[l]) { unsigned char* hb8 = ws + WS_HB8 + (size_t)m * D + kbase;
#pragma unroll
                    for (int c = 0; c < 2; ++c) { u32x4 o;
                        o.x = pk4_fp8(bflo(hw[8 * c + 0]) + bflo(lw[8 * c + 0]), bfhi(hw[8 * c + 0]) + bfhi(lw[8 * c + 0]), bflo(hw[8 * c + 1]) + bflo(lw[8 * c + 1]), bfhi(hw[8 * c + 1]) + bfhi(lw[8 * c + 1]));
                        o.y = pk4_fp8(bflo(hw[8 * c + 2]) + bflo(lw[8 * c + 2]), bfhi(hw[8 * c + 2]) + bfhi(lw[8 * c + 2]), bflo(hw[8 * c + 3]) + bflo(lw[8 * c + 3]), bfhi(hw[8 * c + 3]) + bfhi(lw[8 * c + 3]));
                        o.z = pk4_fp8(bflo(hw[8 * c + 4]) + bflo(lw[8 * c + 4]), bfhi(hw[8 * c + 4]) + bfhi(lw[8 * c + 4]), bflo(hw[8 * c + 5]) + bflo(lw[8 * c + 5]), bfhi(hw[8 * c + 5]) + bfhi(lw[8 * c + 5]));
                        o.w = pk4_fp8(bflo(hw[8 * c + 6]) + bflo(lw[8 * c + 6]), bfhi(hw[8 * c + 6]) + bfhi(lw[8 * c + 6]), bflo(hw[8 * c + 7]) + bflo(lw[8 * c + 7]), bfhi(hw[8 * c + 7]) + bfhi(lw[8 * c + 7]));
                        *(u32x4*)(hb8 + 16 * c) = o; } }
                if (!F8_LAYER[l]) {
#pragma unroll
                    for (int c = 0; c < 4; ++c) *(u32x4*)(hb + (size_t)m * D + kbase + 8 * c) = (u32x4){hw[4 * c], hw[4 * c + 1], hw[4 * c + 2], hw[4 * c + 3]}; } }
#pragma unroll
            for (int c = 0; c < 4; ++c) { *(LAS u32x4*)(AT + ts * 136 + 32 * kq + 8 * c) = (u32x4){hw[4 * c], hw[4 * c + 1], hw[4 * c + 2], hw[4 * c + 3]};
                *(LAS u32x4*)(AT + 16 * 136 + ts * 136 + 32 * kq + 8 * c) = (u32x4){lw[4 * c], lw[4 * c + 1], lw[4 * c + 2], lw[4 * c + 3]}; }
        }
        f32x4 acc[2]; acc[0] = (f32x4){0.f, 0.f, 0.f, 0.f}; acc[1] = acc[0];
#pragma unroll
        for (int sk = 0; sk < 4; ++sk) { const bf16x8 ah = *(const LAS bf16x8*)(AT + fr * 136 + 32 * sk + 8 * fq), al = *(const LAS bf16x8*)(AT + 16 * 136 + fr * 136 + 32 * sk + 8 * fq);
#pragma unroll
            for (int nt = 0; nt < 2; ++nt) { acc[nt] = __builtin_amdgcn_mfma_f32_16x16x32_bf16(ah, bh[sk][nt], acc[nt], 0, 0, 0); acc[nt] = __builtin_amdgcn_mfma_f32_16x16x32_bf16(ah, bl[sk][nt], acc[nt], 0, 0, 0);
                acc[nt] = __builtin_amdgcn_mfma_f32_16x16x32_bf16(al, bh[sk][nt], acc[nt], 0, 0, 0); } }
#pragma unroll
        for (int nt = 0; nt < 2; ++nt)
#pragma unroll
            for (int j = 0; j < 4; ++j) PL[((buf * 8 + w) * 16 + fq * 4 + j) * 33 + nt * 16 + fr] = acc[nt][j];
        LDS_BARRIER();
        {
            const int tt = 2 * w + (lane >> 5), e = lane & 31, mt = tb + 16 * it + tt;
            float lg = rbias;
#pragma unroll
            for (int q = 0; q < 8; ++q) lg += PL[((buf * 8 + q) * 16 + tt) * 33 + e];
            float bval[4]; int bidx[4]; float cur = lg;
#pragma unroll
            for (int k = 0; k < 4; ++k) { float bv = cur; int bi = e;
#pragma unroll
                for (int o = 1; o < 32; o <<= 1) { const float ov = __shfl_xor(bv, o); const int oi = __shfl_xor(bi, o); const bool take = (ov > bv) || (ov == bv && oi < bi); bv = take ? ov : bv; bi = take ? oi : bi; }
                bval[k] = bv; bidx[k] = bi; if (e == bi) cur = -INFINITY; }
            float ex[4], sum = 0.f;
#pragma unroll
            for (int k = 0; k < 4; ++k) { ex[k] = __expf(bval[k] - bval[0]); sum += ex[k]; }
            if (e == 0 && mt < te) { const int tl = 16 * it + tt;
#pragma unroll
                for (int k = 0; k < 4; ++k) { const int lp = __hip_atomic_fetch_add((LAS int*)(F.lds + AX_LCNT) + bidx[k], 1, __ATOMIC_RELAXED, __HIP_MEMORY_SCOPE_WORKGROUP);
                    LE[tl * 4 + k] = bidx[k]; LP[tl * 4 + k] = lp; aprob[(size_t)mt * 4 + k] = ex[k] / sum; } }
        }
    }
    LDS_BARRIER();
    if (tid < 32) gbase[tid] = (int)__hip_atomic_fetch_add((unsigned*)(ws + WS_CTL) + CW_CNT + l * 64 + tid, (unsigned)lcnt[tid], __ATOMIC_RELAXED, __HIP_MEMORY_SCOPE_AGENT);
    LDS_BARRIER();
    int* aexp = (int*)(ws + WS_AEXP); int* apos = (int*)(ws + WS_APOS);
    int* elist = (int*)(ws + WS_XB);
    for (int i = tid; i < (te - tb) * 4; i += NTHREADS) { const int e = LE[i]; const int pos = gbase[e] + LP[i]; aexp[(size_t)tb * 4 + i] = e; apos[(size_t)tb * 4 + i] = pos; elist[(size_t)e * NTOK + pos] = tb + (i >> 2); }
    LDS_BARRIER();
}

__device__ __forceinline__ void moe_prep(const Frame& F, const Params& P, int l) {
    unsigned char* ws = P.ws;
    volatile LAS int* TS = (volatile LAS int*)(F.lds + LC_TS);
    if (F.tid < 64) { const int e = F.lane & 31;
        const unsigned c = __hip_atomic_load((unsigned*)(ws + WS_CTL) + CW_CNT + l * 64 + e, __ATOMIC_RELAXED, __HIP_MEMORY_SCOPE_AGENT);
        int incl = (int)((c + 255u) >> 8);
#pragma unroll
        for (int o = 1; o < 32; o <<= 1) { const int v = __shfl_up(incl, o); if (e >= o) incl += v; }
        if (F.lane < 32) { TS[e + 1] = incl; TS[64 + e] = (int)c; }
        if (F.lane == 0) TS[0] = 0; }
    LDS_BARRIER();
}

__device__ __forceinline__ void phase_gather8(const Frame& F, const Params& P, int l, int ntok) {
    unsigned char* ws = P.ws;
    moe_prep(F, P, l);
    const volatile LAS int* TS = (const volatile LAS int*)(F.lds + LC_TS);
    const int gw = F.bid * NWAVES + F.wave, NGW = F.G * NWAVES;
    const int* aexp = (const int*)(ws + WS_AEXP); const int* apos = (const int*)(ws + WS_APOS);
    const unsigned char* hb8 = ws + WS_HB8; unsigned char* xb8 = ws + WS_XB8;
    for (int cidx = gw; cidx < ntok / 16; cidx += NGW) {
        const int a0 = cidx * 64; const int e = aexp[a0 + F.lane]; const int rowl = TS[e] * 256 + apos[a0 + F.lane];
#pragma unroll 1
        for (int t4 = 0; t4 < 16; t4 += 4) {
            u32x4 v0[4];
#pragma unroll
            for (int q = 0; q < 4; ++q) v0[q] = ((const u32x4*)(hb8 + (size_t)(a0 / 4 + t4 + q) * D))[F.lane];
#pragma unroll
            for (int q = 0; q < 4; ++q)
#pragma unroll
                for (int k = 0; k < 4; ++k) { const int row = __shfl(rowl, (t4 + q) * 4 + k); ((u32x4*)(xb8 + (size_t)row * D))[F.lane] = v0[q]; }
        }
    }
}

__device__ __forceinline__ void phase_combine(const Frame& F, const Params& P, int l, int ntok, bool last) {
    static_assert(F8_LAYER[0] && F8_LAYER[1], "combine reads fp8 expert outputs");
    unsigned char* ws = P.ws;
    const int gw = F.bid * NWAVES + F.wave, NGW = F.G * NWAVES, lane = F.lane, c0 = 16 * lane;
    bf16_t* xres = (bf16_t*)(ws + WS_XRES); const unsigned char* yb8 = ws + WS_YB;
    const int* aexp = (const int*)(ws + WS_AEXP); const int* apos = (const int*)(ws + WS_APOS); const float* aprob = (const float*)(ws + WS_APROB);
    const volatile LAS int* TS = (const volatile LAS int*)(F.lds + LC_TS);
    if (gw >= ntok) return;
    f32x4 g5[4], gn[4], sc1[4], sh[4]; int cur_v = -1;
    { const float* gp = last ? P.in[25] : P.in[4] + (size_t)(l + 1) * D;
#pragma unroll
      for (int q = 0; q < 4; ++q) gn[q] = *(const f32x4*)(gp + c0 + 4 * q); }
    i32x4 ae_n = *(const i32x4*)(aexp + (size_t)gw * 4), ap_n = *(const i32x4*)(apos + (size_t)gw * 4); f32x4 pr_n = *(const f32x4*)(aprob + (size_t)gw * 4);
    u32x4 wv[4], xo[2]; f32x4 pr;
    {
        int sl[4];
#pragma unroll
        for (int k = 0; k < 4; ++k) sl[k] = TS[ae_n[k]] * 256 + ap_n[k];
#pragma unroll
        for (int k = 0; k < 4; ++k) wv[k] = *(const u32x4*)(yb8 + (size_t)sl[k] * D + c0);
#pragma unroll
        for (int q = 0; q < 2; ++q) xo[q] = *(const u32x4*)(xres + (size_t)gw * D + c0 + 8 * q);
        pr = pr_n;
        const int m1 = (gw + NGW < ntok) ? gw + NGW : gw;
        ae_n = *(const i32x4*)(aexp + (size_t)m1 * 4); ap_n = *(const i32x4*)(apos + (size_t)m1 * 4); pr_n = *(const f32x4*)(aprob + (size_t)m1 * 4);
    }
    for (int m = gw; m < ntok; m += NGW) {
        const int v = (m >= NLAT) ? 2 : (m >= SEQ ? 1 : 0);
        if (v != cur_v) { cur_v = v;
            const float* mf = (const float*)(ws + WS_MODF) + ((size_t)l * 3 + v) * 6144; const float* mn = (const float*)(ws + WS_MODF) + ((size_t)((l + 1) & 1) * 3 + v) * 6144;
#pragma unroll
            for (int q = 0; q < 4; ++q) { g5[q] = *(const f32x4*)(mf + 5 * 1024 + c0 + 4 * q);
                if (!last) { sh[q] = *(const f32x4*)(mn + c0 + 4 * q); sc1[q] = *(const f32x4*)(mn + 1024 + c0 + 4 * q) + 1.0f; } } }
        f32x4 y[4];
#pragma unroll
        for (int q = 0; q < 4; ++q) y[q] = (f32x4){0.f, 0.f, 0.f, 0.f};
#pragma unroll
        for (int k = 0; k < 4; ++k) { const float pk_ = pr[k]; const u32x4 w4 = wv[k];
#pragma unroll
            for (int q = 0; q < 4; ++q) { const unsigned wd = (q == 0) ? w4.x : (q == 1 ? w4.y : (q == 2 ? w4.z : w4.w));
                const f32x2 lo = __builtin_amdgcn_cvt_pk_f32_fp8(wd, false), hi = __builtin_amdgcn_cvt_pk_f32_fp8(wd, true); y[q] += (f32x4){lo.x, lo.y, hi.x, hi.y} * pk_; } }
        f32x4 x[4];
        x[0] = (f32x4){bflo(xo[0].x), bfhi(xo[0].x), bflo(xo[0].y), bfhi(xo[0].y)} + g5[0] * y[0]; x[1] = (f32x4){bflo(xo[0].z), bfhi(xo[0].z), bflo(xo[0].w), bfhi(xo[0].w)} + g5[1] * y[1];
        x[2] = (f32x4){bflo(xo[1].x), bfhi(xo[1].x), bflo(xo[1].y), bfhi(xo[1].y)} + g5[2] * y[2]; x[3] = (f32x4){bflo(xo[1].z), bfhi(xo[1].z), bflo(xo[1].w), bfhi(xo[1].w)} + g5[3] * y[3];
        const int mn1 = m + NGW;
        if (mn1 < ntok) {
            int sl[4];
#pragma unroll
            for (int k = 0; k < 4; ++k) sl[k] = TS[ae_n[k]] * 256 + ap_n[k];
#pragma unroll
            for (int k = 0; k < 4; ++k) wv[k] = *(const u32x4*)(yb8 + (size_t)sl[k] * D + c0);
#pragma unroll
            for (int q = 0; q < 2; ++q) xo[q] = *(const u32x4*)(xres + (size_t)mn1 * D + c0 + 8 * q);
            pr = pr_n;
            const int m2 = (mn1 + NGW < ntok) ? mn1 + NGW : mn1;
            ae_n = *(const i32x4*)(aexp + (size_t)m2 * 4); ap_n = *(const i32x4*)(apos + (size_t)m2 * 4); pr_n = *(const f32x4*)(aprob + (size_t)m2 * 4); }
        float ss = 0.f;
#pragma unroll
        for (int q = 0; q < 4; ++q) ss += (x[q].x * x[q].x + x[q].y * x[q].y) + (x[q].z * x[q].z + x[q].w * x[q].w);
        const float rstd = 1.0f / sqrtf(wave_sum(ss) * (1.0f / D) + NORM_EPS);
        if (!last) {
#pragma unroll
            for (int q = 0; q < 2; ++q) { u32x4 o; o.x = pk2(x[2 * q].x, x[2 * q].y); o.y = pk2(x[2 * q].z, x[2 * q].w); o.z = pk2(x[2 * q + 1].x, x[2 * q + 1].y); o.w = pk2(x[2 * q + 1].z, x[2 * q + 1].w);
                *(u32x4*)(xres + (size_t)m * D + c0 + 8 * q) = o; }
            f32x4 hv[4];
#pragma unroll
            for (int q = 0; q < 4; ++q) hv[q] = (x[q] * rstd) * gn[q] * sc1[q] + sh[q];
            bf16_t* hrow = (bf16_t*)(ws + WS_HBUF) + (size_t)m * D + c0;
#pragma unroll
            for (int q = 0; q < 2; ++q) { u32x4 o; o.x = pk2(hv[2 * q].x, hv[2 * q].y); o.y = pk2(hv[2 * q].z, hv[2 * q].w); o.z = pk2(hv[2 * q + 1].x, hv[2 * q + 1].y); o.w = pk2(hv[2 * q + 1].z, hv[2 * q + 1].w);
                *(u32x4*)(hrow + 8 * q) = o; }
            if (F8_GEMM1[(l + 1) & 1]) { u32x4 o; o.x = pk4_fp8(hv[0].x, hv[0].y, hv[0].z, hv[0].w); o.y = pk4_fp8(hv[1].x, hv[1].y, hv[1].z, hv[1].w); o.z = pk4_fp8(hv[2].x, hv[2].y, hv[2].z, hv[2].w); o.w = pk4_fp8(hv[3].x, hv[3].y, hv[3].z, hv[3].w);
                *(u32x4*)(ws + WS_HB8 + (size_t)m * D + c0) = o; }
        } else {
#pragma unroll
            for (int q = 0; q < 4; ++q) *(f32x4*)(P.out + (size_t)m * D + c0 + 4 * q) = (x[q] * rstd) * gn[q];
        }
    }
}

#ifndef REP_PRO
#define REP_PRO 1
#endif
#ifndef REP_GEMM1
#define REP_GEMM1 1
#endif
#ifndef REP_G1U
#define REP_G1U 1
#endif
#ifndef REP_F1U
#define REP_F1U 1
#endif
#ifndef REP_CONV
#define REP_CONV 1
#endif
#ifndef REP_F2U
#define REP_F2U 1
#endif
#ifndef REP_G3U
#define REP_G3U 1
#endif
#ifndef REP_GU
#define REP_GU 1
#endif
#ifndef REP_DN
#define REP_DN 1
#endif
#ifndef REP_GATH
#define REP_GATH 1
#endif
__global__ void __launch_bounds__(NTHREADS, 2) mega_fwd(Params P0) {
    extern __shared__ __attribute__((aligned(16))) unsigned char lds_raw[];
    Frame F0; F0.lds = (LAS unsigned char*)lds_raw; F0.tid = threadIdx.x; F0.lane = F0.tid & 63; F0.wave = __builtin_amdgcn_readfirstlane(F0.tid >> 6); F0.G = gridDim.x; F0.bid = blockIdx.x;
#define KAS __attribute__((address_space(4)))
    struct ParamsK { const GAS float* in[26]; GAS float* out; GAS unsigned char* ws; };
#define PHASE_ENV() Frame F = F0; asm volatile("" : "+v"(F.tid)); F.lane = F.tid & 63; F.wave = __builtin_amdgcn_readfirstlane(F.tid >> 6); asm volatile("" : "+s"(F.bid), "+s"(F.G)); \
    const KAS ParamsK* kp_ = (const KAS ParamsK*)__builtin_amdgcn_kernarg_segment_ptr(); asm volatile("" : "+s"(kp_)); Params P; \
    _Pragma("unroll") for (int i_ = 0; i_ < 26; ++i_) P.in[i_] = (const float*)kp_->in[i_]; \
    P.out = (float*)kp_->out; P.ws = (unsigned char*)kp_->ws; unsigned char* ws = P.ws; (void)ws;
    { PHASE_ENV();
    for (int u = F.tid; u < (LDS_BYTES - LCTL_OFF) / 4; u += NTHREADS) ((LAS unsigned*)(F.lds + LCTL_OFF))[u] = 0u;
    LDS_BARRIER();
    }
    { PHASE_ENV(); (void)xcd_barrier_post((unsigned*)(ws + WS_CTL) + CW_BAR, (volatile LAS unsigned*)(F.lds + LC_BAR)); }
#define GRID_BAR() do { PHASE_ENV(); XcdBarrier b_; b_.bar = (unsigned*)(ws + WS_CTL) + CW_BAR; b_.x = xb_xcc_id(); b_.st = (volatile LAS unsigned*)(F.lds + LC_BAR); xcd_barrier(b_); } while (0)

    for (int rep = 0; rep < REP_PRO; ++rep) { PHASE_ENV(); phase_prologue(F, P); }
    GRID_BAR();
    { PHASE_ENV(); phase_p1(F, P); }
    GRID_BAR();

    {
        constexpr int l = 0; constexpr bool last = (l == DEPTH - 1);
        for (int rep = 0; rep < REP_GEMM1; ++rep) { PHASE_ENV();
          pg8::StaticOrder S; S.init(NTOK, INP, F.G, F.bid);
          if constexpr (F8_GEMM1[l]) {
              pg8::Gemm g{(const bf16_t*)(ws + WS_HB8), (const bf16_t*)(ws + WS_WIN + (size_t)l * INP * D * 2), NTOK, INP, D / 2};
              pg8::EpiStoreBf16S E{(bf16_t*)(ws + WS_PBUF), INP};
              pg8::gemm_phase<pg8::EpiStoreBf16S, pg8::StaticOrder, true, true, true>(F.lds, g, S, E, F.tid);
          } else {
              pg8::Gemm g{(const bf16_t*)(ws + WS_HBUF), (const bf16_t*)(ws + WS_WIN) + (size_t)l * INP * D, NTOK, INP, D};
              pg8::EpiStoreBf16 E{(bf16_t*)(ws + WS_PBUF), INP};
              pg8::gemm_phase<pg8::EpiStoreBf16, pg8::StaticOrder>(F.lds, g, S, E, F.tid); }
          const int nun = (NTOK / 256) * (INP / 256), rr = nun % F.G, first = (rr == 0) ? 0 : rr, nidle = F.G - first;
          if (F.bid >= first) for (int t = F.bid - first; t < NTOK / 256; t += nidle) {
              SkEpiBf16 SE{(bf16_t*)(ws + WS_LRB) + (size_t)t * 256 * 32, 32};
              skinny_unit(F, (const bf16_t*)(ws + WS_HBUF) + (size_t)t * 256 * D, (const bf16_t*)(ws + WS_WGT) + (size_t)l * 32 * D, SE); } }
        GRID_BAR();
        for (int rep = 0; rep < REP_G1U; ++rep) { PHASE_ENV();
        { LAS unsigned char* scr8 = F.lds + GL_WT8 + F.wave * 2304; const int gw_ = F.bid * NWAVES + F.wave, NGW_ = F.G * NWAVES; int q_ = gw_;
          constexpr int QHI = 16 * WT_I_GU;
        G1Ops ops_; { int r0_, h0_; gla_unit_rows(F.bid, r0_, h0_); ops_.gr = gla_load_gate_regs(F, P, l, r0_, h0_); gla_load_kt(F, P, r0_, h0_, ops_.kv); gla_load_v(F, P, r0_, h0_, ops_.vv); }
        for (int u = F.bid; u < 2080; u += F.G) { int nrow0, nh; const bool hn_ = u + F.G < 2080; gla_unit_rows(hn_ ? u + F.G : u, nrow0, nh);
            const bool bgw = q_ < QHI; float tv_[32];
            const WtSrc ws_ = wt_decode(P, l, bgw ? q_ : q_ - NGW_); wt_issue(ws_, F.lane, tv_);
            gla_g1_unit(F, P, l, u, ops_, hn_, nrow0, nh);
            wt_finish(ws_, F.lane, tv_, scr8); if (bgw) q_ += NGW_; }
        for (; q_ < QHI; q_ += NGW_) { WtSrc ws_ = wt_decode(P, l, q_); float tv_[32]; wt_issue(ws_, F.lane, tv_); wt_finish(ws_, F.lane, tv_, scr8); } }
        LDS_BARRIER(); }
        for (int rep = 0; rep < REP_F1U; ++rep) { PHASE_ENV();
        { f1_lat_tables(F, P);
          F1Ops fo_; { const int u = F.bid, b = u >> 9, nlo = (u >> 2) & 127, h = u & 3; f1_lat_load_u(F, P, b * SEQ + nlo, h, fo_.uv); f1_lat_load_t(F, (const bf16_t*)(ws + WS_TLAT) + (size_t)nlo * 32768, fo_.tcp, fo_.tsp); }
          for (int u = F.bid; u < 1024; u += F.G) { const int b = u >> 9, nlo = (u >> 2) & 127, h = u & 3; const bool hn_ = u + F.G < 1024; const int un = hn_ ? u + F.G : u, bn = un >> 9, nlon = (un >> 2) & 127, hn = un & 3;
            fourier_f1_lat_unit(F, P, h, b * SEQ + nlo, fo_, hn_, bn * SEQ + nlon, hn, (const bf16_t*)(ws + WS_TLAT) + (size_t)nlon * 32768); } }
        }
        { PHASE_ENV();
        if (!last) for (int u = (F.bid + F.G - 32) % F.G; u < 8; u += F.G) { const int b = u >> 2, h = u & 3;
            fourier_f1_unit<256, 2>(F, P, NLAT + b * CTXL, 1, h, (const bf16_t*)(ws + WS_TCTX), NLAT + b * CTXL, 1.0f / 128.0f); }
        }
        for (int rep = 0; rep < REP_CONV; ++rep) { PHASE_ENV();
        for (int u = F.bid; u < 512 + F.G; u += F.G) {
            int rowbase = 64 * u, Ls = 64, t0 = 0;
            if (u >= 512) { const int q = (u - 512) - 40; if (last || q < 0 || q >= 8) break; rowbase = NLAT + (q >> 2) * CTXL; Ls = CTXL; t0 = 64 * (q & 3); }
            conv_unit(F, P, l, rowbase, Ls, t0); } }
        GRID_BAR();
        { PHASE_ENV(); gla_scan(F, P, l * WT_PER_LAYER + WT_I_IN + WT_I_OUT + NE * WT_I_GU, (l + 1) * WT_PER_LAYER); LDS_BARRIER(); }
        for (int rep = 0; rep < REP_F2U; ++rep) { PHASE_ENV();
        fourier_f2_tables(F, P);
        for (int u = F.bid; u < 512; u += F.G) fourier_f2_unit(F, P, u >> 8, (u >> 1) & 127, u & 1); }
        GRID_BAR();
        for (int rep = 0; rep < REP_G3U; ++rep) { PHASE_ENV();
        { LAS unsigned char* scr8 = F.lds + GL_WT8 + F.wave * 2304; const int gw_ = F.bid * NWAVES + F.wave, NGW_ = F.G * NWAVES; int q_ = 16 * WT_I_GU + gw_;
          constexpr int QHI = NE * WT_I_GU;
        constexpr int NU3 = last ? 2048 : 2080;
        float ngv_[4];
#pragma unroll
        for (int nt = 0; nt < 4; ++nt) ngv_[nt] = (P.in[13] + (size_t)l * 128)[(F.wave >> 2) * 64 + nt * 16 + (F.lane & 15)];
        G3Ops ops_; { int r0_, h0_; gla_unit_rows(F.bid, r0_, h0_); ops_.gr = gla_load_gate_regs(F, P, l, r0_, h0_); gla_load_q(F, P, r0_, h0_, ops_.qv); gla_load_k(F, P, r0_, h0_, ops_.kv);
            gla_load_v(F, P, r0_, h0_, ops_.vv); gla_load_r(F, P, r0_, h0_, ops_.rv); gla_load_state(F, P, F.bid, ops_.stv); }
        for (int u = F.bid; u < NU3; u += F.G) { int row0, h, nrow0, nh; gla_unit_rows(u, row0, h); const bool hn_ = u + F.G < NU3; gla_unit_rows(hn_ ? u + F.G : u, nrow0, nh);
            const bool bgw = q_ < QHI; float tv_[32];
            const WtSrc ws_ = wt_decode(P, l, bgw ? q_ : q_ - NGW_); wt_issue(ws_, F.lane, tv_);
            gla_g3_unit(F, P, l, row0, h, u, ops_, ngv_, hn_, nrow0, nh, hn_ ? u + F.G : u);
            wt_finish(ws_, F.lane, tv_, scr8); if (bgw) q_ += NGW_; }
        for (; q_ < QHI; q_ += NGW_) { WtSrc ws_ = wt_decode(P, l, q_); float tv_[32]; wt_issue(ws_, F.lane, tv_); wt_finish(ws_, F.lane, tv_, scr8); } }
        LDS_BARRIER(); }
        GRID_BAR();
        { PHASE_ENV(); const int M2 = NLAT;
          pg8::Gemm g{(const bf16_t*)(ws + WS_CAT), (const bf16_t*)(ws + WS_WOUT) + (size_t)l * D * D, M2, D, D};
          pg8::StaticOrder S; S.init(M2, D, F.G, F.bid);
          pg8::EpiResid<l == 0> E{(bf16_t*)(ws + WS_XRES), (l == 0) ? (const void*)P.in[0] : (const void*)(ws + WS_XRES), (const float*)(ws + WS_MODF) + (size_t)l * 3 * 6144};
          pg8::gemm_phase<pg8::EpiResid<l == 0>, pg8::StaticOrder>(F.lds, g, S, E, F.tid);
          if (!last) for (int t = F.bid; t < 2 * 32; t += F.G) { const int pm = NLAT / 256 + (t >> 5), nt32 = t & 31;
              SkEpiResid SE{(bf16_t*)(ws + WS_XRES) + (size_t)pm * 256 * D + nt32 * 32, P.in[2] + (size_t)(pm - NLAT / 256) * 256 * D + nt32 * 32, (const float*)(ws + WS_MODF) + ((size_t)l * 3 + 2) * 6144 + 2 * 1024 + nt32 * 32};
              skinny_unit(F, (const bf16_t*)(ws + WS_CAT) + (size_t)pm * 256 * D, (const bf16_t*)(ws + WS_WOUT) + (size_t)l * D * D + (size_t)nt32 * 32 * D, SE); } }
        GRID_BAR();
        const int ntok = last ? NLAT : NTOK;
        { PHASE_ENV(); phase_route(F, P, l, ntok); }
        GRID_BAR();
        for (int rep = 0; rep < REP_GU; ++rep) { PHASE_ENV(); moe_prep(F, P, l); const volatile LAS int* TS = (const volatile LAS int*)(F.lds + LC_TS);
          pg8::MoeOrder S{8, F.G, F.bid, TS[NE], TS};
          if constexpr (F8_LAYER[l]) {
              pg8::Gemm g{(const bf16_t*)(ws + WS_HB8), (const bf16_t*)(ws + WS_WGU + (size_t)l * NE * 2048 * D * 2), 0, 2048, D / 2};
              pg8::EpiGateUp8 E{ws + WS_ACT, P.in[22] + (size_t)l * NE * 2048};
              pg8::gemm_phase_gather<pg8::EpiGateUp8, pg8::MoeOrder, true>(F.lds, g, (const int*)(ws + WS_XB), S, E, F.tid);
          } else {
              pg8::Gemm g{(const bf16_t*)(ws + WS_HBUF), (const bf16_t*)(ws + WS_WGU) + (size_t)l * NE * 2048 * D, 0, 2048, D};
              pg8::EpiGateUp E{(bf16_t*)(ws + WS_ACT), P.in[22] + (size_t)l * NE * 2048};
              pg8::gemm_phase_gather<pg8::EpiGateUp, pg8::MoeOrder>(F.lds, g, (const int*)(ws + WS_XB), S, E, F.tid); } }
        GRID_BAR();
        for (int rep = 0; rep < REP_DN; ++rep) { PHASE_ENV(); const volatile LAS int* TS = (const volatile LAS int*)(F.lds + LC_TS);
          pg8::MoeOrder S{4, F.G, F.bid, TS[NE], TS};
          if constexpr (F8_LAYER[l]) {
              pg8::Gemm g{(const bf16_t*)(ws + WS_ACT), (const bf16_t*)(ws + WS_WDN + (size_t)l * NE * D * DFF * 2), 0, D, DFF / 2};
              pg8::EpiDown8 E{ws + WS_YB, P.in[24] + (size_t)l * NE * D};
              pg8::gemm_phase<pg8::EpiDown8, pg8::MoeOrder, true, true, true>(F.lds, g, S, E, F.tid);
          } else {
              pg8::Gemm g{(const bf16_t*)(ws + WS_ACT), (const bf16_t*)(ws + WS_WDN) + (size_t)l * NE * D * DFF, 0, D, DFF};
              pg8::EpiDown E{(bf16_t*)(ws + WS_YB), P.in[24] + (size_t)l * NE * D};
              pg8::gemm_phase<pg8::EpiDown, pg8::MoeOrder>(F.lds, g, S, E, F.tid); } }
        GRID_BAR();
        { PHASE_ENV(); phase_combine(F, P, l, ntok, last); }
        if (!last) GRID_BAR();
    }
    {
        constexpr int l = 1; constexpr bool last = (l == DEPTH - 1);
        for (int rep = 0; rep < REP_GEMM1; ++rep) { PHASE_ENV();
          pg8::StaticOrder S; S.init(NTOK, INP, F.G, F.bid);
          if constexpr (F8_GEMM1[l]) {
              pg8::Gemm g{(const bf16_t*)(ws + WS_HB8), (const bf16_t*)(ws + WS_WIN + (size_t)l * INP * D * 2), NTOK, INP, D / 2};
              pg8::EpiStoreBf16S E{(bf16_t*)(ws + WS_PBUF), INP};
              pg8::gemm_phase<pg8::EpiStoreBf16S, pg8::StaticOrder, true, true, true>(F.lds, g, S, E, F.tid);
          } else {
              pg8::Gemm g{(const bf16_t*)(ws + WS_HBUF), (const bf16_t*)(ws + WS_WIN) + (size_t)l * INP * D, NTOK, INP, D};
              pg8::EpiStoreBf16 E{(bf16_t*)(ws + WS_PBUF), INP};
              pg8::gemm_phase<pg8::EpiStoreBf16, pg8::StaticOrder>(F.lds, g, S, E, F.tid); }
          const int nun = (NTOK / 256) * (INP / 256), rr = nun % F.G, first = (rr == 0) ? 0 : rr, nidle = F.G - first;
          if (F.bid >= first) for (int t = F.bid - first; t < NTOK / 256; t += nidle) {
              SkEpiBf16 SE{(bf16_t*)(ws + WS_LRB) + (size_t)t * 256 * 32, 32};
              skinny_unit(F, (const bf16_t*)(ws + WS_HBUF) + (size_t)t * 256 * D, (const bf16_t*)(ws + WS_WGT) + (size_t)l * 32 * D, SE); } }
        GRID_BAR();
        for (int rep = 0; rep < REP_G1U; ++rep) { PHASE_ENV();
        { LAS unsigned char* scr8 = F.lds + GL_WT8 + F.wave * 2304; const int gw_ = F.bid * NWAVES + F.wave, NGW_ = F.G * NWAVES; int q_ = gw_;
          constexpr int QHI = 16 * WT_I_GU;
        G1Ops ops_; { int r0_, h0_; gla_unit_rows(F.bid, r0_, h0_); ops_.gr = gla_load_gate_regs(F, P, l, r0_, h0_); gla_load_kt(F, P, r0_, h0_, ops_.kv); gla_load_v(F, P, r0_, h0_, ops_.vv); }
        for (int u = F.bid; u < 2080; u += F.G) { int nrow0, nh; const bool hn_ = u + F.G < 2080; gla_unit_rows(hn_ ? u + F.G : u, nrow0, nh);
            const bool bgw = q_ < QHI; float tv_[32];
            const WtSrc ws_ = wt_decode(P, l, bgw ? q_ : q_ - NGW_); wt_issue(ws_, F.lane, tv_);
            gla_g1_unit(F, P, l, u, ops_, hn_, nrow0, nh);
            wt_finish(ws_, F.lane, tv_, scr8); if (bgw) q_ += NGW_; }
        for (; q_ < QHI; q_ += NGW_) { WtSrc ws_ = wt_decode(P, l, q_); float tv_[32]; wt_issue(ws_, F.lane, tv_); wt_finish(ws_, F.lane, tv_, scr8); } }
        LDS_BARRIER(); }
        for (int rep = 0; rep < REP_F1U; ++rep) { PHASE_ENV();
        { f1_lat_tables(F, P);
          F1Ops fo_; { const int u = F.bid, b = u >> 9, nlo = (u >> 2) & 127, h = u & 3; f1_lat_load_u(F, P, b * SEQ + nlo, h, fo_.uv); f1_lat_load_t(F, (const bf16_t*)(ws + WS_TLAT) + (size_t)nlo * 32768, fo_.tcp, fo_.tsp); }
          for (int u = F.bid; u < 1024; u += F.G) { const int b = u >> 9, nlo = (u >> 2) & 127, h = u & 3; const bool hn_ = u + F.G < 1024; const int un = hn_ ? u + F.G : u, bn = un >> 9, nlon = (un >> 2) & 127, hn = un & 3;
            fourier_f1_lat_unit(F, P, h, b * SEQ + nlo, fo_, hn_, bn * SEQ + nlon, hn, (const bf16_t*)(ws + WS_TLAT) + (size_t)nlon * 32768); } }
        }
        { PHASE_ENV();
        if (!last) for (int u = (F.bid + F.G - 32) % F.G; u < 8; u += F.G) { const int b = u >> 2, h = u & 3;
            fourier_f1_unit<256, 2>(F, P, NLAT + b * CTXL, 1, h, (const bf16_t*)(ws + WS_TCTX), NLAT + b * CTXL, 1.0f / 128.0f); }
        }
        for (int rep = 0; rep < REP_CONV; ++rep) { PHASE_ENV();
        for (int u = F.bid; u < 512 + F.G; u += F.G) {
            int rowbase = 64 * u, Ls = 64, t0 = 0;
            if (u >= 512) { const int q = (u - 512) - 40; if (last || q < 0 || q >= 8) break; rowbase = NLAT + (q >> 2) * CTXL; Ls = CTXL; t0 = 64 * (q & 3); }
            conv_unit(F, P, l, rowbase, Ls, t0); } }
        GRID_BAR();
        { PHASE_ENV(); gla_scan(F, P, l * WT_PER_LAYER + WT_I_IN + WT_I_OUT + NE * WT_I_GU, (l + 1) * WT_PER_LAYER); LDS_BARRIER(); }
        for (int rep = 0; rep < REP_F2U; ++rep) { PHASE_ENV();
        fourier_f2_tables(F, P);
        for (int u = F.bid; u < 512; u += F.G) fourier_f2_unit(F, P, u >> 8, (u >> 1) & 127, u & 1); }
        GRID_BAR();
        for (int rep = 0; rep < REP_G3U; ++rep) { PHASE_ENV();
        { LAS unsigned char* scr8 = F.lds + GL_WT8 + F.wave * 2304; const int gw_ = F.bid * NWAVES + F.wave, NGW_ = F.G * NWAVES; int q_ = 16 * WT_I_GU + gw_;
          constexpr int QHI = NE * WT_I_GU;
        constexpr int NU3 = last ? 2048 : 2080;
        float ngv_[4];
#pragma unroll
        for (int nt = 0; nt < 4; ++nt) ngv_[nt] = (P.in[13] + (size_t)l * 128)[(F.wave >> 2) * 64 + nt * 16 + (F.lane & 15)];
        G3Ops ops_; { int r0_, h0_; gla_unit_rows(F.bid, r0_, h0_); ops_.gr = gla_load_gate_regs(F, P, l, r0_, h0_); gla_load_q(F, P, r0_, h0_, ops_.qv); gla_load_k(F, P, r0_, h0_, ops_.kv);
            gla_load_v(F, P, r0_, h0_, ops_.vv); gla_load_r(F, P, r0_, h0_, ops_.rv); gla_load_state(F, P, F.bid, ops_.stv); }
        for (int u = F.bid; u < NU3; u += F.G) { int row0, h, nrow0, nh; gla_unit_rows(u, row0, h); const bool hn_ = u + F.G < NU3; gla_unit_rows(hn_ ? u + F.G : u, nrow0, nh);
            const bool bgw = q_ < QHI; float tv_[32];
            const WtSrc ws_ = wt_decode(P, l, bgw ? q_ : q_ - NGW_); wt_issue(ws_, F.lane, tv_);
            gla_g3_unit(F, P, l, row0, h, u, ops_, ngv_, hn_, nrow0, nh, hn_ ? u + F.G : u);
            wt_finish(ws_, F.lane, tv_, scr8); if (bgw) q_ += NGW_; }
        for (; q_ < QHI; q_ += NGW_) { WtSrc ws_ = wt_decode(P, l, q_); float tv_[32]; wt_issue(ws_, F.lane, tv_); wt_finish(ws_, F.lane, tv_, scr8); } }
        LDS_BARRIER(); }
        GRID_BAR();
        { PHASE_ENV(); const int M2 = NLAT;
          pg8::Gemm g{(const bf16_t*)(ws + WS_CAT), (const bf16_t*)(ws + WS_WOUT) + (size_t)l * D * D, M2, D, D};
          pg8::StaticOrder S; S.init(M2, D, F.G, F.bid);
          pg8::EpiResid<l == 0> E{(bf16_t*)(ws + WS_XRES), (l == 0) ? (const void*)P.in[0] : (const void*)(ws + WS_XRES), (const float*)(ws + WS_MODF) + (size_t)l * 3 * 6144};
          pg8::gemm_phase<pg8::EpiResid<l == 0>, pg8::StaticOrder>(F.lds, g, S, E, F.tid);
          if (!last) for (int t = F.bid; t < 2 * 32; t += F.G) { const int pm = NLAT / 256 + (t >> 5), nt32 = t & 31;
              SkEpiResid SE{(bf16_t*)(ws + WS_XRES) + (size_t)pm * 256 * D + nt32 * 32, P.in[2] + (size_t)(pm - NLAT / 256) * 256 * D + nt32 * 32, (const float*)(ws + WS_MODF) + ((size_t)l * 3 + 2) * 6144 + 2 * 1024 + nt32 * 32};
              skinny_unit(F, (const bf16_t*)(ws + WS_CAT) + (size_t)pm * 256 * D, (const bf16_t*)(ws + WS_WOUT) + (size_t)l * D * D + (size_t)nt32 * 32 * D, SE); } }
        GRID_BAR();
        const int ntok = last ? NLAT : NTOK;
        { PHASE_ENV(); phase_route(F, P, l, ntok); }
        GRID_BAR();
        for (int rep = 0; rep < REP_GU; ++rep) { PHASE_ENV(); moe_prep(F, P, l); const volatile LAS int* TS = (const volatile LAS int*)(F.lds + LC_TS);
          pg8::MoeOrder S{8, F.G, F.bid, TS[NE], TS};
          if constexpr (F8_LAYER[l]) {
              pg8::Gemm g{(const bf16_t*)(ws + WS_HB8), (const bf16_t*)(ws + WS_WGU + (size_t)l * NE * 2048 * D * 2), 0, 2048, D / 2};
              pg8::EpiGateUp8 E{ws + WS_ACT, P.in[22] + (size_t)l * NE * 2048};
              pg8::gemm_phase_gather<pg8::EpiGateUp8, pg8::MoeOrder, true>(F.lds, g, (const int*)(ws + WS_XB), S, E, F.tid);
          } else {
              pg8::Gemm g{(const bf16_t*)(ws + WS_HBUF), (const bf16_t*)(ws + WS_WGU) + (size_t)l * NE * 2048 * D, 0, 2048, D};
              pg8::EpiGateUp E{(bf16_t*)(ws + WS_ACT), P.in[22] + (size_t)l * NE * 2048};
              pg8::gemm_phase_gather<pg8::EpiGateUp, pg8::MoeOrder>(F.lds, g, (const int*)(ws + WS_XB), S, E, F.tid); } }
        GRID_BAR();
        for (int rep = 0; rep < REP_DN; ++rep) { PHASE_ENV(); const volatile LAS int* TS = (const volatile LAS int*)(F.lds + LC_TS);
          pg8::MoeOrder S{4, F.G, F.bid, TS[NE], TS};
          if constexpr (F8_LAYER[l]) {
              pg8::Gemm g{(const bf16_t*)(ws + WS_ACT), (const bf16_t*)(ws + WS_WDN + (size_t)l * NE * D * DFF * 2), 0, D, DFF / 2};
              pg8::EpiDown8 E{ws + WS_YB, P.in[24] + (size_t)l * NE * D};
              pg8::gemm_phase<pg8::EpiDown8, pg8::MoeOrder, true, true, true>(F.lds, g, S, E, F.tid);
          } else {
              pg8::Gemm g{(const bf16_t*)(ws + WS_ACT), (const bf16_t*)(ws + WS_WDN) + (size_t)l * NE * D * DFF, 0, D, DFF};
              pg8::EpiDown E{(bf16_t*)(ws + WS_YB), P.in[24] + (size_t)l * NE * D};
              pg8::gemm_phase<pg8::EpiDown, pg8::MoeOrder>(F.lds, g, S, E, F.tid); } }
        GRID_BAR();
        { PHASE_ENV(); phase_combine(F, P, l, ntok, last); }
        if (!last) GRID_BAR();
    }
}

extern "C" void kernel_launch(void* const* d_in, const int* in_sizes, int n_in, void* d_out, int out_size, void* d_ws, size_t ws_size, hipStream_t stream) {
    static int grid = 0;
    if (grid == 0) {
        if (n_in != 26 || ws_size < WS_END) { fprintf(stderr, "kernel_launch: unexpected n_in %d or ws_size %zu (need %zu)\n", n_in, ws_size, (size_t)WS_END); grid = -1; return; }
        int dev = 0, cus = 0, per_cu = 0;
        if (hipGetDevice(&dev) != hipSuccess || hipDeviceGetAttribute(&cus, hipDeviceAttributeMultiprocessorCount, dev) != hipSuccess) { grid = -1; return; }
        if (hipFuncSetAttribute((const void*)mega_fwd, hipFuncAttributeMaxDynamicSharedMemorySize, LDS_BYTES) != hipSuccess) { fprintf(stderr, "kernel_launch: hipFuncSetAttribute failed\n"); grid = -1; return; }
        if (hipOccupancyMaxActiveBlocksPerMultiprocessor(&per_cu, (const void*)mega_fwd, NTHREADS, LDS_BYTES) != hipSuccess || per_cu < 1) { fprintf(stderr, "kernel_launch: occupancy query says %d\n", per_cu); }
        (void)hipGetLastError();
        grid = cus;
    }
    if (grid < 0) return;
    (void)hipMemsetAsync((char*)d_ws + WS_CTL, 0, CTL_ZERO_BYTES, stream);
    Params p{};
    for (int i = 0; i < 26; ++i) p.in[i] = (const float*)d_in[i];
    p.out = (float*)d_out; p.ws = (unsigned char*)d_ws;
    hipLaunchKernelGGL(mega_fwd, dim3(grid), dim3(NTHREADS), LDS_BYTES, stream, p);
}
```

```cpp
#include <hip/hip_runtime.h>
#include <cstdio>
#include <cstdint>

#define LAS __attribute__((address_space(3)))
#define GAS __attribute__((address_space(1)))
typedef unsigned short bf16_t;
typedef short bf16x8 __attribute__((ext_vector_type(8)));
typedef float f32x4 __attribute__((ext_vector_type(4)));
typedef float f32x2 __attribute__((ext_vector_type(2)));
typedef unsigned u32x4 __attribute__((ext_vector_type(4)));
typedef unsigned u32x2 __attribute__((ext_vector_type(2)));

constexpr int D = 1024, NBATCH = 2, SEQ = 16384, NLAT = NBATCH * SEQ, CTXL = 256, NCTX = NBATCH * CTXL, NTOK = NLAT + NCTX, DEPTH = 2;
constexpr int INW = 2336, INP = 2304;
constexpr int C_FOUR = 0, C_Q = 256, C_K = 512, C_V = 768, C_R = 1280, C_CA = 1792, C_CG = 2048;
constexpr int NE = 32, TOPK = 4, DFF = 1024;
constexpr int MAXROWS = NTOK * TOPK + NE * 256;
constexpr float NORM_EPS = 1e-6f;
constexpr int NTHREADS = 512, NWAVES = 8;

constexpr size_t MiB = 1u << 20;
constexpr size_t WS_CTL = 0, CTL_ZERO_BYTES = 1 * MiB;
constexpr size_t WS_MODP = 1 * MiB;
constexpr size_t WS_MODF = 3 * MiB;
constexpr size_t WS_RW = 3 * MiB + 512 * 1024;
constexpr size_t WS_WGT = 3 * MiB + 768 * 1024;
constexpr size_t WS_CM3 = 4 * MiB;
constexpr size_t WS_TF2 = 4 * MiB + 65536;
constexpr size_t WS_TCTX = 4 * MiB + 262144;
constexpr size_t WS_TLAT = 5 * MiB;
constexpr size_t WS_WIN = 13 * MiB;
constexpr size_t WS_WOUT = 23 * MiB;
constexpr size_t WS_WGU = 27 * MiB;
constexpr size_t WS_WDN = 283 * MiB;
constexpr size_t WS_XRES = 411 * MiB;
constexpr size_t WS_HBUF = 541 * MiB;
constexpr size_t WS_PBUF = 606 * MiB;
constexpr size_t WS_CAT = 769 * MiB;
constexpr size_t WS_T2 = 834 * MiB;
constexpr size_t WS_STATE = 866 * MiB;
constexpr size_t WS_DECAY = 996 * MiB;
constexpr size_t WS_AEXP = 998 * MiB, WS_APOS = 999 * MiB, WS_APROB = 1000 * MiB, WS_ASLOT = 1001 * MiB;
constexpr size_t WS_XB8 = 1106 * MiB;
constexpr size_t WS_HB8 = 1066 * MiB;
constexpr bool F8_LAYER[2] = {true, true};
constexpr bool F8_GEMM1[2] = {false, true};
constexpr size_t WS_LRB = 1018 * MiB;
constexpr size_t WS_XB = 1002 * MiB, WS_ACT = 1278 * MiB, WS_YB = 1554 * MiB, WS_END = 1830 * MiB;
constexpr int CW_BAR = 4096, CW_CNT = 16384;

constexpr int RING_BYTES = 131072;
constexpr int AUX_OFF = RING_BYTES;
constexpr int LCTL_OFF = RING_BYTES + 8192;
constexpr int LC_BIAS = LCTL_OFF + 2048;
constexpr int LDS_BYTES = 147456;

__device__ __forceinline__ unsigned pk2(float lo, float hi) { typedef __bf16 bf2_t __attribute__((ext_vector_type(2))); typedef float fl2_t __attribute__((ext_vector_type(2))); const fl2_t v = {lo, hi}; return __builtin_bit_cast(unsigned, __builtin_convertvector(v, bf2_t)); }
__device__ __forceinline__ unsigned f2bf(float f) { return pk2(f, 0.f) & 0xffffu; }
__device__ __forceinline__ float bf2f(unsigned b) { return __builtin_bit_cast(float, b << 16); }
__device__ __forceinline__ float bflo(unsigned w) { return __builtin_bit_cast(float, w << 16); }
__device__ __forceinline__ float bfhi(unsigned w) { return __builtin_bit_cast(float, w & 0xffff0000u); }
__device__ __forceinline__ float wave_sum(float v) {
#pragma unroll
    for (int o = 1; o < 64; o <<= 1) v += __shfl_xor(v, o);
    return v;
}
__device__ __forceinline__ float wave_sum_dpp(float v) {
#define WS_ROR(n) v += __builtin_bit_cast(float, __builtin_amdgcn_update_dpp(0, __builtin_bit_cast(int, v), 0x120 + (n), 0xf, 0xf, false));
    WS_ROR(8) WS_ROR(4) WS_ROR(2) WS_ROR(1)
#undef WS_ROR
    const int vi = __builtin_bit_cast(int, v);
    const float r0 = __builtin_bit_cast(float, __builtin_amdgcn_readlane(vi, 0)), r1 = __builtin_bit_cast(float, __builtin_amdgcn_readlane(vi, 16)), r2 = __builtin_bit_cast(float, __builtin_amdgcn_readlane(vi, 32)), r3 = __builtin_bit_cast(float, __builtin_amdgcn_readlane(vi, 48));
    return (r0 + r1) + (r2 + r3);
}
__device__ __forceinline__ float sigmoidf_(float x) { return __builtin_amdgcn_rcpf(1.0f + __builtin_amdgcn_exp2f(-1.44269504089f * x)); }

#define LDS_BARRIER() do { asm volatile("s_waitcnt lgkmcnt(0)" ::: "memory"); __builtin_amdgcn_s_barrier(); asm volatile("" ::: "memory"); } while (0)

#define XB_TMO      128
#define XB_XCNT(j)  (256  + 64 * (j))
#define XB_XSUB(j)  (1280 + 64 * (j))
#define XB_XGEN(j)  (2304 + 64 * (j))
#define XB_TOP      3328
#define XB_TOPGEN   3392
#define XCD_BAR_WORDS 3456
#define XB_SPIN_CAP (1u << 22)

__device__ __forceinline__ unsigned xb_ld(unsigned* p)              { return __hip_atomic_load(p, __ATOMIC_RELAXED, __HIP_MEMORY_SCOPE_AGENT); }
__device__ __forceinline__ unsigned xb_add(unsigned* p, unsigned v) { return __hip_atomic_fetch_add(p, v, __ATOMIC_RELAXED, __HIP_MEMORY_SCOPE_AGENT); }
__device__ __forceinline__ unsigned xb_xcc_id() { return (unsigned)__builtin_amdgcn_s_getreg((3 << 11) | 20) & 0xFu; }
#define XB_SPIN(cond, bar) do { unsigned _sp = 0; while (cond) { __builtin_amdgcn_s_sleep(1); \
    if ((++_sp & 255u) == 0u) { if (xb_ld(&(bar)[XB_TMO])) break; if (_sp > XB_SPIN_CAP) { atomicAdd(&(bar)[XB_TMO], 1u); break; } } } } while (0)

struct XcdBarrier { unsigned* bar; unsigned x; volatile LAS unsigned* st; };

__device__ __forceinline__ XcdBarrier xcd_barrier_post(unsigned* bar, volatile LAS unsigned* st) {
    XcdBarrier b; b.bar = bar; b.x = xb_xcc_id(); b.st = st;
    if (threadIdx.x == 0) (void)xb_add(&bar[XB_XCNT(b.x)], 1u);
    return b;
}
__device__ __forceinline__ void xcd_barrier_complete(unsigned* bar, unsigned x, unsigned& nloc, unsigned& nx) {
    const unsigned G = gridDim.x * gridDim.y * gridDim.z;
    unsigned sum, cnt, mine, sp = 0u;
    for (;;) {
        sum = 0u; cnt = 0u; mine = 0u;
#pragma unroll
        for (unsigned j = 0; j < 16; ++j) { const unsigned c = xb_ld(&bar[XB_XCNT(j)]); sum += c; cnt += (c > 0u) ? 1u : 0u; mine = (j == x) ? c : mine; }
        if (sum == G) break;
        __builtin_amdgcn_s_sleep(1);
        if ((++sp & 255u) == 0u) { if (xb_ld(&bar[XB_TMO])) break; if (sp > XB_SPIN_CAP) { atomicAdd(&bar[XB_TMO], 1u); break; } }
    }
    nloc = mine > 0u ? mine : 1u; nx = cnt > 0u ? cnt : 1u;
}
__device__ __forceinline__ void xcd_barrier_t0(const XcdBarrier& b) {
    if (threadIdx.x == 0) {
        unsigned* bar = b.bar;
        __builtin_amdgcn_s_waitcnt(0);
        unsigned nloc = b.st[0], nx = b.st[1];
        if (nloc == 0u) { xcd_barrier_complete(bar, b.x, nloc, nx); b.st[0] = nloc; b.st[1] = nx; }
        const unsigned old = xb_add(&bar[XB_XSUB(b.x)], 1u);
        const unsigned gen = old / nloc;
        if (old + 1u == (gen + 1u) * nloc) {
            __builtin_amdgcn_fence(__ATOMIC_RELEASE, "agent");
            asm volatile("s_waitcnt vmcnt(0)" ::: "memory");
            const unsigned og = xb_add(&bar[XB_TOP], 1u);
            const unsigned tg = og / nx;
            if (og + 1u == (tg + 1u) * nx) xb_add(&bar[XB_TOPGEN], 1u);
            else XB_SPIN(xb_ld(&bar[XB_TOPGEN]) == tg, bar);
            __builtin_amdgcn_fence(__ATOMIC_ACQUIRE, "agent");
            xb_add(&bar[XB_XGEN(b.x)], 1u);
            asm volatile("s_waitcnt vmcnt(0)" ::: "memory");
        } else {
            XB_SPIN(xb_ld(&bar[XB_XGEN(b.x)]) == gen, bar);
            __builtin_amdgcn_fence(__ATOMIC_ACQUIRE, "agent");
            asm volatile("s_waitcnt vmcnt(0)" ::: "memory");
        }
    }
}
__device__ __forceinline__ void xcd_barrier(const XcdBarrier& b) {
    asm volatile("s_waitcnt vmcnt(0)" ::: "memory");
    __syncthreads();
    xcd_barrier_t0(b);
    __syncthreads();
}

constexpr int PB_CHUNK = 64 * INP, PB_V = 49152, PB_CA = 114688;
__device__ __forceinline__ size_t pb_addr(int row, int col) {
    const size_t cb = (size_t)(row >> 6) * PB_CHUNK; const int tl = row & 63;
    if (col < C_V) { const int comp = col >> 8, cc = col & 255; return cb + comp * 16384 + ((cc >> 6) * 64 + tl) * 64 + (cc & 63); }
    if (col < C_CA) { const int cc = col - C_V, comp = cc >> 9, c2 = cc & 511; return cb + PB_V + comp * 32768 + ((c2 >> 7) * 64 + tl) * 128 + (c2 & 127); }
    const int cc = col - C_CA, comp = cc >> 8; return cb + PB_CA + comp * 16384 + tl * 256 + (cc & 255);
}
namespace pg8 {
constexpr int BM = 256, BK = 64, HALF = 128, HTB = HALF * BK * 2, STAGE_BYTES = 8 * HTB, NXCD = 8, WGM = 8;
__host__ __device__ __forceinline__ int lds_byte(int r, int c) { const int st = (r >> 4) * 2 + (c >> 5), rr = r & 15, cc = c & 31, ob = rr * 64 + cc * 2; return st * 1024 + (ob ^ (((ob >> 9) & 1) << 5)); }
__host__ __device__ __forceinline__ void stage_rc(int b, int& R, int& C) { const int st = b / 1024, sb = b % 1024, swz = sb ^ (((sb >> 9) & 1) << 5); R = (st >> 1) * 16 + swz / 64; C = (st & 1) * 32 + (swz % 64) / 2; }
__host__ __device__ __forceinline__ int perm32(int rho) { const int n = rho >> 4, i = rho & 15; return 8 * (i >> 2) + 4 * n + (i & 3); }

struct Unit { int pm, pn, lbase, nvalid; };
struct Gemm { const bf16_t* A; const bf16_t* Bt; int M, N, K; };

struct StaticOrder {
    int nM, nN, nwg, G, c;
    __device__ void init(int M, int N, int G_, int c_) { nM = M / BM; nN = N / BM; nwg = nM * nN; G = G_; c = c_; }
    __device__ bool next(int i, Unit& u) const {
        const long L = (long)i * G + c; if (L >= nwg) return false;
        int wgid = (int)L; { const int q = nwg / NXCD, r = nwg % NXCD, xcd = wgid % NXCD, off = wgid / NXCD; wgid = (xcd < r ? xcd * (q + 1) : r * (q + 1) + (xcd - r) * q) + off; }
        const int nig = WGM * nN, gid = wgid / nig, fm = gid * WGM, gsz = (nM - fm) < WGM ? (nM - fm) : WGM;
        u.pm = fm + ((wgid % nig) % gsz); u.pn = (wgid % nig) / gsz; u.lbase = 0; u.nvalid = 0; return true;
    }
};
struct MoeOrder {
    int nN, G, c, MT; const volatile LAS int* ts;
    __device__ bool next(int i, Unit& u) const {
        const long L = (G % 8 == 0) ? ((long)i * G + (long)(c & 7) * (G >> 3) + (c >> 3)) : ((long)i * G + c);
        if (L >= (long)MT * nN) return false;
        const int mt = (int)(L / nN), pl = (int)(L % nN);
        const int lane = threadIdx.x & 63;
        const unsigned long long bal = __ballot(lane >= 1 && lane < NE && ts[lane] <= mt);
        const int e = __popcll(bal);
        const int j = mt - ts[e];
        u.pm = mt; u.pn = e * nN + pl; u.lbase = e * NTOK + j * 256; u.nvalid = ts[64 + e] - j * 256; return true;
    }
};

__device__ __forceinline__ unsigned cvt_pk_bf16(float lo, float hi) { unsigned r; asm volatile("v_cvt_pk_bf16_f32 %0, %1, %2" : "=v"(r) : "v"(lo), "v"(hi)); return r; }

struct EpiStoreBf16 {
    static constexpr bool PERM = true; static constexpr int NST = 16; static constexpr bool BIAS_DMA = false;
    bf16_t* O; int ldc;
    __device__ __forceinline__ void operator()(const f32x4 (&acc)[2][2][4][2], const Unit& u, int wr, int wc, int fr, int fq, const LAS float* bl) const {
        const int row0 = u.pm * BM + wr * 64 + fr; const int col0 = u.pn * BM + wc * 32 + 8 * fq;
#pragma unroll
        for (int ai = 0; ai < 2; ++ai)
#pragma unroll
            for (int m = 0; m < 4; ++m) {
#pragma unroll
                for (int bj = 0; bj < 2; ++bj) { const f32x4 v0 = acc[ai][bj][m][0], v1 = acc[ai][bj][m][1];
                    u32x4 w; w.x = cvt_pk_bf16(v0[0], v0[1]); w.y = cvt_pk_bf16(v0[2], v0[3]); w.z = cvt_pk_bf16(v1[0], v1[1]); w.w = cvt_pk_bf16(v1[2], v1[3]);
                    *(u32x4*)(O + pb_addr(row0 + ai * HALF + m * 16, col0 + bj * HALF)) = w; } }
    }
};
struct EpiStoreBf16S {
    static constexpr bool PERM = true; static constexpr int NST = 16; static constexpr bool BIAS_DMA = false;
    bf16_t* O; int ldc;
    __device__ __forceinline__ void operator()(const f32x4 (&acc)[2][2][4][2], const Unit& u, int wr, int wc, int fr, int fq, const LAS float* bl) const {
        const int row0 = u.pm * BM + wr * 64 + fr; const int col0 = u.pn * BM + wc * 32 + 8 * fq;
#pragma unroll
        for (int ai = 0; ai < 2; ++ai)
#pragma unroll
            for (int m = 0; m < 4; ++m) {
#pragma unroll
                for (int bj = 0; bj < 2; ++bj) { const f32x4 v0 = acc[ai][bj][m][0] * 0.015625f, v1 = acc[ai][bj][m][1] * 0.015625f;
                    u32x4 w; w.x = cvt_pk_bf16(v0[0], v0[1]); w.y = cvt_pk_bf16(v0[2], v0[3]); w.z = cvt_pk_bf16(v1[0], v1[1]); w.w = cvt_pk_bf16(v1[2], v1[3]);
                    *(u32x4*)(O + pb_addr(row0 + ai * HALF + m * 16, col0 + bj * HALF)) = w; } }
    }
};
template <bool XS_F32>
struct EpiResid {
    static constexpr bool PERM = true; static constexpr int NST = 0; static constexpr bool BIAS_DMA = false;
    bf16_t* X; const void* Xs; const float* modf;
    __device__ __forceinline__ void operator()(const f32x4 (&acc)[2][2][4][2], const Unit& u, int wr, int wc, int fr, int fq, const LAS float* bl) const {
        const int row0 = u.pm * BM + wr * 64 + fr, col0 = u.pn * BM + wc * 32 + 8 * fq;
        const int v = (u.pm >= NLAT / BM) ? 2 : (u.pm >= SEQ / BM ? 1 : 0);
        const float* gv = modf + (size_t)v * 6144 + 2 * 1024;
        f32x4 bv[2][2];
#pragma unroll
        for (int bj = 0; bj < 2; ++bj)
#pragma unroll
            for (int n = 0; n < 2; ++n) bv[bj][n] = *(const f32x4*)(gv + col0 + bj * HALF + 4 * n);
#pragma unroll
        for (int ai = 0; ai < 2; ++ai) {
            if constexpr (XS_F32) {
                f32x4 xv[4][2][2];
#pragma unroll
                for (int m = 0; m < 4; ++m) { const float* rowp = (const float*)Xs + (size_t)(row0 + ai * HALF + m * 16) * D + col0;
#pragma unroll
                    for (int bj = 0; bj < 2; ++bj)
#pragma unroll
                        for (int n = 0; n < 2; ++n) xv[m][bj][n] = *(const f32x4*)(rowp + bj * HALF + 4 * n); }
#pragma unroll
                for (int m = 0; m < 4; ++m) { bf16_t* rowp = X + (size_t)(row0 + ai * HALF + m * 16) * D + col0;
#pragma unroll
                    for (int bj = 0; bj < 2; ++bj) { const f32x4 v0 = xv[m][bj][0] + bv[bj][0] * acc[ai][bj][m][0], v1 = xv[m][bj][1] + bv[bj][1] * acc[ai][bj][m][1];
                        u32x4 w; w.x = cvt_pk_bf16(v0[0], v0[1]); w.y = cvt_pk_bf16(v0[2], v0[3]); w.z = cvt_pk_bf16(v1[0], v1[1]); w.w = cvt_pk_bf16(v1[2], v1[3]);
                        *(u32x4*)(rowp + bj * HALF) = w; } }
            } else {
                u32x4 xv[4][2];
#pragma unroll
                for (int m = 0; m < 4; ++m) { const bf16_t* rowp = (const bf16_t*)Xs + (size_t)(row0 + ai * HALF + m * 16) * D + col0;
#pragma unroll
                    for (int bj = 0; bj < 2; ++bj) xv[m][bj] = *(const u32x4*)(rowp + bj * HALF); }
#pragma unroll
                for (int m = 0; m < 4; ++m) { bf16_t* rowp = X + (size_t)(row0 + ai * HALF + m * 16) * D + col0;
#pragma unroll
                    for (int bj = 0; bj < 2; ++bj) { const u32x4 xw = xv[m][bj];
                        const f32x4 x0 = {bflo(xw.x), bfhi(xw.x), bflo(xw.y), bfhi(xw.y)}, x1 = {bflo(xw.z), bfhi(xw.z), bflo(xw.w), bfhi(xw.w)};
                        const f32x4 v0 = x0 + bv[bj][0] * acc[ai][bj][m][0], v1 = x1 + bv[bj][1] * acc[ai][bj][m][1];
                        u32x4 w; w.x = cvt_pk_bf16(v0[0], v0[1]); w.y = cvt_pk_bf16(v0[2], v0[3]); w.z = cvt_pk_bf16(v1[0], v1[1]); w.w = cvt_pk_bf16(v1[2], v1[3]);
                        *(u32x4*)(rowp + bj * HALF) = w; } }
            }
        }
    }
};
struct EpiGateUp {
    static constexpr bool PERM = true; static constexpr int NST = 0; static constexpr bool BIAS_DMA = false;
    bf16_t* O; const float* bgu;
    __device__ __forceinline__ void operator()(const f32x4 (&acc)[2][2][4][2], const Unit& u, int wr, int wc, int fr, int fq, const LAS float* bl) const {
        const int e = u.pn >> 3, pl = u.pn & 7;
        const int row0 = u.pm * BM + wr * 64 + fr; const int cl = pl * 128 + wc * 32 + 8 * fq;
        const float* bg = bgu + (size_t)e * 2048 + cl; const float* bu = bg + 1024;
        f32x4 g0 = *(const f32x4*)bg, g1 = *(const f32x4*)(bg + 4), u0 = *(const f32x4*)bu, u1 = *(const f32x4*)(bu + 4);
#pragma unroll
        for (int ai = 0; ai < 2; ++ai)
#pragma unroll
            for (int m = 0; m < 4; ++m) { bf16_t* rowp = O + (size_t)(row0 + ai * HALF + m * 16) * DFF + cl;
                float r[8];
#pragma unroll
                for (int n = 0; n < 2; ++n) { const f32x4 gb = n ? g1 : g0, ub = n ? u1 : u0; const f32x4 ga = acc[ai][0][m][n] + gb, ua = acc[ai][1][m][n] + ub;
#pragma unroll
                    for (int j = 0; j < 4; ++j) { const float gate = fminf(ga[j], 7.0f), up = fminf(fmaxf(ua[j], -7.0f), 7.0f);
                        r[n * 4 + j] = gate * __builtin_amdgcn_rcpf(1.0f + __expf(-1.702f * gate)) * (up + 1.0f); } }
                u32x4 w; w.x = cvt_pk_bf16(r[0], r[1]); w.y = cvt_pk_bf16(r[2], r[3]); w.z = cvt_pk_bf16(r[4], r[5]); w.w = cvt_pk_bf16(r[6], r[7]);
                *(u32x4*)rowp = w; }
    }
};
struct EpiDown {
    static constexpr bool PERM = true; static constexpr int NST = 0; static constexpr bool BIAS_DMA = false;
    bf16_t* O; const float* bdn;
    __device__ __forceinline__ void operator()(const f32x4 (&acc)[2][2][4][2], const Unit& u, int wr, int wc, int fr, int fq, const LAS float* bl) const {
        const int e = u.pn >> 2, pl = u.pn & 3;
        const int row0 = u.pm * BM + wr * 64 + fr; const int col0 = pl * BM + wc * 32 + 8 * fq;
        f32x4 bv[2][2];
#pragma unroll
        for (int bj = 0; bj < 2; ++bj)
#pragma unroll
            for (int n = 0; n < 2; ++n) bv[bj][n] = *(const f32x4*)(bdn + (size_t)e * 1024 + col0 + bj * HALF + 4 * n);
#pragma unroll
        for (int ai = 0; ai < 2; ++ai)
#pragma unroll
            for (int m = 0; m < 4; ++m) { bf16_t* rowp = O + (size_t)(row0 + ai * HALF + m * 16) * D + col0;
#pragma unroll
                for (int bj = 0; bj < 2; ++bj) { const f32x4 v0 = acc[ai][bj][m][0] + bv[bj][0], v1 = acc[ai][bj][m][1] + bv[bj][1];
                    u32x4 w; w.x = cvt_pk_bf16(v0[0], v0[1]); w.y = cvt_pk_bf16(v0[2], v0[3]); w.z = cvt_pk_bf16(v1[0], v1[1]); w.w = cvt_pk_bf16(v1[2], v1[3]);
                    *(u32x4*)(rowp + bj * HALF) = w; } }
    }
};

__device__ __forceinline__ unsigned pk4_fp8(float a, float b, float c, float d) { unsigned w = 0u; w = __builtin_amdgcn_cvt_pk_fp8_f32(a, b, w, false); w = __builtin_amdgcn_cvt_pk_fp8_f32(c, d, w, true); return w; }
struct EpiGateUp8 {
    static constexpr bool PERM = true; static constexpr int NST = 8; static constexpr bool BIAS_DMA = true;
    unsigned char* O; const float* bgu;
    __device__ __forceinline__ const float* bias_src(const Unit& u, int lane) const { const int e = u.pn >> 3, pl = u.pn & 7; return bgu + (size_t)e * 2048 + (lane >> 5) * 1024 + pl * 128 + (lane & 31) * 4; }
    __device__ __forceinline__ void operator()(const f32x4 (&acc)[2][2][4][2], const Unit& u, int wr, int wc, int fr, int fq, const LAS float* bl) const {
        const int e = u.pn >> 3, pl = u.pn & 7;
        const int row0 = u.pm * BM + wr * 64 + fr; const int cl = pl * 128 + wc * 32 + 8 * fq;
        (void)e; const LAS float* bgl = bl + wc * 32 + 8 * fq;
        f32x4 g0 = *(const LAS f32x4*)bgl, g1 = *(const LAS f32x4*)(bgl + 4), u0 = *(const LAS f32x4*)(bgl + 128), u1 = *(const LAS f32x4*)(bgl + 132);
#pragma unroll
        for (int ai = 0; ai < 2; ++ai)
#pragma unroll
            for (int m = 0; m < 4; ++m) { unsigned char* rowp = O + (size_t)(row0 + ai * HALF + m * 16) * DFF + cl;
                float r[8];
#pragma unroll
                for (int n = 0; n < 2; ++n) { const f32x4 gb = n ? g1 : g0, ub = n ? u1 : u0;
                    const f32x4 ga = acc[ai][0][m][n] * 0.015625f + gb, ua = acc[ai][1][m][n] * 0.015625f + ub;
                    const f32x4 gate = __builtin_elementwise_min(ga, (f32x4){7.f, 7.f, 7.f, 7.f});
                    const f32x4 up1 = __builtin_elementwise_min(__builtin_elementwise_max(ua, (f32x4){-7.f, -7.f, -7.f, -7.f}), (f32x4){7.f, 7.f, 7.f, 7.f}) + 1.0f;
                    const f32x4 xa = gate * (-1.702f * 1.44269504089f);
                    f32x4 den; den.x = __builtin_amdgcn_exp2f(xa.x); den.y = __builtin_amdgcn_exp2f(xa.y); den.z = __builtin_amdgcn_exp2f(xa.z); den.w = __builtin_amdgcn_exp2f(xa.w);
                    den = den + 1.0f;
                    f32x4 rc; rc.x = __builtin_amdgcn_rcpf(den.x); rc.y = __builtin_amdgcn_rcpf(den.y); rc.z = __builtin_amdgcn_rcpf(den.z); rc.w = __builtin_amdgcn_rcpf(den.w);
                    const f32x4 o = (gate * rc) * up1;
                    r[n * 4 + 0] = o.x; r[n * 4 + 1] = o.y; r[n * 4 + 2] = o.z; r[n * 4 + 3] = o.w; }
                u32x2 w; w.x = pk4_fp8(r[0], r[1], r[2], r[3]); w.y = pk4_fp8(r[4], r[5], r[6], r[7]);
                *(u32x2*)rowp = w; }
    }
};
struct EpiDown8 {
    static constexpr bool PERM = true; static constexpr int NST = 16; static constexpr bool BIAS_DMA = true;
    unsigned char* O; const float* bdn;
    __device__ __forceinline__ const float* bias_src(const Unit& u, int lane) const { const int e = u.pn >> 2, pl = u.pn & 3; return bdn + (size_t)e * 1024 + pl * 256 + lane * 4; }
    __device__ __forceinline__ void operator()(const f32x4 (&acc)[2][2][4][2], const Unit& u, int wr, int wc, int fr, int fq, const LAS float* bl) const {
        const int e = u.pn >> 2, pl = u.pn & 3;
        const int row0 = u.pm * BM + wr * 64 + fr; const int col0 = pl * BM + wc * 32 + 8 * fq;
        f32x4 bv[2][2];
#pragma unroll
        for (int bj = 0; bj < 2; ++bj)
#pragma unroll
            for (int n = 0; n < 2; ++n) bv[bj][n] = *(const LAS f32x4*)(bl + wc * 32 + 8 * fq + bj * HALF + 4 * n);
#pragma unroll
        for (int ai = 0; ai < 2; ++ai)
#pragma unroll
            for (int m = 0; m < 4; ++m) { unsigned char* rowp = O + (size_t)(row0 + ai * HALF + m * 16) * D + col0;
#pragma unroll
                for (int bj = 0; bj < 2; ++bj) { const f32x4 v0 = acc[ai][bj][m][0] * 0.015625f + bv[bj][0], v1 = acc[ai][bj][m][1] * 0.015625f + bv[bj][1];
                    u32x2 w; w.x = pk4_fp8(v0[0], v0[1], v0[2], v0[3]); w.y = pk4_fp8(v1[0], v1[1], v1[2], v1[3]);
                    *(u32x2*)(rowp + bj * HALF) = w; } }
    }
};

typedef int i32x8 __attribute__((ext_vector_type(8)));
typedef int i32x4 __attribute__((ext_vector_type(4)));
__device__ __forceinline__ i32x8 cat8(const bf16x8 lo, const bf16x8 hi) { const i32x4 a = __builtin_bit_cast(i32x4, lo), b = __builtin_bit_cast(i32x4, hi); return __builtin_shufflevector(a, b, 0, 1, 2, 3, 4, 5, 6, 7); }
template <class Epi, class Sched, bool ALIGN_EPI = true, bool SP2 = true, bool F8 = false>
__device__ __forceinline__ void gemm_phase(LAS unsigned char* lds, const Gemm g, const Sched& S, const Epi& E, const int tid) {
    const int wid = __builtin_amdgcn_readfirstlane(tid >> 6), lane = tid & 63, wr = wid >> 2, wc = wid & 3, fr = lane & 15, fq = lane >> 4;
    const int K = g.K, nt = K / BK;
    unsigned voffA[2], voffB[2];
#pragma unroll
    for (int i = 0; i < 2; ++i) { int R, C; stage_rc(tid * 16 + i * 8192, R, C); const int Rb = Epi::PERM ? ((R & ~31) + perm32(R & 31)) : R;
        voffA[i] = (unsigned)(R * K + C) * 2u; voffB[i] = (unsigned)(Rb * K + C) * 2u; }
    const size_t kstep = (size_t)(BK * 2);
    const size_t hstep = (size_t)HALF * K * 2;
    const size_t tstep = 2 * hstep;
    const unsigned ldsw = (unsigned)wid * 1024u;
    const int aoff = lds_byte(wr * 64 + fr, fq * 8), boff = lds_byte(wc * 32 + fr, fq * 8);
#define PG8_SA(b, h) (((b) * 2 + (h)) * HTB)
#define PG8_SB(b, h) ((4 + (b) * 2 + (h)) * HTB)
#define PG8_STAGE(bufoff, gbase, voff) do { _Pragma("unroll") for (int _i = 0; _i < 2; ++_i) \
        __builtin_amdgcn_global_load_lds((const unsigned*)((const char*)(gbase) + (voff)[_i]), (LAS unsigned*)(lds + (bufoff) + ldsw + _i * 8192), 16, 0, 0); } while (0)
#define PG8_LDA(dst, b, h) do { _Pragma("unroll") for (int m = 0; m < 4; ++m) { if constexpr (F8) dst##8[m] = cat8(*(const LAS bf16x8*)(lds + PG8_SA(b, h) + aoff + m * 2048), *(const LAS bf16x8*)(lds + PG8_SA(b, h) + aoff + m * 2048 + 1024)); \
        else { _Pragma("unroll") for (int k = 0; k < 2; ++k) dst[m][k] = *(const LAS bf16x8*)(lds + PG8_SA(b, h) + aoff + m * 2048 + k * 1024); } } } while (0)
#define PG8_LDB(dst, b, h) do { _Pragma("unroll") for (int n = 0; n < 2; ++n) { if constexpr (F8) dst##8[n] = cat8(*(const LAS bf16x8*)(lds + PG8_SB(b, h) + boff + n * 2048), *(const LAS bf16x8*)(lds + PG8_SB(b, h) + boff + n * 2048 + 1024)); \
        else { _Pragma("unroll") for (int k = 0; k < 2; ++k) dst[n][k] = *(const LAS bf16x8*)(lds + PG8_SB(b, h) + boff + n * 2048 + k * 1024); } } } while (0)
#define PG8_MMA(ai, bj, At, Bt) do { __builtin_amdgcn_s_setprio(1); \
        if constexpr (F8) { _Pragma("unroll") for (int m = 0; m < 4; ++m) _Pragma("unroll") for (int n = 0; n < 2; ++n) \
            acc[ai][bj][m][n] = __builtin_amdgcn_mfma_scale_f32_16x16x128_f8f6f4(Bt##8[n], At##8[m], acc[ai][bj][m][n], 0, 0, 0, 0x7f7f7f7f, 0, 0x7f7f7f7f); \
            _Pragma("unroll") for (int m = 0; m < 4; ++m) _Pragma("unroll") for (int n = 0; n < 2; ++n) asm volatile("" : "+v"(acc[ai][bj][m][n])); } \
        else { _Pragma("unroll") for (int m = 0; m < 4; ++m) _Pragma("unroll") for (int n = 0; n < 2; ++n) _Pragma("unroll") for (int k = 0; k < 2; ++k) \
            acc[ai][bj][m][n] = __builtin_amdgcn_mfma_f32_16x16x32_bf16(Bt[n][k], At[m][k], acc[ai][bj][m][n], 0, 0, 0); } \
        __builtin_amdgcn_s_setprio(0); } while (0)
#define PG8_WAIT_V(n) asm volatile("s_waitcnt vmcnt(" #n ")" ::: "memory")
#define PG8_WAIT_VR(rlx) do { if constexpr (Epi::NST == 16) asm volatile("s_cmp_lg_u32 %0, 0\n\ts_cbranch_scc1 .Lrlx%=\n\ts_waitcnt vmcnt(8)\n.Lrlx%=:\n\ts_waitcnt vmcnt(24)" :: "s"(rlx) : "scc", "memory"); \
        else if constexpr (Epi::NST == 8) asm volatile("s_cmp_lg_u32 %0, 0\n\ts_cbranch_scc1 .Lrlx%=\n\ts_waitcnt vmcnt(8)\n.Lrlx%=:\n\ts_waitcnt vmcnt(16)" :: "s"(rlx) : "scc", "memory"); else PG8_WAIT_V(8); } while (0)
#define PG8_WAIT_L(n) asm volatile("s_waitcnt lgkmcnt(" #n ")" ::: "memory")
#define PG8_BAR __builtin_amdgcn_s_barrier()
#define PG8_SCHED __builtin_amdgcn_sched_barrier(0)
    Unit cur, nxt; int ui = 0;
    if (!S.next(0, cur)) return;
    f32x4 acc[2][2][4][2];
#pragma unroll
    for (int a = 0; a < 2; ++a)
#pragma unroll
        for (int b = 0; b < 2; ++b)
#pragma unroll
            for (int m = 0; m < 4; ++m)
#pragma unroll
                for (int n = 0; n < 2; ++n) acc[a][b][m][n] = (f32x4){0.f, 0.f, 0.f, 0.f};
    bf16x8 At[4][2], B0[2][2], B1[2][2]; i32x8 At8[4], B08[2], B18[2];
    const char* cA = (const char*)g.A + (size_t)cur.pm * tstep; const char* cB = (const char*)g.Bt + (size_t)cur.pn * tstep;
    if constexpr (SP2) {
        PG8_STAGE(PG8_SB(0, 0), cB, voffB); PG8_STAGE(PG8_SB(0, 1), cB + hstep, voffB); PG8_STAGE(PG8_SA(0, 0), cA, voffA); PG8_STAGE(PG8_SA(0, 1), cA + hstep, voffA);
        if (wr == 1) PG8_BAR;
        PG8_WAIT_V(2); PG8_BAR;
        PG8_STAGE(PG8_SB(1, 0), cB + kstep, voffB); PG8_STAGE(PG8_SA(1, 0), cA + kstep, voffA); PG8_STAGE(PG8_SB(1, 1), cB + hstep + kstep, voffB);
        PG8_WAIT_V(6); PG8_BAR;
    } else {
        PG8_STAGE(PG8_SB(0, 0), cB, voffB); PG8_STAGE(PG8_SA(0, 0), cA, voffA); PG8_STAGE(PG8_SB(0, 1), cB + hstep, voffB); PG8_STAGE(PG8_SA(0, 1), cA + hstep, voffA);
        if (wr == 1) PG8_BAR;
        PG8_WAIT_V(4); PG8_BAR;
        PG8_STAGE(PG8_SB(1, 0), cB + kstep, voffB); PG8_STAGE(PG8_SA(1, 0), cA + kstep, voffA); PG8_STAGE(PG8_SB(1, 1), cB + hstep + kstep, voffB);
        PG8_WAIT_V(6); PG8_BAR;
    }
    for (;;) {
        const bool has_next = S.next(ui + 1, nxt);
        if constexpr (Epi::BIAS_DMA) { if (wid == 0) __builtin_amdgcn_global_load_lds((const unsigned*)E.bias_src(cur, lane), (LAS unsigned*)(lds + LC_BIAS + (ui & 1) * 1024), 16, 0, 0); }
        const char* nA = has_next ? (const char*)g.A + (size_t)nxt.pm * tstep : cA; const char* nB = has_next ? (const char*)g.Bt + (size_t)nxt.pn * tstep : cB;
        for (int t = 0; t < nt; t += 2) {
            const bool last = (t == nt - 2);
            const int rlx = __builtin_amdgcn_readfirstlane(((t == 0) && (ui > 0)) ? 1 : 0);
            const char* a1 = cA + (size_t)(t + 1) * kstep;
            const char* a2 = last ? nA : cA + (size_t)(t + 2) * kstep; const char* b2 = last ? nB : cB + (size_t)(t + 2) * kstep;
            const char* a3 = a2 + kstep; const char* b3 = b2 + kstep;
            if constexpr (SP2) {
            PG8_LDB(B0, 0, 0); PG8_LDB(B1, 0, 1); PG8_SCHED; PG8_LDA(At, 0, 0); PG8_STAGE(PG8_SA(1, 1), a1 + hstep, voffA);
            PG8_WAIT_VR(rlx); PG8_WAIT_L(0); PG8_BAR; PG8_MMA(0, 0, At, B0); PG8_MMA(0, 1, At, B1); PG8_BAR; PG8_SCHED;
            PG8_LDA(At, 0, 1); PG8_STAGE(PG8_SB(0, 0), b2, voffB); PG8_STAGE(PG8_SB(0, 1), b2 + hstep, voffB); PG8_STAGE(PG8_SA(0, 0), a2, voffA);
            PG8_WAIT_VR(rlx); PG8_WAIT_L(0); PG8_BAR; PG8_MMA(1, 0, At, B0); PG8_MMA(1, 1, At, B1); PG8_BAR; PG8_SCHED;
            PG8_LDB(B0, 1, 0); PG8_LDB(B1, 1, 1); PG8_SCHED; PG8_LDA(At, 1, 0); PG8_STAGE(PG8_SA(0, 1), a2 + hstep, voffA);
            PG8_WAIT_V(8); PG8_WAIT_L(0); PG8_BAR; PG8_MMA(0, 0, At, B0); PG8_MMA(0, 1, At, B1); PG8_BAR; PG8_SCHED;
            PG8_LDA(At, 1, 1); PG8_STAGE(PG8_SB(1, 0), b3, voffB); PG8_STAGE(PG8_SB(1, 1), b3 + hstep, voffB); PG8_STAGE(PG8_SA(1, 0), a3, voffA);
            PG8_WAIT_V(8); PG8_WAIT_L(0); PG8_BAR; PG8_MMA(1, 0, At, B0); PG8_MMA(1, 1, At, B1); PG8_BAR; PG8_SCHED;
            } else {
            PG8_LDB(B0, 0, 0); PG8_SCHED; PG8_LDA(At, 0, 0); PG8_STAGE(PG8_SA(1, 1), a1 + hstep, voffA);
            PG8_WAIT_L(8); PG8_BAR; PG8_WAIT_L(0); PG8_MMA(0, 0, At, B0); PG8_BAR; PG8_SCHED;
            PG8_LDB(B1, 0, 1); PG8_STAGE(PG8_SB(0, 0), b2, voffB);
            PG8_BAR; PG8_WAIT_L(0); PG8_MMA(0, 1, At, B1); PG8_BAR;
            PG8_LDA(At, 0, 1); PG8_STAGE(PG8_SA(0, 0), a2, voffA);
            PG8_BAR; PG8_WAIT_L(0); PG8_MMA(1, 0, At, B0); PG8_BAR; PG8_SCHED;
            PG8_STAGE(PG8_SB(0, 1), b2 + hstep, voffB);
            PG8_WAIT_V(6); PG8_BAR; PG8_MMA(1, 1, At, B1); PG8_BAR;
            PG8_LDB(B0, 1, 0); PG8_SCHED; PG8_LDA(At, 1, 0); PG8_STAGE(PG8_SA(0, 1), a2 + hstep, voffA);
            PG8_WAIT_L(8); PG8_BAR; PG8_WAIT_L(0); PG8_MMA(0, 0, At, B0); PG8_BAR; PG8_SCHED;
            PG8_LDB(B1, 1, 1); PG8_STAGE(PG8_SB(1, 0), b3, voffB);
            PG8_BAR; PG8_WAIT_L(0); PG8_MMA(0, 1, At, B1); PG8_BAR;
            PG8_LDA(At, 1, 1); PG8_STAGE(PG8_SA(1, 0), a3, voffA);
            PG8_BAR; PG8_WAIT_L(0); PG8_MMA(1, 0, At, B0); PG8_BAR; PG8_SCHED;
            PG8_STAGE(PG8_SB(1, 1), b3 + hstep, voffB);
            PG8_WAIT_V(6); PG8_BAR; PG8_MMA(1, 1, At, B1); PG8_BAR;
            }
        }
        if constexpr (ALIGN_EPI) { if (wr == 0) PG8_BAR; }
        E(acc, cur, wr, wc, fr, fq, (const LAS float*)(lds + LC_BIAS + (ui & 1) * 1024));
        if (!has_next) break;
#pragma unroll
        for (int a = 0; a < 2; ++a)
#pragma unroll
            for (int b = 0; b < 2; ++b)
#pragma unroll
                for (int m = 0; m < 4; ++m)
#pragma unroll
                    for (int n = 0; n < 2; ++n) acc[a][b][m][n] = (f32x4){0.f, 0.f, 0.f, 0.f};
        cur = nxt; cA = nA; cB = nB; ++ui;
        if constexpr (ALIGN_EPI) { if (wr == 1) PG8_BAR; }
    }
    PG8_WAIT_V(0);
    if constexpr (!ALIGN_EPI) { if (wr == 0) PG8_BAR; }
    PG8_BAR;
#undef PG8_SA
#undef PG8_SB
#undef PG8_STAGE
#undef PG8_LDA
#undef PG8_LDB
#undef PG8_MMA
#undef PG8_WAIT_V
#undef PG8_WAIT_VR
#undef PG8_WAIT_L
#undef PG8_BAR
#undef PG8_SCHED
}

template <class Epi, class Sched, bool F8 = false>
__device__ __forceinline__ void gemm_phase_gather(LAS unsigned char* lds, const Gemm g, const int* list, const Sched& S, const Epi& E, const int tid) {
    const int wid = __builtin_amdgcn_readfirstlane(tid >> 6), lane = tid & 63, wr = wid >> 2, wc = wid & 3, fr = lane & 15, fq = lane >> 4;
    const int K = g.K, nt = K / BK;
    unsigned voffB0, cA2;
    { int R, C; stage_rc(tid * 16, R, C); const int Rb = Epi::PERM ? ((R & ~31) + perm32(R & 31)) : R; cA2 = (unsigned)C * 2u; voffB0 = (unsigned)(Rb * K + C) * 2u; }
    const unsigned voffB[2] = {voffB0, voffB0 + (unsigned)(64 * K * 2)};
    const size_t kstep = (size_t)(BK * 2);
    const size_t hstep = (size_t)HALF * K * 2;
    const size_t tstep = 2 * hstep;
    const unsigned ldsw = (unsigned)wid * 1024u;
    const int aoff = lds_byte(wr * 64 + fr, fq * 8), boff = lds_byte(wc * 32 + fr, fq * 8);
#define PG8_SA(b, h) (((b) * 2 + (h)) * HTB)
#define PG8_SB(b, h) ((4 + (b) * 2 + (h)) * HTB)
#define PG8_STAGE(bufoff, gbase, voff) do { _Pragma("unroll") for (int _i = 0; _i < 2; ++_i) \
        __builtin_amdgcn_global_load_lds((const unsigned*)((const char*)(gbase) + (voff)[_i]), (LAS unsigned*)(lds + (bufoff) + ldsw + _i * 8192), 16, 0, 0); } while (0)
#define PG8_LDA(dst, b, h) do { _Pragma("unroll") for (int m = 0; m < 4; ++m) { if constexpr (F8) dst##8[m] = cat8(*(const LAS bf16x8*)(lds + PG8_SA(b, h) + aoff + m * 2048), *(const LAS bf16x8*)(lds + PG8_SA(b, h) + aoff + m * 2048 + 1024)); \
        else { _Pragma("unroll") for (int k = 0; k < 2; ++k) dst[m][k] = *(const LAS bf16x8*)(lds + PG8_SA(b, h) + aoff + m * 2048 + k * 1024); } } } while (0)
#define PG8_LDB(dst, b, h) do { _Pragma("unroll") for (int n = 0; n < 2; ++n) { if constexpr (F8) dst##8[n] = cat8(*(const LAS bf16x8*)(lds + PG8_SB(b, h) + boff + n * 2048), *(const LAS bf16x8*)(lds + PG8_SB(b, h) + boff + n * 2048 + 1024)); \
        else { _Pragma("unroll") for (int k = 0; k < 2; ++k) dst[n][k] = *(const LAS bf16x8*)(lds + PG8_SB(b, h) + boff + n * 2048 + k * 1024); } } } while (0)
#define PG8_MMA(ai, bj, At, Bt) do { __builtin_amdgcn_s_setprio(1); \
        if constexpr (F8) { _Pragma("unroll") for (int m = 0; m < 4; ++m) _Pragma("unroll") for (int n = 0; n < 2; ++n) \
            acc[ai][bj][m][n] = __builtin_amdgcn_mfma_scale_f32_16x16x128_f8f6f4(Bt##8[n], At##8[m], acc[ai][bj][m][n], 0, 0, 0, 0x7f7f7f7f, 0, 0x7f7f7f7f); \
            asm volatile("" : "+v"(acc[ai][bj][0][0]), "+v"(acc[ai][bj][0][1]), "+v"(acc[ai][bj][1][0]), "+v"(acc[ai][bj][1][1]), "+v"(acc[ai][bj][2][0]), "+v"(acc[ai][bj][2][1]), "+v"(acc[ai][bj][3][0]), "+v"(acc[ai][bj][3][1])); } \
        else { _Pragma("unroll") for (int m = 0; m < 4; ++m) _Pragma("unroll") for (int n = 0; n < 2; ++n) _Pragma("unroll") for (int k = 0; k < 2; ++k) \
            acc[ai][bj][m][n] = __builtin_amdgcn_mfma_f32_16x16x32_bf16(Bt[n][k], At[m][k], acc[ai][bj][m][n], 0, 0, 0); } \
        __builtin_amdgcn_s_setprio(0); } while (0)
#define PG8_WAIT_V(n) asm volatile("s_waitcnt vmcnt(" #n ")" ::: "memory")
#define PG8_WAIT_VR(rlx) do { if constexpr (Epi::NST == 16) asm volatile("v_cmp_ne_u32_e32 vcc, 0, %0\n\ts_cbranch_vccnz .Lrlx%=\n\ts_waitcnt vmcnt(8)\n.Lrlx%=:\n\ts_waitcnt vmcnt(24)" :: "v"(rlx) : "vcc", "memory"); \
        else if constexpr (Epi::NST == 8) asm volatile("v_cmp_ne_u32_e32 vcc, 0, %0\n\ts_cbranch_vccnz .Lrlx%=\n\ts_waitcnt vmcnt(8)\n.Lrlx%=:\n\ts_waitcnt vmcnt(16)" :: "v"(rlx) : "vcc", "memory"); else PG8_WAIT_V(8); } while (0)
#define PG8_WAIT_L(n) asm volatile("s_waitcnt lgkmcnt(" #n ")" ::: "memory")
#define PG8_BAR __builtin_amdgcn_s_barrier()
#define PG8_SCHED __builtin_amdgcn_sched_barrier(0)
#define PG8_TOKIDX(u, r) ((u).lbase + ((r) < (u).nvalid - 1 ? (r) : (u).nvalid - 1))
#define PG8_LOADTOK(u, vo) do { int _ra0, _ra1, _c; stage_rc(tid * 16, _ra0, _c); stage_rc(tid * 16 + 8192, _ra1, _c); _Pragma("unroll") for (int _h = 0; _h < 2; ++_h) { \
        const unsigned _t0 = (unsigned)list[PG8_TOKIDX(u, _h * HALF + _ra0)], _t1 = (unsigned)list[PG8_TOKIDX(u, _h * HALF + _ra1)]; (vo)[_h] = _t0 | (_t1 << 16); } } while (0)
#define PG8_TOKSLOT(k) (lds + AUX_OFF + (unsigned)wid * 1024u + (k) * 256)
#define PG8_LOADTOK_DMA(u) do { int _ra0, _ra1, _c; stage_rc(tid * 16, _ra0, _c); stage_rc(tid * 16 + 8192, _ra1, _c); _Pragma("unroll") for (int _h = 0; _h < 2; ++_h) { \
        __builtin_amdgcn_global_load_lds((const unsigned*)(list + PG8_TOKIDX(u, _h * HALF + _ra0)), (LAS unsigned*)PG8_TOKSLOT(2 * _h), 4, 0, 0); \
        __builtin_amdgcn_global_load_lds((const unsigned*)(list + PG8_TOKIDX(u, _h * HALF + _ra1)), (LAS unsigned*)PG8_TOKSLOT(2 * _h + 1), 4, 0, 0); } } while (0)
#define PG8_READTOK(vo) do { _Pragma("unroll") for (int _h = 0; _h < 2; ++_h) { const unsigned _t0 = *(const LAS unsigned*)(PG8_TOKSLOT(2 * _h) + lane * 4), _t1 = *(const LAS unsigned*)(PG8_TOKSLOT(2 * _h + 1) + lane * 4); (vo)[_h] = _t0 | (_t1 << 16); } } while (0)
#define PG8_STAGE_A(bufoff, gbase, pk) do { _Pragma("unroll") for (int _i = 0; _i < 2; ++_i) { const unsigned _off = (((pk) >> (16 * _i)) & 0xffffu) * (unsigned)(K * 2) + cA2; \
        __builtin_amdgcn_global_load_lds((const unsigned*)((const char*)(gbase) + _off), (LAS unsigned*)(lds + (bufoff) + ldsw + _i * 8192), 16, 0, 0); } } while (0)
    Unit cur, nxt; int ui = 0;
    if (!S.next(0, cur)) return;
    f32x4 acc[2][2][4][2];
#pragma unroll
    for (int a = 0; a < 2; ++a)
#pragma unroll
        for (int b = 0; b < 2; ++b)
#pragma unroll
            for (int m = 0; m < 4; ++m)
#pragma unroll
                for (int n = 0; n < 2; ++n) acc[a][b][m][n] = (f32x4){0.f, 0.f, 0.f, 0.f};
    bf16x8 At[4][2], B0[2][2], B1[2][2]; i32x8 At8[4], B08[2], B18[2];
    unsigned vc[2];
    PG8_LOADTOK(cur, vc);
    const char* gA = (const char*)g.A; const char* cB = (const char*)g.Bt + (size_t)cur.pn * tstep;
    PG8_STAGE(PG8_SB(0, 0), cB, voffB); PG8_STAGE(PG8_SB(0, 1), cB + hstep, voffB); PG8_STAGE_A(PG8_SA(0, 0), gA, vc[0]); PG8_STAGE_A(PG8_SA(0, 1), gA, vc[1]);
    if (wr == 1) PG8_BAR;
    PG8_WAIT_V(2); PG8_BAR;
    PG8_STAGE(PG8_SB(1, 0), cB + kstep, voffB); PG8_STAGE_A(PG8_SA(1, 0), gA + kstep, vc[0]); PG8_STAGE(PG8_SB(1, 1), cB + hstep + kstep, voffB);
    PG8_WAIT_V(6); PG8_BAR;
    for (;;) {
        const bool has_next = S.next(ui + 1, nxt);
        if constexpr (Epi::BIAS_DMA) { if (wid == 0) __builtin_amdgcn_global_load_lds((const unsigned*)E.bias_src(cur, lane), (LAS unsigned*)(lds + LC_BIAS + (ui & 1) * 1024), 16, 0, 0); }
        { const Unit& lu_ = has_next ? nxt : cur; PG8_LOADTOK_DMA(lu_); }
        const char* nB = has_next ? (const char*)g.Bt + (size_t)nxt.pn * tstep : cB;
        for (int t = 0; t < nt; t += 2) {
            const bool last = (t == nt - 2);
            const int rlx = ((t == 0) && (ui > 0)) ? 1 : 0;
            const char* a1 = gA + (size_t)(t + 1) * kstep;
            const char* b2 = last ? nB : cB + (size_t)(t + 2) * kstep; const char* b3 = b2 + kstep;
            const char* a2 = last ? gA : gA + (size_t)(t + 2) * kstep; const char* a3 = a2 + kstep;
            PG8_LDB(B0, 0, 0); PG8_LDB(B1, 0, 1); PG8_SCHED; PG8_LDA(At, 0, 0); PG8_STAGE_A(PG8_SA(1, 1), a1, vc[1]);
            if (last && has_next) {
                PG8_READTOK(vc); }
            PG8_WAIT_VR(rlx); PG8_WAIT_L(0); PG8_BAR; PG8_MMA(0, 0, At, B0); PG8_MMA(0, 1, At, B1); PG8_BAR; PG8_SCHED;
            PG8_LDA(At, 0, 1); PG8_STAGE(PG8_SB(0, 0), b2, voffB); PG8_STAGE(PG8_SB(0, 1), b2 + hstep, voffB); PG8_STAGE_A(PG8_SA(0, 0), a2, vc[0]);
            PG8_WAIT_VR(rlx); PG8_WAIT_L(0); PG8_BAR; PG8_MMA(1, 0, At, B0); PG8_MMA(1, 1, At, B1); PG8_BAR; PG8_SCHED;
            PG8_LDB(B0, 1, 0); PG8_LDB(B1, 1, 1); PG8_SCHED; PG8_LDA(At, 1, 0); PG8_STAGE_A(PG8_SA(0, 1), a2, vc[1]);
            PG8_WAIT_V(8); PG8_WAIT_L(0); PG8_BAR; PG8_MMA(0, 0, At, B0); PG8_MMA(0, 1, At, B1); PG8_BAR; PG8_SCHED;
            PG8_LDA(At, 1, 1); PG8_STAGE(PG8_SB(1, 0), b3, voffB); PG8_STAGE(PG8_SB(1, 1), b3 + hstep, voffB); PG8_STAGE_A(PG8_SA(1, 0), a3, vc[0]);
            PG8_WAIT_V(8); PG8_WAIT_L(0); PG8_BAR; PG8_MMA(1, 0, At, B0); PG8_MMA(1, 1, At, B1); PG8_BAR; PG8_SCHED;
        }
        if (wr == 0) PG8_BAR;
        E(acc, cur, wr, wc, fr, fq, (const LAS float*)(lds + LC_BIAS + (ui & 1) * 1024));
        if (!has_next) break;
#pragma unroll
        for (int a = 0; a < 2; ++a)
#pragma unroll
            for (int b = 0; b < 2; ++b)
#pragma unroll
                for (int m = 0; m < 4; ++m)
#pragma unroll
                    for (int n = 0; n < 2; ++n) acc[a][b][m][n] = (f32x4){0.f, 0.f, 0.f, 0.f};
        cur = nxt; cB = nB; ++ui;
        if (wr == 1) PG8_BAR;
    }
    PG8_WAIT_V(0);
    PG8_BAR;
#undef PG8_SA
#undef PG8_SB
#undef PG8_STAGE
#undef PG8_LDA
#undef PG8_LDB
#undef PG8_MMA
#undef PG8_WAIT_V
#undef PG8_WAIT_VR
#undef PG8_WAIT_L
#undef PG8_BAR
#undef PG8_SCHED
#undef PG8_STAGE_A
#undef PG8_LOADTOK
#undef PG8_LOADTOK_DMA
#undef PG8_READTOK
#undef PG8_TOKSLOT
#undef PG8_TOKIDX
}
}

struct Params {
    const float* in[26];
    float* out;
    unsigned char* ws;
};
struct Frame {
    LAS unsigned char* lds;
    int tid, lane, wave, G, bid;
};

template <int MT, int NT>
__device__ __forceinline__ void mma_nt(f32x4 (&acc)[MT][NT], const LAS bf16_t* A, int lda, const LAS bf16_t* B, int ldb, int K, int fr, int fq) {
    for (int k0 = 0; k0 < K; k0 += 32) {
        bf16x8 a[MT], b[NT];
#pragma unroll
        for (int m = 0; m < MT; ++m) a[m] = *(const LAS bf16x8*)(A + (m * 16 + fr) * lda + k0 + fq * 8);
#pragma unroll
        for (int n = 0; n < NT; ++n) b[n] = *(const LAS bf16x8*)(B + (n * 16 + fr) * ldb + k0 + fq * 8);
#pragma unroll
        for (int m = 0; m < MT; ++m)
#pragma unroll
            for (int n = 0; n < NT; ++n) acc[m][n] = __builtin_amdgcn_mfma_f32_16x16x32_bf16(a[m], b[n], acc[m][n], 0, 0, 0);
    }
}
template <int MT, int NT> __device__ __forceinline__ void zero_acc(f32x4 (&acc)[MT][NT]) {
#pragma unroll
    for (int m = 0; m < MT; ++m)
#pragma unroll
        for (int n = 0; n < NT; ++n) acc[m][n] = (f32x4){0.f, 0.f, 0.f, 0.f};
}

constexpr int SK_A = 0, SK_B = 69632;
template <class Epi>
__device__ __forceinline__ void skinny_unit(const Frame& F, const bf16_t* A, const bf16_t* Bt, const Epi& E) {
    LAS bf16_t* As = (LAS bf16_t*)(F.lds + SK_A); LAS bf16_t* Bs = (LAS bf16_t*)(F.lds + SK_B);
    const int tid = F.tid, fr = F.lane & 15, fq = F.lane >> 4, w = F.wave;
    f32x4 acc[2][2]; zero_acc<2, 2>(acc);
    u32x4 av[8], bv;
#pragma unroll
    for (int i = 0; i < 8; ++i) { const int ch = tid + NTHREADS * i, r = ch >> 4, c8 = (ch & 15) * 8; av[i] = *(const u32x4*)(A + (size_t)r * D + c8); }
    { const int r = tid >> 4, c8 = (tid & 15) * 8; bv = *(const u32x4*)(Bt + (size_t)r * D + c8); }
    for (int kc = 0; kc < 8; ++kc) {
        LDS_BARRIER();
#pragma unroll
        for (int i = 0; i < 8; ++i) { const int ch = tid + NTHREADS * i, r = ch >> 4, c8 = (ch & 15) * 8; *(LAS u32x4*)(As + r * 136 + c8) = av[i]; }
        { const int r = tid >> 4, c8 = (tid & 15) * 8; *(LAS u32x4*)(Bs + r * 136 + c8) = bv; }
        if (kc + 1 < 8) {
#pragma unroll
            for (int i = 0; i < 8; ++i) { const int ch = tid + NTHREADS * i, r = ch >> 4, c8 = (ch & 15) * 8; av[i] = *(const u32x4*)(A + (size_t)r * D + (kc + 1) * 128 + c8); }
            { const int r = tid >> 4, c8 = (tid & 15) * 8; bv = *(const u32x4*)(Bt + (size_t)r * D + (kc + 1) * 128 + c8); } }
        LDS_BARRIER();
        mma_nt<2, 2>(acc, As + (32 * w) * 136, 136, Bs, 136, 128, fr, fq);
    }
#pragma unroll
    for (int mt = 0; mt < 2; ++mt)
#pragma unroll
        for (int nt = 0; nt < 2; ++nt)
#pragma unroll
            for (int j = 0; j < 4; ++j) E(32 * w + mt * 16 + fq * 4 + j, nt * 16 + fr, acc[mt][nt][j]);
    LDS_BARRIER();
}
struct SkEpiBf16 { bf16_t* O; int ldc; __device__ __forceinline__ void operator()(int r, int c, float v) const { O[(size_t)r * ldc + c] = (bf16_t)f2bf(v); } };
struct SkEpiResid { bf16_t* X; const float* Xs; const float* gate; __device__ __forceinline__ void operator()(int r, int c, float v) const { X[(size_t)r * D + c] = (bf16_t)f2bf(Xs[(size_t)r * D + c] + gate[c] * v); } };

__device__ __forceinline__ void p0_transpose_item(const float* W, int K, int N, bf16_t* WT, int k0, int n0, int orow0, LAS float* scr, int lane) {
    float tv[32];
#pragma unroll
    for (int i = 0; i < 32; ++i) { const int kk = 2 * i + (lane >> 5); tv[i] = W[(size_t)(k0 + kk) * N + n0 + (lane & 31)]; }
#pragma unroll
    for (int i = 0; i < 32; ++i) { const int kk = 2 * i + (lane >> 5); scr[kk * 33 + (lane & 31)] = tv[i]; }
    asm volatile("s_waitcnt lgkmcnt(0)" ::: "memory");
    const int c = lane & 7;
#pragma unroll
    for (int j = 0; j < 4; ++j) { const int n = (lane >> 3) + 8 * j; const LAS float* s = scr + (8 * c) * 33 + n;
        u32x4 o; o.x = pk2(s[0 * 33], s[1 * 33]); o.y = pk2(s[2 * 33], s[3 * 33]); o.z = pk2(s[4 * 33], s[5 * 33]); o.w = pk2(s[6 * 33], s[7 * 33]);
        *(u32x4*)(WT + (size_t)(orow0 + n) * K + k0 + 8 * c) = o; }
    asm volatile("s_waitcnt lgkmcnt(0)" ::: "memory");
}

using pg8::pk4_fp8; using pg8::i32x4;
struct WtSrc { const float* W; int N, k0, n0; unsigned char* dst; };
__device__ __forceinline__ void wt_issue(const WtSrc& r, int lane, float (&tv)[32]) {
#pragma unroll
    for (int i = 0; i < 8; ++i) { const f32x4 v = *(const f32x4*)(r.W + (size_t)(r.k0 + 8 * (lane >> 3) + i) * r.N + r.n0 + 4 * (lane & 7)); tv[4 * i] = v.x; tv[4 * i + 1] = v.y; tv[4 * i + 2] = v.z; tv[4 * i + 3] = v.w; }
}
__device__ __forceinline__ void wt_finish(const WtSrc& r, int lane, const float (&tv)[32], LAS unsigned char* scr8) {
    const int kq = lane >> 3, n4 = lane & 7;
#pragma unroll
    for (int c = 0; c < 4; ++c) { u32x2 o;
        o.x = pk4_fp8(64.f * tv[0 * 4 + c], 64.f * tv[1 * 4 + c], 64.f * tv[2 * 4 + c], 64.f * tv[3 * 4 + c]); o.y = pk4_fp8(64.f * tv[4 * 4 + c], 64.f * tv[5 * 4 + c], 64.f * tv[6 * 4 + c], 64.f * tv[7 * 4 + c]);
        *(LAS u32x2*)(scr8 + (4 * n4 + c) * 72 + 8 * kq) = o; }
    asm volatile("s_waitcnt lgkmcnt(0)" ::: "memory");
#pragma unroll
    for (int c2 = 0; c2 < 2; ++c2) { const int c = lane + 64 * c2, nn = c >> 2, k16 = (c & 3) * 16; const LAS unsigned* sp = (const LAS unsigned*)(scr8 + nn * 72 + k16);
        u32x4 o; o.x = sp[0]; o.y = sp[1]; o.z = sp[2]; o.w = sp[3];
        *(u32x4*)(r.dst + (size_t)nn * 1024 + k16) = o; }
    asm volatile("s_waitcnt lgkmcnt(0)" ::: "memory");
}

__device__ __forceinline__ void p0_transpose_item8(const float* W, int K, int N, unsigned char* WT8, int k0, int n0, int orow0, LAS float* scr, int lane) {
    WtSrc r; r.W = W; r.N = N; r.k0 = k0; r.n0 = n0; r.dst = WT8 + (size_t)orow0 * K + k0;
    float tv[32]; wt_issue(r, lane, tv); wt_finish(r, lane, tv, (LAS unsigned char*)scr);
}
constexpr int WT_I_IN = 16 * 73, WT_I_OUT = 16 * 32, WT_I_GU = 16 * 64, WT_I_DN = 16 * 32;
constexpr int WT_PER_LAYER = WT_I_IN + WT_I_OUT + NE * WT_I_GU + NE * WT_I_DN;
constexpr int WT_DEF0_LO = WT_PER_LAYER + WT_I_IN + WT_I_OUT + NE * WT_I_GU, WT_DEF0_HI = 2 * WT_PER_LAYER;
constexpr int WT_DEF1_LO = WT_PER_LAYER + WT_I_IN + WT_I_OUT, WT_DEF1_HI = WT_DEF1_LO + 16 * WT_I_GU;
__device__ __forceinline__ void weight_item(const Params& P, int it, LAS float* scr, int lane) {
    unsigned char* ws = P.ws;
    const int l = it / WT_PER_LAYER; int r = it % WT_PER_LAYER;
    if (r < WT_I_IN) { const int kb = r / 73, nb = r % 73;
        if (nb == 56) p0_transpose_item(P.in[8] + (size_t)l * D * INW, D, INW, (bf16_t*)(ws + WS_WGT) + (size_t)l * 32 * D, 64 * kb, 32 * nb, 0, scr, lane);
        else if (F8_GEMM1[l]) p0_transpose_item8(P.in[8] + (size_t)l * D * INW, D, INW, ws + WS_WIN + (size_t)l * INP * D * 2, 64 * kb, 32 * nb, nb < 56 ? 32 * nb : 32 * (nb - 1), scr, lane);
        else p0_transpose_item(P.in[8] + (size_t)l * D * INW, D, INW, (bf16_t*)(ws + WS_WIN) + (size_t)l * INP * D, 64 * kb, 32 * nb, nb < 56 ? 32 * nb : 32 * (nb - 1), scr, lane);
        return; }
    r -= WT_I_IN;
    if (r < WT_I_OUT) { const int kb = r / 32, nb = r % 32;
        p0_transpose_item(P.in[18] + (size_t)l * D * D, D, D, (bf16_t*)(ws + WS_WOUT) + (size_t)l * D * D, 64 * kb, 32 * nb, 32 * nb, scr, lane); return; }
    r -= WT_I_OUT;
    if (r < NE * WT_I_GU) { const int e = r / WT_I_GU, q = r % WT_I_GU, kb = q / 64, nb = q % 64; const int n0 = 32 * nb;
        const int j = n0 & 1023, orow = 256 * (j >> 7) + (n0 >= 1024 ? 128 : 0) + (j & 127);
        if (F8_LAYER[l]) p0_transpose_item8(P.in[21] + ((size_t)l * NE + e) * D * 2048, D, 2048, ws + WS_WGU + (size_t)l * NE * 2048 * D * 2 + (size_t)e * 2048 * D, 64 * kb, n0, orow, scr, lane);
        else p0_transpose_item(P.in[21] + ((size_t)l * NE + e) * D * 2048, D, 2048, (bf16_t*)(ws + WS_WGU) + ((size_t)l * NE + e) * 2048 * D, 64 * kb, n0, orow, scr, lane);
        return; }
    r -= NE * WT_I_GU;
    { const int e = r / WT_I_DN, q = r % WT_I_DN, kb = q / 32, nb = q % 32;
        if (F8_LAYER[l]) p0_transpose_item8(P.in[23] + ((size_t)l * NE + e) * DFF * D, DFF, D, ws + WS_WDN + (size_t)l * NE * D * DFF * 2 + (size_t)e * D * DFF, 64 * kb, 32 * nb, 32 * nb, scr, lane);
        else p0_transpose_item(P.in[23] + ((size_t)l * NE + e) * DFF * D, DFF, D, (bf16_t*)(ws + WS_WDN) + ((size_t)l * NE + e) * D * DFF, 64 * kb, 32 * nb, 32 * nb, scr, lane); }
}

constexpr int WT_EXP_ITEMS = NE * WT_I_GU + NE * WT_I_DN;
constexpr int GL_WT8 = 115200;
__device__ __forceinline__ WtSrc wt_decode(const Params& P, int l, int q) {
    unsigned char* ws = P.ws; WtSrc r;
    if (q < NE * WT_I_GU) { const int e = q / WT_I_GU, t = q % WT_I_GU, kb = t / 64, nb = t % 64; const int n0 = 32 * nb; const int j = n0 & 1023, orow = 256 * (j >> 7) + (n0 >= 1024 ? 128 : 0) + (j & 127);
        r.W = P.in[21] + ((size_t)l * NE + e) * D * 2048; r.N = 2048; r.k0 = 64 * kb; r.n0 = n0; r.dst = ws + WS_WGU + (size_t)l * NE * 2048 * D * 2 + ((size_t)e * 2048 + orow) * D + 64 * kb; }
    else { const int q2 = q - NE * WT_I_GU; const int e = q2 / WT_I_DN, t = q2 % WT_I_DN, kb = t / 32, nb = t % 32;
        r.W = P.in[23] + ((size_t)l * NE + e) * DFF * D; r.N = D; r.k0 = 64 * kb; r.n0 = 32 * nb; r.dst = ws + WS_WDN + (size_t)l * NE * D * DFF * 2 + ((size_t)e * D + 32 * nb) * DFF + 64 * kb; }
    return r;
}
constexpr int SH_N = 2;
__device__ __forceinline__ void shadow_convert(const Frame& F, const Params& P, int l, int krel) {
    const int stride = F.G * 7, lim = NE * WT_I_GU - 1; LAS unsigned char* scr8 = F.lds + F.wave * 2304;
    const int q0 = krel * SH_N * stride + F.bid * 7 + (F.wave - 1), q1 = q0 + stride;
    const WtSrc a = wt_decode(P, l, q0 < lim ? q0 : lim), b = wt_decode(P, l, q1 < lim ? q1 : lim);
    float tA[32], tB[32];
    wt_issue(a, F.lane, tA); wt_issue(b, F.lane, tB); wt_finish(a, F.lane, tA, scr8); wt_finish(b, F.lane, tB, scr8);
}
__device__ __forceinline__ void phase_prologue(const Frame& F, const Params& P) {
    unsigned char* ws = P.ws;
    LAS float* scr = (LAS float*)(F.lds + F.wave * 16384);
    const int gw = F.bid * NWAVES + F.wave, NGW = F.G * NWAVES;
    for (int it = gw; it < DEPTH * (WT_I_IN + WT_I_OUT); it += NGW) { const int l = it / (WT_I_IN + WT_I_OUT), r = it % (WT_I_IN + WT_I_OUT); weight_item(P, l * WT_PER_LAYER + r, scr, F.lane); }
    {
        const int gt = F.bid * NTHREADS + F.tid, NGT = F.G * NTHREADS;
        bf16_t* cm3 = (bf16_t*)(ws + WS_CM3);
        for (int i = gt; i < 192 * 64; i += NGT) { const int m = i >> 6, n2 = i & 63, part = m >> 6, k2 = m & 63; const int ph = (k2 * n2) & 63;
            float s, c; sincospif((float)ph * (1.0f / 32.0f), &s, &c); const float v = part == 0 ? c : (part == 1 ? -s : -c); cm3[i] = (bf16_t)f2bf(v); }
        bf16_t* rwt = (bf16_t*)(ws + WS_RW);
        for (int i = gt; i < DEPTH * NE * D; i += NGT) { const int l = i / (NE * D), q = i % (NE * D), k = q >> 5, e = q & 31;
            const float w = P.in[19][(size_t)l * D * NE + q]; const unsigned hi = f2bf(w); const unsigned lo = f2bf(w - bf2f(hi));
            rwt[((size_t)l * 2 + 0) * NE * D + e * D + k] = (bf16_t)hi; rwt[((size_t)l * 2 + 1) * NE * D + e * D + k] = (bf16_t)lo; }
        bf16_t* tf2 = (bf16_t*)(ws + WS_TF2);
        for (int i = gt; i < 128 * 128; i += NGT) { const int c_ = i >> 7, n = i & 127; const int ph = (c_ * n) & 127;
            float s, c; sincospif((float)ph * (1.0f / 64.0f), &s, &c); tf2[i] = (bf16_t)f2bf(c); tf2[128 * 128 + i] = (bf16_t)f2bf(s); }
        bf16_t* tctx = (bf16_t*)(ws + WS_TCTX);
        for (int i = gt; i < 256 * 256; i += NGT) { const int k1 = i >> 8, n = i & 255; const int ph = (k1 * n) & 255;
            float s, c; sincospif((float)ph * (1.0f / 128.0f), &s, &c); tctx[i] = (bf16_t)f2bf(c); tctx[256 * 256 + i] = (bf16_t)f2bf(s); }
        bf16_t* tlat = (bf16_t*)(ws + WS_TLAT);
        for (int i = gt; i < 128 * 128 * 128; i += NGT) { const int nlo = i >> 14, d = (i >> 7) & 127, a = i & 127; const int ph = (d * (nlo + 128 * a)) & 16383;
            float s, c; sincospif((float)ph * (1.0f / 8192.0f), &s, &c);
            tlat[(size_t)nlo * 32768 + d * 128 + a] = (bf16_t)f2bf(c); tlat[(size_t)nlo * 32768 + 16384 + d * 128 + a] = (bf16_t)f2bf(s); }
    }
    for (int it = F.bid + F.G * F.wave; it < DEPTH * 24 * 8; it += NGW) {
        const int l = it / 192, q = it % 192, cb = q >> 3, ks = q & 7;
        const float* wm = P.in[6] + (size_t)l * D * 6144 + (size_t)(ks * 128) * 6144 + cb * 256 + 4 * F.lane;
        f32x4 a0 = {0.f, 0.f, 0.f, 0.f}, a1 = a0, a2 = a0;
#pragma unroll 16
        for (int k = 0; k < 128; ++k) { const int kk = ks * 128 + k;
            const float c0 = P.in[1][kk], c1 = P.in[1][D + kk], c2 = P.in[3][kk];
            const float s0 = c0 * sigmoidf_(c0), s1 = c1 * sigmoidf_(c1), s2 = c2 * sigmoidf_(c2);
            const f32x4 w = *(const f32x4*)(wm + (size_t)k * 6144);
            a0 += w * s0; a1 += w * s1; a2 += w * s2; }
        float* mp = (float*)(ws + WS_MODP) + ((size_t)(l * 8 + ks) * 3) * 6144 + cb * 256 + 4 * F.lane;
        *(f32x4*)(mp) = a0; *(f32x4*)(mp + 6144) = a1; *(f32x4*)(mp + 2 * 6144) = a2;
    }
}

__device__ __forceinline__ f32x4 mod_from_partials(const Params& P, int l, int v, int c4) {
    f32x4 s = *(const f32x4*)(P.in[7] + (size_t)l * 6144 + c4);
    const float* mp = (const float*)(P.ws + WS_MODP) + ((size_t)(l * 8) * 3 + v) * 6144 + c4;
#pragma unroll
    for (int ks = 0; ks < 8; ++ks) s += *(const f32x4*)(mp + (size_t)ks * 3 * 6144);
    return s;
}

__device__ __forceinline__ void norm_row_store(const f32x4 (&x)[4], const float* g, const f32x4 (&shv)[4], const f32x4 (&scv)[4], bf16_t* orow, int lane, unsigned char* orow8 = nullptr) {
    float ss = 0.f;
#pragma unroll
    for (int j = 0; j < 4; ++j) ss += (x[j].x * x[j].x + x[j].y * x[j].y) + (x[j].z * x[j].z + x[j].w * x[j].w);
    const float rstd = 1.0f / sqrtf(wave_sum(ss) * (1.0f / D) + NORM_EPS);
#pragma unroll
    for (int j = 0; j < 4; ++j) { const int c = 4 * lane + 256 * j;
        const f32x4 gv = *(const f32x4*)(g + c);
        const f32x4 y = (x[j] * rstd) * gv * (scv[j] + 1.0f) + shv[j];
        u32x2 o; o.x = pk2(y.x, y.y); o.y = pk2(y.z, y.w);
        *(u32x2*)(orow + c) = o;
        if (orow8) *(unsigned*)(orow8 + c) = pk4_fp8(y.x, y.y, y.z, y.w); }
}

__device__ __forceinline__ void phase_p1(const Frame& F, const Params& P) {
    unsigned char* ws = P.ws;
    const int gt = F.bid * NTHREADS + F.tid, NGT = F.G * NTHREADS;
    float* modf = (float*)(ws + WS_MODF);
    for (int i = gt; i < DEPTH * 3 * 1536; i += NGT) { const int l = i / 4608, q = i % 4608, v = q / 1536, c4 = (q % 1536) * 4;
        *(f32x4*)(modf + ((size_t)l * 3 + v) * 6144 + c4) = mod_from_partials(P, l, v, c4); }
    const int gw = F.bid * NWAVES + F.wave, NGW = F.G * NWAVES;
    bf16_t* hb = (bf16_t*)(ws + WS_HBUF);
    int cur_v = -1; f32x4 shv[4], scv[4], xn[4];
    auto rowp = [&](int m) { return (m < NLAT) ? (P.in[0] + (size_t)m * D) : (P.in[2] + (size_t)(m - NLAT) * D); };
    if (gw < NTOK) {
#pragma unroll
        for (int j = 0; j < 4; ++j) xn[j] = *(const f32x4*)(rowp(gw) + 4 * F.lane + 256 * j); }
    for (int m = gw; m < NTOK; m += NGW) {
        const int v = (m >= NLAT) ? 2 : (m >= SEQ ? 1 : 0);
        f32x4 x[4];
#pragma unroll
        for (int j = 0; j < 4; ++j) x[j] = xn[j];
        if (m + NGW < NTOK) {
#pragma unroll
            for (int j = 0; j < 4; ++j) xn[j] = *(const f32x4*)(rowp(m + NGW) + 4 * F.lane + 256 * j); }
        if (v != cur_v) { cur_v = v;
#pragma unroll
            for (int j = 0; j < 4; ++j) { const int c = 4 * F.lane + 256 * j; shv[j] = mod_from_partials(P, 0, v, c); scv[j] = mod_from_partials(P, 0, v, 1024 + c); } }
        norm_row_store(x, P.in[4], shv, scv, hb + (size_t)m * D, F.lane);
    }
}

constexpr int GL_GT = 0;
constexpr int GL_A1 = 34816, GL_KE = 60416, GL_VTB = 78848, GL_RS = 97280, GL_RT = 97792;
constexpr int GL_KDT = 34816, GL_VT = 53248;

__device__ __forceinline__ float logsigmoid2f_(float x) { const float z = 1.44269504089f * x; return fminf(z, 0.f) - __builtin_amdgcn_logf(1.0f + __builtin_amdgcn_exp2f(-fabsf(z))); }
__device__ __forceinline__ float bfel(const u32x4& v, int j) { const unsigned w = (j < 2) ? v.x : (j < 4 ? v.y : (j < 6 ? v.z : v.w)); return (j & 1) ? bfhi(w) : bflo(w); }
__device__ __forceinline__ unsigned short bfraw(const u32x4& v, int j) { const unsigned w = (j < 2) ? v.x : (j < 4 ? v.y : (j < 6 ? v.z : v.w)); return (unsigned short)((j & 1) ? (w >> 16) : (w & 0xffffu)); }

struct GateRegs { bf16x8 a[4]; float bw[8]; float bg; };
__device__ __forceinline__ GateRegs gla_load_gate_regs(const Frame& F, const Params& P, int l, int row0, int h) {
    GateRegs g;
    const int dir = F.wave >> 2, dbase = (F.wave & 3) * 16, fr = F.lane & 15, fq = F.lane >> 4;
    const bf16_t* lrb = (const bf16_t*)(P.ws + WS_LRB);
#pragma unroll
    for (int mt = 0; mt < 4; ++mt) g.a[mt] = *(const bf16x8*)(lrb + (size_t)(row0 + mt * 16 + fr) * 32 + dir * 16 + (fq & 1) * 8);
    const float* wgp = (dir ? P.in[11] : P.in[9]) + (size_t)l * 16 * 256 + 64 * h + dbase + fr;
#pragma unroll
    for (int j = 0; j < 8; ++j) g.bw[j] = wgp[((fq & 1) * 8 + j) * 256];
    g.bg = (dir ? P.in[12] : P.in[10])[(size_t)l * 256 + 64 * h + dbase + fr];
    return g;
}
__device__ __forceinline__ void gla_gates(const Frame& F, const GateRegs& gr) {
    LAS float* GT = (LAS float*)(F.lds + GL_GT);
    const int dir = F.wave >> 2, dbase = (F.wave & 3) * 16, lane = F.lane, fr = lane & 15, fq = lane >> 4;
    float p[4][4]; float T[4];
    const bf16x8 z8 = {0, 0, 0, 0, 0, 0, 0, 0}; bf16x8 gb;
    { const u32x4 pb_ = {pk2(gr.bw[0], gr.bw[1]), pk2(gr.bw[2], gr.bw[3]), pk2(gr.bw[4], gr.bw[5]), pk2(gr.bw[6], gr.bw[7])}; gb = (fq < 2) ? __builtin_bit_cast(bf16x8, pb_) : z8; }
#pragma unroll
    for (int mt = 0; mt < 4; ++mt) { const f32x4 acc = __builtin_amdgcn_mfma_f32_16x16x32_bf16((fq < 2) ? gr.a[mt] : z8, gb, (f32x4){0.f, 0.f, 0.f, 0.f}, 0, 0, 0);
#pragma unroll
        for (int j = 0; j < 4; ++j) p[mt][j] = logsigmoid2f_(acc[j] + gr.bg) * (1.0f / 16.0f); }
    if (dir == 0) {
#pragma unroll
        for (int mt = 0; mt < 4; ++mt) { p[mt][1] += p[mt][0]; p[mt][2] += p[mt][1]; p[mt][3] += p[mt][2]; T[mt] = p[mt][3]; }
        float base = 0.f;
#pragma unroll
        for (int mt = 0; mt < 4; ++mt) { float inc = T[mt]; float v = __shfl_up(inc, 16); inc += (fq >= 1) ? v : 0.f; v = __shfl_up(inc, 32); inc += (fq >= 2) ? v : 0.f;
            const float off = base + (inc - T[mt]); const float ct = __shfl(inc, 48 + fr);
#pragma unroll
            for (int j = 0; j < 4; ++j) GT[(dbase + fr) * 65 + mt * 16 + fq * 4 + j] = off + p[mt][j];
            base += ct; }
    } else {
#pragma unroll
        for (int mt = 0; mt < 4; ++mt) { p[mt][2] += p[mt][3]; p[mt][1] += p[mt][2]; p[mt][0] += p[mt][1]; T[mt] = p[mt][0]; }
        float base = 0.f;
#pragma unroll
        for (int mt = 3; mt >= 0; --mt) { float inc = T[mt]; float v = __shfl_down(inc, 16); inc += (fq <= 2) ? v : 0.f; v = __shfl_down(inc, 32); inc += (fq <= 1) ? v : 0.f;
            const float off = base + (inc - T[mt]); const float ct = __shfl(inc, fr);
#pragma unroll
            for (int j = 0; j < 4; ++j) GT[(64 + dbase + fr) * 65 + mt * 16 + fq * 4 + j] = off + p[mt][j];
            base += ct; }
    }
}

__device__ __forceinline__ void gla_unit_rows(int u, int& row0, int& h) {
    if (u < 2048) { const int bh = u >> 8, n = u & 255; h = bh & 3; row0 = (bh >> 2) * SEQ + 64 * n; }
    else { const int q = u - 2048, bh = q >> 2, n = q & 3; h = bh & 3; row0 = NLAT + (bh >> 2) * CTXL + 64 * n; }
}
struct G1Ops { GateRegs gr; u32x4 kv; u32x4 vv[2]; };
struct G3Ops { GateRegs gr; u32x4 qv, kv; u32x4 vv[2], rv[2], stv[4]; };
__device__ __forceinline__ void gla_map_rm64(const Frame& F, int& row, int& c8) { row = F.tid >> 3; c8 = (F.tid & 7) * 8; }
__device__ __forceinline__ void gla_map_tr64(const Frame& F, int& row, int& c8) { row = 32 * (F.wave & 1) + (F.lane & 31); c8 = 8 * (2 * (F.wave >> 1) + (F.lane >> 5)); }
__device__ __forceinline__ void gla_map_tr128(const Frame& F, int i, int& row, int& c8) { row = 32 * i + (F.lane & 31); c8 = 8 * (2 * F.wave + (F.lane >> 5)); }
__device__ __forceinline__ void gla_map_rm128(const Frame& F, int i, int& row, int& c8) { const int id = F.tid + 512 * i; row = id >> 4; c8 = (id & 15) * 8; }
__device__ __forceinline__ void gla_load_k(const Frame& F, const Params& P, int row0, int h, u32x4& kv) { int r, c; gla_map_rm64(F, r, c);
    kv = *(const u32x4*)((const bf16_t*)(P.ws + WS_PBUF) + pb_addr(row0 + r, C_K + 64 * h + c)); }
__device__ __forceinline__ void gla_load_q(const Frame& F, const Params& P, int row0, int h, u32x4& qv) { int r, c; gla_map_rm64(F, r, c);
    qv = *(const u32x4*)((const bf16_t*)(P.ws + WS_PBUF) + pb_addr(row0 + r, C_Q + 64 * h + c)); }
__device__ __forceinline__ void gla_load_kt(const Frame& F, const Params& P, int row0, int h, u32x4& kv) { int r, c; gla_map_tr64(F, r, c);
    kv = *(const u32x4*)((const bf16_t*)(P.ws + WS_PBUF) + pb_addr(row0 + r, C_K + 64 * h + c)); }
__device__ __forceinline__ void gla_load_v(const Frame& F, const Params& P, int row0, int h, u32x4 (&v)[2]) {
#pragma unroll
    for (int i = 0; i < 2; ++i) { int r, c; gla_map_tr128(F, i, r, c); v[i] = *(const u32x4*)((const bf16_t*)(P.ws + WS_PBUF) + pb_addr(row0 + r, C_V + 128 * h + c)); } }
__device__ __forceinline__ void gla_load_r(const Frame& F, const Params& P, int row0, int h, u32x4 (&v)[2]) {
#pragma unroll
    for (int i = 0; i < 2; ++i) { int r, c; gla_map_rm128(F, i, r, c); v[i] = *(const u32x4*)((const bf16_t*)(P.ws + WS_PBUF) + pb_addr(row0 + r, C_R + 128 * h + c)); } }
__device__ __forceinline__ void gla_load_state(const Frame& F, const Params& P, int unit, u32x4 (&stv)[4]) {
    const bf16_t* st = (const bf16_t*)(P.ws + WS_STATE) + (size_t)unit * 16384;
#pragma unroll
    for (int i = 0; i < 4; ++i) stv[i] = *(const u32x4*)(st + (i * 512 + F.tid) * 8); }
__device__ __forceinline__ void gla_g1_unit(const Frame& F, const Params& P, int l, int unit, G1Ops& o, bool has_next, int nrow0, int nh) {
    const int tid = F.tid; int row, c8; gla_map_tr64(F, row, c8);
    gla_gates(F, o.gr);
    o.gr = gla_load_gate_regs(F, P, l, nrow0, nh);
    LDS_BARRIER();
    LAS float* GT = (LAS float*)(F.lds + GL_GT);
    LAS bf16_t* KDT = (LAS bf16_t*)(F.lds + GL_KDT); LAS bf16_t* VT = (LAS bf16_t*)(F.lds + GL_VT);
#pragma unroll
    for (int j = 0; j < 8; ++j) { const int d = c8 + j; const float k_ = bfel(o.kv, j);
        KDT[d * 72 + row] = (bf16_t)f2bf(k_ * __builtin_amdgcn_exp2f(GT[d * 65 + 63] - GT[d * 65 + row])); KDT[(64 + d) * 72 + row] = (bf16_t)f2bf(k_ * __builtin_amdgcn_exp2f(GT[(64 + d) * 65] - GT[(64 + d) * 65 + row])); }
    gla_load_kt(F, P, nrow0, nh, o.kv);
#pragma unroll
    for (int i = 0; i < 2; ++i) { int vr, vc; gla_map_tr128(F, i, vr, vc);
#pragma unroll
        for (int j = 0; j < 8; ++j) VT[(vc + j) * 72 + vr] = bfraw(o.vv[i], j); }
    gla_load_v(F, P, nrow0, nh, o.vv);
    if (tid < 128) ((float*)(P.ws + WS_DECAY))[(size_t)unit * 128 + tid] = __builtin_amdgcn_exp2f(tid < 64 ? GT[tid * 65 + 63] : GT[tid * 65]);
    LDS_BARRIER();
    const int fr = F.lane & 15, fq = F.lane >> 4, w = F.wave;
    f32x4 acc[1][8]; zero_acc<1, 8>(acc);
    mma_nt<1, 8>(acc, KDT + (16 * w) * 72, 72, VT, 72, 64, fr, fq);
    bf16_t* st = (bf16_t*)(P.ws + WS_STATE) + (size_t)unit * 16384;
#pragma unroll
    for (int nt = 0; nt < 8; ++nt) { u32x2 ov; ov.x = pk2(acc[0][nt][0], acc[0][nt][1]); ov.y = pk2(acc[0][nt][2], acc[0][nt][3]); *(u32x2*)(st + (nt * 16 + fr) * 128 + 16 * w + fq * 4) = ov; }
}

__device__ __forceinline__ void gla_scan(const Frame& F, const Params& P, int def_lo, int def_hi) {
    unsigned* stt = (unsigned*)(P.ws + WS_STATE); const float* dec = (const float*)(P.ws + WS_DECAY);
    if (F.tid >= 256) {
        LAS float* scr = (LAS float*)(F.lds + F.wave * 16384);
        for (int it = def_lo + F.bid * 4 + (F.wave - 4); it < def_hi; it += F.G * 4) weight_item(P, it, scr, F.lane);
        return; }
    for (int gid = F.bid * 256 + F.tid; gid < 8 * 128 * 64; gid += F.G * 256) {
        const int dp = gid & 63, e = (gid >> 6) & 127, bh = gid >> 13, dir = dp >> 5;
        const int latb = bh * 256, ctxb = 2048 + bh * 4;
        auto unit_of = [&](int p) { return dir == 0 ? (p < 4 ? ctxb + p : latb + (p - 4)) : (p < 4 ? ctxb + 3 - p : latb + 255 - (p - 4)); };
        float s0 = 0.f, s1 = 0.f;
        unsigned dA[10], dB[10]; f32x2 cA[10], cB[10];
#pragma unroll
        for (int i = 0; i < 10; ++i) { const int u = unit_of(i); dA[i] = stt[((size_t)u * 128 + e) * 64 + dp]; cA[i] = *(const f32x2*)(dec + (size_t)u * 128 + 2 * dp); }
        for (int p0 = 0; p0 < 260; p0 += 20) {
#pragma unroll
            for (int i = 0; i < 10; ++i) { const int u = unit_of(p0 + 10 + i); dB[i] = stt[((size_t)u * 128 + e) * 64 + dp]; cB[i] = *(const f32x2*)(dec + (size_t)u * 128 + 2 * dp); }
#pragma unroll
            for (int i = 0; i < 10; ++i) { const int u = unit_of(p0 + i); stt[((size_t)u * 128 + e) * 64 + dp] = pk2(s0, s1); s0 = cA[i].x * s0 + bflo(dA[i]); s1 = cA[i].y * s1 + bfhi(dA[i]); }
            if (p0 + 20 < 260) {
#pragma unroll
                for (int i = 0; i < 10; ++i) { const int u = unit_of(p0 + 20 + i); dA[i] = stt[((size_t)u * 128 + e) * 64 + dp]; cA[i] = *(const f32x2*)(dec + (size_t)u * 128 + 2 * dp); } }
#pragma unroll
            for (int i = 0; i < 10; ++i) { const int u = unit_of(p0 + 10 + i); stt[((size_t)u * 128 + e) * 64 + dp] = pk2(s0, s1); s0 = cB[i].x * s0 + bflo(dB[i]); s1 = cB[i].y * s1 + bfhi(dB[i]); }
        }
    }
}

__device__ __forceinline__ void gla_g3_unit(const Frame& F, const Params& P, int l, int row0, int h, int unit, G3Ops& o, const float (&ngv)[4], bool has_next, int nrow0, int nh, int nunit) {
    const int tid = F.tid, fr = F.lane & 15, fq = F.lane >> 4, w = F.wave; int row, c8; gla_map_rm64(F, row, c8);
    gla_gates(F, o.gr);
    o.gr = gla_load_gate_regs(F, P, l, nrow0, nh);
    LDS_BARRIER();
    LAS float* GT = (LAS float*)(F.lds + GL_GT);
    LAS bf16_t* A1 = (LAS bf16_t*)(F.lds + GL_A1); LAS bf16_t* KE = (LAS bf16_t*)(F.lds + GL_KE); LAS bf16_t* VTb = (LAS bf16_t*)(F.lds + GL_VTB); LAS bf16_t* STb = (LAS bf16_t*)(F.lds + GL_GT);
    LAS float* RS = (LAS float*)(F.lds + GL_RS); LAS bf16_t* RT = (LAS bf16_t*)(F.lds + GL_RT);
    { float qf[8], qb[8], kf[8], kb[8];
#pragma unroll
      for (int j = 0; j < 8; ++j) { const float q_ = bfel(o.qv, j) * 0.125f, k_ = bfel(o.kv, j); const float bf_ = GT[(c8 + j) * 65 + row], bb_ = GT[(64 + c8 + j) * 65 + row];
          qf[j] = q_ * __builtin_amdgcn_exp2f(bf_); qb[j] = q_ * __builtin_amdgcn_exp2f(bb_); kf[j] = k_ * __builtin_amdgcn_exp2f(-bf_); kb[j] = k_ * __builtin_amdgcn_exp2f(-bb_); }
      *(LAS u32x4*)(A1 + row * 200 + 64 + c8) = (u32x4){pk2(qf[0], qf[1]), pk2(qf[2], qf[3]), pk2(qf[4], qf[5]), pk2(qf[6], qf[7])};
      *(LAS u32x4*)(A1 + row * 200 + 128 + c8) = (u32x4){pk2(qb[0], qb[1]), pk2(qb[2], qb[3]), pk2(qb[4], qb[5]), pk2(qb[6], qb[7])};
      *(LAS u32x4*)(KE + row * 72 + c8) = (u32x4){pk2(kf[0], kf[1]), pk2(kf[2], kf[3]), pk2(kf[4], kf[5]), pk2(kf[6], kf[7])};
      *(LAS u32x4*)(KE + 4608 + row * 72 + c8) = (u32x4){pk2(kb[0], kb[1]), pk2(kb[2], kb[3]), pk2(kb[4], kb[5]), pk2(kb[6], kb[7])}; }
    gla_load_q(F, P, nrow0, nh, o.qv); gla_load_k(F, P, nrow0, nh, o.kv);
#pragma unroll
    for (int i = 0; i < 2; ++i) { int rr, rc, vr, vc; gla_map_rm128(F, i, rr, rc); gla_map_tr128(F, i, vr, vc); *(LAS u32x4*)(RT + rr * 136 + rc) = o.rv[i];
#pragma unroll
        for (int j = 0; j < 8; ++j) VTb[(vc + j) * 72 + vr] = bfraw(o.vv[i], j); }
    gla_load_v(F, P, nrow0, nh, o.vv); gla_load_r(F, P, nrow0, nh, o.rv);
    LDS_BARRIER();
    {
        const int mt = w & 3, ntp = w >> 2;
        f32x4 af[1][2], ab[1][2]; zero_acc<1, 2>(af); zero_acc<1, 2>(ab);
        mma_nt<1, 2>(af, A1 + (16 * mt) * 200 + 64, 200, KE + (32 * ntp) * 72, 72, 64, fr, fq);
        mma_nt<1, 2>(ab, A1 + (16 * mt) * 200 + 128, 200, KE + 4608 + (32 * ntp) * 72, 72, 64, fr, fq);
#pragma unroll
        for (int i = 0; i < 4; ++i) { const int idx = (i * 512 + tid) * 8, e = idx >> 7, dd = idx & 127; *(LAS u32x4*)(STb + e * 136 + dd) = o.stv[i]; }
        gla_load_state(F, P, nunit, o.stv);
#pragma unroll
        for (int nt = 0; nt < 2; ++nt)
#pragma unroll
            for (int j = 0; j < 4; ++j) { const int i = 16 * mt + fq * 4 + j, jj = (2 * ntp + nt) * 16 + fr;
                const float p = (jj <= i ? af[0][nt][j] : 0.f) + (jj >= i ? ab[0][nt][j] : 0.f); A1[i * 200 + jj] = (bf16_t)f2bf(p); }
    }
    LDS_BARRIER();
    {
        const int mt = w & 3, nh = w >> 2;
        f32x4 acc[1][4]; zero_acc<1, 4>(acc);
        mma_nt<1, 4>(acc, A1 + (16 * mt) * 200, 200, VTb + (64 * nh) * 72, 72, 64, fr, fq);
        mma_nt<1, 4>(acc, A1 + (16 * mt) * 200 + 64, 200, STb + (64 * nh) * 136, 136, 128, fr, fq);
        float ss[4];
#pragma unroll
        for (int j = 0; j < 4; ++j) { float s = 0.f;
#pragma unroll
            for (int nt = 0; nt < 4; ++nt) s += acc[0][nt][j] * acc[0][nt][j];
            s += __shfl_xor(s, 1); s += __shfl_xor(s, 2); s += __shfl_xor(s, 4); s += __shfl_xor(s, 8); ss[j] = s; }
        if (fr == 0) {
#pragma unroll
            for (int j = 0; j < 4; ++j) RS[nh * 64 + 16 * mt + fq * 4 + j] = ss[j]; }
        LDS_BARRIER();
        bf16_t* cat = (bf16_t*)(P.ws + WS_CAT);
#pragma unroll
        for (int j = 0; j < 4; ++j) { const int i = 16 * mt + fq * 4 + j; const float rinv = 1.0f / sqrtf((RS[i] + RS[64 + i]) * (1.0f / 128.0f) + NORM_EPS);
#pragma unroll
            for (int nt = 0; nt < 4; ++nt) { const int e = nh * 64 + nt * 16 + fr; const float r_ = bf2f(RT[i * 136 + e]);
                const float o = acc[0][nt][j] * rinv * ngv[nt] * (r_ * sigmoidf_(r_)); cat[(size_t)(row0 + i) * D + 256 + 128 * h + e] = (bf16_t)f2bf(o); } }
    }
}

__device__ __forceinline__ void conv_unit(const Frame& F, const Params& P, int l, int rowbase, int Ls, int t0) {
    const bf16_t* pb = (const bf16_t*)(P.ws + WS_PBUF);
    LAS bf16_t* Y = (LAS bf16_t*)(F.lds);
    LAS float* Z = (LAS float*)(F.lds + 49152);
    const int tid = F.tid;
    {
        u32x4 av[6], gv[6];
#pragma unroll
        for (int i = 0; i < 6; ++i) { const int ch = tid + 512 * i, r = ch >> 5, cc = (ch & 31) * 8, t = t0 - 15 + r;
            av[i] = (u32x4){0u, 0u, 0u, 0u}; gv[i] = av[i];
            if (ch < 94 * 32 && t >= 0 && t < Ls) { av[i] = *(const u32x4*)(pb + pb_addr(rowbase + t, C_CA + cc)); gv[i] = *(const u32x4*)(pb + pb_addr(rowbase + t, C_CG + cc)); } }
#pragma unroll
        for (int i = 0; i < 6; ++i) { const int ch = tid + 512 * i, r = ch >> 5, cc = (ch & 31) * 8; const u32x4 a = av[i], g = gv[i]; u32x4 o;
            o.x = pk2(bflo(a.x) * sigmoidf_(bflo(g.x)), bfhi(a.x) * sigmoidf_(bfhi(g.x))); o.y = pk2(bflo(a.y) * sigmoidf_(bflo(g.y)), bfhi(a.y) * sigmoidf_(bfhi(g.y)));
            o.z = pk2(bflo(a.z) * sigmoidf_(bflo(g.z)), bfhi(a.z) * sigmoidf_(bfhi(g.z))); o.w = pk2(bflo(a.w) * sigmoidf_(bflo(g.w)), bfhi(a.w) * sigmoidf_(bfhi(g.w)));
            if (ch < 94 * 32) *(LAS u32x4*)(Y + r * 256 + cc) = o; }
    }
    const int c2 = (tid & 127) * 2, qtr = tid >> 7; const float* cw = P.in[14] + (size_t)l * 31 * 256 + c2; const f32x2 cb = *(const f32x2*)(P.in[15] + (size_t)l * 256 + c2);
    f32x2 wv[31];
#pragma unroll
    for (int j = 0; j < 31; ++j) wv[j] = *(const f32x2*)(cw + j * 256);
    const f32x4 lng = *(const f32x4*)(P.in[16] + (size_t)l * 256 + 4 * F.lane), lnb = *(const f32x4*)(P.in[17] + (size_t)l * 256 + 4 * F.lane);
    LDS_BARRIER();
#pragma unroll 1
    for (int hp = 0; hp < 2; ++hp) { f32x2 yv[38]; const int rb = qtr * 16 + hp * 8;
#pragma unroll
      for (int r = 0; r < 38; ++r) { const unsigned wd = *(const LAS unsigned*)(Y + (rb + r) * 256 + c2); yv[r] = (f32x2){bflo(wd), bfhi(wd)}; }
#pragma unroll
      for (int tt = 0; tt < 8; ++tt) { f32x2 z = cb;
#pragma unroll
          for (int j = 0; j < 31; ++j) z += wv[j] * yv[tt + j];
          *(LAS f32x2*)(Z + (rb + tt) * 256 + c2) = z; } }
    LDS_BARRIER();
    { bf16_t* cat = (bf16_t*)(P.ws + WS_CAT);
#pragma unroll 2
      for (int i = 0; i < 8; ++i) { const int t = F.wave * 8 + i; const f32x4 z = *(const LAS f32x4*)(Z + t * 256 + 4 * F.lane);
          const float mean = wave_sum_dpp((z.x + z.y) + (z.z + z.w)) * (1.0f / 256.0f); const f32x4 zc = z - mean;
          const float var = wave_sum_dpp((zc.x * zc.x + zc.y * zc.y) + (zc.z * zc.z + zc.w * zc.w)) * (1.0f / 256.0f); const float rstd = 1.0f / sqrtf(var + NORM_EPS);
          const f32x4 y = zc * rstd * lng + lnb; u32x2 o; o.x = pk2(y.x * sigmoidf_(y.x), y.y * sigmoidf_(y.y)); o.y = pk2(y.z * sigmoidf_(y.z), y.w * sigmoidf_(y.w));
          *(u32x2*)(cat + (size_t)(rowbase + t0 + t) * D + 768 + 4 * F.lane) = o; } }
    LDS_BARRIER();
}

template <int R, int NP>
__device__ __forceinline__ void fourier_f1_unit(const Frame& F, const Params& P, int rowbase, int rstride, int h, const bf16_t* tab, int orow0, float oscale) {
    const bf16_t* pb = (const bf16_t*)(P.ws + WS_PBUF); const bf16_t* cm3 = (const bf16_t*)(P.ws + WS_CM3);
    constexpr int LZ = R + 8, MT0 = 4 * NP, NTW = R / 128, MTW = R / 128;
    LAS bf16_t* U = (LAS bf16_t*)(F.lds); LAS bf16_t* CM = U + R * 72; LAS bf16_t* ZT = CM + 64 * NP * 72;
    const int tid = F.tid, fr = F.lane & 15, fq = F.lane >> 4, w = F.wave;
    bf16x8 tcp[4], tsp[4];
    if constexpr (R == 128) {
#pragma unroll
        for (int k = 0; k < 4; ++k) { tcp[k] = *(const bf16x8*)(tab + (size_t)(w * 16 + fr) * R + k * 32 + fq * 8); tsp[k] = *(const bf16x8*)(tab + (size_t)R * R + (size_t)(w * 16 + fr) * R + k * 32 + fq * 8); } }
    { constexpr int NU = R * 8 / NTHREADS, NC = (64 * NP * 8 + NTHREADS - 1) / NTHREADS; u32x4 uv[NU], cv[NC];
#pragma unroll
      for (int i = 0; i < NU; ++i) { const int ch = tid + NTHREADS * i, a = ch >> 3, c8 = (ch & 7) * 8; uv[i] = *(const u32x4*)(pb + pb_addr(rowbase + a * rstride, C_FOUR + 64 * h + c8)); }
#pragma unroll
      for (int i = 0; i < NC; ++i) { const int ch = tid + NTHREADS * i, m = ch >> 3, c8 = (ch & 7) * 8; cv[i] = (ch < 64 * NP * 8) ? *(const u32x4*)(cm3 + m * 64 + c8) : (u32x4){0u, 0u, 0u, 0u}; }
#pragma unroll
      for (int i = 0; i < NU; ++i) { const int ch = tid + NTHREADS * i, a = ch >> 3, c8 = (ch & 7) * 8; *(LAS u32x4*)(U + a * 72 + c8) = uv[i]; }
#pragma unroll
      for (int i = 0; i < NC; ++i) { const int ch = tid + NTHREADS * i, m = ch >> 3, c8 = (ch & 7) * 8; if (ch < 64 * NP * 8) *(LAS u32x4*)(CM + m * 72 + c8) = cv[i]; } }
    LDS_BARRIER();
    {
        f32x4 acc[MT0][NTW]; zero_acc<MT0, NTW>(acc);
        mma_nt<MT0, NTW>(acc, CM, 72, U + (w * NTW * 16) * 72, 72, 64, fr, fq);
#pragma unroll
        for (int mt = 0; mt < MT0; ++mt)
#pragma unroll
            for (int nt = 0; nt < NTW; ++nt)
#pragma unroll
                for (int j = 0; j < 4; ++j) ZT[(mt * 16 + fq * 4 + j) * LZ + (w * NTW + nt) * 16 + fr] = (bf16_t)f2bf(acc[mt][nt][j]);
    }
    LDS_BARRIER();
    {
        f32x4 are[MTW][4], aim[MTW][4]; zero_acc<MTW, 4>(are); zero_acc<MTW, 4>(aim);
        const int m0 = w * MTW * 16;
#pragma unroll
        for (int k0 = 0; k0 < R; k0 += 32) {
            bf16x8 tc[MTW], ts[MTW];
#pragma unroll
            for (int mi = 0; mi < MTW; ++mi) { if constexpr (R == 128) { tc[mi] = tcp[k0 / 32]; ts[mi] = tsp[k0 / 32]; } else { tc[mi] = *(const bf16x8*)(tab + (size_t)(m0 + mi * 16 + fr) * R + k0 + fq * 8); ts[mi] = *(const bf16x8*)(tab + (size_t)R * R + (size_t)(m0 + mi * 16 + fr) * R + k0 + fq * 8); } }
#pragma unroll
            for (int nt = 0; nt < 4; ++nt) {
                const bf16x8 zr = *(const LAS bf16x8*)(ZT + (nt * 16 + fr) * LZ + k0 + fq * 8), zi = *(const LAS bf16x8*)(ZT + (64 + nt * 16 + fr) * LZ + k0 + fq * 8);
#pragma unroll
                for (int mi = 0; mi < MTW; ++mi) { are[mi][nt] = __builtin_amdgcn_mfma_f32_16x16x32_bf16(tc[mi], zr, are[mi][nt], 0, 0, 0); are[mi][nt] = __builtin_amdgcn_mfma_f32_16x16x32_bf16(ts[mi], zi, are[mi][nt], 0, 0, 0); }
                if constexpr (NP == 3) { const bf16x8 nzr = *(const LAS bf16x8*)(ZT + (128 + nt * 16 + fr) * LZ + k0 + fq * 8);
#pragma unroll
                    for (int mi = 0; mi < MTW; ++mi) { aim[mi][nt] = __builtin_amdgcn_mfma_f32_16x16x32_bf16(tc[mi], zi, aim[mi][nt], 0, 0, 0); aim[mi][nt] = __builtin_amdgcn_mfma_f32_16x16x32_bf16(ts[mi], nzr, aim[mi][nt], 0, 0, 0); } }
            }
        }
#pragma unroll
        for (int mi = 0; mi < MTW; ++mi)
#pragma unroll
            for (int nt = 0; nt < 4; ++nt)
#pragma unroll
                for (int j = 0; j < 4; ++j) { const int m = m0 + mi * 16 + fq * 4 + j, k2 = nt * 16 + fr;
                    if constexpr (NP == 3) { unsigned* t2 = (unsigned*)(P.ws + WS_T2); t2[(size_t)(orow0 + 128 * m) * 256 + h * 64 + k2] = pk2(are[mi][nt][j], aim[mi][nt][j]); }
                    else { bf16_t* cat = (bf16_t*)(P.ws + WS_CAT); cat[(size_t)(orow0 + m) * D + h * 64 + k2] = (bf16_t)f2bf(are[mi][nt][j] * oscale); } }
    }
    LDS_BARRIER();
}

struct F1Ops { bf16x8 tcp[4], tsp[4]; u32x4 uv[2]; };
__device__ __forceinline__ void f1_lat_load_u(const Frame& F, const Params& P, int rowbase, int h, u32x4 (&uv)[2]) {
#pragma unroll
    for (int i = 0; i < 2; ++i) { const int ch = F.tid + NTHREADS * i, a = ch >> 3, c8 = (ch & 7) * 8; uv[i] = *(const u32x4*)((const bf16_t*)(P.ws + WS_PBUF) + pb_addr(rowbase + a * 128, C_FOUR + 64 * h + c8)); } }
__device__ __forceinline__ void f1_lat_load_t(const Frame& F, const bf16_t* tab, bf16x8 (&tcp)[4], bf16x8 (&tsp)[4]) {
    const int fr = F.lane & 15, fq = F.lane >> 4, w = F.wave;
#pragma unroll
    for (int k = 0; k < 4; ++k) { tcp[k] = *(const bf16x8*)(tab + (size_t)(w * 16 + fr) * 128 + k * 32 + fq * 8); tsp[k] = *(const bf16x8*)(tab + (size_t)128 * 128 + (size_t)(w * 16 + fr) * 128 + k * 32 + fq * 8); } }
__device__ __forceinline__ void f1_lat_tables(const Frame& F, const Params& P) {
    const bf16_t* cm3 = (const bf16_t*)(P.ws + WS_CM3); LAS bf16_t* CM = (LAS bf16_t*)(F.lds) + 128 * 72;
#pragma unroll
    for (int i = 0; i < 3; ++i) { const int ch = F.tid + NTHREADS * i, m = ch >> 3, c8 = (ch & 7) * 8; *(LAS u32x4*)(CM + m * 72 + c8) = *(const u32x4*)(cm3 + m * 64 + c8); }
}
__device__ __forceinline__ void fourier_f1_lat_unit(const Frame& F, const Params& P, int h, int orow0, F1Ops& o, bool has_next, int nrowbase, int nh, const bf16_t* ntab) {
    constexpr int R = 128, LZ = R + 8;
    LAS bf16_t* U = (LAS bf16_t*)(F.lds); LAS bf16_t* CM = U + R * 72; LAS bf16_t* ZT = CM + 64 * 3 * 72;
    const int tid = F.tid, fr = F.lane & 15, fq = F.lane >> 4, w = F.wave;
#pragma unroll
    for (int i = 0; i < 2; ++i) { const int ch = tid + NTHREADS * i, a = ch >> 3, c8 = (ch & 7) * 8; *(LAS u32x4*)(U + a * 72 + c8) = o.uv[i]; }
    f1_lat_load_u(F, P, nrowbase, nh, o.uv);
    LDS_BARRIER();
    {
        f32x4 acc[12][1]; zero_acc<12, 1>(acc);
        mma_nt<12, 1>(acc, CM, 72, U + (w * 16) * 72, 72, 64, fr, fq);
#pragma unroll
        for (int mt = 0; mt < 12; ++mt)
#pragma unroll
            for (int j = 0; j < 4; ++j) ZT[(mt * 16 + fq * 4 + j) * LZ + w * 16 + fr] = (bf16_t)f2bf(acc[mt][0][j]);
    }
    LDS_BARRIER();
    {
        f32x4 are[4], aim[4];
#pragma unroll
        for (int nt = 0; nt < 4; ++nt) { are[nt] = (f32x4){0.f, 0.f, 0.f, 0.f}; aim[nt] = are[nt]; }
        const int m0 = w * 16;
#pragma unroll
        for (int k0 = 0; k0 < R; k0 += 32) {
            const bf16x8 tc = o.tcp[k0 / 32], ts = o.tsp[k0 / 32];
#pragma unroll
            for (int nt = 0; nt < 4; ++nt) {
                const bf16x8 zr = *(const LAS bf16x8*)(ZT + (nt * 16 + fr) * LZ + k0 + fq * 8), zi = *(const LAS bf16x8*)(ZT + (64 + nt * 16 + fr) * LZ + k0 + fq * 8), nzr = *(const LAS bf16x8*)(ZT + (128 + nt * 16 + fr) * LZ + k0 + fq * 8);
                are[nt] = __builtin_amdgcn_mfma_f32_16x16x32_bf16(tc, zr, are[nt], 0, 0, 0); are[nt] = __builtin_amdgcn_mfma_f32_16x16x32_bf16(ts, zi, are[nt], 0, 0, 0);
                aim[nt] = __builtin_amdgcn_mfma_f32_16x16x32_bf16(tc, zi, aim[nt], 0, 0, 0); aim[nt] = __builtin_amdgcn_mfma_f32_16x16x32_bf16(ts, nzr, aim[nt], 0, 0, 0); }
        }
        f1_lat_load_t(F, ntab, o.tcp, o.tsp);
        unsigned* t2 = (unsigned*)(P.ws + WS_T2);
#pragma unroll
        for (int nt = 0; nt < 4; ++nt)
#pragma unroll
            for (int j = 0; j < 4; ++j) { const int m = m0 + fq * 4 + j, k2 = nt * 16 + fr; t2[(size_t)(orow0 + 128 * m) * 256 + h * 64 + k2] = pk2(are[nt][j], aim[nt][j]); }
    }
    LDS_BARRIER();
}

constexpr int F2_X = 0, F2_T = 67584;
__device__ __forceinline__ void fourier_f2_tables(const Frame& F, const Params& P) {
    const bf16_t* tf2 = (const bf16_t*)(P.ws + WS_TF2); LAS bf16_t* T = (LAS bf16_t*)(F.lds + F2_T);
#pragma unroll
    for (int i = 0; i < 8; ++i) { const int ch = F.tid + 512 * i, r = ch >> 4, c8 = (ch & 15) * 8; *(LAS u32x4*)(T + r * 136 + c8) = *(const u32x4*)(tf2 + r * 128 + c8); }
    LDS_BARRIER();
}
__device__ __forceinline__ void fourier_f2_unit(const Frame& F, const Params& P, int b, int d, int hp) {
    const bf16_t* t2 = (const bf16_t*)(P.ws + WS_T2);
    LAS bf16_t* X = (LAS bf16_t*)(F.lds + F2_X); const LAS bf16_t* T = (const LAS bf16_t*)(F.lds + F2_T);
    const int tid = F.tid, fr = F.lane & 15, fq = F.lane >> 4, w = F.wave;
    { u32x4 xv[8];
#pragma unroll
      for (int i = 0; i < 8; ++i) { const int ch = tid + 512 * i, n = ch >> 5, c8 = (ch & 31) * 8; xv[i] = *(const u32x4*)(t2 + (size_t)(b * SEQ + 128 * d + n) * 512 + hp * 256 + c8); }
#pragma unroll
      for (int i = 0; i < 8; ++i) { const int ch = tid + 512 * i, n = ch >> 5, c8 = (ch & 31) * 8; *(LAS u32x4*)(X + n * 264 + c8) = xv[i]; } }
    LDS_BARRIER();
    f32x4 acc[8];
#pragma unroll
    for (int mt = 0; mt < 8; ++mt) acc[mt] = (f32x4){0.f, 0.f, 0.f, 0.f};
#pragma unroll
    for (int k0 = 0; k0 < 128; k0 += 32) {
        bf16x8 xr, xi;
#pragma unroll
        for (int jj = 0; jj < 8; ++jj) { const unsigned wd = *(const LAS unsigned*)(X + (k0 + fq * 8 + jj) * 264 + 2 * (w * 16 + fr)); xr[jj] = (short)(wd & 0xffffu); xi[jj] = (short)(wd >> 16); }
#pragma unroll
        for (int mt = 0; mt < 8; ++mt) { const bf16x8 tc = *(const LAS bf16x8*)(T + (mt * 16 + fr) * 136 + k0 + fq * 8), ts = *(const LAS bf16x8*)(T + (128 + mt * 16 + fr) * 136 + k0 + fq * 8);
            acc[mt] = __builtin_amdgcn_mfma_f32_16x16x32_bf16(tc, xr, acc[mt], 0, 0, 0); acc[mt] = __builtin_amdgcn_mfma_f32_16x16x32_bf16(ts, xi, acc[mt], 0, 0, 0); }
    }
    bf16_t* cat = (bf16_t*)(P.ws + WS_CAT);
#pragma unroll
    for (int mt = 0; mt < 8; ++mt)
#pragma unroll
        for (int j = 0; j < 4; ++j) { const int c = mt * 16 + fq * 4 + j; cat[(size_t)(b * SEQ + 128 * c + d) * D + hp * 128 + w * 16 + fr] = (bf16_t)f2bf(acc[mt][j] * (1.0f / 1024.0f)); }
    LDS_BARRIER();
}

constexpr int AX_LCNT = AUX_OFF, AX_GBASE = AUX_OFF + 128, AX_LE = AUX_OFF + 256, AX_LP = AUX_OFF + 256 + 2560;
constexpr int LC_BAR = LCTL_OFF, LC_TS = LCTL_OFF + 64;

constexpr int RT_GS = 0, RT_SSQ = 24576, RT_AT = 25600, RT_PL = 95232;
__device__ __forceinline__ void phase_route(const Frame& F, const Params& P, int l, int ntok) {
    unsigned char* ws = P.ws;
    LAS float* GS = (LAS float*)(F.lds + RT_GS); LAS float* SSQ = (LAS float*)(F.lds + RT_SSQ); LAS float* PL = (LAS float*)(F.lds + RT_PL);
    volatile LAS int* lcnt = (volatile LAS int*)(F.lds + AX_LCNT); volatile LAS int* gbase = (volatile LAS int*)(F.lds + AX_GBASE);
    volatile LAS int* LE = (volatile LAS int*)(F.lds + AX_LE); volatile LAS int* LP = (volatile LAS int*)(F.lds + AX_LP);
    const int tid = F.tid, lane = F.lane, w = F.wave, fr = lane & 15, fq = lane >> 4, ts = lane >> 2, kq = lane & 3, kbase = 128 * w + 32 * kq;
    LAS bf16_t* AT = (LAS bf16_t*)(F.lds + RT_AT) + w * (2 * 16 * 136);
    const int tpb = (ntok + F.G - 1) / F.G, tb = F.bid * tpb, te = (tb + tpb < ntok) ? tb + tpb : ntok, ntile = (te - tb + 15) >> 4;
    { const float* g2 = P.in[5] + (size_t)l * D;
      for (int i = tid; i < 3 * 1024; i += NTHREADS) { const int v = i >> 10, k = i & 1023; const float* mf = (const float*)(ws + WS_MODF) + ((size_t)l * 3 + v) * 6144;
          GS[(v * 2 + 0) * 1024 + k] = g2[k] * (1.0f + mf[4 * 1024 + k]); GS[(v * 2 + 1) * 1024 + k] = mf[3 * 1024 + k]; } }
    if (tid < 32) lcnt[tid] = 0;
    bf16x8 bh[4][2], bl[4][2];
    { const bf16_t* rwh = (const bf16_t*)(ws + WS_RW) + (size_t)l * 2 * NE * D; const bf16_t* rwl = rwh + NE * D;
#pragma unroll
      for (int sk = 0; sk < 4; ++sk)
#pragma unroll
          for (int nt = 0; nt < 2; ++nt) { const int off = (nt * 16 + fr) * D + 128 * w + 32 * sk + 8 * fq; bh[sk][nt] = *(const bf16x8*)(rwh + off); bl[sk][nt] = *(const bf16x8*)(rwl + off); } }
    const bf16_t* xres = (const bf16_t*)(ws + WS_XRES); bf16_t* hb = (bf16_t*)(ws + WS_HBUF);
    const float rbias = P.in[20][(size_t)l * NE + (lane & 31)];
    float* aprob = (float*)(ws + WS_APROB);
    u32x4 xn[4];
    { const int m = tb + ts;
#pragma unroll
      for (int j = 0; j < 4; ++j) xn[j] = (m < te) ? *(const u32x4*)(xres + (size_t)m * D + kbase + 8 * j) : (u32x4){0u, 0u, 0u, 0u}; }
    LDS_BARRIER();
    for (int it = 0; it < ntile; ++it) {
        const int buf = it & 1; const int m = tb + 16 * it + ts; const bool valid = m < te; const int v = (m >= NLAT) ? 2 : (m >= SEQ ? 1 : 0);
        f32x4 x[8]; float ss = 0.f;
#pragma unroll
        for (int j = 0; j < 8; ++j) { const u32x4 xw = xn[j >> 1]; x[j] = (j & 1) ? (f32x4){bflo(xw.z), bfhi(xw.z), bflo(xw.w), bfhi(xw.w)} : (f32x4){bflo(xw.x), bfhi(xw.x), bflo(xw.y), bfhi(xw.y)};
            ss += (x[j].x * x[j].x + x[j].y * x[j].y) + (x[j].z * x[j].z + x[j].w * x[j].w); }
        if (it + 1 < ntile) { const int mn = m + 16;
#pragma unroll
            for (int j = 0; j < 4; ++j) xn[j] = (mn < te) ? *(const u32x4*)(xres + (size_t)mn * D + kbase + 8 * j) : (u32x4){0u, 0u, 0u, 0u}; }
        ss += __shfl_xor(ss, 1); ss += __shfl_xor(ss, 2);
        if (kq == 0) SSQ[(buf * 8 + w) * 16 + ts] = ss;
        LDS_BARRIER();
        float tot = 0.f;
#pragma unroll
        for (int q = 0; q < 8; ++q) tot += SSQ[(buf * 8 + q) * 16 + ts];
        const float rstd = 1.0f / sqrtf(tot * (1.0f / D) + NORM_EPS);
        {
            unsigned hw[16], lw[16];
#pragma unroll
            for (int j = 0; j < 8; ++j) { const f32x4 gs = *(const LAS f32x4*)(GS + (v * 2 + 0) * 1024 + kbase + 4 * j), sh = *(const LAS f32x4*)(GS + (v * 2 + 1) * 1024 + kbase + 4 * j);
                const f32x4 h = (x[j] * rstd) * gs + sh;
                const unsigned h0 = f2bf(h.x), h1 = f2bf(h.y), h2 = f2bf(h.z), h3 = f2bf(h.w);
                hw[2 * j] = h0 | (h1 << 16); hw[2 * j + 1] = h2 | (h3 << 16);
                lw[2 * j] = pk2(h.x - bf2f(h0), h.y - bf2f(h1)); lw[2 * j + 1] = pk2(h.z - bf2f(h2), h.w - bf2f(h3)); }
            if (valid) {
                if (F8_LAYER[l]) { unsigned char* hb8 = ws + WS_HB8 + (size_t)m * D + kbase;
#pragma unroll
                    for (int c = 0; c < 2; ++c) { u32x4 o;
                        o.x = pk4_fp8(bflo(hw[8 * c + 0]) + bflo(lw[8 * c + 0]), bfhi(hw[8 * c + 0]) + bfhi(lw[8 * c + 0]), bflo(hw[8 * c + 1]) + bflo(lw[8 * c + 1]), bfhi(hw[8 * c + 1]) + bfhi(lw[8 * c + 1]));
                        o.y = pk4_fp8(bflo(hw[8 * c + 2]) + bflo(lw[8 * c + 2]), bfhi(hw[8 * c + 2]) + bfhi(lw[8 * c + 2]), bflo(hw[8 * c + 3]) + bflo(lw[8 * c + 3]), bfhi(hw[8 * c + 3]) + bfhi(lw[8 * c + 3]));
                        o.z = pk4_fp8(bflo(hw[8 * c + 4]) + bflo(lw[8 * c + 4]), bfhi(hw[8 * c + 4]) + bfhi(lw[8 * c + 4]), bflo(hw[8 * c + 5]) + bflo(lw[8 * c + 5]), bfhi(hw[8 * c + 5]) + bfhi(lw[8 * c + 5]));
                        o.w = pk4_fp8(bflo(hw[8 * c + 6]) + bflo(lw[8 * c + 6]), bfhi(hw[8 * c + 6]) + bfhi(lw[8 * c + 6]), bflo(hw[8 * c + 7]) + bflo(lw[8 * c + 7]), bfhi(hw[8 * c + 7]) + bfhi(lw[8 * c + 7]));
                        *(u32x4*)(hb8 + 16 * c) = o; } }
                if (!F8_LAYER[l]) {
#pragma unroll
                    for (int c = 0; c < 4; ++c) *(u32x4*)(hb + (size_t)m * D + kbase + 8 * c) = (u32x4){hw[4 * c], hw[4 * c + 1], hw[4 * c + 2], hw[4 * c + 3]}; } }
#pragma unroll
            for (int c = 0; c < 4; ++c) { *(LAS u32x4*)(AT + ts * 136 + 32 * kq + 8 * c) = (u32x4){hw[4 * c], hw[4 * c + 1], hw[4 * c + 2], hw[4 * c + 3]};
                *(LAS u32x4*)(AT + 16 * 136 + ts * 136 + 32 * kq + 8 * c) = (u32x4){lw[4 * c], lw[4 * c + 1], lw[4 * c + 2], lw[4 * c + 3]}; }
        }
        f32x4 acc[2]; acc[0] = (f32x4){0.f, 0.f, 0.f, 0.f}; acc[1] = acc[0];
#pragma unroll
        for (int sk = 0; sk < 4; ++sk) { const bf16x8 ah = *(const LAS bf16x8*)(AT + fr * 136 + 32 * sk + 8 * fq), al = *(const LAS bf16x8*)(AT + 16 * 136 + fr * 136 + 32 * sk + 8 * fq);
#pragma unroll
            for (int nt = 0; nt < 2; ++nt) { acc[nt] = __builtin_amdgcn_mfma_f32_16x16x32_bf16(ah, bh[sk][nt], acc[nt], 0, 0, 0); acc[nt] = __builtin_amdgcn_mfma_f32_16x16x32_bf16(ah, bl[sk][nt], acc[nt], 0, 0, 0);
                acc[nt] = __builtin_amdgcn_mfma_f32_16x16x32_bf16(al, bh[sk][nt], acc[nt], 0, 0, 0); } }
#pragma unroll
        for (int nt = 0; nt < 2; ++nt)
#pragma unroll
            for (int j = 0; j < 4; ++j) PL[((buf * 8 + w) * 16 + fq * 4 + j) * 33 + nt * 16 + fr] = acc[nt][j];
        LDS_BARRIER();
        {
            const int tt = 2 * w + (lane >> 5), e = lane & 31, mt = tb + 16 * it + tt;
            float lg = rbias;
#pragma unroll
            for (int q = 0; q < 8; ++q) lg += PL[((buf * 8 + q) * 16 + tt) * 33 + e];
            float bval[4]; int bidx[4]; float cur = lg;
#pragma unroll
            for (int k = 0; k < 4; ++k) { float bv = cur; int bi = e;
#pragma unroll
                for (int o = 1; o < 32; o <<= 1) { const float ov = __shfl_xor(bv, o); const int oi = __shfl_xor(bi, o); const bool take = (ov > bv) || (ov == bv && oi < bi); bv = take ? ov : bv; bi = take ? oi : bi; }
                bval[k] = bv; bidx[k] = bi; if (e == bi) cur = -INFINITY; }
            float ex[4], sum = 0.f;
#pragma unroll
            for (int k = 0; k < 4; ++k) { ex[k] = __expf(bval[k] - bval[0]); sum += ex[k]; }
            if (e == 0 && mt < te) { const int tl = 16 * it + tt;
#pragma unroll
                for (int k = 0; k < 4; ++k) { const int lp = __hip_atomic_fetch_add((LAS int*)(F.lds + AX_LCNT) + bidx[k], 1, __ATOMIC_RELAXED, __HIP_MEMORY_SCOPE_WORKGROUP);
                    LE[tl * 4 + k] = bidx[k]; LP[tl * 4 + k] = lp; aprob[(size_t)mt * 4 + k] = ex[k] / sum; } }
        }
    }
    LDS_BARRIER();
    if (tid < 32) gbase[tid] = (int)__hip_atomic_fetch_add((unsigned*)(ws + WS_CTL) + CW_CNT + l * 64 + tid, (unsigned)lcnt[tid], __ATOMIC_RELAXED, __HIP_MEMORY_SCOPE_AGENT);
    LDS_BARRIER();
    int* aexp = (int*)(ws + WS_AEXP); int* apos = (int*)(ws + WS_APOS);
    int* elist = (int*)(ws + WS_XB);
    for (int i = tid; i < (te - tb) * 4; i += NTHREADS) { const int e = LE[i]; const int pos = gbase[e] + LP[i]; aexp[(size_t)tb * 4 + i] = e; apos[(size_t)tb * 4 + i] = pos; elist[(size_t)e * NTOK + pos] = tb + (i >> 2); }
    LDS_BARRIER();
}

__device__ __forceinline__ void moe_prep(const Frame& F, const Params& P, int l) {
    unsigned char* ws = P.ws;
    volatile LAS int* TS = (volatile LAS int*)(F.lds + LC_TS);
    if (F.tid < 64) { const int e = F.lane & 31;
        const unsigned c = __hip_atomic_load((unsigned*)(ws + WS_CTL) + CW_CNT + l * 64 + e, __ATOMIC_RELAXED, __HIP_MEMORY_SCOPE_AGENT);
        int incl = (int)((c + 255u) >> 8);
#pragma unroll
        for (int o = 1; o < 32; o <<= 1) { const int v = __shfl_up(incl, o); if (e >= o) incl += v; }
        if (F.lane < 32) { TS[e + 1] = incl; TS[64 + e] = (int)c; }
        if (F.lane == 0) TS[0] = 0; }
    LDS_BARRIER();
}

__device__ __forceinline__ void phase_gather8(const Frame& F, const Params& P, int l, int ntok) {
    unsigned char* ws = P.ws;
    moe_prep(F, P, l);
    const volatile LAS int* TS = (const volatile LAS int*)(F.lds + LC_TS);
    const int gw = F.bid * NWAVES + F.wave, NGW = F.G * NWAVES;
    const int* aexp = (const int*)(ws + WS_AEXP); const int* apos = (const int*)(ws + WS_APOS);
    const unsigned char* hb8 = ws + WS_HB8; unsigned char* xb8 = ws + WS_XB8;
    for (int cidx = gw; cidx < ntok / 16; cidx += NGW) {
        const int a0 = cidx * 64; const int e = aexp[a0 + F.lane]; const int rowl = TS[e] * 256 + apos[a0 + F.lane];
#pragma unroll 1
        for (int t4 = 0; t4 < 16; t4 += 4) {
            u32x4 v0[4];
#pragma unroll
            for (int q = 0; q < 4; ++q) v0[q] = ((const u32x4*)(hb8 + (size_t)(a0 / 4 + t4 + q) * D))[F.lane];
#pragma unroll
            for (int q = 0; q < 4; ++q)
#pragma unroll
                for (int k = 0; k < 4; ++k) { const int row = __shfl(rowl, (t4 + q) * 4 + k); ((u32x4*)(xb8 + (size_t)row * D))[F.lane] = v0[q]; }
        }
    }
}

__device__ __forceinline__ void phase_combine(const Frame& F, const Params& P, int l, int ntok, bool last) {
    static_assert(F8_LAYER[0] && F8_LAYER[1], "combine reads fp8 expert outputs");
    unsigned char* ws = P.ws;
    const int gw = F.bid * NWAVES + F.wave, NGW = F.G * NWAVES, lane = F.lane, c0 = 16 * lane;
    bf16_t* xres = (bf16_t*)(ws + WS_XRES); const unsigned char* yb8 = ws + WS_YB;
    const int* aexp = (const int*)(ws + WS_AEXP); const int* apos = (const int*)(ws + WS_APOS); const float* aprob = (const float*)(ws + WS_APROB);
    const volatile LAS int* TS = (const volatile LAS int*)(F.lds + LC_TS);
    if (gw >= ntok) return;
    f32x4 g5[4], gn[4], sc1[4], sh[4]; int cur_v = -1;
    { const float* gp = last ? P.in[25] : P.in[4] + (size_t)(l + 1) * D;
#pragma unroll
      for (int q = 0; q < 4; ++q) gn[q] = *(const f32x4*)(gp + c0 + 4 * q); }
    i32x4 ae_n = *(const i32x4*)(aexp + (size_t)gw * 4), ap_n = *(const i32x4*)(apos + (size_t)gw * 4); f32x4 pr_n = *(const f32x4*)(aprob + (size_t)gw * 4);
    u32x4 wv[4], xo[2]; f32x4 pr;
    {
        int sl[4];
#pragma unroll
        for (int k = 0; k < 4; ++k) sl[k] = TS[ae_n[k]] * 256 + ap_n[k];
#pragma unroll
        for (int k = 0; k < 4; ++k) wv[k] = *(const u32x4*)(yb8 + (size_t)sl[k] * D + c0);
#pragma unroll
        for (int q = 0; q < 2; ++q) xo[q] = *(const u32x4*)(xres + (size_t)gw * D + c0 + 8 * q);
        pr = pr_n;
        const int m1 = (gw + NGW < ntok) ? gw + NGW : gw;
        ae_n = *(const i32x4*)(aexp + (size_t)m1 * 4); ap_n = *(const i32x4*)(apos + (size_t)m1 * 4); pr_n = *(const f32x4*)(aprob + (size_t)m1 * 4);
    }
    for (int m = gw; m < ntok; m += NGW) {
        const int v = (m >= NLAT) ? 2 : (m >= SEQ ? 1 : 0);
        if (v != cur_v) { cur_v = v;
            const float* mf = (const float*)(ws + WS_MODF) + ((size_t)l * 3 + v) * 6144; const float* mn = (const float*)(ws + WS_MODF) + ((size_t)((l + 1) & 1) * 3 + v) * 6144;
#pragma unroll
            for (int q = 0; q < 4; ++q) { g5[q] = *(const f32x4*)(mf + 5 * 1024 + c0 + 4 * q);
                if (!last) { sh[q] = *(const f32x4*)(mn + c0 + 4 * q); sc1[q] = *(const f32x4*)(mn + 1024 + c0 + 4 * q) + 1.0f; } } }
        f32x4 y[4];
#pragma unroll
        for (int q = 0; q < 4; ++q) y[q] = (f32x4){0.f, 0.f, 0.f, 0.f};
#pragma unroll
        for (int k = 0; k < 4; ++k) { const float pk_ = pr[k]; const u32x4 w4 = wv[k];
#pragma unroll
            for (int q = 0; q < 4; ++q) { const unsigned wd = (q == 0) ? w4.x : (q == 1 ? w4.y : (q == 2 ? w4.z : w4.w));
                const f32x2 lo = __builtin_amdgcn_cvt_pk_f32_fp8(wd, false), hi = __builtin_amdgcn_cvt_pk_f32_fp8(wd, true); y[q] += (f32x4){lo.x, lo.y, hi.x, hi.y} * pk_; } }
        f32x4 x[4];
        x[0] = (f32x4){bflo(xo[0].x), bfhi(xo[0].x), bflo(xo[0].y), bfhi(xo[0].y)} + g5[0] * y[0]; x[1] = (f32x4){bflo(xo[0].z), bfhi(xo[0].z), bflo(xo[0].w), bfhi(xo[0].w)} + g5[1] * y[1];
        x[2] = (f32x4){bflo(xo[1].x), bfhi(xo[1].x), bflo(xo[1].y), bfhi(xo[1].y)} + g5[2] * y[2]; x[3] = (f32x4){bflo(xo[1].z), bfhi(xo[1].z), bflo(xo[1].w), bfhi(xo[1].w)} + g5[3] * y[3];
        const int mn1 = m + NGW;
        if (mn1 < ntok) {
            int sl[4];
#pragma unroll
            for (int k = 0; k < 4; ++k) sl[k] = TS[ae_n[k]] * 256 + ap_n[k];
#pragma unroll
            for (int k = 0; k < 4; ++k) wv[k] = *(const u32x4*)(yb8 + (size_t)sl[k] * D + c0);
#pragma unroll
            for (int q = 0; q < 2; ++q) xo[q] = *(const u32x4*)(xres + (size_t)mn1 * D + c0 + 8 * q);
            pr = pr_n;
            const int m2 = (mn1 + NGW < ntok) ? mn1 + NGW : mn1;
            ae_n = *(const i32x4*)(aexp + (size_t)m2 * 4); ap_n = *(const i32x4*)(apos + (size_t)m2 * 4); pr_n = *(const f32x4*)(aprob + (size_t)m2 * 4); }
        float ss = 0.f;
#pragma unroll
        for (int q = 0; q < 4; ++q) ss += (x[q].x * x[q].x + x[q].y * x[q].y) + (x[q].z * x[q].z + x[q].w * x[q].w);
        const float rstd = 1.0f / sqrtf(wave_sum(ss) * (1.0f / D) + NORM_EPS);
        if (!last) {
#pragma unroll
            for (int q = 0; q < 2; ++q) { u32x4 o; o.x = pk2(x[2 * q].x, x[2 * q].y); o.y = pk2(x[2 * q].z, x[2 * q].w); o.z = pk2(x[2 * q + 1].x, x[2 * q + 1].y); o.w = pk2(x[2 * q + 1].z, x[2 * q + 1].w);
                *(u32x4*)(xres + (size_t)m * D + c0 + 8 * q) = o; }
            f32x4 hv[4];
#pragma unroll
            for (int q = 0; q < 4; ++q) hv[q] = (x[q] * rstd) * gn[q] * sc1[q] + sh[q];
            bf16_t* hrow = (bf16_t*)(ws + WS_HBUF) + (size_t)m * D + c0;
#pragma unroll
            for (int q = 0; q < 2; ++q) { u32x4 o; o.x = pk2(hv[2 * q].x, hv[2 * q].y); o.y = pk2(hv[2 * q].z, hv[2 * q].w); o.z = pk2(hv[2 * q + 1].x, hv[2 * q + 1].y); o.w = pk2(hv[2 * q + 1].z, hv[2 * q + 1].w);
                *(u32x4*)(hrow + 8 * q) = o; }
            if (F8_GEMM1[(l + 1) & 1]) { u32x4 o; o.x = pk4_fp8(hv[0].x, hv[0].y, hv[0].z, hv[0].w); o.y = pk4_fp8(hv[1].x, hv[1].y, hv[1].z, hv[1].w); o.z = pk4_fp8(hv[2].x, hv[2].y, hv[2].z, hv[2].w); o.w = pk4_fp8(hv[3].x, hv[3].y, hv[3].z, hv[3].w);
                *(u32x4*)(ws + WS_HB8 + (size_t)m * D + c0) = o; }
        } else {
#pragma unroll
            for (int q = 0; q < 4; ++q) *(f32x4*)(P.out + (size_t)m * D + c0 + 4 * q) = (x[q] * rstd) * gn[q];
        }
    }
}

#ifndef REP_PRO
#define REP_PRO 1
#endif
#ifndef REP_GEMM1
#define REP_GEMM1 1
#endif
#ifndef REP_G1U
#define REP_G1U 1
#endif
#ifndef REP_F1U
#define REP_F1U 1
#endif
#ifndef REP_CONV
#define REP_CONV 1
#endif
#ifndef REP_F2U
#define REP_F2U 1
#endif
#ifndef REP_G3U
#define REP_G3U 1
#endif
#ifndef REP_GU
#define REP_GU 1
#endif
#ifndef REP_DN
#define REP_DN 1
#endif
#ifndef REP_GATH
#define REP_GATH 1
#endif
__global__ void __launch_bounds__(NTHREADS, 2) mega_fwd(Params P0) {
    extern __shared__ __attribute__((aligned(16))) unsigned char lds_raw[];
    Frame F0; F0.lds = (LAS unsigned char*)lds_raw; F0.tid = threadIdx.x; F0.lane = F0.tid & 63; F0.wave = __builtin_amdgcn_readfirstlane(F0.tid >> 6); F0.G = gridDim.x; F0.bid = blockIdx.x;
#define KAS __attribute__((address_space(4)))
    struct ParamsK { const GAS float* in[26]; GAS float* out; GAS unsigned char* ws; };
#define PHASE_ENV() Frame F = F0; asm volatile("" : "+v"(F.tid)); F.lane = F.tid & 63; F.wave = __builtin_amdgcn_readfirstlane(F.tid >> 6); asm volatile("" : "+s"(F.bid), "+s"(F.G)); \
    const KAS ParamsK* kp_ = (const KAS ParamsK*)__builtin_amdgcn_kernarg_segment_ptr(); asm volatile("" : "+s"(kp_)); Params P; \
    _Pragma("unroll") for (int i_ = 0; i_ < 26; ++i_) P.in[i_] = (const float*)kp_->in[i_]; \
    P.out = (float*)kp_->out; P.ws = (unsigned char*)kp_->ws; unsigned char* ws = P.ws; (void)ws;
    { PHASE_ENV();
    for (int u = F.tid; u < (LDS_BYTES - LCTL_OFF) / 4; u += NTHREADS) ((LAS unsigned*)(F.lds + LCTL_OFF))[u] = 0u;
    LDS_BARRIER();
    }
    { PHASE_ENV(); (void)xcd_barrier_post((unsigned*)(ws + WS_CTL) + CW_BAR, (volatile LAS unsigned*)(F.lds + LC_BAR)); }
#define GRID_BAR_SH(LAYER, KREL) do { PHASE_ENV(); XcdBarrier b_; b_.bar = (unsigned*)(ws + WS_CTL) + CW_BAR; b_.x = xb_xcc_id(); b_.st = (volatile LAS unsigned*)(F.lds + LC_BAR); \
    asm volatile("s_waitcnt vmcnt(0)" ::: "memory"); __syncthreads(); if (F.wave == 0) xcd_barrier_t0(b_); else shadow_convert(F, P, LAYER, KREL); __syncthreads(); } while (0)
#define GRID_BAR() do { PHASE_ENV(); XcdBarrier b_; b_.bar = (unsigned*)(ws + WS_CTL) + CW_BAR; b_.x = xb_xcc_id(); b_.st = (volatile LAS unsigned*)(F.lds + LC_BAR); xcd_barrier(b_); } while (0)

    for (int rep = 0; rep < REP_PRO; ++rep) { PHASE_ENV(); phase_prologue(F, P); }
    GRID_BAR_SH(0, 0);
    { PHASE_ENV(); phase_p1(F, P); }
    GRID_BAR_SH(0, 1);

    {
        constexpr int l = 0; constexpr bool last = (l == DEPTH - 1);
        for (int rep = 0; rep < REP_GEMM1; ++rep) { PHASE_ENV();
          pg8::StaticOrder S; S.init(NTOK, INP, F.G, F.bid);
          if constexpr (F8_GEMM1[l]) {
              pg8::Gemm g{(const bf16_t*)(ws + WS_HB8), (const bf16_t*)(ws + WS_WIN + (size_t)l * INP * D * 2), NTOK, INP, D / 2};
              pg8::EpiStoreBf16S E{(bf16_t*)(ws + WS_PBUF), INP};
              pg8::gemm_phase<pg8::EpiStoreBf16S, pg8::StaticOrder, true, true, true>(F.lds, g, S, E, F.tid);
          } else {
              pg8::Gemm g{(const bf16_t*)(ws + WS_HBUF), (const bf16_t*)(ws + WS_WIN) + (size_t)l * INP * D, NTOK, INP, D};
              pg8::EpiStoreBf16 E{(bf16_t*)(ws + WS_PBUF), INP};
              pg8::gemm_phase<pg8::EpiStoreBf16, pg8::StaticOrder>(F.lds, g, S, E, F.tid); }
          const int nun = (NTOK / 256) * (INP / 256), rr = nun % F.G, first = (rr == 0) ? 0 : rr, nidle = F.G - first;
          if (F.bid >= first) for (int t = F.bid - first; t < NTOK / 256; t += nidle) {
              SkEpiBf16 SE{(bf16_t*)(ws + WS_LRB) + (size_t)t * 256 * 32, 32};
              skinny_unit(F, (const bf16_t*)(ws + WS_HBUF) + (size_t)t * 256 * D, (const bf16_t*)(ws + WS_WGT) + (size_t)l * 32 * D, SE); } }
        GRID_BAR_SH(0, 2);
        for (int rep = 0; rep < REP_G1U; ++rep) { PHASE_ENV();
        { LAS unsigned char* scr8 = F.lds + GL_WT8 + F.wave * 2304; const int gw_ = F.bid * NWAVES + F.wave, NGW_ = F.G * NWAVES;
          constexpr int QHI = NE * WT_I_GU; const int QLO = (l == 0 ? 7 : 9) * SH_N * 7 * F.G, nbg = (QHI - QLO + NGW_ - 1) / NGW_; int q_ = QLO + gw_;
        G1Ops ops_; { int r0_, h0_; gla_unit_rows(F.bid, r0_, h0_); ops_.gr = gla_load_gate_regs(F, P, l, r0_, h0_); gla_load_kt(F, P, r0_, h0_, ops_.kv); gla_load_v(F, P, r0_, h0_, ops_.vv); }
        int u = F.bid;
        for (int i_ = 0; i_ < nbg && u < 2080; ++i_, u += F.G) { int nrow0, nh; const bool hn_ = u + F.G < 2080; gla_unit_rows(hn_ ? u + F.G : u, nrow0, nh);
            float tv_[32]; const WtSrc ws_ = wt_decode(P, l, q_ < QHI ? q_ : QHI - 1); wt_issue(ws_, F.lane, tv_);
            gla_g1_unit(F, P, l, u, ops_, hn_, nrow0, nh);
            wt_finish(ws_, F.lane, tv_, scr8); q_ += NGW_; }
        for (; u < 2080; u += F.G) { int nrow0, nh; const bool hn_ = u + F.G < 2080; gla_unit_rows(hn_ ? u + F.G : u, nrow0, nh);
            gla_g1_unit(F, P, l, u, ops_, hn_, nrow0, nh); } }
        LDS_BARRIER(); }
        for (int rep = 0; rep < REP_F1U; ++rep) { PHASE_ENV();
        { f1_lat_tables(F, P);
          F1Ops fo_; { const int u = F.bid, b = u >> 9, nlo = (u >> 2) & 127, h = u & 3; f1_lat_load_u(F, P, b * SEQ + nlo, h, fo_.uv); f1_lat_load_t(F, (const bf16_t*)(ws + WS_TLAT) + (size_t)nlo * 32768, fo_.tcp, fo_.tsp); }
          for (int u = F.bid; u < 1024; u += F.G) { const int b = u >> 9, nlo = (u >> 2) & 127, h = u & 3; const bool hn_ = u + F.G < 1024; const int un = hn_ ? u + F.G : u, bn = un >> 9, nlon = (un >> 2) & 127, hn = un & 3;
            fourier_f1_lat_unit(F, P, h, b * SEQ + nlo, fo_, hn_, bn * SEQ + nlon, hn, (const bf16_t*)(ws + WS_TLAT) + (size_t)nlon * 32768); } }
        }
        { PHASE_ENV();
        if (!last) for (int u = (F.bid + F.G - 32) % F.G; u < 8; u += F.G) { const int b = u >> 2, h = u & 3;
            fourier_f1_unit<256, 2>(F, P, NLAT + b * CTXL, 1, h, (const bf16_t*)(ws + WS_TCTX), NLAT + b * CTXL, 1.0f / 128.0f); }
        }
        for (int rep = 0; rep < REP_CONV; ++rep) { PHASE_ENV();
        for (int u = F.bid; u < 512 + F.G; u += F.G) {
            int rowbase = 64 * u, Ls = 64, t0 = 0;
            if (u >= 512) { const int q = (u - 512) - 40; if (last || q < 0 || q >= 8) break; rowbase = NLAT + (q >> 2) * CTXL; Ls = CTXL; t0 = 64 * (q & 3); }
            conv_unit(F, P, l, rowbase, Ls, t0); } }
        GRID_BAR_SH(0, 3);
        { PHASE_ENV(); gla_scan(F, P, l * WT_PER_LAYER + WT_I_IN + WT_I_OUT + NE * WT_I_GU, (l + 1) * WT_PER_LAYER); LDS_BARRIER(); }
        for (int rep = 0; rep < REP_F2U; ++rep) { PHASE_ENV();
        fourier_f2_tables(F, P);
        for (int u = F.bid; u < 512; u += F.G) fourier_f2_unit(F, P, u >> 8, (u >> 1) & 127, u & 1); }
        GRID_BAR_SH(0, 4);
        for (int rep = 0; rep < REP_G3U; ++rep) { PHASE_ENV();
        {
        constexpr int NU3 = last ? 2048 : 2080;
        float ngv_[4];
#pragma unroll
        for (int nt = 0; nt < 4; ++nt) ngv_[nt] = (P.in[13] + (size_t)l * 128)[(F.wave >> 2) * 64 + nt * 16 + (F.lane & 15)];
        G3Ops ops_; { int r0_, h0_; gla_unit_rows(F.bid, r0_, h0_); ops_.gr = gla_load_gate_regs(F, P, l, r0_, h0_); gla_load_q(F, P, r0_, h0_, ops_.qv); gla_load_k(F, P, r0_, h0_, ops_.kv);
            gla_load_v(F, P, r0_, h0_, ops_.vv); gla_load_r(F, P, r0_, h0_, ops_.rv); gla_load_state(F, P, F.bid, ops_.stv); }
        for (int u = F.bid; u < NU3; u += F.G) { int row0, h, nrow0, nh; gla_unit_rows(u, row0, h); const bool hn_ = u + F.G < NU3; gla_unit_rows(hn_ ? u + F.G : u, nrow0, nh);
            gla_g3_unit(F, P, l, row0, h, u, ops_, ngv_, hn_, nrow0, nh, hn_ ? u + F.G : u); } }
        LDS_BARRIER(); }
        GRID_BAR_SH(0, 5);
        { PHASE_ENV(); const int M2 = NLAT;
          pg8::Gemm g{(const bf16_t*)(ws + WS_CAT), (const bf16_t*)(ws + WS_WOUT) + (size_t)l * D * D, M2, D, D};
          pg8::StaticOrder S; S.init(M2, D, F.G, F.bid);
          pg8::EpiResid<l == 0> E{(bf16_t*)(ws + WS_XRES), (l == 0) ? (const void*)P.in[0] : (const void*)(ws + WS_XRES), (const float*)(ws + WS_MODF) + (size_t)l * 3 * 6144};
          pg8::gemm_phase<pg8::EpiResid<l == 0>, pg8::StaticOrder>(F.lds, g, S, E, F.tid);
          if (!last) for (int t = F.bid; t < 2 * 32; t += F.G) { const int pm = NLAT / 256 + (t >> 5), nt32 = t & 31;
              SkEpiResid SE{(bf16_t*)(ws + WS_XRES) + (size_t)pm * 256 * D + nt32 * 32, P.in[2] + (size_t)(pm - NLAT / 256) * 256 * D + nt32 * 32, (const float*)(ws + WS_MODF) + ((size_t)l * 3 + 2) * 6144 + 2 * 1024 + nt32 * 32};
              skinny_unit(F, (const bf16_t*)(ws + WS_CAT) + (size_t)pm * 256 * D, (const bf16_t*)(ws + WS_WOUT) + (size_t)l * D * D + (size_t)nt32 * 32 * D, SE); } }
        GRID_BAR_SH(0, 6);
        const int ntok = last ? NLAT : NTOK;
        { PHASE_ENV(); phase_route(F, P, l, ntok); }
        GRID_BAR_SH(1, 0);
        for (int rep = 0; rep < REP_GU; ++rep) { PHASE_ENV(); moe_prep(F, P, l); const volatile LAS int* TS = (const volatile LAS int*)(F.lds + LC_TS);
          pg8::MoeOrder S{8, F.G, F.bid, TS[NE], TS};
          if constexpr (F8_LAYER[l]) {
              pg8::Gemm g{(const bf16_t*)(ws + WS_HB8), (const bf16_t*)(ws + WS_WGU + (size_t)l * NE * 2048 * D * 2), 0, 2048, D / 2};
              pg8::EpiGateUp8 E{ws + WS_ACT, P.in[22] + (size_t)l * NE * 2048};
              pg8::gemm_phase_gather<pg8::EpiGateUp8, pg8::MoeOrder, true>(F.lds, g, (const int*)(ws + WS_XB), S, E, F.tid);
          } else {
              pg8::Gemm g{(const bf16_t*)(ws + WS_HBUF), (const bf16_t*)(ws + WS_WGU) + (size_t)l * NE * 2048 * D, 0, 2048, D};
              pg8::EpiGateUp E{(bf16_t*)(ws + WS_ACT), P.in[22] + (size_t)l * NE * 2048};
              pg8::gemm_phase_gather<pg8::EpiGateUp, pg8::MoeOrder>(F.lds, g, (const int*)(ws + WS_XB), S, E, F.tid); } }
        GRID_BAR_SH(1, 1);
        for (int rep = 0; rep < REP_DN; ++rep) { PHASE_ENV(); const volatile LAS int* TS = (const volatile LAS int*)(F.lds + LC_TS);
          pg8::MoeOrder S{4, F.G, F.bid, TS[NE], TS};
          if constexpr (F8_LAYER[l]) {
              pg8::Gemm g{(const bf16_t*)(ws + WS_ACT), (const bf16_t*)(ws + WS_WDN + (size_t)l * NE * D * DFF * 2), 0, D, DFF / 2};
              pg8::EpiDown8 E{ws + WS_YB, P.in[24] + (size_t)l * NE * D};
              pg8::gemm_phase<pg8::EpiDown8, pg8::MoeOrder, true, true, true>(F.lds, g, S, E, F.tid);
          } else {
              pg8::Gemm g{(const bf16_t*)(ws + WS_ACT), (const bf16_t*)(ws + WS_WDN) + (size_t)l * NE * D * DFF, 0, D, DFF};
              pg8::EpiDown E{(bf16_t*)(ws + WS_YB), P.in[24] + (size_t)l * NE * D};
              pg8::gemm_phase<pg8::EpiDown, pg8::MoeOrder>(F.lds, g, S, E, F.tid); } }
        GRID_BAR_SH(1, 2);
        { PHASE_ENV(); phase_combine(F, P, l, ntok, last); }
        if (!last) GRID_BAR_SH(1, 3);
    }
    {
        constexpr int l = 1; constexpr bool last = (l == DEPTH - 1);
        for (int rep = 0; rep < REP_GEMM1; ++rep) { PHASE_ENV();
          pg8::StaticOrder S; S.init(NTOK, INP, F.G, F.bid);
          if constexpr (F8_GEMM1[l]) {
              pg8::Gemm g{(const bf16_t*)(ws + WS_HB8), (const bf16_t*)(ws + WS_WIN + (size_t)l * INP * D * 2), NTOK, INP, D / 2};
              pg8::EpiStoreBf16S E{(bf16_t*)(ws + WS_PBUF), INP};
              pg8::gemm_phase<pg8::EpiStoreBf16S, pg8::StaticOrder, true, true, true>(F.lds, g, S, E, F.tid);
          } else {
              pg8::Gemm g{(const bf16_t*)(ws + WS_HBUF), (const bf16_t*)(ws + WS_WIN) + (size_t)l * INP * D, NTOK, INP, D};
              pg8::EpiStoreBf16 E{(bf16_t*)(ws + WS_PBUF), INP};
              pg8::gemm_phase<pg8::EpiStoreBf16, pg8::StaticOrder>(F.lds, g, S, E, F.tid); }
          const int nun = (NTOK / 256) * (INP / 256), rr = nun % F.G, first = (rr == 0) ? 0 : rr, nidle = F.G - first;
          if (F.bid >= first) for (int t = F.bid - first; t < NTOK / 256; t += nidle) {
              SkEpiBf16 SE{(bf16_t*)(ws + WS_LRB) + (size_t)t * 256 * 32, 32};
              skinny_unit(F, (const bf16_t*)(ws + WS_HBUF) + (size_t)t * 256 * D, (const bf16_t*)(ws + WS_WGT) + (size_t)l * 32 * D, SE); } }
        GRID_BAR_SH(1, 4);
        for (int rep = 0; rep < REP_G1U; ++rep) { PHASE_ENV();
        { LAS unsigned char* scr8 = F.lds + GL_WT8 + F.wave * 2304; const int gw_ = F.bid * NWAVES + F.wave, NGW_ = F.G * NWAVES;
          constexpr int QHI = NE * WT_I_GU; const int QLO = (l == 0 ? 7 : 9) * SH_N * 7 * F.G, nbg = (QHI - QLO + NGW_ - 1) / NGW_; int q_ = QLO + gw_;
        G1Ops ops_; { int r0_, h0_; gla_unit_rows(F.bid, r0_, h0_); ops_.gr = gla_load_gate_regs(F, P, l, r0_, h0_); gla_load_kt(F, P, r0_, h0_, ops_.kv); gla_load_v(F, P, r0_, h0_, ops_.vv); }
        int u = F.bid;
        for (int i_ = 0; i_ < nbg && u < 2080; ++i_, u += F.G) { int nrow0, nh; const bool hn_ = u + F.G < 2080; gla_unit_rows(hn_ ? u + F.G : u, nrow0, nh);
            float tv_[32]; const WtSrc ws_ = wt_decode(P, l, q_ < QHI ? q_ : QHI - 1); wt_issue(ws_, F.lane, tv_);
            gla_g1_unit(F, P, l, u, ops_, hn_, nrow0, nh);
            wt_finish(ws_, F.lane, tv_, scr8); q_ += NGW_; }
        for (; u < 2080; u += F.G) { int nrow0, nh; const bool hn_ = u + F.G < 2080; gla_unit_rows(hn_ ? u + F.G : u, nrow0, nh);
            gla_g1_unit(F, P, l, u, ops_, hn_, nrow0, nh); } }
        LDS_BARRIER(); }
        for (int rep = 0; rep < REP_F1U; ++rep) { PHASE_ENV();
        { f1_lat_tables(F, P);
          F1Ops fo_; { const int u = F.bid, b = u >> 9, nlo = (u >> 2) & 127, h = u & 3; f1_lat_load_u(F, P, b * SEQ + nlo, h, fo_.uv); f1_lat_load_t(F, (const bf16_t*)(ws + WS_TLAT) + (size_t)nlo * 32768, fo_.tcp, fo_.tsp); }
          for (int u = F.bid; u < 1024; u += F.G) { const int b = u >> 9, nlo = (u >> 2) & 127, h = u & 3; const bool hn_ = u + F.G < 1024; const int un = hn_ ? u + F.G : u, bn = un >> 9, nlon = (un >> 2) & 127, hn = un & 3;
            fourier_f1_lat_unit(F, P, h, b * SEQ + nlo, fo_, hn_, bn * SEQ + nlon, hn, (const bf16_t*)(ws + WS_TLAT) + (size_t)nlon * 32768); } }
        }
        { PHASE_ENV();
        if (!last) for (int u = (F.bid + F.G - 32) % F.G; u < 8; u += F.G) { const int b = u >> 2, h = u & 3;
            fourier_f1_unit<256, 2>(F, P, NLAT + b * CTXL, 1, h, (const bf16_t*)(ws + WS_TCTX), NLAT + b * CTXL, 1.0f / 128.0f); }
        }
        for (int rep = 0; rep < REP_CONV; ++rep) { PHASE_ENV();
        for (int u = F.bid; u < 512 + F.G; u += F.G) {
            int rowbase = 64 * u, Ls = 64, t0 = 0;
            if (u >= 512) { const int q = (u - 512) - 40; if (last || q < 0 || q >= 8) break; rowbase = NLAT + (q >> 2) * CTXL; Ls = CTXL; t0 = 64 * (q & 3); }
            conv_unit(F, P, l, rowbase, Ls, t0); } }
        GRID_BAR_SH(1, 5);
        { PHASE_ENV(); gla_scan(F, P, l * WT_PER_LAYER + WT_I_IN + WT_I_OUT + NE * WT_I_GU, (l + 1) * WT_PER_LAYER); LDS_BARRIER(); }
        for (int rep = 0; rep < REP_F2U; ++rep) { PHASE_ENV();
        fourier_f2_tables(F, P);
        for (int u = F.bid; u < 512; u += F.G) fourier_f2_unit(F, P, u >> 8, (u >> 1) & 127, u & 1); }
        GRID_BAR_SH(1, 6);
        for (int rep = 0; rep < REP_G3U; ++rep) { PHASE_ENV();
        {
        constexpr int NU3 = last ? 2048 : 2080;
        float ngv_[4];
#pragma unroll
        for (int nt = 0; nt < 4; ++nt) ngv_[nt] = (P.in[13] + (size_t)l * 128)[(F.wave >> 2) * 64 + nt * 16 + (F.lane & 15)];
        G3Ops ops_; { int r0_, h0_; gla_unit_rows(F.bid, r0_, h0_); ops_.gr = gla_load_gate_regs(F, P, l, r0_, h0_); gla_load_q(F, P, r0_, h0_, ops_.qv); gla_load_k(F, P, r0_, h0_, ops_.kv);
            gla_load_v(F, P, r0_, h0_, ops_.vv); gla_load_r(F, P, r0_, h0_, ops_.rv); gla_load_state(F, P, F.bid, ops_.stv); }
        for (int u = F.bid; u < NU3; u += F.G) { int row0, h, nrow0, nh; gla_unit_rows(u, row0, h); const bool hn_ = u + F.G < NU3; gla_unit_rows(hn_ ? u + F.G : u, nrow0, nh);
            gla_g3_unit(F, P, l, row0, h, u, ops_, ngv_, hn_, nrow0, nh, hn_ ? u + F.G : u); } }
        LDS_BARRIER(); }
        GRID_BAR_SH(1, 7);
        { PHASE_ENV(); const int M2 = NLAT;
          pg8::Gemm g{(const bf16_t*)(ws + WS_CAT), (const bf16_t*)(ws + WS_WOUT) + (size_t)l * D * D, M2, D, D};
          pg8::StaticOrder S; S.init(M2, D, F.G, F.bid);
          pg8::EpiResid<l == 0> E{(bf16_t*)(ws + WS_XRES), (l == 0) ? (const void*)P.in[0] : (const void*)(ws + WS_XRES), (const float*)(ws + WS_MODF) + (size_t)l * 3 * 6144};
          pg8::gemm_phase<pg8::EpiResid<l == 0>, pg8::StaticOrder>(F.lds, g, S, E, F.tid);
          if (!last) for (int t = F.bid; t < 2 * 32; t += F.G) { const int pm = NLAT / 256 + (t >> 5), nt32 = t & 31;
              SkEpiResid SE{(bf16_t*)(ws + WS_XRES) + (size_t)pm * 256 * D + nt32 * 32, P.in[2] + (size_t)(pm - NLAT / 256) * 256 * D + nt32 * 32, (const float*)(ws + WS_MODF) + ((size_t)l * 3 + 2) * 6144 + 2 * 1024 + nt32 * 32};
              skinny_unit(F, (const bf16_t*)(ws + WS_CAT) + (size_t)pm * 256 * D, (const bf16_t*)(ws + WS_WOUT) + (size_t)l * D * D + (size_t)nt32 * 32 * D, SE); } }
        GRID_BAR_SH(1, 8);
        const int ntok = last ? NLAT : NTOK;
        { PHASE_ENV(); phase_route(F, P, l, ntok); }
        GRID_BAR();
        for (int rep = 0; rep < REP_GU; ++rep) { PHASE_ENV(); moe_prep(F, P, l); const volatile LAS int* TS = (const volatile LAS int*)(F.lds + LC_TS);
          pg8::MoeOrder S{8, F.G, F.bid, TS[NE], TS};
          if constexpr (F8_LAYER[l]) {
              pg8::Gemm g{(const bf16_t*)(ws + WS_HB8), (const bf16_t*)(ws + WS_WGU + (size_t)l * NE * 2048 * D * 2), 0, 2048, D / 2};
              pg8::EpiGateUp8 E{ws + WS_ACT, P.in[22] + (size_t)l * NE * 2048};
              pg8::gemm_phase_gather<pg8::EpiGateUp8, pg8::MoeOrder, true>(F.lds, g, (const int*)(ws + WS_XB), S, E, F.tid);
          } else {
              pg8::Gemm g{(const bf16_t*)(ws + WS_HBUF), (const bf16_t*)(ws + WS_WGU) + (size_t)l * NE * 2048 * D, 0, 2048, D};
              pg8::EpiGateUp E{(bf16_t*)(ws + WS_ACT), P.in[22] + (size_t)l * NE * 2048};
              pg8::gemm_phase_gather<pg8::EpiGateUp, pg8::MoeOrder>(F.lds, g, (const int*)(ws + WS_XB), S, E, F.tid); } }
        GRID_BAR();
        for (int rep = 0; rep < REP_DN; ++rep) { PHASE_ENV(); const volatile LAS int* TS = (const volatile LAS int*)(F.lds + LC_TS);
          pg8::MoeOrder S{4, F.G, F.bid, TS[NE], TS};
          if constexpr (F8_LAYER[l]) {
              pg8::Gemm g{(const bf16_t*)(ws + WS_ACT), (const bf16_t*)(ws + WS_WDN + (size_t)l * NE * D * DFF * 2), 0, D, DFF / 2};
              pg8::EpiDown8 E{ws + WS_YB, P.in[24] + (size_t)l * NE * D};
              pg8::gemm_phase<pg8::EpiDown8, pg8::MoeOrder, true, true, true>(F.lds, g, S, E, F.tid);
          } else {
              pg8::Gemm g{(const bf16_t*)(ws + WS_ACT), (const bf16_t*)(ws + WS_WDN) + (size_t)l * NE * D * DFF, 0, D, DFF};
              pg8::EpiDown E{(bf16_t*)(ws + WS_YB), P.in[24] + (size_t)l * NE * D};
              pg8::gemm_phase<pg8::EpiDown, pg8::MoeOrder>(F.lds, g, S, E, F.tid); } }
        GRID_BAR();
        { PHASE_ENV(); phase_combine(F, P, l, ntok, last); }
        if (!last) GRID_BAR();
    }
}

extern "C" void kernel_launch(void* const* d_in, const int* in_sizes, int n_in, void* d_out, int out_size, void* d_ws, size_t ws_size, hipStream_t stream) {
    static int grid = 0;
    if (grid == 0) {
        if (n_in != 26 || ws_size < WS_END) { fprintf(stderr, "kernel_launch: unexpected n_in %d or ws_size %zu (need %zu)\n", n_in, ws_size, (size_t)WS_END); grid = -1; return; }
        int dev = 0, cus = 0, per_cu = 0;
        if (hipGetDevice(&dev) != hipSuccess || hipDeviceGetAttribute(&cus, hipDeviceAttributeMultiprocessorCount, dev) != hipSuccess) { grid = -1; return; }
        if (hipFuncSetAttribute((const void*)mega_fwd, hipFuncAttributeMaxDynamicSharedMemorySize, LDS_BYTES) != hipSuccess) { fprintf(stderr, "kernel_launch: hipFuncSetAttribute failed\n"); grid = -1; return; }
        if (hipOccupancyMaxActiveBlocksPerMultiprocessor(&per_cu, (const void*)mega_fwd, NTHREADS, LDS_BYTES) != hipSuccess || per_cu < 1) { fprintf(stderr, "kernel_launch: occupancy query says %d\n", per_cu); }
        (void)hipGetLastError();
        grid = cus;
    }
    if (grid < 0) return;
    (void)hipMemsetAsync((char*)d_ws + WS_CTL, 0, CTL_ZERO_BYTES, stream);
    Params p{};
    for (int i = 0; i < 26; ++i) p.in[i] = (const float*)d_in[i];
    p.out = (float*)d_out; p.ws = (unsigned char*)d_ws;
    hipLaunchKernelGGL(mega_fwd, dim3(grid), dim3(NTHREADS), LDS_BYTES, stream, p);
}
```

```cpp
#include <hip/hip_runtime.h>
#include <cstdio>
#include <cstdint>

#define LAS __attribute__((address_space(3)))
#define GAS __attribute__((address_space(1)))
typedef unsigned short bf16_t;
typedef short bf16x8 __attribute__((ext_vector_type(8)));
typedef float f32x4 __attribute__((ext_vector_type(4)));
typedef float f32x2 __attribute__((ext_vector_type(2)));
typedef unsigned u32x4 __attribute__((ext_vector_type(4)));
typedef unsigned u32x2 __attribute__((ext_vector_type(2)));

constexpr int D = 1024, NBATCH = 2, SEQ = 16384, NLAT = NBATCH * SEQ, CTXL = 256, NCTX = NBATCH * CTXL, NTOK = NLAT + NCTX, DEPTH = 2;
constexpr int INW = 2336, INP = 2304;
constexpr int C_FOUR = 0, C_Q = 256, C_K = 512, C_V = 768, C_R = 1280, C_CA = 1792, C_CG = 2048;
constexpr int NE = 32, TOPK = 4, DFF = 1024;
constexpr int MAXROWS = NTOK * TOPK + NE * 256;
constexpr float NORM_EPS = 1e-6f;
constexpr int NTHREADS = 512, NWAVES = 8;

constexpr size_t MiB = 1u << 20;
constexpr size_t WS_CTL = 0, CTL_ZERO_BYTES = 1 * MiB;
constexpr size_t WS_MODP = 1 * MiB;
constexpr size_t WS_MODF = 3 * MiB;
constexpr size_t WS_RW = 3 * MiB + 512 * 1024;
constexpr size_t WS_WGT = 3 * MiB + 768 * 1024;
constexpr size_t WS_CM3 = 4 * MiB;
constexpr size_t WS_TF2 = 4 * MiB + 65536;
constexpr size_t WS_TCTX = 4 * MiB + 262144;
constexpr size_t WS_TLAT = 5 * MiB;
constexpr size_t WS_WIN = 13 * MiB;
constexpr size_t WS_WOUT = 23 * MiB;
constexpr size_t WS_WGU = 27 * MiB;
constexpr size_t WS_WDN = 283 * MiB;
constexpr size_t WS_XRES = 411 * MiB;
constexpr size_t WS_HBUF = 541 * MiB;
constexpr size_t WS_PBUF = 606 * MiB;
constexpr size_t WS_CAT = 769 * MiB;
constexpr size_t WS_CATC = 803 * MiB;
constexpr size_t WS_WOUT8 = 805 * MiB;
constexpr size_t WS_T2 = 834 * MiB;
constexpr size_t WS_STATE = 866 * MiB;
constexpr size_t WS_DECAY = 996 * MiB;
constexpr size_t WS_AEXP = 998 * MiB, WS_APOS = 999 * MiB, WS_APROB = 1000 * MiB, WS_ASLOT = 1001 * MiB;
constexpr size_t WS_XB8 = 1106 * MiB;
constexpr size_t WS_HB8 = 1066 * MiB;
constexpr bool F8_LAYER[2] = {true, true};
constexpr bool F8_GEMM1[2] = {false, true};
constexpr size_t WS_LRB = 1018 * MiB;
constexpr size_t WS_XB = 1002 * MiB, WS_ACT = 1278 * MiB, WS_YB = 1554 * MiB, WS_END = 1830 * MiB;
constexpr int CW_BAR = 4096, CW_CNT = 16384;

constexpr int RING_BYTES = 131072;
constexpr int AUX_OFF = RING_BYTES;
constexpr int LCTL_OFF = RING_BYTES + 8192;
constexpr int LC_BIAS = LCTL_OFF + 2048;
constexpr int LDS_BYTES = 147456;

__device__ __forceinline__ unsigned pk2(float lo, float hi) { typedef __bf16 bf2_t __attribute__((ext_vector_type(2))); typedef float fl2_t __attribute__((ext_vector_type(2))); const fl2_t v = {lo, hi}; return __builtin_bit_cast(unsigned, __builtin_convertvector(v, bf2_t)); }
__device__ __forceinline__ unsigned f2bf(float f) { return pk2(f, 0.f) & 0xffffu; }
__device__ __forceinline__ float bf2f(unsigned b) { return __builtin_bit_cast(float, b << 16); }
__device__ __forceinline__ float bflo(unsigned w) { return __builtin_bit_cast(float, w << 16); }
__device__ __forceinline__ float bfhi(unsigned w) { return __builtin_bit_cast(float, w & 0xffff0000u); }
__device__ __forceinline__ float wave_sum(float v) {
#pragma unroll
    for (int o = 1; o < 64; o <<= 1) v += __shfl_xor(v, o);
    return v;
}
__device__ __forceinline__ float wave_sum_dpp(float v) {
#define WS_ROR(n) v += __builtin_bit_cast(float, __builtin_amdgcn_update_dpp(0, __builtin_bit_cast(int, v), 0x120 + (n), 0xf, 0xf, false));
    WS_ROR(8) WS_ROR(4) WS_ROR(2) WS_ROR(1)
#undef WS_ROR
    const int vi = __builtin_bit_cast(int, v);
    const float r0 = __builtin_bit_cast(float, __builtin_amdgcn_readlane(vi, 0)), r1 = __builtin_bit_cast(float, __builtin_amdgcn_readlane(vi, 16)), r2 = __builtin_bit_cast(float, __builtin_amdgcn_readlane(vi, 32)), r3 = __builtin_bit_cast(float, __builtin_amdgcn_readlane(vi, 48));
    return (r0 + r1) + (r2 + r3);
}
__device__ __forceinline__ float sigmoidf_(float x) { return __builtin_amdgcn_rcpf(1.0f + __builtin_amdgcn_exp2f(-1.44269504089f * x)); }

#define LDS_BARRIER() do { asm volatile("s_waitcnt lgkmcnt(0)" ::: "memory"); __builtin_amdgcn_s_barrier(); asm volatile("" ::: "memory"); } while (0)

#define XB_TMO      128
#define XB_XCNT(j)  (256  + 64 * (j))
#define XB_XSUB(j)  (1280 + 64 * (j))
#define XB_XGEN(j)  (2304 + 64 * (j))
#define XB_TOP      3328
#define XB_TOPGEN   3392
#define XCD_BAR_WORDS 3456
#define XB_SPIN_CAP (1u << 22)

__device__ __forceinline__ unsigned xb_ld(unsigned* p)              { return __hip_atomic_load(p, __ATOMIC_RELAXED, __HIP_MEMORY_SCOPE_AGENT); }
__device__ __forceinline__ unsigned xb_add(unsigned* p, unsigned v) { return __hip_atomic_fetch_add(p, v, __ATOMIC_RELAXED, __HIP_MEMORY_SCOPE_AGENT); }
__device__ __forceinline__ unsigned xb_xcc_id() { return (unsigned)__builtin_amdgcn_s_getreg((3 << 11) | 20) & 0xFu; }
#define XB_SPIN(cond, bar) do { unsigned _sp = 0; while (cond) { __builtin_amdgcn_s_sleep(1); \
    if ((++_sp & 255u) == 0u) { if (xb_ld(&(bar)[XB_TMO])) break; if (_sp > XB_SPIN_CAP) { atomicAdd(&(bar)[XB_TMO], 1u); break; } } } } while (0)

struct XcdBarrier { unsigned* bar; unsigned x; volatile LAS unsigned* st; };

__device__ __forceinline__ XcdBarrier xcd_barrier_post(unsigned* bar, volatile LAS unsigned* st) {
    XcdBarrier b; b.bar = bar; b.x = xb_xcc_id(); b.st = st;
    if (threadIdx.x == 0) (void)xb_add(&bar[XB_XCNT(b.x)], 1u);
    return b;
}
__device__ __forceinline__ void xcd_barrier_complete(unsigned* bar, unsigned x, unsigned& nloc, unsigned& nx) {
    const unsigned G = gridDim.x * gridDim.y * gridDim.z;
    unsigned sum, cnt, mine, sp = 0u;
    for (;;) {
        sum = 0u; cnt = 0u; mine = 0u;
#pragma unroll
        for (unsigned j = 0; j < 16; ++j) { const unsigned c = xb_ld(&bar[XB_XCNT(j)]); sum += c; cnt += (c > 0u) ? 1u : 0u; mine = (j == x) ? c : mine; }
        if (sum == G) break;
        __builtin_amdgcn_s_sleep(1);
        if ((++sp & 255u) == 0u) { if (xb_ld(&bar[XB_TMO])) break; if (sp > XB_SPIN_CAP) { atomicAdd(&bar[XB_TMO], 1u); break; } }
    }
    nloc = mine > 0u ? mine : 1u; nx = cnt > 0u ? cnt : 1u;
}
__device__ __forceinline__ void xcd_barrier_t0(const XcdBarrier& b) {
    if (threadIdx.x == 0) {
        unsigned* bar = b.bar;
        __builtin_amdgcn_s_waitcnt(0);
        unsigned nloc = b.st[0], nx = b.st[1];
        if (nloc == 0u) { xcd_barrier_complete(bar, b.x, nloc, nx); b.st[0] = nloc; b.st[1] = nx; }
        const unsigned old = xb_add(&bar[XB_XSUB(b.x)], 1u);
        const unsigned gen = old / nloc;
        if (old + 1u == (gen + 1u) * nloc) {
            __builtin_amdgcn_fence(__ATOMIC_RELEASE, "agent");
            asm volatile("s_waitcnt vmcnt(0)" ::: "memory");
            const unsigned og = xb_add(&bar[XB_TOP], 1u);
            const unsigned tg = og / nx;
            if (og + 1u == (tg + 1u) * nx) xb_add(&bar[XB_TOPGEN], 1u);
            else XB_SPIN(xb_ld(&bar[XB_TOPGEN]) == tg, bar);
            __builtin_amdgcn_fence(__ATOMIC_ACQUIRE, "agent");
            xb_add(&bar[XB_XGEN(b.x)], 1u);
            asm volatile("s_waitcnt vmcnt(0)" ::: "memory");
        } else {
            XB_SPIN(xb_ld(&bar[XB_XGEN(b.x)]) == gen, bar);
            __builtin_amdgcn_fence(__ATOMIC_ACQUIRE, "agent");
            asm volatile("s_waitcnt vmcnt(0)" ::: "memory");
        }
    }
}
__device__ __forceinline__ void xcd_barrier(const XcdBarrier& b) {
    asm volatile("s_waitcnt vmcnt(0)" ::: "memory");
    __syncthreads();
    xcd_barrier_t0(b);
    __syncthreads();
}
#ifndef XB_ALLPOLL
#define XB_ALLPOLL 0
#endif
__device__ __forceinline__ void xcd_barrier2_t0(const XcdBarrier& b) {
    if (threadIdx.x == 0) {
        unsigned* bar = b.bar;
        __builtin_amdgcn_s_setprio(3);
        __builtin_amdgcn_s_waitcnt(0);
        unsigned nloc = b.st[0], nx = b.st[1];
        if (nloc == 0u) { xcd_barrier_complete(bar, b.x, nloc, nx); b.st[0] = nloc; b.st[1] = nx; }
        const unsigned old = xb_add(&bar[XB_XSUB(b.x)], 1u);
        const unsigned gen = old / nloc;
        const bool lastx = (old + 1u == (gen + 1u) * nloc);
        const unsigned want = nx * (gen + 1u);
        if (lastx) {
            __builtin_amdgcn_fence(__ATOMIC_RELEASE, "agent");
            asm volatile("s_waitcnt vmcnt(0)" ::: "memory");
            (void)xb_add(&bar[XB_TOP], 1u);
        }
        if (XB_ALLPOLL) {
            XB_SPIN(xb_ld(&bar[XB_TOP]) < want, bar);
            __builtin_amdgcn_fence(__ATOMIC_ACQUIRE, "agent");
            asm volatile("s_waitcnt vmcnt(0)" ::: "memory");
        } else if (lastx) {
            XB_SPIN(xb_ld(&bar[XB_TOP]) < want, bar);
            __builtin_amdgcn_fence(__ATOMIC_ACQUIRE, "agent");
            xb_add(&bar[XB_XGEN(b.x)], 1u);
            asm volatile("s_waitcnt vmcnt(0)" ::: "memory");
        } else {
            XB_SPIN(xb_ld(&bar[XB_XGEN(b.x)]) == gen, bar);
            __builtin_amdgcn_fence(__ATOMIC_ACQUIRE, "agent");
            asm volatile("s_waitcnt vmcnt(0)" ::: "memory");
        }
        __builtin_amdgcn_s_setprio(0);
    }
}

constexpr int PB_CHUNK = 64 * INP, PB_V = 49152, PB_CA = 114688;
__device__ __forceinline__ size_t pb_addr(int row, int col) {
    const size_t cb = (size_t)(row >> 6) * PB_CHUNK; const int tl = row & 63;
    if (col < C_V) { const int comp = col >> 8, cc = col & 255; return cb + comp * 16384 + ((cc >> 6) * 64 + tl) * 64 + (cc & 63); }
    if (col < C_CA) { const int cc = col - C_V, comp = cc >> 9, c2 = cc & 511; return cb + PB_V + comp * 32768 + ((c2 >> 7) * 64 + tl) * 128 + (c2 & 127); }
    const int cc = col - C_CA, comp = cc >> 8; return cb + PB_CA + comp * 16384 + tl * 256 + (cc & 255);
}
namespace pg8 {
constexpr int BM = 256, BK = 64, HALF = 128, HTB = HALF * BK * 2, STAGE_BYTES = 8 * HTB, NXCD = 8, WGM = 8;
__host__ __device__ __forceinline__ int lds_byte(int r, int c) { const int st = (r >> 4) * 2 + (c >> 5), rr = r & 15, cc = c & 31, ob = rr * 64 + cc * 2; return st * 1024 + (ob ^ (((ob >> 9) & 1) << 5)); }
__host__ __device__ __forceinline__ void stage_rc(int b, int& R, int& C) { const int st = b / 1024, sb = b % 1024, swz = sb ^ (((sb >> 9) & 1) << 5); R = (st >> 1) * 16 + swz / 64; C = (st & 1) * 32 + (swz % 64) / 2; }
__host__ __device__ __forceinline__ int perm16(int R) { return 64 * (R >> 5) + 16 * ((R >> 2) & 3) + 4 * ((R >> 4) & 1) + (R & 3); }
__host__ __device__ __forceinline__ int perm32(int rho) { const int n = rho >> 4, i = rho & 15; return 8 * (i >> 2) + 4 * n + (i & 3); }

struct Unit { int pm, pn, lbase, nvalid; };
struct Gemm { const bf16_t* A; const bf16_t* Bt; int M, N, K; };

struct StaticOrder {
    int nM, nN, nwg, G, c;
    __device__ void init(int M, int N, int G_, int c_) { nM = M / BM; nN = N / BM; nwg = nM * nN; G = G_; c = c_; }
    __device__ bool next(int i, Unit& u) const {
        const long L = (long)i * G + c; if (L >= nwg) return false;
        int wgid = (int)L; { const int q = nwg / NXCD, r = nwg % NXCD, xcd = wgid % NXCD, off = wgid / NXCD; wgid = (xcd < r ? xcd * (q + 1) : r * (q + 1) + (xcd - r) * q) + off; }
        const int nig = WGM * nN, gid = wgid / nig, fm = gid * WGM, gsz = (nM - fm) < WGM ? (nM - fm) : WGM;
        u.pm = fm + ((wgid % nig) % gsz); u.pn = (wgid % nig) / gsz; u.lbase = 0; u.nvalid = 0; return true;
    }
};
__device__ __forceinline__ void moe_desync(int MT, int nN, int G, int c) {
    const long total = (long)MT * nN; const int R = (int)((total + G - 1) / G);
    const long Llast = (G % 8 == 0) ? ((long)(R - 1) * G + (long)(c & 7) * (G >> 3) + (c >> 3)) : ((long)(R - 1) * G + c);
    if (Llast >= total) { __builtin_amdgcn_s_sleep(127); __builtin_amdgcn_s_sleep(127); }
}
struct MoeOrder {
    int nN, G, c, MT; const volatile LAS int* ts;
    __device__ bool next(int i, Unit& u) const {
        const long L = (G % 8 == 0) ? ((long)i * G + (long)(c & 7) * (G >> 3) + (c >> 3)) : ((long)i * G + c);
        if (L >= (long)MT * nN) return false;
        const int mt = (int)(L / nN), pl = (int)(L % nN);
        const int lane = threadIdx.x & 63;
        const unsigned long long bal = __ballot(lane >= 1 && lane < NE && ts[lane] <= mt);
        const int e = __popcll(bal);
        const int j = mt - ts[e];
        u.pm = mt; u.pn = e * nN + pl; u.lbase = e * NTOK + j * 256; u.nvalid = ts[64 + e] - j * 256; return true;
    }
};

__device__ __forceinline__ unsigned cvt_pk_bf16(float lo, float hi) { unsigned r; asm volatile("v_cvt_pk_bf16_f32 %0, %1, %2" : "=v"(r) : "v"(lo), "v"(hi)); return r; }

struct EpiStoreBf16 {
    static constexpr bool PERM = true; static constexpr int NST = 16; static constexpr bool PERM16 = false; static constexpr bool BIAS_DMA = false;
    bf16_t* O; int ldc;
    __device__ __forceinline__ void operator()(const f32x4 (&acc)[2][2][4][2], const Unit& u, int wr, int wc, int fr, int fq, const LAS float* bl) const {
        const int row0 = u.pm * BM + wr * 64 + fr; const int col0 = u.pn * BM + wc * 32 + 8 * fq;
#pragma unroll
        for (int ai = 0; ai < 2; ++ai)
#pragma unroll
            for (int m = 0; m < 4; ++m) {
#pragma unroll
                for (int bj = 0; bj < 2; ++bj) { const f32x4 v0 = acc[ai][bj][m][0], v1 = acc[ai][bj][m][1];
                    u32x4 w; w.x = cvt_pk_bf16(v0[0], v0[1]); w.y = cvt_pk_bf16(v0[2], v0[3]); w.z = cvt_pk_bf16(v1[0], v1[1]); w.w = cvt_pk_bf16(v1[2], v1[3]);
                    *(u32x4*)(O + pb_addr(row0 + ai * HALF + m * 16, col0 + bj * HALF)) = w; } }
    }
};
struct EpiStoreBf16S {
    static constexpr bool PERM = true; static constexpr int NST = 16; static constexpr bool PERM16 = false; static constexpr bool BIAS_DMA = false;
    bf16_t* O; int ldc;
    __device__ __forceinline__ void operator()(const f32x4 (&acc)[2][2][4][2], const Unit& u, int wr, int wc, int fr, int fq, const LAS float* bl) const {
        const int row0 = u.pm * BM + wr * 64 + fr; const int col0 = u.pn * BM + wc * 32 + 8 * fq;
#pragma unroll
        for (int ai = 0; ai < 2; ++ai)
#pragma unroll
            for (int m = 0; m < 4; ++m) {
#pragma unroll
                for (int bj = 0; bj < 2; ++bj) { const f32x4 v0 = acc[ai][bj][m][0] * 0.015625f, v1 = acc[ai][bj][m][1] * 0.015625f;
                    u32x4 w; w.x = cvt_pk_bf16(v0[0], v0[1]); w.y = cvt_pk_bf16(v0[2], v0[3]); w.z = cvt_pk_bf16(v1[0], v1[1]); w.w = cvt_pk_bf16(v1[2], v1[3]);
                    *(u32x4*)(O + pb_addr(row0 + ai * HALF + m * 16, col0 + bj * HALF)) = w; } }
    }
};
template <bool XS_F32>
struct EpiResid {
    static constexpr bool PERM = true; static constexpr int NST = 16; static constexpr bool PERM16 = false; static constexpr bool BIAS_DMA = false;
    bf16_t* X; const void* Xs; const float* modf; float sc;
    __device__ __forceinline__ void operator()(const f32x4 (&acc)[2][2][4][2], const Unit& u, int wr, int wc, int fr, int fq, const LAS float* bl) const {
        const int row0 = u.pm * BM + wr * 64 + fr, col0 = u.pn * BM + wc * 32 + 8 * fq;
        const int v = (u.pm >= NLAT / BM) ? 2 : (u.pm >= SEQ / BM ? 1 : 0);
        const float* gv = modf + (size_t)v * 6144 + 2 * 1024;
        f32x4 bv[2][2];
#pragma unroll
        for (int bj = 0; bj < 2; ++bj)
#pragma unroll
            for (int n = 0; n < 2; ++n) bv[bj][n] = *(const f32x4*)(gv + col0 + bj * HALF + 4 * n) * sc;
#pragma unroll
        for (int ai = 0; ai < 2; ++ai) {
            if constexpr (XS_F32) {
                f32x4 xv[4][2][2];
#pragma unroll
                for (int m = 0; m < 4; ++m) { const float* rowp = (const float*)Xs + (size_t)(row0 + ai * HALF + m * 16) * D + col0;
#pragma unroll
                    for (int bj = 0; bj < 2; ++bj)
#pragma unroll
                        for (int n = 0; n < 2; ++n) xv[m][bj][n] = *(const f32x4*)(rowp + bj * HALF + 4 * n); }
#pragma unroll
                for (int m = 0; m < 4; ++m) { bf16_t* rowp = X + (size_t)(row0 + ai * HALF + m * 16) * D + col0;
#pragma unroll
                    for (int bj = 0; bj < 2; ++bj) { const f32x4 v0 = xv[m][bj][0] + bv[bj][0] * acc[ai][bj][m][0], v1 = xv[m][bj][1] + bv[bj][1] * acc[ai][bj][m][1];
                        u32x4 w; w.x = cvt_pk_bf16(v0[0], v0[1]); w.y = cvt_pk_bf16(v0[2], v0[3]); w.z = cvt_pk_bf16(v1[0], v1[1]); w.w = cvt_pk_bf16(v1[2], v1[3]);
                        *(u32x4*)(rowp + bj * HALF) = w; } }
            } else {
                u32x4 xv[4][2];
#pragma unroll
                for (int m = 0; m < 4; ++m) { const bf16_t* rowp = (const bf16_t*)Xs + (size_t)(row0 + ai * HALF + m * 16) * D + col0;
#pragma unroll
                    for (int bj = 0; bj < 2; ++bj) xv[m][bj] = *(const u32x4*)(rowp + bj * HALF); }
#pragma unroll
                for (int m = 0; m < 4; ++m) { bf16_t* rowp = X + (size_t)(row0 + ai * HALF + m * 16) * D + col0;
#pragma unroll
                    for (int bj = 0; bj < 2; ++bj) { const u32x4 xw = xv[m][bj];
                        const f32x4 x0 = {bflo(xw.x), bfhi(xw.x), bflo(xw.y), bfhi(xw.y)}, x1 = {bflo(xw.z), bfhi(xw.z), bflo(xw.w), bfhi(xw.w)};
                        const f32x4 v0 = x0 + bv[bj][0] * acc[ai][bj][m][0], v1 = x1 + bv[bj][1] * acc[ai][bj][m][1];
                        u32x4 w; w.x = cvt_pk_bf16(v0[0], v0[1]); w.y = cvt_pk_bf16(v0[2], v0[3]); w.z = cvt_pk_bf16(v1[0], v1[1]); w.w = cvt_pk_bf16(v1[2], v1[3]);
                        *(u32x4*)(rowp + bj * HALF) = w; } }
            }
        }
    }
};
struct EpiGateUp {
    static constexpr bool PERM = true; static constexpr int NST = 0; static constexpr bool PERM16 = false; static constexpr bool BIAS_DMA = false;
    bf16_t* O; const float* bgu;
    __device__ __forceinline__ void operator()(const f32x4 (&acc)[2][2][4][2], const Unit& u, int wr, int wc, int fr, int fq, const LAS float* bl) const {
        const int e = u.pn >> 3, pl = u.pn & 7;
        const int row0 = u.pm * BM + wr * 64 + fr; const int cl = pl * 128 + wc * 32 + 8 * fq;
        const float* bg = bgu + (size_t)e * 2048 + cl; const float* bu = bg + 1024;
        f32x4 g0 = *(const f32x4*)bg, g1 = *(const f32x4*)(bg + 4), u0 = *(const f32x4*)bu, u1 = *(const f32x4*)(bu + 4);
#pragma unroll
        for (int ai = 0; ai < 2; ++ai)
#pragma unroll
            for (int m = 0; m < 4; ++m) { bf16_t* rowp = O + (size_t)(row0 + ai * HALF + m * 16) * DFF + cl;
                float r[8];
#pragma unroll
                for (int n = 0; n < 2; ++n) { const f32x4 gb = n ? g1 : g0, ub = n ? u1 : u0; const f32x4 ga = acc[ai][0][m][n] + gb, ua = acc[ai][1][m][n] + ub;
#pragma unroll
                    for (int j = 0; j < 4; ++j) { const float gate = fminf(ga[j], 7.0f), up = fminf(fmaxf(ua[j], -7.0f), 7.0f);
                        r[n * 4 + j] = gate * __builtin_amdgcn_rcpf(1.0f + __expf(-1.702f * gate)) * (up + 1.0f); } }
                u32x4 w; w.x = cvt_pk_bf16(r[0], r[1]); w.y = cvt_pk_bf16(r[2], r[3]); w.z = cvt_pk_bf16(r[4], r[5]); w.w = cvt_pk_bf16(r[6], r[7]);
                *(u32x4*)rowp = w; }
    }
};
struct EpiDown {
    static constexpr bool PERM = true; static constexpr int NST = 0; static constexpr bool PERM16 = false; static constexpr bool BIAS_DMA = false;
    bf16_t* O; const float* bdn;
    __device__ __forceinline__ void operator()(const f32x4 (&acc)[2][2][4][2], const Unit& u, int wr, int wc, int fr, int fq, const LAS float* bl) const {
        const int e = u.pn >> 2, pl = u.pn & 3;
        const int row0 = u.pm * BM + wr * 64 + fr; const int col0 = pl * BM + wc * 32 + 8 * fq;
        f32x4 bv[2][2];
#pragma unroll
        for (int bj = 0; bj < 2; ++bj)
#pragma unroll
            for (int n = 0; n < 2; ++n) bv[bj][n] = *(const f32x4*)(bdn + (size_t)e * 1024 + col0 + bj * HALF + 4 * n);
#pragma unroll
        for (int ai = 0; ai < 2; ++ai)
#pragma unroll
            for (int m = 0; m < 4; ++m) { bf16_t* rowp = O + (size_t)(row0 + ai * HALF + m * 16) * D + col0;
#pragma unroll
                for (int bj = 0; bj < 2; ++bj) { const f32x4 v0 = acc[ai][bj][m][0] + bv[bj][0], v1 = acc[ai][bj][m][1] + bv[bj][1];
                    u32x4 w; w.x = cvt_pk_bf16(v0[0], v0[1]); w.y = cvt_pk_bf16(v0[2], v0[3]); w.z = cvt_pk_bf16(v1[0], v1[1]); w.w = cvt_pk_bf16(v1[2], v1[3]);
                    *(u32x4*)(rowp + bj * HALF) = w; } }
    }
};

__device__ __forceinline__ unsigned pk4_fp8(float a, float b, float c, float d) { unsigned w = 0u; w = __builtin_amdgcn_cvt_pk_fp8_f32(a, b, w, false); w = __builtin_amdgcn_cvt_pk_fp8_f32(c, d, w, true); return w; }
struct EpiGateUp8 {
    static constexpr bool PERM = true; static constexpr int NST = 8; static constexpr bool PERM16 = false; static constexpr bool BIAS_DMA = true;
    unsigned char* O; const float* bgu;
    __device__ __forceinline__ const float* bias_src(const Unit& u, int lane) const { const int e = u.pn >> 3, pl = u.pn & 7; return bgu + (size_t)e * 2048 + (lane >> 5) * 1024 + pl * 128 + (lane & 31) * 4; }
    __device__ __forceinline__ void operator()(const f32x4 (&acc)[2][2][4][2], const Unit& u, int wr, int wc, int fr, int fq, const LAS float* bl) const {
        const int e = u.pn >> 3, pl = u.pn & 7;
        const int row0 = u.pm * BM + wr * 64 + fr; const int cl = pl * 128 + wc * 32 + 8 * fq;
        (void)e; const LAS float* bgl = bl + wc * 32 + 8 * fq;
        f32x4 g0 = *(const LAS f32x4*)bgl, g1 = *(const LAS f32x4*)(bgl + 4), u0 = *(const LAS f32x4*)(bgl + 128), u1 = *(const LAS f32x4*)(bgl + 132);
#pragma unroll
        for (int ai = 0; ai < 2; ++ai)
#pragma unroll
            for (int m = 0; m < 4; ++m) { unsigned char* rowp = O + (size_t)(row0 + ai * HALF + m * 16) * DFF + cl;
                float r[8];
#pragma unroll
                for (int n = 0; n < 2; ++n) { const f32x4 gb = n ? g1 : g0, ub = n ? u1 : u0;
                    const f32x4 ga = acc[ai][0][m][n] * 0.015625f + gb, ua = acc[ai][1][m][n] * 0.015625f + ub;
                    const f32x4 gate = __builtin_elementwise_min(ga, (f32x4){7.f, 7.f, 7.f, 7.f});
                    const f32x4 up1 = __builtin_elementwise_min(__builtin_elementwise_max(ua, (f32x4){-7.f, -7.f, -7.f, -7.f}), (f32x4){7.f, 7.f, 7.f, 7.f}) + 1.0f;
                    const f32x4 xa = gate * (-1.702f * 1.44269504089f);
                    f32x4 den; den.x = __builtin_amdgcn_exp2f(xa.x); den.y = __builtin_amdgcn_exp2f(xa.y); den.z = __builtin_amdgcn_exp2f(xa.z); den.w = __builtin_amdgcn_exp2f(xa.w);
                    den = den + 1.0f;
                    f32x4 rc; rc.x = __builtin_amdgcn_rcpf(den.x); rc.y = __builtin_amdgcn_rcpf(den.y); rc.z = __builtin_amdgcn_rcpf(den.z); rc.w = __builtin_amdgcn_rcpf(den.w);
                    const f32x4 o = (gate * rc) * up1;
                    r[n * 4 + 0] = o.x; r[n * 4 + 1] = o.y; r[n * 4 + 2] = o.z; r[n * 4 + 3] = o.w; }
                u32x2 w; w.x = pk4_fp8(r[0], r[1], r[2], r[3]); w.y = pk4_fp8(r[4], r[5], r[6], r[7]);
                *(u32x2*)rowp = w; }
    }
};
struct EpiDown8 {
    static constexpr bool PERM = true; static constexpr int NST = 8; static constexpr bool PERM16 = true; static constexpr bool BIAS_DMA = true;
    unsigned char* O; const float* bdn;
    __device__ __forceinline__ const float* bias_src(const Unit& u, int lane) const { const int e = u.pn >> 2, pl = u.pn & 3; return bdn + (size_t)e * 1024 + pl * 256 + lane * 4; }
    __device__ __forceinline__ void operator()(const f32x4 (&acc)[2][2][4][2], const Unit& u, int wr, int wc, int fr, int fq, const LAS float* bl) const {
        const int pl = u.pn & 3;
        const int row0 = u.pm * BM + wr * 64 + fr; const int col0 = pl * BM + wc * 64 + 16 * fq;
        f32x4 bv[2][2];
#pragma unroll
        for (int bj = 0; bj < 2; ++bj)
#pragma unroll
            for (int n = 0; n < 2; ++n) bv[bj][n] = *(const LAS f32x4*)(bl + wc * 64 + 16 * fq + 8 * bj + 4 * n);
#pragma unroll
        for (int ai = 0; ai < 2; ++ai)
#pragma unroll
            for (int m = 0; m < 4; ++m) { unsigned char* rowp = O + (size_t)(row0 + ai * HALF + m * 16) * D + col0;
                u32x4 w;
                { const f32x4 v0 = acc[ai][0][m][0] * 0.015625f + bv[0][0], v1 = acc[ai][0][m][1] * 0.015625f + bv[0][1]; w.x = pk4_fp8(v0[0], v0[1], v0[2], v0[3]); w.y = pk4_fp8(v1[0], v1[1], v1[2], v1[3]); }
                { const f32x4 v0 = acc[ai][1][m][0] * 0.015625f + bv[1][0], v1 = acc[ai][1][m][1] * 0.015625f + bv[1][1]; w.z = pk4_fp8(v0[0], v0[1], v0[2], v0[3]); w.w = pk4_fp8(v1[0], v1[1], v1[2], v1[3]); }
                *(u32x4*)rowp = w; }
    }
};

typedef int i32x8 __attribute__((ext_vector_type(8)));
typedef int i32x4 __attribute__((ext_vector_type(4)));
__device__ __forceinline__ i32x8 cat8(const bf16x8 lo, const bf16x8 hi) { const i32x4 a = __builtin_bit_cast(i32x4, lo), b = __builtin_bit_cast(i32x4, hi); return __builtin_shufflevector(a, b, 0, 1, 2, 3, 4, 5, 6, 7); }
template <class Epi, class Sched, bool ALIGN_EPI = true, bool SP2 = true, bool F8 = false>
__device__ __forceinline__ void gemm_phase(LAS unsigned char* lds, const Gemm g, const Sched& S, const Epi& E, const int tid) {
    const int wid = __builtin_amdgcn_readfirstlane(tid >> 6), lane = tid & 63, wr = wid >> 2, wc = wid & 3, fr = lane & 15, fq = lane >> 4;
    const int K = g.K, nt = K / BK;
    unsigned voffA[2], voffB[2];
#pragma unroll
    for (int i = 0; i < 2; ++i) { int R, C; stage_rc(tid * 16 + i * 8192, R, C); const int Rb = Epi::PERM16 ? perm16(R) : (Epi::PERM ? ((R & ~31) + perm32(R & 31)) : R);
        voffA[i] = (unsigned)(R * K + C) * 2u; voffB[i] = (unsigned)(Rb * K + C) * 2u; }
    const size_t kstep = (size_t)(BK * 2);
    const size_t hstep = (size_t)HALF * K * 2;
    const size_t tstep = 2 * hstep;
    const size_t hstepB = Epi::PERM16 ? (size_t)8 * K * 2 : hstep;
    const unsigned ldsw = (unsigned)wid * 1024u;
    const int aoff = lds_byte(wr * 64 + fr, fq * 8), boff = lds_byte(wc * 32 + fr, fq * 8);
#define PG8_SA(b, h) (((b) * 2 + (h)) * HTB)
#define PG8_SB(b, h) ((4 + (b) * 2 + (h)) * HTB)
#define PG8_STAGE(bufoff, gbase, voff) do { _Pragma("unroll") for (int _i = 0; _i < 2; ++_i) \
        __builtin_amdgcn_global_load_lds((const unsigned*)((const char*)(gbase) + (voff)[_i]), (LAS unsigned*)(lds + (bufoff) + ldsw + _i * 8192), 16, 0, 0); } while (0)
#define PG8_LDA(dst, b, h) do { _Pragma("unroll") for (int m = 0; m < 4; ++m) { if constexpr (F8) dst##8[m] = cat8(*(const LAS bf16x8*)(lds + PG8_SA(b, h) + aoff + m * 2048), *(const LAS bf16x8*)(lds + PG8_SA(b, h) + aoff + m * 2048 + 1024)); \
        else { _Pragma("unroll") for (int k = 0; k < 2; ++k) dst[m][k] = *(const LAS bf16x8*)(lds + PG8_SA(b, h) + aoff + m * 2048 + k * 1024); } } } while (0)
#define PG8_LDB(dst, b, h) do { _Pragma("unroll") for (int n = 0; n < 2; ++n) { if constexpr (F8) dst##8[n] = cat8(*(const LAS bf16x8*)(lds + PG8_SB(b, h) + boff + n * 2048), *(const LAS bf16x8*)(lds + PG8_SB(b, h) + boff + n * 2048 + 1024)); \
        else { _Pragma("unroll") for (int k = 0; k < 2; ++k) dst[n][k] = *(const LAS bf16x8*)(lds + PG8_SB(b, h) + boff + n * 2048 + k * 1024); } } } while (0)
#define PG8_MMA(ai, bj, At, Bt) do { __builtin_amdgcn_s_setprio(1); \
        if constexpr (F8) { _Pragma("unroll") for (int m = 0; m < 4; ++m) _Pragma("unroll") for (int n = 0; n < 2; ++n) \
            acc[ai][bj][m][n] = __builtin_amdgcn_mfma_scale_f32_16x16x128_f8f6f4(Bt##8[n], At##8[m], acc[ai][bj][m][n], 0, 0, 0, 0x7f7f7f7f, 0, 0x7f7f7f7f); \
            _Pragma("unroll") for (int m = 0; m < 4; ++m) _Pragma("unroll") for (int n = 0; n < 2; ++n) asm volatile("" : "+v"(acc[ai][bj][m][n])); } \
        else { _Pragma("unroll") for (int m = 0; m < 4; ++m) _Pragma("unroll") for (int n = 0; n < 2; ++n) _Pragma("unroll") for (int k = 0; k < 2; ++k) \
            acc[ai][bj][m][n] = __builtin_amdgcn_mfma_f32_16x16x32_bf16(Bt[n][k], At[m][k], acc[ai][bj][m][n], 0, 0, 0); } \
        __builtin_amdgcn_s_setprio(0); } while (0)
#define PG8_WAIT_V(n) asm volatile("s_waitcnt vmcnt(" #n ")" ::: "memory")
#define PG8_WAIT_VR(rlx) do { if constexpr (Epi::NST == 16) asm volatile("s_cmp_lg_u32 %0, 0\n\ts_cbranch_scc1 .Lrlx%=\n\ts_waitcnt vmcnt(8)\n.Lrlx%=:\n\ts_waitcnt vmcnt(24)" :: "s"(rlx) : "scc", "memory"); \
        else if constexpr (Epi::NST == 8) asm volatile("s_cmp_lg_u32 %0, 0\n\ts_cbranch_scc1 .Lrlx%=\n\ts_waitcnt vmcnt(8)\n.Lrlx%=:\n\ts_waitcnt vmcnt(16)" :: "s"(rlx) : "scc", "memory"); else PG8_WAIT_V(8); } while (0)
#define PG8_WAIT_L(n) asm volatile("s_waitcnt lgkmcnt(" #n ")" ::: "memory")
#define PG8_BAR __builtin_amdgcn_s_barrier()
#define PG8_SCHED __builtin_amdgcn_sched_barrier(0)
    Unit cur, nxt; int ui = 0;
    if (!S.next(0, cur)) return;
    f32x4 acc[2][2][4][2];
#pragma unroll
    for (int a = 0; a < 2; ++a)
#pragma unroll
        for (int b = 0; b < 2; ++b)
#pragma unroll
            for (int m = 0; m < 4; ++m)
#pragma unroll
                for (int n = 0; n < 2; ++n) acc[a][b][m][n] = (f32x4){0.f, 0.f, 0.f, 0.f};
    bf16x8 At[4][2], B0[2][2], B1[2][2]; i32x8 At8[4], B08[2], B18[2];
    const char* cA = (const char*)g.A + (size_t)cur.pm * tstep; const char* cB = (const char*)g.Bt + (size_t)cur.pn * tstep;
    if constexpr (SP2) {
        PG8_STAGE(PG8_SB(0, 0), cB, voffB); PG8_STAGE(PG8_SB(0, 1), cB + hstepB, voffB); PG8_STAGE(PG8_SA(0, 0), cA, voffA); PG8_STAGE(PG8_SA(0, 1), cA + hstep, voffA);
        if (wr == 1) PG8_BAR;
        PG8_WAIT_V(2); PG8_BAR;
        PG8_STAGE(PG8_SB(1, 0), cB + kstep, voffB); PG8_STAGE(PG8_SA(1, 0), cA + kstep, voffA); PG8_STAGE(PG8_SB(1, 1), cB + hstepB + kstep, voffB); PG8_STAGE(PG8_SA(1, 1), cA + hstep + kstep, voffA);
        PG8_WAIT_V(8); PG8_BAR;
    } else {
        PG8_STAGE(PG8_SB(0, 0), cB, voffB); PG8_STAGE(PG8_SA(0, 0), cA, voffA); PG8_STAGE(PG8_SB(0, 1), cB + hstepB, voffB); PG8_STAGE(PG8_SA(0, 1), cA + hstep, voffA);
        if (wr == 1) PG8_BAR;
        PG8_WAIT_V(4); PG8_BAR;
        PG8_STAGE(PG8_SB(1, 0), cB + kstep, voffB); PG8_STAGE(PG8_SA(1, 0), cA + kstep, voffA); PG8_STAGE(PG8_SB(1, 1), cB + hstepB + kstep, voffB);
        PG8_WAIT_V(6); PG8_BAR;
    }
    for (;;) {
        const bool has_next = S.next(ui + 1, nxt);
        if constexpr (Epi::BIAS_DMA) { if (wid == 0) __builtin_amdgcn_global_load_lds((const unsigned*)E.bias_src(cur, lane), (LAS unsigned*)(lds + LC_BIAS + (ui & 1) * 1024), 16, 0, 0); }
        const char* nA = has_next ? (const char*)g.A + (size_t)nxt.pm * tstep : cA; const char* nB = has_next ? (const char*)g.Bt + (size_t)nxt.pn * tstep : cB;
        for (int t = 0; t < nt; t += 2) {
            const bool last = (t == nt - 2);
            const int rlx = __builtin_amdgcn_readfirstlane(((t == 0) && (ui > 0)) ? 1 : 0);
            const char* a1 = cA + (size_t)(t + 1) * kstep;
            const char* a2 = last ? nA : cA + (size_t)(t + 2) * kstep; const char* b2 = last ? nB : cB + (size_t)(t + 2) * kstep;
            const char* a3 = a2 + kstep; const char* b3 = b2 + kstep;
            if constexpr (SP2) {
            PG8_LDB(B0, 0, 0); PG8_LDB(B1, 0, 1); PG8_SCHED; PG8_LDA(At, 0, 0);
            PG8_WAIT_VR(rlx); PG8_WAIT_L(0); PG8_BAR; PG8_MMA(0, 0, At, B0); PG8_MMA(0, 1, At, B1); PG8_BAR; PG8_SCHED;
            PG8_LDA(At, 0, 1); PG8_STAGE(PG8_SB(0, 0), b2, voffB); PG8_STAGE(PG8_SB(0, 1), b2 + hstepB, voffB); PG8_STAGE(PG8_SA(0, 0), a2, voffA);
            PG8_WAIT_VR(rlx); PG8_WAIT_L(0); PG8_BAR; PG8_MMA(1, 0, At, B0); PG8_MMA(1, 1, At, B1); PG8_BAR; PG8_SCHED;
            PG8_LDB(B0, 1, 0); PG8_LDB(B1, 1, 1); PG8_SCHED; PG8_LDA(At, 1, 0); PG8_STAGE(PG8_SA(0, 1), a2 + hstep, voffA);
            PG8_WAIT_VR(rlx); PG8_WAIT_L(0); PG8_BAR; PG8_MMA(0, 0, At, B0); PG8_MMA(0, 1, At, B1); PG8_BAR; PG8_SCHED;
            PG8_LDA(At, 1, 1); PG8_STAGE(PG8_SB(1, 0), b3, voffB); PG8_STAGE(PG8_SB(1, 1), b3 + hstepB, voffB); PG8_STAGE(PG8_SA(1, 0), a3, voffA);
            PG8_WAIT_V(8); PG8_WAIT_L(0); PG8_BAR; PG8_MMA(1, 0, At, B0); PG8_MMA(1, 1, At, B1); PG8_BAR; PG8_SCHED;
            PG8_STAGE(PG8_SA(1, 1), a3 + hstep, voffA);
            } else {
            PG8_LDB(B0, 0, 0); PG8_SCHED; PG8_LDA(At, 0, 0); PG8_STAGE(PG8_SA(1, 1), a1 + hstep, voffA);
            PG8_WAIT_L(8); PG8_BAR; PG8_WAIT_L(0); PG8_MMA(0, 0, At, B0); PG8_BAR; PG8_SCHED;
            PG8_LDB(B1, 0, 1); PG8_STAGE(PG8_SB(0, 0), b2, voffB);
            PG8_BAR; PG8_WAIT_L(0); PG8_MMA(0, 1, At, B1); PG8_BAR;
            PG8_LDA(At, 0, 1); PG8_STAGE(PG8_SA(0, 0), a2, voffA);
            PG8_BAR; PG8_WAIT_L(0); PG8_MMA(1, 0, At, B0); PG8_BAR; PG8_SCHED;
            PG8_STAGE(PG8_SB(0, 1), b2 + hstepB, voffB);
            PG8_WAIT_V(6); PG8_BAR; PG8_MMA(1, 1, At, B1); PG8_BAR;
            PG8_LDB(B0, 1, 0); PG8_SCHED; PG8_LDA(At, 1, 0); PG8_STAGE(PG8_SA(0, 1), a2 + hstep, voffA);
            PG8_WAIT_L(8); PG8_BAR; PG8_WAIT_L(0); PG8_MMA(0, 0, At, B0); PG8_BAR; PG8_SCHED;
            PG8_LDB(B1, 1, 1); PG8_STAGE(PG8_SB(1, 0), b3, voffB);
            PG8_BAR; PG8_WAIT_L(0); PG8_MMA(0, 1, At, B1); PG8_BAR;
            PG8_LDA(At, 1, 1); PG8_STAGE(PG8_SA(1, 0), a3, voffA);
            PG8_BAR; PG8_WAIT_L(0); PG8_MMA(1, 0, At, B0); PG8_BAR; PG8_SCHED;
            PG8_STAGE(PG8_SB(1, 1), b3 + hstepB, voffB);
            PG8_WAIT_V(6); PG8_BAR; PG8_MMA(1, 1, At, B1); PG8_BAR;
            }
        }
        if constexpr (ALIGN_EPI) { if (wr == 0) PG8_BAR; }
        E(acc, cur, wr, wc, fr, fq, (const LAS float*)(lds + LC_BIAS + (ui & 1) * 1024));
        if (!has_next) break;
#pragma unroll
        for (int a = 0; a < 2; ++a)
#pragma unroll
            for (int b = 0; b < 2; ++b)
#pragma unroll
                for (int m = 0; m < 4; ++m)
#pragma unroll
                    for (int n = 0; n < 2; ++n) acc[a][b][m][n] = (f32x4){0.f, 0.f, 0.f, 0.f};
        cur = nxt; cA = nA; cB = nB; ++ui;
        if constexpr (ALIGN_EPI) { if (wr == 1) PG8_BAR; }
    }
    PG8_WAIT_V(0);
    if constexpr (!ALIGN_EPI) { if (wr == 0) PG8_BAR; }
    PG8_BAR;
#undef PG8_SA
#undef PG8_SB
#undef PG8_STAGE
#undef PG8_LDA
#undef PG8_LDB
#undef PG8_MMA
#undef PG8_WAIT_V
#undef PG8_WAIT_VR
#undef PG8_WAIT_L
#undef PG8_BAR
#undef PG8_SCHED
}

template <class Epi, class Sched, bool F8 = false>
__device__ __forceinline__ void gemm_phase_gather(LAS unsigned char* lds, const Gemm g, const int* list, const Sched& S, const Epi& E, const int tid) {
    const int wid = __builtin_amdgcn_readfirstlane(tid >> 6), lane = tid & 63, wr = wid >> 2, wc = wid & 3, fr = lane & 15, fq = lane >> 4;
    const int K = g.K, nt = K / BK;
    unsigned voffB0, cA2;
    { int R, C; stage_rc(tid * 16, R, C); const int Rb = Epi::PERM ? ((R & ~31) + perm32(R & 31)) : R; cA2 = (unsigned)C * 2u; voffB0 = (unsigned)(Rb * K + C) * 2u; }
    const unsigned voffB[2] = {voffB0, voffB0 + (unsigned)(64 * K * 2)};
    const size_t kstep = (size_t)(BK * 2);
    const size_t hstep = (size_t)HALF * K * 2;
    const size_t tstep = 2 * hstep;
    const unsigned ldsw = (unsigned)wid * 1024u;
    const int aoff = lds_byte(wr * 64 + fr, fq * 8), boff = lds_byte(wc * 32 + fr, fq * 8);
#define PG8_SA(b, h) (((b) * 2 + (h)) * HTB)
#define PG8_SB(b, h) ((4 + (b) * 2 + (h)) * HTB)
#define PG8_STAGE(bufoff, gbase, voff) do { _Pragma("unroll") for (int _i = 0; _i < 2; ++_i) \
        __builtin_amdgcn_global_load_lds((const unsigned*)((const char*)(gbase) + (voff)[_i]), (LAS unsigned*)(lds + (bufoff) + ldsw + _i * 8192), 16, 0, 0); } while (0)
#define PG8_LDA(dst, b, h) do { _Pragma("unroll") for (int m = 0; m < 4; ++m) { if constexpr (F8) dst##8[m] = cat8(*(const LAS bf16x8*)(lds + PG8_SA(b, h) + aoff + m * 2048), *(const LAS bf16x8*)(lds + PG8_SA(b, h) + aoff + m * 2048 + 1024)); \
        else { _Pragma("unroll") for (int k = 0; k < 2; ++k) dst[m][k] = *(const LAS bf16x8*)(lds + PG8_SA(b, h) + aoff + m * 2048 + k * 1024); } } } while (0)
#define PG8_LDB(dst, b, h) do { _Pragma("unroll") for (int n = 0; n < 2; ++n) { if constexpr (F8) dst##8[n] = cat8(*(const LAS bf16x8*)(lds + PG8_SB(b, h) + boff + n * 2048), *(const LAS bf16x8*)(lds + PG8_SB(b, h) + boff + n * 2048 + 1024)); \
        else { _Pragma("unroll") for (int k = 0; k < 2; ++k) dst[n][k] = *(const LAS bf16x8*)(lds + PG8_SB(b, h) + boff + n * 2048 + k * 1024); } } } while (0)
#define PG8_MMA(ai, bj, At, Bt) do { __builtin_amdgcn_s_setprio(1); \
        if constexpr (F8) { _Pragma("unroll") for (int m = 0; m < 4; ++m) _Pragma("unroll") for (int n = 0; n < 2; ++n) \
            acc[ai][bj][m][n] = __builtin_amdgcn_mfma_scale_f32_16x16x128_f8f6f4(Bt##8[n], At##8[m], acc[ai][bj][m][n], 0, 0, 0, 0x7f7f7f7f, 0, 0x7f7f7f7f); \
            asm volatile("" : "+v"(acc[ai][bj][0][0]), "+v"(acc[ai][bj][0][1]), "+v"(acc[ai][bj][1][0]), "+v"(acc[ai][bj][1][1]), "+v"(acc[ai][bj][2][0]), "+v"(acc[ai][bj][2][1]), "+v"(acc[ai][bj][3][0]), "+v"(acc[ai][bj][3][1])); } \
        else { _Pragma("unroll") for (int m = 0; m < 4; ++m) _Pragma("unroll") for (int n = 0; n < 2; ++n) _Pragma("unroll") for (int k = 0; k < 2; ++k) \
            acc[ai][bj][m][n] = __builtin_amdgcn_mfma_f32_16x16x32_bf16(Bt[n][k], At[m][k], acc[ai][bj][m][n], 0, 0, 0); } \
        __builtin_amdgcn_s_setprio(0); } while (0)
#define PG8_WAIT_V(n) asm volatile("s_waitcnt vmcnt(" #n ")" ::: "memory")
#define PG8_WAIT_VR(rlx) do { if constexpr (Epi::NST == 16) asm volatile("v_cmp_ne_u32_e32 vcc, 0, %0\n\ts_cbranch_vccnz .Lrlx%=\n\ts_waitcnt vmcnt(8)\n.Lrlx%=:\n\ts_waitcnt vmcnt(24)" :: "v"(rlx) : "vcc", "memory"); \
        else if constexpr (Epi::NST == 8) asm volatile("v_cmp_ne_u32_e32 vcc, 0, %0\n\ts_cbranch_vccnz .Lrlx%=\n\ts_waitcnt vmcnt(8)\n.Lrlx%=:\n\ts_waitcnt vmcnt(16)" :: "v"(rlx) : "vcc", "memory"); else PG8_WAIT_V(8); } while (0)
#define PG8_WAIT_L(n) asm volatile("s_waitcnt lgkmcnt(" #n ")" ::: "memory")
#define PG8_BAR __builtin_amdgcn_s_barrier()
#define PG8_SCHED __builtin_amdgcn_sched_barrier(0)
#define PG8_TOKIDX(u, r) ((u).lbase + ((r) < (u).nvalid - 1 ? (r) : (u).nvalid - 1))
#define PG8_LOADTOK(u, vo) do { int _ra0, _ra1, _c; stage_rc(tid * 16, _ra0, _c); stage_rc(tid * 16 + 8192, _ra1, _c); _Pragma("unroll") for (int _h = 0; _h < 2; ++_h) { \
        const unsigned _t0 = (unsigned)list[PG8_TOKIDX(u, _h * HALF + _ra0)], _t1 = (unsigned)list[PG8_TOKIDX(u, _h * HALF + _ra1)]; (vo)[_h] = _t0 | (_t1 << 16); } } while (0)
#define PG8_TOKSLOT(k) (lds + AUX_OFF + (unsigned)wid * 1024u + (k) * 256)
#define PG8_LOADTOK_DMA(u) do { int _ra0, _ra1, _c; stage_rc(tid * 16, _ra0, _c); stage_rc(tid * 16 + 8192, _ra1, _c); _Pragma("unroll") for (int _h = 0; _h < 2; ++_h) { \
        __builtin_amdgcn_global_load_lds((const unsigned*)(list + PG8_TOKIDX(u, _h * HALF + _ra0)), (LAS unsigned*)PG8_TOKSLOT(2 * _h), 4, 0, 0); \
        __builtin_amdgcn_global_load_lds((const unsigned*)(list + PG8_TOKIDX(u, _h * HALF + _ra1)), (LAS unsigned*)PG8_TOKSLOT(2 * _h + 1), 4, 0, 0); } } while (0)
#define PG8_READTOK(vo) do { _Pragma("unroll") for (int _h = 0; _h < 2; ++_h) { const unsigned _t0 = *(const LAS unsigned*)(PG8_TOKSLOT(2 * _h) + lane * 4), _t1 = *(const LAS unsigned*)(PG8_TOKSLOT(2 * _h + 1) + lane * 4); (vo)[_h] = _t0 | (_t1 << 16); } } while (0)
#define PG8_STAGE_A(bufoff, gbase, pk) do { _Pragma("unroll") for (int _i = 0; _i < 2; ++_i) { const unsigned _off = (((pk) >> (16 * _i)) & 0xffffu) * (unsigned)(K * 2) + cA2; \
        __builtin_amdgcn_global_load_lds((const unsigned*)((const char*)(gbase) + _off), (LAS unsigned*)(lds + (bufoff) + ldsw + _i * 8192), 16, 0, 0); } } while (0)
    Unit cur, nxt; int ui = 0;
    if (!S.next(0, cur)) return;
    f32x4 acc[2][2][4][2];
#pragma unroll
    for (int a = 0; a < 2; ++a)
#pragma unroll
        for (int b = 0; b < 2; ++b)
#pragma unroll
            for (int m = 0; m < 4; ++m)
#pragma unroll
                for (int n = 0; n < 2; ++n) acc[a][b][m][n] = (f32x4){0.f, 0.f, 0.f, 0.f};
    bf16x8 At[4][2], B0[2][2], B1[2][2]; i32x8 At8[4], B08[2], B18[2];
    unsigned vc[2];
    PG8_LOADTOK(cur, vc);
    const char* gA = (const char*)g.A; const char* cB = (const char*)g.Bt + (size_t)cur.pn * tstep;
    PG8_STAGE(PG8_SB(0, 0), cB, voffB); PG8_STAGE(PG8_SB(0, 1), cB + hstep, voffB); PG8_STAGE_A(PG8_SA(0, 0), gA, vc[0]); PG8_STAGE_A(PG8_SA(0, 1), gA, vc[1]);
    if (wr == 1) PG8_BAR;
    PG8_WAIT_V(2); PG8_BAR;
    PG8_STAGE(PG8_SB(1, 0), cB + kstep, voffB); PG8_STAGE_A(PG8_SA(1, 0), gA + kstep, vc[0]); PG8_STAGE(PG8_SB(1, 1), cB + hstep + kstep, voffB);
    PG8_WAIT_V(6); PG8_BAR;
    for (;;) {
        const bool has_next = S.next(ui + 1, nxt);
        if constexpr (Epi::BIAS_DMA) { if (wid == 0) __builtin_amdgcn_global_load_lds((const unsigned*)E.bias_src(cur, lane), (LAS unsigned*)(lds + LC_BIAS + (ui & 1) * 1024), 16, 0, 0); }
        { const Unit& lu_ = has_next ? nxt : cur; PG8_LOADTOK_DMA(lu_); }
        const char* nB = has_next ? (const char*)g.Bt + (size_t)nxt.pn * tstep : cB;
        for (int t = 0; t < nt; t += 2) {
            const bool last = (t == nt - 2);
            const int rlx = ((t == 0) && (ui > 0)) ? 1 : 0;
            const char* a1 = gA + (size_t)(t + 1) * kstep;
            const char* b2 = last ? nB : cB + (size_t)(t + 2) * kstep; const char* b3 = b2 + kstep;
            const char* a2 = last ? gA : gA + (size_t)(t + 2) * kstep; const char* a3 = a2 + kstep;
            PG8_LDB(B0, 0, 0); PG8_LDB(B1, 0, 1); PG8_SCHED; PG8_LDA(At, 0, 0); PG8_STAGE_A(PG8_SA(1, 1), a1, vc[1]);
            if (last && has_next) {
                PG8_READTOK(vc); }
            PG8_WAIT_VR(rlx); PG8_WAIT_L(0); PG8_BAR; PG8_MMA(0, 0, At, B0); PG8_MMA(0, 1, At, B1); PG8_BAR; PG8_SCHED;
            PG8_LDA(At, 0, 1); PG8_STAGE(PG8_SB(0, 0), b2, voffB); PG8_STAGE(PG8_SB(0, 1), b2 + hstep, voffB); PG8_STAGE_A(PG8_SA(0, 0), a2, vc[0]);
            PG8_WAIT_VR(rlx); PG8_WAIT_L(0); PG8_BAR; PG8_MMA(1, 0, At, B0); PG8_MMA(1, 1, At, B1); PG8_BAR; PG8_SCHED;
            PG8_LDB(B0, 1, 0); PG8_LDB(B1, 1, 1); PG8_SCHED; PG8_LDA(At, 1, 0); PG8_STAGE_A(PG8_SA(0, 1), a2, vc[1]);
            PG8_WAIT_V(8); PG8_WAIT_L(0); PG8_BAR; PG8_MMA(0, 0, At, B0); PG8_MMA(0, 1, At, B1); PG8_BAR; PG8_SCHED;
            PG8_LDA(At, 1, 1); PG8_STAGE(PG8_SB(1, 0), b3, voffB); PG8_STAGE(PG8_SB(1, 1), b3 + hstep, voffB); PG8_STAGE_A(PG8_SA(1, 0), a3, vc[0]);
            PG8_WAIT_V(8); PG8_WAIT_L(0); PG8_BAR; PG8_MMA(1, 0, At, B0); PG8_MMA(1, 1, At, B1); PG8_BAR; PG8_SCHED;
        }
        if (wr == 0) PG8_BAR;
        E(acc, cur, wr, wc, fr, fq, (const LAS float*)(lds + LC_BIAS + (ui & 1) * 1024));
        if (!has_next) break;
#pragma unroll
        for (int a = 0; a < 2; ++a)
#pragma unroll
            for (int b = 0; b < 2; ++b)
#pragma unroll
                for (int m = 0; m < 4; ++m)
#pragma unroll
                    for (int n = 0; n < 2; ++n) acc[a][b][m][n] = (f32x4){0.f, 0.f, 0.f, 0.f};
        cur = nxt; cB = nB; ++ui;
        if (wr == 1) PG8_BAR;
    }
    PG8_WAIT_V(0);
    PG8_BAR;
#undef PG8_SA
#undef PG8_SB
#undef PG8_STAGE
#undef PG8_LDA
#undef PG8_LDB
#undef PG8_MMA
#undef PG8_WAIT_V
#undef PG8_WAIT_VR
#undef PG8_WAIT_L
#undef PG8_BAR
#undef PG8_SCHED
#undef PG8_STAGE_A
#undef PG8_LOADTOK
#undef PG8_LOADTOK_DMA
#undef PG8_READTOK
#undef PG8_TOKSLOT
#undef PG8_TOKIDX
}
}

struct Params {
    const float* in[26];
    float* out;
    unsigned char* ws;
};
struct Frame {
    LAS unsigned char* lds;
    int tid, lane, wave, G, bid;
};

template <int MT, int NT>
__device__ __forceinline__ void mma_nt(f32x4 (&acc)[MT][NT], const LAS bf16_t* A, int lda, const LAS bf16_t* B, int ldb, int K, int fr, int fq) {
    for (int k0 = 0; k0 < K; k0 += 32) {
        bf16x8 a[MT], b[NT];
#pragma unroll
        for (int m = 0; m < MT; ++m) a[m] = *(const LAS bf16x8*)(A + (m * 16 + fr) * lda + k0 + fq * 8);
#pragma unroll
        for (int n = 0; n < NT; ++n) b[n] = *(const LAS bf16x8*)(B + (n * 16 + fr) * ldb + k0 + fq * 8);
#pragma unroll
        for (int m = 0; m < MT; ++m)
#pragma unroll
            for (int n = 0; n < NT; ++n) acc[m][n] = __builtin_amdgcn_mfma_f32_16x16x32_bf16(a[m], b[n], acc[m][n], 0, 0, 0);
    }
}
template <int MT, int NT> __device__ __forceinline__ void zero_acc(f32x4 (&acc)[MT][NT]) {
#pragma unroll
    for (int m = 0; m < MT; ++m)
#pragma unroll
        for (int n = 0; n < NT; ++n) acc[m][n] = (f32x4){0.f, 0.f, 0.f, 0.f};
}

constexpr int SK_A = 0, SK_B = 69632;
template <class Epi>
__device__ __forceinline__ void skinny_unit(const Frame& F, const bf16_t* A, const bf16_t* Bt, const Epi& E) {
    LAS bf16_t* As = (LAS bf16_t*)(F.lds + SK_A); LAS bf16_t* Bs = (LAS bf16_t*)(F.lds + SK_B);
    const int tid = F.tid, fr = F.lane & 15, fq = F.lane >> 4, w = F.wave;
    f32x4 acc[2][2]; zero_acc<2, 2>(acc);
    u32x4 av[8], bv;
#pragma unroll
    for (int i = 0; i < 8; ++i) { const int ch = tid + NTHREADS * i, r = ch >> 4, c8 = (ch & 15) * 8; av[i] = *(const u32x4*)(A + (size_t)r * D + c8); }
    { const int r = tid >> 4, c8 = (tid & 15) * 8; bv = *(const u32x4*)(Bt + (size_t)r * D + c8); }
    for (int kc = 0; kc < 8; ++kc) {
        LDS_BARRIER();
#pragma unroll
        for (int i = 0; i < 8; ++i) { const int ch = tid + NTHREADS * i, r = ch >> 4, c8 = (ch & 15) * 8; *(LAS u32x4*)(As + r * 136 + c8) = av[i]; }
        { const int r = tid >> 4, c8 = (tid & 15) * 8; *(LAS u32x4*)(Bs + r * 136 + c8) = bv; }
        if (kc + 1 < 8) {
#pragma unroll
            for (int i = 0; i < 8; ++i) { const int ch = tid + NTHREADS * i, r = ch >> 4, c8 = (ch & 15) * 8; av[i] = *(const u32x4*)(A + (size_t)r * D + (kc + 1) * 128 + c8); }
            { const int r = tid >> 4, c8 = (tid & 15) * 8; bv = *(const u32x4*)(Bt + (size_t)r * D + (kc + 1) * 128 + c8); } }
        LDS_BARRIER();
        mma_nt<2, 2>(acc, As + (32 * w) * 136, 136, Bs, 136, 128, fr, fq);
    }
#pragma unroll
    for (int mt = 0; mt < 2; ++mt)
#pragma unroll
        for (int nt = 0; nt < 2; ++nt)
#pragma unroll
            for (int j = 0; j < 4; ++j) E(32 * w + mt * 16 + fq * 4 + j, nt * 16 + fr, acc[mt][nt][j]);
    LDS_BARRIER();
}
struct SkEpiBf16 { bf16_t* O; int ldc; __device__ __forceinline__ void operator()(int r, int c, float v) const { O[(size_t)r * ldc + c] = (bf16_t)f2bf(v); } };
struct SkEpiResid { bf16_t* X; const float* Xs; const float* gate; __device__ __forceinline__ void operator()(int r, int c, float v) const { X[(size_t)r * D + c] = (bf16_t)f2bf(Xs[(size_t)r * D + c] + gate[c] * v); } };

__device__ __forceinline__ void p0_transpose_item(const float* W, int K, int N, bf16_t* WT, int k0, int n0, int orow0, LAS float* scr, int lane) {
    float tv[32];
#pragma unroll
    for (int i = 0; i < 32; ++i) { const int kk = 2 * i + (lane >> 5); tv[i] = W[(size_t)(k0 + kk) * N + n0 + (lane & 31)]; }
#pragma unroll
    for (int i = 0; i < 32; ++i) { const int kk = 2 * i + (lane >> 5); scr[kk * 33 + (lane & 31)] = tv[i]; }
    asm volatile("s_waitcnt lgkmcnt(0)" ::: "memory");
    const int c = lane & 7;
#pragma unroll
    for (int j = 0; j < 4; ++j) { const int n = (lane >> 3) + 8 * j; const LAS float* s = scr + (8 * c) * 33 + n;
        u32x4 o; o.x = pk2(s[0 * 33], s[1 * 33]); o.y = pk2(s[2 * 33], s[3 * 33]); o.z = pk2(s[4 * 33], s[5 * 33]); o.w = pk2(s[6 * 33], s[7 * 33]);
        *(u32x4*)(WT + (size_t)(orow0 + n) * K + k0 + 8 * c) = o; }
    asm volatile("s_waitcnt lgkmcnt(0)" ::: "memory");
}

using pg8::pk4_fp8; using pg8::i32x4;
__device__ __forceinline__ unsigned char f2fp8(float v) { return (unsigned char)(__builtin_amdgcn_cvt_pk_fp8_f32(v, v, 0u, false) & 0xffu); }
struct WtSrc { const float* W; int N, k0, n0; unsigned char* dst; };
__device__ __forceinline__ void wt_issue(const WtSrc& r, int lane, float (&tv)[32]) {
#pragma unroll
    for (int i = 0; i < 8; ++i) { const f32x4 v = *(const f32x4*)(r.W + (size_t)(r.k0 + 8 * (lane >> 3) + i) * r.N + r.n0 + 4 * (lane & 7)); tv[4 * i] = v.x; tv[4 * i + 1] = v.y; tv[4 * i + 2] = v.z; tv[4 * i + 3] = v.w; }
}
__device__ __forceinline__ void wt_finish(const WtSrc& r, int lane, const float (&tv)[32], LAS unsigned char* scr8) {
    const int kq = lane >> 3, n4 = lane & 7;
#pragma unroll
    for (int c = 0; c < 4; ++c) { u32x2 o;
        o.x = pk4_fp8(64.f * tv[0 * 4 + c], 64.f * tv[1 * 4 + c], 64.f * tv[2 * 4 + c], 64.f * tv[3 * 4 + c]); o.y = pk4_fp8(64.f * tv[4 * 4 + c], 64.f * tv[5 * 4 + c], 64.f * tv[6 * 4 + c], 64.f * tv[7 * 4 + c]);
        *(LAS u32x2*)(scr8 + (4 * n4 + c) * 72 + 8 * kq) = o; }
    asm volatile("s_waitcnt lgkmcnt(0)" ::: "memory");
#pragma unroll
    for (int c2 = 0; c2 < 2; ++c2) { const int c = lane + 64 * c2, nn = c >> 2, k16 = (c & 3) * 16; const LAS unsigned* sp = (const LAS unsigned*)(scr8 + nn * 72 + k16);
        u32x4 o; o.x = sp[0]; o.y = sp[1]; o.z = sp[2]; o.w = sp[3];
        *(u32x4*)(r.dst + (size_t)nn * 1024 + k16) = o; }
    asm volatile("s_waitcnt lgkmcnt(0)" ::: "memory");
}

__device__ __forceinline__ void p0_transpose_item8(const float* W, int K, int N, unsigned char* WT8, int k0, int n0, int orow0, LAS float* scr, int lane) {
    WtSrc r; r.W = W; r.N = N; r.k0 = k0; r.n0 = n0; r.dst = WT8 + (size_t)orow0 * K + k0;
    float tv[32]; wt_issue(r, lane, tv); wt_finish(r, lane, tv, (LAS unsigned char*)scr);
}
constexpr int WT_I_IN = 16 * 73, WT_I_OUT = 16 * 32, WT_I_GU = 16 * 64, WT_I_DN = 16 * 32;
constexpr int WT_PER_LAYER = WT_I_IN + WT_I_OUT + NE * WT_I_GU + NE * WT_I_DN;
constexpr int WT_DEF0_LO = WT_PER_LAYER + WT_I_IN + WT_I_OUT + NE * WT_I_GU, WT_DEF0_HI = 2 * WT_PER_LAYER;
constexpr int WT_DEF1_LO = WT_PER_LAYER + WT_I_IN + WT_I_OUT, WT_DEF1_HI = WT_DEF1_LO + 16 * WT_I_GU;
__device__ __forceinline__ void weight_item(const Params& P, int it, LAS float* scr, int lane) {
    unsigned char* ws = P.ws;
    const int l = it / WT_PER_LAYER; int r = it % WT_PER_LAYER;
    if (r < WT_I_IN) { const int kb = r / 73, nb = r % 73;
        if (nb == 56) p0_transpose_item(P.in[8] + (size_t)l * D * INW, D, INW, (bf16_t*)(ws + WS_WGT) + (size_t)l * 32 * D, 64 * kb, 32 * nb, 0, scr, lane);
        else if (F8_GEMM1[l]) p0_transpose_item8(P.in[8] + (size_t)l * D * INW, D, INW, ws + WS_WIN + (size_t)l * INP * D * 2, 64 * kb, 32 * nb, nb < 56 ? 32 * nb : 32 * (nb - 1), scr, lane);
        else p0_transpose_item(P.in[8] + (size_t)l * D * INW, D, INW, (bf16_t*)(ws + WS_WIN) + (size_t)l * INP * D, 64 * kb, 32 * nb, nb < 56 ? 32 * nb : 32 * (nb - 1), scr, lane);
        return; }
    r -= WT_I_IN;
    if (r < WT_I_OUT) { const int kb = r / 32, nb = r % 32;
        p0_transpose_item(P.in[18] + (size_t)l * D * D, D, D, (bf16_t*)(ws + WS_WOUT) + (size_t)l * D * D, 64 * kb, 32 * nb, 32 * nb, scr, lane);
        p0_transpose_item8(P.in[18] + (size_t)l * D * D, D, D, ws + WS_WOUT8 + (size_t)l * D * D, 64 * kb, 32 * nb, 32 * nb, scr, lane); return; }
    r -= WT_I_OUT;
    if (r < NE * WT_I_GU) { const int e = r / WT_I_GU, q = r % WT_I_GU, kb = q / 64, nb = q % 64; const int n0 = 32 * nb;
        const int j = n0 & 1023, orow = 256 * (j >> 7) + (n0 >= 1024 ? 128 : 0) + (j & 127);
        if (F8_LAYER[l]) p0_transpose_item8(P.in[21] + ((size_t)l * NE + e) * D * 2048, D, 2048, ws + WS_WGU + (size_t)l * NE * 2048 * D * 2 + (size_t)e * 2048 * D, 64 * kb, n0, orow, scr, lane);
        else p0_transpose_item(P.in[21] + ((size_t)l * NE + e) * D * 2048, D, 2048, (bf16_t*)(ws + WS_WGU) + ((size_t)l * NE + e) * 2048 * D, 64 * kb, n0, orow, scr, lane);
        return; }
    r -= NE * WT_I_GU;
    { const int e = r / WT_I_DN, q = r % WT_I_DN, kb = q / 32, nb = q % 32;
        if (F8_LAYER[l]) p0_transpose_item8(P.in[23] + ((size_t)l * NE + e) * DFF * D, DFF, D, ws + WS_WDN + (size_t)l * NE * D * DFF * 2 + (size_t)e * D * DFF, 64 * kb, 32 * nb, 32 * nb, scr, lane);
        else p0_transpose_item(P.in[23] + ((size_t)l * NE + e) * DFF * D, DFF, D, (bf16_t*)(ws + WS_WDN) + ((size_t)l * NE + e) * D * DFF, 64 * kb, 32 * nb, 32 * nb, scr, lane); }
}

constexpr int WT_EXP_ITEMS = NE * WT_I_GU + NE * WT_I_DN;
constexpr int GL_WT8 = 115200;
__device__ __forceinline__ WtSrc wt_decode(const Params& P, int l, int q) {
    unsigned char* ws = P.ws; WtSrc r;
    if (q < NE * WT_I_GU) { const int e = q / WT_I_GU, t = q % WT_I_GU, kb = t / 64, nb = t % 64; const int n0 = 32 * nb; const int j = n0 & 1023, orow = 256 * (j >> 7) + (n0 >= 1024 ? 128 : 0) + (j & 127);
        r.W = P.in[21] + ((size_t)l * NE + e) * D * 2048; r.N = 2048; r.k0 = 64 * kb; r.n0 = n0; r.dst = ws + WS_WGU + (size_t)l * NE * 2048 * D * 2 + ((size_t)e * 2048 + orow) * D + 64 * kb; }
    else { const int q2 = q - NE * WT_I_GU; const int e = q2 / WT_I_DN, t = q2 % WT_I_DN, kb = t / 32, nb = t % 32;
        r.W = P.in[23] + ((size_t)l * NE + e) * DFF * D; r.N = D; r.k0 = 64 * kb; r.n0 = 32 * nb; r.dst = ws + WS_WDN + (size_t)l * NE * D * DFF * 2 + ((size_t)e * D + 32 * nb) * DFF + 64 * kb; }
    return r;
}
constexpr int SH_N = 2;
__device__ __forceinline__ void shadow_convert(const Frame& F, const Params& P, int l, int krel) {
    const int stride = F.G * 7, lim = NE * WT_I_GU - 1; LAS unsigned char* scr8 = F.lds + F.wave * 2304;
    const int q0 = krel * SH_N * stride + F.bid * 7 + (F.wave - 1), q1 = q0 + stride;
    const WtSrc a = wt_decode(P, l, q0 < lim ? q0 : lim), b = wt_decode(P, l, q1 < lim ? q1 : lim);
    float tA[32], tB[32];
    wt_issue(a, F.lane, tA); wt_issue(b, F.lane, tB); wt_finish(a, F.lane, tA, scr8); wt_finish(b, F.lane, tB, scr8);
}
__device__ __forceinline__ void phase_prologue(const Frame& F, const Params& P) {
    unsigned char* ws = P.ws;
    LAS float* scr = (LAS float*)(F.lds + F.wave * 16384);
    const int gw = F.bid * NWAVES + F.wave, NGW = F.G * NWAVES;
    for (int it = gw; it < DEPTH * (WT_I_IN + WT_I_OUT); it += NGW) { const int l = it / (WT_I_IN + WT_I_OUT), r = it % (WT_I_IN + WT_I_OUT); weight_item(P, l * WT_PER_LAYER + r, scr, F.lane); }
    {
        const int gt = F.bid * NTHREADS + F.tid, NGT = F.G * NTHREADS;
        bf16_t* cm3 = (bf16_t*)(ws + WS_CM3);
        for (int i = gt; i < 192 * 64; i += NGT) { const int m = i >> 6, n2 = i & 63, part = m >> 6, k2 = m & 63; const int ph = (k2 * n2) & 63;
            float s, c; sincospif((float)ph * (1.0f / 32.0f), &s, &c); const float v = part == 0 ? c : (part == 1 ? -s : -c); cm3[i] = (bf16_t)f2bf(v); }
        bf16_t* rwt = (bf16_t*)(ws + WS_RW);
        for (int i = gt; i < DEPTH * NE * D; i += NGT) { const int l = i / (NE * D), q = i % (NE * D), k = q >> 5, e = q & 31;
            const float w = P.in[19][(size_t)l * D * NE + q]; const unsigned hi = f2bf(w); const unsigned lo = f2bf(w - bf2f(hi));
            rwt[((size_t)l * 2 + 0) * NE * D + e * D + k] = (bf16_t)hi; rwt[((size_t)l * 2 + 1) * NE * D + e * D + k] = (bf16_t)lo; }
        bf16_t* tf2 = (bf16_t*)(ws + WS_TF2);
        for (int i = gt; i < 128 * 128; i += NGT) { const int c_ = i >> 7, n = i & 127; const int ph = (c_ * n) & 127;
            float s, c; sincospif((float)ph * (1.0f / 64.0f), &s, &c); tf2[i] = (bf16_t)f2bf(c); tf2[128 * 128 + i] = (bf16_t)f2bf(s); }
        bf16_t* tctx = (bf16_t*)(ws + WS_TCTX);
        for (int i = gt; i < 256 * 256; i += NGT) { const int k1 = i >> 8, n = i & 255; const int ph = (k1 * n) & 255;
            float s, c; sincospif((float)ph * (1.0f / 128.0f), &s, &c); tctx[i] = (bf16_t)f2bf(c); tctx[256 * 256 + i] = (bf16_t)f2bf(s); }
        bf16_t* tlat = (bf16_t*)(ws + WS_TLAT);
        for (int i = gt; i < 128 * 128 * 128; i += NGT) { const int nlo = i >> 14, d = (i >> 7) & 127, a = i & 127; const int ph = (d * (nlo + 128 * a)) & 16383;
            float s, c; sincospif((float)ph * (1.0f / 8192.0f), &s, &c);
            tlat[(size_t)nlo * 32768 + d * 128 + a] = (bf16_t)f2bf(c); tlat[(size_t)nlo * 32768 + 16384 + d * 128 + a] = (bf16_t)f2bf(s); }
    }
    for (int it = F.bid + F.G * F.wave; it < DEPTH * 24 * 8; it += NGW) {
        const int l = it / 192, q = it % 192, cb = q >> 3, ks = q & 7;
        const float* wm = P.in[6] + (size_t)l * D * 6144 + (size_t)(ks * 128) * 6144 + cb * 256 + 4 * F.lane;
        f32x4 a0 = {0.f, 0.f, 0.f, 0.f}, a1 = a0, a2 = a0;
#pragma unroll 16
        for (int k = 0; k < 128; ++k) { const int kk = ks * 128 + k;
            const float c0 = P.in[1][kk], c1 = P.in[1][D + kk], c2 = P.in[3][kk];
            const float s0 = c0 * sigmoidf_(c0), s1 = c1 * sigmoidf_(c1), s2 = c2 * sigmoidf_(c2);
            const f32x4 w = *(const f32x4*)(wm + (size_t)k * 6144);
            a0 += w * s0; a1 += w * s1; a2 += w * s2; }
        float* mp = (float*)(ws + WS_MODP) + ((size_t)(l * 8 + ks) * 3) * 6144 + cb * 256 + 4 * F.lane;
        *(f32x4*)(mp) = a0; *(f32x4*)(mp + 6144) = a1; *(f32x4*)(mp + 2 * 6144) = a2;
    }
}

__device__ __forceinline__ f32x4 mod_from_partials(const Params& P, int l, int v, int c4) {
    f32x4 s = *(const f32x4*)(P.in[7] + (size_t)l * 6144 + c4);
    const float* mp = (const float*)(P.ws + WS_MODP) + ((size_t)(l * 8) * 3 + v) * 6144 + c4;
#pragma unroll
    for (int ks = 0; ks < 8; ++ks) s += *(const f32x4*)(mp + (size_t)ks * 3 * 6144);
    return s;
}

__device__ __forceinline__ void norm_row_store(const f32x4 (&x)[4], const float* g, const f32x4 (&shv)[4], const f32x4 (&scv)[4], bf16_t* orow, int lane, unsigned char* orow8 = nullptr) {
    float ss = 0.f;
#pragma unroll
    for (int j = 0; j < 4; ++j) ss += (x[j].x * x[j].x + x[j].y * x[j].y) + (x[j].z * x[j].z + x[j].w * x[j].w);
    const float rstd = 1.0f / sqrtf(wave_sum(ss) * (1.0f / D) + NORM_EPS);
#pragma unroll
    for (int j = 0; j < 4; ++j) { const int c = 4 * lane + 256 * j;
        const f32x4 gv = *(const f32x4*)(g + c);
        const f32x4 y = (x[j] * rstd) * gv * (scv[j] + 1.0f) + shv[j];
        u32x2 o; o.x = pk2(y.x, y.y); o.y = pk2(y.z, y.w);
        *(u32x2*)(orow + c) = o;
        if (orow8) *(unsigned*)(orow8 + c) = pk4_fp8(y.x, y.y, y.z, y.w); }
}

__device__ __forceinline__ void phase_p1(const Frame& F, const Params& P) {
    unsigned char* ws = P.ws;
    const int gt = F.bid * NTHREADS + F.tid, NGT = F.G * NTHREADS;
    float* modf = (float*)(ws + WS_MODF);
    for (int i = gt; i < DEPTH * 3 * 1536; i += NGT) { const int l = i / 4608, q = i % 4608, v = q / 1536, c4 = (q % 1536) * 4;
        *(f32x4*)(modf + ((size_t)l * 3 + v) * 6144 + c4) = mod_from_partials(P, l, v, c4); }
    const int gw = F.bid * NWAVES + F.wave, NGW = F.G * NWAVES;
    bf16_t* hb = (bf16_t*)(ws + WS_HBUF);
    int cur_v = -1; f32x4 shv[4], scv[4], xn[4];
    auto rowp = [&](int m) { return (m < NLAT) ? (P.in[0] + (size_t)m * D) : (P.in[2] + (size_t)(m - NLAT) * D); };
    if (gw < NTOK) {
#pragma unroll
        for (int j = 0; j < 4; ++j) xn[j] = *(const f32x4*)(rowp(gw) + 4 * F.lane + 256 * j); }
    for (int m = gw; m < NTOK; m += NGW) {
        const int v = (m >= NLAT) ? 2 : (m >= SEQ ? 1 : 0);
        f32x4 x[4];
#pragma unroll
        for (int j = 0; j < 4; ++j) x[j] = xn[j];
        if (m + NGW < NTOK) {
#pragma unroll
            for (int j = 0; j < 4; ++j) xn[j] = *(const f32x4*)(rowp(m + NGW) + 4 * F.lane + 256 * j); }
        if (v != cur_v) { cur_v = v;
#pragma unroll
            for (int j = 0; j < 4; ++j) { const int c = 4 * F.lane + 256 * j; shv[j] = mod_from_partials(P, 0, v, c); scv[j] = mod_from_partials(P, 0, v, 1024 + c); } }
        norm_row_store(x, P.in[4], shv, scv, hb + (size_t)m * D, F.lane);
    }
}

constexpr int GL_GT = 0;
constexpr int GL_A1 = 34816, GL_KE = 60416, GL_VTB = 78848, GL_RS = 97280, GL_RT = 97792;
constexpr int GL_KDT = 34816, GL_VT = 53248;

__device__ __forceinline__ float logsigmoid2f_(float x) { const float z = 1.44269504089f * x; return fminf(z, 0.f) - __builtin_amdgcn_logf(1.0f + __builtin_amdgcn_exp2f(-fabsf(z))); }
__device__ __forceinline__ float bfel(const u32x4& v, int j) { const unsigned w = (j < 2) ? v.x : (j < 4 ? v.y : (j < 6 ? v.z : v.w)); return (j & 1) ? bfhi(w) : bflo(w); }
__device__ __forceinline__ unsigned short bfraw(const u32x4& v, int j) { const unsigned w = (j < 2) ? v.x : (j < 4 ? v.y : (j < 6 ? v.z : v.w)); return (unsigned short)((j & 1) ? (w >> 16) : (w & 0xffffu)); }

struct GateRegs { bf16x8 a[4]; float bw[8]; float bg; };
__device__ __forceinline__ GateRegs gla_load_gate_regs(const Frame& F, const Params& P, int l, int row0, int h) {
    GateRegs g;
    const int dir = F.wave >> 2, dbase = (F.wave & 3) * 16, fr = F.lane & 15, fq = F.lane >> 4;
    const bf16_t* lrb = (const bf16_t*)(P.ws + WS_LRB);
#pragma unroll
    for (int mt = 0; mt < 4; ++mt) g.a[mt] = *(const bf16x8*)(lrb + (size_t)(row0 + mt * 16 + fr) * 32 + dir * 16 + (fq & 1) * 8);
    const float* wgp = (dir ? P.in[11] : P.in[9]) + (size_t)l * 16 * 256 + 64 * h + dbase + fr;
#pragma unroll
    for (int j = 0; j < 8; ++j) g.bw[j] = wgp[((fq & 1) * 8 + j) * 256];
    g.bg = (dir ? P.in[12] : P.in[10])[(size_t)l * 256 + 64 * h + dbase + fr];
    return g;
}
__device__ __forceinline__ void gla_gates(const Frame& F, const GateRegs& gr) {
    LAS float* GT = (LAS float*)(F.lds + GL_GT);
    const int dir = F.wave >> 2, dbase = (F.wave & 3) * 16, lane = F.lane, fr = lane & 15, fq = lane >> 4;
    float p[4][4]; float T[4];
    const bf16x8 z8 = {0, 0, 0, 0, 0, 0, 0, 0}; bf16x8 gb;
    { const u32x4 pb_ = {pk2(gr.bw[0], gr.bw[1]), pk2(gr.bw[2], gr.bw[3]), pk2(gr.bw[4], gr.bw[5]), pk2(gr.bw[6], gr.bw[7])}; gb = (fq < 2) ? __builtin_bit_cast(bf16x8, pb_) : z8; }
#pragma unroll
    for (int mt = 0; mt < 4; ++mt) { const f32x4 acc = __builtin_amdgcn_mfma_f32_16x16x32_bf16((fq < 2) ? gr.a[mt] : z8, gb, (f32x4){0.f, 0.f, 0.f, 0.f}, 0, 0, 0);
#pragma unroll
        for (int j = 0; j < 4; ++j) p[mt][j] = logsigmoid2f_(acc[j] + gr.bg) * (1.0f / 16.0f); }
    if (dir == 0) {
#pragma unroll
        for (int mt = 0; mt < 4; ++mt) { p[mt][1] += p[mt][0]; p[mt][2] += p[mt][1]; p[mt][3] += p[mt][2]; T[mt] = p[mt][3]; }
        float base = 0.f;
#pragma unroll
        for (int mt = 0; mt < 4; ++mt) { float inc = T[mt]; float v = __shfl_up(inc, 16); inc += (fq >= 1) ? v : 0.f; v = __shfl_up(inc, 32); inc += (fq >= 2) ? v : 0.f;
            const float off = base + (inc - T[mt]); const float ct = __shfl(inc, 48 + fr);
#pragma unroll
            for (int j = 0; j < 4; ++j) GT[(dbase + fr) * 65 + mt * 16 + fq * 4 + j] = off + p[mt][j];
            base += ct; }
    } else {
#pragma unroll
        for (int mt = 0; mt < 4; ++mt) { p[mt][2] += p[mt][3]; p[mt][1] += p[mt][2]; p[mt][0] += p[mt][1]; T[mt] = p[mt][0]; }
        float base = 0.f;
#pragma unroll
        for (int mt = 3; mt >= 0; --mt) { float inc = T[mt]; float v = __shfl_down(inc, 16); inc += (fq <= 2) ? v : 0.f; v = __shfl_down(inc, 32); inc += (fq <= 1) ? v : 0.f;
            const float off = base + (inc - T[mt]); const float ct = __shfl(inc, fr);
#pragma unroll
            for (int j = 0; j < 4; ++j) GT[(64 + dbase + fr) * 65 + mt * 16 + fq * 4 + j] = off + p[mt][j];
            base += ct; }
    }
}

__device__ __forceinline__ void gla_unit_rows(int u, int& row0, int& h) {
    if (u < 2048) { const int bh = u >> 8, n = u & 255; h = bh & 3; row0 = (bh >> 2) * SEQ + 64 * n; }
    else { const int q = u - 2048, bh = q >> 2, n = q & 3; h = bh & 3; row0 = NLAT + (bh >> 2) * CTXL + 64 * n; }
}
struct G1Ops { GateRegs gr; u32x4 kv; u32x4 vv[2]; };
struct G3Ops { GateRegs gr; u32x4 qv, kv; u32x4 vv[2], rv[2], stv[4]; };
__device__ __forceinline__ void gla_map_rm64(const Frame& F, int& row, int& c8) { row = F.tid >> 3; c8 = (F.tid & 7) * 8; }
__device__ __forceinline__ void gla_map_tr64(const Frame& F, int& row, int& c8) { row = 32 * (F.wave & 1) + (F.lane & 31); c8 = 8 * (2 * (F.wave >> 1) + (F.lane >> 5)); }
__device__ __forceinline__ void gla_map_tr128(const Frame& F, int i, int& row, int& c8) { row = 32 * i + (F.lane & 31); c8 = 8 * (2 * F.wave + (F.lane >> 5)); }
__device__ __forceinline__ void gla_map_rm128(const Frame& F, int i, int& row, int& c8) { const int id = F.tid + 512 * i; row = id >> 4; c8 = (id & 15) * 8; }
__device__ __forceinline__ void gla_load_k(const Frame& F, const Params& P, int row0, int h, u32x4& kv) { int r, c; gla_map_rm64(F, r, c);
    kv = *(const u32x4*)((const bf16_t*)(P.ws + WS_PBUF) + pb_addr(row0 + r, C_K + 64 * h + c)); }
__device__ __forceinline__ void gla_load_q(const Frame& F, const Params& P, int row0, int h, u32x4& qv) { int r, c; gla_map_rm64(F, r, c);
    qv = *(const u32x4*)((const bf16_t*)(P.ws + WS_PBUF) + pb_addr(row0 + r, C_Q + 64 * h + c)); }
__device__ __forceinline__ void gla_load_kt(const Frame& F, const Params& P, int row0, int h, u32x4& kv) { int r, c; gla_map_tr64(F, r, c);
    kv = *(const u32x4*)((const bf16_t*)(P.ws + WS_PBUF) + pb_addr(row0 + r, C_K + 64 * h + c)); }
__device__ __forceinline__ void gla_load_v(const Frame& F, const Params& P, int row0, int h, u32x4 (&v)[2]) {
#pragma unroll
    for (int i = 0; i < 2; ++i) { int r, c; gla_map_tr128(F, i, r, c); v[i] = *(const u32x4*)((const bf16_t*)(P.ws + WS_PBUF) + pb_addr(row0 + r, C_V + 128 * h + c)); } }
__device__ __forceinline__ void gla_load_r(const Frame& F, const Params& P, int row0, int h, u32x4 (&v)[2]) {
#pragma unroll
    for (int i = 0; i < 2; ++i) { int r, c; gla_map_rm128(F, i, r, c); v[i] = *(const u32x4*)((const bf16_t*)(P.ws + WS_PBUF) + pb_addr(row0 + r, C_R + 128 * h + c)); } }
__device__ __forceinline__ void gla_load_state(const Frame& F, const Params& P, int unit, u32x4 (&stv)[4]) {
    const bf16_t* st = (const bf16_t*)(P.ws + WS_STATE) + (size_t)unit * 16384;
#pragma unroll
    for (int i = 0; i < 4; ++i) stv[i] = *(const u32x4*)(st + (i * 512 + F.tid) * 8); }
__device__ __forceinline__ void gla_g1_unit(const Frame& F, const Params& P, int l, int unit, G1Ops& o, bool has_next, int nrow0, int nh) {
    const int tid = F.tid; int row, c8; gla_map_tr64(F, row, c8);
    gla_gates(F, o.gr);
    o.gr = gla_load_gate_regs(F, P, l, nrow0, nh);
    LDS_BARRIER();
    LAS float* GT = (LAS float*)(F.lds + GL_GT);
    LAS bf16_t* KDT = (LAS bf16_t*)(F.lds + GL_KDT); LAS bf16_t* VT = (LAS bf16_t*)(F.lds + GL_VT);
#pragma unroll
    for (int j = 0; j < 8; ++j) { const int d = c8 + j; const float k_ = bfel(o.kv, j);
        KDT[d * 72 + row] = (bf16_t)f2bf(k_ * __builtin_amdgcn_exp2f(GT[d * 65 + 63] - GT[d * 65 + row])); KDT[(64 + d) * 72 + row] = (bf16_t)f2bf(k_ * __builtin_amdgcn_exp2f(GT[(64 + d) * 65] - GT[(64 + d) * 65 + row])); }
    gla_load_kt(F, P, nrow0, nh, o.kv);
#pragma unroll
    for (int i = 0; i < 2; ++i) { int vr, vc; gla_map_tr128(F, i, vr, vc);
#pragma unroll
        for (int j = 0; j < 8; ++j) VT[(vc + j) * 72 + vr] = bfraw(o.vv[i], j); }
    gla_load_v(F, P, nrow0, nh, o.vv);
    if (tid < 128) ((float*)(P.ws + WS_DECAY))[(size_t)unit * 128 + tid] = __builtin_amdgcn_exp2f(tid < 64 ? GT[tid * 65 + 63] : GT[tid * 65]);
    LDS_BARRIER();
    const int fr = F.lane & 15, fq = F.lane >> 4, w = F.wave;
    f32x4 acc[1][8]; zero_acc<1, 8>(acc);
    mma_nt<1, 8>(acc, KDT + (16 * w) * 72, 72, VT, 72, 64, fr, fq);
    bf16_t* st = (bf16_t*)(P.ws + WS_STATE) + (size_t)unit * 16384;
#pragma unroll
    for (int nt = 0; nt < 8; ++nt) { u32x2 ov; ov.x = pk2(acc[0][nt][0], acc[0][nt][1]); ov.y = pk2(acc[0][nt][2], acc[0][nt][3]); *(u32x2*)(st + (nt * 16 + fr) * 128 + 16 * w + fq * 4) = ov; }
}

__device__ __forceinline__ void gla_scan(const Frame& F, const Params& P, int def_lo, int def_hi) {
    unsigned* stt = (unsigned*)(P.ws + WS_STATE); const float* dec = (const float*)(P.ws + WS_DECAY);
    if (F.tid >= 256) {
        LAS float* scr = (LAS float*)(F.lds + F.wave * 16384);
        for (int it = def_lo + F.bid * 4 + (F.wave - 4); it < def_hi; it += F.G * 4) weight_item(P, it, scr, F.lane);
        return; }
    for (int gid = F.bid * 256 + F.tid; gid < 8 * 128 * 64; gid += F.G * 256) {
        const int dp = gid & 63, e = (gid >> 6) & 127, bh = gid >> 13, dir = dp >> 5;
        const int latb = bh * 256, ctxb = 2048 + bh * 4;
        auto unit_of = [&](int p) { return dir == 0 ? (p < 4 ? ctxb + p : latb + (p - 4)) : (p < 4 ? ctxb + 3 - p : latb + 255 - (p - 4)); };
        float s0 = 0.f, s1 = 0.f;
        unsigned dA[10], dB[10]; f32x2 cA[10], cB[10];
#pragma unroll
        for (int i = 0; i < 10; ++i) { const int u = unit_of(i); dA[i] = stt[((size_t)u * 128 + e) * 64 + dp]; cA[i] = *(const f32x2*)(dec + (size_t)u * 128 + 2 * dp); }
        for (int p0 = 0; p0 < 260; p0 += 20) {
#pragma unroll
            for (int i = 0; i < 10; ++i) { const int u = unit_of(p0 + 10 + i); dB[i] = stt[((size_t)u * 128 + e) * 64 + dp]; cB[i] = *(const f32x2*)(dec + (size_t)u * 128 + 2 * dp); }
#pragma unroll
            for (int i = 0; i < 10; ++i) { const int u = unit_of(p0 + i); stt[((size_t)u * 128 + e) * 64 + dp] = pk2(s0, s1); s0 = cA[i].x * s0 + bflo(dA[i]); s1 = cA[i].y * s1 + bfhi(dA[i]); }
            if (p0 + 20 < 260) {
#pragma unroll
                for (int i = 0; i < 10; ++i) { const int u = unit_of(p0 + 20 + i); dA[i] = stt[((size_t)u * 128 + e) * 64 + dp]; cA[i] = *(const f32x2*)(dec + (size_t)u * 128 + 2 * dp); } }
#pragma unroll
            for (int i = 0; i < 10; ++i) { const int u = unit_of(p0 + 10 + i); stt[((size_t)u * 128 + e) * 64 + dp] = pk2(s0, s1); s0 = cB[i].x * s0 + bflo(dB[i]); s1 = cB[i].y * s1 + bfhi(dB[i]); }
        }
    }
}

__device__ __forceinline__ void gla_g3_unit(const Frame& F, const Params& P, int l, int row0, int h, int unit, G3Ops& o, const float (&ngv)[4], bool has_next, int nrow0, int nh, int nunit) {
    const int tid = F.tid, fr = F.lane & 15, fq = F.lane >> 4, w = F.wave; int row, c8; gla_map_rm64(F, row, c8);
    gla_gates(F, o.gr);
    o.gr = gla_load_gate_regs(F, P, l, nrow0, nh);
    LDS_BARRIER();
    LAS float* GT = (LAS float*)(F.lds + GL_GT);
    LAS bf16_t* A1 = (LAS bf16_t*)(F.lds + GL_A1); LAS bf16_t* KE = (LAS bf16_t*)(F.lds + GL_KE); LAS bf16_t* VTb = (LAS bf16_t*)(F.lds + GL_VTB); LAS bf16_t* STb = (LAS bf16_t*)(F.lds + GL_GT);
    LAS float* RS = (LAS float*)(F.lds + GL_RS); LAS bf16_t* RT = (LAS bf16_t*)(F.lds + GL_RT);
    { float qf[8], qb[8], kf[8], kb[8];
#pragma unroll
      for (int j = 0; j < 8; ++j) { const float q_ = bfel(o.qv, j) * 0.125f, k_ = bfel(o.kv, j); const float bf_ = GT[(c8 + j) * 65 + row], bb_ = GT[(64 + c8 + j) * 65 + row];
          qf[j] = q_ * __builtin_amdgcn_exp2f(bf_); qb[j] = q_ * __builtin_amdgcn_exp2f(bb_); kf[j] = k_ * __builtin_amdgcn_exp2f(-bf_); kb[j] = k_ * __builtin_amdgcn_exp2f(-bb_); }
      *(LAS u32x4*)(A1 + row * 200 + 64 + c8) = (u32x4){pk2(qf[0], qf[1]), pk2(qf[2], qf[3]), pk2(qf[4], qf[5]), pk2(qf[6], qf[7])};
      *(LAS u32x4*)(A1 + row * 200 + 128 + c8) = (u32x4){pk2(qb[0], qb[1]), pk2(qb[2], qb[3]), pk2(qb[4], qb[5]), pk2(qb[6], qb[7])};
      *(LAS u32x4*)(KE + row * 72 + c8) = (u32x4){pk2(kf[0], kf[1]), pk2(kf[2], kf[3]), pk2(kf[4], kf[5]), pk2(kf[6], kf[7])};
      *(LAS u32x4*)(KE + 4608 + row * 72 + c8) = (u32x4){pk2(kb[0], kb[1]), pk2(kb[2], kb[3]), pk2(kb[4], kb[5]), pk2(kb[6], kb[7])}; }
    gla_load_q(F, P, nrow0, nh, o.qv); gla_load_k(F, P, nrow0, nh, o.kv);
#pragma unroll
    for (int i = 0; i < 2; ++i) { int rr, rc, vr, vc; gla_map_rm128(F, i, rr, rc); gla_map_tr128(F, i, vr, vc); *(LAS u32x4*)(RT + rr * 136 + rc) = o.rv[i];
#pragma unroll
        for (int j = 0; j < 8; ++j) VTb[(vc + j) * 72 + vr] = bfraw(o.vv[i], j); }
    gla_load_v(F, P, nrow0, nh, o.vv); gla_load_r(F, P, nrow0, nh, o.rv);
    LDS_BARRIER();
    {
        const int mt = w & 3, ntp = w >> 2;
        f32x4 af[1][2], ab[1][2]; zero_acc<1, 2>(af); zero_acc<1, 2>(ab);
        mma_nt<1, 2>(af, A1 + (16 * mt) * 200 + 64, 200, KE + (32 * ntp) * 72, 72, 64, fr, fq);
        mma_nt<1, 2>(ab, A1 + (16 * mt) * 200 + 128, 200, KE + 4608 + (32 * ntp) * 72, 72, 64, fr, fq);
#pragma unroll
        for (int i = 0; i < 4; ++i) { const int idx = (i * 512 + tid) * 8, e = idx >> 7, dd = idx & 127; *(LAS u32x4*)(STb + e * 136 + dd) = o.stv[i]; }
        gla_load_state(F, P, nunit, o.stv);
#pragma unroll
        for (int nt = 0; nt < 2; ++nt)
#pragma unroll
            for (int j = 0; j < 4; ++j) { const int i = 16 * mt + fq * 4 + j, jj = (2 * ntp + nt) * 16 + fr;
                const float p = (jj <= i ? af[0][nt][j] : 0.f) + (jj >= i ? ab[0][nt][j] : 0.f); A1[i * 200 + jj] = (bf16_t)f2bf(p); }
    }
    LDS_BARRIER();
    {
        const int mt = w & 3, nh = w >> 2;
        f32x4 acc[1][4]; zero_acc<1, 4>(acc);
        mma_nt<1, 4>(acc, A1 + (16 * mt) * 200, 200, VTb + (64 * nh) * 72, 72, 64, fr, fq);
        mma_nt<1, 4>(acc, A1 + (16 * mt) * 200 + 64, 200, STb + (64 * nh) * 136, 136, 128, fr, fq);
        float ss[4];
#pragma unroll
        for (int j = 0; j < 4; ++j) { float s = 0.f;
#pragma unroll
            for (int nt = 0; nt < 4; ++nt) s += acc[0][nt][j] * acc[0][nt][j];
            s += __shfl_xor(s, 1); s += __shfl_xor(s, 2); s += __shfl_xor(s, 4); s += __shfl_xor(s, 8); ss[j] = s; }
        if (fr == 0) {
#pragma unroll
            for (int j = 0; j < 4; ++j) RS[nh * 64 + 16 * mt + fq * 4 + j] = ss[j]; }
        LDS_BARRIER();
        unsigned char* cat8 = P.ws + WS_CAT; bf16_t* catc = (bf16_t*)(P.ws + WS_CATC); const bool lat = row0 < NLAT;
#pragma unroll
        for (int j = 0; j < 4; ++j) { const int i = 16 * mt + fq * 4 + j; const float rinv = 1.0f / sqrtf((RS[i] + RS[64 + i]) * (1.0f / 128.0f) + NORM_EPS);
#pragma unroll
            for (int nt = 0; nt < 4; ++nt) { const int e = nh * 64 + nt * 16 + fr; const float r_ = bf2f(RT[i * 136 + e]);
                const float o = acc[0][nt][j] * rinv * ngv[nt] * (r_ * sigmoidf_(r_)); if (lat) cat8[(size_t)(row0 + i) * D + 256 + 128 * h + e] = f2fp8(o); else catc[(size_t)(row0 - NLAT + i) * D + 256 + 128 * h + e] = (bf16_t)f2bf(o); } }
    }
}

__device__ __forceinline__ void conv_unit(const Frame& F, const Params& P, int l, int rowbase, int Ls, int t0) {
    const bf16_t* pb = (const bf16_t*)(P.ws + WS_PBUF);
    LAS bf16_t* Y = (LAS bf16_t*)(F.lds);
    LAS float* Z = (LAS float*)(F.lds + 49152);
    const int tid = F.tid;
    {
        u32x4 av[6], gv[6];
#pragma unroll
        for (int i = 0; i < 6; ++i) { const int ch = tid + 512 * i, r = ch >> 5, cc = (ch & 31) * 8, t = t0 - 15 + r;
            av[i] = (u32x4){0u, 0u, 0u, 0u}; gv[i] = av[i];
            if (ch < 94 * 32 && t >= 0 && t < Ls) { av[i] = *(const u32x4*)(pb + pb_addr(rowbase + t, C_CA + cc)); gv[i] = *(const u32x4*)(pb + pb_addr(rowbase + t, C_CG + cc)); } }
#pragma unroll
        for (int i = 0; i < 6; ++i) { const int ch = tid + 512 * i, r = ch >> 5, cc = (ch & 31) * 8; const u32x4 a = av[i], g = gv[i]; u32x4 o;
            o.x = pk2(bflo(a.x) * sigmoidf_(bflo(g.x)), bfhi(a.x) * sigmoidf_(bfhi(g.x))); o.y = pk2(bflo(a.y) * sigmoidf_(bflo(g.y)), bfhi(a.y) * sigmoidf_(bfhi(g.y)));
            o.z = pk2(bflo(a.z) * sigmoidf_(bflo(g.z)), bfhi(a.z) * sigmoidf_(bfhi(g.z))); o.w = pk2(bflo(a.w) * sigmoidf_(bflo(g.w)), bfhi(a.w) * sigmoidf_(bfhi(g.w)));
            if (ch < 94 * 32) *(LAS u32x4*)(Y + r * 256 + cc) = o; }
    }
    const int c2 = (tid & 127) * 2, qtr = tid >> 7; const float* cw = P.in[14] + (size_t)l * 31 * 256 + c2; const f32x2 cb = *(const f32x2*)(P.in[15] + (size_t)l * 256 + c2);
    f32x2 wv[31];
#pragma unroll
    for (int j = 0; j < 31; ++j) wv[j] = *(const f32x2*)(cw + j * 256);
    const f32x4 lng = *(const f32x4*)(P.in[16] + (size_t)l * 256 + 4 * F.lane), lnb = *(const f32x4*)(P.in[17] + (size_t)l * 256 + 4 * F.lane);
    LDS_BARRIER();
#pragma unroll 1
    for (int hp = 0; hp < 2; ++hp) { f32x2 yv[38]; const int rb = qtr * 16 + hp * 8;
#pragma unroll
      for (int r = 0; r < 38; ++r) { const unsigned wd = *(const LAS unsigned*)(Y + (rb + r) * 256 + c2); yv[r] = (f32x2){bflo(wd), bfhi(wd)}; }
#pragma unroll
      for (int tt = 0; tt < 8; ++tt) { f32x2 z = cb;
#pragma unroll
          for (int j = 0; j < 31; ++j) z += wv[j] * yv[tt + j];
          *(LAS f32x2*)(Z + (rb + tt) * 256 + c2) = z; } }
    LDS_BARRIER();
    { unsigned char* cat8 = P.ws + WS_CAT; bf16_t* catc = (bf16_t*)(P.ws + WS_CATC); const bool lat = rowbase < NLAT;
#pragma unroll 2
      for (int i = 0; i < 8; ++i) { const int t = F.wave * 8 + i; const f32x4 z = *(const LAS f32x4*)(Z + t * 256 + 4 * F.lane);
          const float mean = wave_sum_dpp((z.x + z.y) + (z.z + z.w)) * (1.0f / 256.0f); const f32x4 zc = z - mean;
          const float var = wave_sum_dpp((zc.x * zc.x + zc.y * zc.y) + (zc.z * zc.z + zc.w * zc.w)) * (1.0f / 256.0f); const float rstd = 1.0f / sqrtf(var + NORM_EPS);
          const f32x4 y = zc * rstd * lng + lnb; const f32x4 yo = {y.x * sigmoidf_(y.x), y.y * sigmoidf_(y.y), y.z * sigmoidf_(y.z), y.w * sigmoidf_(y.w)};
          if (lat) *(unsigned*)(cat8 + (size_t)(rowbase + t0 + t) * D + 768 + 4 * F.lane) = pk4_fp8(yo.x, yo.y, yo.z, yo.w);
          else { u32x2 o; o.x = pk2(yo.x, yo.y); o.y = pk2(yo.z, yo.w); *(u32x2*)(catc + (size_t)(rowbase - NLAT + t0 + t) * D + 768 + 4 * F.lane) = o; } } }
    LDS_BARRIER();
}

template <int R, int NP>
__device__ __forceinline__ void fourier_f1_unit(const Frame& F, const Params& P, int rowbase, int rstride, int h, const bf16_t* tab, int orow0, float oscale) {
    const bf16_t* pb = (const bf16_t*)(P.ws + WS_PBUF); const bf16_t* cm3 = (const bf16_t*)(P.ws + WS_CM3);
    constexpr int LZ = R + 8, MT0 = 4 * NP, NTW = R / 128, MTW = R / 128;
    LAS bf16_t* U = (LAS bf16_t*)(F.lds); LAS bf16_t* CM = U + R * 72; LAS bf16_t* ZT = CM + 64 * NP * 72;
    const int tid = F.tid, fr = F.lane & 15, fq = F.lane >> 4, w = F.wave;
    bf16x8 tcp[4], tsp[4];
    if constexpr (R == 128) {
#pragma unroll
        for (int k = 0; k < 4; ++k) { tcp[k] = *(const bf16x8*)(tab + (size_t)(w * 16 + fr) * R + k * 32 + fq * 8); tsp[k] = *(const bf16x8*)(tab + (size_t)R * R + (size_t)(w * 16 + fr) * R + k * 32 + fq * 8); } }
    { constexpr int NU = R * 8 / NTHREADS, NC = (64 * NP * 8 + NTHREADS - 1) / NTHREADS; u32x4 uv[NU], cv[NC];
#pragma unroll
      for (int i = 0; i < NU; ++i) { const int ch = tid + NTHREADS * i, a = ch >> 3, c8 = (ch & 7) * 8; uv[i] = *(const u32x4*)(pb + pb_addr(rowbase + a * rstride, C_FOUR + 64 * h + c8)); }
#pragma unroll
      for (int i = 0; i < NC; ++i) { const int ch = tid + NTHREADS * i, m = ch >> 3, c8 = (ch & 7) * 8; cv[i] = (ch < 64 * NP * 8) ? *(const u32x4*)(cm3 + m * 64 + c8) : (u32x4){0u, 0u, 0u, 0u}; }
#pragma unroll
      for (int i = 0; i < NU; ++i) { const int ch = tid + NTHREADS * i, a = ch >> 3, c8 = (ch & 7) * 8; *(LAS u32x4*)(U + a * 72 + c8) = uv[i]; }
#pragma unroll
      for (int i = 0; i < NC; ++i) { const int ch = tid + NTHREADS * i, m = ch >> 3, c8 = (ch & 7) * 8; if (ch < 64 * NP * 8) *(LAS u32x4*)(CM + m * 72 + c8) = cv[i]; } }
    LDS_BARRIER();
    {
        f32x4 acc[MT0][NTW]; zero_acc<MT0, NTW>(acc);
        mma_nt<MT0, NTW>(acc, CM, 72, U + (w * NTW * 16) * 72, 72, 64, fr, fq);
#pragma unroll
        for (int mt = 0; mt < MT0; ++mt)
#pragma unroll
            for (int nt = 0; nt < NTW; ++nt)
#pragma unroll
                for (int j = 0; j < 4; ++j) ZT[(mt * 16 + fq * 4 + j) * LZ + (w * NTW + nt) * 16 + fr] = (bf16_t)f2bf(acc[mt][nt][j]);
    }
    LDS_BARRIER();
    {
        f32x4 are[MTW][4], aim[MTW][4]; zero_acc<MTW, 4>(are); zero_acc<MTW, 4>(aim);
        const int m0 = w * MTW * 16;
#pragma unroll
        for (int k0 = 0; k0 < R; k0 += 32) {
            bf16x8 tc[MTW], ts[MTW];
#pragma unroll
            for (int mi = 0; mi < MTW; ++mi) { if constexpr (R == 128) { tc[mi] = tcp[k0 / 32]; ts[mi] = tsp[k0 / 32]; } else { tc[mi] = *(const bf16x8*)(tab + (size_t)(m0 + mi * 16 + fr) * R + k0 + fq * 8); ts[mi] = *(const bf16x8*)(tab + (size_t)R * R + (size_t)(m0 + mi * 16 + fr) * R + k0 + fq * 8); } }
#pragma unroll
            for (int nt = 0; nt < 4; ++nt) {
                const bf16x8 zr = *(const LAS bf16x8*)(ZT + (nt * 16 + fr) * LZ + k0 + fq * 8), zi = *(const LAS bf16x8*)(ZT + (64 + nt * 16 + fr) * LZ + k0 + fq * 8);
#pragma unroll
                for (int mi = 0; mi < MTW; ++mi) { are[mi][nt] = __builtin_amdgcn_mfma_f32_16x16x32_bf16(tc[mi], zr, are[mi][nt], 0, 0, 0); are[mi][nt] = __builtin_amdgcn_mfma_f32_16x16x32_bf16(ts[mi], zi, are[mi][nt], 0, 0, 0); }
                if constexpr (NP == 3) { const bf16x8 nzr = *(const LAS bf16x8*)(ZT + (128 + nt * 16 + fr) * LZ + k0 + fq * 8);
#pragma unroll
                    for (int mi = 0; mi < MTW; ++mi) { aim[mi][nt] = __builtin_amdgcn_mfma_f32_16x16x32_bf16(tc[mi], zi, aim[mi][nt], 0, 0, 0); aim[mi][nt] = __builtin_amdgcn_mfma_f32_16x16x32_bf16(ts[mi], nzr, aim[mi][nt], 0, 0, 0); } }
            }
        }
#pragma unroll
        for (int mi = 0; mi < MTW; ++mi)
#pragma unroll
            for (int nt = 0; nt < 4; ++nt)
#pragma unroll
                for (int j = 0; j < 4; ++j) { const int m = m0 + mi * 16 + fq * 4 + j, k2 = nt * 16 + fr;
                    if constexpr (NP == 3) { unsigned* t2 = (unsigned*)(P.ws + WS_T2); t2[(size_t)(orow0 + 128 * m) * 256 + h * 64 + k2] = pk2(are[mi][nt][j], aim[mi][nt][j]); }
                    else { bf16_t* catc = (bf16_t*)(P.ws + WS_CATC); catc[(size_t)(orow0 - NLAT + m) * D + h * 64 + k2] = (bf16_t)f2bf(are[mi][nt][j] * oscale); } }
    }
    LDS_BARRIER();
}

struct F1Ops { bf16x8 tcp[4], tsp[4]; u32x4 uv[2]; };
__device__ __forceinline__ void f1_lat_load_u(const Frame& F, const Params& P, int rowbase, int h, u32x4 (&uv)[2]) {
#pragma unroll
    for (int i = 0; i < 2; ++i) { const int ch = F.tid + NTHREADS * i, a = ch >> 3, c8 = (ch & 7) * 8; uv[i] = *(const u32x4*)((const bf16_t*)(P.ws + WS_PBUF) + pb_addr(rowbase + a * 128, C_FOUR + 64 * h + c8)); } }
__device__ __forceinline__ void f1_lat_load_t(const Frame& F, const bf16_t* tab, bf16x8 (&tcp)[4], bf16x8 (&tsp)[4]) {
    const int fr = F.lane & 15, fq = F.lane >> 4, w = F.wave;
#pragma unroll
    for (int k = 0; k < 4; ++k) { tcp[k] = *(const bf16x8*)(tab + (size_t)(w * 16 + fr) * 128 + k * 32 + fq * 8); tsp[k] = *(const bf16x8*)(tab + (size_t)128 * 128 + (size_t)(w * 16 + fr) * 128 + k * 32 + fq * 8); } }
__device__ __forceinline__ void f1_lat_tables(const Frame& F, const Params& P) {
    const bf16_t* cm3 = (const bf16_t*)(P.ws + WS_CM3); LAS bf16_t* CM = (LAS bf16_t*)(F.lds) + 128 * 72;
#pragma unroll
    for (int i = 0; i < 3; ++i) { const int ch = F.tid + NTHREADS * i, m = ch >> 3, c8 = (ch & 7) * 8; *(LAS u32x4*)(CM + m * 72 + c8) = *(const u32x4*)(cm3 + m * 64 + c8); }
}
__device__ __forceinline__ void fourier_f1_lat_unit(const Frame& F, const Params& P, int h, int orow0, F1Ops& o, bool has_next, int nrowbase, int nh, const bf16_t* ntab) {
    constexpr int R = 128, LZ = R + 8;
    LAS bf16_t* U = (LAS bf16_t*)(F.lds); LAS bf16_t* CM = U + R * 72; LAS bf16_t* ZT = CM + 64 * 3 * 72;
    const int tid = F.tid, fr = F.lane & 15, fq = F.lane >> 4, w = F.wave;
#pragma unroll
    for (int i = 0; i < 2; ++i) { const int ch = tid + NTHREADS * i, a = ch >> 3, c8 = (ch & 7) * 8; *(LAS u32x4*)(U + a * 72 + c8) = o.uv[i]; }
    f1_lat_load_u(F, P, nrowbase, nh, o.uv);
    LDS_BARRIER();
    {
        f32x4 acc[12][1]; zero_acc<12, 1>(acc);
        mma_nt<12, 1>(acc, CM, 72, U + (w * 16) * 72, 72, 64, fr, fq);
#pragma unroll
        for (int mt = 0; mt < 12; ++mt)
#pragma unroll
            for (int j = 0; j < 4; ++j) ZT[(mt * 16 + fq * 4 + j) * LZ + w * 16 + fr] = (bf16_t)f2bf(acc[mt][0][j]);
    }
    LDS_BARRIER();
    {
        f32x4 are[4], aim[4];
#pragma unroll
        for (int nt = 0; nt < 4; ++nt) { are[nt] = (f32x4){0.f, 0.f, 0.f, 0.f}; aim[nt] = are[nt]; }
        const int m0 = w * 16;
#pragma unroll
        for (int k0 = 0; k0 < R; k0 += 32) {
            const bf16x8 tc = o.tcp[k0 / 32], ts = o.tsp[k0 / 32];
#pragma unroll
            for (int nt = 0; nt < 4; ++nt) {
                const bf16x8 zr = *(const LAS bf16x8*)(ZT + (nt * 16 + fr) * LZ + k0 + fq * 8), zi = *(const LAS bf16x8*)(ZT + (64 + nt * 16 + fr) * LZ + k0 + fq * 8), nzr = *(const LAS bf16x8*)(ZT + (128 + nt * 16 + fr) * LZ + k0 + fq * 8);
                are[nt] = __builtin_amdgcn_mfma_f32_16x16x32_bf16(tc, zr, are[nt], 0, 0, 0); are[nt] = __builtin_amdgcn_mfma_f32_16x16x32_bf16(ts, zi, are[nt], 0, 0, 0);
                aim[nt] = __builtin_amdgcn_mfma_f32_16x16x32_bf16(tc, zi, aim[nt], 0, 0, 0); aim[nt] = __builtin_amdgcn_mfma_f32_16x16x32_bf16(ts, nzr, aim[nt], 0, 0, 0); }
        }
        f1_lat_load_t(F, ntab, o.tcp, o.tsp);
        unsigned* t2 = (unsigned*)(P.ws + WS_T2);
#pragma unroll
        for (int nt = 0; nt < 4; ++nt)
#pragma unroll
            for (int j = 0; j < 4; ++j) { const int m = m0 + fq * 4 + j, k2 = nt * 16 + fr; t2[(size_t)(orow0 + 128 * m) * 256 + h * 64 + k2] = pk2(are[nt][j], aim[nt][j]); }
    }
    LDS_BARRIER();
}

constexpr int F2_X = 0, F2_T = 67584;
__device__ __forceinline__ void fourier_f2_tables(const Frame& F, const Params& P) {
    const bf16_t* tf2 = (const bf16_t*)(P.ws + WS_TF2); LAS bf16_t* T = (LAS bf16_t*)(F.lds + F2_T);
#pragma unroll
    for (int i = 0; i < 8; ++i) { const int ch = F.tid + 512 * i, r = ch >> 4, c8 = (ch & 15) * 8; *(LAS u32x4*)(T + r * 136 + c8) = *(const u32x4*)(tf2 + r * 128 + c8); }
    LDS_BARRIER();
}
__device__ __forceinline__ void fourier_f2_unit(const Frame& F, const Params& P, int b, int d, int hp) {
    const bf16_t* t2 = (const bf16_t*)(P.ws + WS_T2);
    LAS bf16_t* X = (LAS bf16_t*)(F.lds + F2_X); const LAS bf16_t* T = (const LAS bf16_t*)(F.lds + F2_T);
    const int tid = F.tid, fr = F.lane & 15, fq = F.lane >> 4, w = F.wave;
    { u32x4 xv[8];
#pragma unroll
      for (int i = 0; i < 8; ++i) { const int ch = tid + 512 * i, n = ch >> 5, c8 = (ch & 31) * 8; xv[i] = *(const u32x4*)(t2 + (size_t)(b * SEQ + 128 * d + n) * 512 + hp * 256 + c8); }
#pragma unroll
      for (int i = 0; i < 8; ++i) { const int ch = tid + 512 * i, n = ch >> 5, c8 = (ch & 31) * 8; *(LAS u32x4*)(X + n * 264 + c8) = xv[i]; } }
    LDS_BARRIER();
    f32x4 acc[8];
#pragma unroll
    for (int mt = 0; mt < 8; ++mt) acc[mt] = (f32x4){0.f, 0.f, 0.f, 0.f};
#pragma unroll
    for (int k0 = 0; k0 < 128; k0 += 32) {
        bf16x8 xr, xi;
#pragma unroll
        for (int jj = 0; jj < 8; ++jj) { const unsigned wd = *(const LAS unsigned*)(X + (k0 + fq * 8 + jj) * 264 + 2 * (w * 16 + fr)); xr[jj] = (short)(wd & 0xffffu); xi[jj] = (short)(wd >> 16); }
#pragma unroll
        for (int mt = 0; mt < 8; ++mt) { const bf16x8 tc = *(const LAS bf16x8*)(T + (mt * 16 + fr) * 136 + k0 + fq * 8), ts = *(const LAS bf16x8*)(T + (128 + mt * 16 + fr) * 136 + k0 + fq * 8);
            acc[mt] = __builtin_amdgcn_mfma_f32_16x16x32_bf16(tc, xr, acc[mt], 0, 0, 0); acc[mt] = __builtin_amdgcn_mfma_f32_16x16x32_bf16(ts, xi, acc[mt], 0, 0, 0); }
    }
    unsigned char* cat8 = P.ws + WS_CAT;
#pragma unroll
    for (int mt = 0; mt < 8; ++mt)
#pragma unroll
        for (int j = 0; j < 4; ++j) { const int c = mt * 16 + fq * 4 + j; cat8[(size_t)(b * SEQ + 128 * c + d) * D + hp * 128 + w * 16 + fr] = f2fp8(acc[mt][j] * (1.0f / 1024.0f)); }
    LDS_BARRIER();
}

constexpr int AX_LCNT = AUX_OFF, AX_GBASE = AUX_OFF + 128, AX_LE = AUX_OFF + 256, AX_LP = AUX_OFF + 256 + 2560;
constexpr int LC_BAR = LCTL_OFF, LC_TS = LCTL_OFF + 64;

constexpr int RT_GS = 0, RT_SSQ = 24576, RT_AT = 25600, RT_PL = 95232;
__device__ __forceinline__ void phase_route(const Frame& F, const Params& P, int l, int ntok) {
    unsigned char* ws = P.ws;
    LAS float* GS = (LAS float*)(F.lds + RT_GS); LAS float* SSQ = (LAS float*)(F.lds + RT_SSQ); LAS float* PL = (LAS float*)(F.lds + RT_PL);
    volatile LAS int* lcnt = (volatile LAS int*)(F.lds + AX_LCNT); volatile LAS int* gbase = (volatile LAS int*)(F.lds + AX_GBASE);
    volatile LAS int* LE = (volatile LAS int*)(F.lds + AX_LE); volatile LAS int* LP = (volatile LAS int*)(F.lds + AX_LP);
    const int tid = F.tid, lane = F.lane, w = F.wave, fr = lane & 15, fq = lane >> 4, ts = lane >> 2, kq = lane & 3, kbase = 128 * w + 32 * kq;
    LAS bf16_t* AT = (LAS bf16_t*)(F.lds + RT_AT) + w * (2 * 16 * 136);
    const int tpb = (ntok + F.G - 1) / F.G, tb = F.bid * tpb, te = (tb + tpb < ntok) ? tb + tpb : ntok, ntile = (te - tb + 15) >> 4;
    { const float* g2 = P.in[5] + (size_t)l * D;
      for (int i = tid; i < 3 * 1024; i += NTHREADS) { const int v = i >> 10, k = i & 1023; const float* mf = (const float*)(ws + WS_MODF) + ((size_t)l * 3 + v) * 6144;
          GS[(v * 2 + 0) * 1024 + k] = g2[k] * (1.0f + mf[4 * 1024 + k]); GS[(v * 2 + 1) * 1024 + k] = mf[3 * 1024 + k]; } }
    if (tid < 32) lcnt[tid] = 0;
    bf16x8 bh[4][2], bl[4][2];
    { const bf16_t* rwh = (const bf16_t*)(ws + WS_RW) + (size_t)l * 2 * NE * D; const bf16_t* rwl = rwh + NE * D;
#pragma unroll
      for (int sk = 0; sk < 4; ++sk)
#pragma unroll
          for (int nt = 0; nt < 2; ++nt) { const int off = (nt * 16 + fr) * D + 128 * w + 32 * sk + 8 * fq; bh[sk][nt] = *(const bf16x8*)(rwh + off); bl[sk][nt] = *(const bf16x8*)(rwl + off); } }
    const bf16_t* xres = (const bf16_t*)(ws + WS_XRES); bf16_t* hb = (bf16_t*)(ws + WS_HBUF);
    const float rbias = P.in[20][(size_t)l * NE + (lane & 31)];
    float* aprob = (float*)(ws + WS_APROB);
    u32x4 xn[4];
    { const int m = tb + ts;
#pragma unroll
      for (int j = 0; j < 4; ++j) xn[j] = (m < te) ? *(const u32x4*)(xres + (size_t)m * D + kbase + 8 * j) : (u32x4){0u, 0u, 0u, 0u}; }
    LDS_BARRIER();
    for (int it = 0; it < ntile; ++it) {
        const int buf = it & 1; const int m = tb + 16 * it + ts; const bool valid = m < te; const int v = (m >= NLAT) ? 2 : (m >= SEQ ? 1 : 0);
        f32x4 x[8]; float ss = 0.f;
#pragma unroll
        for (int j = 0; j < 8; ++j) { const u32x4 xw = xn[j >> 1]; x[j] = (j & 1) ? (f32x4){bflo(xw.z), bfhi(xw.z), bflo(xw.w), bfhi(xw.w)} : (f32x4){bflo(xw.x), bfhi(xw.x), bflo(xw.y), bfhi(xw.y)};
            ss += (x[j].x * x[j].x + x[j].y * x[j].y) + (x[j].z * x[j].z + x[j].w * x[j].w); }
        if (it + 1 < ntile) { const int mn = m + 16;
#pragma unroll
            for (int j = 0; j < 4; ++j) xn[j] = (mn < te) ? *(const u32x4*)(xres + (size_t)mn * D + kbase + 8 * j) : (u32x4){0u, 0u, 0u, 0u}; }
        ss += __shfl_xor(ss, 1); ss += __shfl_xor(ss, 2);
        if (kq == 0) SSQ[(buf * 8 + w) * 16 + ts] = ss;
        LDS_BARRIER();
        float tot = 0.f;
#pragma unroll
        for (int q = 0; q < 8; ++q) tot += SSQ[(buf * 8 + q) * 16 + ts];
        const float rstd = 1.0f / sqrtf(tot * (1.0f / D) + NORM_EPS);
        {
            unsigned hw[16], lw[16];
#pragma unroll
            for (int j = 0; j < 8; ++j) { const f32x4 gs = *(const LAS f32x4*)(GS + (v * 2 + 0) * 1024 + kbase + 4 * j), sh = *(const LAS f32x4*)(GS + (v * 2 + 1) * 1024 + kbase + 4 * j);
                const f32x4 h = (x[j] * rstd) * gs + sh;
                const unsigned h0 = f2bf(h.x), h1 = f2bf(h.y), h2 = f2bf(h.z), h3 = f2bf(h.w);
                hw[2 * j] = h0 | (h1 << 16); hw[2 * j + 1] = h2 | (h3 << 16);
                lw[2 * j] = pk2(h.x - bf2f(h0), h.y - bf2f(h1)); lw[2 * j + 1] = pk2(h.z - bf2f(h2), h.w - bf2f(h3)); }
            if (valid) {
                if (F8_LAYER[l]) { unsigned char* hb8 = ws + WS_HB8 + (size_t)m * D + kbase;
#pragma unroll
                    for (int c = 0; c < 2; ++c) { u32x4 o;
                        o.x = pk4_fp8(bflo(hw[8 * c + 0]) + bflo(lw[8 * c + 0]), bfhi(hw[8 * c + 0]) + bfhi(lw[8 * c + 0]), bflo(hw[8 * c + 1]) + bflo(lw[8 * c + 1]), bfhi(hw[8 * c + 1]) + bfhi(lw[8 * c + 1]));
                        o.y = pk4_fp8(bflo(hw[8 * c + 2]) + bflo(lw[8 * c + 2]), bfhi(hw[8 * c + 2]) + bfhi(lw[8 * c + 2]), bflo(hw[8 * c + 3]) + bflo(lw[8 * c + 3]), bfhi(hw[8 * c + 3]) + bfhi(lw[8 * c + 3]));
                        o.z = pk4_fp8(bflo(hw[8 * c + 4]) + bflo(lw[8 * c + 4]), bfhi(hw[8 * c + 4]) + bfhi(lw[8 * c + 4]), bflo(hw[8 * c + 5]) + bflo(lw[8 * c + 5]), bfhi(hw[8 * c + 5]) + bfhi(lw[8 * c + 5]));
                        o.w = pk4_fp8(bflo(hw[8 * c + 6]) + bflo(lw[8 * c + 6]), bfhi(hw[8 * c + 6]) + bfhi(lw[8 * c + 6]), bflo(hw[8 * c + 7]) + bflo(lw[8 * c + 7]), bfhi(hw[8 * c + 7]) + bfhi(lw[8 * c + 7]));
                        *(u32x4*)(hb8 + 16 * c) = o; } }
                if (!F8_LAYER[l]) {
#pragma unroll
                    for (int c = 0; c < 4; ++c) *(u32x4*)(hb + (size_t)m * D + kbase + 8 * c) = (u32x4){hw[4 * c], hw[4 * c + 1], hw[4 * c + 2], hw[4 * c + 3]}; } }
#pragma unroll
            for (int c = 0; c < 4; ++c) { *(LAS u32x4*)(AT + ts * 136 + 32 * kq + 8 * c) = (u32x4){hw[4 * c], hw[4 * c + 1], hw[4 * c + 2], hw[4 * c + 3]};
                *(LAS u32x4*)(AT + 16 * 136 + ts * 136 + 32 * kq + 8 * c) = (u32x4){lw[4 * c], lw[4 * c + 1], lw[4 * c + 2], lw[4 * c + 3]}; }
        }
        f32x4 acc[2]; acc[0] = (f32x4){0.f, 0.f, 0.f, 0.f}; acc[1] = acc[0];
#pragma unroll
        for (int sk = 0; sk < 4; ++sk) { const bf16x8 ah = *(const LAS bf16x8*)(AT + fr * 136 + 32 * sk + 8 * fq), al = *(const LAS bf16x8*)(AT + 16 * 136 + fr * 136 + 32 * sk + 8 * fq);
#pragma unroll
            for (int nt = 0; nt < 2; ++nt) { acc[nt] = __builtin_amdgcn_mfma_f32_16x16x32_bf16(ah, bh[sk][nt], acc[nt], 0, 0, 0); acc[nt] = __builtin_amdgcn_mfma_f32_16x16x32_bf16(ah, bl[sk][nt], acc[nt], 0, 0, 0);
                acc[nt] = __builtin_amdgcn_mfma_f32_16x16x32_bf16(al, bh[sk][nt], acc[nt], 0, 0, 0); } }
#pragma unroll
        for (int nt = 0; nt < 2; ++nt)
#pragma unroll
            for (int j = 0; j < 4; ++j) PL[((buf * 8 + w) * 16 + fq * 4 + j) * 33 + nt * 16 + fr] = acc[nt][j];
        LDS_BARRIER();
        {
            const int tt = 2 * w + (lane >> 5), e = lane & 31, mt = tb + 16 * it + tt;
            float lg = rbias;
#pragma unroll
            for (int q = 0; q < 8; ++q) lg += PL[((buf * 8 + q) * 16 + tt) * 33 + e];
            float bval[4]; int bidx[4]; float cur = lg;
#pragma unroll
            for (int k = 0; k < 4; ++k) { float bv = cur; int bi = e;
#pragma unroll
                for (int o = 1; o < 32; o <<= 1) { const float ov = __shfl_xor(bv, o); const int oi = __shfl_xor(bi, o); const bool take = (ov > bv) || (ov == bv && oi < bi); bv = take ? ov : bv; bi = take ? oi : bi; }
                bval[k] = bv; bidx[k] = bi; if (e == bi) cur = -INFINITY; }
            float ex[4], sum = 0.f;
#pragma unroll
            for (int k = 0; k < 4; ++k) { ex[k] = __expf(bval[k] - bval[0]); sum += ex[k]; }
            if (e == 0 && mt < te) { const int tl = 16 * it + tt;
#pragma unroll
                for (int k = 0; k < 4; ++k) { const int lp = __hip_atomic_fetch_add((LAS int*)(F.lds + AX_LCNT) + bidx[k], 1, __ATOMIC_RELAXED, __HIP_MEMORY_SCOPE_WORKGROUP);
                    LE[tl * 4 + k] = bidx[k]; LP[tl * 4 + k] = lp; aprob[(size_t)mt * 4 + k] = ex[k] / sum; } }
        }
    }
    LDS_BARRIER();
    if (tid < 32) gbase[tid] = (int)__hip_atomic_fetch_add((unsigned*)(ws + WS_CTL) + CW_CNT + l * 64 + tid, (unsigned)lcnt[tid], __ATOMIC_RELAXED, __HIP_MEMORY_SCOPE_AGENT);
    LDS_BARRIER();
    int* aexp = (int*)(ws + WS_AEXP); int* apos = (int*)(ws + WS_APOS);
    int* elist = (int*)(ws + WS_XB);
    for (int i = tid; i < (te - tb) * 4; i += NTHREADS) { const int e = LE[i]; const int pos = gbase[e] + LP[i]; aexp[(size_t)tb * 4 + i] = e; apos[(size_t)tb * 4 + i] = pos; elist[(size_t)e * NTOK + pos] = tb + (i >> 2); }
    LDS_BARRIER();
}

__device__ __forceinline__ void moe_prep(const Frame& F, const Params& P, int l) {
    unsigned char* ws = P.ws;
    volatile LAS int* TS = (volatile LAS int*)(F.lds + LC_TS);
    if (F.tid < 64) { const int e = F.lane & 31;
        const unsigned c = __hip_atomic_load((unsigned*)(ws + WS_CTL) + CW_CNT + l * 64 + e, __ATOMIC_RELAXED, __HIP_MEMORY_SCOPE_AGENT);
        int incl = (int)((c + 255u) >> 8);
#pragma unroll
        for (int o = 1; o < 32; o <<= 1) { const int v = __shfl_up(incl, o); if (e >= o) incl += v; }
        if (F.lane < 32) { TS[e + 1] = incl; TS[64 + e] = (int)c; }
        if (F.lane == 0) TS[0] = 0; }
    LDS_BARRIER();
}

__device__ __forceinline__ void phase_gather8(const Frame& F, const Params& P, int l, int ntok) {
    unsigned char* ws = P.ws;
    moe_prep(F, P, l);
    const volatile LAS int* TS = (const volatile LAS int*)(F.lds + LC_TS);
    const int gw = F.bid * NWAVES + F.wave, NGW = F.G * NWAVES;
    const int* aexp = (const int*)(ws + WS_AEXP); const int* apos = (const int*)(ws + WS_APOS);
    const unsigned char* hb8 = ws + WS_HB8; unsigned char* xb8 = ws + WS_XB8;
    for (int cidx = gw; cidx < ntok / 16; cidx += NGW) {
        const int a0 = cidx * 64; const int e = aexp[a0 + F.lane]; const int rowl = TS[e] * 256 + apos[a0 + F.lane];
#pragma unroll 1
        for (int t4 = 0; t4 < 16; t4 += 4) {
            u32x4 v0[4];
#pragma unroll
            for (int q = 0; q < 4; ++q) v0[q] = ((const u32x4*)(hb8 + (size_t)(a0 / 4 + t4 + q) * D))[F.lane];
#pragma unroll
            for (int q = 0; q < 4; ++q)
#pragma unroll
                for (int k = 0; k < 4; ++k) { const int row = __shfl(rowl, (t4 + q) * 4 + k); ((u32x4*)(xb8 + (size_t)row * D))[F.lane] = v0[q]; }
        }
    }
}

__device__ __forceinline__ void phase_combine(const Frame& F, const Params& P, int l, int ntok, bool last) {
    static_assert(F8_LAYER[0] && F8_LAYER[1], "combine reads fp8 expert outputs");
    unsigned char* ws = P.ws;
    const int gw = F.bid * NWAVES + F.wave, NGW = F.G * NWAVES, lane = F.lane, c0 = 16 * lane;
    bf16_t* xres = (bf16_t*)(ws + WS_XRES); const unsigned char* yb8 = ws + WS_YB;
    const int* aexp = (const int*)(ws + WS_AEXP); const int* apos = (const int*)(ws + WS_APOS); const float* aprob = (const float*)(ws + WS_APROB);
    const volatile LAS int* TS = (const volatile LAS int*)(F.lds + LC_TS);
    if (gw >= ntok) return;
    f32x4 g5[4], gn[4], sc1[4], sh[4]; int cur_v = -1;
    { const float* gp = last ? P.in[25] : P.in[4] + (size_t)(l + 1) * D;
#pragma unroll
      for (int q = 0; q < 4; ++q) gn[q] = *(const f32x4*)(gp + c0 + 4 * q); }
    i32x4 ae_n = *(const i32x4*)(aexp + (size_t)gw * 4), ap_n = *(const i32x4*)(apos + (size_t)gw * 4); f32x4 pr_n = *(const f32x4*)(aprob + (size_t)gw * 4);
    u32x4 wv[4], xo[2]; f32x4 pr;
    {
        int sl[4];
#pragma unroll
        for (int k = 0; k < 4; ++k) sl[k] = TS[ae_n[k]] * 256 + ap_n[k];
#pragma unroll
        for (int k = 0; k < 4; ++k) wv[k] = *(const u32x4*)(yb8 + (size_t)sl[k] * D + c0);
#pragma unroll
        for (int q = 0; q < 2; ++q) xo[q] = *(const u32x4*)(xres + (size_t)gw * D + c0 + 8 * q);
        pr = pr_n;
        const int m1 = (gw + NGW < ntok) ? gw + NGW : gw;
        ae_n = *(const i32x4*)(aexp + (size_t)m1 * 4); ap_n = *(const i32x4*)(apos + (size_t)m1 * 4); pr_n = *(const f32x4*)(aprob + (size_t)m1 * 4);
    }
    for (int m = gw; m < ntok; m += NGW) {
        const int v = (m >= NLAT) ? 2 : (m >= SEQ ? 1 : 0);
        if (v != cur_v) { cur_v = v;
            const float* mf = (const float*)(ws + WS_MODF) + ((size_t)l * 3 + v) * 6144; const float* mn = (const float*)(ws + WS_MODF) + ((size_t)((l + 1) & 1) * 3 + v) * 6144;
#pragma unroll
            for (int q = 0; q < 4; ++q) { g5[q] = *(const f32x4*)(mf + 5 * 1024 + c0 + 4 * q);
                if (!last) { sh[q] = *(const f32x4*)(mn + c0 + 4 * q); sc1[q] = *(const f32x4*)(mn + 1024 + c0 + 4 * q) + 1.0f; } } }
        f32x4 y[4];
#pragma unroll
        for (int q = 0; q < 4; ++q) y[q] = (f32x4){0.f, 0.f, 0.f, 0.f};
#pragma unroll
        for (int k = 0; k < 4; ++k) { const float pk_ = pr[k]; const u32x4 w4 = wv[k];
#pragma unroll
            for (int q = 0; q < 4; ++q) { const unsigned wd = (q == 0) ? w4.x : (q == 1 ? w4.y : (q == 2 ? w4.z : w4.w));
                const f32x2 lo = __builtin_amdgcn_cvt_pk_f32_fp8(wd, false), hi = __builtin_amdgcn_cvt_pk_f32_fp8(wd, true); y[q] += (f32x4){lo.x, lo.y, hi.x, hi.y} * pk_; } }
        f32x4 x[4];
        x[0] = (f32x4){bflo(xo[0].x), bfhi(xo[0].x), bflo(xo[0].y), bfhi(xo[0].y)} + g5[0] * y[0]; x[1] = (f32x4){bflo(xo[0].z), bfhi(xo[0].z), bflo(xo[0].w), bfhi(xo[0].w)} + g5[1] * y[1];
        x[2] = (f32x4){bflo(xo[1].x), bfhi(xo[1].x), bflo(xo[1].y), bfhi(xo[1].y)} + g5[2] * y[2]; x[3] = (f32x4){bflo(xo[1].z), bfhi(xo[1].z), bflo(xo[1].w), bfhi(xo[1].w)} + g5[3] * y[3];
        const int mn1 = m + NGW;
        if (mn1 < ntok) {
            int sl[4];
#pragma unroll
            for (int k = 0; k < 4; ++k) sl[k] = TS[ae_n[k]] * 256 + ap_n[k];
#pragma unroll
            for (int k = 0; k < 4; ++k) wv[k] = *(const u32x4*)(yb8 + (size_t)sl[k] * D + c0);
#pragma unroll
            for (int q = 0; q < 2; ++q) xo[q] = *(const u32x4*)(xres + (size_t)mn1 * D + c0 + 8 * q);
            pr = pr_n;
            const int m2 = (mn1 + NGW < ntok) ? mn1 + NGW : mn1;
            ae_n = *(const i32x4*)(aexp + (size_t)m2 * 4); ap_n = *(const i32x4*)(apos + (size_t)m2 * 4); pr_n = *(const f32x4*)(aprob + (size_t)m2 * 4); }
        float ss = 0.f;
#pragma unroll
        for (int q = 0; q < 4; ++q) ss += (x[q].x * x[q].x + x[q].y * x[q].y) + (x[q].z * x[q].z + x[q].w * x[q].w);
        const float rstd = 1.0f / sqrtf(wave_sum(ss) * (1.0f / D) + NORM_EPS);
        if (!last) {
#pragma unroll
            for (int q = 0; q < 2; ++q) { u32x4 o; o.x = pk2(x[2 * q].x, x[2 * q].y); o.y = pk2(x[2 * q].z, x[2 * q].w); o.z = pk2(x[2 * q + 1].x, x[2 * q + 1].y); o.w = pk2(x[2 * q + 1].z, x[2 * q + 1].w);
                *(u32x4*)(xres + (size_t)m * D + c0 + 8 * q) = o; }
            f32x4 hv[4];
#pragma unroll
            for (int q = 0; q < 4; ++q) hv[q] = (x[q] * rstd) * gn[q] * sc1[q] + sh[q];
            bf16_t* hrow = (bf16_t*)(ws + WS_HBUF) + (size_t)m * D + c0;
#pragma unroll
            for (int q = 0; q < 2; ++q) { u32x4 o; o.x = pk2(hv[2 * q].x, hv[2 * q].y); o.y = pk2(hv[2 * q].z, hv[2 * q].w); o.z = pk2(hv[2 * q + 1].x, hv[2 * q + 1].y); o.w = pk2(hv[2 * q + 1].z, hv[2 * q + 1].w);
                *(u32x4*)(hrow + 8 * q) = o; }
            if (F8_GEMM1[(l + 1) & 1]) { u32x4 o; o.x = pk4_fp8(hv[0].x, hv[0].y, hv[0].z, hv[0].w); o.y = pk4_fp8(hv[1].x, hv[1].y, hv[1].z, hv[1].w); o.z = pk4_fp8(hv[2].x, hv[2].y, hv[2].z, hv[2].w); o.w = pk4_fp8(hv[3].x, hv[3].y, hv[3].z, hv[3].w);
                *(u32x4*)(ws + WS_HB8 + (size_t)m * D + c0) = o; }
        } else {
#pragma unroll
            for (int q = 0; q < 4; ++q) *(f32x4*)(P.out + (size_t)m * D + c0 + 4 * q) = (x[q] * rstd) * gn[q];
        }
    }
}

#ifndef REP_PRO
#define REP_PRO 1
#endif
#ifndef REP_GEMM1
#define REP_GEMM1 1
#endif
#ifndef REP_G1U
#define REP_G1U 1
#endif
#ifndef REP_F1U
#define REP_F1U 1
#endif
#ifndef REP_CONV
#define REP_CONV 1
#endif
#ifndef REP_F2U
#define REP_F2U 1
#endif
#ifndef REP_G3U
#define REP_G3U 1
#endif
#ifndef REP_GU
#define REP_GU 1
#endif
#ifndef REP_DN
#define REP_DN 1
#endif
#ifndef REP_GATH
#define REP_GATH 1
#endif
__global__ void __launch_bounds__(NTHREADS, 2) mega_fwd(Params P0) {
    extern __shared__ __attribute__((aligned(16))) unsigned char lds_raw[];
    Frame F0; F0.lds = (LAS unsigned char*)lds_raw; F0.tid = threadIdx.x; F0.lane = F0.tid & 63; F0.wave = __builtin_amdgcn_readfirstlane(F0.tid >> 6); F0.G = gridDim.x; F0.bid = blockIdx.x;
#define KAS __attribute__((address_space(4)))
    struct ParamsK { const GAS float* in[26]; GAS float* out; GAS unsigned char* ws; };
#define PHASE_ENV() Frame F = F0; asm volatile("" : "+v"(F.tid)); F.lane = F.tid & 63; F.wave = __builtin_amdgcn_readfirstlane(F.tid >> 6); asm volatile("" : "+s"(F.bid), "+s"(F.G)); \
    const KAS ParamsK* kp_ = (const KAS ParamsK*)__builtin_amdgcn_kernarg_segment_ptr(); asm volatile("" : "+s"(kp_)); Params P; \
    _Pragma("unroll") for (int i_ = 0; i_ < 26; ++i_) P.in[i_] = (const float*)kp_->in[i_]; \
    P.out = (float*)kp_->out; P.ws = (unsigned char*)kp_->ws; unsigned char* ws = P.ws; (void)ws;
    { PHASE_ENV();
    for (int u = F.tid; u < (LDS_BYTES - LCTL_OFF) / 4; u += NTHREADS) ((LAS unsigned*)(F.lds + LCTL_OFF))[u] = 0u;
    LDS_BARRIER();
    }
    { PHASE_ENV(); (void)xcd_barrier_post((unsigned*)(ws + WS_CTL) + CW_BAR, (volatile LAS unsigned*)(F.lds + LC_BAR)); }
#define GRID_BAR_SH(LAYER, KREL) do { PHASE_ENV(); XcdBarrier b_; b_.bar = (unsigned*)(ws + WS_CTL) + CW_BAR; b_.x = xb_xcc_id(); b_.st = (volatile LAS unsigned*)(F.lds + LC_BAR); \
    asm volatile("s_waitcnt vmcnt(0)" ::: "memory"); __syncthreads(); if (F.wave == 0) xcd_barrier2_t0(b_); else shadow_convert(F, P, LAYER, KREL); __syncthreads(); } while (0)
#define GRID_BAR() do { PHASE_ENV(); XcdBarrier b_; b_.bar = (unsigned*)(ws + WS_CTL) + CW_BAR; b_.x = xb_xcc_id(); b_.st = (volatile LAS unsigned*)(F.lds + LC_BAR); asm volatile("s_waitcnt vmcnt(0)" ::: "memory"); __syncthreads(); xcd_barrier2_t0(b_); __syncthreads(); } while (0)

    for (int rep = 0; rep < REP_PRO; ++rep) { PHASE_ENV(); phase_prologue(F, P); }
    GRID_BAR_SH(0, 0);
    { PHASE_ENV(); phase_p1(F, P); }
    GRID_BAR_SH(0, 1);

    {
        constexpr int l = 0; constexpr bool last = (l == DEPTH - 1);
        for (int rep = 0; rep < REP_GEMM1; ++rep) { PHASE_ENV();
          const int nun = (NTOK / 256) * (INP / 256), rr = nun % F.G, first = (rr == 0) ? 0 : rr, nidle = F.G - first;
          if (F.bid >= first) for (int t = F.bid - first; t < NTOK / 256; t += nidle) {
              SkEpiBf16 SE{(bf16_t*)(ws + WS_LRB) + (size_t)t * 256 * 32, 32};
              skinny_unit(F, (const bf16_t*)(ws + WS_HBUF) + (size_t)t * 256 * D, (const bf16_t*)(ws + WS_WGT) + (size_t)l * 32 * D, SE); }
          pg8::StaticOrder S; S.init(NTOK, INP, F.G, F.bid);
          if constexpr (F8_GEMM1[l]) {
              pg8::Gemm g{(const bf16_t*)(ws + WS_HB8), (const bf16_t*)(ws + WS_WIN + (size_t)l * INP * D * 2), NTOK, INP, D / 2};
              pg8::EpiStoreBf16S E{(bf16_t*)(ws + WS_PBUF), INP};
              pg8::gemm_phase<pg8::EpiStoreBf16S, pg8::StaticOrder, true, true, true>(F.lds, g, S, E, F.tid);
          } else {
              pg8::Gemm g{(const bf16_t*)(ws + WS_HBUF), (const bf16_t*)(ws + WS_WIN) + (size_t)l * INP * D, NTOK, INP, D};
              pg8::EpiStoreBf16 E{(bf16_t*)(ws + WS_PBUF), INP};
              pg8::gemm_phase<pg8::EpiStoreBf16, pg8::StaticOrder>(F.lds, g, S, E, F.tid); }
 }
        GRID_BAR_SH(0, 2);
        for (int st_ = 0; st_ < 3; ++st_) { const int wh_ = ((F0.bid >> 3) & 1) ? 2 - st_ : st_;
        if (wh_ == 0) {
        for (int rep = 0; rep < REP_G1U; ++rep) { PHASE_ENV();
        { LAS unsigned char* scr8 = F.lds + GL_WT8 + F.wave * 2304; const int gw_ = F.bid * NWAVES + F.wave, NGW_ = F.G * NWAVES;
          constexpr int QHI = NE * WT_I_GU; const int QLO = (l == 0 ? 7 : 9) * SH_N * 7 * F.G, nbg = (QHI - QLO + NGW_ - 1) / NGW_; int q_ = QLO + gw_;
        G1Ops ops_; { int r0_, h0_; gla_unit_rows(F.bid, r0_, h0_); ops_.gr = gla_load_gate_regs(F, P, l, r0_, h0_); gla_load_kt(F, P, r0_, h0_, ops_.kv); gla_load_v(F, P, r0_, h0_, ops_.vv); }
        int u = F.bid;
        for (int i_ = 0; i_ < nbg && u < 2080; ++i_, u += F.G) { int nrow0, nh; const bool hn_ = u + F.G < 2080; gla_unit_rows(hn_ ? u + F.G : u, nrow0, nh);
            float tv_[32]; const WtSrc ws_ = wt_decode(P, l, q_ < QHI ? q_ : QHI - 1); wt_issue(ws_, F.lane, tv_);
            gla_g1_unit(F, P, l, u, ops_, hn_, nrow0, nh);
            wt_finish(ws_, F.lane, tv_, scr8); q_ += NGW_; }
        for (; u < 2080; u += F.G) { int nrow0, nh; const bool hn_ = u + F.G < 2080; gla_unit_rows(hn_ ? u + F.G : u, nrow0, nh);
            gla_g1_unit(F, P, l, u, ops_, hn_, nrow0, nh); } }
        LDS_BARRIER(); }
        } else if (wh_ == 1) {
        for (int rep = 0; rep < REP_F1U; ++rep) { PHASE_ENV();
        { f1_lat_tables(F, P);
          F1Ops fo_; { const int u = F.bid, b = u >> 9, nlo = (u >> 2) & 127, h = u & 3; f1_lat_load_u(F, P, b * SEQ + nlo, h, fo_.uv); f1_lat_load_t(F, (const bf16_t*)(ws + WS_TLAT) + (size_t)nlo * 32768, fo_.tcp, fo_.tsp); }
          for (int u = F.bid; u < 1024; u += F.G) { const int b = u >> 9, nlo = (u >> 2) & 127, h = u & 3; const bool hn_ = u + F.G < 1024; const int un = hn_ ? u + F.G : u, bn = un >> 9, nlon = (un >> 2) & 127, hn = un & 3;
            fourier_f1_lat_unit(F, P, h, b * SEQ + nlo, fo_, hn_, bn * SEQ + nlon, hn, (const bf16_t*)(ws + WS_TLAT) + (size_t)nlon * 32768); } }
        }
        { PHASE_ENV();
        if (!last) for (int u = (F.bid + F.G - 32) % F.G; u < 8; u += F.G) { const int b = u >> 2, h = u & 3;
            fourier_f1_unit<256, 2>(F, P, NLAT + b * CTXL, 1, h, (const bf16_t*)(ws + WS_TCTX), NLAT + b * CTXL, 1.0f / 128.0f); }
        }
        } else {
        for (int rep = 0; rep < REP_CONV; ++rep) { PHASE_ENV();
        for (int u = F.bid; u < 512 + F.G; u += F.G) {
            int rowbase = 64 * u, Ls = 64, t0 = 0;
            if (u >= 512) { const int q = (u - 512) - 40; if (last || q < 0 || q >= 8) break; rowbase = NLAT + (q >> 2) * CTXL; Ls = CTXL; t0 = 64 * (q & 3); }
            conv_unit(F, P, l, rowbase, Ls, t0); } }
        }
        LDS_BARRIER(); }
        GRID_BAR_SH(0, 3);
        { PHASE_ENV(); gla_scan(F, P, l * WT_PER_LAYER + WT_I_IN + WT_I_OUT + NE * WT_I_GU, (l + 1) * WT_PER_LAYER); LDS_BARRIER(); }
        for (int rep = 0; rep < REP_F2U; ++rep) { PHASE_ENV();
        fourier_f2_tables(F, P);
        for (int u = F.bid; u < 512; u += F.G) fourier_f2_unit(F, P, u >> 8, (u >> 1) & 127, u & 1); }
        GRID_BAR_SH(0, 4);
        for (int rep = 0; rep < REP_G3U; ++rep) { PHASE_ENV();
        {
        constexpr int NU3 = last ? 2048 : 2080;
        float ngv_[4];
#pragma unroll
        for (int nt = 0; nt < 4; ++nt) ngv_[nt] = (P.in[13] + (size_t)l * 128)[(F.wave >> 2) * 64 + nt * 16 + (F.lane & 15)];
        G3Ops ops_; { int r0_, h0_; gla_unit_rows(F.bid, r0_, h0_); ops_.gr = gla_load_gate_regs(F, P, l, r0_, h0_); gla_load_q(F, P, r0_, h0_, ops_.qv); gla_load_k(F, P, r0_, h0_, ops_.kv);
            gla_load_v(F, P, r0_, h0_, ops_.vv); gla_load_r(F, P, r0_, h0_, ops_.rv); gla_load_state(F, P, F.bid, ops_.stv); }
        for (int u = F.bid; u < NU3; u += F.G) { int row0, h, nrow0, nh; gla_unit_rows(u, row0, h); const bool hn_ = u + F.G < NU3; gla_unit_rows(hn_ ? u + F.G : u, nrow0, nh);
            gla_g3_unit(F, P, l, row0, h, u, ops_, ngv_, hn_, nrow0, nh, hn_ ? u + F.G : u); } }
        LDS_BARRIER(); }
        GRID_BAR_SH(0, 5);
        { PHASE_ENV(); const int M2 = NLAT;
          pg8::Gemm g{(const bf16_t*)(ws + WS_CAT), (const bf16_t*)(ws + WS_WOUT8 + (size_t)l * D * D), M2, D, D / 2};
          pg8::StaticOrder S; S.init(M2, D, F.G, F.bid);
          pg8::EpiResid<l == 0> E{(bf16_t*)(ws + WS_XRES), (l == 0) ? (const void*)P.in[0] : (const void*)(ws + WS_XRES), (const float*)(ws + WS_MODF) + (size_t)l * 3 * 6144, 0.015625f};
          pg8::gemm_phase<pg8::EpiResid<l == 0>, pg8::StaticOrder, true, true, true>(F.lds, g, S, E, F.tid);
          if (!last) for (int t = F.bid; t < 2 * 32; t += F.G) { const int pm = NLAT / 256 + (t >> 5), nt32 = t & 31;
              SkEpiResid SE{(bf16_t*)(ws + WS_XRES) + (size_t)pm * 256 * D + nt32 * 32, P.in[2] + (size_t)(pm - NLAT / 256) * 256 * D + nt32 * 32, (const float*)(ws + WS_MODF) + ((size_t)l * 3 + 2) * 6144 + 2 * 1024 + nt32 * 32};
              skinny_unit(F, (const bf16_t*)(ws + WS_CATC) + (size_t)(pm - NLAT / 256) * 256 * D, (const bf16_t*)(ws + WS_WOUT) + (size_t)l * D * D + (size_t)nt32 * 32 * D, SE); } }
        GRID_BAR_SH(0, 6);
        const int ntok = last ? NLAT : NTOK;
        { PHASE_ENV(); phase_route(F, P, l, ntok); }
        GRID_BAR_SH(1, 0);
        for (int rep = 0; rep < REP_GU; ++rep) { PHASE_ENV(); moe_prep(F, P, l); const volatile LAS int* TS = (const volatile LAS int*)(F.lds + LC_TS);
          pg8::MoeOrder S{8, F.G, F.bid, TS[NE], TS};
          pg8::moe_desync(TS[NE], 8, F.G, F.bid);
          if constexpr (F8_LAYER[l]) {
              pg8::Gemm g{(const bf16_t*)(ws + WS_HB8), (const bf16_t*)(ws + WS_WGU + (size_t)l * NE * 2048 * D * 2), 0, 2048, D / 2};
              pg8::EpiGateUp8 E{ws + WS_ACT, P.in[22] + (size_t)l * NE * 2048};
              pg8::gemm_phase_gather<pg8::EpiGateUp8, pg8::MoeOrder, true>(F.lds, g, (const int*)(ws + WS_XB), S, E, F.tid);
          } else {
              pg8::Gemm g{(const bf16_t*)(ws + WS_HBUF), (const bf16_t*)(ws + WS_WGU) + (size_t)l * NE * 2048 * D, 0, 2048, D};
              pg8::EpiGateUp E{(bf16_t*)(ws + WS_ACT), P.in[22] + (size_t)l * NE * 2048};
              pg8::gemm_phase_gather<pg8::EpiGateUp, pg8::MoeOrder>(F.lds, g, (const int*)(ws + WS_XB), S, E, F.tid); } }
        GRID_BAR_SH(1, 1);
        for (int rep = 0; rep < REP_DN; ++rep) { PHASE_ENV(); const volatile LAS int* TS = (const volatile LAS int*)(F.lds + LC_TS);
          pg8::MoeOrder S{4, F.G, F.bid, TS[NE], TS};
          pg8::moe_desync(TS[NE], 4, F.G, F.bid);
          if constexpr (F8_LAYER[l]) {
              pg8::Gemm g{(const bf16_t*)(ws + WS_ACT), (const bf16_t*)(ws + WS_WDN + (size_t)l * NE * D * DFF * 2), 0, D, DFF / 2};
              pg8::EpiDown8 E{ws + WS_YB, P.in[24] + (size_t)l * NE * D};
              pg8::gemm_phase<pg8::EpiDown8, pg8::MoeOrder, true, true, true>(F.lds, g, S, E, F.tid);
          } else {
              pg8::Gemm g{(const bf16_t*)(ws + WS_ACT), (const bf16_t*)(ws + WS_WDN) + (size_t)l * NE * D * DFF, 0, D, DFF};
              pg8::EpiDown E{(bf16_t*)(ws + WS_YB), P.in[24] + (size_t)l * NE * D};
              pg8::gemm_phase<pg8::EpiDown, pg8::MoeOrder>(F.lds, g, S, E, F.tid); } }
        GRID_BAR_SH(1, 2);
        { PHASE_ENV(); phase_combine(F, P, l, ntok, last); }
        if (!last) GRID_BAR_SH(1, 3);
    }
    {
        constexpr int l = 1; constexpr bool last = (l == DEPTH - 1);
        for (int rep = 0; rep < REP_GEMM1; ++rep) { PHASE_ENV();
          const int nun = (NTOK / 256) * (INP / 256), rr = nun % F.G, first = (rr == 0) ? 0 : rr, nidle = F.G - first;
          if (F.bid >= first) for (int t = F.bid - first; t < NTOK / 256; t += nidle) {
              SkEpiBf16 SE{(bf16_t*)(ws + WS_LRB) + (size_t)t * 256 * 32, 32};
              skinny_unit(F, (const bf16_t*)(ws + WS_HBUF) + (size_t)t * 256 * D, (const bf16_t*)(ws + WS_WGT) + (size_t)l * 32 * D, SE); }
          pg8::StaticOrder S; S.init(NTOK, INP, F.G, F.bid);
          if constexpr (F8_GEMM1[l]) {
              pg8::Gemm g{(const bf16_t*)(ws + WS_HB8), (const bf16_t*)(ws + WS_WIN + (size_t)l * INP * D * 2), NTOK, INP, D / 2};
              pg8::EpiStoreBf16S E{(bf16_t*)(ws + WS_PBUF), INP};
              pg8::gemm_phase<pg8::EpiStoreBf16S, pg8::StaticOrder, true, true, true>(F.lds, g, S, E, F.tid);
          } else {
              pg8::Gemm g{(const bf16_t*)(ws + WS_HBUF), (const bf16_t*)(ws + WS_WIN) + (size_t)l * INP * D, NTOK, INP, D};
              pg8::EpiStoreBf16 E{(bf16_t*)(ws + WS_PBUF), INP};
              pg8::gemm_phase<pg8::EpiStoreBf16, pg8::StaticOrder>(F.lds, g, S, E, F.tid); }
 }
        GRID_BAR_SH(1, 4);
        for (int st_ = 0; st_ < 3; ++st_) { const int wh_ = ((F0.bid >> 3) & 1) ? 2 - st_ : st_;
        if (wh_ == 0) {
        for (int rep = 0; rep < REP_G1U; ++rep) { PHASE_ENV();
        { LAS unsigned char* scr8 = F.lds + GL_WT8 + F.wave * 2304; const int gw_ = F.bid * NWAVES + F.wave, NGW_ = F.G * NWAVES;
          constexpr int QHI = NE * WT_I_GU; const int QLO = (l == 0 ? 7 : 9) * SH_N * 7 * F.G, nbg = (QHI - QLO + NGW_ - 1) / NGW_; int q_ = QLO + gw_;
        G1Ops ops_; { int r0_, h0_; gla_unit_rows(F.bid, r0_, h0_); ops_.gr = gla_load_gate_regs(F, P, l, r0_, h0_); gla_load_kt(F, P, r0_, h0_, ops_.kv); gla_load_v(F, P, r0_, h0_, ops_.vv); }
        int u = F.bid;
        for (int i_ = 0; i_ < nbg && u < 2080; ++i_, u += F.G) { int nrow0, nh; const bool hn_ = u + F.G < 2080; gla_unit_rows(hn_ ? u + F.G : u, nrow0, nh);
            float tv_[32]; const WtSrc ws_ = wt_decode(P, l, q_ < QHI ? q_ : QHI - 1); wt_issue(ws_, F.lane, tv_);
            gla_g1_unit(F, P, l, u, ops_, hn_, nrow0, nh);
            wt_finish(ws_, F.lane, tv_, scr8); q_ += NGW_; }
        for (; u < 2080; u += F.G) { int nrow0, nh; const bool hn_ = u + F.G < 2080; gla_unit_rows(hn_ ? u + F.G : u, nrow0, nh);
            gla_g1_unit(F, P, l, u, ops_, hn_, nrow0, nh); } }
        LDS_BARRIER(); }
        } else if (wh_ == 1) {
        for (int rep = 0; rep < REP_F1U; ++rep) { PHASE_ENV();
        { f1_lat_tables(F, P);
          F1Ops fo_; { const int u = F.bid, b = u >> 9, nlo = (u >> 2) & 127, h = u & 3; f1_lat_load_u(F, P, b * SEQ + nlo, h, fo_.uv); f1_lat_load_t(F, (const bf16_t*)(ws + WS_TLAT) + (size_t)nlo * 32768, fo_.tcp, fo_.tsp); }
          for (int u = F.bid; u < 1024; u += F.G) { const int b = u >> 9, nlo = (u >> 2) & 127, h = u & 3; const bool hn_ = u + F.G < 1024; const int un = hn_ ? u + F.G : u, bn = un >> 9, nlon = (un >> 2) & 127, hn = un & 3;
            fourier_f1_lat_unit(F, P, h, b * SEQ + nlo, fo_, hn_, bn * SEQ + nlon, hn, (const bf16_t*)(ws + WS_TLAT) + (size_t)nlon * 32768); } }
        }
        { PHASE_ENV();
        if (!last) for (int u = (F.bid + F.G - 32) % F.G; u < 8; u += F.G) { const int b = u >> 2, h = u & 3;
            fourier_f1_unit<256, 2>(F, P, NLAT + b * CTXL, 1, h, (const bf16_t*)(ws + WS_TCTX), NLAT + b * CTXL, 1.0f / 128.0f); }
        }
        } else {
        for (int rep = 0; rep < REP_CONV; ++rep) { PHASE_ENV();
        for (int u = F.bid; u < 512 + F.G; u += F.G) {
            int rowbase = 64 * u, Ls = 64, t0 = 0;
            if (u >= 512) { const int q = (u - 512) - 40; if (last || q < 0 || q >= 8) break; rowbase = NLAT + (q >> 2) * CTXL; Ls = CTXL; t0 = 64 * (q & 3); }
            conv_unit(F, P, l, rowbase, Ls, t0); } }
        }
        LDS_BARRIER(); }
        GRID_BAR_SH(1, 5);
        { PHASE_ENV(); gla_scan(F, P, l * WT_PER_LAYER + WT_I_IN + WT_I_OUT + NE * WT_I_GU, (l + 1) * WT_PER_LAYER); LDS_BARRIER(); }
        for (int rep = 0; rep < REP_F2U; ++rep) { PHASE_ENV();
        fourier_f2_tables(F, P);
        for (int u = F.bid; u < 512; u += F.G) fourier_f2_unit(F, P, u >> 8, (u >> 1) & 127, u & 1); }
        GRID_BAR_SH(1, 6);
        for (int rep = 0; rep < REP_G3U; ++rep) { PHASE_ENV();
        {
        constexpr int NU3 = last ? 2048 : 2080;
        float ngv_[4];
#pragma unroll
        for (int nt = 0; nt < 4; ++nt) ngv_[nt] = (P.in[13] + (size_t)l * 128)[(F.wave >> 2) * 64 + nt * 16 + (F.lane & 15)];
        G3Ops ops_; { int r0_, h0_; gla_unit_rows(F.bid, r0_, h0_); ops_.gr = gla_load_gate_regs(F, P, l, r0_, h0_); gla_load_q(F, P, r0_, h0_, ops_.qv); gla_load_k(F, P, r0_, h0_, ops_.kv);
            gla_load_v(F, P, r0_, h0_, ops_.vv); gla_load_r(F, P, r0_, h0_, ops_.rv); gla_load_state(F, P, F.bid, ops_.stv); }
        for (int u = F.bid; u < NU3; u += F.G) { int row0, h, nrow0, nh; gla_unit_rows(u, row0, h); const bool hn_ = u + F.G < NU3; gla_unit_rows(hn_ ? u + F.G : u, nrow0, nh);
            gla_g3_unit(F, P, l, row0, h, u, ops_, ngv_, hn_, nrow0, nh, hn_ ? u + F.G : u); } }
        LDS_BARRIER(); }
        GRID_BAR_SH(1, 7);
        { PHASE_ENV(); const int M2 = NLAT;
          pg8::Gemm g{(const bf16_t*)(ws + WS_CAT), (const bf16_t*)(ws + WS_WOUT8 + (size_t)l * D * D), M2, D, D / 2};
          pg8::StaticOrder S; S.init(M2, D, F.G, F.bid);
          pg8::EpiResid<l == 0> E{(bf16_t*)(ws + WS_XRES), (l == 0) ? (const void*)P.in[0] : (const void*)(ws + WS_XRES), (const float*)(ws + WS_MODF) + (size_t)l * 3 * 6144, 0.015625f};
          pg8::gemm_phase<pg8::EpiResid<l == 0>, pg8::StaticOrder, true, true, true>(F.lds, g, S, E, F.tid);
          if (!last) for (int t = F.bid; t < 2 * 32; t += F.G) { const int pm = NLAT / 256 + (t >> 5), nt32 = t & 31;
              SkEpiResid SE{(bf16_t*)(ws + WS_XRES) + (size_t)pm * 256 * D + nt32 * 32, P.in[2] + (size_t)(pm - NLAT / 256) * 256 * D + nt32 * 32, (const float*)(ws + WS_MODF) + ((size_t)l * 3 + 2) * 6144 + 2 * 1024 + nt32 * 32};
              skinny_unit(F, (const bf16_t*)(ws + WS_CATC) + (size_t)(pm - NLAT / 256) * 256 * D, (const bf16_t*)(ws + WS_WOUT) + (size_t)l * D * D + (size_t)nt32 * 32 * D, SE); } }
        GRID_BAR_SH(1, 8);
        const int ntok = last ? NLAT : NTOK;
        { PHASE_ENV(); phase_route(F, P, l, ntok); }
        GRID_BAR();
        for (int rep = 0; rep < REP_GU; ++rep) { PHASE_ENV(); moe_prep(F, P, l); const volatile LAS int* TS = (const volatile LAS int*)(F.lds + LC_TS);
          pg8::MoeOrder S{8, F.G, F.bid, TS[NE], TS};
          pg8::moe_desync(TS[NE], 8, F.G, F.bid);
          if constexpr (F8_LAYER[l]) {
              pg8::Gemm g{(const bf16_t*)(ws + WS_HB8), (const bf16_t*)(ws + WS_WGU + (size_t)l * NE * 2048 * D * 2), 0, 2048, D / 2};
              pg8::EpiGateUp8 E{ws + WS_ACT, P.in[22] + (size_t)l * NE * 2048};
              pg8::gemm_phase_gather<pg8::EpiGateUp8, pg8::MoeOrder, true>(F.lds, g, (const int*)(ws + WS_XB), S, E, F.tid);
          } else {
              pg8::Gemm g{(const bf16_t*)(ws + WS_HBUF), (const bf16_t*)(ws + WS_WGU) + (size_t)l * NE * 2048 * D, 0, 2048, D};
              pg8::EpiGateUp E{(bf16_t*)(ws + WS_ACT), P.in[22] + (size_t)l * NE * 2048};
              pg8::gemm_phase_gather<pg8::EpiGateUp, pg8::MoeOrder>(F.lds, g, (const int*)(ws + WS_XB), S, E, F.tid); } }
        GRID_BAR();
        for (int rep = 0; rep < REP_DN; ++rep) { PHASE_ENV(); const volatile LAS int* TS = (const volatile LAS int*)(F.lds + LC_TS);
          pg8::MoeOrder S{4, F.G, F.bid, TS[NE], TS};
          pg8::moe_desync(TS[NE], 4, F.G, F.bid);
          if constexpr (F8_LAYER[l]) {
              pg8::Gemm g{(const bf16_t*)(ws + WS_ACT), (const bf16_t*)(ws + WS_WDN + (size_t)l * NE * D * DFF * 2), 0, D, DFF / 2};
              pg8::EpiDown8 E{ws + WS_YB, P.in[24] + (size_t)l * NE * D};
              pg8::gemm_phase<pg8::EpiDown8, pg8::MoeOrder, true, true, true>(F.lds, g, S, E, F.tid);
          } else {
              pg8::Gemm g{(const bf16_t*)(ws + WS_ACT), (const bf16_t*)(ws + WS_WDN) + (size_t)l * NE * D * DFF, 0, D, DFF};
              pg8::EpiDown E{(bf16_t*)(ws + WS_YB), P.in[24] + (size_t)l * NE * D};
              pg8::gemm_phase<pg8::EpiDown, pg8::MoeOrder>(F.lds, g, S, E, F.tid); } }
        GRID_BAR();
        { PHASE_ENV(); phase_combine(F, P, l, ntok, last); }
        if (!last) GRID_BAR();
    }
}

extern "C" void kernel_launch(void* const* d_in, const int* in_sizes, int n_in, void* d_out, int out_size, void* d_ws, size_t ws_size, hipStream_t stream) {
    static int grid = 0;
    if (grid == 0) {
        if (n_in != 26 || ws_size < WS_END) { fprintf(stderr, "kernel_launch: unexpected n_in %d or ws_size %zu (need %zu)\n", n_in, ws_size, (size_t)WS_END); grid = -1; return; }
        int dev = 0, cus = 0, per_cu = 0;
        if (hipGetDevice(&dev) != hipSuccess || hipDeviceGetAttribute(&cus, hipDeviceAttributeMultiprocessorCount, dev) != hipSuccess) { grid = -1; return; }
        if (hipFuncSetAttribute((const void*)mega_fwd, hipFuncAttributeMaxDynamicSharedMemorySize, LDS_BYTES) != hipSuccess) { fprintf(stderr, "kernel_launch: hipFuncSetAttribute failed\n"); grid = -1; return; }
        if (hipOccupancyMaxActiveBlocksPerMultiprocessor(&per_cu, (const void*)mega_fwd, NTHREADS, LDS_BYTES) != hipSuccess || per_cu < 1) { fprintf(stderr, "kernel_launch: occupancy query says %d\n", per_cu); }
        (void)hipGetLastError();
        grid = cus;
    }
    if (grid < 0) return;
    (void)hipMemsetAsync((char*)d_ws + WS_CTL, 0, CTL_ZERO_BYTES, stream);
    Params p{};
    for (int i = 0; i < 26; ++i) p.in[i] = (const float*)d_in[i];
    p.out = (float*)d_out; p.ws = (unsigned char*)d_ws;
    hipLaunchKernelGGL(mega_fwd, dim3(grid), dim3(NTHREADS), LDS_BYTES, stream, p);
}
```
